# Optimizing an MI355X kernel written in HIP

```python
import math
import jax
import jax.numpy as jnp
from jax import lax
import numpy as np

D_MODEL = 1024
BATCH = 8
SEQ = 2048
DEPTH = 2
DEC_BATCH = 128
DEC_SEQ = 1
PAST_LEN = 16384
PAGE_SIZE = 128

DN_ALPHA = (2 * DEPTH) ** 0.25
DN_BETA = (8 * DEPTH) ** -0.25
LN_EPS = 1e-5
RMS_EPS = 1e-5
FFN_RES = 0.5
D_FF = 2752
N_MODS = 9

GLA_HEADS = 4
GLA_DK = 64
GLA_DV = 128
GLA_KEY = GLA_HEADS * GLA_DK
GLA_VAL = GLA_HEADS * GLA_DV
GLA_GATE_RANK = 16
GLA_GATE_NORM = 16.0
GLA_CHUNK = 32

S5_GROUP = 16
S5_WIDTH = 512
S5_GROUPS = S5_WIDTH // S5_GROUP
S5_STATE = 64
S5_DT_MIN = 1e-3
S5_DT_MAX = 1e-1

MIX_WIDTH = GLA_VAL + S5_WIDTH
IN_SPLITS = (GLA_KEY, 2 * GLA_KEY, 2 * GLA_KEY + GLA_VAL, 2 * GLA_KEY + 2 * GLA_VAL, 2 * GLA_KEY + 2 * GLA_VAL + GLA_GATE_RANK)
IN_WIDTH = 2 * GLA_KEY + 2 * GLA_VAL + GLA_GATE_RANK + S5_WIDTH

RWKV_HEAD = 64
RWKV_HEADS = D_MODEL // RWKV_HEAD
RWKV_DECAY_LORA = 64
RWKV_A_LORA = 64
RWKV_GATE_LORA = 160
RWKV_LNX_EPS = 64e-5
NORM_EPS = 1e-12

kernel_name = 'hybrid_gla_s5_rwkv7_adaln_deepnorm_step'


def layer_norm(x, g, b, eps=LN_EPS):
    xf = x.astype(jnp.float32)
    mu = jnp.mean(xf, -1, keepdims=True)
    var = jnp.mean(jnp.square(xf - mu), -1, keepdims=True)
    return ((xf - mu) * lax.rsqrt(var + eps) * g.astype(jnp.float32) + b.astype(jnp.float32)).astype(x.dtype)


def post_norm(x, r, g, b):
    return layer_norm(DN_ALPHA * x + r, g, b)


def swiglu(h, wg, wu, wd):
    return (jax.nn.silu(h @ wg) * (h @ wu)) @ wd


def ada_mods(c, w, b):
    m = jax.nn.silu(c) @ w + b
    return jnp.split(m[:, None, :], N_MODS, axis=-1)


def gla_chunked(q, k, v, gk, s0):
    f32 = jnp.float32
    B, T, H = q.shape[0], q.shape[1], q.shape[2]
    C = min(GLA_CHUNK, T)
    n = -(-T // C)
    pad = n * C - T

    def blk(t):
        t = jnp.pad(t.astype(f32), ((0, 0), (0, pad), (0, 0), (0, 0)))
        return t.reshape(B, n, C, t.shape[2], t.shape[3])

    q, k, v, gk = blk(q), blk(k), blk(v), blk(gk)
    b = jnp.cumsum(gk, axis=2)
    b_last = b[:, :, -1:]
    q_in = q * jnp.exp(b)
    k_in = k * jnp.exp(-b)
    k_st = k * jnp.exp(b_last - b)
    causal = jnp.tril(jnp.ones((C, C), dtype=bool))
    scores = jnp.where(causal, jnp.einsum('bnthd,bnshd->bnhts', q_in, k_in), 0.0)
    o_intra = jnp.einsum('bnhts,bnshv->bnthv', scores, v)
    kv = jnp.einsum('bnshd,bnshv->bnhdv', k_st, v)
    decay = jnp.exp(b_last[:, :, 0])

    def step(s, inp):
        dec, kv_n = inp
        return dec[..., None] * s + kv_n, s

    s_final, s_prev = lax.scan(step, s0.astype(f32), (jnp.moveaxis(decay, 1, 0), jnp.moveaxis(kv, 1, 0)))
    s_prev = jnp.moveaxis(s_prev, 0, 1)
    o = o_intra + jnp.einsum('bnthd,bnhdv->bnthv', q_in, s_prev)
    o = o.reshape(B, n * C, H, v.shape[-1])[:, :T]
    return o, s_final


def s5_scan(u, a_re, a_im, log_step, b_re, b_im, c_re, c_im, d, h0_re, h0_im):
    f32 = jnp.float32
    a_re, a_im = a_re.astype(f32), a_im.astype(f32)
    b_re, b_im = b_re.astype(f32), b_im.astype(f32)
    c_re, c_im = c_re.astype(f32), c_im.astype(f32)
    dt = jnp.exp(log_step.astype(f32))[:, None]
    mag = jnp.exp(a_re * dt)
    ab_re = mag * jnp.cos(a_im * dt)
    ab_im = mag * jnp.sin(a_im * dt)
    den = jnp.square(a_re) + jnp.square(a_im)
    nr = ab_re - 1.0
    z_re = (nr * a_re + ab_im * a_im) / den
    z_im = (ab_im * a_re - nr * a_im) / den
    bb_re = z_re[..., None] * b_re - z_im[..., None] * b_im
    bb_im = z_re[..., None] * b_im + z_im[..., None] * b_re
    bu_re = jnp.einsum('btgc,gpc->btgp', u, bb_re)
    bu_im = jnp.einsum('btgc,gpc->btgp', u, bb_im)
    h0_re, h0_im = h0_re.astype(f32), h0_im.astype(f32)
    bu_re = bu_re.at[:, 0].add(ab_re * h0_re - ab_im * h0_im)
    bu_im = bu_im.at[:, 0].add(ab_re * h0_im + ab_im * h0_re)
    T = u.shape[1]
    a_shape = (1, T) + ab_re.shape
    elems = (jnp.broadcast_to(ab_re, a_shape), jnp.broadcast_to(ab_im, a_shape), bu_re, bu_im)

    def combine(e1, e2):
        a1r, a1i, b1r, b1i = e1
        a2r, a2i, b2r, b2i = e2
        return (a2r * a1r - a2i * a1i, a2r * a1i + a2i * a1r,
                a2r * b1r - a2i * b1i + b2r, a2r * b1i + a2i * b1r + b2i)

    _, _, h_re, h_im = lax.associative_scan(combine, elems, axis=1)
    y = (jnp.einsum('gcp,btgp->btgc', c_re, h_re) - jnp.einsum('gcp,btgp->btgc', c_im, h_im)
         + d.astype(f32) * u)
    return y, h_re[:, -1], h_im[:, -1]


def gla_s5_mixer(h, s_gla, s_re, s_im, w_in, w_out, gla_w_gk, gla_b_gk, gla_norm_g,
                 s5_a_re, s5_a_im, s5_log_step, s5_b_re, s5_b_im, s5_c_re, s5_c_im, s5_d,
                 s5_w_glu, s5_b_glu):
    f32 = jnp.float32
    B, T, _ = h.shape
    q, k, v, g, gk_low, u = jnp.split(h @ w_in, IN_SPLITS, axis=-1)
    q = q.reshape(B, T, GLA_HEADS, GLA_DK) * (GLA_DK ** -0.5)
    k = k.reshape(B, T, GLA_HEADS, GLA_DK)
    v = v.reshape(B, T, GLA_HEADS, GLA_DV)
    gk = jax.nn.log_sigmoid((gk_low @ gla_w_gk + gla_b_gk).astype(f32)) / GLA_GATE_NORM
    o, s_gla = gla_chunked(q, k, v, gk.reshape(B, T, GLA_HEADS, GLA_DK), s_gla)
    o = o * lax.rsqrt(jnp.mean(jnp.square(o), -1, keepdims=True) + RMS_EPS) * gla_norm_g.astype(f32)
    o_gla = o.reshape(B, T, GLA_VAL).astype(h.dtype) * jax.nn.silu(g)
    y, s_re, s_im = s5_scan(u.reshape(B, T, S5_GROUPS, S5_GROUP).astype(f32), s5_a_re, s5_a_im,
                            s5_log_step, s5_b_re, s5_b_im, s5_c_re, s5_c_im, s5_d, s_re, s_im)
    z = jax.nn.gelu(y.reshape(B, T, S5_WIDTH)).astype(h.dtype)
    o_s5 = z * jax.nn.sigmoid(z @ s5_w_glu + s5_b_glu)
    out = jnp.concatenate([o_gla, o_s5], axis=-1) @ w_out
    return out, s_gla, s_re, s_im


def wkv7_scan(r, w, k, v, a, b, s0):
    def step(s, inp):
        r_t, w_t, k_t, v_t, a_t, b_t = inp
        sa = jnp.einsum('bhij,bhj->bhi', s, a_t)
        s = s * w_t[:, :, None, :] + sa[..., None] * b_t[:, :, None, :] + v_t[..., None] * k_t[:, :, None, :]
        return s, jnp.einsum('bhij,bhj->bhi', s, r_t)

    xs = tuple(jnp.moveaxis(t, 1, 0) for t in (r, w, k, v, a, b))
    s_final, y = lax.scan(step, s0, xs)
    return jnp.moveaxis(y, 0, 1), s_final


def rwkv7_mixer(h, s_shift, s_wkv, mu, w_r, w_k, w_v, w_o, w0, w1, w2, a0, a1, a2,
                g1, g2, k_k, k_a, r_k, lnx_g, lnx_b):
    f32 = jnp.float32
    B, T, D = h.shape
    H, N = RWKV_HEADS, RWKV_HEAD
    prev = jnp.concatenate([s_shift[:, None, :].astype(h.dtype), h[:, :-1]], axis=1)
    xx = prev - h
    xr, xw, xk, xv, xa, xg = [h + xx * mu[i] for i in range(6)]
    r = xr @ w_r
    k = xk @ w_k
    v = xv @ w_v
    w = -jax.nn.softplus(-(w0 + jnp.tanh(xw @ w1) @ w2).astype(f32)) - 0.5
    a = jax.nn.sigmoid((a0 + (xa @ a1) @ a2).astype(f32))
    gate = jax.nn.sigmoid(xg @ g1) @ g2

    def heads(t):
        return t.astype(f32).reshape(B, T, H, N)

    r, k, v, a, w = heads(r), heads(k), heads(v), heads(a), heads(w)
    kk = k * k_k.astype(f32).reshape(H, N)
    kk = kk / jnp.maximum(jnp.sqrt(jnp.sum(jnp.square(kk), -1, keepdims=True)), NORM_EPS)
    k = k * (1.0 + (a - 1.0) * k_a.astype(f32).reshape(H, N))
    y, s_wkv = wkv7_scan(r, jnp.exp(-jnp.exp(w)), k, v, -kk, kk * a, s_wkv.astype(f32))
    mu_y = jnp.mean(y, -1, keepdims=True)
    var_y = jnp.mean(jnp.square(y - mu_y), -1, keepdims=True)
    y = ((y - mu_y) * lax.rsqrt(var_y + RWKV_LNX_EPS) * lnx_g.astype(f32).reshape(H, N)
         + lnx_b.astype(f32).reshape(H, N))
    y = y + jnp.sum(r * k * r_k.astype(f32), -1, keepdims=True) * v
    out = (y.reshape(B, T, D).astype(h.dtype) * gate) @ w_o
    return out, h[:, -1], s_wkv


def setup_inputs(seed: int = 0) -> dict:
    key = jax.random.key(seed)
    ks = iter(jax.random.split(key, 96))
    f32 = jnp.float32

    def nrm(shape, s=1.0):
        return s * jax.random.normal(next(ks), shape, f32)

    def uni(shape, lo, hi):
        return jax.random.uniform(next(ks), shape, f32, lo, hi)

    D, P, G = D_MODEL, S5_STATE, S5_GROUPS
    inp = {}
    inp['x_prompt'] = nrm((BATCH, SEQ, D))
    inp['x_sample'] = nrm((DEC_BATCH, DEC_SEQ, D))
    inp['state_gla'] = nrm((DEC_BATCH, GLA_HEADS, GLA_DK, GLA_DV), 0.5)
    inp['state_s5_re'] = nrm((DEC_BATCH, G, P), 0.5)
    inp['state_s5_im'] = nrm((DEC_BATCH, G, P), 0.5)
    inp['state_rwkv_shift'] = nrm((DEC_BATCH, D))
    inp['state_rwkv_wkv'] = nrm((DEC_BATCH, RWKV_HEADS, RWKV_HEAD, RWKV_HEAD), 0.3)
    inp['c_prompt'] = nrm((BATCH, D))
    inp['c_sample'] = nrm((DEC_BATCH, D))
    inp['ada_w'] = nrm((DEPTH, D, N_MODS * D), 0.3 * D ** -0.5)
    inp['ada_b'] = nrm((DEPTH, N_MODS * D), 0.02)
    inp['ln_g'] = 1.0 + nrm((DEPTH, 3, D), 0.02)
    inp['ln_b'] = nrm((DEPTH, 3, D), 0.02)
    for name in ('ffn1', 'ffn2'):
        inp[name + '_wg'] = nrm((DEPTH, D, D_FF), D ** -0.5)
        inp[name + '_wu'] = nrm((DEPTH, D, D_FF), D ** -0.5)
        inp[name + '_wd'] = nrm((DEPTH, D_FF, D), DN_BETA * D_FF ** -0.5)
    inp['w_in'] = nrm((D, IN_WIDTH), D ** -0.5)
    inp['w_out'] = nrm((MIX_WIDTH, D), DN_BETA * MIX_WIDTH ** -0.5)
    inp['gla_w_gk'] = nrm((GLA_GATE_RANK, GLA_KEY), GLA_GATE_RANK ** -0.5)
    inp['gla_b_gk'] = nrm((GLA_KEY,), 0.1)
    inp['gla_norm_g'] = 1.0 + nrm((GLA_DV,), 0.02)
    inp['s5_a_re'] = -0.5 + nrm((G, P), 0.01)
    inp['s5_a_im'] = jnp.pi * jnp.arange(P, dtype=f32)[None, :] + nrm((G, P), 0.01)
    inp['s5_log_step'] = uni((G,), math.log(S5_DT_MIN), math.log(S5_DT_MAX))
    inp['s5_b_re'] = nrm((G, P, S5_GROUP), (2 * S5_GROUP) ** -0.5)
    inp['s5_b_im'] = nrm((G, P, S5_GROUP), (2 * S5_GROUP) ** -0.5)
    inp['s5_c_re'] = nrm((G, S5_GROUP, P), (2 * P) ** -0.5)
    inp['s5_c_im'] = nrm((G, S5_GROUP, P), (2 * P) ** -0.5)
    inp['s5_d'] = nrm((G, S5_GROUP))
    inp['s5_w_glu'] = nrm((S5_WIDTH, S5_WIDTH), S5_WIDTH ** -0.5)
    inp['s5_b_glu'] = nrm((S5_WIDTH,), 0.02)
    inp['rwkv_mu'] = uni((6, D), 0.0, 1.0)
    inp['rwkv_w_r'] = nrm((D, D), D ** -0.5)
    inp['rwkv_w_k'] = nrm((D, D), D ** -0.5)
    inp['rwkv_w_v'] = nrm((D, D), D ** -0.5)
    inp['rwkv_w_o'] = nrm((D, D), DN_BETA * D ** -0.5)
    inp['rwkv_w0'] = uni((D,), -6.5, -1.5)
    inp['rwkv_w1'] = nrm((D, RWKV_DECAY_LORA), D ** -0.5)
    inp['rwkv_w2'] = nrm((RWKV_DECAY_LORA, D), 0.1 * RWKV_DECAY_LORA ** -0.5)
    inp['rwkv_a0'] = nrm((D,), 0.1)
    inp['rwkv_a1'] = nrm((D, RWKV_A_LORA), D ** -0.5)
    inp['rwkv_a2'] = nrm((RWKV_A_LORA, D), 0.1 * RWKV_A_LORA ** -0.5)
    inp['rwkv_g1'] = nrm((D, RWKV_GATE_LORA), D ** -0.5)
    inp['rwkv_g2'] = nrm((RWKV_GATE_LORA, D), RWKV_GATE_LORA ** -0.5)
    inp['rwkv_k_k'] = 0.85 + nrm((D,), 0.02)
    inp['rwkv_k_a'] = 1.0 + nrm((D,), 0.02)
    inp['rwkv_r_k'] = nrm((RWKV_HEADS, RWKV_HEAD), 0.1)
    inp['rwkv_lnx_g'] = 1.0 + nrm((D,), 0.02)
    inp['rwkv_lnx_b'] = nrm((D,), 0.02)
    return inp


def reference(x_prompt, x_sample, state_gla, state_s5_re, state_s5_im, state_rwkv_shift, state_rwkv_wkv,
              c_prompt, c_sample, ada_w, ada_b, ln_g, ln_b,
              ffn1_wg, ffn1_wu, ffn1_wd, ffn2_wg, ffn2_wu, ffn2_wd,
              w_in, w_out, gla_w_gk, gla_b_gk, gla_norm_g,
              s5_a_re, s5_a_im, s5_log_step, s5_b_re, s5_b_im, s5_c_re, s5_c_im, s5_d, s5_w_glu, s5_b_glu,
              rwkv_mu, rwkv_w_r, rwkv_w_k, rwkv_w_v, rwkv_w_o, rwkv_w0, rwkv_w1, rwkv_w2,
              rwkv_a0, rwkv_a1, rwkv_a2, rwkv_g1, rwkv_g2, rwkv_k_k, rwkv_k_a, rwkv_r_k,
              rwkv_lnx_g, rwkv_lnx_b):
    f32 = jnp.float32

    def run_group(x, c, s_gla, s_re, s_im, s_shift, s_wkv):
        for layer in range(DEPTH):
            sh1, sc1, gt1, sh2, sc2, gt2, sh3, sc3, gt3 = ada_mods(c, ada_w[layer], ada_b[layer])
            y = swiglu(x * (1.0 + sc1) + sh1, ffn1_wg[layer], ffn1_wu[layer], ffn1_wd[layer])
            x = post_norm(x, FFN_RES * (1.0 + gt1) * y, ln_g[layer, 0], ln_b[layer, 0])
            h = x * (1.0 + sc2) + sh2
            if layer % 2 == 0:
                y, s_gla, s_re, s_im = gla_s5_mixer(
                    h, s_gla, s_re, s_im, w_in, w_out, gla_w_gk, gla_b_gk, gla_norm_g,
                    s5_a_re, s5_a_im, s5_log_step, s5_b_re, s5_b_im, s5_c_re, s5_c_im, s5_d,
                    s5_w_glu, s5_b_glu)
            else:
                y, s_shift, s_wkv = rwkv7_mixer(
                    h, s_shift, s_wkv, rwkv_mu, rwkv_w_r, rwkv_w_k, rwkv_w_v, rwkv_w_o,
                    rwkv_w0, rwkv_w1, rwkv_w2, rwkv_a0, rwkv_a1, rwkv_a2, rwkv_g1, rwkv_g2,
                    rwkv_k_k, rwkv_k_a, rwkv_r_k, rwkv_lnx_g, rwkv_lnx_b)
            x = post_norm(x, (1.0 + gt2) * y, ln_g[layer, 1], ln_b[layer, 1])
            y = swiglu(x * (1.0 + sc3) + sh3, ffn2_wg[layer], ffn2_wu[layer], ffn2_wd[layer])
            x = post_norm(x, FFN_RES * (1.0 + gt3) * y, ln_g[layer, 2], ln_b[layer, 2])
        return x, s_gla, s_re, s_im, s_shift, s_wkv

    bp = x_prompt.shape[0]
    y_prompt, gla_p, s5_re_p, s5_im_p, shift_p, wkv_p = run_group(
        x_prompt, c_prompt,
        jnp.zeros((bp, GLA_HEADS, GLA_DK, GLA_DV), f32),
        jnp.zeros((bp, S5_GROUPS, S5_STATE), f32),
        jnp.zeros((bp, S5_GROUPS, S5_STATE), f32),
        jnp.zeros((bp, D_MODEL), x_prompt.dtype),
        jnp.zeros((bp, RWKV_HEADS, RWKV_HEAD, RWKV_HEAD), f32))
    y_sample, gla_s, s5_re_s, s5_im_s, shift_s, wkv_s = run_group(
        x_sample, c_sample, state_gla, state_s5_re, state_s5_im, state_rwkv_shift, state_rwkv_wkv)
    return (y_prompt, y_sample, gla_p, s5_re_p, s5_im_p, shift_p, wkv_p,
            gla_s, s5_re_s, s5_im_s, shift_s, wkv_s)
```

```cpp
#include <hip/hip_runtime.h>
#include <cstdint>
#include <cstdio>

typedef unsigned short bf16;
typedef short bf16x8 __attribute__((ext_vector_type(8)));
typedef float f32x4 __attribute__((ext_vector_type(4)));
#define DEVI __device__ __forceinline__

constexpr int D = 1024, NP = 16384, NS = 128, MT = NP + NS, MTP = 16640, TP = 2048, BP = 8;
constexpr int FF = 2752, FFP = 2816, NUP = 2 * FFP;
constexpr int NIN = 2064, NINP = 2304;
constexpr int NRK = 3584, KRK = 2048, NL1 = 384;
constexpr int NMODROW = 136;
constexpr float ALPHA = 1.41421356237309515f;

constexpr size_t O_Y = 0, O_GLA_P = 16908288, O_S5RE_P = 17170432, O_S5IM_P = 17186816, O_SHIFT_P = 17203200, O_WKV_P = 17211392,
                 O_GLA_S = 17735680, O_S5RE_S = 21929984, O_S5IM_S = 22192128, O_SHIFT_S = 22454272, O_WKV_S = 22585344;

constexpr size_t MiB = 1u << 20;
constexpr size_t WS_MODS = 1 * MiB, WS_SP = 12 * MiB;
constexpr size_t WS_W = 13 * MiB;
constexpr size_t WS_WUP0 = WS_W;
constexpr size_t SZ_WUP = (size_t)NUP * D * 2;
constexpr size_t SZ_WDN = (size_t)D * FFP * 2;
constexpr size_t WS_L0 = WS_W;
constexpr size_t WS_WUP_L0 = WS_L0, WS_WDN_L0 = WS_L0 + 22 * MiB, WS_WIN = WS_L0 + 33 * MiB, WS_WGLU = WS_WIN + 4608 * 1024, WS_WOUT = WS_WGLU + 512 * 1024;
constexpr size_t WS_L1 = WS_L0 + 40 * MiB;
constexpr size_t WS_WUP_L1 = WS_L1, WS_WDN_L1 = WS_L1 + 22 * MiB, WS_WRK = WS_L1 + 33 * MiB, WS_WL2 = WS_WRK + 14 * MiB, WS_WO = WS_WL2 + 2304 * 1024;
static_assert(WS_WO + 2 * MiB <= 105 * MiB, "W region");
constexpr size_t WS_H = 105 * MiB, WS_Z = 138 * MiB, WS_ACT = 203 * MiB, WS_S2 = 293 * MiB, WS_END = 340 * MiB;
constexpr size_t WS_P = WS_ACT, WS_GKL = 277 * MiB, WS_OG = WS_S2, WS_Z5 = WS_Z, WS_O = WS_H;
constexpr size_t WS_A2 = WS_ACT, WS_R = WS_H, WS_K = WS_Z, WS_V = WS_Z + (size_t)MTP * D * 2, WS_L1A = WS_L0, WS_WD = WS_ACT, WS_AS = 268 * MiB, WS_G = WS_AS + (size_t)MTP * D * 2;
static_assert(WS_G + (size_t)MTP * D * 2 <= WS_END, "ws");

DEVI unsigned f2bf(float f) { unsigned u = __float_as_uint(f); return (u + 0x7fffu + ((u >> 16) & 1u)) >> 16; }
DEVI float bf2f(unsigned short h) { return __uint_as_float(((unsigned)h) << 16); }
DEVI int mrow(int i) { return i < NP ? (i >> 11) : (8 + i - NP); }
DEVI float sigmoidf_(float x) { return 1.0f / (1.0f + __expf(-x)); }
DEVI float siluf_(float x) { return x / (1.0f + __expf(-x)); }
DEVI float softplusf_(float x) { return fmaxf(x, 0.f) + log1pf(__expf(-fabsf(x))); }
DEVI float gelu_tanh(float x) { const float u = 0.7978845608028654f * (x + 0.044715f * x * x * x); return 0.5f * x * (1.0f + tanhf(u)); }
DEVI float wave_sum(float v) {
#pragma unroll
    for (int o = 1; o < 64; o <<= 1) v += __shfl_xor(v, o);
    return v;
}

struct CvtJob { const float* s0; const float* s1; const float* s2; const float* mu; bf16* dst; int mode, Nd, Kd, K, N, pad; };
struct RkPtrs { const float *w_r, *w_k, *w_v, *w1, *a1, *g1, *w2, *a2, *g2, *mu; };
DEVI float cvt_src(const CvtJob& j, const RkPtrs& rk, int k, int n) {
    switch (j.mode) {
    case 0: return (k < j.K && n < j.N) ? j.s0[(size_t)k * j.N + n] : 0.f;
    case 1: { const int pn = n >> 8, jj = n & 255, half = jj >> 7, c = pn * 128 + (jj & 127); if (c >= FF) return 0.f; return (half ? j.s1 : j.s0)[(size_t)k * FF + c]; }
    case 2: {
        const int kk = k & 1023; const bool isprev = k < 1024;
        const float* W; int ld, col, mi;
        if (n < 3072) { const int w = n >> 10; W = w == 0 ? rk.w_r : (w == 1 ? rk.w_k : rk.w_v); mi = w == 0 ? 0 : (w == 1 ? 2 : 3); ld = 1024; col = n & 1023; }
        else { const int c = n - 3072; if (c < 64) { W = rk.w1; mi = 1; ld = 64; col = c; } else if (c < 128) { W = rk.a1; mi = 4; ld = 64; col = c - 64; } else if (c < 288) { W = rk.g1; mi = 5; ld = 160; col = c - 128; } else return 0.f; }
        const float m = rk.mu[mi * 1024 + kk];
        return (isprev ? m : (1.0f - m)) * W[(size_t)kk * ld + col];
    }
    default: {
        if (n < 1024) return k < 64 ? rk.w2[(size_t)k * 1024 + n] : 0.f;
        if (n < 2048) return (k >= 64 && k < 128) ? rk.a2[(size_t)(k - 64) * 1024 + (n - 1024)] : 0.f;
        return (k >= 128 && k < 288) ? rk.g2[(size_t)(k - 128) * 1024 + (n - 2048)] : 0.f;
    }
    }
}
__global__ __launch_bounds__(256) void k_convert(CvtJob j, RkPtrs rk) {
    __shared__ float t[32][33];
    const int n0 = blockIdx.x * 32, k0 = blockIdx.y * 32, tx = threadIdx.x & 31, ty = threadIdx.x >> 5;
#pragma unroll
    for (int i = 0; i < 4; ++i) { const int kk = ty + 8 * i; t[kk][tx] = cvt_src(j, rk, k0 + kk, n0 + tx); }
    __syncthreads();
#pragma unroll
    for (int i = 0; i < 4; ++i) { const int nn = ty + 8 * i; j.dst[(size_t)(n0 + nn) * j.Kd + k0 + tx] = (bf16)f2bf(t[tx][nn]); }
}

__global__ __launch_bounds__(256) void k_mods(const float* c_p, const float* c_s, const float* ada_w, const float* ada_b, float* mods) {
    __shared__ float sc[8][1024];
    const int l = blockIdx.z, r0 = blockIdx.y * 8, n = blockIdx.x * 256 + threadIdx.x;
    for (int i = threadIdx.x; i < 8 * 1024; i += 256) { const int r = r0 + (i >> 10), k = i & 1023; const float v = r < 8 ? c_p[r * 1024 + k] : c_s[(r - 8) * 1024 + k]; sc[i >> 10][k] = siluf_(v); }
    __syncthreads();
    float acc[8];
#pragma unroll
    for (int j = 0; j < 8; ++j) acc[j] = 0.f;
    const float* w = ada_w + (size_t)l * 1024 * 9216 + n;
    for (int k = 0; k < 1024; ++k) { const float wv = w[(size_t)k * 9216];
#pragma unroll
        for (int j = 0; j < 8; ++j) acc[j] += sc[j][k] * wv; }
    const float b = ada_b[l * 9216 + n];
#pragma unroll
    for (int j = 0; j < 8; ++j) mods[((size_t)l * NMODROW + r0 + j) * 9216 + n] = acc[j] + b;
}
__host__ __device__ __forceinline__ const float* modp(const float* mods, int l, int which) { return mods + (size_t)l * NMODROW * 9216 + which * 1024; }

DEVI void sincos_d(double x, double& s, double& c) {
    const double n = rint(x * 0.63661977236758134308);
    double r = fma(-n, 1.57079632679489655800e+00, x); r = fma(-n, 6.12323399573676603587e-17, r);
    const double r2 = r * r;
    double sp = -7.6471637318198164759e-13; sp = fma(sp, r2, 1.6059043836821614599e-10); sp = fma(sp, r2, -2.5052108385441718775e-08); sp = fma(sp, r2, 2.7557319223985890653e-06);
    sp = fma(sp, r2, -1.9841269841269841270e-04); sp = fma(sp, r2, 8.3333333333333333333e-03); sp = fma(sp, r2, -1.6666666666666666667e-01); const double sr = fma(sp * r2, r, r);
    double cp = 4.7794773323873852974e-14; cp = fma(cp, r2, -1.1470745597729724714e-11); cp = fma(cp, r2, 2.0876756987868098979e-09); cp = fma(cp, r2, -2.7557319223985890653e-07);
    cp = fma(cp, r2, 2.4801587301587301587e-05); cp = fma(cp, r2, -1.3888888888888888889e-03); cp = fma(cp, r2, 4.1666666666666666667e-02); cp = fma(cp, r2, -0.5); const double cr = fma(cp, r2, 1.0);
    const int q = ((int)n) & 3;
    s = (q == 0) ? sr : (q == 1) ? cr : (q == 2) ? -sr : -cr;
    c = (q == 0) ? cr : (q == 1) ? -sr : (q == 2) ? -cr : sr;
}
__global__ void k_s5prep(const float* a_re, const float* a_im, const float* log_step, const float* b_re, const float* b_im, float* sp) {
    const int i = blockIdx.x * blockDim.x + threadIdx.x; if (i >= 2048) return;
    const int g = i >> 6;
    const double dt = exp((double)log_step[g]), ar = a_re[i], ai = a_im[i];
    const double mag = exp(ar * dt); double s, c; sincos_d(ai * dt, s, c);
    const double abr = mag * c, abi = mag * s, den = ar * ar + ai * ai, nr = abr - 1.0;
    const double zr = (nr * ar + abi * ai) / den, zi = (abi * ar - nr * ai) / den;
    sp[i] = (float)abr; sp[2048 + i] = (float)abi;
    for (int cc = 0; cc < 16; ++cc) { const double br = b_re[i * 16 + cc], bi = b_im[i * 16 + cc];
        sp[4096 + i * 16 + cc] = (float)(zr * br - zi * bi); sp[4096 + 32768 + i * 16 + cc] = (float)(zr * bi + zi * br); }
}

__global__ __launch_bounds__(256) void k_init(const float* xp, const float* xs, const float* mods, float* X, bf16* H) {
    const int row = blockIdx.x * 4 + (threadIdx.x >> 6), lane = threadIdx.x & 63; if (row >= MTP) return;
    if (row >= MT) { for (int j = 0; j < 16; ++j) H[(size_t)row * D + j * 64 + lane] = 0; return; }
    const float* src = row < NP ? xp + (size_t)row * D : xs + (size_t)(row - NP) * D;
    const float* sh = modp(mods, 0, 0) + (size_t)mrow(row) * 9216; const float* sc = modp(mods, 0, 1) + (size_t)mrow(row) * 9216;
    for (int j = 0; j < 16; ++j) { const int c = j * 64 + lane; const float v = src[c]; X[(size_t)row * D + c] = v; H[(size_t)row * D + c] = (bf16)f2bf(v * (1.f + sc[c]) + sh[c]); }
}

__global__ __launch_bounds__(256) void k_ln(const float* Z, const float* g, const float* b, float* X, bf16* H, const float* sh, const float* sc) {
    const int row = blockIdx.x * 4 + (threadIdx.x >> 6), lane = threadIdx.x & 63; if (row >= MT) return;
    const float* z = Z + (size_t)row * D; float v[16]; float s = 0.f;
#pragma unroll
    for (int j = 0; j < 16; ++j) { v[j] = z[j * 64 + lane]; s += v[j]; }
    const float mean = wave_sum(s) * (1.f / D); float q = 0.f;
#pragma unroll
    for (int j = 0; j < 16; ++j) { v[j] -= mean; q += v[j] * v[j]; }
    const float rstd = rsqrtf(wave_sum(q) * (1.f / D) + 1e-5f);
    const int mr = mrow(row);
#pragma unroll
    for (int j = 0; j < 16; ++j) { const int c = j * 64 + lane; const float x = v[j] * rstd * g[c] + b[c]; X[(size_t)row * D + c] = x;
        if (H) H[(size_t)row * D + c] = (bf16)f2bf(x * (1.f + sc[(size_t)mr * 9216 + c]) + sh[(size_t)mr * 9216 + c]); }
}

template <class Epi>
__global__ __launch_bounds__(256) void gemm_v0(const bf16* __restrict__ A, int lda, const bf16* __restrict__ Bt, int ldb, int K, Epi epi) {
    const int tid = threadIdx.x, lane = tid & 63, wq = tid >> 6, fr = lane & 15, fq = lane >> 4;
    const int row0 = blockIdx.x * 64, col0 = blockIdx.y * 256;
    f32x4 acc[4][2][2];
#pragma unroll
    for (int m = 0; m < 4; ++m)
#pragma unroll
        for (int bj = 0; bj < 2; ++bj)
#pragma unroll
            for (int nf = 0; nf < 2; ++nf) acc[m][bj][nf] = (f32x4){0.f, 0.f, 0.f, 0.f};
    const bf16* ap = A + (size_t)(row0 + fr) * lda + fq * 8;
    const bf16* bp = Bt + (size_t)(col0 + wq * 32 + fr) * ldb + fq * 8;
    for (int k = 0; k < K; k += 32) {
        bf16x8 a[4], b[2][2];
#pragma unroll
        for (int m = 0; m < 4; ++m) a[m] = *(const bf16x8*)(ap + (size_t)m * 16 * lda + k);
#pragma unroll
        for (int bj = 0; bj < 2; ++bj)
#pragma unroll
            for (int nf = 0; nf < 2; ++nf) b[bj][nf] = *(const bf16x8*)(bp + (size_t)(bj * 128 + nf * 16) * ldb + k);
#pragma unroll
        for (int m = 0; m < 4; ++m)
#pragma unroll
            for (int bj = 0; bj < 2; ++bj)
#pragma unroll
                for (int nf = 0; nf < 2; ++nf) acc[m][bj][nf] = __builtin_amdgcn_mfma_f32_16x16x32_bf16(b[bj][nf], a[m], acc[m][bj][nf], 0, 0, 0);
    }
#pragma unroll
    for (int m = 0; m < 4; ++m) epi(row0 + m * 16 + fr, col0, wq, fq, acc[m]);
}
struct EpiSwiglu { bf16* ACT;
    DEVI void operator()(int row, int col0, int wq, int fq, const f32x4 (&v)[2][2]) const {
#pragma unroll
        for (int nf = 0; nf < 2; ++nf)
#pragma unroll
            for (int e = 0; e < 4; ++e) { const int c = (col0 >> 1) + wq * 32 + nf * 16 + fq * 4 + e; ACT[(size_t)row * FFP + c] = (bf16)f2bf(siluf_(v[0][nf][e]) * v[1][nf][e]); } } };
struct EpiResid { const float* X; float* Z; const float* gate; float rc; int pad;
    DEVI void operator()(int row, int col0, int wq, int fq, const f32x4 (&v)[2][2]) const {
        if (row >= MT) return; const int mr = mrow(row);
#pragma unroll
        for (int bj = 0; bj < 2; ++bj)
#pragma unroll
            for (int nf = 0; nf < 2; ++nf)
#pragma unroll
                for (int e = 0; e < 4; ++e) { const int c = col0 + bj * 128 + wq * 32 + nf * 16 + fq * 4 + e;
                    Z[(size_t)row * D + c] = ALPHA * X[(size_t)row * D + c] + rc * (1.f + gate[(size_t)mr * 9216 + c]) * v[bj][nf][e]; } } };
struct EpiInproj { bf16* P; float* GKL;
    DEVI void operator()(int row, int col0, int wq, int fq, const f32x4 (&v)[2][2]) const {
#pragma unroll
        for (int bj = 0; bj < 2; ++bj)
#pragma unroll
            for (int nf = 0; nf < 2; ++nf)
#pragma unroll
                for (int e = 0; e < 4; ++e) { const int c = col0 + bj * 128 + wq * 32 + nf * 16 + fq * 4 + e; P[(size_t)row * NINP + c] = (bf16)f2bf(v[bj][nf][e]);
                    if (c >= 1536 && c < 1552) GKL[(size_t)row * 16 + c - 1536] = v[bj][nf][e]; } } };
struct EpiGlu { const bf16* Z5; bf16* O; const float* bg;
    DEVI void operator()(int row, int col0, int wq, int fq, const f32x4 (&v)[2][2]) const {
#pragma unroll
        for (int bj = 0; bj < 2; ++bj)
#pragma unroll
            for (int nf = 0; nf < 2; ++nf)
#pragma unroll
                for (int e = 0; e < 4; ++e) { const int c = col0 + bj * 128 + wq * 32 + nf * 16 + fq * 4 + e; const float z = bf2f(Z5[(size_t)row * 512 + c]);
                    O[(size_t)row * D + 512 + c] = (bf16)f2bf(z * sigmoidf_(v[bj][nf][e] + bg[c])); } } };
struct EpiRk { bf16* R; bf16* Kb; bf16* V; bf16* L1;
    DEVI void operator()(int row, int col0, int wq, int fq, const f32x4 (&v)[2][2]) const {
#pragma unroll
        for (int bj = 0; bj < 2; ++bj)
#pragma unroll
            for (int nf = 0; nf < 2; ++nf)
#pragma unroll
                for (int e = 0; e < 4; ++e) { const int c = col0 + bj * 128 + wq * 32 + nf * 16 + fq * 4 + e; const float x = v[bj][nf][e];
                    if (c < 3072) { bf16* dst = c < 1024 ? R : (c < 2048 ? Kb : V); dst[(size_t)row * D + (c & 1023)] = (bf16)f2bf(x); }
                    else { const int cc = c - 3072; if (cc < NL1) { float y = x; if (cc < 64) y = tanhf(x); else if (cc >= 128 && cc < 288) y = sigmoidf_(x); else if (cc >= 288) y = 0.f; L1[(size_t)row * NL1 + cc] = (bf16)f2bf(y); } } } } };
struct EpiLora2 { float* WD; bf16* AS; bf16* G; const float* w0; const float* a0;
    DEVI void operator()(int row, int col0, int wq, int fq, const f32x4 (&v)[2][2]) const {
#pragma unroll
        for (int bj = 0; bj < 2; ++bj)
#pragma unroll
            for (int nf = 0; nf < 2; ++nf)
#pragma unroll
                for (int e = 0; e < 4; ++e) { const int c = col0 + bj * 128 + wq * 32 + nf * 16 + fq * 4 + e; const float x = v[bj][nf][e];
                    if (c < 1024) { const float wl = -softplusf_(-(w0[c] + x)) - 0.5f; WD[(size_t)row * D + c] = expf(-expf(wl)); }
                    else if (c < 2048) AS[(size_t)row * D + c - 1024] = (bf16)f2bf(sigmoidf_(a0[c - 1024] + x));
                    else G[(size_t)row * D + c - 2048] = (bf16)f2bf(x); } } };

__global__ __launch_bounds__(128) void k_gla(const bf16* P, const float* GKL, const float* w_gk, const float* b_gk, int tok_base, int T, const float* s0, float* s_out, float* OG) {
    __shared__ float sdec[32][64], sq[32][64], sk[32][64];
    const int b = blockIdx.x >> 2, h = blockIdx.x & 3, dv = threadIdx.x;
    float S[64];
#pragma unroll
    for (int i = 0; i < 64; ++i) S[i] = s0 ? s0[(((size_t)b * 4 + h) * 64 + i) * 128 + dv] : 0.f;
    for (int t0 = 0; t0 < T; t0 += 32) {
        const int nt = (T - t0) < 32 ? (T - t0) : 32;
        __syncthreads();
        for (int it = threadIdx.x; it < nt * 64; it += 128) { const int tt = it >> 6, dk = it & 63; const size_t tok = (size_t)tok_base + (size_t)b * T + t0 + tt;
            float x = b_gk[h * 64 + dk];
#pragma unroll
            for (int r = 0; r < 16; ++r) x += GKL[tok * 16 + r] * w_gk[r * 256 + h * 64 + dk];
            const float ls = fminf(x, 0.f) - log1pf(__expf(-fabsf(x)));
            sdec[tt][dk] = __expf(ls * (1.f / 16.f));
            sq[tt][dk] = bf2f(P[tok * NINP + h * 64 + dk]) * 0.125f; sk[tt][dk] = bf2f(P[tok * NINP + 256 + h * 64 + dk]); }
        __syncthreads();
        for (int tt = 0; tt < nt; ++tt) { const size_t tok = (size_t)tok_base + (size_t)b * T + t0 + tt;
            const float v = bf2f(P[tok * NINP + 512 + h * 128 + dv]); float o = 0.f;
#pragma unroll
            for (int i = 0; i < 64; ++i) { S[i] = S[i] * sdec[tt][i] + sk[tt][i] * v; o += sq[tt][i] * S[i]; }
            OG[tok * 512 + h * 128 + dv] = o; }
    }
#pragma unroll
    for (int i = 0; i < 64; ++i) s_out[(((size_t)b * 4 + h) * 64 + i) * 128 + dv] = S[i];
}
__global__ __launch_bounds__(256) void k_gla_post(const float* OG, const bf16* P, const float* norm_g, bf16* O) {
    const int w = blockIdx.x * 4 + (threadIdx.x >> 6), lane = threadIdx.x & 63; if (w >= MT * 4) return;
    const int tok = w >> 2, h = w & 3;
    const float o0 = OG[(size_t)tok * 512 + h * 128 + lane], o1 = OG[(size_t)tok * 512 + h * 128 + 64 + lane];
    const float ms = wave_sum(o0 * o0 + o1 * o1) * (1.f / 128.f), r = rsqrtf(ms + 1e-5f);
    const float g0 = bf2f(P[(size_t)tok * NINP + 1024 + h * 128 + lane]), g1 = bf2f(P[(size_t)tok * NINP + 1024 + h * 128 + 64 + lane]);
    O[(size_t)tok * D + h * 128 + lane] = (bf16)f2bf(o0 * r * norm_g[lane] * siluf_(g0));
    O[(size_t)tok * D + h * 128 + 64 + lane] = (bf16)f2bf(o1 * r * norm_g[64 + lane] * siluf_(g1));
}

__global__ __launch_bounds__(64) void k_s5(const bf16* P, const float* sp, const float* c_re, const float* c_im, const float* dd, int tok_base, int T, const float* h0re, const float* h0im, float* ore, float* oim, bf16* Z5) {
    __shared__ float hs[2][2][64];
    const int b = blockIdx.x >> 5, g = blockIdx.x & 31, p = threadIdx.x, c = p & 15, pq = p >> 4;
    const float abr = sp[g * 64 + p], abi = sp[2048 + g * 64 + p];
    float bbr[16], bbi[16], cr[16], ci[16];
#pragma unroll
    for (int i = 0; i < 16; ++i) { bbr[i] = sp[4096 + (g * 64 + p) * 16 + i]; bbi[i] = sp[4096 + 32768 + (g * 64 + p) * 16 + i];
        cr[i] = c_re[(g * 16 + c) * 64 + pq * 16 + i]; ci[i] = c_im[(g * 16 + c) * 64 + pq * 16 + i]; }
    const float dv = dd[g * 16 + c];
    float hr = h0re ? h0re[((size_t)b * 32 + g) * 64 + p] : 0.f, hi = h0im ? h0im[((size_t)b * 32 + g) * 64 + p] : 0.f;
    for (int t = 0; t < T; ++t) { const size_t tok = (size_t)tok_base + (size_t)b * T + t;
        const bf16* up = P + tok * NINP + 1552 + g * 16; float u[16];
#pragma unroll
        for (int i = 0; i < 16; ++i) u[i] = bf2f(up[i]);
        float br = 0.f, bi = 0.f;
#pragma unroll
        for (int i = 0; i < 16; ++i) { br += u[i] * bbr[i]; bi += u[i] * bbi[i]; }
        const float nr = abr * hr - abi * hi + br, ni = abr * hi + abi * hr + bi; hr = nr; hi = ni;
        hs[t & 1][0][p] = hr; hs[t & 1][1][p] = hi;
        __syncthreads();
        float y = 0.f;
#pragma unroll
        for (int i = 0; i < 16; ++i) y += cr[i] * hs[t & 1][0][pq * 16 + i] - ci[i] * hs[t & 1][1][pq * 16 + i];
        y += __shfl_xor(y, 16); y += __shfl_xor(y, 32);
        const float uc = bf2f(up[c]);
        if (p < 16) { y += dv * uc; Z5[tok * 512 + g * 16 + c] = (bf16)f2bf(gelu_tanh(y)); }
    }
    ore[((size_t)b * 32 + g) * 64 + p] = hr; oim[((size_t)b * 32 + g) * 64 + p] = hi;
}

__global__ __launch_bounds__(256) void k_shiftcat(const float* X, const float* mods, const float* shift_in, bf16* A2, float* out) {
    const int row = blockIdx.x * 4 + (threadIdx.x >> 6), lane = threadIdx.x & 63; if (row >= MTP) return;
    if (row >= MT) { for (int j = 0; j < 32; ++j) A2[(size_t)row * KRK + j * 64 + lane] = 0; return; }
    const int mr = mrow(row); const float* sh = modp(mods, 1, 3) + (size_t)mr * 9216; const float* sc = modp(mods, 1, 4) + (size_t)mr * 9216;
    const bool prompt = row < NP; const int t = row & 2047;
    for (int j = 0; j < 16; ++j) { const int c = j * 64 + lane; const float h = X[(size_t)row * D + c] * (1.f + sc[c]) + sh[c];
        float pv; if (prompt) pv = t == 0 ? 0.f : X[(size_t)(row - 1) * D + c] * (1.f + sc[c]) + sh[c]; else pv = shift_in[(size_t)(row - NP) * D + c];
        A2[(size_t)row * KRK + c] = (bf16)f2bf(pv); A2[(size_t)row * KRK + 1024 + c] = (bf16)f2bf(h);
        if (prompt) { if (t == 2047) out[O_SHIFT_P + (size_t)(row >> 11) * D + c] = h; } else out[O_SHIFT_S + (size_t)(row - NP) * D + c] = h; }
}
__global__ __launch_bounds__(64) void k_wkv(const bf16* R, const bf16* Kb, const bf16* V, const float* WD, const bf16* AS, bf16* GO, const float* k_k, const float* k_a, const float* r_k, const float* lnx_g, const float* lnx_b,
                                           int tok_base, int T, const float* s0, float* s_out) {
    __shared__ float sw[16][64], skm[16][64], sa_[16][64], sb[16][64], sr[16][64], sbon[16];
    const int b = blockIdx.x >> 4, h = blockIdx.x & 15, i = threadIdx.x, ch = h * 64 + i;
    float S[64];
#pragma unroll
    for (int j = 0; j < 64; ++j) S[j] = s0 ? s0[(((size_t)b * 16 + h) * 64 + i) * 64 + j] : 0.f;
    const float kkc = k_k[ch], kac = k_a[ch], rkc = r_k[ch], lg = lnx_g[ch], lb = lnx_b[ch];
    for (int t0 = 0; t0 < T; t0 += 16) { const int nt = (T - t0) < 16 ? (T - t0) : 16;
        __syncthreads();
        for (int tt = 0; tt < nt; ++tt) { const size_t tok = (size_t)tok_base + (size_t)b * T + t0 + tt;
            const float k = bf2f(Kb[tok * D + ch]), r = bf2f(R[tok * D + ch]), a = bf2f(AS[tok * D + ch]), w = WD[tok * D + ch];
            float kk = k * kkc; const float nrm = sqrtf(wave_sum(kk * kk)); kk = kk / fmaxf(nrm, 1e-12f);
            const float km = k * (1.f + (a - 1.f) * kac);
            sw[tt][i] = w; skm[tt][i] = km; sa_[tt][i] = -kk; sb[tt][i] = kk * a; sr[tt][i] = r;
            const float bon = wave_sum(r * km * rkc); if (i == 0) sbon[tt] = bon; }
        __syncthreads();
        for (int tt = 0; tt < nt; ++tt) { const size_t tok = (size_t)tok_base + (size_t)b * T + t0 + tt;
            const float v = bf2f(V[tok * D + ch]); float sa = 0.f;
#pragma unroll
            for (int j = 0; j < 64; ++j) sa += S[j] * sa_[tt][j];
            float y = 0.f;
#pragma unroll
            for (int j = 0; j < 64; ++j) { S[j] = S[j] * sw[tt][j] + sa * sb[tt][j] + v * skm[tt][j]; y += S[j] * sr[tt][j]; }
            const float mean = wave_sum(y) * (1.f / 64.f), dy = y - mean, var = wave_sum(dy * dy) * (1.f / 64.f);
            float yn = dy * rsqrtf(var + 64e-5f) * lg + lb; yn += sbon[tt] * v;
            const float gt = bf2f(GO[tok * D + ch]); GO[tok * D + ch] = (bf16)f2bf(yn * gt); }
    }
#pragma unroll
    for (int j = 0; j < 64; ++j) s_out[(((size_t)b * 16 + h) * 64 + i) * 64 + j] = S[j];
}

extern "C" void kernel_launch(void* const* d_in, const int* in_sizes, int n_in, void* d_out, int out_size, void* d_ws, size_t ws_size, hipStream_t stream) {
    if (n_in != 52 || ws_size < WS_END) { fprintf(stderr, "kernel_launch: unexpected n_in %d or ws %zu\n", n_in, ws_size); return; }
    auto in = [&](int i) { return (const float*)d_in[i]; };
    unsigned char* ws = (unsigned char*)d_ws; float* out = (float*)d_out;
    float* MODS = (float*)(ws + WS_MODS); float* SP = (float*)(ws + WS_SP);
    bf16* H = (bf16*)(ws + WS_H); float* Z = (float*)(ws + WS_Z); bf16* ACT = (bf16*)(ws + WS_ACT); float* X = out;
    RkPtrs rk{in(35), in(36), in(37), in(40), in(43), in(45), in(41), in(44), in(46), in(34)};
    auto cvt = [&](int mode, const float* s0, const float* s1, bf16* dst, int Nd, int Kd, int K, int N) {
        CvtJob j{s0, s1, nullptr, nullptr, dst, mode, Nd, Kd, K, N, 0}; hipLaunchKernelGGL(k_convert, dim3(Nd / 32, Kd / 32), dim3(256), 0, stream, j, rk); };
    bf16* WUP[2][2]; bf16* WDN[2][2];
    for (int l = 0; l < 2; ++l) for (int f = 0; f < 2; ++f) {
        WUP[l][f] = (bf16*)(ws + (l ? WS_WUP_L1 : WS_WUP_L0) + f * SZ_WUP); WDN[l][f] = (bf16*)(ws + (l ? WS_WDN_L1 : WS_WDN_L0) + f * SZ_WDN);
        const float* wg = in(f ? 16 : 13) + (size_t)l * D * FF; const float* wu = in(f ? 17 : 14) + (size_t)l * D * FF; const float* wd = in(f ? 18 : 15) + (size_t)l * FF * D;
        cvt(1, wg, wu, WUP[l][f], NUP, D, D, FF); cvt(0, wd, nullptr, WDN[l][f], D, FFP, FF, D); }
    bf16* WIN = (bf16*)(ws + WS_WIN); bf16* WGLU = (bf16*)(ws + WS_WGLU); bf16* WOUT = (bf16*)(ws + WS_WOUT); bf16* WRK = (bf16*)(ws + WS_WRK); bf16* WL2 = (bf16*)(ws + WS_WL2); bf16* WO = (bf16*)(ws + WS_WO);
    cvt(0, in(19), nullptr, WIN, NINP, D, D, NIN); cvt(0, in(32), nullptr, WGLU, 512, 512, 512, 512); cvt(0, in(20), nullptr, WOUT, D, D, D, D);
    cvt(2, nullptr, nullptr, WRK, NRK, KRK, KRK, NRK); cvt(3, nullptr, nullptr, WL2, 3072, NL1, NL1, 3072); cvt(0, in(38), nullptr, WO, D, D, D, D);
    hipLaunchKernelGGL(k_mods, dim3(36, 17, 2), dim3(256), 0, stream, in(7), in(8), in(9), in(10), MODS);
    hipLaunchKernelGGL(k_s5prep, dim3(8), dim3(256), 0, stream, in(24), in(25), in(26), in(27), in(28), SP);
    hipLaunchKernelGGL(k_init, dim3(MTP / 4), dim3(256), 0, stream, in(0), in(1), MODS, X, H);

    auto ffn = [&](int l, int f, int which0  , int lnidx, const float* nsh, const float* nsc, bool last) {
        hipLaunchKernelGGL(gemm_v0<EpiSwiglu>, dim3(MTP / 64, NUP / 256), dim3(256), 0, stream, H, D, WUP[l][f], D, D, EpiSwiglu{ACT});
        hipLaunchKernelGGL(gemm_v0<EpiResid>, dim3(MTP / 64, D / 256), dim3(256), 0, stream, ACT, FFP, WDN[l][f], FFP, FFP, EpiResid{X, Z, modp(MODS, l, which0 + 2), 0.5f, 0});
        hipLaunchKernelGGL(k_ln, dim3(MTP / 4), dim3(256), 0, stream, Z, in(11) + (l * 3 + lnidx) * D, in(12) + (l * 3 + lnidx) * D, X, last ? (bf16*)nullptr : H, nsh, nsc);
    };
    ffn(0, 0, 0, 0, modp(MODS, 0, 3), modp(MODS, 0, 4), false);
    {
        bf16* P = (bf16*)(ws + WS_P); float* GKL = (float*)(ws + WS_GKL); float* OG = (float*)(ws + WS_OG); bf16* Z5 = (bf16*)(ws + WS_Z5); bf16* O = (bf16*)(ws + WS_O);
        hipLaunchKernelGGL(gemm_v0<EpiInproj>, dim3(MTP / 64, NINP / 256), dim3(256), 0, stream, H, D, WIN, D, D, EpiInproj{P, GKL});
        hipLaunchKernelGGL(k_gla, dim3(BP * 4), dim3(128), 0, stream, P, GKL, in(21), in(22), 0, TP, (const float*)nullptr, out + O_GLA_P, OG);
        hipLaunchKernelGGL(k_gla, dim3(NS * 4), dim3(128), 0, stream, P, GKL, in(21), in(22), NP, 1, in(2), out + O_GLA_S, OG);
        hipLaunchKernelGGL(k_s5, dim3(BP * 32), dim3(64), 0, stream, P, SP, in(29), in(30), in(31), 0, TP, (const float*)nullptr, (const float*)nullptr, out + O_S5RE_P, out + O_S5IM_P, Z5);
        hipLaunchKernelGGL(k_s5, dim3(NS * 32), dim3(64), 0, stream, P, SP, in(29), in(30), in(31), NP, 1, in(3), in(4), out + O_S5RE_S, out + O_S5IM_S, Z5);
        hipLaunchKernelGGL(k_gla_post, dim3(MT), dim3(256), 0, stream, OG, P, in(23), O);
        hipLaunchKernelGGL(gemm_v0<EpiGlu>, dim3(MTP / 64, 2), dim3(256), 0, stream, Z5, 512, WGLU, 512, 512, EpiGlu{Z5, O, in(33)});
        hipLaunchKernelGGL(gemm_v0<EpiResid>, dim3(MTP / 64, D / 256), dim3(256), 0, stream, O, D, WOUT, D, D, EpiResid{X, Z, modp(MODS, 0, 5), 1.0f, 0});
        hipLaunchKernelGGL(k_ln, dim3(MTP / 4), dim3(256), 0, stream, Z, in(11) + (0 * 3 + 1) * D, in(12) + (0 * 3 + 1) * D, X, H, modp(MODS, 0, 6), modp(MODS, 0, 7));
    }
    ffn(0, 1, 6, 2, modp(MODS, 1, 0), modp(MODS, 1, 1), false);
    ffn(1, 0, 0, 0, modp(MODS, 1, 3), modp(MODS, 1, 4), false);
    {
        bf16* A2 = (bf16*)(ws + WS_A2); bf16* R = (bf16*)(ws + WS_R); bf16* Kb = (bf16*)(ws + WS_K); bf16* V = (bf16*)(ws + WS_V); bf16* L1 = (bf16*)(ws + WS_L1A);
        float* WD = (float*)(ws + WS_WD); bf16* AS = (bf16*)(ws + WS_AS); bf16* G = (bf16*)(ws + WS_G);
        hipLaunchKernelGGL(k_shiftcat, dim3(MTP / 4), dim3(256), 0, stream, X, MODS, in(5), A2, out);
        hipLaunchKernelGGL(gemm_v0<EpiRk>, dim3(MTP / 64, NRK / 256), dim3(256), 0, stream, A2, KRK, WRK, KRK, KRK, EpiRk{R, Kb, V, L1});
        hipLaunchKernelGGL(gemm_v0<EpiLora2>, dim3(MTP / 64, 3072 / 256), dim3(256), 0, stream, L1, NL1, WL2, NL1, NL1, EpiLora2{WD, AS, G, in(39), in(42)});
        hipLaunchKernelGGL(k_wkv, dim3(BP * 16), dim3(64), 0, stream, R, Kb, V, WD, AS, G, in(47), in(48), in(49), in(50), in(51), 0, TP, (const float*)nullptr, out + O_WKV_P);
        hipLaunchKernelGGL(k_wkv, dim3(NS * 16), dim3(64), 0, stream, R, Kb, V, WD, AS, G, in(47), in(48), in(49), in(50), in(51), NP, 1, in(6), out + O_WKV_S);
        hipLaunchKernelGGL(gemm_v0<EpiResid>, dim3(MTP / 64, D / 256), dim3(256), 0, stream, G, D, WO, D, D, EpiResid{X, Z, modp(MODS, 1, 5), 1.0f, 0});
        hipLaunchKernelGGL(k_ln, dim3(MTP / 4), dim3(256), 0, stream, Z, in(11) + (1 * 3 + 1) * D, in(12) + (1 * 3 + 1) * D, X, H, modp(MODS, 1, 6), modp(MODS, 1, 7));
    }
    ffn(1, 1, 6, 2, nullptr, nullptr, true);
}
```

```cpp
#include <hip/hip_runtime.h>
#include <cstdint>
#include <cstdio>

typedef unsigned short bf16;
typedef short bf16x8 __attribute__((ext_vector_type(8)));
typedef float f32x4 __attribute__((ext_vector_type(4)));
#define DEVI __device__ __forceinline__

constexpr int D = 1024, NP = 16384, NS = 128, MT = NP + NS, MTP = 16640, TP = 2048, BP = 8;
constexpr int FF = 2752, FFP = 2816, NUP = 2 * FFP;
constexpr int NIN = 2064, NINP = 2304;
constexpr int NRK = 3584, KRK = 2048, NL1 = 384;
constexpr int NMODROW = 136;
constexpr float ALPHA = 1.41421356237309515f;

constexpr size_t O_Y = 0, O_GLA_P = 16908288, O_S5RE_P = 17170432, O_S5IM_P = 17186816, O_SHIFT_P = 17203200, O_WKV_P = 17211392,
                 O_GLA_S = 17735680, O_S5RE_S = 21929984, O_S5IM_S = 22192128, O_SHIFT_S = 22454272, O_WKV_S = 22585344;

constexpr size_t MiB = 1u << 20;
constexpr size_t WS_CTL = 0, CTL_ZERO_BYTES = 1 * MiB;
constexpr size_t WS_MODS = 1 * MiB, WS_SP = 12 * MiB;
constexpr size_t WS_W = 13 * MiB;
constexpr size_t SZ_WUP = (size_t)NUP * D * 2;
constexpr size_t SZ_WDN = (size_t)D * FFP * 2;
constexpr size_t WS_L0 = WS_W;
constexpr size_t WS_WUP_L0 = WS_L0, WS_WDN_L0 = WS_L0 + 22 * MiB, WS_WIN = WS_L0 + 33 * MiB, WS_WGLU = WS_WIN + 4608 * 1024, WS_WOUT = WS_WGLU + 512 * 1024;
constexpr size_t WS_L1 = WS_L0 + 40 * MiB;
constexpr size_t WS_WUP_L1 = WS_L1, WS_WDN_L1 = WS_L1 + 22 * MiB, WS_WRK = WS_L1 + 33 * MiB, WS_WL2 = WS_WRK + 14 * MiB, WS_WO = WS_WL2 + 2304 * 1024;
static_assert(WS_WO + 2 * MiB <= 105 * MiB, "W region");
constexpr size_t WS_H = 105 * MiB, WS_Z = 138 * MiB, WS_ACT = 203 * MiB, WS_S2 = 293 * MiB, WS_END = 340 * MiB;
constexpr size_t WS_P = WS_ACT, WS_GKL = 277 * MiB, WS_OG = WS_S2, WS_Z5 = WS_Z, WS_O = WS_H;
constexpr size_t WS_A2 = WS_ACT, WS_K = WS_Z, WS_R = WS_Z - (size_t)MTP * D * 2, WS_V = WS_Z + (size_t)MTP * D * 2, WS_L1A = WS_L0, WS_WD = WS_ACT, WS_AS = 268 * MiB, WS_G = WS_AS + (size_t)MTP * D * 2;
static_assert(WS_G + (size_t)MTP * D * 2 <= WS_END, "ws");
constexpr int CW_TMO = 0, CW_BAR = 4096;

#define GAS __attribute__((address_space(1)))
#define LAS __attribute__((address_space(3)))
typedef unsigned short bf16;
typedef unsigned v4u __attribute__((ext_vector_type(4)));
typedef float f32x4 __attribute__((ext_vector_type(4)));
typedef short bf16x8 __attribute__((ext_vector_type(8)));
typedef GAS unsigned gu32;
typedef GAS unsigned long long gu64;
#define RLX_AGENT __ATOMIC_RELAXED, __HIP_MEMORY_SCOPE_AGENT
#define LDS_WAIT() asm volatile("s_waitcnt lgkmcnt(0)" ::: "memory")
#define VM_WAIT() asm volatile("s_waitcnt vmcnt(0)" ::: "memory")
__device__ __forceinline__ unsigned long long rt() { return __builtin_amdgcn_s_memrealtime(); }
__device__ __forceinline__ unsigned f2bf(float f) { unsigned u = __builtin_bit_cast(unsigned, f); return (u + 0x7fffu + ((u >> 16) & 1u)) >> 16; }
__device__ __forceinline__ unsigned pk2(float lo, float hi) { return f2bf(lo) | (f2bf(hi) << 16); }

#define XB_TMO      128
#define XB_XCNT(j)  (256  + 64 * (j))
#define XB_XSUB(j)  (1280 + 64 * (j))
#define XB_XGEN(j)  (2304 + 64 * (j))
#define XB_TOP      3328
#define XB_TOPGEN   3392
#define XCD_BAR_WORDS 3456
#define XB_SPIN_CAP (1u << 18)

__device__ __forceinline__ unsigned xb_ld(unsigned* p)              { return __hip_atomic_load(p, __ATOMIC_RELAXED, __HIP_MEMORY_SCOPE_AGENT); }
__device__ __forceinline__ unsigned xb_add(unsigned* p, unsigned v) { return __hip_atomic_fetch_add(p, v, __ATOMIC_RELAXED, __HIP_MEMORY_SCOPE_AGENT); }
__device__ __forceinline__ unsigned xb_xcc_id() { return (unsigned)__builtin_amdgcn_s_getreg((3 << 11) | 20) & 0xFu; }
#define XB_SPIN(cond, bar) do { unsigned _sp = 0; while (cond) { __builtin_amdgcn_s_sleep(1); \
    if ((++_sp & 255u) == 0u) { if (xb_ld(&(bar)[XB_TMO])) break; if (_sp > XB_SPIN_CAP) { atomicAdd(&(bar)[XB_TMO], 1u); break; } } } } while (0)

struct XcdBarrier {
    unsigned* bar; unsigned x;
    volatile LAS unsigned* st;
};

__device__ __forceinline__ XcdBarrier xcd_barrier_post(unsigned* bar, volatile LAS unsigned* st) {
    XcdBarrier b; b.bar = bar; b.x = xb_xcc_id(); b.st = st;
    if (threadIdx.x == 0) (void)xb_add(&bar[XB_XCNT(b.x)], 1u);
    return b;
}
__device__ __forceinline__ void xcd_barrier_complete(unsigned* bar, unsigned x, unsigned& nloc, unsigned& nx) {
    const unsigned G = gridDim.x * gridDim.y * gridDim.z;
    unsigned sum, cnt, mine, sp = 0u;
    for (;;) {
        sum = 0u; cnt = 0u; mine = 0u;
#pragma unroll
        for (unsigned j = 0; j < 16; ++j) { const unsigned c = xb_ld(&bar[XB_XCNT(j)]); sum += c; cnt += (c > 0u) ? 1u : 0u; mine = (j == x) ? c : mine; }
        if (sum == G) break;
        __builtin_amdgcn_s_sleep(1);
        if ((++sp & 255u) == 0u) { if (xb_ld(&bar[XB_TMO])) break; if (sp > XB_SPIN_CAP) { atomicAdd(&bar[XB_TMO], 1u); break; } }
    }
    nloc = mine > 0u ? mine : 1u; nx = cnt > 0u ? cnt : 1u;
}

__device__ __forceinline__ void xcd_barrier(const XcdBarrier& b) {
    asm volatile("s_waitcnt vmcnt(0)" ::: "memory");
    __syncthreads();
    if (threadIdx.x == 0) {
        unsigned* bar = b.bar;
        __builtin_amdgcn_s_waitcnt(0);
        unsigned nloc = b.st[0], nx = b.st[1];
        if (nloc == 0u) { xcd_barrier_complete(bar, b.x, nloc, nx); b.st[0] = nloc; b.st[1] = nx; }
        const unsigned old = xb_add(&bar[XB_XSUB(b.x)], 1u);
        const unsigned gen = old / nloc;
        if (old + 1u == (gen + 1u) * nloc) {
            __builtin_amdgcn_fence(__ATOMIC_RELEASE, "agent");
            asm volatile("s_waitcnt vmcnt(0)" ::: "memory");
            const unsigned og = xb_add(&bar[XB_TOP], 1u);
            const unsigned tg = og / nx;
            if (og + 1u == (tg + 1u) * nx) xb_add(&bar[XB_TOPGEN], 1u);
            else XB_SPIN(xb_ld(&bar[XB_TOPGEN]) == tg, bar);
            __builtin_amdgcn_fence(__ATOMIC_ACQUIRE, "agent");
            xb_add(&bar[XB_XGEN(b.x)], 1u);
            asm volatile("s_waitcnt vmcnt(0)" ::: "memory");
        } else {
            XB_SPIN(xb_ld(&bar[XB_XGEN(b.x)]) == gen, bar);
            __builtin_amdgcn_fence(__ATOMIC_ACQUIRE, "agent");
            asm volatile("s_waitcnt vmcnt(0)" ::: "memory");
        }
    }
    __syncthreads();
}

DEVI float bf2f(unsigned short h) { return __uint_as_float(((unsigned)h) << 16); }
DEVI int mrow(int i) { return i < NP ? (i >> 11) : (8 + i - NP); }
DEVI float sigmoidf_(float x) { return 1.0f / (1.0f + __expf(-x)); }
DEVI float siluf_(float x) { return x / (1.0f + __expf(-x)); }
DEVI float softplusf_(float x) { return fmaxf(x, 0.f) + log1pf(__expf(-fabsf(x))); }
DEVI float gelu_tanh(float x) { const float u = 0.7978845608028654f * (x + 0.044715f * x * x * x); return 0.5f * x * (1.0f + tanhf(u)); }
DEVI float wave_sum(float v) {
#pragma unroll
    for (int o = 1; o < 64; o <<= 1) v += __shfl_xor(v, o);
    return v;
}
__host__ __device__ __forceinline__ const float* modp(const float* mods, int l, int which) { return mods + (size_t)l * NMODROW * 9216 + which * 1024; }

namespace pg8 {
#define PG8_LAS __attribute__((address_space(3)))
typedef unsigned short bf16_t;
typedef short bf16x8 __attribute__((ext_vector_type(8)));
typedef float f32x4 __attribute__((ext_vector_type(4)));
typedef unsigned u32x4 __attribute__((ext_vector_type(4)));
constexpr int BM = 256, BK = 64, HALF = 128, HTB = HALF * BK * 2  , STAGE_BYTES = 8 * HTB, NXCD = 8, WGM = 8;

__host__ __device__ __forceinline__ int lds_byte(int r, int c) { const int st = (r >> 4) * 2 + (c >> 5), rr = r & 15, cc = c & 31, ob = rr * 64 + cc * 2; return st * 1024 + (ob ^ (((ob >> 9) & 1) << 5)); }
__host__ __device__ __forceinline__ void stage_rc(int b, int& R, int& C) { const int st = b / 1024, sb = b % 1024, swz = sb ^ (((sb >> 9) & 1) << 5); R = (st >> 1) * 16 + swz / 64; C = (st & 1) * 32 + (swz % 64) / 2; }
__host__ __device__ __forceinline__ int perm32(int rho) { const int n = rho >> 4, i = rho & 15; return 8 * (i >> 2) + 4 * n + (i & 3); }

struct Unit { int pm, pn; };
struct Gemm { const bf16_t* A; const bf16_t* Bt; int M, N, K; };

struct StaticOrder {
    int nM, nN, nwg, G, c;
    __host__ __device__ void init(int M, int N, int G_, int c_) { nM = M / BM; nN = N / BM; nwg = nM * nN; G = G_; c = c_; }
    __host__ __device__ bool next(int i, Unit& u) const {
        const long L = (long)i * G + c; if (L >= nwg) return false;
        int wgid = (int)L; { const int q = nwg / NXCD, r = nwg % NXCD, xcd = wgid % NXCD, off = wgid / NXCD; wgid = (xcd < r ? xcd * (q + 1) : r * (q + 1) + (xcd - r) * q) + off; }
        const int nig = WGM * nN, gid = wgid / nig, fm = gid * WGM, gsz = (nM - fm) < WGM ? (nM - fm) : WGM;
        u.pm = fm + ((wgid % nig) % gsz); u.pn = (wgid % nig) / gsz; return true;
    }
    __device__ __forceinline__ void a_ready(const Unit&) const {}
    __device__ __forceinline__ void done(const Unit&) const {}
};


__device__ __forceinline__ unsigned cvt_pk_bf16(float lo, float hi) { unsigned r; asm volatile("v_cvt_pk_bf16_f32 %0, %1, %2" : "=v"(r) : "v"(lo), "v"(hi)); return r; }
__device__ __forceinline__ float fsilu(float x) { return x * __builtin_amdgcn_rcpf(1.0f + __builtin_amdgcn_exp2f(-1.44269504089f * x)); }
__device__ __forceinline__ float fsigm(float x) { return __builtin_amdgcn_rcpf(1.0f + __builtin_amdgcn_exp2f(-1.44269504089f * x)); }
__device__ __forceinline__ u32x4 pack8(const f32x4 a, const f32x4 b) { u32x4 w; w.x = cvt_pk_bf16(a[0], a[1]); w.y = cvt_pk_bf16(a[2], a[3]); w.z = cvt_pk_bf16(b[0], b[1]); w.w = cvt_pk_bf16(b[2], b[3]); return w; }
struct EpiSwiglu { static constexpr bool PERM = true, AFTER_DRAIN = false; bf16_t* ACT;
    __device__ __forceinline__ void operator()(const f32x4 (&acc)[2][2][4][2], const Unit& u, int wr, int wc, int fr, int fq) const {
        const int row0 = u.pm * BM + wr * 64 + fr, col0 = u.pn * 128 + wc * 32 + 8 * fq;
#pragma unroll
        for (int ai = 0; ai < 2; ++ai)
#pragma unroll
            for (int m = 0; m < 4; ++m) { f32x4 o0, o1;
#pragma unroll
                for (int e = 0; e < 4; ++e) { o0[e] = fsilu(acc[ai][0][m][0][e]) * acc[ai][1][m][0][e]; o1[e] = fsilu(acc[ai][0][m][1][e]) * acc[ai][1][m][1][e]; }
                *(u32x4*)(ACT + (size_t)(row0 + ai * HALF + m * 16) * 2816 + col0) = pack8(o0, o1); }
    } };
struct EpiResid { static constexpr bool PERM = true, AFTER_DRAIN = false; const float* X; float* Z; const float* gate; float rc; int pad;
    __device__ __forceinline__ void operator()(const f32x4 (&acc)[2][2][4][2], const Unit& u, int wr, int wc, int fr, int fq) const {
        const int row0 = u.pm * BM + wr * 64 + fr;
#pragma unroll
        for (int ai = 0; ai < 2; ++ai) { if (u.pm == 64 && ai == 1) break;
#pragma unroll
            for (int m = 0; m < 4; ++m) { const int row = row0 + ai * HALF + m * 16; const int mr = row < 16384 ? (row >> 11) : (8 + row - 16384);
#pragma unroll
                for (int bj = 0; bj < 2; ++bj)
#pragma unroll
                    for (int n = 0; n < 2; ++n) { const int c = u.pn * BM + bj * HALF + wc * 32 + 8 * fq + 4 * n;
                        const f32x4 x = *(const f32x4*)(X + (size_t)row * 1024 + c), g = *(const f32x4*)(gate + (size_t)mr * 9216 + c);
                        *(f32x4*)(Z + (size_t)row * 1024 + c) = x * 1.41421356237309515f + (g + 1.0f) * rc * acc[ai][bj][m][n]; } } }
    } };
struct EpiInproj { static constexpr bool PERM = true, AFTER_DRAIN = false; bf16_t* P; float* GKL;
    __device__ __forceinline__ void operator()(const f32x4 (&acc)[2][2][4][2], const Unit& u, int wr, int wc, int fr, int fq) const {
        const int row0 = u.pm * BM + wr * 64 + fr;
#pragma unroll
        for (int ai = 0; ai < 2; ++ai)
#pragma unroll
            for (int m = 0; m < 4; ++m) { const int row = row0 + ai * HALF + m * 16;
#pragma unroll
                for (int bj = 0; bj < 2; ++bj) { const int c = u.pn * BM + bj * HALF + wc * 32 + 8 * fq;
                    *(u32x4*)(P + (size_t)row * 2304 + c) = pack8(acc[ai][bj][m][0], acc[ai][bj][m][1]);
                    if (c >= 1536 && c < 1552) { *(f32x4*)(GKL + (size_t)row * 16 + (c - 1536)) = acc[ai][bj][m][0]; *(f32x4*)(GKL + (size_t)row * 16 + (c - 1536) + 4) = acc[ai][bj][m][1]; } } }
    } };
struct EpiGlu { static constexpr bool PERM = true, AFTER_DRAIN = false; const bf16_t* Z5; bf16_t* O; const float* bg;
    __device__ __forceinline__ void operator()(const f32x4 (&acc)[2][2][4][2], const Unit& u, int wr, int wc, int fr, int fq) const {
        const int row0 = u.pm * BM + wr * 64 + fr;
#pragma unroll
        for (int ai = 0; ai < 2; ++ai)
#pragma unroll
            for (int m = 0; m < 4; ++m) { const int row = row0 + ai * HALF + m * 16;
#pragma unroll
                for (int bj = 0; bj < 2; ++bj) { const int c = u.pn * BM + bj * HALF + wc * 32 + 8 * fq;
                    const u32x4 zz = *(const u32x4*)(Z5 + (size_t)row * 512 + c); const f32x4 b0 = *(const f32x4*)(bg + c), b1 = *(const f32x4*)(bg + c + 4);
                    f32x4 o0, o1;
#pragma unroll
                    for (int e = 0; e < 4; ++e) { const unsigned w0 = zz[e >> 1], w1 = zz[2 + (e >> 1)];
                        const float z0 = __uint_as_float((e & 1) ? (w0 & 0xffff0000u) : (w0 << 16)), z1 = __uint_as_float((e & 1) ? (w1 & 0xffff0000u) : (w1 << 16));
                        o0[e] = z0 * fsigm(acc[ai][bj][m][0][e] + b0[e]); o1[e] = z1 * fsigm(acc[ai][bj][m][1][e] + b1[e]); }
                    *(u32x4*)(O + (size_t)row * 1024 + 512 + c) = pack8(o0, o1); } }
    } };
__device__ __forceinline__ float ftanh(float x) { const float e = __builtin_amdgcn_exp2f(-2.88539008178f * fabsf(x)); const float t = (1.0f - e) * __builtin_amdgcn_rcpf(1.0f + e); return x < 0.f ? -t : t; }
struct EpiRk { static constexpr bool PERM = true, AFTER_DRAIN = false; bf16_t* R; size_t rkv_stride; bf16_t* L1;
    __device__ __forceinline__ void operator()(const f32x4 (&acc)[2][2][4][2], const Unit& u, int wr, int wc, int fr, int fq) const {
        const int row0 = u.pm * BM + wr * 64 + fr;
#pragma unroll
        for (int ai = 0; ai < 2; ++ai)
#pragma unroll
            for (int m = 0; m < 4; ++m) { const int row = row0 + ai * HALF + m * 16;
#pragma unroll
                for (int bj = 0; bj < 2; ++bj) { const int c = u.pn * BM + bj * HALF + wc * 32 + 8 * fq;
                    if (c < 3072) { bf16_t* dst = R + (size_t)(c >> 10) * rkv_stride; *(u32x4*)(dst + (size_t)row * 1024 + (c & 1023)) = pack8(acc[ai][bj][m][0], acc[ai][bj][m][1]); }
                    else { const int cc = c - 3072; if (cc < 384) { f32x4 o0 = acc[ai][bj][m][0], o1 = acc[ai][bj][m][1];
                        if (cc < 64) {
#pragma unroll
                            for (int e = 0; e < 4; ++e) { o0[e] = ftanh(o0[e]); o1[e] = ftanh(o1[e]); } }
                        else if (cc >= 128 && cc < 288) {
#pragma unroll
                            for (int e = 0; e < 4; ++e) { o0[e] = fsigm(o0[e]); o1[e] = fsigm(o1[e]); } }
                        else if (cc >= 288) { o0 = (f32x4){0.f, 0.f, 0.f, 0.f}; o1 = o0; }
                        *(u32x4*)(L1 + (size_t)row * 384 + cc) = pack8(o0, o1); } } } }
    } };
struct EpiLora2 { static constexpr bool PERM = true, AFTER_DRAIN = false; float* WD; bf16_t* AS; bf16_t* G; const float* w0; const float* a0;
    __device__ __forceinline__ void operator()(const f32x4 (&acc)[2][2][4][2], const Unit& u, int wr, int wc, int fr, int fq) const {
        const int row0 = u.pm * BM + wr * 64 + fr;
#pragma unroll
        for (int ai = 0; ai < 2; ++ai)
#pragma unroll
            for (int m = 0; m < 4; ++m) { const int row = row0 + ai * HALF + m * 16;
#pragma unroll
                for (int bj = 0; bj < 2; ++bj) { const int c = u.pn * BM + bj * HALF + wc * 32 + 8 * fq;
                    if (c < 1024) {
#pragma unroll
                        for (int n = 0; n < 2; ++n) { const f32x4 wv = *(const f32x4*)(w0 + c + 4 * n); f32x4 o;
#pragma unroll
                            for (int e = 0; e < 4; ++e) { const float x = -(wv[e] + acc[ai][bj][m][n][e]); const float sp = fmaxf(x, 0.f) + 0.69314718056f * __builtin_amdgcn_logf(1.0f + __builtin_amdgcn_exp2f(-1.44269504089f * fabsf(x)));
                                const float ee = __builtin_amdgcn_exp2f(-1.44269504089f * (sp + 0.5f)); o[e] = __builtin_amdgcn_exp2f(-1.44269504089f * ee); }
                            *(f32x4*)(WD + (size_t)row * 1024 + c + 4 * n) = o; } }
                    else if (c < 2048) { const f32x4 a0v = *(const f32x4*)(a0 + c - 1024), a1v = *(const f32x4*)(a0 + c - 1024 + 4); f32x4 o0, o1;
#pragma unroll
                        for (int e = 0; e < 4; ++e) { o0[e] = fsigm(a0v[e] + acc[ai][bj][m][0][e]); o1[e] = fsigm(a1v[e] + acc[ai][bj][m][1][e]); }
                        *(u32x4*)(AS + (size_t)row * 1024 + c - 1024) = pack8(o0, o1); }
                    else *(u32x4*)(G + (size_t)row * 1024 + c - 2048) = pack8(acc[ai][bj][m][0], acc[ai][bj][m][1]); } }
    } };

template <class Epi, class Sched, bool ALIGN_EPI = false, bool SP2 = false>
__device__ __forceinline__ void gemm_phase(PG8_LAS unsigned char* lds, const Gemm g, const Sched& S, const Epi& E) {
    int tid_ = threadIdx.x; asm volatile("" : "+v"(tid_));
    const int tid = tid_, wid = __builtin_amdgcn_readfirstlane(tid >> 6), lane = tid & 63, wr = wid >> 2, wc = wid & 3, fr = lane & 15, fq = lane >> 4;
    int K_ = g.K; asm volatile("" : "+s"(K_));
    const int K = K_, nt = K / BK;
    unsigned voffA[2], voffB[2];
#pragma unroll
    for (int i = 0; i < 2; ++i) { int R, C; stage_rc(tid * 16 + i * 8192, R, C); const int Rb = Epi::PERM ? ((R & ~31) + perm32(R & 31)) : R;
        voffA[i] = (unsigned)(R * K + C) * 2u; voffB[i] = (unsigned)(Rb * K + C) * 2u; }
    const size_t kstep = (size_t)(BK * 2);
    const size_t hstep = (size_t)HALF * K * 2;
    const size_t tstep = 2 * hstep;
    const unsigned ldsw = (unsigned)wid * 1024u;
    const int aoff = lds_byte(wr * 64 + fr, fq * 8), boff = lds_byte(wc * 32 + fr, fq * 8);
#define PG8_SA(b, h) (((b) * 2 + (h)) * HTB)
#define PG8_SB(b, h) ((4 + (b) * 2 + (h)) * HTB)
#define PG8_STAGE(bufoff, gbase, voff) do { _Pragma("unroll") for (int _i = 0; _i < 2; ++_i) \
        __builtin_amdgcn_global_load_lds((const unsigned*)((const char*)(gbase) + (voff)[_i]), (PG8_LAS unsigned*)(lds + (bufoff) + ldsw + _i * 8192), 16, 0, 0); } while (0)
#define PG8_LDA(dst, b, h) do { _Pragma("unroll") for (int m = 0; m < 4; ++m) _Pragma("unroll") for (int k = 0; k < 2; ++k) dst[m][k] = *(const PG8_LAS bf16x8*)(lds + PG8_SA(b, h) + aoff + m * 2048 + k * 1024); } while (0)
#define PG8_LDB(dst, b, h) do { _Pragma("unroll") for (int n = 0; n < 2; ++n) _Pragma("unroll") for (int k = 0; k < 2; ++k) dst[n][k] = *(const PG8_LAS bf16x8*)(lds + PG8_SB(b, h) + boff + n * 2048 + k * 1024); } while (0)
#define PG8_MMA(ai, bj, At, Bt) do { __builtin_amdgcn_s_setprio(1); _Pragma("unroll") for (int m = 0; m < 4; ++m) _Pragma("unroll") for (int n = 0; n < 2; ++n) _Pragma("unroll") for (int k = 0; k < 2; ++k) \
        acc[ai][bj][m][n] = __builtin_amdgcn_mfma_f32_16x16x32_bf16(Bt[n][k], At[m][k], acc[ai][bj][m][n], 0, 0, 0); __builtin_amdgcn_s_setprio(0); } while (0)
#define PG8_WAIT_V(n) asm volatile("s_waitcnt vmcnt(" #n ")" ::: "memory")
#define PG8_WAIT_L(n) asm volatile("s_waitcnt lgkmcnt(" #n ")" ::: "memory")
#define PG8_BAR __builtin_amdgcn_s_barrier()
#define PG8_SCHED __builtin_amdgcn_sched_barrier(0)
    Unit cur, nxt; int ui = 0;
    if (!S.next(0, cur)) return;
    f32x4 acc[2][2][4][2];
#pragma unroll
    for (int a = 0; a < 2; ++a)
#pragma unroll
        for (int b = 0; b < 2; ++b)
#pragma unroll
            for (int m = 0; m < 4; ++m)
#pragma unroll
                for (int n = 0; n < 2; ++n) acc[a][b][m][n] = (f32x4){0.f, 0.f, 0.f, 0.f};
    bf16x8 At[4][2], B0[2][2], B1[2][2];
    const char* cA = (const char*)g.A + (size_t)cur.pm * tstep; const char* cB = (const char*)g.Bt + (size_t)cur.pn * tstep;
    S.a_ready(cur);
    if constexpr (SP2) {
        PG8_STAGE(PG8_SB(0, 0), cB, voffB); PG8_STAGE(PG8_SB(0, 1), cB + hstep, voffB); PG8_STAGE(PG8_SA(0, 0), cA, voffA); PG8_STAGE(PG8_SA(0, 1), cA + hstep, voffA);
        if (wr == 1) PG8_BAR;
        PG8_WAIT_V(2); PG8_BAR;
        PG8_STAGE(PG8_SB(1, 0), cB + kstep, voffB); PG8_STAGE(PG8_SA(1, 0), cA + kstep, voffA); PG8_STAGE(PG8_SB(1, 1), cB + hstep + kstep, voffB);
        PG8_WAIT_V(6); PG8_BAR;
    } else {
        PG8_STAGE(PG8_SB(0, 0), cB, voffB); PG8_STAGE(PG8_SA(0, 0), cA, voffA); PG8_STAGE(PG8_SB(0, 1), cB + hstep, voffB); PG8_STAGE(PG8_SA(0, 1), cA + hstep, voffA);
        if (wr == 1) PG8_BAR;
        PG8_WAIT_V(4); PG8_BAR;
        PG8_STAGE(PG8_SB(1, 0), cB + kstep, voffB); PG8_STAGE(PG8_SA(1, 0), cA + kstep, voffA); PG8_STAGE(PG8_SB(1, 1), cB + hstep + kstep, voffB);
        PG8_WAIT_V(6); PG8_BAR;
    }
    for (;;) {
        const bool has_next = S.next(ui + 1, nxt);
        const char* nA = has_next ? (const char*)g.A + (size_t)nxt.pm * tstep : cA; const char* nB = has_next ? (const char*)g.Bt + (size_t)nxt.pn * tstep : cB;
        for (int t = 0; t < nt; t += 2) {
            const bool last = (t == nt - 2);
            const char* a1 = cA + (size_t)(t + 1) * kstep;
            const char* a2 = last ? nA : cA + (size_t)(t + 2) * kstep; const char* b2 = last ? nB : cB + (size_t)(t + 2) * kstep;
            const char* a3 = a2 + kstep; const char* b3 = b2 + kstep;
            if (last && has_next) S.a_ready(nxt);
            if constexpr (SP2) {
            PG8_LDB(B0, 0, 0); PG8_LDB(B1, 0, 1); PG8_SCHED; PG8_LDA(At, 0, 0); PG8_STAGE(PG8_SA(1, 1), a1 + hstep, voffA);
            PG8_WAIT_V(8); PG8_WAIT_L(0); PG8_BAR; PG8_MMA(0, 0, At, B0); PG8_MMA(0, 1, At, B1); PG8_BAR; PG8_SCHED;
            PG8_LDA(At, 0, 1); PG8_STAGE(PG8_SB(0, 0), b2, voffB); PG8_STAGE(PG8_SB(0, 1), b2 + hstep, voffB); PG8_STAGE(PG8_SA(0, 0), a2, voffA);
            PG8_WAIT_V(8); PG8_WAIT_L(0); PG8_BAR; PG8_MMA(1, 0, At, B0); PG8_MMA(1, 1, At, B1); PG8_BAR; PG8_SCHED;
            PG8_LDB(B0, 1, 0); PG8_LDB(B1, 1, 1); PG8_SCHED; PG8_LDA(At, 1, 0); PG8_STAGE(PG8_SA(0, 1), a2 + hstep, voffA);
            PG8_WAIT_V(8); PG8_WAIT_L(0); PG8_BAR; PG8_MMA(0, 0, At, B0); PG8_MMA(0, 1, At, B1); PG8_BAR; PG8_SCHED;
            PG8_LDA(At, 1, 1); PG8_STAGE(PG8_SB(1, 0), b3, voffB); PG8_STAGE(PG8_SB(1, 1), b3 + hstep, voffB); PG8_STAGE(PG8_SA(1, 0), a3, voffA);
            PG8_WAIT_V(8); PG8_WAIT_L(0); PG8_BAR; PG8_MMA(1, 0, At, B0); PG8_MMA(1, 1, At, B1); PG8_BAR; PG8_SCHED;
            } else {
            PG8_LDB(B0, 0, 0); PG8_SCHED; PG8_LDA(At, 0, 0); PG8_STAGE(PG8_SA(1, 1), a1 + hstep, voffA);
            PG8_WAIT_L(8); PG8_BAR; PG8_WAIT_L(0); PG8_MMA(0, 0, At, B0); PG8_BAR; PG8_SCHED;
            PG8_LDB(B1, 0, 1); PG8_STAGE(PG8_SB(0, 0), b2, voffB);
            PG8_BAR; PG8_WAIT_L(0); PG8_MMA(0, 1, At, B1); PG8_BAR;
            PG8_LDA(At, 0, 1); PG8_STAGE(PG8_SA(0, 0), a2, voffA);
            PG8_BAR; PG8_WAIT_L(0); PG8_MMA(1, 0, At, B0); PG8_BAR; PG8_SCHED;
            PG8_STAGE(PG8_SB(0, 1), b2 + hstep, voffB);
            PG8_WAIT_V(6); PG8_BAR; PG8_MMA(1, 1, At, B1); PG8_BAR;
            PG8_LDB(B0, 1, 0); PG8_SCHED; PG8_LDA(At, 1, 0); PG8_STAGE(PG8_SA(0, 1), a2 + hstep, voffA);
            PG8_WAIT_L(8); PG8_BAR; PG8_WAIT_L(0); PG8_MMA(0, 0, At, B0); PG8_BAR; PG8_SCHED;
            PG8_LDB(B1, 1, 1); PG8_STAGE(PG8_SB(1, 0), b3, voffB);
            PG8_BAR; PG8_WAIT_L(0); PG8_MMA(0, 1, At, B1); PG8_BAR;
            PG8_LDA(At, 1, 1); PG8_STAGE(PG8_SA(1, 0), a3, voffA);
            PG8_BAR; PG8_WAIT_L(0); PG8_MMA(1, 0, At, B0); PG8_BAR; PG8_SCHED;
            PG8_STAGE(PG8_SB(1, 1), b3 + hstep, voffB);
            PG8_WAIT_V(6); PG8_BAR; PG8_MMA(1, 1, At, B1); PG8_BAR;
            }
        }
        if constexpr (ALIGN_EPI) { if (wr == 0) PG8_BAR; }
        if constexpr (!Epi::AFTER_DRAIN) { E(acc, cur, wr, wc, fr, fq); S.done(cur); }
        if (!has_next) break;
#pragma unroll
        for (int a = 0; a < 2; ++a)
#pragma unroll
            for (int b = 0; b < 2; ++b)
#pragma unroll
                for (int m = 0; m < 4; ++m)
#pragma unroll
                    for (int n = 0; n < 2; ++n) acc[a][b][m][n] = (f32x4){0.f, 0.f, 0.f, 0.f};
        cur = nxt; cA = nA; cB = nB; ++ui;
        if constexpr (ALIGN_EPI) { if (wr == 1) PG8_BAR; }
    }
    PG8_WAIT_V(0);
    if constexpr (!ALIGN_EPI) { if (wr == 0) PG8_BAR; }
    PG8_BAR;
    if constexpr (Epi::AFTER_DRAIN) { E.fused(acc, cur, wr, wc, fr, fq, lds, wid, lane); S.done(cur); }
#undef PG8_SA
#undef PG8_SB
#undef PG8_STAGE
#undef PG8_LDA
#undef PG8_LDB
#undef PG8_MMA
#undef PG8_WAIT_V
#undef PG8_WAIT_L
#undef PG8_BAR
#undef PG8_SCHED
}
}

constexpr int NWAVES = 8;
constexpr int RING_OFF = 0, RING_BYTES = 131072;
constexpr int LDSCTL_OFF = RING_BYTES, MISC_OFF = LDSCTL_OFF + 320;
constexpr int LDS_BYTES = 147456;

struct Args { const float* in[52]; float* out; unsigned char* ws; };

struct Frame {
    LAS unsigned char* lds; int tid, lane, wave, G, blk;
    const float* const* in; float* out; unsigned char* ws;
};
#define INP(i) (args.in[i])
#define INPD(i) ({ int i_ = (i); asm volatile("" : "+s"(i_)); args.in[i_]; })

template <class Src>
DEVI void cvt_item(const Src src, bf16* WT, int Kd, int nblk, LAS float* scr, int item, int lane) {
    const int kb = item / nblk, nb = item % nblk, k0 = 64 * kb, n0 = 32 * nb;
#pragma unroll 8
    for (int i = 0; i < 32; ++i) { const int kk = 2 * i + (lane >> 5); scr[kk * 33 + (lane & 31)] = src(k0 + kk, n0 + (lane & 31)); }
    LDS_WAIT(); asm volatile("" ::: "memory");
    const int c = lane & 7;
#pragma unroll
    for (int j = 0; j < 4; ++j) { const int n = (lane >> 3) + 8 * j; const LAS float* s = scr + (8 * c) * 33 + n;
        v4u o; o.x = pk2(s[0 * 33], s[1 * 33]); o.y = pk2(s[2 * 33], s[3 * 33]); o.z = pk2(s[4 * 33], s[5 * 33]); o.w = pk2(s[6 * 33], s[7 * 33]);
        *(GAS v4u*)(WT + (size_t)(n0 + n) * Kd + k0 + 8 * c) = o; }
    LDS_WAIT(); asm volatile("" ::: "memory");
}
struct SrcPlain { const float* W; int K, N, ld; DEVI float operator()(int k, int n) const { return (k < K && n < N) ? W[(size_t)k * ld + n] : 0.f; } };
struct SrcFold { const float* W; const float* mu; int ld; DEVI float operator()(int k, int n) const { const int kk = k & 1023; const float m = mu[kk]; return (k < 1024 ? m : (1.0f - m)) * W[(size_t)kk * ld + n]; } };
struct SrcBlk { const float* W; int k0, k1; DEVI float operator()(int k, int n) const { return (k >= k0 && k < k1) ? W[(size_t)(k - k0) * 1024 + n] : 0.f; } };
struct SrcZero { DEVI float operator()(int, int) const { return 0.f; } };

DEVI void sincos_d(double x, double& s, double& c) {
    const double n = rint(x * 0.63661977236758134308);
    double r = fma(-n, 1.57079632679489655800e+00, x); r = fma(-n, 6.12323399573676603587e-17, r);
    const double r2 = r * r;
    double sp = -7.6471637318198164759e-13; sp = fma(sp, r2, 1.6059043836821614599e-10); sp = fma(sp, r2, -2.5052108385441718775e-08); sp = fma(sp, r2, 2.7557319223985890653e-06);
    sp = fma(sp, r2, -1.9841269841269841270e-04); sp = fma(sp, r2, 8.3333333333333333333e-03); sp = fma(sp, r2, -1.6666666666666666667e-01); const double sr = fma(sp * r2, r, r);
    double cp = 4.7794773323873852974e-14; cp = fma(cp, r2, -1.1470745597729724714e-11); cp = fma(cp, r2, 2.0876756987868098979e-09); cp = fma(cp, r2, -2.7557319223985890653e-07);
    cp = fma(cp, r2, 2.4801587301587301587e-05); cp = fma(cp, r2, -1.3888888888888888889e-03); cp = fma(cp, r2, 4.1666666666666666667e-02); cp = fma(cp, r2, -0.5); const double cr = fma(cp, r2, 1.0);
    const int q = ((int)n) & 3;
    s = (q == 0) ? sr : (q == 1) ? cr : (q == 2) ? -sr : -cr;
    c = (q == 0) ? cr : (q == 1) ? -sr : (q == 2) ? -cr : sr;
}
DEVI void s5prep_one(int i, const float* a_re, const float* a_im, const float* log_step, const float* b_re, const float* b_im, float* sp) {
    const int g = i >> 6;
    const double dt = exp((double)log_step[g]), ar = a_re[i], ai = a_im[i];
    const double mag = exp(ar * dt); double s, c; sincos_d(ai * dt, s, c);
    const double abr = mag * c, abi = mag * s, den = ar * ar + ai * ai, nr = abr - 1.0;
    const double zr = (nr * ar + abi * ai) / den, zi = (abi * ar - nr * ai) / den;
    sp[i] = (float)abr; sp[2048 + i] = (float)abi;
    for (int cc = 0; cc < 16; ++cc) { const double br = b_re[i * 16 + cc], bi = b_im[i * 16 + cc];
        sp[4096 + i * 16 + cc] = (float)(zr * br - zi * bi); sp[4096 + 32768 + i * 16 + cc] = (float)(zr * bi + zi * br); }
}

DEVI void init_row(int row, int lane, const float* xp, const float* xs, const float* mods, float* X, bf16* H) {
    if (row >= MT) { for (int j = 0; j < 16; ++j) H[(size_t)row * D + j * 64 + lane] = 0; return; }
    const float* src = row < NP ? xp + (size_t)row * D : xs + (size_t)(row - NP) * D;
    const float* sh = modp(mods, 0, 0) + (size_t)mrow(row) * 9216; const float* sc = modp(mods, 0, 1) + (size_t)mrow(row) * 9216;
#pragma unroll
    for (int j = 0; j < 4; ++j) { const int c = j * 256 + lane * 4; const f32x4 v = *(const f32x4*)(src + c), a = *(const f32x4*)(sc + c), b = *(const f32x4*)(sh + c);
        *(f32x4*)(X + (size_t)row * D + c) = v; const f32x4 h = v * (a + 1.0f) + b;
        *(unsigned long long*)(H + (size_t)row * D + c) = (unsigned long long)pk2(h[0], h[1]) | ((unsigned long long)pk2(h[2], h[3]) << 32); }
}
DEVI void ln_row(int row, int lane, const float* Z, const float* g, const float* b, float* X, bf16* H, const float* sh, const float* sc) {
    const float* z = Z + (size_t)row * D; f32x4 v[4]; float s = 0.f;
#pragma unroll
    for (int j = 0; j < 4; ++j) { v[j] = *(const f32x4*)(z + j * 256 + lane * 4); s += (v[j][0] + v[j][1]) + (v[j][2] + v[j][3]); }
    const float mean = wave_sum(s) * (1.f / D); float q = 0.f;
#pragma unroll
    for (int j = 0; j < 4; ++j) { v[j] = v[j] - mean; q += (v[j][0] * v[j][0] + v[j][1] * v[j][1]) + (v[j][2] * v[j][2] + v[j][3] * v[j][3]); }
    const float rstd = rsqrtf(wave_sum(q) * (1.f / D) + 1e-5f);
    const int mr = mrow(row);
#pragma unroll
    for (int j = 0; j < 4; ++j) { const int c = j * 256 + lane * 4; const f32x4 x = v[j] * rstd * *(const f32x4*)(g + c) + *(const f32x4*)(b + c); *(f32x4*)(X + (size_t)row * D + c) = x;
        if (H) { const f32x4 h = x * (*(const f32x4*)(sc + (size_t)mr * 9216 + c) + 1.0f) + *(const f32x4*)(sh + (size_t)mr * 9216 + c);
            *(unsigned long long*)(H + (size_t)row * D + c) = (unsigned long long)pk2(h[0], h[1]) | ((unsigned long long)pk2(h[2], h[3]) << 32); } }
}
DEVI void shiftcat_row(int row, int lane, const float* X, const float* mods, const float* shift_in, bf16* A2, float* out) {
    if (row >= MT) { for (int j = 0; j < 32; ++j) A2[(size_t)row * KRK + j * 64 + lane] = 0; return; }
    const int mr = mrow(row); const float* sh = modp(mods, 1, 3) + (size_t)mr * 9216; const float* sc = modp(mods, 1, 4) + (size_t)mr * 9216;
    const bool prompt = row < NP; const int t = row & 2047;
    for (int j = 0; j < 16; ++j) { const int c = j * 64 + lane; const float h = X[(size_t)row * D + c] * (1.f + sc[c]) + sh[c];
        float pv; if (prompt) pv = t == 0 ? 0.f : X[(size_t)(row - 1) * D + c] * (1.f + sc[c]) + sh[c]; else pv = shift_in[(size_t)(row - NP) * D + c];
        A2[(size_t)row * KRK + c] = (bf16)f2bf(pv); A2[(size_t)row * KRK + 1024 + c] = (bf16)f2bf(h);
        if (prompt) { if (t == 2047) out[O_SHIFT_P + (size_t)(row >> 11) * D + c] = h; } else out[O_SHIFT_S + (size_t)(row - NP) * D + c] = h; }
}
DEVI void gla_post_one(int w, int lane, const float* OG, const bf16* P, const float* norm_g, bf16* O) {
    const int tok = w >> 2, h = w & 3;
    const float o0 = OG[(size_t)tok * 512 + h * 128 + lane], o1 = OG[(size_t)tok * 512 + h * 128 + 64 + lane];
    const float ms = wave_sum(o0 * o0 + o1 * o1) * (1.f / 128.f), r = rsqrtf(ms + 1e-5f);
    const float g0 = bf2f(P[(size_t)tok * NINP + 1024 + h * 128 + lane]), g1 = bf2f(P[(size_t)tok * NINP + 1024 + h * 128 + 64 + lane]);
    O[(size_t)tok * D + h * 128 + lane] = (bf16)f2bf(o0 * r * norm_g[lane] * siluf_(g0));
    O[(size_t)tok * D + h * 128 + 64 + lane] = (bf16)f2bf(o1 * r * norm_g[64 + lane] * siluf_(g1));
}

DEVI void gla_job(LAS float* scr, int lane, int b, int h, int half, const bf16* P, const float* GKL, const float* w_gk, const float* b_gk, int tok_base, int T, const float* s0, float* s_out, float* OG) {
    LAS float* sdec = scr; LAS float* sq = scr + 1024; LAS float* sk = scr + 2048;
    const int dv = half * 64 + lane;
    float S[64];
#pragma unroll
    for (int i = 0; i < 64; ++i) S[i] = s0 ? s0[(((size_t)b * 4 + h) * 64 + i) * 128 + dv] : 0.f;
    float wg[16];
#pragma unroll
    for (int r = 0; r < 16; ++r) wg[r] = w_gk[r * 256 + h * 64 + lane];
    const float bg = b_gk[h * 64 + lane];
    for (int t0 = 0; t0 < T; t0 += 16) { const int nt = (T - t0) < 16 ? (T - t0) : 16;
        for (int tt = 0; tt < nt; ++tt) { const size_t tok = (size_t)tok_base + (size_t)b * T + t0 + tt; float x = bg;
#pragma unroll
            for (int r = 0; r < 16; ++r) x += GKL[tok * 16 + r] * wg[r];
            const float ls = fminf(x, 0.f) - log1pf(__expf(-fabsf(x)));
            sdec[tt * 64 + lane] = __expf(ls * (1.f / 16.f)); sq[tt * 64 + lane] = bf2f(P[tok * NINP + h * 64 + lane]) * 0.125f; sk[tt * 64 + lane] = bf2f(P[tok * NINP + 256 + h * 64 + lane]); }
        LDS_WAIT(); asm volatile("" ::: "memory");
        for (int tt = 0; tt < nt; ++tt) { const size_t tok = (size_t)tok_base + (size_t)b * T + t0 + tt;
            const float v = bf2f(P[tok * NINP + 512 + h * 128 + dv]); float o = 0.f;
#pragma unroll
            for (int i = 0; i < 64; ++i) { S[i] = S[i] * sdec[tt * 64 + i] + sk[tt * 64 + i] * v; o += sq[tt * 64 + i] * S[i]; }
            OG[tok * 512 + h * 128 + dv] = o; }
        LDS_WAIT(); asm volatile("" ::: "memory");
    }
#pragma unroll
    for (int i = 0; i < 64; ++i) s_out[(((size_t)b * 4 + h) * 64 + i) * 128 + dv] = S[i];
}
DEVI void s5_job(LAS float* scr, int lane, int g, int b0, int nb, const bf16* P, const float* sp, const float* c_re, const float* c_im, const float* dd, int tok_base, int T,
                 const float* h0re, const float* h0im, float* ore, float* oim, bf16* Z5) {
    const int p = lane, c = p & 15, pq = p >> 4;
    const float abr = sp[g * 64 + p], abi = sp[2048 + g * 64 + p];
    float bbr[16], bbi[16], cr[16], ci[16];
#pragma unroll
    for (int i = 0; i < 16; ++i) { bbr[i] = sp[4096 + (g * 64 + p) * 16 + i]; bbi[i] = sp[4096 + 32768 + (g * 64 + p) * 16 + i];
        cr[i] = c_re[(g * 16 + c) * 64 + pq * 16 + i]; ci[i] = c_im[(g * 16 + c) * 64 + pq * 16 + i]; }
    const float dv = dd[g * 16 + c];
    for (int b = b0; b < b0 + nb; ++b) {
        float hr = h0re ? h0re[((size_t)b * 32 + g) * 64 + p] : 0.f, hi = h0im ? h0im[((size_t)b * 32 + g) * 64 + p] : 0.f;
        for (int t = 0; t < T; ++t) { const size_t tok = (size_t)tok_base + (size_t)b * T + t;
            const bf16* up = P + tok * NINP + 1552 + g * 16; float u[16];
#pragma unroll
            for (int i = 0; i < 16; ++i) u[i] = bf2f(up[i]);
            const float uc = bf2f(up[c]);
            float br = 0.f, bi = 0.f;
#pragma unroll
            for (int i = 0; i < 16; ++i) { br += u[i] * bbr[i]; bi += u[i] * bbi[i]; }
            const float nr = abr * hr - abi * hi + br, ni = abr * hi + abi * hr + bi; hr = nr; hi = ni;
            LAS float* hs = scr + (t & 1) * 128;
            hs[p] = hr; hs[64 + p] = hi;
            LDS_WAIT(); asm volatile("" ::: "memory");
            float y = 0.f;
#pragma unroll
            for (int i = 0; i < 16; ++i) y += cr[i] * hs[pq * 16 + i] - ci[i] * hs[64 + pq * 16 + i];
            y += __shfl_xor(y, 16); y += __shfl_xor(y, 32);
            if (p < 16) { y += dv * uc; Z5[tok * 512 + g * 16 + c] = (bf16)f2bf(gelu_tanh(y)); }
        }
        ore[((size_t)b * 32 + g) * 64 + p] = hr; oim[((size_t)b * 32 + g) * 64 + p] = hi;
        LDS_WAIT(); asm volatile("" ::: "memory");
    }
}
DEVI void wkv_job(LAS float* scr, int lane, int b, int h, const bf16* R, const bf16* Kb, const bf16* V, const float* WD, const bf16* AS, bf16* GO, const float* k_k, const float* k_a, const float* r_k, const float* lnx_g, const float* lnx_b,
                  int tok_base, int T, const float* s0, float* s_out) {
    LAS float* sw = scr; LAS float* skm = scr + 512; LAS float* sa_ = scr + 1024; LAS float* sb = scr + 1536; LAS float* sr = scr + 2048; LAS float* sbon = scr + 2560;
    const int i = lane, ch = h * 64 + i;
    float S[64];
#pragma unroll
    for (int j = 0; j < 64; ++j) S[j] = s0 ? s0[(((size_t)b * 16 + h) * 64 + i) * 64 + j] : 0.f;
    const float kkc = k_k[ch], kac = k_a[ch], rkc = r_k[ch], lg = lnx_g[ch], lb = lnx_b[ch];
    for (int t0 = 0; t0 < T; t0 += 8) { const int nt = (T - t0) < 8 ? (T - t0) : 8;
        for (int tt = 0; tt < nt; ++tt) { const size_t tok = (size_t)tok_base + (size_t)b * T + t0 + tt;
            const float k = bf2f(Kb[tok * D + ch]), r = bf2f(R[tok * D + ch]), a = bf2f(AS[tok * D + ch]), w = WD[tok * D + ch];
            float kk = k * kkc; const float nrm = sqrtf(wave_sum(kk * kk)); kk = kk / fmaxf(nrm, 1e-12f);
            const float km = k * (1.f + (a - 1.f) * kac);
            sw[tt * 64 + i] = w; skm[tt * 64 + i] = km; sa_[tt * 64 + i] = -kk; sb[tt * 64 + i] = kk * a; sr[tt * 64 + i] = r;
            const float bon = wave_sum(r * km * rkc); if (i == 0) sbon[tt] = bon; }
        LDS_WAIT(); asm volatile("" ::: "memory");
        for (int tt = 0; tt < nt; ++tt) { const size_t tok = (size_t)tok_base + (size_t)b * T + t0 + tt;
            const float v = bf2f(V[tok * D + ch]); float sa = 0.f;
#pragma unroll
            for (int j = 0; j < 64; ++j) sa += S[j] * sa_[tt * 64 + j];
            float y = 0.f;
#pragma unroll
            for (int j = 0; j < 64; ++j) { S[j] = S[j] * sw[tt * 64 + j] + sa * sb[tt * 64 + j] + v * skm[tt * 64 + j]; y += S[j] * sr[tt * 64 + j]; }
            const float mean = wave_sum(y) * (1.f / 64.f), dy = y - mean, var = wave_sum(dy * dy) * (1.f / 64.f);
            float yn = dy * rsqrtf(var + 64e-5f) * lg + lb; yn += sbon[tt] * v;
            const float gt = bf2f(GO[tok * D + ch]); GO[tok * D + ch] = (bf16)f2bf(yn * gt); }
        LDS_WAIT(); asm volatile("" ::: "memory");
    }
#pragma unroll
    for (int j = 0; j < 64; ++j) s_out[(((size_t)b * 16 + h) * 64 + i) * 64 + j] = S[j];
}

__global__ void __launch_bounds__(NWAVES * 64, 2) mk_fwd(Args args) {
    extern __shared__ __attribute__((aligned(16))) unsigned char lds_raw[];
    LAS unsigned char* lds = (LAS unsigned char*)lds_raw;
    volatile LAS unsigned* MISC = (volatile LAS unsigned*)(lds + MISC_OFF);
    const int tid = threadIdx.x, lane = tid & 63, wave = __builtin_amdgcn_readfirstlane(tid >> 6), G = gridDim.x, blk = blockIdx.x;
#define LW() ({ unsigned char* p_ = args.ws; asm volatile("" : "+s"(p_)); p_; })
#define LO() ({ float* p_ = args.out; asm volatile("" : "+s"(p_)); p_; })
#define PTRS unsigned char* ws = LW(); float* out = LO(); float* MODS = (float*)(ws + WS_MODS); float* SP = (float*)(ws + WS_SP); bf16* H = (bf16*)(ws + WS_H); float* Z = (float*)(ws + WS_Z); bf16* ACT = (bf16*)(ws + WS_ACT); float* X = out; \
    (void)MODS; (void)SP; (void)H; (void)Z; (void)ACT; (void)X
    for (int u = tid; u < (LDS_BYTES - LDSCTL_OFF) / 4; u += NWAVES * 64) ((LAS unsigned*)(lds + LDSCTL_OFF))[u] = 0u;
    __syncthreads();
    { XcdBarrier b0_ = xcd_barrier_post((unsigned*)(LW() + WS_CTL) + CW_BAR, MISC + 8); (void)b0_; }
#define GRID_BAR() do { XcdBarrier b_; b_.bar = (unsigned*)(LW() + WS_CTL) + CW_BAR; b_.x = xb_xcc_id(); b_.st = MISC + 8; xcd_barrier(b_); } while (0)
    const int gw = blk * NWAVES + wave, NGW = G * NWAVES;
    const int gws = wave * G + blk;
    LAS float* wscr = (LAS float*)(lds + RING_OFF + wave * 16384);

    { PTRS;
        constexpr int I_UP = (D / 64) * (NUP / 32), I_DN = (FFP / 64) * (D / 32), I_IN = (D / 64) * (NINP / 32), I_GLU = (512 / 64) * (512 / 32), I_SQ = (D / 64) * (D / 32), I_RK = (KRK / 64) * (NRK / 32), I_L2 = (NL1 / 64) * (3072 / 32);
        constexpr int NITEMS = 4 * I_UP + 4 * I_DN + I_IN + I_GLU + 2 * I_SQ + I_RK + I_L2;
        for (int it = gw; it < NITEMS; it += NGW) {
            int r = it;
            if (r < 4 * I_UP) { const int q = r / I_UP, l = q >> 1, f = q & 1; r -= q * I_UP;
                const int kb = r / (NUP / 32), nb = r % (NUP / 32), pn = nb >> 3, half = (nb >> 2) & 1, c0 = pn * 128 + (nb & 3) * 32;
                bf16* dst = (bf16*)(ws + (l ? WS_WUP_L1 : WS_WUP_L0) + f * SZ_WUP) + (size_t)(nb * 32) * D;
                if (c0 >= FF) { SrcZero s; cvt_item(s, dst, D, 1, wscr, kb, lane); }
                else if (half) { SrcPlain s{INPD(f ? 17 : 14) + (size_t)l * D * FF + c0, D, FF - c0, FF}; cvt_item(s, dst, D, 1, wscr, kb, lane); }
                else { SrcPlain s{INPD(f ? 16 : 13) + (size_t)l * D * FF + c0, D, FF - c0, FF}; cvt_item(s, dst, D, 1, wscr, kb, lane); }
                continue; } r -= 4 * I_UP;
            if (r < 4 * I_DN) { const int q = r / I_DN, l = q >> 1, f = q & 1; r -= q * I_DN;
                SrcPlain s{INPD(f ? 18 : 15) + (size_t)l * FF * D, FF, D, D};
                cvt_item(s, (bf16*)(ws + (l ? WS_WDN_L1 : WS_WDN_L0) + f * SZ_WDN), FFP, D / 32, wscr, r, lane); continue; } r -= 4 * I_DN;
            if (r < I_IN) { SrcPlain s{INPD(19), D, NIN, NIN}; cvt_item(s, (bf16*)(ws + WS_WIN), D, NINP / 32, wscr, r, lane); continue; } r -= I_IN;
            if (r < I_GLU) { SrcPlain s{INPD(32), 512, 512, 512}; cvt_item(s, (bf16*)(ws + WS_WGLU), 512, 512 / 32, wscr, r, lane); continue; } r -= I_GLU;
            if (r < I_SQ) { SrcPlain s{INPD(20), D, D, D}; cvt_item(s, (bf16*)(ws + WS_WOUT), D, D / 32, wscr, r, lane); continue; } r -= I_SQ;
            if (r < I_SQ) { SrcPlain s{INPD(38), D, D, D}; cvt_item(s, (bf16*)(ws + WS_WO), D, D / 32, wscr, r, lane); continue; } r -= I_SQ;
            if (r < I_RK) { const int kb = r / (NRK / 32), nb = r % (NRK / 32), n0 = nb * 32; bf16* dst = (bf16*)(ws + WS_WRK) + (size_t)n0 * KRK;
                if (n0 < 1024) { SrcFold s{INPD(35) + n0, INPD(34) + 0 * 1024, 1024}; cvt_item(s, dst, KRK, 1, wscr, kb, lane); }
                else if (n0 < 2048) { SrcFold s{INPD(36) + (n0 - 1024), INPD(34) + 2 * 1024, 1024}; cvt_item(s, dst, KRK, 1, wscr, kb, lane); }
                else if (n0 < 3072) { SrcFold s{INPD(37) + (n0 - 2048), INPD(34) + 3 * 1024, 1024}; cvt_item(s, dst, KRK, 1, wscr, kb, lane); }
                else if (n0 < 3136) { SrcFold s{INPD(40) + (n0 - 3072), INPD(34) + 1 * 1024, 64}; cvt_item(s, dst, KRK, 1, wscr, kb, lane); }
                else if (n0 < 3200) { SrcFold s{INPD(43) + (n0 - 3136), INPD(34) + 4 * 1024, 64}; cvt_item(s, dst, KRK, 1, wscr, kb, lane); }
                else if (n0 < 3360) { SrcFold s{INPD(45) + (n0 - 3200), INPD(34) + 5 * 1024, 160}; cvt_item(s, dst, KRK, 1, wscr, kb, lane); }
                else { SrcZero s; cvt_item(s, dst, KRK, 1, wscr, kb, lane); }
                continue; } r -= I_RK;
            { const int kb = r / (3072 / 32), nb = r % (3072 / 32), n0 = nb * 32; bf16* dst = (bf16*)(ws + WS_WL2) + (size_t)n0 * NL1;
                if (n0 < 1024) { SrcBlk s{INPD(41) + n0, 0, 64}; cvt_item(s, dst, NL1, 1, wscr, kb, lane); }
                else if (n0 < 2048) { SrcBlk s{INPD(44) + (n0 - 1024), 64, 128}; cvt_item(s, dst, NL1, 1, wscr, kb, lane); }
                else { SrcBlk s{INPD(46) + (n0 - 2048), 128, 288}; cvt_item(s, dst, NL1, 1, wscr, kb, lane); } }
        }
        __syncthreads();
        {
            const int vb = tid >> 8, t8 = tid & 255; LAS float* sc = (LAS float*)(lds + vb * 32768);
            for (int j0 = blk * 2; j0 < 1224; j0 += G * 2) { const int j = j0 + vb; const bool act = j < 1224;
                const int l = j / 612, rem = j % 612, ry = rem / 36, nx = rem % 36, r0 = ry * 8, n = nx * 256 + t8;
                __syncthreads();
                if (act) for (int i = t8; i < 8 * 1024; i += 256) { const int r = r0 + (i >> 10), k = i & 1023; const float v = r < 8 ? INP(7)[r * 1024 + k] : INP(8)[(r - 8) * 1024 + k]; sc[i] = siluf_(v); }
                __syncthreads();
                if (act) { float acc[8];
#pragma unroll
                    for (int q = 0; q < 8; ++q) acc[q] = 0.f;
                    const float* w = INP(9) + (size_t)l * 1024 * 9216 + n;
                    for (int k = 0; k < 1024; k += 4) { const float w0 = w[(size_t)k * 9216], w1 = w[(size_t)(k + 1) * 9216], w2 = w[(size_t)(k + 2) * 9216], w3 = w[(size_t)(k + 3) * 9216];
#pragma unroll
                        for (int q = 0; q < 8; ++q) { const f32x4 s4 = *(const LAS f32x4*)(sc + q * 1024 + k); acc[q] += s4[0] * w0 + s4[1] * w1 + s4[2] * w2 + s4[3] * w3; } }
                    const float bb = INP(10)[l * 9216 + n];
#pragma unroll
                    for (int q = 0; q < 8; ++q) MODS[((size_t)l * NMODROW + r0 + q) * 9216 + n] = acc[q] + bb; }
            }
            __syncthreads();
        }
        if (blk == G - 1) for (int i = tid; i < 2048; i += NWAVES * 64) s5prep_one(i, INP(24), INP(25), INP(26), INP(27), INP(28), SP);
    }
    GRID_BAR();
    { PTRS; for (int row = gw; row < MTP; row += NGW) init_row(row, lane, INP(0), INP(1), MODS, X, H); }
    GRID_BAR();

#define GEMM_PHASE(EPI, Aptr, Bptr, NN, KK, ...) do { pg8::Gemm g_{(const pg8::bf16_t*)(Aptr), (const pg8::bf16_t*)(Bptr), MTP, NN, KK}; pg8::StaticOrder S_; S_.init(MTP, NN, G, blk); pg8::EPI E_{__VA_ARGS__}; \
        pg8::gemm_phase<pg8::EPI, pg8::StaticOrder, true, true>(lds + RING_OFF, g_, S_, E_); } while (0)
#define LN_PASS(l, idx, Hout, nsh, nsc) do { PTRS; for (int row = gw; row < MT; row += NGW) ln_row(row, lane, Z, INP(11) + ((l) * 3 + (idx)) * D, INP(12) + ((l) * 3 + (idx)) * D, X, Hout, nsh, nsc); } while (0)
#define FFN(l, f, which0, lnidx, HOUT, nshw, nscw) do { \
        { PTRS; GEMM_PHASE(EpiSwiglu, H, ws + ((l) ? WS_WUP_L1 : WS_WUP_L0) + (f) * SZ_WUP, NUP, D, (pg8::bf16_t*)ACT); } GRID_BAR(); \
        { PTRS; GEMM_PHASE(EpiResid, ACT, ws + ((l) ? WS_WDN_L1 : WS_WDN_L0) + (f) * SZ_WDN, D, FFP, X, Z, modp(MODS, l, (which0) + 2), 0.5f, 0); } GRID_BAR(); \
        LN_PASS(l, lnidx, HOUT, nshw, nscw); GRID_BAR(); } while (0)

    FFN(0, 0, 0, 0, H, modp(MODS, 0, 3), modp(MODS, 0, 4));
#define L0PTRS PTRS; bf16* P = (bf16*)(ws + WS_P); float* GKL = (float*)(ws + WS_GKL); float* OG = (float*)(ws + WS_OG); bf16* Z5 = (bf16*)(ws + WS_Z5); bf16* O = (bf16*)(ws + WS_O); (void)P; (void)GKL; (void)OG; (void)Z5; (void)O
    { L0PTRS; GEMM_PHASE(EpiInproj, H, ws + WS_WIN, NINP, D, (pg8::bf16_t*)P, GKL); } GRID_BAR();
    { L0PTRS;
        if (gws < 64) gla_job(wscr, lane, gws >> 3, (gws >> 1) & 3, gws & 1, P, GKL, INPD(21), INPD(22), 0, TP, nullptr, out + O_GLA_P, OG);
        else if (gws < 320) { const int j = gws - 64; s5_job(wscr, lane, j & 31, j >> 5, 1, P, SP, INPD(29), INPD(30), INPD(31), 0, TP, nullptr, nullptr, out + O_S5RE_P, out + O_S5IM_P, Z5); }
        else { for (int s = gws - 320; s < 1536; s += NGW - 320) {
                if (s < 1024) gla_job(wscr, lane, s >> 3, (s >> 1) & 3, s & 1, P, GKL, INPD(21), INPD(22), NP, 1, INPD(2), out + O_GLA_S, OG);
                else { const int j = s - 1024; s5_job(wscr, lane, j & 31, (j >> 5) * 8, 8, P, SP, INPD(29), INPD(30), INPD(31), NP, 1, INPD(3), INPD(4), out + O_S5RE_S, out + O_S5IM_S, Z5); } } }
    }
    GRID_BAR();
    { L0PTRS; for (int w = gw; w < MT * 4; w += NGW) gla_post_one(w, lane, OG, P, INP(23), O);
        GEMM_PHASE(EpiGlu, Z5, ws + WS_WGLU, 512, 512, (const pg8::bf16_t*)Z5, (pg8::bf16_t*)O, INP(33)); } GRID_BAR();
    { L0PTRS; GEMM_PHASE(EpiResid, O, ws + WS_WOUT, D, D, X, Z, modp(MODS, 0, 5), 1.0f, 0); } GRID_BAR();
    LN_PASS(0, 1, H, modp(MODS, 0, 6), modp(MODS, 0, 7)); GRID_BAR();
    FFN(0, 1, 6, 2, H, modp(MODS, 1, 0), modp(MODS, 1, 1));
    FFN(1, 0, 0, 0, (bf16*)nullptr, (const float*)nullptr, (const float*)nullptr);
#define L1PTRS PTRS; bf16* A2 = (bf16*)(ws + WS_A2); bf16* R = (bf16*)(ws + WS_R); bf16* Kb = (bf16*)(ws + WS_K); bf16* V = (bf16*)(ws + WS_V); bf16* L1 = (bf16*)(ws + WS_L1A); \
        float* WD = (float*)(ws + WS_WD); bf16* AS = (bf16*)(ws + WS_AS); bf16* Gt = (bf16*)(ws + WS_G); (void)A2; (void)R; (void)Kb; (void)V; (void)L1; (void)WD; (void)AS; (void)Gt
    { L1PTRS; for (int row = gw; row < MTP; row += NGW) shiftcat_row(row, lane, X, MODS, INP(5), A2, out); } GRID_BAR();
    { L1PTRS; GEMM_PHASE(EpiRk, A2, ws + WS_WRK, NRK, KRK, (pg8::bf16_t*)R, (size_t)MTP * D, (pg8::bf16_t*)L1); } GRID_BAR();
    { L1PTRS; GEMM_PHASE(EpiLora2, L1, ws + WS_WL2, 3072, NL1, WD, (pg8::bf16_t*)AS, (pg8::bf16_t*)Gt, INP(39), INP(42)); } GRID_BAR();
    { L1PTRS;
        if (gws < 128) wkv_job(wscr, lane, gws >> 4, gws & 15, R, Kb, V, WD, AS, Gt, INPD(47), INPD(48), INPD(49), INPD(50), INPD(51), 0, TP, nullptr, out + O_WKV_P);
        else for (int s = gws - 128; s < 2048; s += NGW - 128) wkv_job(wscr, lane, s >> 4, s & 15, R, Kb, V, WD, AS, Gt, INPD(47), INPD(48), INPD(49), INPD(50), INPD(51), NP, 1, INPD(6), out + O_WKV_S);
    }
    GRID_BAR();
    { L1PTRS; GEMM_PHASE(EpiResid, Gt, ws + WS_WO, D, D, X, Z, modp(MODS, 1, 5), 1.0f, 0); } GRID_BAR();
    LN_PASS(1, 1, H, modp(MODS, 1, 6), modp(MODS, 1, 7)); GRID_BAR();
    { PTRS; GEMM_PHASE(EpiSwiglu, H, ws + WS_WUP_L1 + SZ_WUP, NUP, D, (pg8::bf16_t*)ACT); } GRID_BAR();
    { PTRS; GEMM_PHASE(EpiResid, ACT, ws + WS_WDN_L1 + SZ_WDN, D, FFP, X, Z, modp(MODS, 1, 8), 0.5f, 0); } GRID_BAR();
    LN_PASS(1, 2, (bf16*)nullptr, (const float*)nullptr, (const float*)nullptr);
}

extern "C" void kernel_launch(void* const* d_in, const int* in_sizes, int n_in, void* d_out, int out_size, void* d_ws, size_t ws_size, hipStream_t stream) {
    static int grid = 0;
    if (grid == 0) {
        if (n_in != 52 || ws_size < WS_END) { fprintf(stderr, "kernel_launch: unexpected n_in %d or ws %zu\n", n_in, ws_size); grid = -1; return; }
        int dev = 0, cus = 0, per_cu = 0;
        if (hipGetDevice(&dev) != hipSuccess || hipDeviceGetAttribute(&cus, hipDeviceAttributeMultiprocessorCount, dev) != hipSuccess) { grid = -1; return; }
        if (hipFuncSetAttribute((const void*)mk_fwd, hipFuncAttributeMaxDynamicSharedMemorySize, LDS_BYTES) != hipSuccess) { fprintf(stderr, "hipFuncSetAttribute failed\n"); grid = -1; return; }
        if (hipOccupancyMaxActiveBlocksPerMultiprocessor(&per_cu, (const void*)mk_fwd, NWAVES * 64, LDS_BYTES) != hipSuccess || per_cu < 1) { fprintf(stderr, "occupancy query: %d\n", per_cu); per_cu = 1; }
        (void)hipGetLastError();
        grid = cus;
    }
    if (grid < 0) return;
    (void)hipMemsetAsync((char*)d_ws + WS_CTL, 0, CTL_ZERO_BYTES, stream);
    Args a{};
    for (int i = 0; i < 52; ++i) a.in[i] = (const float*)d_in[i];
    a.out = (float*)d_out; a.ws = (unsigned char*)d_ws;
    hipLaunchKernelGGL(mk_fwd, dim3(grid), dim3(NWAVES * 64), LDS_BYTES, stream, a);
}
```

```cpp
#include <hip/hip_runtime.h>
#include <cstdint>
#include <cstdio>

typedef unsigned short bf16;
typedef short bf16x8 __attribute__((ext_vector_type(8)));
typedef float f32x4 __attribute__((ext_vector_type(4)));
#define DEVI __device__ __forceinline__

constexpr int D = 1024, NP = 16384, NS = 128, MT = NP + NS, MTP = 16640, TP = 2048, BP = 8;
constexpr int FF = 2752, FFP = 2816, NUP = 2 * FFP;
constexpr int NIN = 2064, NINP = 2304;
constexpr int NRK = 3584, KRK = 2048, NL1 = 384;
constexpr int NMODROW = 136;
constexpr float ALPHA = 1.41421356237309515f;

constexpr size_t O_Y = 0, O_GLA_P = 16908288, O_S5RE_P = 17170432, O_S5IM_P = 17186816, O_SHIFT_P = 17203200, O_WKV_P = 17211392,
                 O_GLA_S = 17735680, O_S5RE_S = 21929984, O_S5IM_S = 22192128, O_SHIFT_S = 22454272, O_WKV_S = 22585344;

constexpr size_t MiB = 1u << 20;
constexpr size_t WS_CTL = 0, CTL_ZERO_BYTES = 1 * MiB;
constexpr size_t WS_MODS = 1 * MiB, WS_SP = 12 * MiB;
constexpr size_t WS_W = 13 * MiB;
constexpr size_t SZ_WUP = (size_t)NUP * D * 2;
constexpr size_t SZ_WDN = (size_t)D * FFP * 2;
constexpr size_t WS_L0 = WS_W;
constexpr size_t WS_WUP_L0 = WS_L0, WS_WDN_L0 = WS_L0 + 22 * MiB, WS_WIN = WS_L0 + 33 * MiB, WS_WGLU = WS_WIN + 4608 * 1024, WS_WOUT = WS_WGLU + 512 * 1024;
constexpr size_t WS_L1 = WS_L0 + 40 * MiB;
constexpr size_t WS_WUP_L1 = WS_L1, WS_WDN_L1 = WS_L1 + 22 * MiB, WS_WRK = WS_L1 + 33 * MiB, WS_WL2 = WS_WRK + 14 * MiB, WS_WO = WS_WL2 + 2304 * 1024;
static_assert(WS_WO + 2 * MiB <= 105 * MiB, "W region");
constexpr size_t WS_H = 105 * MiB, WS_Z = 138 * MiB, WS_ACT = 203 * MiB, WS_S2 = 293 * MiB, WS_END = 340 * MiB;
constexpr size_t WS_P = WS_ACT, WS_GKL = 277 * MiB, WS_OG = WS_S2, WS_Z5 = WS_Z, WS_O = WS_H;
constexpr size_t WS_A2 = WS_ACT, WS_K = WS_Z, WS_R = WS_Z - (size_t)MTP * D * 2, WS_V = WS_Z + (size_t)MTP * D * 2, WS_L1A = WS_L0, WS_WD = WS_ACT, WS_AS = 268 * MiB, WS_G = WS_AS + (size_t)MTP * D * 2;
static_assert(WS_G + (size_t)MTP * D * 2 <= WS_END, "ws");
constexpr int CW_TMO = 0, CW_BAR = 4096;

#define GAS __attribute__((address_space(1)))
#define LAS __attribute__((address_space(3)))
typedef unsigned short bf16;
typedef unsigned v4u __attribute__((ext_vector_type(4)));
typedef float f32x4 __attribute__((ext_vector_type(4)));
typedef short bf16x8 __attribute__((ext_vector_type(8)));
typedef GAS unsigned gu32;
typedef GAS unsigned long long gu64;
#define RLX_AGENT __ATOMIC_RELAXED, __HIP_MEMORY_SCOPE_AGENT
#define LDS_WAIT() asm volatile("s_waitcnt lgkmcnt(0)" ::: "memory")
#define VM_WAIT() asm volatile("s_waitcnt vmcnt(0)" ::: "memory")
__device__ __forceinline__ unsigned long long rt() { return __builtin_amdgcn_s_memrealtime(); }
__device__ __forceinline__ unsigned f2bf(float f) { unsigned u = __builtin_bit_cast(unsigned, f); return (u + 0x7fffu + ((u >> 16) & 1u)) >> 16; }
__device__ __forceinline__ unsigned pk2(float lo, float hi) { return f2bf(lo) | (f2bf(hi) << 16); }

#define XB_TMO      128
#define XB_XCNT(j)  (256  + 64 * (j))
#define XB_XSUB(j)  (1280 + 64 * (j))
#define XB_XGEN(j)  (2304 + 64 * (j))
#define XB_TOP      3328
#define XB_TOPGEN   3392
#define XCD_BAR_WORDS 3456
#define XB_SPIN_CAP (1u << 18)

__device__ __forceinline__ unsigned xb_ld(unsigned* p)              { return __hip_atomic_load(p, __ATOMIC_RELAXED, __HIP_MEMORY_SCOPE_AGENT); }
__device__ __forceinline__ unsigned xb_add(unsigned* p, unsigned v) { return __hip_atomic_fetch_add(p, v, __ATOMIC_RELAXED, __HIP_MEMORY_SCOPE_AGENT); }
__device__ __forceinline__ unsigned xb_xcc_id() { return (unsigned)__builtin_amdgcn_s_getreg((3 << 11) | 20) & 0xFu; }
#define XB_SPIN(cond, bar) do { unsigned _sp = 0; while (cond) { __builtin_amdgcn_s_sleep(1); \
    if ((++_sp & 255u) == 0u) { if (xb_ld(&(bar)[XB_TMO])) break; if (_sp > XB_SPIN_CAP) { atomicAdd(&(bar)[XB_TMO], 1u); break; } } } } while (0)

struct XcdBarrier {
    unsigned* bar; unsigned x;
    volatile LAS unsigned* st;
};

__device__ __forceinline__ XcdBarrier xcd_barrier_post(unsigned* bar, volatile LAS unsigned* st) {
    XcdBarrier b; b.bar = bar; b.x = xb_xcc_id(); b.st = st;
    if (threadIdx.x == 0) (void)xb_add(&bar[XB_XCNT(b.x)], 1u);
    return b;
}
__device__ __forceinline__ void xcd_barrier_complete(unsigned* bar, unsigned x, unsigned& nloc, unsigned& nx) {
    const unsigned G = gridDim.x * gridDim.y * gridDim.z;
    unsigned sum, cnt, mine, sp = 0u;
    for (;;) {
        sum = 0u; cnt = 0u; mine = 0u;
#pragma unroll
        for (unsigned j = 0; j < 16; ++j) { const unsigned c = xb_ld(&bar[XB_XCNT(j)]); sum += c; cnt += (c > 0u) ? 1u : 0u; mine = (j == x) ? c : mine; }
        if (sum == G) break;
        __builtin_amdgcn_s_sleep(1);
        if ((++sp & 255u) == 0u) { if (xb_ld(&bar[XB_TMO])) break; if (sp > XB_SPIN_CAP) { atomicAdd(&bar[XB_TMO], 1u); break; } }
    }
    nloc = mine > 0u ? mine : 1u; nx = cnt > 0u ? cnt : 1u;
}

__device__ __forceinline__ void xcd_barrier(const XcdBarrier& b) {
    asm volatile("s_waitcnt vmcnt(0)" ::: "memory");
    __syncthreads();
    if (threadIdx.x == 0) {
        unsigned* bar = b.bar;
        __builtin_amdgcn_s_waitcnt(0);
        unsigned nloc = b.st[0], nx = b.st[1];
        if (nloc == 0u) { xcd_barrier_complete(bar, b.x, nloc, nx); b.st[0] = nloc; b.st[1] = nx; }
        const unsigned old = xb_add(&bar[XB_XSUB(b.x)], 1u);
        const unsigned gen = old / nloc;
        if (old + 1u == (gen + 1u) * nloc) {
            __builtin_amdgcn_fence(__ATOMIC_RELEASE, "agent");
            asm volatile("s_waitcnt vmcnt(0)" ::: "memory");
            const unsigned og = xb_add(&bar[XB_TOP], 1u);
            const unsigned tg = og / nx;
            if (og + 1u == (tg + 1u) * nx) xb_add(&bar[XB_TOPGEN], 1u);
            else XB_SPIN(xb_ld(&bar[XB_TOPGEN]) == tg, bar);
            __builtin_amdgcn_fence(__ATOMIC_ACQUIRE, "agent");
            xb_add(&bar[XB_XGEN(b.x)], 1u);
            asm volatile("s_waitcnt vmcnt(0)" ::: "memory");
        } else {
            XB_SPIN(xb_ld(&bar[XB_XGEN(b.x)]) == gen, bar);
            __builtin_amdgcn_fence(__ATOMIC_ACQUIRE, "agent");
            asm volatile("s_waitcnt vmcnt(0)" ::: "memory");
        }
    }
    __syncthreads();
}

DEVI float bf2f(unsigned short h) { return __uint_as_float(((unsigned)h) << 16); }
DEVI int mrow(int i) { return i < NP ? (i >> 11) : (8 + i - NP); }
DEVI float sigmoidf_(float x) { return 1.0f / (1.0f + __expf(-x)); }
DEVI float siluf_(float x) { return x / (1.0f + __expf(-x)); }
DEVI float softplusf_(float x) { return fmaxf(x, 0.f) + log1pf(__expf(-fabsf(x))); }
DEVI float gelu_tanh(float x) { const float u = 0.7978845608028654f * (x + 0.044715f * x * x * x); return 0.5f * x * (1.0f + tanhf(u)); }
DEVI float wave_sum(float v) {
#pragma unroll
    for (int o = 1; o < 64; o <<= 1) v += __shfl_xor(v, o);
    return v;
}
__host__ __device__ __forceinline__ const float* modp(const float* mods, int l, int which) { return mods + (size_t)l * NMODROW * 9216 + which * 1024; }

namespace pg8 {
#define PG8_LAS __attribute__((address_space(3)))
typedef unsigned short bf16_t;
typedef short bf16x8 __attribute__((ext_vector_type(8)));
typedef float f32x4 __attribute__((ext_vector_type(4)));
typedef unsigned u32x4 __attribute__((ext_vector_type(4)));
constexpr int BM = 256, BK = 64, HALF = 128, HTB = HALF * BK * 2  , STAGE_BYTES = 8 * HTB, NXCD = 8, WGM = 8;

__host__ __device__ __forceinline__ int lds_byte(int r, int c) { const int st = (r >> 4) * 2 + (c >> 5), rr = r & 15, cc = c & 31, ob = rr * 64 + cc * 2; return st * 1024 + (ob ^ (((ob >> 9) & 1) << 5)); }
__host__ __device__ __forceinline__ void stage_rc(int b, int& R, int& C) { const int st = b / 1024, sb = b % 1024, swz = sb ^ (((sb >> 9) & 1) << 5); R = (st >> 1) * 16 + swz / 64; C = (st & 1) * 32 + (swz % 64) / 2; }
__host__ __device__ __forceinline__ int perm32(int rho) { const int n = rho >> 4, i = rho & 15; return 8 * (i >> 2) + 4 * n + (i & 3); }

struct Unit { int pm, pn; };
struct Gemm { const bf16_t* A; const bf16_t* Bt; int M, N, K; };

struct StaticOrder {
    int nM, nN, nwg, G, c;
    __host__ __device__ void init(int M, int N, int G_, int c_) { nM = M / BM; nN = N / BM; nwg = nM * nN; G = G_; c = c_; }
    __host__ __device__ bool next(int i, Unit& u) const {
        const long L = (long)i * G + c; if (L >= nwg) return false;
        int wgid = (int)L; { const int q = nwg / NXCD, r = nwg % NXCD, xcd = wgid % NXCD, off = wgid / NXCD; wgid = (xcd < r ? xcd * (q + 1) : r * (q + 1) + (xcd - r) * q) + off; }
        const int nig = WGM * nN, gid = wgid / nig, fm = gid * WGM, gsz = (nM - fm) < WGM ? (nM - fm) : WGM;
        u.pm = fm + ((wgid % nig) % gsz); u.pn = (wgid % nig) / gsz; return true;
    }
    __device__ __forceinline__ void a_ready(const Unit&) const {}
    __device__ __forceinline__ void done(const Unit&) const {}
};


__device__ __forceinline__ unsigned cvt_pk_bf16(float lo, float hi) { unsigned r; asm volatile("v_cvt_pk_bf16_f32 %0, %1, %2" : "=v"(r) : "v"(lo), "v"(hi)); return r; }
__device__ __forceinline__ float fsilu(float x) { return x * __builtin_amdgcn_rcpf(1.0f + __builtin_amdgcn_exp2f(-1.44269504089f * x)); }
__device__ __forceinline__ float fsigm(float x) { return __builtin_amdgcn_rcpf(1.0f + __builtin_amdgcn_exp2f(-1.44269504089f * x)); }
__device__ __forceinline__ u32x4 pack8(const f32x4 a, const f32x4 b) { u32x4 w; w.x = cvt_pk_bf16(a[0], a[1]); w.y = cvt_pk_bf16(a[2], a[3]); w.z = cvt_pk_bf16(b[0], b[1]); w.w = cvt_pk_bf16(b[2], b[3]); return w; }
struct EpiSwiglu { static constexpr bool PERM = true, AFTER_DRAIN = false; bf16_t* ACT;
    __device__ __forceinline__ void operator()(const f32x4 (&acc)[2][2][4][2], const Unit& u, int wr, int wc, int fr, int fq) const {
        const int row0 = u.pm * BM + wr * 64 + fr, col0 = u.pn * 128 + wc * 32 + 8 * fq;
#pragma unroll
        for (int ai = 0; ai < 2; ++ai)
#pragma unroll
            for (int m = 0; m < 4; ++m) { f32x4 o0, o1;
#pragma unroll
                for (int e = 0; e < 4; ++e) { o0[e] = fsilu(acc[ai][0][m][0][e]) * acc[ai][1][m][0][e]; o1[e] = fsilu(acc[ai][0][m][1][e]) * acc[ai][1][m][1][e]; }
                *(u32x4*)(ACT + (size_t)(row0 + ai * HALF + m * 16) * 2816 + col0) = pack8(o0, o1); }
    } };
struct EpiResid { static constexpr bool PERM = true, AFTER_DRAIN = false; const float* X; float* Z; const float* gate; float rc; int pad;
    __device__ __forceinline__ void operator()(const f32x4 (&acc)[2][2][4][2], const Unit& u, int wr, int wc, int fr, int fq) const {
        const int row0 = u.pm * BM + wr * 64 + fr;
#pragma unroll
        for (int ai = 0; ai < 2; ++ai) { if (u.pm == 64 && ai == 1) break;
#pragma unroll
            for (int m = 0; m < 4; ++m) { const int row = row0 + ai * HALF + m * 16; const int mr = row < 16384 ? (row >> 11) : (8 + row - 16384);
#pragma unroll
                for (int bj = 0; bj < 2; ++bj)
#pragma unroll
                    for (int n = 0; n < 2; ++n) { const int c = u.pn * BM + bj * HALF + wc * 32 + 8 * fq + 4 * n;
                        const f32x4 x = *(const f32x4*)(X + (size_t)row * 1024 + c), g = *(const f32x4*)(gate + (size_t)mr * 9216 + c);
                        *(f32x4*)(Z + (size_t)row * 1024 + c) = x * 1.41421356237309515f + (g + 1.0f) * rc * acc[ai][bj][m][n]; } } }
    } };
struct EpiInproj { static constexpr bool PERM = true, AFTER_DRAIN = false; bf16_t* P; float* GKL;
    __device__ __forceinline__ void operator()(const f32x4 (&acc)[2][2][4][2], const Unit& u, int wr, int wc, int fr, int fq) const {
        const int row0 = u.pm * BM + wr * 64 + fr;
#pragma unroll
        for (int ai = 0; ai < 2; ++ai)
#pragma unroll
            for (int m = 0; m < 4; ++m) { const int row = row0 + ai * HALF + m * 16;
#pragma unroll
                for (int bj = 0; bj < 2; ++bj) { const int c = u.pn * BM + bj * HALF + wc * 32 + 8 * fq;
                    *(u32x4*)(P + (size_t)row * 2304 + c) = pack8(acc[ai][bj][m][0], acc[ai][bj][m][1]);
                    if (c >= 1536 && c < 1552) { *(f32x4*)(GKL + (size_t)row * 16 + (c - 1536)) = acc[ai][bj][m][0]; *(f32x4*)(GKL + (size_t)row * 16 + (c - 1536) + 4) = acc[ai][bj][m][1]; } } }
    } };
struct EpiGlu { static constexpr bool PERM = true, AFTER_DRAIN = false; const bf16_t* Z5; bf16_t* O; const float* bg;
    __device__ __forceinline__ void operator()(const f32x4 (&acc)[2][2][4][2], const Unit& u, int wr, int wc, int fr, int fq) const {
        const int row0 = u.pm * BM + wr * 64 + fr;
#pragma unroll
        for (int ai = 0; ai < 2; ++ai)
#pragma unroll
            for (int m = 0; m < 4; ++m) { const int row = row0 + ai * HALF + m * 16;
#pragma unroll
                for (int bj = 0; bj < 2; ++bj) { const int c = u.pn * BM + bj * HALF + wc * 32 + 8 * fq;
                    const u32x4 zz = *(const u32x4*)(Z5 + (size_t)row * 512 + c); const f32x4 b0 = *(const f32x4*)(bg + c), b1 = *(const f32x4*)(bg + c + 4);
                    f32x4 o0, o1;
#pragma unroll
                    for (int e = 0; e < 4; ++e) { const unsigned w0 = zz[e >> 1], w1 = zz[2 + (e >> 1)];
                        const float z0 = __uint_as_float((e & 1) ? (w0 & 0xffff0000u) : (w0 << 16)), z1 = __uint_as_float((e & 1) ? (w1 & 0xffff0000u) : (w1 << 16));
                        o0[e] = z0 * fsigm(acc[ai][bj][m][0][e] + b0[e]); o1[e] = z1 * fsigm(acc[ai][bj][m][1][e] + b1[e]); }
                    *(u32x4*)(O + (size_t)row * 1024 + 512 + c) = pack8(o0, o1); } }
    } };
__device__ __forceinline__ float ftanh(float x) { const float e = __builtin_amdgcn_exp2f(-2.88539008178f * fabsf(x)); const float t = (1.0f - e) * __builtin_amdgcn_rcpf(1.0f + e); return x < 0.f ? -t : t; }
struct EpiRk { static constexpr bool PERM = true, AFTER_DRAIN = false; bf16_t* R; size_t rkv_stride; bf16_t* L1;
    __device__ __forceinline__ void operator()(const f32x4 (&acc)[2][2][4][2], const Unit& u, int wr, int wc, int fr, int fq) const {
        const int row0 = u.pm * BM + wr * 64 + fr;
#pragma unroll
        for (int ai = 0; ai < 2; ++ai)
#pragma unroll
            for (int m = 0; m < 4; ++m) { const int row = row0 + ai * HALF + m * 16;
#pragma unroll
                for (int bj = 0; bj < 2; ++bj) { const int c = u.pn * BM + bj * HALF + wc * 32 + 8 * fq;
                    if (c < 3072) { bf16_t* dst = R + (size_t)(c >> 10) * rkv_stride; *(u32x4*)(dst + (size_t)row * 1024 + (c & 1023)) = pack8(acc[ai][bj][m][0], acc[ai][bj][m][1]); }
                    else { const int cc = c - 3072; if (cc < 384) { f32x4 o0 = acc[ai][bj][m][0], o1 = acc[ai][bj][m][1];
                        if (cc < 64) {
#pragma unroll
                            for (int e = 0; e < 4; ++e) { o0[e] = ftanh(o0[e]); o1[e] = ftanh(o1[e]); } }
                        else if (cc >= 128 && cc < 288) {
#pragma unroll
                            for (int e = 0; e < 4; ++e) { o0[e] = fsigm(o0[e]); o1[e] = fsigm(o1[e]); } }
                        else if (cc >= 288) { o0 = (f32x4){0.f, 0.f, 0.f, 0.f}; o1 = o0; }
                        *(u32x4*)(L1 + (size_t)row * 384 + cc) = pack8(o0, o1); } } } }
    } };
struct EpiLora2 { static constexpr bool PERM = true, AFTER_DRAIN = false; float* WD; bf16_t* AS; bf16_t* G; const float* w0; const float* a0;
    __device__ __forceinline__ void operator()(const f32x4 (&acc)[2][2][4][2], const Unit& u, int wr, int wc, int fr, int fq) const {
        const int row0 = u.pm * BM + wr * 64 + fr;
#pragma unroll
        for (int ai = 0; ai < 2; ++ai)
#pragma unroll
            for (int m = 0; m < 4; ++m) { const int row = row0 + ai * HALF + m * 16;
#pragma unroll
                for (int bj = 0; bj < 2; ++bj) { const int c = u.pn * BM + bj * HALF + wc * 32 + 8 * fq;
                    if (c < 1024) {
#pragma unroll
                        for (int n = 0; n < 2; ++n) { const f32x4 wv = *(const f32x4*)(w0 + c + 4 * n); f32x4 o;
#pragma unroll
                            for (int e = 0; e < 4; ++e) { const float x = -(wv[e] + acc[ai][bj][m][n][e]); const float sp = fmaxf(x, 0.f) + 0.69314718056f * __builtin_amdgcn_logf(1.0f + __builtin_amdgcn_exp2f(-1.44269504089f * fabsf(x)));
                                const float ee = __builtin_amdgcn_exp2f(-1.44269504089f * (sp + 0.5f)); o[e] = __builtin_amdgcn_exp2f(-1.44269504089f * ee); }
                            *(f32x4*)(WD + (size_t)row * 1024 + c + 4 * n) = o; } }
                    else if (c < 2048) { const f32x4 a0v = *(const f32x4*)(a0 + c - 1024), a1v = *(const f32x4*)(a0 + c - 1024 + 4); f32x4 o0, o1;
#pragma unroll
                        for (int e = 0; e < 4; ++e) { o0[e] = fsigm(a0v[e] + acc[ai][bj][m][0][e]); o1[e] = fsigm(a1v[e] + acc[ai][bj][m][1][e]); }
                        *(u32x4*)(AS + (size_t)row * 1024 + c - 1024) = pack8(o0, o1); }
                    else *(u32x4*)(G + (size_t)row * 1024 + c - 2048) = pack8(acc[ai][bj][m][0], acc[ai][bj][m][1]); } }
    } };

template <class Epi, class Sched, bool ALIGN_EPI = false, bool SP2 = false>
__device__ __forceinline__ void gemm_phase(PG8_LAS unsigned char* lds, const Gemm g, const Sched& S, const Epi& E) {
    int tid_ = threadIdx.x; asm volatile("" : "+v"(tid_));
    const int tid = tid_, wid = __builtin_amdgcn_readfirstlane(tid >> 6), lane = tid & 63, wr = wid >> 2, wc = wid & 3, fr = lane & 15, fq = lane >> 4;
    int K_ = g.K; asm volatile("" : "+s"(K_));
    const int K = K_, nt = K / BK;
    unsigned voffA[2], voffB[2];
#pragma unroll
    for (int i = 0; i < 2; ++i) { int R, C; stage_rc(tid * 16 + i * 8192, R, C); const int Rb = Epi::PERM ? ((R & ~31) + perm32(R & 31)) : R;
        voffA[i] = (unsigned)(R * K + C) * 2u; voffB[i] = (unsigned)(Rb * K + C) * 2u; }
    const size_t kstep = (size_t)(BK * 2);
    const size_t hstep = (size_t)HALF * K * 2;
    const size_t tstep = 2 * hstep;
    const unsigned ldsw = (unsigned)wid * 1024u;
    const int aoff = lds_byte(wr * 64 + fr, fq * 8), boff = lds_byte(wc * 32 + fr, fq * 8);
#define PG8_SA(b, h) (((b) * 2 + (h)) * HTB)
#define PG8_SB(b, h) ((4 + (b) * 2 + (h)) * HTB)
#define PG8_STAGE(bufoff, gbase, voff) do { _Pragma("unroll") for (int _i = 0; _i < 2; ++_i) \
        __builtin_amdgcn_global_load_lds((const unsigned*)((const char*)(gbase) + (voff)[_i]), (PG8_LAS unsigned*)(lds + (bufoff) + ldsw + _i * 8192), 16, 0, 0); } while (0)
#define PG8_LDA(dst, b, h) do { _Pragma("unroll") for (int m = 0; m < 4; ++m) _Pragma("unroll") for (int k = 0; k < 2; ++k) dst[m][k] = *(const PG8_LAS bf16x8*)(lds + PG8_SA(b, h) + aoff + m * 2048 + k * 1024); } while (0)
#define PG8_LDB(dst, b, h) do { _Pragma("unroll") for (int n = 0; n < 2; ++n) _Pragma("unroll") for (int k = 0; k < 2; ++k) dst[n][k] = *(const PG8_LAS bf16x8*)(lds + PG8_SB(b, h) + boff + n * 2048 + k * 1024); } while (0)
#define PG8_MMA(ai, bj, At, Bt) do { __builtin_amdgcn_s_setprio(1); _Pragma("unroll") for (int m = 0; m < 4; ++m) _Pragma("unroll") for (int n = 0; n < 2; ++n) _Pragma("unroll") for (int k = 0; k < 2; ++k) \
        acc[ai][bj][m][n] = __builtin_amdgcn_mfma_f32_16x16x32_bf16(Bt[n][k], At[m][k], acc[ai][bj][m][n], 0, 0, 0); __builtin_amdgcn_s_setprio(0); } while (0)
#define PG8_WAIT_V(n) asm volatile("s_waitcnt vmcnt(" #n ")" ::: "memory")
#define PG8_WAIT_L(n) asm volatile("s_waitcnt lgkmcnt(" #n ")" ::: "memory")
#define PG8_BAR __builtin_amdgcn_s_barrier()
#define PG8_SCHED __builtin_amdgcn_sched_barrier(0)
    Unit cur, nxt; int ui = 0;
    if (!S.next(0, cur)) return;
    f32x4 acc[2][2][4][2];
#pragma unroll
    for (int a = 0; a < 2; ++a)
#pragma unroll
        for (int b = 0; b < 2; ++b)
#pragma unroll
            for (int m = 0; m < 4; ++m)
#pragma unroll
                for (int n = 0; n < 2; ++n) acc[a][b][m][n] = (f32x4){0.f, 0.f, 0.f, 0.f};
    bf16x8 At[4][2], B0[2][2], B1[2][2];
    const char* cA = (const char*)g.A + (size_t)cur.pm * tstep; const char* cB = (const char*)g.Bt + (size_t)cur.pn * tstep;
    S.a_ready(cur);
    if constexpr (SP2) {
        PG8_STAGE(PG8_SB(0, 0), cB, voffB); PG8_STAGE(PG8_SB(0, 1), cB + hstep, voffB); PG8_STAGE(PG8_SA(0, 0), cA, voffA); PG8_STAGE(PG8_SA(0, 1), cA + hstep, voffA);
        if (wr == 1) PG8_BAR;
        PG8_WAIT_V(2); PG8_BAR;
        PG8_STAGE(PG8_SB(1, 0), cB + kstep, voffB); PG8_STAGE(PG8_SA(1, 0), cA + kstep, voffA); PG8_STAGE(PG8_SB(1, 1), cB + hstep + kstep, voffB);
        PG8_WAIT_V(6); PG8_BAR;
    } else {
        PG8_STAGE(PG8_SB(0, 0), cB, voffB); PG8_STAGE(PG8_SA(0, 0), cA, voffA); PG8_STAGE(PG8_SB(0, 1), cB + hstep, voffB); PG8_STAGE(PG8_SA(0, 1), cA + hstep, voffA);
        if (wr == 1) PG8_BAR;
        PG8_WAIT_V(4); PG8_BAR;
        PG8_STAGE(PG8_SB(1, 0), cB + kstep, voffB); PG8_STAGE(PG8_SA(1, 0), cA + kstep, voffA); PG8_STAGE(PG8_SB(1, 1), cB + hstep + kstep, voffB);
        PG8_WAIT_V(6); PG8_BAR;
    }
    for (;;) {
        const bool has_next = S.next(ui + 1, nxt);
        const char* nA = has_next ? (const char*)g.A + (size_t)nxt.pm * tstep : cA; const char* nB = has_next ? (const char*)g.Bt + (size_t)nxt.pn * tstep : cB;
        for (int t = 0; t < nt; t += 2) {
            const bool last = (t == nt - 2);
            const char* a1 = cA + (size_t)(t + 1) * kstep;
            const char* a2 = last ? nA : cA + (size_t)(t + 2) * kstep; const char* b2 = last ? nB : cB + (size_t)(t + 2) * kstep;
            const char* a3 = a2 + kstep; const char* b3 = b2 + kstep;
            if (last && has_next) S.a_ready(nxt);
            if constexpr (SP2) {
            PG8_LDB(B0, 0, 0); PG8_LDB(B1, 0, 1); PG8_SCHED; PG8_LDA(At, 0, 0); PG8_STAGE(PG8_SA(1, 1), a1 + hstep, voffA);
            PG8_WAIT_V(8); PG8_WAIT_L(0); PG8_BAR; PG8_MMA(0, 0, At, B0); PG8_MMA(0, 1, At, B1); PG8_BAR; PG8_SCHED;
            PG8_LDA(At, 0, 1); PG8_STAGE(PG8_SB(0, 0), b2, voffB); PG8_STAGE(PG8_SB(0, 1), b2 + hstep, voffB); PG8_STAGE(PG8_SA(0, 0), a2, voffA);
            PG8_WAIT_V(8); PG8_WAIT_L(0); PG8_BAR; PG8_MMA(1, 0, At, B0); PG8_MMA(1, 1, At, B1); PG8_BAR; PG8_SCHED;
            PG8_LDB(B0, 1, 0); PG8_LDB(B1, 1, 1); PG8_SCHED; PG8_LDA(At, 1, 0); PG8_STAGE(PG8_SA(0, 1), a2 + hstep, voffA);
            PG8_WAIT_V(8); PG8_WAIT_L(0); PG8_BAR; PG8_MMA(0, 0, At, B0); PG8_MMA(0, 1, At, B1); PG8_BAR; PG8_SCHED;
            PG8_LDA(At, 1, 1); PG8_STAGE(PG8_SB(1, 0), b3, voffB); PG8_STAGE(PG8_SB(1, 1), b3 + hstep, voffB); PG8_STAGE(PG8_SA(1, 0), a3, voffA);
            PG8_WAIT_V(8); PG8_WAIT_L(0); PG8_BAR; PG8_MMA(1, 0, At, B0); PG8_MMA(1, 1, At, B1); PG8_BAR; PG8_SCHED;
            } else {
            PG8_LDB(B0, 0, 0); PG8_SCHED; PG8_LDA(At, 0, 0); PG8_STAGE(PG8_SA(1, 1), a1 + hstep, voffA);
            PG8_WAIT_L(8); PG8_BAR; PG8_WAIT_L(0); PG8_MMA(0, 0, At, B0); PG8_BAR; PG8_SCHED;
            PG8_LDB(B1, 0, 1); PG8_STAGE(PG8_SB(0, 0), b2, voffB);
            PG8_BAR; PG8_WAIT_L(0); PG8_MMA(0, 1, At, B1); PG8_BAR;
            PG8_LDA(At, 0, 1); PG8_STAGE(PG8_SA(0, 0), a2, voffA);
            PG8_BAR; PG8_WAIT_L(0); PG8_MMA(1, 0, At, B0); PG8_BAR; PG8_SCHED;
            PG8_STAGE(PG8_SB(0, 1), b2 + hstep, voffB);
            PG8_WAIT_V(6); PG8_BAR; PG8_MMA(1, 1, At, B1); PG8_BAR;
            PG8_LDB(B0, 1, 0); PG8_SCHED; PG8_LDA(At, 1, 0); PG8_STAGE(PG8_SA(0, 1), a2 + hstep, voffA);
            PG8_WAIT_L(8); PG8_BAR; PG8_WAIT_L(0); PG8_MMA(0, 0, At, B0); PG8_BAR; PG8_SCHED;
            PG8_LDB(B1, 1, 1); PG8_STAGE(PG8_SB(1, 0), b3, voffB);
            PG8_BAR; PG8_WAIT_L(0); PG8_MMA(0, 1, At, B1); PG8_BAR;
            PG8_LDA(At, 1, 1); PG8_STAGE(PG8_SA(1, 0), a3, voffA);
            PG8_BAR; PG8_WAIT_L(0); PG8_MMA(1, 0, At, B0); PG8_BAR; PG8_SCHED;
            PG8_STAGE(PG8_SB(1, 1), b3 + hstep, voffB);
            PG8_WAIT_V(6); PG8_BAR; PG8_MMA(1, 1, At, B1); PG8_BAR;
            }
        }
        if constexpr (ALIGN_EPI) { if (wr == 0) PG8_BAR; }
        if constexpr (!Epi::AFTER_DRAIN) { E(acc, cur, wr, wc, fr, fq); S.done(cur); }
        if (!has_next) break;
#pragma unroll
        for (int a = 0; a < 2; ++a)
#pragma unroll
            for (int b = 0; b < 2; ++b)
#pragma unroll
                for (int m = 0; m < 4; ++m)
#pragma unroll
                    for (int n = 0; n < 2; ++n) acc[a][b][m][n] = (f32x4){0.f, 0.f, 0.f, 0.f};
        cur = nxt; cA = nA; cB = nB; ++ui;
        if constexpr (ALIGN_EPI) { if (wr == 1) PG8_BAR; }
    }
    PG8_WAIT_V(0);
    if constexpr (!ALIGN_EPI) { if (wr == 0) PG8_BAR; }
    PG8_BAR;
    if constexpr (Epi::AFTER_DRAIN) { E.fused(acc, cur, wr, wc, fr, fq, lds, wid, lane); S.done(cur); }
#undef PG8_SA
#undef PG8_SB
#undef PG8_STAGE
#undef PG8_LDA
#undef PG8_LDB
#undef PG8_MMA
#undef PG8_WAIT_V
#undef PG8_WAIT_L
#undef PG8_BAR
#undef PG8_SCHED
}
}

constexpr int NWAVES = 8;
constexpr int RING_OFF = 0, RING_BYTES = 131072;
constexpr int LDSCTL_OFF = RING_BYTES, MISC_OFF = LDSCTL_OFF + 320;
constexpr int LDS_BYTES = 147456;

struct Args { const float* in[52]; float* out; unsigned char* ws; };

struct Frame {
    LAS unsigned char* lds; int tid, lane, wave, G, blk;
    const float* const* in; float* out; unsigned char* ws;
};
#define INP(i) (args.in[i])
#define INPD(i) ({ int i_ = (i); asm volatile("" : "+s"(i_)); args.in[i_]; })

template <class Src>
DEVI void cvt_item(const Src src, bf16* WT, int Kd, int nblk, LAS float* scr, int item, int lane) {
    const int kb = item / nblk, nb = item % nblk, k0 = 64 * kb, n0 = 32 * nb;
#pragma unroll 8
    for (int i = 0; i < 32; ++i) { const int kk = 2 * i + (lane >> 5); scr[kk * 33 + (lane & 31)] = src(k0 + kk, n0 + (lane & 31)); }
    LDS_WAIT(); asm volatile("" ::: "memory");
    const int c = lane & 7;
#pragma unroll
    for (int j = 0; j < 4; ++j) { const int n = (lane >> 3) + 8 * j; const LAS float* s = scr + (8 * c) * 33 + n;
        v4u o; o.x = pk2(s[0 * 33], s[1 * 33]); o.y = pk2(s[2 * 33], s[3 * 33]); o.z = pk2(s[4 * 33], s[5 * 33]); o.w = pk2(s[6 * 33], s[7 * 33]);
        *(GAS v4u*)(WT + (size_t)(n0 + n) * Kd + k0 + 8 * c) = o; }
    LDS_WAIT(); asm volatile("" ::: "memory");
}
struct SrcPlain { const float* W; int K, N, ld; DEVI float operator()(int k, int n) const { return (k < K && n < N) ? W[(size_t)k * ld + n] : 0.f; } };
struct SrcFold { const float* W; const float* mu; int ld; DEVI float operator()(int k, int n) const { const int kk = k & 1023; const float m = mu[kk]; return (k < 1024 ? m : (1.0f - m)) * W[(size_t)kk * ld + n]; } };
struct SrcBlk { const float* W; int k0, k1; DEVI float operator()(int k, int n) const { return (k >= k0 && k < k1) ? W[(size_t)(k - k0) * 1024 + n] : 0.f; } };
struct SrcZero { DEVI float operator()(int, int) const { return 0.f; } };

DEVI void sincos_d(double x, double& s, double& c) {
    const double n = rint(x * 0.63661977236758134308);
    double r = fma(-n, 1.57079632679489655800e+00, x); r = fma(-n, 6.12323399573676603587e-17, r);
    const double r2 = r * r;
    double sp = -7.6471637318198164759e-13; sp = fma(sp, r2, 1.6059043836821614599e-10); sp = fma(sp, r2, -2.5052108385441718775e-08); sp = fma(sp, r2, 2.7557319223985890653e-06);
    sp = fma(sp, r2, -1.9841269841269841270e-04); sp = fma(sp, r2, 8.3333333333333333333e-03); sp = fma(sp, r2, -1.6666666666666666667e-01); const double sr = fma(sp * r2, r, r);
    double cp = 4.7794773323873852974e-14; cp = fma(cp, r2, -1.1470745597729724714e-11); cp = fma(cp, r2, 2.0876756987868098979e-09); cp = fma(cp, r2, -2.7557319223985890653e-07);
    cp = fma(cp, r2, 2.4801587301587301587e-05); cp = fma(cp, r2, -1.3888888888888888889e-03); cp = fma(cp, r2, 4.1666666666666666667e-02); cp = fma(cp, r2, -0.5); const double cr = fma(cp, r2, 1.0);
    const int q = ((int)n) & 3;
    s = (q == 0) ? sr : (q == 1) ? cr : (q == 2) ? -sr : -cr;
    c = (q == 0) ? cr : (q == 1) ? -sr : (q == 2) ? -cr : sr;
}
DEVI void s5prep_one(int i, const float* a_re, const float* a_im, const float* log_step, const float* b_re, const float* b_im, float* sp) {
    const int g = i >> 6;
    const double dt = exp((double)log_step[g]), ar = a_re[i], ai = a_im[i];
    const double mag = exp(ar * dt); double s, c; sincos_d(ai * dt, s, c);
    const double abr = mag * c, abi = mag * s, den = ar * ar + ai * ai, nr = abr - 1.0;
    const double zr = (nr * ar + abi * ai) / den, zi = (abi * ar - nr * ai) / den;
    sp[i] = (float)abr; sp[2048 + i] = (float)abi;
    for (int cc = 0; cc < 16; ++cc) { const double br = b_re[i * 16 + cc], bi = b_im[i * 16 + cc];
        sp[4096 + i * 16 + cc] = (float)(zr * br - zi * bi); sp[4096 + 32768 + i * 16 + cc] = (float)(zr * bi + zi * br); }
}

DEVI void init_row(int row, int lane, const float* xp, const float* xs, const float* mods, float* X, bf16* H) {
    if (row >= MT) { for (int j = 0; j < 16; ++j) H[(size_t)row * D + j * 64 + lane] = 0; return; }
    const float* src = row < NP ? xp + (size_t)row * D : xs + (size_t)(row - NP) * D;
    const float* sh = modp(mods, 0, 0) + (size_t)mrow(row) * 9216; const float* sc = modp(mods, 0, 1) + (size_t)mrow(row) * 9216;
#pragma unroll
    for (int j = 0; j < 4; ++j) { const int c = j * 256 + lane * 4; const f32x4 v = *(const f32x4*)(src + c), a = *(const f32x4*)(sc + c), b = *(const f32x4*)(sh + c);
        *(f32x4*)(X + (size_t)row * D + c) = v; const f32x4 h = v * (a + 1.0f) + b;
        *(unsigned long long*)(H + (size_t)row * D + c) = (unsigned long long)pk2(h[0], h[1]) | ((unsigned long long)pk2(h[2], h[3]) << 32); }
}
DEVI void ln_row(int row, int lane, const float* Z, const float* g, const float* b, float* X, bf16* H, const float* sh, const float* sc) {
    const float* z = Z + (size_t)row * D; f32x4 v[4]; float s = 0.f;
#pragma unroll
    for (int j = 0; j < 4; ++j) { v[j] = *(const f32x4*)(z + j * 256 + lane * 4); s += (v[j][0] + v[j][1]) + (v[j][2] + v[j][3]); }
    const float mean = wave_sum(s) * (1.f / D); float q = 0.f;
#pragma unroll
    for (int j = 0; j < 4; ++j) { v[j] = v[j] - mean; q += (v[j][0] * v[j][0] + v[j][1] * v[j][1]) + (v[j][2] * v[j][2] + v[j][3] * v[j][3]); }
    const float rstd = rsqrtf(wave_sum(q) * (1.f / D) + 1e-5f);
    const int mr = mrow(row);
#pragma unroll
    for (int j = 0; j < 4; ++j) { const int c = j * 256 + lane * 4; const f32x4 x = v[j] * rstd * *(const f32x4*)(g + c) + *(const f32x4*)(b + c); *(f32x4*)(X + (size_t)row * D + c) = x;
        if (H) { const f32x4 h = x * (*(const f32x4*)(sc + (size_t)mr * 9216 + c) + 1.0f) + *(const f32x4*)(sh + (size_t)mr * 9216 + c);
            *(unsigned long long*)(H + (size_t)row * D + c) = (unsigned long long)pk2(h[0], h[1]) | ((unsigned long long)pk2(h[2], h[3]) << 32); } }
}
DEVI void shiftcat_row(int row, int lane, const float* X, const float* mods, const float* shift_in, bf16* A2, float* out) {
    if (row >= MT) { for (int j = 0; j < 32; ++j) A2[(size_t)row * KRK + j * 64 + lane] = 0; return; }
    const int mr = mrow(row); const float* sh = modp(mods, 1, 3) + (size_t)mr * 9216; const float* sc = modp(mods, 1, 4) + (size_t)mr * 9216;
    const bool prompt = row < NP; const int t = row & 2047;
    for (int j = 0; j < 16; ++j) { const int c = j * 64 + lane; const float h = X[(size_t)row * D + c] * (1.f + sc[c]) + sh[c];
        float pv; if (prompt) pv = t == 0 ? 0.f : X[(size_t)(row - 1) * D + c] * (1.f + sc[c]) + sh[c]; else pv = shift_in[(size_t)(row - NP) * D + c];
        A2[(size_t)row * KRK + c] = (bf16)f2bf(pv); A2[(size_t)row * KRK + 1024 + c] = (bf16)f2bf(h);
        if (prompt) { if (t == 2047) out[O_SHIFT_P + (size_t)(row >> 11) * D + c] = h; } else out[O_SHIFT_S + (size_t)(row - NP) * D + c] = h; }
}
DEVI void gla_post_one(int w, int lane, const float* OG, const bf16* P, const float* norm_g, bf16* O) {
    const int tok = w >> 2, h = w & 3;
    const float o0 = OG[(size_t)tok * 512 + h * 128 + lane], o1 = OG[(size_t)tok * 512 + h * 128 + 64 + lane];
    const float ms = wave_sum(o0 * o0 + o1 * o1) * (1.f / 128.f), r = rsqrtf(ms + 1e-5f);
    const float g0 = bf2f(P[(size_t)tok * NINP + 1024 + h * 128 + lane]), g1 = bf2f(P[(size_t)tok * NINP + 1024 + h * 128 + 64 + lane]);
    O[(size_t)tok * D + h * 128 + lane] = (bf16)f2bf(o0 * r * norm_g[lane] * siluf_(g0));
    O[(size_t)tok * D + h * 128 + 64 + lane] = (bf16)f2bf(o1 * r * norm_g[64 + lane] * siluf_(g1));
}

DEVI void gla_job(LAS float* scr, int lane, int b, int h, int half, const bf16* P, const float* GKL, const float* w_gk, const float* b_gk, int tok_base, int T, const float* s0, float* s_out, float* OG) {
    LAS float* sdec = scr; LAS float* sq = scr + 1024; LAS float* sk = scr + 2048;
    const int dv = half * 64 + lane;
    float S[64];
#pragma unroll
    for (int i = 0; i < 64; ++i) S[i] = s0 ? s0[(((size_t)b * 4 + h) * 64 + i) * 128 + dv] : 0.f;
    float wg[16];
#pragma unroll
    for (int r = 0; r < 16; ++r) wg[r] = w_gk[r * 256 + h * 64 + lane];
    const float bg = b_gk[h * 64 + lane];
    for (int t0 = 0; t0 < T; t0 += 16) { const int nt = (T - t0) < 16 ? (T - t0) : 16;
        for (int tt = 0; tt < nt; ++tt) { const size_t tok = (size_t)tok_base + (size_t)b * T + t0 + tt; float x = bg;
#pragma unroll
            for (int r = 0; r < 16; ++r) x += GKL[tok * 16 + r] * wg[r];
            const float ls = fminf(x, 0.f) - log1pf(__expf(-fabsf(x)));
            sdec[tt * 64 + lane] = __expf(ls * (1.f / 16.f)); sq[tt * 64 + lane] = bf2f(P[tok * NINP + h * 64 + lane]) * 0.125f; sk[tt * 64 + lane] = bf2f(P[tok * NINP + 256 + h * 64 + lane]); }
        LDS_WAIT(); asm volatile("" ::: "memory");
        for (int tt = 0; tt < nt; ++tt) { const size_t tok = (size_t)tok_base + (size_t)b * T + t0 + tt;
            const float v = bf2f(P[tok * NINP + 512 + h * 128 + dv]); float o = 0.f;
#pragma unroll
            for (int i = 0; i < 64; ++i) { S[i] = S[i] * sdec[tt * 64 + i] + sk[tt * 64 + i] * v; o += sq[tt * 64 + i] * S[i]; }
            OG[tok * 512 + h * 128 + dv] = o; }
        LDS_WAIT(); asm volatile("" ::: "memory");
    }
#pragma unroll
    for (int i = 0; i < 64; ++i) s_out[(((size_t)b * 4 + h) * 64 + i) * 128 + dv] = S[i];
}
DEVI void s5_job(LAS float* scr, int lane, int g, int b0, int nb, const bf16* P, const float* sp, const float* c_re, const float* c_im, const float* dd, int tok_base, int T,
                 const float* h0re, const float* h0im, float* ore, float* oim, bf16* Z5) {
    const int p = lane, c = p & 15, pq = p >> 4;
    const float abr = sp[g * 64 + p], abi = sp[2048 + g * 64 + p];
    float bbr[16], bbi[16], cr[16], ci[16];
#pragma unroll
    for (int i = 0; i < 16; ++i) { bbr[i] = sp[4096 + (g * 64 + p) * 16 + i]; bbi[i] = sp[4096 + 32768 + (g * 64 + p) * 16 + i];
        cr[i] = c_re[(g * 16 + c) * 64 + pq * 16 + i]; ci[i] = c_im[(g * 16 + c) * 64 + pq * 16 + i]; }
    const float dv = dd[g * 16 + c];
    for (int b = b0; b < b0 + nb; ++b) {
        float hr = h0re ? h0re[((size_t)b * 32 + g) * 64 + p] : 0.f, hi = h0im ? h0im[((size_t)b * 32 + g) * 64 + p] : 0.f;
        for (int t = 0; t < T; ++t) { const size_t tok = (size_t)tok_base + (size_t)b * T + t;
            const bf16* up = P + tok * NINP + 1552 + g * 16; float u[16];
#pragma unroll
            for (int i = 0; i < 16; ++i) u[i] = bf2f(up[i]);
            const float uc = bf2f(up[c]);
            float br = 0.f, bi = 0.f;
#pragma unroll
            for (int i = 0; i < 16; ++i) { br += u[i] * bbr[i]; bi += u[i] * bbi[i]; }
            const float nr = abr * hr - abi * hi + br, ni = abr * hi + abi * hr + bi; hr = nr; hi = ni;
            LAS float* hs = scr + (t & 1) * 128;
            hs[p] = hr; hs[64 + p] = hi;
            LDS_WAIT(); asm volatile("" ::: "memory");
            float y = 0.f;
#pragma unroll
            for (int i = 0; i < 16; ++i) y += cr[i] * hs[pq * 16 + i] - ci[i] * hs[64 + pq * 16 + i];
            y += __shfl_xor(y, 16); y += __shfl_xor(y, 32);
            if (p < 16) { y += dv * uc; Z5[tok * 512 + g * 16 + c] = (bf16)f2bf(gelu_tanh(y)); }
        }
        ore[((size_t)b * 32 + g) * 64 + p] = hr; oim[((size_t)b * 32 + g) * 64 + p] = hi;
        LDS_WAIT(); asm volatile("" ::: "memory");
    }
}
DEVI void wkv_job(LAS float* scr, int lane, int b, int h, const bf16* R, const bf16* Kb, const bf16* V, const float* WD, const bf16* AS, bf16* GO, const float* k_k, const float* k_a, const float* r_k, const float* lnx_g, const float* lnx_b,
                  int tok_base, int T, const float* s0, float* s_out) {
    LAS float* sw = scr; LAS float* skm = scr + 512; LAS float* sa_ = scr + 1024; LAS float* sb = scr + 1536; LAS float* sr = scr + 2048; LAS float* sbon = scr + 2560;
    const int i = lane, ch = h * 64 + i;
    float S[64];
#pragma unroll
    for (int j = 0; j < 64; ++j) S[j] = s0 ? s0[(((size_t)b * 16 + h) * 64 + i) * 64 + j] : 0.f;
    const float kkc = k_k[ch], kac = k_a[ch], rkc = r_k[ch], lg = lnx_g[ch], lb = lnx_b[ch];
    for (int t0 = 0; t0 < T; t0 += 8) { const int nt = (T - t0) < 8 ? (T - t0) : 8;
        for (int tt = 0; tt < nt; ++tt) { const size_t tok = (size_t)tok_base + (size_t)b * T + t0 + tt;
            const float k = bf2f(Kb[tok * D + ch]), r = bf2f(R[tok * D + ch]), a = bf2f(AS[tok * D + ch]), w = WD[tok * D + ch];
            float kk = k * kkc; const float nrm = sqrtf(wave_sum(kk * kk)); kk = kk / fmaxf(nrm, 1e-12f);
            const float km = k * (1.f + (a - 1.f) * kac);
            sw[tt * 64 + i] = w; skm[tt * 64 + i] = km; sa_[tt * 64 + i] = -kk; sb[tt * 64 + i] = kk * a; sr[tt * 64 + i] = r;
            const float bon = wave_sum(r * km * rkc); if (i == 0) sbon[tt] = bon; }
        LDS_WAIT(); asm volatile("" ::: "memory");
        for (int tt = 0; tt < nt; ++tt) { const size_t tok = (size_t)tok_base + (size_t)b * T + t0 + tt;
            const float v = bf2f(V[tok * D + ch]); float sa = 0.f;
#pragma unroll
            for (int j = 0; j < 64; ++j) sa += S[j] * sa_[tt * 64 + j];
            float y = 0.f;
#pragma unroll
            for (int j = 0; j < 64; ++j) { S[j] = S[j] * sw[tt * 64 + j] + sa * sb[tt * 64 + j] + v * skm[tt * 64 + j]; y += S[j] * sr[tt * 64 + j]; }
            const float mean = wave_sum(y) * (1.f / 64.f), dy = y - mean, var = wave_sum(dy * dy) * (1.f / 64.f);
            float yn = dy * rsqrtf(var + 64e-5f) * lg + lb; yn += sbon[tt] * v;
            const float gt = bf2f(GO[tok * D + ch]); GO[tok * D + ch] = (bf16)f2bf(yn * gt); }
        LDS_WAIT(); asm volatile("" ::: "memory");
    }
#pragma unroll
    for (int j = 0; j < 64; ++j) s_out[(((size_t)b * 16 + h) * 64 + i) * 64 + j] = S[j];
}

DEVI float dpp_add(float v, const int ctrl_sel) {
    int r;
    switch (ctrl_sel) {
    case 0: r = __builtin_amdgcn_update_dpp(0, __builtin_bit_cast(int, v), 0xB1, 0xF, 0xF, true); break;
    case 1: r = __builtin_amdgcn_update_dpp(0, __builtin_bit_cast(int, v), 0x4E, 0xF, 0xF, true); break;
    case 2: r = __builtin_amdgcn_update_dpp(0, __builtin_bit_cast(int, v), 0x141, 0xF, 0xF, true); break;
    default: r = __builtin_amdgcn_update_dpp(0, __builtin_bit_cast(int, v), 0x140, 0xF, 0xF, true); break;
    }
    return v + __builtin_bit_cast(float, r);
}
DEVI float red16(float v) { v = dpp_add(v, 0); v = dpp_add(v, 1); v = dpp_add(v, 2); v = dpp_add(v, 3); return v; }
constexpr int WK_TB = 32;
constexpr int WK_W = 0, WK_KM = 2048, WK_NA = 4096, WK_BB = 6144, WK_R = 8192, WK_V = 10240, WK_BON = 12288, WK_PB = 12320;
constexpr int WK_Y = 2 * WK_PB;
static_assert((WK_Y + 2048) * 4 <= RING_BYTES, "wkv lds");
struct WkvLoad { uint2 k, r, a, v, g; f32x4 w; };
DEVI void wkv_chain(LAS float* L, int tid, int b, int h, const bf16* R, const bf16* Kb, const bf16* V, const float* WD, const bf16* AS, bf16* GO,
                    const float* k_k, const float* k_a, const float* r_k, const float* lnx_g, const float* lnx_b, float* s_out) {
    const int rp = tid >> 4, jq = tid & 15, tt = tid >> 4;
    const int ch = h * 64 + 4 * jq;
    const f32x4 kkc = *(const f32x4*)(k_k + ch), kac = *(const f32x4*)(k_a + ch), rkc = *(const f32x4*)(r_k + ch), lg = *(const f32x4*)(lnx_g + ch), lb = *(const f32x4*)(lnx_b + ch);
    f32x4 S0 = {0.f, 0.f, 0.f, 0.f}, S1 = {0.f, 0.f, 0.f, 0.f};
    const size_t tokb = (size_t)b * TP;
    WkvLoad ld; uint2 gcur;
    auto bf4 = [](uint2 u) -> f32x4 { f32x4 o; o[0] = __uint_as_float(u.x << 16); o[1] = __uint_as_float(u.x & 0xffff0000u); o[2] = __uint_as_float(u.y << 16); o[3] = __uint_as_float(u.y & 0xffff0000u); return o; };
#define WK_ISSUE(blkidx) do { const size_t o_ = (tokb + (size_t)(blkidx) * WK_TB + tt) * D + ch; ld.k = *(const uint2*)(Kb + o_); ld.r = *(const uint2*)(R + o_); ld.a = *(const uint2*)(AS + o_); ld.v = *(const uint2*)(V + o_); \
        ld.g = *(const uint2*)(GO + o_); ld.w = *(const f32x4*)(WD + o_); } while (0)
#define WK_PREP(bufidx) do { LAS float* pb_ = L + (bufidx) * WK_PB; const f32x4 k4 = bf4(ld.k), r4 = bf4(ld.r), a4 = bf4(ld.a), v4 = bf4(ld.v); \
        f32x4 kk = k4 * kkc; float ss = red16((kk[0] * kk[0] + kk[1] * kk[1]) + (kk[2] * kk[2] + kk[3] * kk[3])); const float inv = 1.0f / fmaxf(sqrtf(ss), 1e-12f); kk = kk * inv; \
        const f32x4 km = k4 * ((a4 - 1.0f) * kac + 1.0f); const f32x4 pr = r4 * km * rkc; const float bon = red16((pr[0] + pr[1]) + (pr[2] + pr[3])); \
        *(LAS f32x4*)(pb_ + WK_W + tt * 64 + 4 * jq) = ld.w; *(LAS f32x4*)(pb_ + WK_KM + tt * 64 + 4 * jq) = km; *(LAS f32x4*)(pb_ + WK_NA + tt * 64 + 4 * jq) = -kk; \
        *(LAS f32x4*)(pb_ + WK_BB + tt * 64 + 4 * jq) = kk * a4; *(LAS f32x4*)(pb_ + WK_R + tt * 64 + 4 * jq) = r4; *(LAS f32x4*)(pb_ + WK_V + tt * 64 + 4 * jq) = v4; if (jq == 0) pb_[WK_BON + tt] = bon; } while (0)
    WK_ISSUE(0); WK_PREP(0); gcur = ld.g;
    LDS_WAIT(); __builtin_amdgcn_s_barrier(); asm volatile("" ::: "memory");
    constexpr int NB = TP / WK_TB;
    for (int n = 0; n < NB; ++n) {
        const int cur = n & 1; const LAS float* pb = L + cur * WK_PB;
        if (n + 1 < NB) WK_ISSUE(n + 1);
#pragma unroll 4
        for (int t = 0; t < WK_TB; ++t) {
            const f32x4 na = *(const LAS f32x4*)(pb + WK_NA + t * 64 + 4 * jq), w4 = *(const LAS f32x4*)(pb + WK_W + t * 64 + 4 * jq), bb = *(const LAS f32x4*)(pb + WK_BB + t * 64 + 4 * jq),
                        km = *(const LAS f32x4*)(pb + WK_KM + t * 64 + 4 * jq), r4 = *(const LAS f32x4*)(pb + WK_R + t * 64 + 4 * jq);
            const float v0 = pb[WK_V + t * 64 + 2 * rp], v1 = pb[WK_V + t * 64 + 2 * rp + 1];
            float sa0 = (S0[0] * na[0] + S0[1] * na[1]) + (S0[2] * na[2] + S0[3] * na[3]), sa1 = (S1[0] * na[0] + S1[1] * na[1]) + (S1[2] * na[2] + S1[3] * na[3]);
            sa0 = dpp_add(sa0, 0); sa1 = dpp_add(sa1, 0); sa0 = dpp_add(sa0, 1); sa1 = dpp_add(sa1, 1); sa0 = dpp_add(sa0, 2); sa1 = dpp_add(sa1, 2); sa0 = dpp_add(sa0, 3); sa1 = dpp_add(sa1, 3);
            S0 = S0 * w4 + (bb * sa0 + km * v0); S1 = S1 * w4 + (bb * sa1 + km * v1);
            float y0 = (S0[0] * r4[0] + S0[1] * r4[1]) + (S0[2] * r4[2] + S0[3] * r4[3]), y1 = (S1[0] * r4[0] + S1[1] * r4[1]) + (S1[2] * r4[2] + S1[3] * r4[3]);
            y0 = dpp_add(y0, 0); y1 = dpp_add(y1, 0); y0 = dpp_add(y0, 1); y1 = dpp_add(y1, 1); y0 = dpp_add(y0, 2); y1 = dpp_add(y1, 2); y0 = dpp_add(y0, 3); y1 = dpp_add(y1, 3);
            if (jq == 0) { L[WK_Y + t * 64 + 2 * rp] = y0; L[WK_Y + t * 64 + 2 * rp + 1] = y1; }
        }
        const uint2 gnext = ld.g;
        if (n + 1 < NB) WK_PREP(cur ^ 1);
        LDS_WAIT(); __builtin_amdgcn_s_barrier(); asm volatile("" ::: "memory");
        {
            const f32x4 y4 = *(const LAS f32x4*)(L + WK_Y + tt * 64 + 4 * jq), v4 = *(const LAS f32x4*)(pb + WK_V + tt * 64 + 4 * jq); const float bon = pb[WK_BON + tt];
            const float mean = red16((y4[0] + y4[1]) + (y4[2] + y4[3])) * (1.f / 64.f); const f32x4 dy = y4 - mean;
            const float var = red16((dy[0] * dy[0] + dy[1] * dy[1]) + (dy[2] * dy[2] + dy[3] * dy[3])) * (1.f / 64.f);
            const f32x4 yn = dy * rsqrtf(var + 64e-5f) * lg + lb + v4 * bon; const f32x4 o = yn * bf4(gcur);
            uint2 ov; ov.x = pk2(o[0], o[1]); ov.y = pk2(o[2], o[3]);
            *(uint2*)(GO + (tokb + (size_t)n * WK_TB + tt) * D + ch) = ov;
        }
        gcur = gnext;
        LDS_WAIT(); __builtin_amdgcn_s_barrier(); asm volatile("" ::: "memory");
    }
#undef WK_ISSUE
#undef WK_PREP
    float* so = s_out + (((size_t)b * 16 + h) * 64 + 2 * rp) * 64 + 4 * jq;
    *(f32x4*)so = S0; *(f32x4*)(so + 64) = S1;
}

__global__ void __launch_bounds__(NWAVES * 64, 2) mk_fwd(Args args) {
    extern __shared__ __attribute__((aligned(16))) unsigned char lds_raw[];
    LAS unsigned char* lds = (LAS unsigned char*)lds_raw;
    volatile LAS unsigned* MISC = (volatile LAS unsigned*)(lds + MISC_OFF);
    const int tid = threadIdx.x, lane = tid & 63, wave = __builtin_amdgcn_readfirstlane(tid >> 6), G = gridDim.x, blk = blockIdx.x;
#define LW() ({ unsigned char* p_ = args.ws; asm volatile("" : "+s"(p_)); p_; })
#define LO() ({ float* p_ = args.out; asm volatile("" : "+s"(p_)); p_; })
#define PTRS unsigned char* ws = LW(); float* out = LO(); float* MODS = (float*)(ws + WS_MODS); float* SP = (float*)(ws + WS_SP); bf16* H = (bf16*)(ws + WS_H); float* Z = (float*)(ws + WS_Z); bf16* ACT = (bf16*)(ws + WS_ACT); float* X = out; \
    (void)MODS; (void)SP; (void)H; (void)Z; (void)ACT; (void)X
    for (int u = tid; u < (LDS_BYTES - LDSCTL_OFF) / 4; u += NWAVES * 64) ((LAS unsigned*)(lds + LDSCTL_OFF))[u] = 0u;
    __syncthreads();
    { XcdBarrier b0_ = xcd_barrier_post((unsigned*)(LW() + WS_CTL) + CW_BAR, MISC + 8); (void)b0_; }
#define GRID_BAR() do { XcdBarrier b_; b_.bar = (unsigned*)(LW() + WS_CTL) + CW_BAR; b_.x = xb_xcc_id(); b_.st = MISC + 8; xcd_barrier(b_); } while (0)
    const int gw = blk * NWAVES + wave, NGW = G * NWAVES;
    const int gws = wave * G + blk;
    LAS float* wscr = (LAS float*)(lds + RING_OFF + wave * 16384);

    { PTRS;
        constexpr int I_UP = (D / 64) * (NUP / 32), I_DN = (FFP / 64) * (D / 32), I_IN = (D / 64) * (NINP / 32), I_GLU = (512 / 64) * (512 / 32), I_SQ = (D / 64) * (D / 32), I_RK = (KRK / 64) * (NRK / 32), I_L2 = (NL1 / 64) * (3072 / 32);
        constexpr int NITEMS = 4 * I_UP + 4 * I_DN + I_IN + I_GLU + 2 * I_SQ + I_RK + I_L2;
        for (int it = gw; it < NITEMS; it += NGW) {
            int r = it;
            if (r < 4 * I_UP) { const int q = r / I_UP, l = q >> 1, f = q & 1; r -= q * I_UP;
                const int kb = r / (NUP / 32), nb = r % (NUP / 32), pn = nb >> 3, half = (nb >> 2) & 1, c0 = pn * 128 + (nb & 3) * 32;
                bf16* dst = (bf16*)(ws + (l ? WS_WUP_L1 : WS_WUP_L0) + f * SZ_WUP) + (size_t)(nb * 32) * D;
                if (c0 >= FF) { SrcZero s; cvt_item(s, dst, D, 1, wscr, kb, lane); }
                else if (half) { SrcPlain s{INPD(f ? 17 : 14) + (size_t)l * D * FF + c0, D, FF - c0, FF}; cvt_item(s, dst, D, 1, wscr, kb, lane); }
                else { SrcPlain s{INPD(f ? 16 : 13) + (size_t)l * D * FF + c0, D, FF - c0, FF}; cvt_item(s, dst, D, 1, wscr, kb, lane); }
                continue; } r -= 4 * I_UP;
            if (r < 4 * I_DN) { const int q = r / I_DN, l = q >> 1, f = q & 1; r -= q * I_DN;
                SrcPlain s{INPD(f ? 18 : 15) + (size_t)l * FF * D, FF, D, D};
                cvt_item(s, (bf16*)(ws + (l ? WS_WDN_L1 : WS_WDN_L0) + f * SZ_WDN), FFP, D / 32, wscr, r, lane); continue; } r -= 4 * I_DN;
            if (r < I_IN) { SrcPlain s{INPD(19), D, NIN, NIN}; cvt_item(s, (bf16*)(ws + WS_WIN), D, NINP / 32, wscr, r, lane); continue; } r -= I_IN;
            if (r < I_GLU) { SrcPlain s{INPD(32), 512, 512, 512}; cvt_item(s, (bf16*)(ws + WS_WGLU), 512, 512 / 32, wscr, r, lane); continue; } r -= I_GLU;
            if (r < I_SQ) { SrcPlain s{INPD(20), D, D, D}; cvt_item(s, (bf16*)(ws + WS_WOUT), D, D / 32, wscr, r, lane); continue; } r -= I_SQ;
            if (r < I_SQ) { SrcPlain s{INPD(38), D, D, D}; cvt_item(s, (bf16*)(ws + WS_WO), D, D / 32, wscr, r, lane); continue; } r -= I_SQ;
            if (r < I_RK) { const int kb = r / (NRK / 32), nb = r % (NRK / 32), n0 = nb * 32; bf16* dst = (bf16*)(ws + WS_WRK) + (size_t)n0 * KRK;
                if (n0 < 1024) { SrcFold s{INPD(35) + n0, INPD(34) + 0 * 1024, 1024}; cvt_item(s, dst, KRK, 1, wscr, kb, lane); }
                else if (n0 < 2048) { SrcFold s{INPD(36) + (n0 - 1024), INPD(34) + 2 * 1024, 1024}; cvt_item(s, dst, KRK, 1, wscr, kb, lane); }
                else if (n0 < 3072) { SrcFold s{INPD(37) + (n0 - 2048), INPD(34) + 3 * 1024, 1024}; cvt_item(s, dst, KRK, 1, wscr, kb, lane); }
                else if (n0 < 3136) { SrcFold s{INPD(40) + (n0 - 3072), INPD(34) + 1 * 1024, 64}; cvt_item(s, dst, KRK, 1, wscr, kb, lane); }
                else if (n0 < 3200) { SrcFold s{INPD(43) + (n0 - 3136), INPD(34) + 4 * 1024, 64}; cvt_item(s, dst, KRK, 1, wscr, kb, lane); }
                else if (n0 < 3360) { SrcFold s{INPD(45) + (n0 - 3200), INPD(34) + 5 * 1024, 160}; cvt_item(s, dst, KRK, 1, wscr, kb, lane); }
                else { SrcZero s; cvt_item(s, dst, KRK, 1, wscr, kb, lane); }
                continue; } r -= I_RK;
            { const int kb = r / (3072 / 32), nb = r % (3072 / 32), n0 = nb * 32; bf16* dst = (bf16*)(ws + WS_WL2) + (size_t)n0 * NL1;
                if (n0 < 1024) { SrcBlk s{INPD(41) + n0, 0, 64}; cvt_item(s, dst, NL1, 1, wscr, kb, lane); }
                else if (n0 < 2048) { SrcBlk s{INPD(44) + (n0 - 1024), 64, 128}; cvt_item(s, dst, NL1, 1, wscr, kb, lane); }
                else { SrcBlk s{INPD(46) + (n0 - 2048), 128, 288}; cvt_item(s, dst, NL1, 1, wscr, kb, lane); } }
        }
        __syncthreads();
        {
            const int vb = tid >> 8, t8 = tid & 255; LAS float* sc = (LAS float*)(lds + vb * 32768);
            for (int j0 = blk * 2; j0 < 1224; j0 += G * 2) { const int j = j0 + vb; const bool act = j < 1224;
                const int l = j / 612, rem = j % 612, ry = rem / 36, nx = rem % 36, r0 = ry * 8, n = nx * 256 + t8;
                __syncthreads();
                if (act) for (int i = t8; i < 8 * 1024; i += 256) { const int r = r0 + (i >> 10), k = i & 1023; const float v = r < 8 ? INP(7)[r * 1024 + k] : INP(8)[(r - 8) * 1024 + k]; sc[i] = siluf_(v); }
                __syncthreads();
                if (act) { float acc[8];
#pragma unroll
                    for (int q = 0; q < 8; ++q) acc[q] = 0.f;
                    const float* w = INP(9) + (size_t)l * 1024 * 9216 + n;
                    for (int k = 0; k < 1024; k += 4) { const float w0 = w[(size_t)k * 9216], w1 = w[(size_t)(k + 1) * 9216], w2 = w[(size_t)(k + 2) * 9216], w3 = w[(size_t)(k + 3) * 9216];
#pragma unroll
                        for (int q = 0; q < 8; ++q) { const f32x4 s4 = *(const LAS f32x4*)(sc + q * 1024 + k); acc[q] += s4[0] * w0 + s4[1] * w1 + s4[2] * w2 + s4[3] * w3; } }
                    const float bb = INP(10)[l * 9216 + n];
#pragma unroll
                    for (int q = 0; q < 8; ++q) MODS[((size_t)l * NMODROW + r0 + q) * 9216 + n] = acc[q] + bb; }
            }
            __syncthreads();
        }
        if (blk == G - 1) for (int i = tid; i < 2048; i += NWAVES * 64) s5prep_one(i, INP(24), INP(25), INP(26), INP(27), INP(28), SP);
    }
    GRID_BAR();
    { PTRS; for (int row = gw; row < MTP; row += NGW) init_row(row, lane, INP(0), INP(1), MODS, X, H); }
    GRID_BAR();

#define GEMM_PHASE(EPI, Aptr, Bptr, NN, KK, ...) do { pg8::Gemm g_{(const pg8::bf16_t*)(Aptr), (const pg8::bf16_t*)(Bptr), MTP, NN, KK}; pg8::StaticOrder S_; S_.init(MTP, NN, G, blk); pg8::EPI E_{__VA_ARGS__}; \
        pg8::gemm_phase<pg8::EPI, pg8::StaticOrder, true, true>(lds + RING_OFF, g_, S_, E_); } while (0)
#define LN_PASS(l, idx, Hout, nsh, nsc) do { PTRS; for (int row = gw; row < MT; row += NGW) ln_row(row, lane, Z, INP(11) + ((l) * 3 + (idx)) * D, INP(12) + ((l) * 3 + (idx)) * D, X, Hout, nsh, nsc); } while (0)
#define FFN(l, f, which0, lnidx, HOUT, nshw, nscw) do { \
        { PTRS; GEMM_PHASE(EpiSwiglu, H, ws + ((l) ? WS_WUP_L1 : WS_WUP_L0) + (f) * SZ_WUP, NUP, D, (pg8::bf16_t*)ACT); } GRID_BAR(); \
        { PTRS; GEMM_PHASE(EpiResid, ACT, ws + ((l) ? WS_WDN_L1 : WS_WDN_L0) + (f) * SZ_WDN, D, FFP, X, Z, modp(MODS, l, (which0) + 2), 0.5f, 0); } GRID_BAR(); \
        LN_PASS(l, lnidx, HOUT, nshw, nscw); GRID_BAR(); } while (0)

    FFN(0, 0, 0, 0, H, modp(MODS, 0, 3), modp(MODS, 0, 4));
#define L0PTRS PTRS; bf16* P = (bf16*)(ws + WS_P); float* GKL = (float*)(ws + WS_GKL); float* OG = (float*)(ws + WS_OG); bf16* Z5 = (bf16*)(ws + WS_Z5); bf16* O = (bf16*)(ws + WS_O); (void)P; (void)GKL; (void)OG; (void)Z5; (void)O
    { L0PTRS; GEMM_PHASE(EpiInproj, H, ws + WS_WIN, NINP, D, (pg8::bf16_t*)P, GKL); } GRID_BAR();
    { L0PTRS;
        if (gws < 64) gla_job(wscr, lane, gws >> 3, (gws >> 1) & 3, gws & 1, P, GKL, INPD(21), INPD(22), 0, TP, nullptr, out + O_GLA_P, OG);
        else if (gws < 320) { const int j = gws - 64; s5_job(wscr, lane, j & 31, j >> 5, 1, P, SP, INPD(29), INPD(30), INPD(31), 0, TP, nullptr, nullptr, out + O_S5RE_P, out + O_S5IM_P, Z5); }
        else { for (int s = gws - 320; s < 1536; s += NGW - 320) {
                if (s < 1024) gla_job(wscr, lane, s >> 3, (s >> 1) & 3, s & 1, P, GKL, INPD(21), INPD(22), NP, 1, INPD(2), out + O_GLA_S, OG);
                else { const int j = s - 1024; s5_job(wscr, lane, j & 31, (j >> 5) * 8, 8, P, SP, INPD(29), INPD(30), INPD(31), NP, 1, INPD(3), INPD(4), out + O_S5RE_S, out + O_S5IM_S, Z5); } } }
    }
    GRID_BAR();
    { L0PTRS; for (int w = gw; w < MT * 4; w += NGW) gla_post_one(w, lane, OG, P, INP(23), O);
        GEMM_PHASE(EpiGlu, Z5, ws + WS_WGLU, 512, 512, (const pg8::bf16_t*)Z5, (pg8::bf16_t*)O, INP(33)); } GRID_BAR();
    { L0PTRS; GEMM_PHASE(EpiResid, O, ws + WS_WOUT, D, D, X, Z, modp(MODS, 0, 5), 1.0f, 0); } GRID_BAR();
    LN_PASS(0, 1, H, modp(MODS, 0, 6), modp(MODS, 0, 7)); GRID_BAR();
    FFN(0, 1, 6, 2, H, modp(MODS, 1, 0), modp(MODS, 1, 1));
    FFN(1, 0, 0, 0, (bf16*)nullptr, (const float*)nullptr, (const float*)nullptr);
#define L1PTRS PTRS; bf16* A2 = (bf16*)(ws + WS_A2); bf16* R = (bf16*)(ws + WS_R); bf16* Kb = (bf16*)(ws + WS_K); bf16* V = (bf16*)(ws + WS_V); bf16* L1 = (bf16*)(ws + WS_L1A); \
        float* WD = (float*)(ws + WS_WD); bf16* AS = (bf16*)(ws + WS_AS); bf16* Gt = (bf16*)(ws + WS_G); (void)A2; (void)R; (void)Kb; (void)V; (void)L1; (void)WD; (void)AS; (void)Gt
    { L1PTRS; for (int row = gw; row < MTP; row += NGW) shiftcat_row(row, lane, X, MODS, INP(5), A2, out); } GRID_BAR();
    { L1PTRS; GEMM_PHASE(EpiRk, A2, ws + WS_WRK, NRK, KRK, (pg8::bf16_t*)R, (size_t)MTP * D, (pg8::bf16_t*)L1); } GRID_BAR();
    { L1PTRS; GEMM_PHASE(EpiLora2, L1, ws + WS_WL2, 3072, NL1, WD, (pg8::bf16_t*)AS, (pg8::bf16_t*)Gt, INP(39), INP(42)); } GRID_BAR();
    { L1PTRS;
        if (blk < 128) wkv_chain((LAS float*)(lds + RING_OFF), tid, blk >> 4, blk & 15, R, Kb, V, WD, AS, Gt, INPD(47), INPD(48), INPD(49), INPD(50), INPD(51), out + O_WKV_P);
        else { const int sw = (blk - 128) * NWAVES + wave, nsw = (G - 128) * NWAVES;
            for (int s = sw; s < 2048; s += nsw) wkv_job(wscr, lane, s >> 4, s & 15, R, Kb, V, WD, AS, Gt, INPD(47), INPD(48), INPD(49), INPD(50), INPD(51), NP, 1, INPD(6), out + O_WKV_S); }
    }
    GRID_BAR();
    { L1PTRS; GEMM_PHASE(EpiResid, Gt, ws + WS_WO, D, D, X, Z, modp(MODS, 1, 5), 1.0f, 0); } GRID_BAR();
    LN_PASS(1, 1, H, modp(MODS, 1, 6), modp(MODS, 1, 7)); GRID_BAR();
    { PTRS; GEMM_PHASE(EpiSwiglu, H, ws + WS_WUP_L1 + SZ_WUP, NUP, D, (pg8::bf16_t*)ACT); } GRID_BAR();
    { PTRS; GEMM_PHASE(EpiResid, ACT, ws + WS_WDN_L1 + SZ_WDN, D, FFP, X, Z, modp(MODS, 1, 8), 0.5f, 0); } GRID_BAR();
    LN_PASS(1, 2, (bf16*)nullptr, (const float*)nullptr, (const float*)nullptr);
}

extern "C" void kernel_launch(void* const* d_in, const int* in_sizes, int n_in, void* d_out, int out_size, void* d_ws, size_t ws_size, hipStream_t stream) {
    static int grid = 0;
    if (grid == 0) {
        if (n_in != 52 || ws_size < WS_END) { fprintf(stderr, "kernel_launch: unexpected n_in %d or ws %zu\n", n_in, ws_size); grid = -1; return; }
        int dev = 0, cus = 0, per_cu = 0;
        if (hipGetDevice(&dev) != hipSuccess || hipDeviceGetAttribute(&cus, hipDeviceAttributeMultiprocessorCount, dev) != hipSuccess) { grid = -1; return; }
        if (hipFuncSetAttribute((const void*)mk_fwd, hipFuncAttributeMaxDynamicSharedMemorySize, LDS_BYTES) != hipSuccess) { fprintf(stderr, "hipFuncSetAttribute failed\n"); grid = -1; return; }
        if (hipOccupancyMaxActiveBlocksPerMultiprocessor(&per_cu, (const void*)mk_fwd, NWAVES * 64, LDS_BYTES) != hipSuccess || per_cu < 1) { fprintf(stderr, "occupancy query: %d\n", per_cu); per_cu = 1; }
        (void)hipGetLastError();
        grid = cus;
    }
    if (grid < 0) return;
    (void)hipMemsetAsync((char*)d_ws + WS_CTL, 0, CTL_ZERO_BYTES, stream);
    Args a{};
    for (int i = 0; i < 52; ++i) a.in[i] = (const float*)d_in[i];
    a.out = (float*)d_out; a.ws = (unsigned char*)d_ws;
    hipLaunchKernelGGL(mk_fwd, dim3(grid), dim3(NWAVES * 64), LDS_BYTES, stream, a);
}
```

```cpp
#include <hip/hip_runtime.h>
#include <cstdint>
#include <cstdio>

typedef unsigned short bf16;
typedef short bf16x8 __attribute__((ext_vector_type(8)));
typedef float f32x4 __attribute__((ext_vector_type(4)));
#define DEVI __device__ __forceinline__

constexpr int D = 1024, NP = 16384, NS = 128, MT = NP + NS, MTP = 16640, TP = 2048, BP = 8;
constexpr int FF = 2752, FFP = 2816, NUP = 2 * FFP;
constexpr int NIN = 2064, NINP = 2304;
constexpr int NRK = 3584, KRK = 2048, NL1 = 384;
constexpr int NMODROW = 136;
constexpr float ALPHA = 1.41421356237309515f;

constexpr size_t O_Y = 0, O_GLA_P = 16908288, O_S5RE_P = 17170432, O_S5IM_P = 17186816, O_SHIFT_P = 17203200, O_WKV_P = 17211392,
                 O_GLA_S = 17735680, O_S5RE_S = 21929984, O_S5IM_S = 22192128, O_SHIFT_S = 22454272, O_WKV_S = 22585344;

constexpr size_t MiB = 1u << 20;
constexpr size_t WS_CTL = 0, CTL_ZERO_BYTES = 1 * MiB;
constexpr size_t WS_MODS = 1 * MiB, WS_SP = 12 * MiB;
constexpr size_t WS_W = 13 * MiB;
constexpr size_t SZ_WUP = (size_t)NUP * D * 2;
constexpr size_t SZ_WDN = (size_t)D * FFP * 2;
constexpr size_t WS_L0 = WS_W;
constexpr size_t WS_WUP_L0 = WS_L0, WS_WDN_L0 = WS_L0 + 22 * MiB, WS_WIN = WS_L0 + 33 * MiB, WS_WGLU = WS_WIN + 4608 * 1024, WS_WOUT = WS_WGLU + 512 * 1024;
constexpr size_t WS_L1 = WS_L0 + 40 * MiB;
constexpr size_t WS_WUP_L1 = WS_L1, WS_WDN_L1 = WS_L1 + 22 * MiB, WS_WRK = WS_L1 + 33 * MiB, WS_WL2 = WS_WRK + 14 * MiB, WS_WO = WS_WL2 + 2304 * 1024;
static_assert(WS_WO + 2 * MiB <= 105 * MiB, "W region");
constexpr size_t WS_H = 105 * MiB, WS_Z = 138 * MiB, WS_ACT = 203 * MiB, WS_S2 = 293 * MiB, WS_END = 340 * MiB;
constexpr size_t WS_P = WS_ACT, WS_GKL = 277 * MiB, WS_OG = WS_S2, WS_Z5 = WS_Z, WS_O = WS_H;
constexpr size_t WS_UBUF = 155 * MiB, WS_HLOC = 179 * MiB, WS_HM = 326 * MiB, WS_TM = 330 * MiB;
constexpr size_t WS_A2 = WS_ACT, WS_K = WS_Z, WS_R = WS_Z - (size_t)MTP * D * 2, WS_V = WS_Z + (size_t)MTP * D * 2, WS_L1A = WS_L0, WS_WD = WS_ACT, WS_AS = 268 * MiB, WS_G = WS_AS + (size_t)MTP * D * 2;
static_assert(WS_G + (size_t)MTP * D * 2 <= WS_END, "ws");
constexpr int CW_TMO = 0, CW_BAR = 4096;

#define GAS __attribute__((address_space(1)))
#define LAS __attribute__((address_space(3)))
typedef unsigned short bf16;
typedef unsigned v4u __attribute__((ext_vector_type(4)));
typedef float f32x4 __attribute__((ext_vector_type(4)));
typedef short bf16x8 __attribute__((ext_vector_type(8)));
typedef GAS unsigned gu32;
typedef GAS unsigned long long gu64;
#define RLX_AGENT __ATOMIC_RELAXED, __HIP_MEMORY_SCOPE_AGENT
#define LDS_WAIT() asm volatile("s_waitcnt lgkmcnt(0)" ::: "memory")
#define VM_WAIT() asm volatile("s_waitcnt vmcnt(0)" ::: "memory")
__device__ __forceinline__ unsigned long long rt() { return __builtin_amdgcn_s_memrealtime(); }
__device__ __forceinline__ unsigned f2bf(float f) { unsigned u = __builtin_bit_cast(unsigned, f); return (u + 0x7fffu + ((u >> 16) & 1u)) >> 16; }
__device__ __forceinline__ unsigned pk2(float lo, float hi) { return f2bf(lo) | (f2bf(hi) << 16); }

#define XB_TMO      128
#define XB_XCNT(j)  (256  + 64 * (j))
#define XB_XSUB(j)  (1280 + 64 * (j))
#define XB_XGEN(j)  (2304 + 64 * (j))
#define XB_TOP      3328
#define XB_TOPGEN   3392
#define XCD_BAR_WORDS 3456
#define XB_SPIN_CAP (1u << 18)

__device__ __forceinline__ unsigned xb_ld(unsigned* p)              { return __hip_atomic_load(p, __ATOMIC_RELAXED, __HIP_MEMORY_SCOPE_AGENT); }
__device__ __forceinline__ unsigned xb_add(unsigned* p, unsigned v) { return __hip_atomic_fetch_add(p, v, __ATOMIC_RELAXED, __HIP_MEMORY_SCOPE_AGENT); }
__device__ __forceinline__ unsigned xb_xcc_id() { return (unsigned)__builtin_amdgcn_s_getreg((3 << 11) | 20) & 0xFu; }
#define XB_SPIN(cond, bar) do { unsigned _sp = 0; while (cond) { __builtin_amdgcn_s_sleep(1); \
    if ((++_sp & 255u) == 0u) { if (xb_ld(&(bar)[XB_TMO])) break; if (_sp > XB_SPIN_CAP) { atomicAdd(&(bar)[XB_TMO], 1u); break; } } } } while (0)

struct XcdBarrier {
    unsigned* bar; unsigned x;
    volatile LAS unsigned* st;
};

__device__ __forceinline__ XcdBarrier xcd_barrier_post(unsigned* bar, volatile LAS unsigned* st) {
    XcdBarrier b; b.bar = bar; b.x = xb_xcc_id(); b.st = st;
    if (threadIdx.x == 0) (void)xb_add(&bar[XB_XCNT(b.x)], 1u);
    return b;
}
__device__ __forceinline__ void xcd_barrier_complete(unsigned* bar, unsigned x, unsigned& nloc, unsigned& nx) {
    const unsigned G = gridDim.x * gridDim.y * gridDim.z;
    unsigned sum, cnt, mine, sp = 0u;
    for (;;) {
        sum = 0u; cnt = 0u; mine = 0u;
#pragma unroll
        for (unsigned j = 0; j < 16; ++j) { const unsigned c = xb_ld(&bar[XB_XCNT(j)]); sum += c; cnt += (c > 0u) ? 1u : 0u; mine = (j == x) ? c : mine; }
        if (sum == G) break;
        __builtin_amdgcn_s_sleep(1);
        if ((++sp & 255u) == 0u) { if (xb_ld(&bar[XB_TMO])) break; if (sp > XB_SPIN_CAP) { atomicAdd(&bar[XB_TMO], 1u); break; } }
    }
    nloc = mine > 0u ? mine : 1u; nx = cnt > 0u ? cnt : 1u;
}

__device__ __forceinline__ void xcd_barrier(const XcdBarrier& b) {
    asm volatile("s_waitcnt vmcnt(0)" ::: "memory");
    __syncthreads();
    if (threadIdx.x == 0) {
        unsigned* bar = b.bar;
        __builtin_amdgcn_s_waitcnt(0);
        unsigned nloc = b.st[0], nx = b.st[1];
        if (nloc == 0u) { xcd_barrier_complete(bar, b.x, nloc, nx); b.st[0] = nloc; b.st[1] = nx; }
        const unsigned old = xb_add(&bar[XB_XSUB(b.x)], 1u);
        const unsigned gen = old / nloc;
        if (old + 1u == (gen + 1u) * nloc) {
            __builtin_amdgcn_fence(__ATOMIC_RELEASE, "agent");
            asm volatile("s_waitcnt vmcnt(0)" ::: "memory");
            const unsigned og = xb_add(&bar[XB_TOP], 1u);
            const unsigned tg = og / nx;
            if (og + 1u == (tg + 1u) * nx) xb_add(&bar[XB_TOPGEN], 1u);
            else XB_SPIN(xb_ld(&bar[XB_TOPGEN]) == tg, bar);
            __builtin_amdgcn_fence(__ATOMIC_ACQUIRE, "agent");
            xb_add(&bar[XB_XGEN(b.x)], 1u);
            asm volatile("s_waitcnt vmcnt(0)" ::: "memory");
        } else {
            XB_SPIN(xb_ld(&bar[XB_XGEN(b.x)]) == gen, bar);
            __builtin_amdgcn_fence(__ATOMIC_ACQUIRE, "agent");
            asm volatile("s_waitcnt vmcnt(0)" ::: "memory");
        }
    }
    __syncthreads();
}

DEVI float bf2f(unsigned short h) { return __uint_as_float(((unsigned)h) << 16); }
DEVI int mrow(int i) { return i < NP ? (i >> 11) : (8 + i - NP); }
DEVI float sigmoidf_(float x) { return 1.0f / (1.0f + __expf(-x)); }
DEVI float siluf_(float x) { return x / (1.0f + __expf(-x)); }
DEVI float softplusf_(float x) { return fmaxf(x, 0.f) + log1pf(__expf(-fabsf(x))); }
DEVI float gelu_tanh(float x) { const float u = 0.7978845608028654f * (x + 0.044715f * x * x * x); return 0.5f * x * (1.0f + tanhf(u)); }
DEVI float wave_sum(float v) {
#pragma unroll
    for (int o = 1; o < 64; o <<= 1) v += __shfl_xor(v, o);
    return v;
}
__host__ __device__ __forceinline__ const float* modp(const float* mods, int l, int which) { return mods + (size_t)l * NMODROW * 9216 + which * 1024; }

namespace pg8 {
#define PG8_LAS __attribute__((address_space(3)))
typedef unsigned short bf16_t;
typedef short bf16x8 __attribute__((ext_vector_type(8)));
typedef float f32x4 __attribute__((ext_vector_type(4)));
typedef unsigned u32x4 __attribute__((ext_vector_type(4)));
constexpr int BM = 256, BK = 64, HALF = 128, HTB = HALF * BK * 2  , STAGE_BYTES = 8 * HTB, NXCD = 8, WGM = 8;

__host__ __device__ __forceinline__ int lds_byte(int r, int c) { const int st = (r >> 4) * 2 + (c >> 5), rr = r & 15, cc = c & 31, ob = rr * 64 + cc * 2; return st * 1024 + (ob ^ (((ob >> 9) & 1) << 5)); }
__host__ __device__ __forceinline__ void stage_rc(int b, int& R, int& C) { const int st = b / 1024, sb = b % 1024, swz = sb ^ (((sb >> 9) & 1) << 5); R = (st >> 1) * 16 + swz / 64; C = (st & 1) * 32 + (swz % 64) / 2; }
__host__ __device__ __forceinline__ int perm32(int rho) { const int n = rho >> 4, i = rho & 15; return 8 * (i >> 2) + 4 * n + (i & 3); }

struct Unit { int pm, pn; };
struct Gemm { const bf16_t* A; const bf16_t* Bt; int M, N, K; };
struct GemmX { const bf16_t* A; const bf16_t* Bt; int M, N, K, lda, ldb, gsh; };

struct StaticOrder {
    int nM, nN, nwg, G, c;
    __host__ __device__ void init(int M, int N, int G_, int c_) { nM = M / BM; nN = N / BM; nwg = nM * nN; G = G_; c = c_; }
    __host__ __device__ bool next(int i, Unit& u) const {
        const long L = (long)i * G + c; if (L >= nwg) return false;
        int wgid = (int)L; { const int q = nwg / NXCD, r = nwg % NXCD, xcd = wgid % NXCD, off = wgid / NXCD; wgid = (xcd < r ? xcd * (q + 1) : r * (q + 1) + (xcd - r) * q) + off; }
        const int nig = WGM * nN, gid = wgid / nig, fm = gid * WGM, gsz = (nM - fm) < WGM ? (nM - fm) : WGM;
        u.pm = fm + ((wgid % nig) % gsz); u.pn = (wgid % nig) / gsz; return true;
    }
    __device__ __forceinline__ void a_ready(const Unit&) const {}
    __device__ __forceinline__ void done(const Unit&) const {}
};


__device__ __forceinline__ unsigned cvt_pk_bf16(float lo, float hi) { unsigned r; asm volatile("v_cvt_pk_bf16_f32 %0, %1, %2" : "=v"(r) : "v"(lo), "v"(hi)); return r; }
__device__ __forceinline__ float fsilu(float x) { return x * __builtin_amdgcn_rcpf(1.0f + __builtin_amdgcn_exp2f(-1.44269504089f * x)); }
__device__ __forceinline__ float fsigm(float x) { return __builtin_amdgcn_rcpf(1.0f + __builtin_amdgcn_exp2f(-1.44269504089f * x)); }
__device__ __forceinline__ u32x4 pack8(const f32x4 a, const f32x4 b) { u32x4 w; w.x = cvt_pk_bf16(a[0], a[1]); w.y = cvt_pk_bf16(a[2], a[3]); w.z = cvt_pk_bf16(b[0], b[1]); w.w = cvt_pk_bf16(b[2], b[3]); return w; }
struct EpiSwiglu { static constexpr bool PERM = true, AFTER_DRAIN = false; bf16_t* ACT;
    __device__ __forceinline__ void operator()(const f32x4 (&acc)[2][2][4][2], const Unit& u, int wr, int wc, int fr, int fq) const {
        const int row0 = u.pm * BM + wr * 64 + fr, col0 = u.pn * 128 + wc * 32 + 8 * fq;
#pragma unroll
        for (int ai = 0; ai < 2; ++ai)
#pragma unroll
            for (int m = 0; m < 4; ++m) { f32x4 o0, o1;
#pragma unroll
                for (int e = 0; e < 4; ++e) { o0[e] = fsilu(acc[ai][0][m][0][e]) * acc[ai][1][m][0][e]; o1[e] = fsilu(acc[ai][0][m][1][e]) * acc[ai][1][m][1][e]; }
                *(u32x4*)(ACT + (size_t)(row0 + ai * HALF + m * 16) * 2816 + col0) = pack8(o0, o1); }
    } };
struct EpiResid { static constexpr bool PERM = true, AFTER_DRAIN = false; const float* X; float* Z; const float* gate; float rc; int pad;
    __device__ __forceinline__ void operator()(const f32x4 (&acc)[2][2][4][2], const Unit& u, int wr, int wc, int fr, int fq) const {
        const int row0 = u.pm * BM + wr * 64 + fr;
#pragma unroll
        for (int ai = 0; ai < 2; ++ai) { if (u.pm == 64 && ai == 1) break;
#pragma unroll
            for (int m = 0; m < 4; ++m) { const int row = row0 + ai * HALF + m * 16; const int mr = row < 16384 ? (row >> 11) : (8 + row - 16384);
#pragma unroll
                for (int bj = 0; bj < 2; ++bj)
#pragma unroll
                    for (int n = 0; n < 2; ++n) { const int c = u.pn * BM + bj * HALF + wc * 32 + 8 * fq + 4 * n;
                        const f32x4 x = *(const f32x4*)(X + (size_t)row * 1024 + c), g = *(const f32x4*)(gate + (size_t)mr * 9216 + c);
                        *(f32x4*)(Z + (size_t)row * 1024 + c) = x * 1.41421356237309515f + (g + 1.0f) * rc * acc[ai][bj][m][n]; } } }
    } };
struct EpiInproj { static constexpr bool PERM = true, AFTER_DRAIN = false; bf16_t* P; float* GKL; bf16_t* UB;
    __device__ __forceinline__ void operator()(const f32x4 (&acc)[2][2][4][2], const Unit& u, int wr, int wc, int fr, int fq) const {
        const int row0 = u.pm * BM + wr * 64 + fr;
#pragma unroll
        for (int ai = 0; ai < 2; ++ai)
#pragma unroll
            for (int m = 0; m < 4; ++m) { const int row = row0 + ai * HALF + m * 16;
#pragma unroll
                for (int bj = 0; bj < 2; ++bj) { const int c = u.pn * BM + bj * HALF + wc * 32 + 8 * fq;
                    const u32x4 pk = pack8(acc[ai][bj][m][0], acc[ai][bj][m][1]);
                    *(u32x4*)(P + (size_t)row * 2304 + c) = pk;
                    if (c >= 1552 && c < 2064 && row < 16384) { const int cu = c - 1552; *(u32x4*)(UB + ((size_t)((cu >> 4) * 1024 + (row >> 4))) * 384 + (row & 15) * 16 + (cu & 15)) = pk; }
                    if (c >= 1536 && c < 1552) { *(f32x4*)(GKL + (size_t)row * 16 + (c - 1536)) = acc[ai][bj][m][0]; *(f32x4*)(GKL + (size_t)row * 16 + (c - 1536) + 4) = acc[ai][bj][m][1]; } } }
    } };
struct EpiGlu { static constexpr bool PERM = true, AFTER_DRAIN = false; const bf16_t* Z5; bf16_t* O; const float* bg;
    __device__ __forceinline__ void operator()(const f32x4 (&acc)[2][2][4][2], const Unit& u, int wr, int wc, int fr, int fq) const {
        const int row0 = u.pm * BM + wr * 64 + fr;
#pragma unroll
        for (int ai = 0; ai < 2; ++ai)
#pragma unroll
            for (int m = 0; m < 4; ++m) { const int row = row0 + ai * HALF + m * 16;
#pragma unroll
                for (int bj = 0; bj < 2; ++bj) { const int c = u.pn * BM + bj * HALF + wc * 32 + 8 * fq;
                    const u32x4 zz = *(const u32x4*)(Z5 + (size_t)row * 512 + c); const f32x4 b0 = *(const f32x4*)(bg + c), b1 = *(const f32x4*)(bg + c + 4);
                    f32x4 o0, o1;
#pragma unroll
                    for (int e = 0; e < 4; ++e) { const unsigned w0 = zz[e >> 1], w1 = zz[2 + (e >> 1)];
                        const float z0 = __uint_as_float((e & 1) ? (w0 & 0xffff0000u) : (w0 << 16)), z1 = __uint_as_float((e & 1) ? (w1 & 0xffff0000u) : (w1 << 16));
                        o0[e] = z0 * fsigm(acc[ai][bj][m][0][e] + b0[e]); o1[e] = z1 * fsigm(acc[ai][bj][m][1][e] + b1[e]); }
                    *(u32x4*)(O + (size_t)row * 1024 + 512 + c) = pack8(o0, o1); } }
    } };
__device__ __forceinline__ float ftanh(float x) { const float e = __builtin_amdgcn_exp2f(-2.88539008178f * fabsf(x)); const float t = (1.0f - e) * __builtin_amdgcn_rcpf(1.0f + e); return x < 0.f ? -t : t; }
struct EpiRk { static constexpr bool PERM = true, AFTER_DRAIN = false; bf16_t* R; size_t rkv_stride; bf16_t* L1;
    __device__ __forceinline__ void operator()(const f32x4 (&acc)[2][2][4][2], const Unit& u, int wr, int wc, int fr, int fq) const {
        const int row0 = u.pm * BM + wr * 64 + fr;
#pragma unroll
        for (int ai = 0; ai < 2; ++ai)
#pragma unroll
            for (int m = 0; m < 4; ++m) { const int row = row0 + ai * HALF + m * 16;
#pragma unroll
                for (int bj = 0; bj < 2; ++bj) { const int c = u.pn * BM + bj * HALF + wc * 32 + 8 * fq;
                    if (c < 3072) { bf16_t* dst = R + (size_t)(c >> 10) * rkv_stride; *(u32x4*)(dst + (size_t)row * 1024 + (c & 1023)) = pack8(acc[ai][bj][m][0], acc[ai][bj][m][1]); }
                    else { const int cc = c - 3072; if (cc < 384) { f32x4 o0 = acc[ai][bj][m][0], o1 = acc[ai][bj][m][1];
                        if (cc < 64) {
#pragma unroll
                            for (int e = 0; e < 4; ++e) { o0[e] = ftanh(o0[e]); o1[e] = ftanh(o1[e]); } }
                        else if (cc >= 128 && cc < 288) {
#pragma unroll
                            for (int e = 0; e < 4; ++e) { o0[e] = fsigm(o0[e]); o1[e] = fsigm(o1[e]); } }
                        else if (cc >= 288) { o0 = (f32x4){0.f, 0.f, 0.f, 0.f}; o1 = o0; }
                        *(u32x4*)(L1 + (size_t)row * 384 + cc) = pack8(o0, o1); } } } }
    } };
struct EpiLora2 { static constexpr bool PERM = true, AFTER_DRAIN = false; float* WD; bf16_t* AS; bf16_t* G; const float* w0; const float* a0;
    __device__ __forceinline__ void operator()(const f32x4 (&acc)[2][2][4][2], const Unit& u, int wr, int wc, int fr, int fq) const {
        const int row0 = u.pm * BM + wr * 64 + fr;
#pragma unroll
        for (int ai = 0; ai < 2; ++ai)
#pragma unroll
            for (int m = 0; m < 4; ++m) { const int row = row0 + ai * HALF + m * 16;
#pragma unroll
                for (int bj = 0; bj < 2; ++bj) { const int c = u.pn * BM + bj * HALF + wc * 32 + 8 * fq;
                    if (c < 1024) {
#pragma unroll
                        for (int n = 0; n < 2; ++n) { const f32x4 wv = *(const f32x4*)(w0 + c + 4 * n); f32x4 o;
#pragma unroll
                            for (int e = 0; e < 4; ++e) { const float x = -(wv[e] + acc[ai][bj][m][n][e]); const float sp = fmaxf(x, 0.f) + 0.69314718056f * __builtin_amdgcn_logf(1.0f + __builtin_amdgcn_exp2f(-1.44269504089f * fabsf(x)));
                                const float ee = __builtin_amdgcn_exp2f(-1.44269504089f * (sp + 0.5f)); o[e] = __builtin_amdgcn_exp2f(-1.44269504089f * ee); }
                            *(f32x4*)(WD + (size_t)row * 1024 + c + 4 * n) = o; } }
                    else if (c < 2048) { const f32x4 a0v = *(const f32x4*)(a0 + c - 1024), a1v = *(const f32x4*)(a0 + c - 1024 + 4); f32x4 o0, o1;
#pragma unroll
                        for (int e = 0; e < 4; ++e) { o0[e] = fsigm(a0v[e] + acc[ai][bj][m][0][e]); o1[e] = fsigm(a1v[e] + acc[ai][bj][m][1][e]); }
                        *(u32x4*)(AS + (size_t)row * 1024 + c - 1024) = pack8(o0, o1); }
                    else *(u32x4*)(G + (size_t)row * 1024 + c - 2048) = pack8(acc[ai][bj][m][0], acc[ai][bj][m][1]); } }
    } };

struct EpiHloc { static constexpr bool PERM = true, AFTER_DRAIN = false; float* HL;
    __device__ __forceinline__ void operator()(const f32x4 (&acc)[2][2][4][2], const Unit& u, int wr, int wc, int fr, int fq) const {
        const int row0 = u.pm * BM + wr * 64 + fr, c = wc * 32 + 8 * fq;
#pragma unroll
        for (int ai = 0; ai < 2; ++ai)
#pragma unroll
            for (int m = 0; m < 4; ++m) { float* p = HL + (size_t)(row0 + ai * HALF + m * 16) * 128 + c; *(f32x4*)p = acc[ai][0][m][0]; *(f32x4*)(p + 4) = acc[ai][0][m][1]; }
    } };
__device__ __forceinline__ float fgelu(float x) { const float u2 = 1.5957691216057308f * (x + 0.044715f * x * x * x); return x * fsigm(u2); }
struct EpiS5Y { static constexpr bool PERM = true, AFTER_DRAIN = false; bf16_t* Z5;
    __device__ __forceinline__ void operator()(const f32x4 (&acc)[2][2][4][2], const Unit& u, int wr, int wc, int fr, int fq) const {
        const int row0 = u.pm * BM + wr * 64 + fr;
#pragma unroll
        for (int ai = 0; ai < 2; ++ai)
#pragma unroll
            for (int m = 0; m < 4; ++m) { const int row = row0 + ai * HALF + m * 16, g = row >> 10, chunk = row & 1023;
#pragma unroll
                for (int bj = 0; bj < 2; ++bj) { const int c = bj * HALF + wc * 32 + 8 * fq, t = c >> 4, co = c & 15; f32x4 o0, o1;
#pragma unroll
                    for (int e = 0; e < 4; ++e) { o0[e] = fgelu(acc[ai][bj][m][0][e]); o1[e] = fgelu(acc[ai][bj][m][1][e]); }
                    *(u32x4*)(Z5 + (size_t)(chunk * 16 + t) * 512 + g * 16 + co) = pack8(o0, o1); } }
    } };

template <class Epi, class Sched, bool ALIGN_EPI = false, bool SP2 = false>
__device__ __forceinline__ void gemm_phase(PG8_LAS unsigned char* lds, const GemmX g, const Sched& S, const Epi& E) {
    int tid_ = threadIdx.x; asm volatile("" : "+v"(tid_));
    const int tid = tid_, wid = __builtin_amdgcn_readfirstlane(tid >> 6), lane = tid & 63, wr = wid >> 2, wc = wid & 3, fr = lane & 15, fq = lane >> 4;
    int K_ = g.K; asm volatile("" : "+s"(K_));
    const int K = K_, nt = K / BK;
    int lda_ = g.lda, ldb_ = g.ldb; asm volatile("" : "+s"(lda_), "+s"(ldb_)); const int lda = lda_, ldb = ldb_, gsh = g.gsh, nNb = g.N / BM;
    unsigned voffA[2], voffB[2];
#pragma unroll
    for (int i = 0; i < 2; ++i) { int R, C; stage_rc(tid * 16 + i * 8192, R, C); const int Rb = Epi::PERM ? ((R & ~31) + perm32(R & 31)) : R;
        voffA[i] = (unsigned)(R * lda + C) * 2u; voffB[i] = (unsigned)(Rb * ldb + C) * 2u; }
    const size_t kstep = (size_t)(BK * 2);
    const size_t hstepA = (size_t)HALF * lda * 2, hstepB = (size_t)HALF * ldb * 2;
    const size_t tstepA = 2 * hstepA, tstepB = 2 * hstepB;
#define PG8_BTILE(u_) ((size_t)(gsh >= 0 ? ((u_).pm >> gsh) * nNb + (u_).pn : (u_).pn))
    const unsigned ldsw = (unsigned)wid * 1024u;
    const int aoff = lds_byte(wr * 64 + fr, fq * 8), boff = lds_byte(wc * 32 + fr, fq * 8);
#define PG8_SA(b, h) (((b) * 2 + (h)) * HTB)
#define PG8_SB(b, h) ((4 + (b) * 2 + (h)) * HTB)
#define PG8_STAGE(bufoff, gbase, voff) do { _Pragma("unroll") for (int _i = 0; _i < 2; ++_i) \
        __builtin_amdgcn_global_load_lds((const unsigned*)((const char*)(gbase) + (voff)[_i]), (PG8_LAS unsigned*)(lds + (bufoff) + ldsw + _i * 8192), 16, 0, 0); } while (0)
#define PG8_LDA(dst, b, h) do { _Pragma("unroll") for (int m = 0; m < 4; ++m) _Pragma("unroll") for (int k = 0; k < 2; ++k) dst[m][k] = *(const PG8_LAS bf16x8*)(lds + PG8_SA(b, h) + aoff + m * 2048 + k * 1024); } while (0)
#define PG8_LDB(dst, b, h) do { _Pragma("unroll") for (int n = 0; n < 2; ++n) _Pragma("unroll") for (int k = 0; k < 2; ++k) dst[n][k] = *(const PG8_LAS bf16x8*)(lds + PG8_SB(b, h) + boff + n * 2048 + k * 1024); } while (0)
#define PG8_MMA(ai, bj, At, Bt) do { __builtin_amdgcn_s_setprio(1); _Pragma("unroll") for (int m = 0; m < 4; ++m) _Pragma("unroll") for (int n = 0; n < 2; ++n) _Pragma("unroll") for (int k = 0; k < 2; ++k) \
        acc[ai][bj][m][n] = __builtin_amdgcn_mfma_f32_16x16x32_bf16(Bt[n][k], At[m][k], acc[ai][bj][m][n], 0, 0, 0); __builtin_amdgcn_s_setprio(0); } while (0)
#define PG8_WAIT_V(n) asm volatile("s_waitcnt vmcnt(" #n ")" ::: "memory")
#define PG8_WAIT_L(n) asm volatile("s_waitcnt lgkmcnt(" #n ")" ::: "memory")
#define PG8_BAR __builtin_amdgcn_s_barrier()
#define PG8_SCHED __builtin_amdgcn_sched_barrier(0)
    Unit cur, nxt; int ui = 0;
    if (!S.next(0, cur)) return;
    f32x4 acc[2][2][4][2];
#pragma unroll
    for (int a = 0; a < 2; ++a)
#pragma unroll
        for (int b = 0; b < 2; ++b)
#pragma unroll
            for (int m = 0; m < 4; ++m)
#pragma unroll
                for (int n = 0; n < 2; ++n) acc[a][b][m][n] = (f32x4){0.f, 0.f, 0.f, 0.f};
    bf16x8 At[4][2], B0[2][2], B1[2][2];
    const char* cA = (const char*)g.A + (size_t)cur.pm * tstepA; const char* cB = (const char*)g.Bt + PG8_BTILE(cur) * tstepB;
    S.a_ready(cur);
    if constexpr (SP2) {
        PG8_STAGE(PG8_SB(0, 0), cB, voffB); PG8_STAGE(PG8_SB(0, 1), cB + hstepB, voffB); PG8_STAGE(PG8_SA(0, 0), cA, voffA); PG8_STAGE(PG8_SA(0, 1), cA + hstepA, voffA);
        if (wr == 1) PG8_BAR;
        PG8_WAIT_V(2); PG8_BAR;
        PG8_STAGE(PG8_SB(1, 0), cB + kstep, voffB); PG8_STAGE(PG8_SA(1, 0), cA + kstep, voffA); PG8_STAGE(PG8_SB(1, 1), cB + hstepB + kstep, voffB);
        PG8_WAIT_V(6); PG8_BAR;
    } else {
        PG8_STAGE(PG8_SB(0, 0), cB, voffB); PG8_STAGE(PG8_SA(0, 0), cA, voffA); PG8_STAGE(PG8_SB(0, 1), cB + hstepB, voffB); PG8_STAGE(PG8_SA(0, 1), cA + hstepA, voffA);
        if (wr == 1) PG8_BAR;
        PG8_WAIT_V(4); PG8_BAR;
        PG8_STAGE(PG8_SB(1, 0), cB + kstep, voffB); PG8_STAGE(PG8_SA(1, 0), cA + kstep, voffA); PG8_STAGE(PG8_SB(1, 1), cB + hstepB + kstep, voffB);
        PG8_WAIT_V(6); PG8_BAR;
    }
    for (;;) {
        const bool has_next = S.next(ui + 1, nxt);
        const char* nA = has_next ? (const char*)g.A + (size_t)nxt.pm * tstepA : cA; const char* nB = has_next ? (const char*)g.Bt + PG8_BTILE(nxt) * tstepB : cB;
        for (int t = 0; t < nt; t += 2) {
            const bool last = (t == nt - 2);
            const char* a1 = cA + (size_t)(t + 1) * kstep;
            const char* a2 = last ? nA : cA + (size_t)(t + 2) * kstep; const char* b2 = last ? nB : cB + (size_t)(t + 2) * kstep;
            const char* a3 = a2 + kstep; const char* b3 = b2 + kstep;
            if (last && has_next) S.a_ready(nxt);
            if constexpr (SP2) {
            PG8_LDB(B0, 0, 0); PG8_LDB(B1, 0, 1); PG8_SCHED; PG8_LDA(At, 0, 0); PG8_STAGE(PG8_SA(1, 1), a1 + hstepA, voffA);
            PG8_WAIT_V(8); PG8_WAIT_L(0); PG8_BAR; PG8_MMA(0, 0, At, B0); PG8_MMA(0, 1, At, B1); PG8_BAR; PG8_SCHED;
            PG8_LDA(At, 0, 1); PG8_STAGE(PG8_SB(0, 0), b2, voffB); PG8_STAGE(PG8_SB(0, 1), b2 + hstepB, voffB); PG8_STAGE(PG8_SA(0, 0), a2, voffA);
            PG8_WAIT_V(8); PG8_WAIT_L(0); PG8_BAR; PG8_MMA(1, 0, At, B0); PG8_MMA(1, 1, At, B1); PG8_BAR; PG8_SCHED;
            PG8_LDB(B0, 1, 0); PG8_LDB(B1, 1, 1); PG8_SCHED; PG8_LDA(At, 1, 0); PG8_STAGE(PG8_SA(0, 1), a2 + hstepA, voffA);
            PG8_WAIT_V(8); PG8_WAIT_L(0); PG8_BAR; PG8_MMA(0, 0, At, B0); PG8_MMA(0, 1, At, B1); PG8_BAR; PG8_SCHED;
            PG8_LDA(At, 1, 1); PG8_STAGE(PG8_SB(1, 0), b3, voffB); PG8_STAGE(PG8_SB(1, 1), b3 + hstepB, voffB); PG8_STAGE(PG8_SA(1, 0), a3, voffA);
            PG8_WAIT_V(8); PG8_WAIT_L(0); PG8_BAR; PG8_MMA(1, 0, At, B0); PG8_MMA(1, 1, At, B1); PG8_BAR; PG8_SCHED;
            } else {
            PG8_LDB(B0, 0, 0); PG8_SCHED; PG8_LDA(At, 0, 0); PG8_STAGE(PG8_SA(1, 1), a1 + hstepA, voffA);
            PG8_WAIT_L(8); PG8_BAR; PG8_WAIT_L(0); PG8_MMA(0, 0, At, B0); PG8_BAR; PG8_SCHED;
            PG8_LDB(B1, 0, 1); PG8_STAGE(PG8_SB(0, 0), b2, voffB);
            PG8_BAR; PG8_WAIT_L(0); PG8_MMA(0, 1, At, B1); PG8_BAR;
            PG8_LDA(At, 0, 1); PG8_STAGE(PG8_SA(0, 0), a2, voffA);
            PG8_BAR; PG8_WAIT_L(0); PG8_MMA(1, 0, At, B0); PG8_BAR; PG8_SCHED;
            PG8_STAGE(PG8_SB(0, 1), b2 + hstepB, voffB);
            PG8_WAIT_V(6); PG8_BAR; PG8_MMA(1, 1, At, B1); PG8_BAR;
            PG8_LDB(B0, 1, 0); PG8_SCHED; PG8_LDA(At, 1, 0); PG8_STAGE(PG8_SA(0, 1), a2 + hstepA, voffA);
            PG8_WAIT_L(8); PG8_BAR; PG8_WAIT_L(0); PG8_MMA(0, 0, At, B0); PG8_BAR; PG8_SCHED;
            PG8_LDB(B1, 1, 1); PG8_STAGE(PG8_SB(1, 0), b3, voffB);
            PG8_BAR; PG8_WAIT_L(0); PG8_MMA(0, 1, At, B1); PG8_BAR;
            PG8_LDA(At, 1, 1); PG8_STAGE(PG8_SA(1, 0), a3, voffA);
            PG8_BAR; PG8_WAIT_L(0); PG8_MMA(1, 0, At, B0); PG8_BAR; PG8_SCHED;
            PG8_STAGE(PG8_SB(1, 1), b3 + hstepB, voffB);
            PG8_WAIT_V(6); PG8_BAR; PG8_MMA(1, 1, At, B1); PG8_BAR;
            }
        }
        if constexpr (ALIGN_EPI) { if (wr == 0) PG8_BAR; }
        if constexpr (!Epi::AFTER_DRAIN) { E(acc, cur, wr, wc, fr, fq); S.done(cur); }
        if (!has_next) break;
#pragma unroll
        for (int a = 0; a < 2; ++a)
#pragma unroll
            for (int b = 0; b < 2; ++b)
#pragma unroll
                for (int m = 0; m < 4; ++m)
#pragma unroll
                    for (int n = 0; n < 2; ++n) acc[a][b][m][n] = (f32x4){0.f, 0.f, 0.f, 0.f};
        cur = nxt; cA = nA; cB = nB; ++ui;
        if constexpr (ALIGN_EPI) { if (wr == 1) PG8_BAR; }
    }
    PG8_WAIT_V(0);
    if constexpr (!ALIGN_EPI) { if (wr == 0) PG8_BAR; }
    PG8_BAR;
    if constexpr (Epi::AFTER_DRAIN) { E.fused(acc, cur, wr, wc, fr, fq, lds, wid, lane); S.done(cur); }
#undef PG8_BTILE
#undef PG8_SA
#undef PG8_SB
#undef PG8_STAGE
#undef PG8_LDA
#undef PG8_LDB
#undef PG8_MMA
#undef PG8_WAIT_V
#undef PG8_WAIT_L
#undef PG8_BAR
#undef PG8_SCHED
}
}

constexpr int NWAVES = 8;
constexpr int RING_OFF = 0, RING_BYTES = 131072;
constexpr int LDSCTL_OFF = RING_BYTES, MISC_OFF = LDSCTL_OFF + 320;
constexpr int LDS_BYTES = 147456;

struct Args { const float* in[52]; float* out; unsigned char* ws; };

struct Frame {
    LAS unsigned char* lds; int tid, lane, wave, G, blk;
    const float* const* in; float* out; unsigned char* ws;
};
#define INP(i) (args.in[i])
#define INPD(i) ({ int i_ = (i); asm volatile("" : "+s"(i_)); args.in[i_]; })

template <class Src>
DEVI void cvt_item(const Src src, bf16* WT, int Kd, int nblk, LAS float* scr, int item, int lane) {
    const int kb = item / nblk, nb = item % nblk, k0 = 64 * kb, n0 = 32 * nb;
#pragma unroll 8
    for (int i = 0; i < 32; ++i) { const int kk = 2 * i + (lane >> 5); scr[kk * 33 + (lane & 31)] = src(k0 + kk, n0 + (lane & 31)); }
    LDS_WAIT(); asm volatile("" ::: "memory");
    const int c = lane & 7;
#pragma unroll
    for (int j = 0; j < 4; ++j) { const int n = (lane >> 3) + 8 * j; const LAS float* s = scr + (8 * c) * 33 + n;
        v4u o; o.x = pk2(s[0 * 33], s[1 * 33]); o.y = pk2(s[2 * 33], s[3 * 33]); o.z = pk2(s[4 * 33], s[5 * 33]); o.w = pk2(s[6 * 33], s[7 * 33]);
        *(GAS v4u*)(WT + (size_t)(n0 + n) * Kd + k0 + 8 * c) = o; }
    LDS_WAIT(); asm volatile("" ::: "memory");
}
struct SrcPlain { const float* W; int K, N, ld; DEVI float operator()(int k, int n) const { return (k < K && n < N) ? W[(size_t)k * ld + n] : 0.f; } };
struct SrcFold { const float* W; const float* mu; int ld; DEVI float operator()(int k, int n) const { const int kk = k & 1023; const float m = mu[kk]; return (k < 1024 ? m : (1.0f - m)) * W[(size_t)kk * ld + n]; } };
struct SrcBlk { const float* W; int k0, k1; DEVI float operator()(int k, int n) const { return (k >= k0 && k < k1) ? W[(size_t)(k - k0) * 1024 + n] : 0.f; } };
struct SrcZero { DEVI float operator()(int, int) const { return 0.f; } };

DEVI void sincos_d(double x, double& s, double& c) {
    const double n = rint(x * 0.63661977236758134308);
    double r = fma(-n, 1.57079632679489655800e+00, x); r = fma(-n, 6.12323399573676603587e-17, r);
    const double r2 = r * r;
    double sp = -7.6471637318198164759e-13; sp = fma(sp, r2, 1.6059043836821614599e-10); sp = fma(sp, r2, -2.5052108385441718775e-08); sp = fma(sp, r2, 2.7557319223985890653e-06);
    sp = fma(sp, r2, -1.9841269841269841270e-04); sp = fma(sp, r2, 8.3333333333333333333e-03); sp = fma(sp, r2, -1.6666666666666666667e-01); const double sr = fma(sp * r2, r, r);
    double cp = 4.7794773323873852974e-14; cp = fma(cp, r2, -1.1470745597729724714e-11); cp = fma(cp, r2, 2.0876756987868098979e-09); cp = fma(cp, r2, -2.7557319223985890653e-07);
    cp = fma(cp, r2, 2.4801587301587301587e-05); cp = fma(cp, r2, -1.3888888888888888889e-03); cp = fma(cp, r2, 4.1666666666666666667e-02); cp = fma(cp, r2, -0.5); const double cr = fma(cp, r2, 1.0);
    const int q = ((int)n) & 3;
    s = (q == 0) ? sr : (q == 1) ? cr : (q == 2) ? -sr : -cr;
    c = (q == 0) ? cr : (q == 1) ? -sr : (q == 2) ? -cr : sr;
}
DEVI void s5prep_one(int i, const float* a_re, const float* a_im, const float* log_step, const float* b_re, const float* b_im, float* sp) {
    const int g = i >> 6;
    const double dt = exp((double)log_step[g]), ar = a_re[i], ai = a_im[i];
    const double mag = exp(ar * dt); double s, c; sincos_d(ai * dt, s, c);
    const double abr = mag * c, abi = mag * s, den = ar * ar + ai * ai, nr = abr - 1.0;
    const double zr = (nr * ar + abi * ai) / den, zi = (abi * ar - nr * ai) / den;
    sp[i] = (float)abr; sp[2048 + i] = (float)abi;
    for (int cc = 0; cc < 16; ++cc) { const double br = b_re[i * 16 + cc], bi = b_im[i * 16 + cc];
        sp[4096 + i * 16 + cc] = (float)(zr * br - zi * bi); sp[4096 + 32768 + i * 16 + cc] = (float)(zr * bi + zi * br); }
}


constexpr int SP_PW = 4096 + 65536;
DEVI void s5prep_pw(int i, const float* a_re, const float* a_im, const float* log_step, float* sp) {
    const int g = i >> 6; const double dt = exp((double)log_step[g]), ar = a_re[i], ai = a_im[i];
    for (int tau = 0; tau <= 16; ++tau) { const double mag = exp(ar * dt * tau); double s, c; sincos_d(ai * dt * tau, s, c); sp[SP_PW + i * 34 + tau * 2] = (float)(mag * c); sp[SP_PW + i * 34 + tau * 2 + 1] = (float)(mag * s); }
}
DEVI void s5_tm_job(int g, int tau, int lane, const float* sp, const float* c_re, const float* c_im, const float* dd, bf16* TM) {
    bf16* tm = TM + (size_t)g * 256 * 384;
    if (tau <= 15) {
        const int co = lane >> 2, ci0 = (lane & 3) * 4; float kv[4] = {0.f, 0.f, 0.f, 0.f};
        for (int p = 0; p < 64; ++p) { const float pr = sp[SP_PW + (g * 64 + p) * 34 + tau * 2], pi = sp[SP_PW + (g * 64 + p) * 34 + tau * 2 + 1];
            const float cr = c_re[(g * 16 + co) * 64 + p], ci = c_im[(g * 16 + co) * 64 + p];
            const f32x4 br = *(const f32x4*)(sp + 4096 + (g * 64 + p) * 16 + ci0), bi = *(const f32x4*)(sp + 4096 + 32768 + (g * 64 + p) * 16 + ci0);
#pragma unroll
            for (int q = 0; q < 4; ++q) { const float wr = pr * br[q] - pi * bi[q], wi = pr * bi[q] + pi * br[q]; kv[q] += cr * wr - ci * wi; } }
        if (tau == 0) {
#pragma unroll
            for (int q = 0; q < 4; ++q) if (ci0 + q == co) kv[q] += dd[g * 16 + co]; }
        const unsigned long long pk = (unsigned long long)pk2(kv[0], kv[1]) | ((unsigned long long)pk2(kv[2], kv[3]) << 32);
        for (int t = tau; t < 16; ++t) *(unsigned long long*)(tm + (size_t)(t * 16 + co) * 384 + (t - tau) * 16 + ci0) = pk;
        if (tau >= 1) for (int t = 0; t + tau < 16; ++t) *(unsigned long long*)(tm + (size_t)(t * 16 + co) * 384 + (t + tau) * 16 + ci0) = 0ull;
    }
    if (tau >= 1) { const int t = tau - 1, p = lane; const float pr = sp[SP_PW + (g * 64 + p) * 34 + tau * 2], pi = sp[SP_PW + (g * 64 + p) * 34 + tau * 2 + 1];
        for (int co = 0; co < 16; ++co) { const float cr = c_re[(g * 16 + co) * 64 + p], ci = c_im[(g * 16 + co) * 64 + p];
            tm[(size_t)(t * 16 + co) * 384 + 256 + p] = (bf16)f2bf(cr * pr - ci * pi); tm[(size_t)(t * 16 + co) * 384 + 320 + p] = (bf16)f2bf(-(cr * pi + ci * pr)); } }
}
DEVI void s5_hm_job(int g, int s, int lane, const float* sp, bf16* HM) {
    const int p = lane; const float pr = sp[SP_PW + (g * 64 + p) * 34 + (15 - s) * 2], pi = sp[SP_PW + (g * 64 + p) * 34 + (15 - s) * 2 + 1];
    bf16* hr = HM + ((size_t)g * 256 + p) * 256 + s * 16; bf16* hi = hr + 64 * 256;
#pragma unroll
    for (int h8 = 0; h8 < 2; ++h8) { float wr[8], wi[8];
#pragma unroll
        for (int q = 0; q < 8; ++q) { const float br = sp[4096 + (g * 64 + p) * 16 + h8 * 8 + q], bi = sp[4096 + 32768 + (g * 64 + p) * 16 + h8 * 8 + q]; wr[q] = pr * br - pi * bi; wi[q] = pr * bi + pi * br; }
        v4u a, b; a.x = pk2(wr[0], wr[1]); a.y = pk2(wr[2], wr[3]); a.z = pk2(wr[4], wr[5]); a.w = pk2(wr[6], wr[7]); b.x = pk2(wi[0], wi[1]); b.y = pk2(wi[2], wi[3]); b.z = pk2(wi[4], wi[5]); b.w = pk2(wi[6], wi[7]);
        *(v4u*)(hr + h8 * 8) = a; *(v4u*)(hi + h8 * 8) = b; }
}
DEVI void s5_carry_job(int b, int g, int lane, const float* sp, const float* HL, bf16* UB, float* ore, float* oim) {
    const int p = lane; const float ar = sp[SP_PW + (g * 64 + p) * 34 + 32], ai = sp[SP_PW + (g * 64 + p) * 34 + 33];
    float cr = 0.f, ci = 0.f;
#pragma unroll 8
    for (int n = 0; n < 128; ++n) { const size_t row = (size_t)g * 1024 + b * 128 + n;
        UB[row * 384 + 256 + p] = (bf16)f2bf(cr); UB[row * 384 + 320 + p] = (bf16)f2bf(ci);
        const float hr = HL[row * 128 + p], hi = HL[row * 128 + 64 + p];
        const float nr = ar * cr - ai * ci + hr, ni = ar * ci + ai * cr + hi; cr = nr; ci = ni; }
    ore[((size_t)b * 32 + g) * 64 + p] = cr; oim[((size_t)b * 32 + g) * 64 + p] = ci;
}

DEVI void init_row(int row, int lane, const float* xp, const float* xs, const float* mods, float* X, bf16* H) {
    if (row >= MT) { for (int j = 0; j < 16; ++j) H[(size_t)row * D + j * 64 + lane] = 0; return; }
    const float* src = row < NP ? xp + (size_t)row * D : xs + (size_t)(row - NP) * D;
    const float* sh = modp(mods, 0, 0) + (size_t)mrow(row) * 9216; const float* sc = modp(mods, 0, 1) + (size_t)mrow(row) * 9216;
#pragma unroll
    for (int j = 0; j < 4; ++j) { const int c = j * 256 + lane * 4; const f32x4 v = *(const f32x4*)(src + c), a = *(const f32x4*)(sc + c), b = *(const f32x4*)(sh + c);
        *(f32x4*)(X + (size_t)row * D + c) = v; const f32x4 h = v * (a + 1.0f) + b;
        *(unsigned long long*)(H + (size_t)row * D + c) = (unsigned long long)pk2(h[0], h[1]) | ((unsigned long long)pk2(h[2], h[3]) << 32); }
}
DEVI void ln_row(int row, int lane, const float* Z, const float* g, const float* b, float* X, bf16* H, const float* sh, const float* sc) {
    const float* z = Z + (size_t)row * D; f32x4 v[4]; float s = 0.f;
#pragma unroll
    for (int j = 0; j < 4; ++j) { v[j] = *(const f32x4*)(z + j * 256 + lane * 4); s += (v[j][0] + v[j][1]) + (v[j][2] + v[j][3]); }
    const float mean = wave_sum(s) * (1.f / D); float q = 0.f;
#pragma unroll
    for (int j = 0; j < 4; ++j) { v[j] = v[j] - mean; q += (v[j][0] * v[j][0] + v[j][1] * v[j][1]) + (v[j][2] * v[j][2] + v[j][3] * v[j][3]); }
    const float rstd = rsqrtf(wave_sum(q) * (1.f / D) + 1e-5f);
    const int mr = mrow(row);
#pragma unroll
    for (int j = 0; j < 4; ++j) { const int c = j * 256 + lane * 4; const f32x4 x = v[j] * rstd * *(const f32x4*)(g + c) + *(const f32x4*)(b + c); *(f32x4*)(X + (size_t)row * D + c) = x;
        if (H) { const f32x4 h = x * (*(const f32x4*)(sc + (size_t)mr * 9216 + c) + 1.0f) + *(const f32x4*)(sh + (size_t)mr * 9216 + c);
            *(unsigned long long*)(H + (size_t)row * D + c) = (unsigned long long)pk2(h[0], h[1]) | ((unsigned long long)pk2(h[2], h[3]) << 32); } }
}
DEVI void shiftcat_row(int row, int lane, const float* X, const float* mods, const float* shift_in, bf16* A2, float* out) {
    if (row >= MT) { for (int j = 0; j < 32; ++j) A2[(size_t)row * KRK + j * 64 + lane] = 0; return; }
    const int mr = mrow(row); const float* sh = modp(mods, 1, 3) + (size_t)mr * 9216; const float* sc = modp(mods, 1, 4) + (size_t)mr * 9216;
    const bool prompt = row < NP; const int t = row & 2047;
    for (int j = 0; j < 16; ++j) { const int c = j * 64 + lane; const float h = X[(size_t)row * D + c] * (1.f + sc[c]) + sh[c];
        float pv; if (prompt) pv = t == 0 ? 0.f : X[(size_t)(row - 1) * D + c] * (1.f + sc[c]) + sh[c]; else pv = shift_in[(size_t)(row - NP) * D + c];
        A2[(size_t)row * KRK + c] = (bf16)f2bf(pv); A2[(size_t)row * KRK + 1024 + c] = (bf16)f2bf(h);
        if (prompt) { if (t == 2047) out[O_SHIFT_P + (size_t)(row >> 11) * D + c] = h; } else out[O_SHIFT_S + (size_t)(row - NP) * D + c] = h; }
}
DEVI void gla_post_one(int w, int lane, const float* OG, const bf16* P, const float* norm_g, bf16* O) {
    const int tok = w >> 2, h = w & 3;
    const float o0 = OG[(size_t)tok * 512 + h * 128 + lane], o1 = OG[(size_t)tok * 512 + h * 128 + 64 + lane];
    const float ms = wave_sum(o0 * o0 + o1 * o1) * (1.f / 128.f), r = rsqrtf(ms + 1e-5f);
    const float g0 = bf2f(P[(size_t)tok * NINP + 1024 + h * 128 + lane]), g1 = bf2f(P[(size_t)tok * NINP + 1024 + h * 128 + 64 + lane]);
    O[(size_t)tok * D + h * 128 + lane] = (bf16)f2bf(o0 * r * norm_g[lane] * siluf_(g0));
    O[(size_t)tok * D + h * 128 + 64 + lane] = (bf16)f2bf(o1 * r * norm_g[64 + lane] * siluf_(g1));
}

DEVI void gla_job(LAS float* scr, int lane, int b, int h, int half, const bf16* P, const float* GKL, const float* w_gk, const float* b_gk, int tok_base, int T, const float* s0, float* s_out, float* OG) {
    LAS float* sdec = scr; LAS float* sq = scr + 1024; LAS float* sk = scr + 2048;
    const int dv = half * 64 + lane;
    float S[64];
#pragma unroll
    for (int i = 0; i < 64; ++i) S[i] = s0 ? s0[(((size_t)b * 4 + h) * 64 + i) * 128 + dv] : 0.f;
    float wg[16];
#pragma unroll
    for (int r = 0; r < 16; ++r) wg[r] = w_gk[r * 256 + h * 64 + lane];
    const float bg = b_gk[h * 64 + lane];
    for (int t0 = 0; t0 < T; t0 += 16) { const int nt = (T - t0) < 16 ? (T - t0) : 16;
        for (int tt = 0; tt < nt; ++tt) { const size_t tok = (size_t)tok_base + (size_t)b * T + t0 + tt; float x = bg;
#pragma unroll
            for (int r = 0; r < 16; ++r) x += GKL[tok * 16 + r] * wg[r];
            const float ls = fminf(x, 0.f) - log1pf(__expf(-fabsf(x)));
            sdec[tt * 64 + lane] = __expf(ls * (1.f / 16.f)); sq[tt * 64 + lane] = bf2f(P[tok * NINP + h * 64 + lane]) * 0.125f; sk[tt * 64 + lane] = bf2f(P[tok * NINP + 256 + h * 64 + lane]); }
        LDS_WAIT(); asm volatile("" ::: "memory");
        for (int tt = 0; tt < nt; ++tt) { const size_t tok = (size_t)tok_base + (size_t)b * T + t0 + tt;
            const float v = bf2f(P[tok * NINP + 512 + h * 128 + dv]); float o = 0.f;
#pragma unroll
            for (int i = 0; i < 64; ++i) { S[i] = S[i] * sdec[tt * 64 + i] + sk[tt * 64 + i] * v; o += sq[tt * 64 + i] * S[i]; }
            OG[tok * 512 + h * 128 + dv] = o; }
        LDS_WAIT(); asm volatile("" ::: "memory");
    }
#pragma unroll
    for (int i = 0; i < 64; ++i) s_out[(((size_t)b * 4 + h) * 64 + i) * 128 + dv] = S[i];
}
DEVI void s5_job(LAS float* scr, int lane, int g, int b0, int nb, const bf16* P, const float* sp, const float* c_re, const float* c_im, const float* dd, int tok_base, int T,
                 const float* h0re, const float* h0im, float* ore, float* oim, bf16* Z5) {
    const int p = lane, c = p & 15, pq = p >> 4;
    const float abr = sp[g * 64 + p], abi = sp[2048 + g * 64 + p];
    float bbr[16], bbi[16], cr[16], ci[16];
#pragma unroll
    for (int i = 0; i < 16; ++i) { bbr[i] = sp[4096 + (g * 64 + p) * 16 + i]; bbi[i] = sp[4096 + 32768 + (g * 64 + p) * 16 + i];
        cr[i] = c_re[(g * 16 + c) * 64 + pq * 16 + i]; ci[i] = c_im[(g * 16 + c) * 64 + pq * 16 + i]; }
    const float dv = dd[g * 16 + c];
    for (int b = b0; b < b0 + nb; ++b) {
        float hr = h0re ? h0re[((size_t)b * 32 + g) * 64 + p] : 0.f, hi = h0im ? h0im[((size_t)b * 32 + g) * 64 + p] : 0.f;
        for (int t = 0; t < T; ++t) { const size_t tok = (size_t)tok_base + (size_t)b * T + t;
            const bf16* up = P + tok * NINP + 1552 + g * 16; float u[16];
#pragma unroll
            for (int i = 0; i < 16; ++i) u[i] = bf2f(up[i]);
            const float uc = bf2f(up[c]);
            float br = 0.f, bi = 0.f;
#pragma unroll
            for (int i = 0; i < 16; ++i) { br += u[i] * bbr[i]; bi += u[i] * bbi[i]; }
            const float nr = abr * hr - abi * hi + br, ni = abr * hi + abi * hr + bi; hr = nr; hi = ni;
            LAS float* hs = scr + (t & 1) * 128;
            hs[p] = hr; hs[64 + p] = hi;
            LDS_WAIT(); asm volatile("" ::: "memory");
            float y = 0.f;
#pragma unroll
            for (int i = 0; i < 16; ++i) y += cr[i] * hs[pq * 16 + i] - ci[i] * hs[64 + pq * 16 + i];
            y += __shfl_xor(y, 16); y += __shfl_xor(y, 32);
            if (p < 16) { y += dv * uc; Z5[tok * 512 + g * 16 + c] = (bf16)f2bf(gelu_tanh(y)); }
        }
        ore[((size_t)b * 32 + g) * 64 + p] = hr; oim[((size_t)b * 32 + g) * 64 + p] = hi;
        LDS_WAIT(); asm volatile("" ::: "memory");
    }
}
DEVI void wkv_job(LAS float* scr, int lane, int b, int h, const bf16* R, const bf16* Kb, const bf16* V, const float* WD, const bf16* AS, bf16* GO, const float* k_k, const float* k_a, const float* r_k, const float* lnx_g, const float* lnx_b,
                  int tok_base, int T, const float* s0, float* s_out) {
    LAS float* sw = scr; LAS float* skm = scr + 512; LAS float* sa_ = scr + 1024; LAS float* sb = scr + 1536; LAS float* sr = scr + 2048; LAS float* sbon = scr + 2560;
    const int i = lane, ch = h * 64 + i;
    float S[64];
#pragma unroll
    for (int j = 0; j < 64; ++j) S[j] = s0 ? s0[(((size_t)b * 16 + h) * 64 + i) * 64 + j] : 0.f;
    const float kkc = k_k[ch], kac = k_a[ch], rkc = r_k[ch], lg = lnx_g[ch], lb = lnx_b[ch];
    for (int t0 = 0; t0 < T; t0 += 8) { const int nt = (T - t0) < 8 ? (T - t0) : 8;
        for (int tt = 0; tt < nt; ++tt) { const size_t tok = (size_t)tok_base + (size_t)b * T + t0 + tt;
            const float k = bf2f(Kb[tok * D + ch]), r = bf2f(R[tok * D + ch]), a = bf2f(AS[tok * D + ch]), w = WD[tok * D + ch];
            float kk = k * kkc; const float nrm = sqrtf(wave_sum(kk * kk)); kk = kk / fmaxf(nrm, 1e-12f);
            const float km = k * (1.f + (a - 1.f) * kac);
            sw[tt * 64 + i] = w; skm[tt * 64 + i] = km; sa_[tt * 64 + i] = -kk; sb[tt * 64 + i] = kk * a; sr[tt * 64 + i] = r;
            const float bon = wave_sum(r * km * rkc); if (i == 0) sbon[tt] = bon; }
        LDS_WAIT(); asm volatile("" ::: "memory");
        for (int tt = 0; tt < nt; ++tt) { const size_t tok = (size_t)tok_base + (size_t)b * T + t0 + tt;
            const float v = bf2f(V[tok * D + ch]); float sa = 0.f;
#pragma unroll
            for (int j = 0; j < 64; ++j) sa += S[j] * sa_[tt * 64 + j];
            float y = 0.f;
#pragma unroll
            for (int j = 0; j < 64; ++j) { S[j] = S[j] * sw[tt * 64 + j] + sa * sb[tt * 64 + j] + v * skm[tt * 64 + j]; y += S[j] * sr[tt * 64 + j]; }
            const float mean = wave_sum(y) * (1.f / 64.f), dy = y - mean, var = wave_sum(dy * dy) * (1.f / 64.f);
            float yn = dy * rsqrtf(var + 64e-5f) * lg + lb; yn += sbon[tt] * v;
            const float gt = bf2f(GO[tok * D + ch]); GO[tok * D + ch] = (bf16)f2bf(yn * gt); }
        LDS_WAIT(); asm volatile("" ::: "memory");
    }
#pragma unroll
    for (int j = 0; j < 64; ++j) s_out[(((size_t)b * 16 + h) * 64 + i) * 64 + j] = S[j];
}

DEVI float dpp_add(float v, const int ctrl_sel) {
    int r;
    switch (ctrl_sel) {
    case 0: r = __builtin_amdgcn_update_dpp(0, __builtin_bit_cast(int, v), 0xB1, 0xF, 0xF, true); break;
    case 1: r = __builtin_amdgcn_update_dpp(0, __builtin_bit_cast(int, v), 0x4E, 0xF, 0xF, true); break;
    case 2: r = __builtin_amdgcn_update_dpp(0, __builtin_bit_cast(int, v), 0x141, 0xF, 0xF, true); break;
    default: r = __builtin_amdgcn_update_dpp(0, __builtin_bit_cast(int, v), 0x140, 0xF, 0xF, true); break;
    }
    return v + __builtin_bit_cast(float, r);
}
DEVI float red16(float v) { v = dpp_add(v, 0); v = dpp_add(v, 1); v = dpp_add(v, 2); v = dpp_add(v, 3); return v; }
constexpr int WK_TB = 32;
constexpr int WK_W = 0, WK_KM = 2048, WK_NA = 4096, WK_BB = 6144, WK_R = 8192, WK_V = 10240, WK_BON = 12288, WK_PB = 12320;
constexpr int WK_Y = 2 * WK_PB;
static_assert((WK_Y + 2048) * 4 <= RING_BYTES, "wkv lds");
struct WkvLoad { uint2 k, r, a, v, g; f32x4 w; };
DEVI void wkv_chain(LAS float* L, int tid, int b, int h, const bf16* R, const bf16* Kb, const bf16* V, const float* WD, const bf16* AS, bf16* GO,
                    const float* k_k, const float* k_a, const float* r_k, const float* lnx_g, const float* lnx_b, float* s_out) {
    const int rp = tid >> 4, jq = tid & 15, tt = tid >> 4;
    const int ch = h * 64 + 4 * jq;
    const f32x4 kkc = *(const f32x4*)(k_k + ch), kac = *(const f32x4*)(k_a + ch), rkc = *(const f32x4*)(r_k + ch), lg = *(const f32x4*)(lnx_g + ch), lb = *(const f32x4*)(lnx_b + ch);
    f32x4 S0 = {0.f, 0.f, 0.f, 0.f}, S1 = {0.f, 0.f, 0.f, 0.f};
    const size_t tokb = (size_t)b * TP;
    WkvLoad ld; uint2 gcur;
    auto bf4 = [](uint2 u) -> f32x4 { f32x4 o; o[0] = __uint_as_float(u.x << 16); o[1] = __uint_as_float(u.x & 0xffff0000u); o[2] = __uint_as_float(u.y << 16); o[3] = __uint_as_float(u.y & 0xffff0000u); return o; };
#define WK_ISSUE(blkidx) do { const size_t o_ = (tokb + (size_t)(blkidx) * WK_TB + tt) * D + ch; ld.k = *(const uint2*)(Kb + o_); ld.r = *(const uint2*)(R + o_); ld.a = *(const uint2*)(AS + o_); ld.v = *(const uint2*)(V + o_); \
        ld.g = *(const uint2*)(GO + o_); ld.w = *(const f32x4*)(WD + o_); } while (0)
#define WK_PREP(bufidx) do { LAS float* pb_ = L + (bufidx) * WK_PB; const f32x4 k4 = bf4(ld.k), r4 = bf4(ld.r), a4 = bf4(ld.a), v4 = bf4(ld.v); \
        f32x4 kk = k4 * kkc; float ss = red16((kk[0] * kk[0] + kk[1] * kk[1]) + (kk[2] * kk[2] + kk[3] * kk[3])); const float inv = 1.0f / fmaxf(sqrtf(ss), 1e-12f); kk = kk * inv; \
        const f32x4 km = k4 * ((a4 - 1.0f) * kac + 1.0f); const f32x4 pr = r4 * km * rkc; const float bon = red16((pr[0] + pr[1]) + (pr[2] + pr[3])); \
        *(LAS f32x4*)(pb_ + WK_W + tt * 64 + 4 * jq) = ld.w; *(LAS f32x4*)(pb_ + WK_KM + tt * 64 + 4 * jq) = km; *(LAS f32x4*)(pb_ + WK_NA + tt * 64 + 4 * jq) = -kk; \
        *(LAS f32x4*)(pb_ + WK_BB + tt * 64 + 4 * jq) = kk * a4; *(LAS f32x4*)(pb_ + WK_R + tt * 64 + 4 * jq) = r4; *(LAS f32x4*)(pb_ + WK_V + tt * 64 + 4 * jq) = v4; if (jq == 0) pb_[WK_BON + tt] = bon; } while (0)
    WK_ISSUE(0); WK_PREP(0); gcur = ld.g;
    LDS_WAIT(); __builtin_amdgcn_s_barrier(); asm volatile("" ::: "memory");
    constexpr int NB = TP / WK_TB;
    for (int n = 0; n < NB; ++n) {
        const int cur = n & 1; const LAS float* pb = L + cur * WK_PB;
        if (n + 1 < NB) WK_ISSUE(n + 1);
#pragma unroll 4
        for (int t = 0; t < WK_TB; ++t) {
            const f32x4 na = *(const LAS f32x4*)(pb + WK_NA + t * 64 + 4 * jq), w4 = *(const LAS f32x4*)(pb + WK_W + t * 64 + 4 * jq), bb = *(const LAS f32x4*)(pb + WK_BB + t * 64 + 4 * jq),
                        km = *(const LAS f32x4*)(pb + WK_KM + t * 64 + 4 * jq), r4 = *(const LAS f32x4*)(pb + WK_R + t * 64 + 4 * jq);
            const float v0 = pb[WK_V + t * 64 + 2 * rp], v1 = pb[WK_V + t * 64 + 2 * rp + 1];
            float sa0 = (S0[0] * na[0] + S0[1] * na[1]) + (S0[2] * na[2] + S0[3] * na[3]), sa1 = (S1[0] * na[0] + S1[1] * na[1]) + (S1[2] * na[2] + S1[3] * na[3]);
            sa0 = dpp_add(sa0, 0); sa1 = dpp_add(sa1, 0); sa0 = dpp_add(sa0, 1); sa1 = dpp_add(sa1, 1); sa0 = dpp_add(sa0, 2); sa1 = dpp_add(sa1, 2); sa0 = dpp_add(sa0, 3); sa1 = dpp_add(sa1, 3);
            S0 = S0 * w4 + (bb * sa0 + km * v0); S1 = S1 * w4 + (bb * sa1 + km * v1);
            float y0 = (S0[0] * r4[0] + S0[1] * r4[1]) + (S0[2] * r4[2] + S0[3] * r4[3]), y1 = (S1[0] * r4[0] + S1[1] * r4[1]) + (S1[2] * r4[2] + S1[3] * r4[3]);
            y0 = dpp_add(y0, 0); y1 = dpp_add(y1, 0); y0 = dpp_add(y0, 1); y1 = dpp_add(y1, 1); y0 = dpp_add(y0, 2); y1 = dpp_add(y1, 2); y0 = dpp_add(y0, 3); y1 = dpp_add(y1, 3);
            if (jq == 0) { L[WK_Y + t * 64 + 2 * rp] = y0; L[WK_Y + t * 64 + 2 * rp + 1] = y1; }
        }
        const uint2 gnext = ld.g;
        if (n + 1 < NB) WK_PREP(cur ^ 1);
        LDS_WAIT(); __builtin_amdgcn_s_barrier(); asm volatile("" ::: "memory");
        {
            const f32x4 y4 = *(const LAS f32x4*)(L + WK_Y + tt * 64 + 4 * jq), v4 = *(const LAS f32x4*)(pb + WK_V + tt * 64 + 4 * jq); const float bon = pb[WK_BON + tt];
            const float mean = red16((y4[0] + y4[1]) + (y4[2] + y4[3])) * (1.f / 64.f); const f32x4 dy = y4 - mean;
            const float var = red16((dy[0] * dy[0] + dy[1] * dy[1]) + (dy[2] * dy[2] + dy[3] * dy[3])) * (1.f / 64.f);
            const f32x4 yn = dy * rsqrtf(var + 64e-5f) * lg + lb + v4 * bon; const f32x4 o = yn * bf4(gcur);
            uint2 ov; ov.x = pk2(o[0], o[1]); ov.y = pk2(o[2], o[3]);
            *(uint2*)(GO + (tokb + (size_t)n * WK_TB + tt) * D + ch) = ov;
        }
        gcur = gnext;
        LDS_WAIT(); __builtin_amdgcn_s_barrier(); asm volatile("" ::: "memory");
    }
#undef WK_ISSUE
#undef WK_PREP
    float* so = s_out + (((size_t)b * 16 + h) * 64 + 2 * rp) * 64 + 4 * jq;
    *(f32x4*)so = S0; *(f32x4*)(so + 64) = S1;
}

__global__ void __launch_bounds__(NWAVES * 64, 2) mk_fwd(Args args) {
    extern __shared__ __attribute__((aligned(16))) unsigned char lds_raw[];
    LAS unsigned char* lds = (LAS unsigned char*)lds_raw;
    volatile LAS unsigned* MISC = (volatile LAS unsigned*)(lds + MISC_OFF);
    const int tid = threadIdx.x, lane = tid & 63, wave = __builtin_amdgcn_readfirstlane(tid >> 6), G = gridDim.x, blk = blockIdx.x;
#define LW() ({ unsigned char* p_ = args.ws; asm volatile("" : "+s"(p_)); p_; })
#define LO() ({ float* p_ = args.out; asm volatile("" : "+s"(p_)); p_; })
#define PTRS unsigned char* ws = LW(); float* out = LO(); float* MODS = (float*)(ws + WS_MODS); float* SP = (float*)(ws + WS_SP); bf16* H = (bf16*)(ws + WS_H); float* Z = (float*)(ws + WS_Z); bf16* ACT = (bf16*)(ws + WS_ACT); float* X = out; \
    (void)MODS; (void)SP; (void)H; (void)Z; (void)ACT; (void)X
    for (int u = tid; u < (LDS_BYTES - LDSCTL_OFF) / 4; u += NWAVES * 64) ((LAS unsigned*)(lds + LDSCTL_OFF))[u] = 0u;
    __syncthreads();
    { XcdBarrier b0_ = xcd_barrier_post((unsigned*)(LW() + WS_CTL) + CW_BAR, MISC + 8); (void)b0_; }
#define GRID_BAR() do { XcdBarrier b_; b_.bar = (unsigned*)(LW() + WS_CTL) + CW_BAR; b_.x = xb_xcc_id(); b_.st = MISC + 8; xcd_barrier(b_); } while (0)
    const int gw = blk * NWAVES + wave, NGW = G * NWAVES;
    const int gws = wave * G + blk;
    LAS float* wscr = (LAS float*)(lds + RING_OFF + wave * 16384);

    { PTRS;
        constexpr int I_UP = (D / 64) * (NUP / 32), I_DN = (FFP / 64) * (D / 32), I_IN = (D / 64) * (NINP / 32), I_GLU = (512 / 64) * (512 / 32), I_SQ = (D / 64) * (D / 32), I_RK = (KRK / 64) * (NRK / 32), I_L2 = (NL1 / 64) * (3072 / 32);
        constexpr int NITEMS = 4 * I_UP + 4 * I_DN + I_IN + I_GLU + 2 * I_SQ + I_RK + I_L2;
        for (int it = gw; it < NITEMS; it += NGW) {
            int r = it;
            if (r < 4 * I_UP) { const int q = r / I_UP, l = q >> 1, f = q & 1; r -= q * I_UP;
                const int kb = r / (NUP / 32), nb = r % (NUP / 32), pn = nb >> 3, half = (nb >> 2) & 1, c0 = pn * 128 + (nb & 3) * 32;
                bf16* dst = (bf16*)(ws + (l ? WS_WUP_L1 : WS_WUP_L0) + f * SZ_WUP) + (size_t)(nb * 32) * D;
                if (c0 >= FF) { SrcZero s; cvt_item(s, dst, D, 1, wscr, kb, lane); }
                else if (half) { SrcPlain s{INPD(f ? 17 : 14) + (size_t)l * D * FF + c0, D, FF - c0, FF}; cvt_item(s, dst, D, 1, wscr, kb, lane); }
                else { SrcPlain s{INPD(f ? 16 : 13) + (size_t)l * D * FF + c0, D, FF - c0, FF}; cvt_item(s, dst, D, 1, wscr, kb, lane); }
                continue; } r -= 4 * I_UP;
            if (r < 4 * I_DN) { const int q = r / I_DN, l = q >> 1, f = q & 1; r -= q * I_DN;
                SrcPlain s{INPD(f ? 18 : 15) + (size_t)l * FF * D, FF, D, D};
                cvt_item(s, (bf16*)(ws + (l ? WS_WDN_L1 : WS_WDN_L0) + f * SZ_WDN), FFP, D / 32, wscr, r, lane); continue; } r -= 4 * I_DN;
            if (r < I_IN) { SrcPlain s{INPD(19), D, NIN, NIN}; cvt_item(s, (bf16*)(ws + WS_WIN), D, NINP / 32, wscr, r, lane); continue; } r -= I_IN;
            if (r < I_GLU) { SrcPlain s{INPD(32), 512, 512, 512}; cvt_item(s, (bf16*)(ws + WS_WGLU), 512, 512 / 32, wscr, r, lane); continue; } r -= I_GLU;
            if (r < I_SQ) { SrcPlain s{INPD(20), D, D, D}; cvt_item(s, (bf16*)(ws + WS_WOUT), D, D / 32, wscr, r, lane); continue; } r -= I_SQ;
            if (r < I_SQ) { SrcPlain s{INPD(38), D, D, D}; cvt_item(s, (bf16*)(ws + WS_WO), D, D / 32, wscr, r, lane); continue; } r -= I_SQ;
            if (r < I_RK) { const int kb = r / (NRK / 32), nb = r % (NRK / 32), n0 = nb * 32; bf16* dst = (bf16*)(ws + WS_WRK) + (size_t)n0 * KRK;
                if (n0 < 1024) { SrcFold s{INPD(35) + n0, INPD(34) + 0 * 1024, 1024}; cvt_item(s, dst, KRK, 1, wscr, kb, lane); }
                else if (n0 < 2048) { SrcFold s{INPD(36) + (n0 - 1024), INPD(34) + 2 * 1024, 1024}; cvt_item(s, dst, KRK, 1, wscr, kb, lane); }
                else if (n0 < 3072) { SrcFold s{INPD(37) + (n0 - 2048), INPD(34) + 3 * 1024, 1024}; cvt_item(s, dst, KRK, 1, wscr, kb, lane); }
                else if (n0 < 3136) { SrcFold s{INPD(40) + (n0 - 3072), INPD(34) + 1 * 1024, 64}; cvt_item(s, dst, KRK, 1, wscr, kb, lane); }
                else if (n0 < 3200) { SrcFold s{INPD(43) + (n0 - 3136), INPD(34) + 4 * 1024, 64}; cvt_item(s, dst, KRK, 1, wscr, kb, lane); }
                else if (n0 < 3360) { SrcFold s{INPD(45) + (n0 - 3200), INPD(34) + 5 * 1024, 160}; cvt_item(s, dst, KRK, 1, wscr, kb, lane); }
                else { SrcZero s; cvt_item(s, dst, KRK, 1, wscr, kb, lane); }
                continue; } r -= I_RK;
            { const int kb = r / (3072 / 32), nb = r % (3072 / 32), n0 = nb * 32; bf16* dst = (bf16*)(ws + WS_WL2) + (size_t)n0 * NL1;
                if (n0 < 1024) { SrcBlk s{INPD(41) + n0, 0, 64}; cvt_item(s, dst, NL1, 1, wscr, kb, lane); }
                else if (n0 < 2048) { SrcBlk s{INPD(44) + (n0 - 1024), 64, 128}; cvt_item(s, dst, NL1, 1, wscr, kb, lane); }
                else { SrcBlk s{INPD(46) + (n0 - 2048), 128, 288}; cvt_item(s, dst, NL1, 1, wscr, kb, lane); } }
        }
        __syncthreads();
        {
            const int vb = tid >> 8, t8 = tid & 255; LAS float* sc = (LAS float*)(lds + vb * 32768);
            for (int j0 = blk * 2; j0 < 1224; j0 += G * 2) { const int j = j0 + vb; const bool act = j < 1224;
                const int l = j / 612, rem = j % 612, ry = rem / 36, nx = rem % 36, r0 = ry * 8, n = nx * 256 + t8;
                __syncthreads();
                if (act) for (int i = t8; i < 8 * 1024; i += 256) { const int r = r0 + (i >> 10), k = i & 1023; const float v = r < 8 ? INP(7)[r * 1024 + k] : INP(8)[(r - 8) * 1024 + k]; sc[i] = siluf_(v); }
                __syncthreads();
                if (act) { float acc[8];
#pragma unroll
                    for (int q = 0; q < 8; ++q) acc[q] = 0.f;
                    const float* w = INP(9) + (size_t)l * 1024 * 9216 + n;
                    for (int k = 0; k < 1024; k += 4) { const float w0 = w[(size_t)k * 9216], w1 = w[(size_t)(k + 1) * 9216], w2 = w[(size_t)(k + 2) * 9216], w3 = w[(size_t)(k + 3) * 9216];
#pragma unroll
                        for (int q = 0; q < 8; ++q) { const f32x4 s4 = *(const LAS f32x4*)(sc + q * 1024 + k); acc[q] += s4[0] * w0 + s4[1] * w1 + s4[2] * w2 + s4[3] * w3; } }
                    const float bb = INP(10)[l * 9216 + n];
#pragma unroll
                    for (int q = 0; q < 8; ++q) MODS[((size_t)l * NMODROW + r0 + q) * 9216 + n] = acc[q] + bb; }
            }
            __syncthreads();
        }
        if (blk == G - 1) for (int i = tid; i < 2048; i += NWAVES * 64) s5prep_one(i, INP(24), INP(25), INP(26), INP(27), INP(28), SP);
        if (blk >= G - 5 && blk < G - 1) { const int i = (G - 2 - blk) * 512 + tid; s5prep_pw(i, INP(24), INP(25), INP(26), SP); }
    }
    GRID_BAR();
    { PTRS; for (int row = gw; row < MTP; row += NGW) init_row(row, lane, INP(0), INP(1), MODS, X, H);
        bf16* TM = (bf16*)(ws + WS_TM); bf16* HM = (bf16*)(ws + WS_HM);
        for (int j = gws; j < 32 * 17 + 32 * 16; j += NGW) { if (j < 544) s5_tm_job(j / 17, j % 17, lane, SP, INPD(29), INPD(30), INPD(31), TM); else s5_hm_job((j - 544) >> 4, (j - 544) & 15, lane, SP, HM); }
        for (int i = gw * 64 + lane; i < 32 * 128 * 256 / 8; i += NGW * 64) { const int g = i >> 12, r = i & 4095; *(v4u*)(HM + ((size_t)g * 256 + 128) * 256 + (size_t)r * 8) = (v4u){0u, 0u, 0u, 0u}; } }
    GRID_BAR();

#define GEMM_PHASE(EPI, Aptr, Bptr, NN, KK, ...) do { pg8::GemmX g_{(const pg8::bf16_t*)(Aptr), (const pg8::bf16_t*)(Bptr), MTP, NN, KK, KK, KK, -1}; pg8::StaticOrder S_; S_.init(MTP, NN, G, blk); pg8::EPI E_{__VA_ARGS__}; \
        pg8::gemm_phase<pg8::EPI, pg8::StaticOrder, true, true>(lds + RING_OFF, g_, S_, E_); } while (0)
#define GEMMX_PHASE(EPI, Aptr, Bptr, MM, NN, KK, LDA, LDB, GSH, ...) do { pg8::GemmX g_{(const pg8::bf16_t*)(Aptr), (const pg8::bf16_t*)(Bptr), MM, NN, KK, LDA, LDB, GSH}; pg8::StaticOrder S_; S_.init(MM, NN, G, blk); pg8::EPI E_{__VA_ARGS__}; \
        pg8::gemm_phase<pg8::EPI, pg8::StaticOrder, true, true>(lds + RING_OFF, g_, S_, E_); } while (0)
#define LN_PASS(l, idx, Hout, nsh, nsc) do { PTRS; for (int row = gw; row < MT; row += NGW) ln_row(row, lane, Z, INP(11) + ((l) * 3 + (idx)) * D, INP(12) + ((l) * 3 + (idx)) * D, X, Hout, nsh, nsc); } while (0)
#define FFN(l, f, which0, lnidx, HOUT, nshw, nscw) do { \
        { PTRS; GEMM_PHASE(EpiSwiglu, H, ws + ((l) ? WS_WUP_L1 : WS_WUP_L0) + (f) * SZ_WUP, NUP, D, (pg8::bf16_t*)ACT); } GRID_BAR(); \
        { PTRS; GEMM_PHASE(EpiResid, ACT, ws + ((l) ? WS_WDN_L1 : WS_WDN_L0) + (f) * SZ_WDN, D, FFP, X, Z, modp(MODS, l, (which0) + 2), 0.5f, 0); } GRID_BAR(); \
        LN_PASS(l, lnidx, HOUT, nshw, nscw); GRID_BAR(); } while (0)

    FFN(0, 0, 0, 0, H, modp(MODS, 0, 3), modp(MODS, 0, 4));
#define L0PTRS PTRS; bf16* P = (bf16*)(ws + WS_P); float* GKL = (float*)(ws + WS_GKL); float* OG = (float*)(ws + WS_OG); bf16* Z5 = (bf16*)(ws + WS_Z5); bf16* O = (bf16*)(ws + WS_O); \
        bf16* UB = (bf16*)(ws + WS_UBUF); float* HL = (float*)(ws + WS_HLOC); (void)P; (void)GKL; (void)OG; (void)Z5; (void)O; (void)UB; (void)HL
    { L0PTRS; GEMM_PHASE(EpiInproj, H, ws + WS_WIN, NINP, D, (pg8::bf16_t*)P, GKL, (pg8::bf16_t*)UB); } GRID_BAR();
    { L0PTRS;
        GEMMX_PHASE(EpiHloc, UB, ws + WS_HM, 32768, 256, 256, 384, 256, 2, HL);
        if (gws < 64) gla_job(wscr, lane, gws >> 3, (gws >> 1) & 3, gws & 1, P, GKL, INPD(21), INPD(22), 0, TP, nullptr, out + O_GLA_P, OG);
        else { for (int s = gws - 64; s < 1536; s += NGW - 64) {
                if (s < 1024) gla_job(wscr, lane, s >> 3, (s >> 1) & 3, s & 1, P, GKL, INPD(21), INPD(22), NP, 1, INPD(2), out + O_GLA_S, OG);
                else { const int j = s - 1024; s5_job(wscr, lane, j & 31, (j >> 5) * 8, 8, P, SP, INPD(29), INPD(30), INPD(31), NP, 1, INPD(3), INPD(4), out + O_S5RE_S, out + O_S5IM_S, Z5); } } }
    }
    GRID_BAR();
    { L0PTRS; if (gws < 256) s5_carry_job(gws >> 5, gws & 31, lane, SP, HL, UB, out + O_S5RE_P, out + O_S5IM_P); } GRID_BAR();
    { L0PTRS; GEMMX_PHASE(EpiS5Y, UB, ws + WS_TM, 32768, 256, 384, 384, 384, 2, (pg8::bf16_t*)Z5);
        for (int w = gw; w < MT * 4; w += NGW) gla_post_one(w, lane, OG, P, INP(23), O); } GRID_BAR();
    { L0PTRS; GEMM_PHASE(EpiGlu, Z5, ws + WS_WGLU, 512, 512, (const pg8::bf16_t*)Z5, (pg8::bf16_t*)O, INP(33)); } GRID_BAR();
    { L0PTRS; GEMM_PHASE(EpiResid, O, ws + WS_WOUT, D, D, X, Z, modp(MODS, 0, 5), 1.0f, 0); } GRID_BAR();
    LN_PASS(0, 1, H, modp(MODS, 0, 6), modp(MODS, 0, 7)); GRID_BAR();
    FFN(0, 1, 6, 2, H, modp(MODS, 1, 0), modp(MODS, 1, 1));
    FFN(1, 0, 0, 0, (bf16*)nullptr, (const float*)nullptr, (const float*)nullptr);
#define L1PTRS PTRS; bf16* A2 = (bf16*)(ws + WS_A2); bf16* R = (bf16*)(ws + WS_R); bf16* Kb = (bf16*)(ws + WS_K); bf16* V = (bf16*)(ws + WS_V); bf16* L1 = (bf16*)(ws + WS_L1A); \
        float* WD = (float*)(ws + WS_WD); bf16* AS = (bf16*)(ws + WS_AS); bf16* Gt = (bf16*)(ws + WS_G); (void)A2; (void)R; (void)Kb; (void)V; (void)L1; (void)WD; (void)AS; (void)Gt
    { L1PTRS; for (int row = gw; row < MTP; row += NGW) shiftcat_row(row, lane, X, MODS, INP(5), A2, out); } GRID_BAR();
    { L1PTRS; GEMM_PHASE(EpiRk, A2, ws + WS_WRK, NRK, KRK, (pg8::bf16_t*)R, (size_t)MTP * D, (pg8::bf16_t*)L1); } GRID_BAR();
    { L1PTRS; GEMM_PHASE(EpiLora2, L1, ws + WS_WL2, 3072, NL1, WD, (pg8::bf16_t*)AS, (pg8::bf16_t*)Gt, INP(39), INP(42)); } GRID_BAR();
    { L1PTRS;
        if (blk < 128) wkv_chain((LAS float*)(lds + RING_OFF), tid, blk >> 4, blk & 15, R, Kb, V, WD, AS, Gt, INPD(47), INPD(48), INPD(49), INPD(50), INPD(51), out + O_WKV_P);
        else { const int sw = (blk - 128) * NWAVES + wave, nsw = (G - 128) * NWAVES;
            for (int s = sw; s < 2048; s += nsw) wkv_job(wscr, lane, s >> 4, s & 15, R, Kb, V, WD, AS, Gt, INPD(47), INPD(48), INPD(49), INPD(50), INPD(51), NP, 1, INPD(6), out + O_WKV_S); }
    }
    GRID_BAR();
    { L1PTRS; GEMM_PHASE(EpiResid, Gt, ws + WS_WO, D, D, X, Z, modp(MODS, 1, 5), 1.0f, 0); } GRID_BAR();
    LN_PASS(1, 1, H, modp(MODS, 1, 6), modp(MODS, 1, 7)); GRID_BAR();
    { PTRS; GEMM_PHASE(EpiSwiglu, H, ws + WS_WUP_L1 + SZ_WUP, NUP, D, (pg8::bf16_t*)ACT); } GRID_BAR();
    { PTRS; GEMM_PHASE(EpiResid, ACT, ws + WS_WDN_L1 + SZ_WDN, D, FFP, X, Z, modp(MODS, 1, 8), 0.5f, 0); } GRID_BAR();
    LN_PASS(1, 2, (bf16*)nullptr, (const float*)nullptr, (const float*)nullptr);
}

extern "C" void kernel_launch(void* const* d_in, const int* in_sizes, int n_in, void* d_out, int out_size, void* d_ws, size_t ws_size, hipStream_t stream) {
    static int grid = 0;
    if (grid == 0) {
        if (n_in != 52 || ws_size < WS_END) { fprintf(stderr, "kernel_launch: unexpected n_in %d or ws %zu\n", n_in, ws_size); grid = -1; return; }
        int dev = 0, cus = 0, per_cu = 0;
        if (hipGetDevice(&dev) != hipSuccess || hipDeviceGetAttribute(&cus, hipDeviceAttributeMultiprocessorCount, dev) != hipSuccess) { grid = -1; return; }
        if (hipFuncSetAttribute((const void*)mk_fwd, hipFuncAttributeMaxDynamicSharedMemorySize, LDS_BYTES) != hipSuccess) { fprintf(stderr, "hipFuncSetAttribute failed\n"); grid = -1; return; }
        if (hipOccupancyMaxActiveBlocksPerMultiprocessor(&per_cu, (const void*)mk_fwd, NWAVES * 64, LDS_BYTES) != hipSuccess || per_cu < 1) { fprintf(stderr, "occupancy query: %d\n", per_cu); per_cu = 1; }
        (void)hipGetLastError();
        grid = cus;
    }
    if (grid < 0) return;
    (void)hipMemsetAsync((char*)d_ws + WS_CTL, 0, CTL_ZERO_BYTES, stream);
    Args a{};
    for (int i = 0; i < 52; ++i) a.in[i] = (const float*)d_in[i];
    a.out = (float*)d_out; a.ws = (unsigned char*)d_ws;
    hipLaunchKernelGGL(mk_fwd, dim3(grid), dim3(NWAVES * 64), LDS_BYTES, stream, a);
}
```

```cpp
#include <hip/hip_runtime.h>
#include <cstdint>
#include <cstdio>

typedef unsigned short bf16;
typedef short bf16x8 __attribute__((ext_vector_type(8)));
typedef float f32x4 __attribute__((ext_vector_type(4)));
#define DEVI __device__ __forceinline__

constexpr int D = 1024, NP = 16384, NS = 128, MT = NP + NS, MTP = 16640, TP = 2048, BP = 8;
constexpr int FF = 2752, FFP = 2816, NUP = 2 * FFP;
constexpr int NIN = 2064, NINP = 2304;
constexpr int NRK = 3584, KRK = 2048, NL1 = 384;
constexpr int NMODROW = 136;
constexpr float ALPHA = 1.41421356237309515f;

constexpr size_t O_Y = 0, O_GLA_P = 16908288, O_S5RE_P = 17170432, O_S5IM_P = 17186816, O_SHIFT_P = 17203200, O_WKV_P = 17211392,
                 O_GLA_S = 17735680, O_S5RE_S = 21929984, O_S5IM_S = 22192128, O_SHIFT_S = 22454272, O_WKV_S = 22585344;

constexpr size_t MiB = 1u << 20;
constexpr size_t WS_CTL = 0, CTL_ZERO_BYTES = 1 * MiB;
constexpr size_t WS_MODS = 1 * MiB, WS_SP = 12 * MiB;
constexpr size_t WS_W = 13 * MiB;
constexpr size_t SZ_WUP = (size_t)NUP * D * 2;
constexpr size_t SZ_WDN = (size_t)D * FFP * 2;
constexpr size_t WS_L0 = WS_W;
constexpr size_t WS_WUP_L0 = WS_L0, WS_WDN_L0 = WS_L0 + 22 * MiB, WS_WIN = WS_L0 + 33 * MiB, WS_WGLU = WS_WIN + 4608 * 1024, WS_WOUT = WS_WGLU + 512 * 1024;
constexpr size_t WS_L1 = WS_L0 + 40 * MiB;
constexpr size_t WS_WUP_L1 = WS_L1, WS_WDN_L1 = WS_L1 + 22 * MiB, WS_WRK = WS_L1 + 33 * MiB, WS_WL2 = WS_WRK + 14 * MiB, WS_WO = WS_WL2 + 2304 * 1024;
static_assert(WS_WO + 2 * MiB <= 105 * MiB, "W region");
constexpr size_t WS_H = 105 * MiB, WS_Z = 138 * MiB, WS_ACT = 203 * MiB, WS_S2 = 293 * MiB, WS_END = 340 * MiB;
constexpr size_t WS_P = WS_ACT, WS_GKL = 277 * MiB, WS_Z5 = WS_Z, WS_O = WS_H, WS_DEC = 195 * MiB, WS_OGS = 196 * MiB, WS_KV = WS_S2;
constexpr size_t WS_UBUF = 155 * MiB, WS_HLOC = 179 * MiB, WS_HM = 326 * MiB, WS_TM = 330 * MiB;
constexpr size_t WS_A2 = WS_ACT, WS_K = WS_Z, WS_R = WS_Z - (size_t)MTP * D * 2, WS_V = WS_Z + (size_t)MTP * D * 2, WS_L1A = WS_L0, WS_WD = WS_ACT, WS_AS = 268 * MiB, WS_G = WS_AS + (size_t)MTP * D * 2;
static_assert(WS_G + (size_t)MTP * D * 2 <= WS_END, "ws");
constexpr int CW_TMO = 0, CW_BAR = 4096;

#define GAS __attribute__((address_space(1)))
#define LAS __attribute__((address_space(3)))
typedef unsigned short bf16;
typedef unsigned v4u __attribute__((ext_vector_type(4)));
typedef float f32x4 __attribute__((ext_vector_type(4)));
typedef short bf16x8 __attribute__((ext_vector_type(8)));
typedef GAS unsigned gu32;
typedef GAS unsigned long long gu64;
#define RLX_AGENT __ATOMIC_RELAXED, __HIP_MEMORY_SCOPE_AGENT
#define LDS_WAIT() asm volatile("s_waitcnt lgkmcnt(0)" ::: "memory")
#define VM_WAIT() asm volatile("s_waitcnt vmcnt(0)" ::: "memory")
__device__ __forceinline__ unsigned long long rt() { return __builtin_amdgcn_s_memrealtime(); }
__device__ __forceinline__ unsigned f2bf(float f) { unsigned u = __builtin_bit_cast(unsigned, f); return (u + 0x7fffu + ((u >> 16) & 1u)) >> 16; }
__device__ __forceinline__ unsigned pk2(float lo, float hi) { return f2bf(lo) | (f2bf(hi) << 16); }

#define XB_TMO      128
#define XB_XCNT(j)  (256  + 64 * (j))
#define XB_XSUB(j)  (1280 + 64 * (j))
#define XB_XGEN(j)  (2304 + 64 * (j))
#define XB_TOP      3328
#define XB_TOPGEN   3392
#define XCD_BAR_WORDS 3456
#define XB_SPIN_CAP (1u << 18)

__device__ __forceinline__ unsigned xb_ld(unsigned* p)              { return __hip_atomic_load(p, __ATOMIC_RELAXED, __HIP_MEMORY_SCOPE_AGENT); }
__device__ __forceinline__ unsigned xb_add(unsigned* p, unsigned v) { return __hip_atomic_fetch_add(p, v, __ATOMIC_RELAXED, __HIP_MEMORY_SCOPE_AGENT); }
__device__ __forceinline__ unsigned xb_xcc_id() { return (unsigned)__builtin_amdgcn_s_getreg((3 << 11) | 20) & 0xFu; }
#define XB_SPIN(cond, bar) do { unsigned _sp = 0; while (cond) { __builtin_amdgcn_s_sleep(1); \
    if ((++_sp & 255u) == 0u) { if (xb_ld(&(bar)[XB_TMO])) break; if (_sp > XB_SPIN_CAP) { atomicAdd(&(bar)[XB_TMO], 1u); break; } } } } while (0)

struct XcdBarrier {
    unsigned* bar; unsigned x;
    volatile LAS unsigned* st;
};

__device__ __forceinline__ XcdBarrier xcd_barrier_post(unsigned* bar, volatile LAS unsigned* st) {
    XcdBarrier b; b.bar = bar; b.x = xb_xcc_id(); b.st = st;
    if (threadIdx.x == 0) (void)xb_add(&bar[XB_XCNT(b.x)], 1u);
    return b;
}
__device__ __forceinline__ void xcd_barrier_complete(unsigned* bar, unsigned x, unsigned& nloc, unsigned& nx) {
    const unsigned G = gridDim.x * gridDim.y * gridDim.z;
    unsigned sum, cnt, mine, sp = 0u;
    for (;;) {
        sum = 0u; cnt = 0u; mine = 0u;
#pragma unroll
        for (unsigned j = 0; j < 16; ++j) { const unsigned c = xb_ld(&bar[XB_XCNT(j)]); sum += c; cnt += (c > 0u) ? 1u : 0u; mine = (j == x) ? c : mine; }
        if (sum == G) break;
        __builtin_amdgcn_s_sleep(1);
        if ((++sp & 255u) == 0u) { if (xb_ld(&bar[XB_TMO])) break; if (sp > XB_SPIN_CAP) { atomicAdd(&bar[XB_TMO], 1u); break; } }
    }
    nloc = mine > 0u ? mine : 1u; nx = cnt > 0u ? cnt : 1u;
}

__device__ __forceinline__ void xcd_barrier(const XcdBarrier& b) {
    asm volatile("s_waitcnt vmcnt(0)" ::: "memory");
    __syncthreads();
    if (threadIdx.x == 0) {
        unsigned* bar = b.bar;
        __builtin_amdgcn_s_waitcnt(0);
        unsigned nloc = b.st[0], nx = b.st[1];
        if (nloc == 0u) { xcd_barrier_complete(bar, b.x, nloc, nx); b.st[0] = nloc; b.st[1] = nx; }
        const unsigned old = xb_add(&bar[XB_XSUB(b.x)], 1u);
        const unsigned gen = old / nloc;
        if (old + 1u == (gen + 1u) * nloc) {
            __builtin_amdgcn_fence(__ATOMIC_RELEASE, "agent");
            asm volatile("s_waitcnt vmcnt(0)" ::: "memory");
            const unsigned og = xb_add(&bar[XB_TOP], 1u);
            const unsigned tg = og / nx;
            if (og + 1u == (tg + 1u) * nx) xb_add(&bar[XB_TOPGEN], 1u);
            else XB_SPIN(xb_ld(&bar[XB_TOPGEN]) == tg, bar);
            __builtin_amdgcn_fence(__ATOMIC_ACQUIRE, "agent");
            xb_add(&bar[XB_XGEN(b.x)], 1u);
            asm volatile("s_waitcnt vmcnt(0)" ::: "memory");
        } else {
            XB_SPIN(xb_ld(&bar[XB_XGEN(b.x)]) == gen, bar);
            __builtin_amdgcn_fence(__ATOMIC_ACQUIRE, "agent");
            asm volatile("s_waitcnt vmcnt(0)" ::: "memory");
        }
    }
    __syncthreads();
}

DEVI float bf2f(unsigned short h) { return __uint_as_float(((unsigned)h) << 16); }
DEVI int mrow(int i) { return i < NP ? (i >> 11) : (8 + i - NP); }
DEVI float sigmoidf_(float x) { return 1.0f / (1.0f + __expf(-x)); }
DEVI float siluf_(float x) { return x / (1.0f + __expf(-x)); }
DEVI float softplusf_(float x) { return fmaxf(x, 0.f) + log1pf(__expf(-fabsf(x))); }
DEVI float gelu_tanh(float x) { const float u = 0.7978845608028654f * (x + 0.044715f * x * x * x); return 0.5f * x * (1.0f + tanhf(u)); }
DEVI float wave_sum(float v) {
#pragma unroll
    for (int o = 1; o < 64; o <<= 1) v += __shfl_xor(v, o);
    return v;
}
__host__ __device__ __forceinline__ const float* modp(const float* mods, int l, int which) { return mods + (size_t)l * NMODROW * 9216 + which * 1024; }

namespace pg8 {
#define PG8_LAS __attribute__((address_space(3)))
typedef unsigned short bf16_t;
typedef short bf16x8 __attribute__((ext_vector_type(8)));
typedef float f32x4 __attribute__((ext_vector_type(4)));
typedef unsigned u32x4 __attribute__((ext_vector_type(4)));
constexpr int BM = 256, BK = 64, HALF = 128, HTB = HALF * BK * 2  , STAGE_BYTES = 8 * HTB, NXCD = 8, WGM = 8;

__host__ __device__ __forceinline__ int lds_byte(int r, int c) { const int st = (r >> 4) * 2 + (c >> 5), rr = r & 15, cc = c & 31, ob = rr * 64 + cc * 2; return st * 1024 + (ob ^ (((ob >> 9) & 1) << 5)); }
__host__ __device__ __forceinline__ void stage_rc(int b, int& R, int& C) { const int st = b / 1024, sb = b % 1024, swz = sb ^ (((sb >> 9) & 1) << 5); R = (st >> 1) * 16 + swz / 64; C = (st & 1) * 32 + (swz % 64) / 2; }
__host__ __device__ __forceinline__ int perm32(int rho) { const int n = rho >> 4, i = rho & 15; return 8 * (i >> 2) + 4 * n + (i & 3); }

struct Unit { int pm, pn; };
struct Gemm { const bf16_t* A; const bf16_t* Bt; int M, N, K; };
struct GemmX { const bf16_t* A; const bf16_t* Bt; int M, N, K, lda, ldb, gsh; };

struct StaticOrder {
    int nM, nN, nwg, G, c;
    __host__ __device__ void init(int M, int N, int G_, int c_) { nM = M / BM; nN = N / BM; nwg = nM * nN; G = G_; c = c_; }
    __host__ __device__ bool next(int i, Unit& u) const {
        const long L = (long)i * G + c; if (L >= nwg) return false;
        int wgid = (int)L; { const int q = nwg / NXCD, r = nwg % NXCD, xcd = wgid % NXCD, off = wgid / NXCD; wgid = (xcd < r ? xcd * (q + 1) : r * (q + 1) + (xcd - r) * q) + off; }
        const int nig = WGM * nN, gid = wgid / nig, fm = gid * WGM, gsz = (nM - fm) < WGM ? (nM - fm) : WGM;
        u.pm = fm + ((wgid % nig) % gsz); u.pn = (wgid % nig) / gsz; return true;
    }
    __device__ __forceinline__ void a_ready(const Unit&) const {}
    __device__ __forceinline__ void done(const Unit&) const {}
};


__device__ __forceinline__ unsigned cvt_pk_bf16(float lo, float hi) { unsigned r; asm volatile("v_cvt_pk_bf16_f32 %0, %1, %2" : "=v"(r) : "v"(lo), "v"(hi)); return r; }
__device__ __forceinline__ float fsilu(float x) { return x * __builtin_amdgcn_rcpf(1.0f + __builtin_amdgcn_exp2f(-1.44269504089f * x)); }
__device__ __forceinline__ float fsigm(float x) { return __builtin_amdgcn_rcpf(1.0f + __builtin_amdgcn_exp2f(-1.44269504089f * x)); }
__device__ __forceinline__ u32x4 pack8(const f32x4 a, const f32x4 b) { u32x4 w; w.x = cvt_pk_bf16(a[0], a[1]); w.y = cvt_pk_bf16(a[2], a[3]); w.z = cvt_pk_bf16(b[0], b[1]); w.w = cvt_pk_bf16(b[2], b[3]); return w; }
struct EpiSwiglu { static constexpr bool PERM = true, AFTER_DRAIN = false; bf16_t* ACT;
    __device__ __forceinline__ void operator()(const f32x4 (&acc)[2][2][4][2], const Unit& u, int wr, int wc, int fr, int fq) const {
        const int row0 = u.pm * BM + wr * 64 + fr, col0 = u.pn * 128 + wc * 32 + 8 * fq;
#pragma unroll
        for (int ai = 0; ai < 2; ++ai)
#pragma unroll
            for (int m = 0; m < 4; ++m) { f32x4 o0, o1;
#pragma unroll
                for (int e = 0; e < 4; ++e) { o0[e] = fsilu(acc[ai][0][m][0][e]) * acc[ai][1][m][0][e]; o1[e] = fsilu(acc[ai][0][m][1][e]) * acc[ai][1][m][1][e]; }
                *(u32x4*)(ACT + (size_t)(row0 + ai * HALF + m * 16) * 2816 + col0) = pack8(o0, o1); }
    } };
struct EpiResid { static constexpr bool PERM = true, AFTER_DRAIN = false; const float* X; float* Z; const float* gate; float rc; int pad;
    __device__ __forceinline__ void operator()(const f32x4 (&acc)[2][2][4][2], const Unit& u, int wr, int wc, int fr, int fq) const {
        const int row0 = u.pm * BM + wr * 64 + fr;
#pragma unroll
        for (int ai = 0; ai < 2; ++ai) { if (u.pm == 64 && ai == 1) break;
#pragma unroll
            for (int m = 0; m < 4; ++m) { const int row = row0 + ai * HALF + m * 16; const int mr = row < 16384 ? (row >> 11) : (8 + row - 16384);
#pragma unroll
                for (int bj = 0; bj < 2; ++bj)
#pragma unroll
                    for (int n = 0; n < 2; ++n) { const int c = u.pn * BM + bj * HALF + wc * 32 + 8 * fq + 4 * n;
                        const f32x4 x = *(const f32x4*)(X + (size_t)row * 1024 + c), g = *(const f32x4*)(gate + (size_t)mr * 9216 + c);
                        *(f32x4*)(Z + (size_t)row * 1024 + c) = x * 1.41421356237309515f + (g + 1.0f) * rc * acc[ai][bj][m][n]; } } }
    } };
struct EpiInproj { static constexpr bool PERM = true, AFTER_DRAIN = false; bf16_t* P; float* GKL; bf16_t* UB;
    __device__ __forceinline__ void operator()(const f32x4 (&acc)[2][2][4][2], const Unit& u, int wr, int wc, int fr, int fq) const {
        const int row0 = u.pm * BM + wr * 64 + fr;
#pragma unroll
        for (int ai = 0; ai < 2; ++ai)
#pragma unroll
            for (int m = 0; m < 4; ++m) { const int row = row0 + ai * HALF + m * 16;
#pragma unroll
                for (int bj = 0; bj < 2; ++bj) { const int c = u.pn * BM + bj * HALF + wc * 32 + 8 * fq;
                    const u32x4 pk = pack8(acc[ai][bj][m][0], acc[ai][bj][m][1]);
                    *(u32x4*)(P + (size_t)row * 2304 + c) = pk;
                    if (c >= 1552 && c < 2064 && row < 16384) { const int cu = c - 1552; *(u32x4*)(UB + ((size_t)((cu >> 4) * 1024 + (row >> 4))) * 384 + (row & 15) * 16 + (cu & 15)) = pk; }
                    if (c >= 1536 && c < 1552) { *(f32x4*)(GKL + (size_t)row * 16 + (c - 1536)) = acc[ai][bj][m][0]; *(f32x4*)(GKL + (size_t)row * 16 + (c - 1536) + 4) = acc[ai][bj][m][1]; } } }
    } };
struct EpiGlu { static constexpr bool PERM = true, AFTER_DRAIN = false; const bf16_t* Z5; bf16_t* O; const float* bg;
    __device__ __forceinline__ void operator()(const f32x4 (&acc)[2][2][4][2], const Unit& u, int wr, int wc, int fr, int fq) const {
        const int row0 = u.pm * BM + wr * 64 + fr;
#pragma unroll
        for (int ai = 0; ai < 2; ++ai)
#pragma unroll
            for (int m = 0; m < 4; ++m) { const int row = row0 + ai * HALF + m * 16;
#pragma unroll
                for (int bj = 0; bj < 2; ++bj) { const int c = u.pn * BM + bj * HALF + wc * 32 + 8 * fq;
                    const u32x4 zz = *(const u32x4*)(Z5 + (size_t)row * 512 + c); const f32x4 b0 = *(const f32x4*)(bg + c), b1 = *(const f32x4*)(bg + c + 4);
                    f32x4 o0, o1;
#pragma unroll
                    for (int e = 0; e < 4; ++e) { const unsigned w0 = zz[e >> 1], w1 = zz[2 + (e >> 1)];
                        const float z0 = __uint_as_float((e & 1) ? (w0 & 0xffff0000u) : (w0 << 16)), z1 = __uint_as_float((e & 1) ? (w1 & 0xffff0000u) : (w1 << 16));
                        o0[e] = z0 * fsigm(acc[ai][bj][m][0][e] + b0[e]); o1[e] = z1 * fsigm(acc[ai][bj][m][1][e] + b1[e]); }
                    *(u32x4*)(O + (size_t)row * 1024 + 512 + c) = pack8(o0, o1); } }
    } };
__device__ __forceinline__ float ftanh(float x) { const float e = __builtin_amdgcn_exp2f(-2.88539008178f * fabsf(x)); const float t = (1.0f - e) * __builtin_amdgcn_rcpf(1.0f + e); return x < 0.f ? -t : t; }
struct EpiRk { static constexpr bool PERM = true, AFTER_DRAIN = false; bf16_t* R; size_t rkv_stride; bf16_t* L1;
    __device__ __forceinline__ void operator()(const f32x4 (&acc)[2][2][4][2], const Unit& u, int wr, int wc, int fr, int fq) const {
        const int row0 = u.pm * BM + wr * 64 + fr;
#pragma unroll
        for (int ai = 0; ai < 2; ++ai)
#pragma unroll
            for (int m = 0; m < 4; ++m) { const int row = row0 + ai * HALF + m * 16;
#pragma unroll
                for (int bj = 0; bj < 2; ++bj) { const int c = u.pn * BM + bj * HALF + wc * 32 + 8 * fq;
                    if (c < 3072) { bf16_t* dst = R + (size_t)(c >> 10) * rkv_stride; *(u32x4*)(dst + (size_t)row * 1024 + (c & 1023)) = pack8(acc[ai][bj][m][0], acc[ai][bj][m][1]); }
                    else { const int cc = c - 3072; if (cc < 384) { f32x4 o0 = acc[ai][bj][m][0], o1 = acc[ai][bj][m][1];
                        if (cc < 64) {
#pragma unroll
                            for (int e = 0; e < 4; ++e) { o0[e] = ftanh(o0[e]); o1[e] = ftanh(o1[e]); } }
                        else if (cc >= 128 && cc < 288) {
#pragma unroll
                            for (int e = 0; e < 4; ++e) { o0[e] = fsigm(o0[e]); o1[e] = fsigm(o1[e]); } }
                        else if (cc >= 288) { o0 = (f32x4){0.f, 0.f, 0.f, 0.f}; o1 = o0; }
                        *(u32x4*)(L1 + (size_t)row * 384 + cc) = pack8(o0, o1); } } } }
    } };
struct EpiLora2 { static constexpr bool PERM = true, AFTER_DRAIN = false; float* WD; bf16_t* AS; bf16_t* G; const float* w0; const float* a0;
    __device__ __forceinline__ void operator()(const f32x4 (&acc)[2][2][4][2], const Unit& u, int wr, int wc, int fr, int fq) const {
        const int row0 = u.pm * BM + wr * 64 + fr;
#pragma unroll
        for (int ai = 0; ai < 2; ++ai)
#pragma unroll
            for (int m = 0; m < 4; ++m) { const int row = row0 + ai * HALF + m * 16;
#pragma unroll
                for (int bj = 0; bj < 2; ++bj) { const int c = u.pn * BM + bj * HALF + wc * 32 + 8 * fq;
                    if (c < 1024) {
#pragma unroll
                        for (int n = 0; n < 2; ++n) { const f32x4 wv = *(const f32x4*)(w0 + c + 4 * n); f32x4 o;
#pragma unroll
                            for (int e = 0; e < 4; ++e) { const float x = -(wv[e] + acc[ai][bj][m][n][e]); const float sp = fmaxf(x, 0.f) + 0.69314718056f * __builtin_amdgcn_logf(1.0f + __builtin_amdgcn_exp2f(-1.44269504089f * fabsf(x)));
                                const float ee = __builtin_amdgcn_exp2f(-1.44269504089f * (sp + 0.5f)); o[e] = __builtin_amdgcn_exp2f(-1.44269504089f * ee); }
                            *(f32x4*)(WD + (size_t)row * 1024 + c + 4 * n) = o; } }
                    else if (c < 2048) { const f32x4 a0v = *(const f32x4*)(a0 + c - 1024), a1v = *(const f32x4*)(a0 + c - 1024 + 4); f32x4 o0, o1;
#pragma unroll
                        for (int e = 0; e < 4; ++e) { o0[e] = fsigm(a0v[e] + acc[ai][bj][m][0][e]); o1[e] = fsigm(a1v[e] + acc[ai][bj][m][1][e]); }
                        *(u32x4*)(AS + (size_t)row * 1024 + c - 1024) = pack8(o0, o1); }
                    else *(u32x4*)(G + (size_t)row * 1024 + c - 2048) = pack8(acc[ai][bj][m][0], acc[ai][bj][m][1]); } }
    } };

struct EpiHloc { static constexpr bool PERM = true, AFTER_DRAIN = false; float* HL;
    __device__ __forceinline__ void operator()(const f32x4 (&acc)[2][2][4][2], const Unit& u, int wr, int wc, int fr, int fq) const {
        const int row0 = u.pm * BM + wr * 64 + fr, c = wc * 32 + 8 * fq;
#pragma unroll
        for (int ai = 0; ai < 2; ++ai)
#pragma unroll
            for (int m = 0; m < 4; ++m) { float* p = HL + (size_t)(row0 + ai * HALF + m * 16) * 128 + c; *(f32x4*)p = acc[ai][0][m][0]; *(f32x4*)(p + 4) = acc[ai][0][m][1]; }
    } };
__device__ __forceinline__ float fgelu(float x) { const float u2 = 1.5957691216057308f * (x + 0.044715f * x * x * x); return x * fsigm(u2); }
struct EpiS5Y { static constexpr bool PERM = true, AFTER_DRAIN = false; bf16_t* Z5;
    __device__ __forceinline__ void operator()(const f32x4 (&acc)[2][2][4][2], const Unit& u, int wr, int wc, int fr, int fq) const {
        const int row0 = u.pm * BM + wr * 64 + fr;
#pragma unroll
        for (int ai = 0; ai < 2; ++ai)
#pragma unroll
            for (int m = 0; m < 4; ++m) { const int row = row0 + ai * HALF + m * 16, g = row >> 10, chunk = row & 1023;
#pragma unroll
                for (int bj = 0; bj < 2; ++bj) { const int c = bj * HALF + wc * 32 + 8 * fq, t = c >> 4, co = c & 15; f32x4 o0, o1;
#pragma unroll
                    for (int e = 0; e < 4; ++e) { o0[e] = fgelu(acc[ai][bj][m][0][e]); o1[e] = fgelu(acc[ai][bj][m][1][e]); }
                    *(u32x4*)(Z5 + (size_t)(chunk * 16 + t) * 512 + g * 16 + co) = pack8(o0, o1); } }
    } };

template <class Epi, class Sched, bool ALIGN_EPI = false, bool SP2 = false>
__device__ __forceinline__ void gemm_phase(PG8_LAS unsigned char* lds, const GemmX g, const Sched& S, const Epi& E) {
    int tid_ = threadIdx.x; asm volatile("" : "+v"(tid_));
    const int tid = tid_, wid = __builtin_amdgcn_readfirstlane(tid >> 6), lane = tid & 63, wr = wid >> 2, wc = wid & 3, fr = lane & 15, fq = lane >> 4;
    int K_ = g.K; asm volatile("" : "+s"(K_));
    const int K = K_, nt = K / BK;
    int lda_ = g.lda, ldb_ = g.ldb; asm volatile("" : "+s"(lda_), "+s"(ldb_)); const int lda = lda_, ldb = ldb_, gsh = g.gsh, nNb = g.N / BM;
    unsigned voffA[2], voffB[2];
#pragma unroll
    for (int i = 0; i < 2; ++i) { int R, C; stage_rc(tid * 16 + i * 8192, R, C); const int Rb = Epi::PERM ? ((R & ~31) + perm32(R & 31)) : R;
        voffA[i] = (unsigned)(R * lda + C) * 2u; voffB[i] = (unsigned)(Rb * ldb + C) * 2u; }
    const size_t kstep = (size_t)(BK * 2);
    const size_t hstepA = (size_t)HALF * lda * 2, hstepB = (size_t)HALF * ldb * 2;
    const size_t tstepA = 2 * hstepA, tstepB = 2 * hstepB;
#define PG8_BTILE(u_) ((size_t)(gsh >= 0 ? ((u_).pm >> gsh) * nNb + (u_).pn : (u_).pn))
    const unsigned ldsw = (unsigned)wid * 1024u;
    const int aoff = lds_byte(wr * 64 + fr, fq * 8), boff = lds_byte(wc * 32 + fr, fq * 8);
#define PG8_SA(b, h) (((b) * 2 + (h)) * HTB)
#define PG8_SB(b, h) ((4 + (b) * 2 + (h)) * HTB)
#define PG8_STAGE(bufoff, gbase, voff) do { _Pragma("unroll") for (int _i = 0; _i < 2; ++_i) \
        __builtin_amdgcn_global_load_lds((const unsigned*)((const char*)(gbase) + (voff)[_i]), (PG8_LAS unsigned*)(lds + (bufoff) + ldsw + _i * 8192), 16, 0, 0); } while (0)
#define PG8_LDA(dst, b, h) do { _Pragma("unroll") for (int m = 0; m < 4; ++m) _Pragma("unroll") for (int k = 0; k < 2; ++k) dst[m][k] = *(const PG8_LAS bf16x8*)(lds + PG8_SA(b, h) + aoff + m * 2048 + k * 1024); } while (0)
#define PG8_LDB(dst, b, h) do { _Pragma("unroll") for (int n = 0; n < 2; ++n) _Pragma("unroll") for (int k = 0; k < 2; ++k) dst[n][k] = *(const PG8_LAS bf16x8*)(lds + PG8_SB(b, h) + boff + n * 2048 + k * 1024); } while (0)
#define PG8_MMA(ai, bj, At, Bt) do { __builtin_amdgcn_s_setprio(1); _Pragma("unroll") for (int m = 0; m < 4; ++m) _Pragma("unroll") for (int n = 0; n < 2; ++n) _Pragma("unroll") for (int k = 0; k < 2; ++k) \
        acc[ai][bj][m][n] = __builtin_amdgcn_mfma_f32_16x16x32_bf16(Bt[n][k], At[m][k], acc[ai][bj][m][n], 0, 0, 0); __builtin_amdgcn_s_setprio(0); } while (0)
#define PG8_WAIT_V(n) asm volatile("s_waitcnt vmcnt(" #n ")" ::: "memory")
#define PG8_WAIT_L(n) asm volatile("s_waitcnt lgkmcnt(" #n ")" ::: "memory")
#define PG8_BAR __builtin_amdgcn_s_barrier()
#define PG8_SCHED __builtin_amdgcn_sched_barrier(0)
    Unit cur, nxt; int ui = 0;
    if (!S.next(0, cur)) return;
    f32x4 acc[2][2][4][2];
#pragma unroll
    for (int a = 0; a < 2; ++a)
#pragma unroll
        for (int b = 0; b < 2; ++b)
#pragma unroll
            for (int m = 0; m < 4; ++m)
#pragma unroll
                for (int n = 0; n < 2; ++n) acc[a][b][m][n] = (f32x4){0.f, 0.f, 0.f, 0.f};
    bf16x8 At[4][2], B0[2][2], B1[2][2];
    const char* cA = (const char*)g.A + (size_t)cur.pm * tstepA; const char* cB = (const char*)g.Bt + PG8_BTILE(cur) * tstepB;
    S.a_ready(cur);
    if constexpr (SP2) {
        PG8_STAGE(PG8_SB(0, 0), cB, voffB); PG8_STAGE(PG8_SB(0, 1), cB + hstepB, voffB); PG8_STAGE(PG8_SA(0, 0), cA, voffA); PG8_STAGE(PG8_SA(0, 1), cA + hstepA, voffA);
        if (wr == 1) PG8_BAR;
        PG8_WAIT_V(2); PG8_BAR;
        PG8_STAGE(PG8_SB(1, 0), cB + kstep, voffB); PG8_STAGE(PG8_SA(1, 0), cA + kstep, voffA); PG8_STAGE(PG8_SB(1, 1), cB + hstepB + kstep, voffB);
        PG8_WAIT_V(6); PG8_BAR;
    } else {
        PG8_STAGE(PG8_SB(0, 0), cB, voffB); PG8_STAGE(PG8_SA(0, 0), cA, voffA); PG8_STAGE(PG8_SB(0, 1), cB + hstepB, voffB); PG8_STAGE(PG8_SA(0, 1), cA + hstepA, voffA);
        if (wr == 1) PG8_BAR;
        PG8_WAIT_V(4); PG8_BAR;
        PG8_STAGE(PG8_SB(1, 0), cB + kstep, voffB); PG8_STAGE(PG8_SA(1, 0), cA + kstep, voffA); PG8_STAGE(PG8_SB(1, 1), cB + hstepB + kstep, voffB);
        PG8_WAIT_V(6); PG8_BAR;
    }
    for (;;) {
        const bool has_next = S.next(ui + 1, nxt);
        const char* nA = has_next ? (const char*)g.A + (size_t)nxt.pm * tstepA : cA; const char* nB = has_next ? (const char*)g.Bt + PG8_BTILE(nxt) * tstepB : cB;
        for (int t = 0; t < nt; t += 2) {
            const bool last = (t == nt - 2);
            const char* a1 = cA + (size_t)(t + 1) * kstep;
            const char* a2 = last ? nA : cA + (size_t)(t + 2) * kstep; const char* b2 = last ? nB : cB + (size_t)(t + 2) * kstep;
            const char* a3 = a2 + kstep; const char* b3 = b2 + kstep;
            if (last && has_next) S.a_ready(nxt);
            if constexpr (SP2) {
            PG8_LDB(B0, 0, 0); PG8_LDB(B1, 0, 1); PG8_SCHED; PG8_LDA(At, 0, 0); PG8_STAGE(PG8_SA(1, 1), a1 + hstepA, voffA);
            PG8_WAIT_V(8); PG8_WAIT_L(0); PG8_BAR; PG8_MMA(0, 0, At, B0); PG8_MMA(0, 1, At, B1); PG8_BAR; PG8_SCHED;
            PG8_LDA(At, 0, 1); PG8_STAGE(PG8_SB(0, 0), b2, voffB); PG8_STAGE(PG8_SB(0, 1), b2 + hstepB, voffB); PG8_STAGE(PG8_SA(0, 0), a2, voffA);
            PG8_WAIT_V(8); PG8_WAIT_L(0); PG8_BAR; PG8_MMA(1, 0, At, B0); PG8_MMA(1, 1, At, B1); PG8_BAR; PG8_SCHED;
            PG8_LDB(B0, 1, 0); PG8_LDB(B1, 1, 1); PG8_SCHED; PG8_LDA(At, 1, 0); PG8_STAGE(PG8_SA(0, 1), a2 + hstepA, voffA);
            PG8_WAIT_V(8); PG8_WAIT_L(0); PG8_BAR; PG8_MMA(0, 0, At, B0); PG8_MMA(0, 1, At, B1); PG8_BAR; PG8_SCHED;
            PG8_LDA(At, 1, 1); PG8_STAGE(PG8_SB(1, 0), b3, voffB); PG8_STAGE(PG8_SB(1, 1), b3 + hstepB, voffB); PG8_STAGE(PG8_SA(1, 0), a3, voffA);
            PG8_WAIT_V(8); PG8_WAIT_L(0); PG8_BAR; PG8_MMA(1, 0, At, B0); PG8_MMA(1, 1, At, B1); PG8_BAR; PG8_SCHED;
            } else {
            PG8_LDB(B0, 0, 0); PG8_SCHED; PG8_LDA(At, 0, 0); PG8_STAGE(PG8_SA(1, 1), a1 + hstepA, voffA);
            PG8_WAIT_L(8); PG8_BAR; PG8_WAIT_L(0); PG8_MMA(0, 0, At, B0); PG8_BAR; PG8_SCHED;
            PG8_LDB(B1, 0, 1); PG8_STAGE(PG8_SB(0, 0), b2, voffB);
            PG8_BAR; PG8_WAIT_L(0); PG8_MMA(0, 1, At, B1); PG8_BAR;
            PG8_LDA(At, 0, 1); PG8_STAGE(PG8_SA(0, 0), a2, voffA);
            PG8_BAR; PG8_WAIT_L(0); PG8_MMA(1, 0, At, B0); PG8_BAR; PG8_SCHED;
            PG8_STAGE(PG8_SB(0, 1), b2 + hstepB, voffB);
            PG8_WAIT_V(6); PG8_BAR; PG8_MMA(1, 1, At, B1); PG8_BAR;
            PG8_LDB(B0, 1, 0); PG8_SCHED; PG8_LDA(At, 1, 0); PG8_STAGE(PG8_SA(0, 1), a2 + hstepA, voffA);
            PG8_WAIT_L(8); PG8_BAR; PG8_WAIT_L(0); PG8_MMA(0, 0, At, B0); PG8_BAR; PG8_SCHED;
            PG8_LDB(B1, 1, 1); PG8_STAGE(PG8_SB(1, 0), b3, voffB);
            PG8_BAR; PG8_WAIT_L(0); PG8_MMA(0, 1, At, B1); PG8_BAR;
            PG8_LDA(At, 1, 1); PG8_STAGE(PG8_SA(1, 0), a3, voffA);
            PG8_BAR; PG8_WAIT_L(0); PG8_MMA(1, 0, At, B0); PG8_BAR; PG8_SCHED;
            PG8_STAGE(PG8_SB(1, 1), b3 + hstepB, voffB);
            PG8_WAIT_V(6); PG8_BAR; PG8_MMA(1, 1, At, B1); PG8_BAR;
            }
        }
        if constexpr (ALIGN_EPI) { if (wr == 0) PG8_BAR; }
        if constexpr (!Epi::AFTER_DRAIN) { E(acc, cur, wr, wc, fr, fq); S.done(cur); }
        if (!has_next) break;
#pragma unroll
        for (int a = 0; a < 2; ++a)
#pragma unroll
            for (int b = 0; b < 2; ++b)
#pragma unroll
                for (int m = 0; m < 4; ++m)
#pragma unroll
                    for (int n = 0; n < 2; ++n) acc[a][b][m][n] = (f32x4){0.f, 0.f, 0.f, 0.f};
        cur = nxt; cA = nA; cB = nB; ++ui;
        if constexpr (ALIGN_EPI) { if (wr == 1) PG8_BAR; }
    }
    PG8_WAIT_V(0);
    if constexpr (!ALIGN_EPI) { if (wr == 0) PG8_BAR; }
    PG8_BAR;
    if constexpr (Epi::AFTER_DRAIN) { E.fused(acc, cur, wr, wc, fr, fq, lds, wid, lane); S.done(cur); }
#undef PG8_BTILE
#undef PG8_SA
#undef PG8_SB
#undef PG8_STAGE
#undef PG8_LDA
#undef PG8_LDB
#undef PG8_MMA
#undef PG8_WAIT_V
#undef PG8_WAIT_L
#undef PG8_BAR
#undef PG8_SCHED
}
}

constexpr int NWAVES = 8;
constexpr int RING_OFF = 0, RING_BYTES = 131072;
constexpr int LDSCTL_OFF = RING_BYTES, MISC_OFF = LDSCTL_OFF + 320;
constexpr int LDS_BYTES = 147456;

struct Args { const float* in[52]; float* out; unsigned char* ws; };

struct Frame {
    LAS unsigned char* lds; int tid, lane, wave, G, blk;
    const float* const* in; float* out; unsigned char* ws;
};
#define INP(i) (args.in[i])
#define INPD(i) ({ int i_ = (i); asm volatile("" : "+s"(i_)); args.in[i_]; })

template <class Src>
DEVI void cvt_item(const Src src, bf16* WT, int Kd, int nblk, LAS float* scr, int item, int lane) {
    const int kb = item / nblk, nb = item % nblk, k0 = 64 * kb, n0 = 32 * nb;
#pragma unroll 8
    for (int i = 0; i < 32; ++i) { const int kk = 2 * i + (lane >> 5); scr[kk * 33 + (lane & 31)] = src(k0 + kk, n0 + (lane & 31)); }
    LDS_WAIT(); asm volatile("" ::: "memory");
    const int c = lane & 7;
#pragma unroll
    for (int j = 0; j < 4; ++j) { const int n = (lane >> 3) + 8 * j; const LAS float* s = scr + (8 * c) * 33 + n;
        v4u o; o.x = pk2(s[0 * 33], s[1 * 33]); o.y = pk2(s[2 * 33], s[3 * 33]); o.z = pk2(s[4 * 33], s[5 * 33]); o.w = pk2(s[6 * 33], s[7 * 33]);
        *(GAS v4u*)(WT + (size_t)(n0 + n) * Kd + k0 + 8 * c) = o; }
    LDS_WAIT(); asm volatile("" ::: "memory");
}
struct SrcPlain { const float* W; int K, N, ld; DEVI float operator()(int k, int n) const { return (k < K && n < N) ? W[(size_t)k * ld + n] : 0.f; } };
struct SrcFold { const float* W; const float* mu; int ld; DEVI float operator()(int k, int n) const { const int kk = k & 1023; const float m = mu[kk]; return (k < 1024 ? m : (1.0f - m)) * W[(size_t)kk * ld + n]; } };
struct SrcBlk { const float* W; int k0, k1; DEVI float operator()(int k, int n) const { return (k >= k0 && k < k1) ? W[(size_t)(k - k0) * 1024 + n] : 0.f; } };
struct SrcZero { DEVI float operator()(int, int) const { return 0.f; } };

DEVI void sincos_d(double x, double& s, double& c) {
    const double n = rint(x * 0.63661977236758134308);
    double r = fma(-n, 1.57079632679489655800e+00, x); r = fma(-n, 6.12323399573676603587e-17, r);
    const double r2 = r * r;
    double sp = -7.6471637318198164759e-13; sp = fma(sp, r2, 1.6059043836821614599e-10); sp = fma(sp, r2, -2.5052108385441718775e-08); sp = fma(sp, r2, 2.7557319223985890653e-06);
    sp = fma(sp, r2, -1.9841269841269841270e-04); sp = fma(sp, r2, 8.3333333333333333333e-03); sp = fma(sp, r2, -1.6666666666666666667e-01); const double sr = fma(sp * r2, r, r);
    double cp = 4.7794773323873852974e-14; cp = fma(cp, r2, -1.1470745597729724714e-11); cp = fma(cp, r2, 2.0876756987868098979e-09); cp = fma(cp, r2, -2.7557319223985890653e-07);
    cp = fma(cp, r2, 2.4801587301587301587e-05); cp = fma(cp, r2, -1.3888888888888888889e-03); cp = fma(cp, r2, 4.1666666666666666667e-02); cp = fma(cp, r2, -0.5); const double cr = fma(cp, r2, 1.0);
    const int q = ((int)n) & 3;
    s = (q == 0) ? sr : (q == 1) ? cr : (q == 2) ? -sr : -cr;
    c = (q == 0) ? cr : (q == 1) ? -sr : (q == 2) ? -cr : sr;
}
DEVI void s5prep_one(int i, const float* a_re, const float* a_im, const float* log_step, const float* b_re, const float* b_im, float* sp) {
    const int g = i >> 6;
    const double dt = exp((double)log_step[g]), ar = a_re[i], ai = a_im[i];
    const double mag = exp(ar * dt); double s, c; sincos_d(ai * dt, s, c);
    const double abr = mag * c, abi = mag * s, den = ar * ar + ai * ai, nr = abr - 1.0;
    const double zr = (nr * ar + abi * ai) / den, zi = (abi * ar - nr * ai) / den;
    sp[i] = (float)abr; sp[2048 + i] = (float)abi;
    for (int cc = 0; cc < 16; ++cc) { const double br = b_re[i * 16 + cc], bi = b_im[i * 16 + cc];
        sp[4096 + i * 16 + cc] = (float)(zr * br - zi * bi); sp[4096 + 32768 + i * 16 + cc] = (float)(zr * bi + zi * br); }
}


constexpr int SP_PW = 4096 + 65536;
DEVI void s5prep_pw(int i, const float* a_re, const float* a_im, const float* log_step, float* sp) {
    const int g = i >> 6; const double dt = exp((double)log_step[g]), ar = a_re[i], ai = a_im[i];
    for (int tau = 0; tau <= 16; ++tau) { const double mag = exp(ar * dt * tau); double s, c; sincos_d(ai * dt * tau, s, c); sp[SP_PW + i * 34 + tau * 2] = (float)(mag * c); sp[SP_PW + i * 34 + tau * 2 + 1] = (float)(mag * s); }
}
DEVI void s5_tm_job(int g, int tau, int lane, const float* sp, const float* c_re, const float* c_im, const float* dd, bf16* TM) {
    bf16* tm = TM + (size_t)g * 256 * 384;
    if (tau <= 15) {
        const int co = lane >> 2, ci0 = (lane & 3) * 4; float kv[4] = {0.f, 0.f, 0.f, 0.f};
        for (int p = 0; p < 64; ++p) { const float pr = sp[SP_PW + (g * 64 + p) * 34 + tau * 2], pi = sp[SP_PW + (g * 64 + p) * 34 + tau * 2 + 1];
            const float cr = c_re[(g * 16 + co) * 64 + p], ci = c_im[(g * 16 + co) * 64 + p];
            const f32x4 br = *(const f32x4*)(sp + 4096 + (g * 64 + p) * 16 + ci0), bi = *(const f32x4*)(sp + 4096 + 32768 + (g * 64 + p) * 16 + ci0);
#pragma unroll
            for (int q = 0; q < 4; ++q) { const float wr = pr * br[q] - pi * bi[q], wi = pr * bi[q] + pi * br[q]; kv[q] += cr * wr - ci * wi; } }
        if (tau == 0) {
#pragma unroll
            for (int q = 0; q < 4; ++q) if (ci0 + q == co) kv[q] += dd[g * 16 + co]; }
        const unsigned long long pk = (unsigned long long)pk2(kv[0], kv[1]) | ((unsigned long long)pk2(kv[2], kv[3]) << 32);
        for (int t = tau; t < 16; ++t) *(unsigned long long*)(tm + (size_t)(t * 16 + co) * 384 + (t - tau) * 16 + ci0) = pk;
        if (tau >= 1) for (int t = 0; t + tau < 16; ++t) *(unsigned long long*)(tm + (size_t)(t * 16 + co) * 384 + (t + tau) * 16 + ci0) = 0ull;
    }
    if (tau >= 1) { const int t = tau - 1, p = lane; const float pr = sp[SP_PW + (g * 64 + p) * 34 + tau * 2], pi = sp[SP_PW + (g * 64 + p) * 34 + tau * 2 + 1];
        for (int co = 0; co < 16; ++co) { const float cr = c_re[(g * 16 + co) * 64 + p], ci = c_im[(g * 16 + co) * 64 + p];
            tm[(size_t)(t * 16 + co) * 384 + 256 + p] = (bf16)f2bf(cr * pr - ci * pi); tm[(size_t)(t * 16 + co) * 384 + 320 + p] = (bf16)f2bf(-(cr * pi + ci * pr)); } }
}
DEVI void s5_hm_job(int g, int s, int lane, const float* sp, bf16* HM) {
    const int p = lane; const float pr = sp[SP_PW + (g * 64 + p) * 34 + (15 - s) * 2], pi = sp[SP_PW + (g * 64 + p) * 34 + (15 - s) * 2 + 1];
    bf16* hr = HM + ((size_t)g * 256 + p) * 256 + s * 16; bf16* hi = hr + 64 * 256;
#pragma unroll
    for (int h8 = 0; h8 < 2; ++h8) { float wr[8], wi[8];
#pragma unroll
        for (int q = 0; q < 8; ++q) { const float br = sp[4096 + (g * 64 + p) * 16 + h8 * 8 + q], bi = sp[4096 + 32768 + (g * 64 + p) * 16 + h8 * 8 + q]; wr[q] = pr * br - pi * bi; wi[q] = pr * bi + pi * br; }
        v4u a, b; a.x = pk2(wr[0], wr[1]); a.y = pk2(wr[2], wr[3]); a.z = pk2(wr[4], wr[5]); a.w = pk2(wr[6], wr[7]); b.x = pk2(wi[0], wi[1]); b.y = pk2(wi[2], wi[3]); b.z = pk2(wi[4], wi[5]); b.w = pk2(wi[6], wi[7]);
        *(v4u*)(hr + h8 * 8) = a; *(v4u*)(hi + h8 * 8) = b; }
}
DEVI void s5_carry_job(int b, int g, int lane, const float* sp, const float* HL, bf16* UB, float* ore, float* oim) {
    const int p = lane; const float ar = sp[SP_PW + (g * 64 + p) * 34 + 32], ai = sp[SP_PW + (g * 64 + p) * 34 + 33];
    float cr = 0.f, ci = 0.f;
#pragma unroll 8
    for (int n = 0; n < 128; ++n) { const size_t row = (size_t)g * 1024 + b * 128 + n;
        UB[row * 384 + 256 + p] = (bf16)f2bf(cr); UB[row * 384 + 320 + p] = (bf16)f2bf(ci);
        const float hr = HL[row * 128 + p], hi = HL[row * 128 + 64 + p];
        const float nr = ar * cr - ai * ci + hr, ni = ar * ci + ai * cr + hi; cr = nr; ci = ni; }
    ore[((size_t)b * 32 + g) * 64 + p] = cr; oim[((size_t)b * 32 + g) * 64 + p] = ci;
}

DEVI void init_row(int row, int lane, const float* xp, const float* xs, const float* mods, float* X, bf16* H) {
    if (row >= MT) { for (int j = 0; j < 16; ++j) H[(size_t)row * D + j * 64 + lane] = 0; return; }
    const float* src = row < NP ? xp + (size_t)row * D : xs + (size_t)(row - NP) * D;
    const float* sh = modp(mods, 0, 0) + (size_t)mrow(row) * 9216; const float* sc = modp(mods, 0, 1) + (size_t)mrow(row) * 9216;
#pragma unroll
    for (int j = 0; j < 4; ++j) { const int c = j * 256 + lane * 4; const f32x4 v = *(const f32x4*)(src + c), a = *(const f32x4*)(sc + c), b = *(const f32x4*)(sh + c);
        *(f32x4*)(X + (size_t)row * D + c) = v; const f32x4 h = v * (a + 1.0f) + b;
        *(unsigned long long*)(H + (size_t)row * D + c) = (unsigned long long)pk2(h[0], h[1]) | ((unsigned long long)pk2(h[2], h[3]) << 32); }
}
DEVI void ln_row(int row, int lane, const float* Z, const float* g, const float* b, float* X, bf16* H, const float* sh, const float* sc) {
    const float* z = Z + (size_t)row * D; f32x4 v[4]; float s = 0.f;
#pragma unroll
    for (int j = 0; j < 4; ++j) { v[j] = *(const f32x4*)(z + j * 256 + lane * 4); s += (v[j][0] + v[j][1]) + (v[j][2] + v[j][3]); }
    const float mean = wave_sum(s) * (1.f / D); float q = 0.f;
#pragma unroll
    for (int j = 0; j < 4; ++j) { v[j] = v[j] - mean; q += (v[j][0] * v[j][0] + v[j][1] * v[j][1]) + (v[j][2] * v[j][2] + v[j][3] * v[j][3]); }
    const float rstd = rsqrtf(wave_sum(q) * (1.f / D) + 1e-5f);
    const int mr = mrow(row);
#pragma unroll
    for (int j = 0; j < 4; ++j) { const int c = j * 256 + lane * 4; const f32x4 x = v[j] * rstd * *(const f32x4*)(g + c) + *(const f32x4*)(b + c); *(f32x4*)(X + (size_t)row * D + c) = x;
        if (H) { const f32x4 h = x * (*(const f32x4*)(sc + (size_t)mr * 9216 + c) + 1.0f) + *(const f32x4*)(sh + (size_t)mr * 9216 + c);
            *(unsigned long long*)(H + (size_t)row * D + c) = (unsigned long long)pk2(h[0], h[1]) | ((unsigned long long)pk2(h[2], h[3]) << 32); } }
}
DEVI void shiftcat_row(int row, int lane, const float* X, const float* mods, const float* shift_in, bf16* A2, float* out) {
    if (row >= MT) { for (int j = 0; j < 32; ++j) A2[(size_t)row * KRK + j * 64 + lane] = 0; return; }
    const int mr = mrow(row); const float* sh = modp(mods, 1, 3) + (size_t)mr * 9216; const float* sc = modp(mods, 1, 4) + (size_t)mr * 9216;
    const bool prompt = row < NP; const int t = row & 2047;
    for (int j = 0; j < 16; ++j) { const int c = j * 64 + lane; const float h = X[(size_t)row * D + c] * (1.f + sc[c]) + sh[c];
        float pv; if (prompt) pv = t == 0 ? 0.f : X[(size_t)(row - 1) * D + c] * (1.f + sc[c]) + sh[c]; else pv = shift_in[(size_t)(row - NP) * D + c];
        A2[(size_t)row * KRK + c] = (bf16)f2bf(pv); A2[(size_t)row * KRK + 1024 + c] = (bf16)f2bf(h);
        if (prompt) { if (t == 2047) out[O_SHIFT_P + (size_t)(row >> 11) * D + c] = h; } else out[O_SHIFT_S + (size_t)(row - NP) * D + c] = h; }
}
DEVI void gla_post_one(int w, int lane, const float* OG, const bf16* P, const float* norm_g, bf16* O) {
    const int tok = w >> 2, h = w & 3;
    const float o0 = OG[(size_t)tok * 512 + h * 128 + lane], o1 = OG[(size_t)tok * 512 + h * 128 + 64 + lane];
    const float ms = wave_sum(o0 * o0 + o1 * o1) * (1.f / 128.f), r = rsqrtf(ms + 1e-5f);
    const float g0 = bf2f(P[(size_t)tok * NINP + 1024 + h * 128 + lane]), g1 = bf2f(P[(size_t)tok * NINP + 1024 + h * 128 + 64 + lane]);
    O[(size_t)tok * D + h * 128 + lane] = (bf16)f2bf(o0 * r * norm_g[lane] * siluf_(g0));
    O[(size_t)tok * D + h * 128 + 64 + lane] = (bf16)f2bf(o1 * r * norm_g[64 + lane] * siluf_(g1));
}

DEVI void gla_job(LAS float* scr, int lane, int b, int h, int half, const bf16* P, const float* GKL, const float* w_gk, const float* b_gk, int tok_base, int T, const float* s0, float* s_out, float* OG) {
    LAS float* sdec = scr; LAS float* sq = scr + 1024; LAS float* sk = scr + 2048;
    const int dv = half * 64 + lane;
    float S[64];
#pragma unroll
    for (int i = 0; i < 64; ++i) S[i] = s0 ? s0[(((size_t)b * 4 + h) * 64 + i) * 128 + dv] : 0.f;
    float wg[16];
#pragma unroll
    for (int r = 0; r < 16; ++r) wg[r] = w_gk[r * 256 + h * 64 + lane];
    const float bg = b_gk[h * 64 + lane];
    for (int t0 = 0; t0 < T; t0 += 16) { const int nt = (T - t0) < 16 ? (T - t0) : 16;
        for (int tt = 0; tt < nt; ++tt) { const size_t tok = (size_t)tok_base + (size_t)b * T + t0 + tt; float x = bg;
#pragma unroll
            for (int r = 0; r < 16; ++r) x += GKL[tok * 16 + r] * wg[r];
            const float ls = fminf(x, 0.f) - log1pf(__expf(-fabsf(x)));
            sdec[tt * 64 + lane] = __expf(ls * (1.f / 16.f)); sq[tt * 64 + lane] = bf2f(P[tok * NINP + h * 64 + lane]) * 0.125f; sk[tt * 64 + lane] = bf2f(P[tok * NINP + 256 + h * 64 + lane]); }
        LDS_WAIT(); asm volatile("" ::: "memory");
        for (int tt = 0; tt < nt; ++tt) { const size_t tok = (size_t)tok_base + (size_t)b * T + t0 + tt;
            const float v = bf2f(P[tok * NINP + 512 + h * 128 + dv]); float o = 0.f;
#pragma unroll
            for (int i = 0; i < 64; ++i) { S[i] = S[i] * sdec[tt * 64 + i] + sk[tt * 64 + i] * v; o += sq[tt * 64 + i] * S[i]; }
            OG[tok * 512 + h * 128 + dv] = o; }
        LDS_WAIT(); asm volatile("" ::: "memory");
    }
#pragma unroll
    for (int i = 0; i < 64; ++i) s_out[(((size_t)b * 4 + h) * 64 + i) * 128 + dv] = S[i];
}
DEVI void s5_job(LAS float* scr, int lane, int g, int b0, int nb, const bf16* P, const float* sp, const float* c_re, const float* c_im, const float* dd, int tok_base, int T,
                 const float* h0re, const float* h0im, float* ore, float* oim, bf16* Z5) {
    const int p = lane, c = p & 15, pq = p >> 4;
    const float abr = sp[g * 64 + p], abi = sp[2048 + g * 64 + p];
    float bbr[16], bbi[16], cr[16], ci[16];
#pragma unroll
    for (int i = 0; i < 16; ++i) { bbr[i] = sp[4096 + (g * 64 + p) * 16 + i]; bbi[i] = sp[4096 + 32768 + (g * 64 + p) * 16 + i];
        cr[i] = c_re[(g * 16 + c) * 64 + pq * 16 + i]; ci[i] = c_im[(g * 16 + c) * 64 + pq * 16 + i]; }
    const float dv = dd[g * 16 + c];
    for (int b = b0; b < b0 + nb; ++b) {
        float hr = h0re ? h0re[((size_t)b * 32 + g) * 64 + p] : 0.f, hi = h0im ? h0im[((size_t)b * 32 + g) * 64 + p] : 0.f;
        for (int t = 0; t < T; ++t) { const size_t tok = (size_t)tok_base + (size_t)b * T + t;
            const bf16* up = P + tok * NINP + 1552 + g * 16; float u[16];
#pragma unroll
            for (int i = 0; i < 16; ++i) u[i] = bf2f(up[i]);
            const float uc = bf2f(up[c]);
            float br = 0.f, bi = 0.f;
#pragma unroll
            for (int i = 0; i < 16; ++i) { br += u[i] * bbr[i]; bi += u[i] * bbi[i]; }
            const float nr = abr * hr - abi * hi + br, ni = abr * hi + abi * hr + bi; hr = nr; hi = ni;
            LAS float* hs = scr + (t & 1) * 128;
            hs[p] = hr; hs[64 + p] = hi;
            LDS_WAIT(); asm volatile("" ::: "memory");
            float y = 0.f;
#pragma unroll
            for (int i = 0; i < 16; ++i) y += cr[i] * hs[pq * 16 + i] - ci[i] * hs[64 + pq * 16 + i];
            y += __shfl_xor(y, 16); y += __shfl_xor(y, 32);
            if (p < 16) { y += dv * uc; Z5[tok * 512 + g * 16 + c] = (bf16)f2bf(gelu_tanh(y)); }
        }
        ore[((size_t)b * 32 + g) * 64 + p] = hr; oim[((size_t)b * 32 + g) * 64 + p] = hi;
        LDS_WAIT(); asm volatile("" ::: "memory");
    }
}
DEVI void wkv_job(LAS float* scr, int lane, int b, int h, const bf16* R, const bf16* Kb, const bf16* V, const float* WD, const bf16* AS, bf16* GO, const float* k_k, const float* k_a, const float* r_k, const float* lnx_g, const float* lnx_b,
                  int tok_base, int T, const float* s0, float* s_out) {
    LAS float* sw = scr; LAS float* skm = scr + 512; LAS float* sa_ = scr + 1024; LAS float* sb = scr + 1536; LAS float* sr = scr + 2048; LAS float* sbon = scr + 2560;
    const int i = lane, ch = h * 64 + i;
    float S[64];
#pragma unroll
    for (int j = 0; j < 64; ++j) S[j] = s0 ? s0[(((size_t)b * 16 + h) * 64 + i) * 64 + j] : 0.f;
    const float kkc = k_k[ch], kac = k_a[ch], rkc = r_k[ch], lg = lnx_g[ch], lb = lnx_b[ch];
    for (int t0 = 0; t0 < T; t0 += 8) { const int nt = (T - t0) < 8 ? (T - t0) : 8;
        for (int tt = 0; tt < nt; ++tt) { const size_t tok = (size_t)tok_base + (size_t)b * T + t0 + tt;
            const float k = bf2f(Kb[tok * D + ch]), r = bf2f(R[tok * D + ch]), a = bf2f(AS[tok * D + ch]), w = WD[tok * D + ch];
            float kk = k * kkc; const float nrm = sqrtf(wave_sum(kk * kk)); kk = kk / fmaxf(nrm, 1e-12f);
            const float km = k * (1.f + (a - 1.f) * kac);
            sw[tt * 64 + i] = w; skm[tt * 64 + i] = km; sa_[tt * 64 + i] = -kk; sb[tt * 64 + i] = kk * a; sr[tt * 64 + i] = r;
            const float bon = wave_sum(r * km * rkc); if (i == 0) sbon[tt] = bon; }
        LDS_WAIT(); asm volatile("" ::: "memory");
        for (int tt = 0; tt < nt; ++tt) { const size_t tok = (size_t)tok_base + (size_t)b * T + t0 + tt;
            const float v = bf2f(V[tok * D + ch]); float sa = 0.f;
#pragma unroll
            for (int j = 0; j < 64; ++j) sa += S[j] * sa_[tt * 64 + j];
            float y = 0.f;
#pragma unroll
            for (int j = 0; j < 64; ++j) { S[j] = S[j] * sw[tt * 64 + j] + sa * sb[tt * 64 + j] + v * skm[tt * 64 + j]; y += S[j] * sr[tt * 64 + j]; }
            const float mean = wave_sum(y) * (1.f / 64.f), dy = y - mean, var = wave_sum(dy * dy) * (1.f / 64.f);
            float yn = dy * rsqrtf(var + 64e-5f) * lg + lb; yn += sbon[tt] * v;
            const float gt = bf2f(GO[tok * D + ch]); GO[tok * D + ch] = (bf16)f2bf(yn * gt); }
        LDS_WAIT(); asm volatile("" ::: "memory");
    }
#pragma unroll
    for (int j = 0; j < 64; ++j) s_out[(((size_t)b * 16 + h) * 64 + i) * 64 + j] = S[j];
}

DEVI float dpp_add(float v, const int ctrl_sel) {
    int r;
    switch (ctrl_sel) {
    case 0: r = __builtin_amdgcn_update_dpp(0, __builtin_bit_cast(int, v), 0xB1, 0xF, 0xF, true); break;
    case 1: r = __builtin_amdgcn_update_dpp(0, __builtin_bit_cast(int, v), 0x4E, 0xF, 0xF, true); break;
    case 2: r = __builtin_amdgcn_update_dpp(0, __builtin_bit_cast(int, v), 0x141, 0xF, 0xF, true); break;
    default: r = __builtin_amdgcn_update_dpp(0, __builtin_bit_cast(int, v), 0x140, 0xF, 0xF, true); break;
    }
    return v + __builtin_bit_cast(float, r);
}
DEVI float red16(float v) { v = dpp_add(v, 0); v = dpp_add(v, 1); v = dpp_add(v, 2); v = dpp_add(v, 3); return v; }
constexpr int WK_TB = 32;
constexpr int WK_W = 0, WK_KM = 2048, WK_NA = 4096, WK_BB = 6144, WK_R = 8192, WK_V = 10240, WK_BON = 12288, WK_PB = 12320;
constexpr int WK_Y = 2 * WK_PB;
static_assert((WK_Y + 2048) * 4 <= RING_BYTES, "wkv lds");
struct WkvLoad { uint2 k, r, a, v, g; f32x4 w; };
DEVI void wkv_chain(LAS float* L, int tid, int b, int h, const bf16* R, const bf16* Kb, const bf16* V, const float* WD, const bf16* AS, bf16* GO,
                    const float* k_k, const float* k_a, const float* r_k, const float* lnx_g, const float* lnx_b, float* s_out) {
    const int rp = tid >> 4, jq = tid & 15, tt = tid >> 4;
    const int ch = h * 64 + 4 * jq;
    const f32x4 kkc = *(const f32x4*)(k_k + ch), kac = *(const f32x4*)(k_a + ch), rkc = *(const f32x4*)(r_k + ch), lg = *(const f32x4*)(lnx_g + ch), lb = *(const f32x4*)(lnx_b + ch);
    f32x4 S0 = {0.f, 0.f, 0.f, 0.f}, S1 = {0.f, 0.f, 0.f, 0.f};
    const size_t tokb = (size_t)b * TP;
    WkvLoad ld; uint2 gcur;
    auto bf4 = [](uint2 u) -> f32x4 { f32x4 o; o[0] = __uint_as_float(u.x << 16); o[1] = __uint_as_float(u.x & 0xffff0000u); o[2] = __uint_as_float(u.y << 16); o[3] = __uint_as_float(u.y & 0xffff0000u); return o; };
#define WK_ISSUE(blkidx) do { const size_t o_ = (tokb + (size_t)(blkidx) * WK_TB + tt) * D + ch; ld.k = *(const uint2*)(Kb + o_); ld.r = *(const uint2*)(R + o_); ld.a = *(const uint2*)(AS + o_); ld.v = *(const uint2*)(V + o_); \
        ld.g = *(const uint2*)(GO + o_); ld.w = *(const f32x4*)(WD + o_); } while (0)
#define WK_PREP(bufidx) do { LAS float* pb_ = L + (bufidx) * WK_PB; const f32x4 k4 = bf4(ld.k), r4 = bf4(ld.r), a4 = bf4(ld.a), v4 = bf4(ld.v); \
        f32x4 kk = k4 * kkc; float ss = red16((kk[0] * kk[0] + kk[1] * kk[1]) + (kk[2] * kk[2] + kk[3] * kk[3])); const float inv = 1.0f / fmaxf(sqrtf(ss), 1e-12f); kk = kk * inv; \
        const f32x4 km = k4 * ((a4 - 1.0f) * kac + 1.0f); const f32x4 pr = r4 * km * rkc; const float bon = red16((pr[0] + pr[1]) + (pr[2] + pr[3])); \
        *(LAS f32x4*)(pb_ + WK_W + tt * 64 + 4 * jq) = ld.w; *(LAS f32x4*)(pb_ + WK_KM + tt * 64 + 4 * jq) = km; *(LAS f32x4*)(pb_ + WK_NA + tt * 64 + 4 * jq) = -kk; \
        *(LAS f32x4*)(pb_ + WK_BB + tt * 64 + 4 * jq) = kk * a4; *(LAS f32x4*)(pb_ + WK_R + tt * 64 + 4 * jq) = r4; *(LAS f32x4*)(pb_ + WK_V + tt * 64 + 4 * jq) = v4; if (jq == 0) pb_[WK_BON + tt] = bon; } while (0)
    WK_ISSUE(0); WK_PREP(0); gcur = ld.g;
    LDS_WAIT(); __builtin_amdgcn_s_barrier(); asm volatile("" ::: "memory");
    constexpr int NB = TP / WK_TB;
    for (int n = 0; n < NB; ++n) {
        const int cur = n & 1; const LAS float* pb = L + cur * WK_PB;
        if (n + 1 < NB) WK_ISSUE(n + 1);
#pragma unroll 4
        for (int t = 0; t < WK_TB; ++t) {
            const f32x4 na = *(const LAS f32x4*)(pb + WK_NA + t * 64 + 4 * jq), w4 = *(const LAS f32x4*)(pb + WK_W + t * 64 + 4 * jq), bb = *(const LAS f32x4*)(pb + WK_BB + t * 64 + 4 * jq),
                        km = *(const LAS f32x4*)(pb + WK_KM + t * 64 + 4 * jq), r4 = *(const LAS f32x4*)(pb + WK_R + t * 64 + 4 * jq);
            const float v0 = pb[WK_V + t * 64 + 2 * rp], v1 = pb[WK_V + t * 64 + 2 * rp + 1];
            float sa0 = (S0[0] * na[0] + S0[1] * na[1]) + (S0[2] * na[2] + S0[3] * na[3]), sa1 = (S1[0] * na[0] + S1[1] * na[1]) + (S1[2] * na[2] + S1[3] * na[3]);
            sa0 = dpp_add(sa0, 0); sa1 = dpp_add(sa1, 0); sa0 = dpp_add(sa0, 1); sa1 = dpp_add(sa1, 1); sa0 = dpp_add(sa0, 2); sa1 = dpp_add(sa1, 2); sa0 = dpp_add(sa0, 3); sa1 = dpp_add(sa1, 3);
            S0 = S0 * w4 + (bb * sa0 + km * v0); S1 = S1 * w4 + (bb * sa1 + km * v1);
            float y0 = (S0[0] * r4[0] + S0[1] * r4[1]) + (S0[2] * r4[2] + S0[3] * r4[3]), y1 = (S1[0] * r4[0] + S1[1] * r4[1]) + (S1[2] * r4[2] + S1[3] * r4[3]);
            y0 = dpp_add(y0, 0); y1 = dpp_add(y1, 0); y0 = dpp_add(y0, 1); y1 = dpp_add(y1, 1); y0 = dpp_add(y0, 2); y1 = dpp_add(y1, 2); y0 = dpp_add(y0, 3); y1 = dpp_add(y1, 3);
            if (jq == 0) { L[WK_Y + t * 64 + 2 * rp] = y0; L[WK_Y + t * 64 + 2 * rp + 1] = y1; }
        }
        const uint2 gnext = ld.g;
        if (n + 1 < NB) WK_PREP(cur ^ 1);
        LDS_WAIT(); __builtin_amdgcn_s_barrier(); asm volatile("" ::: "memory");
        {
            const f32x4 y4 = *(const LAS f32x4*)(L + WK_Y + tt * 64 + 4 * jq), v4 = *(const LAS f32x4*)(pb + WK_V + tt * 64 + 4 * jq); const float bon = pb[WK_BON + tt];
            const float mean = red16((y4[0] + y4[1]) + (y4[2] + y4[3])) * (1.f / 64.f); const f32x4 dy = y4 - mean;
            const float var = red16((dy[0] * dy[0] + dy[1] * dy[1]) + (dy[2] * dy[2] + dy[3] * dy[3])) * (1.f / 64.f);
            const f32x4 yn = dy * rsqrtf(var + 64e-5f) * lg + lb + v4 * bon; const f32x4 o = yn * bf4(gcur);
            uint2 ov; ov.x = pk2(o[0], o[1]); ov.y = pk2(o[2], o[3]);
            *(uint2*)(GO + (tokb + (size_t)n * WK_TB + tt) * D + ch) = ov;
        }
        gcur = gnext;
        LDS_WAIT(); __builtin_amdgcn_s_barrier(); asm volatile("" ::: "memory");
    }
#undef WK_ISSUE
#undef WK_PREP
    float* so = s_out + (((size_t)b * 16 + h) * 64 + 2 * rp) * 64 + 4 * jq;
    *(f32x4*)so = S0; *(f32x4*)(so + 64) = S1;
}

constexpr int GL_BF = 0, GL_QI = 16384, GL_KI = 25600, GL_SC = 34816, GL_VT = 44032, GL_ST = 62464, GL_RS = 80896, GL_WG = 81920, GL_GKL = 86016, GL_SEG = 90112;
constexpr int GL_LD = 72;
DEVI bf16x8 gl_frag(LAS unsigned char* lds, int base, int row, int k0, int fq) { return *(const LAS bf16x8*)(lds + base + (row * GL_LD + k0 + 8 * fq) * 2); }
DEVI void gla_cumdecay(LAS unsigned char* lds, int tid, int h, size_t tok0, const float* GKL, const float* w_gk, const float* b_gk) {
    LAS float* BF = (LAS float*)(lds + GL_BF); LAS float* WG = (LAS float*)(lds + GL_WG); LAS float* GK = (LAS float*)(lds + GL_GKL); LAS float* SEG = (LAS float*)(lds + GL_SEG);
    for (int i = tid; i < 1024; i += 512) { WG[i] = w_gk[(i >> 6) * 256 + h * 64 + (i & 63)]; GK[i] = GKL[tok0 * 16 + i]; }
    LDS_WAIT(); __builtin_amdgcn_s_barrier(); asm volatile("" ::: "memory");
    { const int t = tid >> 3, d0 = (tid & 7) * 8; float x[8];
#pragma unroll
        for (int e = 0; e < 8; ++e) x[e] = b_gk[h * 64 + d0 + e];
#pragma unroll
        for (int r = 0; r < 16; ++r) { const float gv = GK[t * 16 + r]; const f32x4 w0 = *(const LAS f32x4*)(WG + r * 64 + d0), w1 = *(const LAS f32x4*)(WG + r * 64 + d0 + 4);
#pragma unroll
            for (int e = 0; e < 4; ++e) { x[e] += gv * w0[e]; x[4 + e] += gv * w1[e]; } }
#pragma unroll
        for (int e = 0; e < 8; ++e) { const float xx = x[e]; x[e] = (fminf(xx, 0.f) - log1pf(__expf(-fabsf(xx)))) * (1.f / 16.f); }
        *(LAS f32x4*)(BF + t * 64 + d0) = (f32x4){x[0], x[1], x[2], x[3]}; *(LAS f32x4*)(BF + t * 64 + d0 + 4) = (f32x4){x[4], x[5], x[6], x[7]}; }
    LDS_WAIT(); __builtin_amdgcn_s_barrier(); asm volatile("" ::: "memory");
    { const int dk = tid & 63, sg = tid >> 6; float a = 0.f;
#pragma unroll
        for (int i = 0; i < 8; ++i) { a += BF[(sg * 8 + i) * 64 + dk]; BF[(sg * 8 + i) * 64 + dk] = a; }
        SEG[sg * 64 + dk] = a; }
    LDS_WAIT(); __builtin_amdgcn_s_barrier(); asm volatile("" ::: "memory");
    { const int dk = tid & 63, sg = tid >> 6; float off = 0.f;
        for (int s = 0; s < sg; ++s) off += SEG[s * 64 + dk];
#pragma unroll
        for (int i = 0; i < 8; ++i) BF[(sg * 8 + i) * 64 + dk] += off; }
    LDS_WAIT(); __builtin_amdgcn_s_barrier(); asm volatile("" ::: "memory");
}
DEVI void gla_stage_vt(LAS unsigned char* lds, int tid, int h, size_t tok0, const bf16* P) {
    const int t = tid >> 3, dv0 = (tid & 7) * 16; const bf16* vp = P + (tok0 + t) * NINP + 512 + h * 128 + dv0;
    const v4u a = *(const v4u*)vp, b = *(const v4u*)(vp + 8); LAS bf16* VT = (LAS bf16*)(lds + GL_VT);
    const unsigned w[8] = {a.x, a.y, a.z, a.w, b.x, b.y, b.z, b.w};
#pragma unroll
    for (int e = 0; e < 8; ++e) { VT[(dv0 + 2 * e) * GL_LD + t] = (bf16)(w[e] & 0xffffu); VT[(dv0 + 2 * e + 1) * GL_LD + t] = (bf16)(w[e] >> 16); }
}
DEVI void gla_unit_a(LAS unsigned char* lds, int tid, int u, const bf16* P, const float* GKL, const float* w_gk, const float* b_gk, float* KV, float* DEC) {
    const int bh = u >> 5, ck = u & 31, b = bh >> 2, h = bh & 3; const size_t tok0 = (size_t)b * TP + ck * 64;
    const int lane = tid & 63, wave = tid >> 6, fr = lane & 15, fq = lane >> 4;
    gla_cumdecay(lds, tid, h, tok0, GKL, w_gk, b_gk);
    LAS float* BF = (LAS float*)(lds + GL_BF);
    { const int t = tid >> 3, d0 = (tid & 7) * 8; const v4u kq = *(const v4u*)(P + (tok0 + t) * NINP + 256 + h * 64 + d0); LAS bf16* KST = (LAS bf16*)(lds + GL_QI);
        const unsigned w[4] = {kq.x, kq.y, kq.z, kq.w};
#pragma unroll
        for (int e = 0; e < 8; ++e) { const float kv = __uint_as_float((e & 1) ? (w[e >> 1] & 0xffff0000u) : (w[e >> 1] << 16)); const float sc = __expf(BF[63 * 64 + d0 + e] - BF[t * 64 + d0 + e]);
            KST[(d0 + e) * GL_LD + t] = (bf16)f2bf(kv * sc); } }
    gla_stage_vt(lds, tid, h, tok0, P);
    if (tid < 64) DEC[(size_t)u * 64 + tid] = __expf(BF[63 * 64 + tid]);
    LDS_WAIT(); __builtin_amdgcn_s_barrier(); asm volatile("" ::: "memory");
#pragma unroll
    for (int dt = 0; dt < 4; ++dt) { f32x4 acc = {0.f, 0.f, 0.f, 0.f};
#pragma unroll
        for (int k0 = 0; k0 < 64; k0 += 32) acc = __builtin_amdgcn_mfma_f32_16x16x32_bf16(gl_frag(lds, GL_VT, wave * 16 + fr, k0, fq), gl_frag(lds, GL_QI, dt * 16 + fr, k0, fq), acc, 0, 0, 0);
        *(f32x4*)(KV + ((size_t)u * 64 + dt * 16 + fr) * 128 + wave * 16 + 4 * fq) = acc; }
    LDS_WAIT(); __builtin_amdgcn_s_barrier(); asm volatile("" ::: "memory");
}
DEVI void gla_scan_b(int gtid, float* KV, const float* DEC, float* s_out) {
    const int dv = gtid & 127, dkq = (gtid >> 7) & 15, bh = gtid >> 11; float S[4] = {0.f, 0.f, 0.f, 0.f};
#pragma unroll 4
    for (int c = 0; c < 32; ++c) { const size_t u = (size_t)bh * 32 + c; float* kp = KV + (u * 64 + dkq * 4) * 128 + dv;
#pragma unroll
        for (int e = 0; e < 4; ++e) { const float kv = kp[e * 128], dc = DEC[u * 64 + dkq * 4 + e]; kp[e * 128] = S[e]; S[e] = dc * S[e] + kv; } }
#pragma unroll
    for (int e = 0; e < 4; ++e) s_out[((size_t)bh * 64 + dkq * 4 + e) * 128 + dv] = S[e];
}
DEVI void gla_unit_c(LAS unsigned char* lds, int tid, int u, const bf16* P, const float* GKL, const float* w_gk, const float* b_gk, const float* KV, const float* norm_g, bf16* O) {
    const int bh = u >> 5, ck = u & 31, b = bh >> 2, h = bh & 3; const size_t tok0 = (size_t)b * TP + ck * 64;
    const int lane = tid & 63, wave = tid >> 6, fr = lane & 15, fq = lane >> 4;
    gla_cumdecay(lds, tid, h, tok0, GKL, w_gk, b_gk);
    LAS float* BF = (LAS float*)(lds + GL_BF);
    { const int t = tid >> 3, d0 = (tid & 7) * 8; const v4u qq = *(const v4u*)(P + (tok0 + t) * NINP + h * 64 + d0), kq = *(const v4u*)(P + (tok0 + t) * NINP + 256 + h * 64 + d0);
        const unsigned wq[4] = {qq.x, qq.y, qq.z, qq.w}, wk[4] = {kq.x, kq.y, kq.z, kq.w}; float qo[8], ko[8];
#pragma unroll
        for (int e = 0; e < 8; ++e) { const float qv = __uint_as_float((e & 1) ? (wq[e >> 1] & 0xffff0000u) : (wq[e >> 1] << 16)), kv = __uint_as_float((e & 1) ? (wk[e >> 1] & 0xffff0000u) : (wk[e >> 1] << 16));
            const float bb = BF[t * 64 + d0 + e]; qo[e] = qv * 0.125f * __expf(bb); ko[e] = kv * __expf(-bb); }
        v4u a, c; a.x = pk2(qo[0], qo[1]); a.y = pk2(qo[2], qo[3]); a.z = pk2(qo[4], qo[5]); a.w = pk2(qo[6], qo[7]); c.x = pk2(ko[0], ko[1]); c.y = pk2(ko[2], ko[3]); c.z = pk2(ko[4], ko[5]); c.w = pk2(ko[6], ko[7]);
        *(LAS v4u*)(lds + GL_QI + (t * GL_LD + d0) * 2) = a; *(LAS v4u*)(lds + GL_KI + (t * GL_LD + d0) * 2) = c; }
    gla_stage_vt(lds, tid, h, tok0, P);
    { const int dk = tid >> 3, dv0 = (tid & 7) * 16; const float* sp = KV + ((size_t)u * 64 + dk) * 128 + dv0; LAS bf16* ST = (LAS bf16*)(lds + GL_ST);
#pragma unroll
        for (int q = 0; q < 4; ++q) { const f32x4 s4 = *(const f32x4*)(sp + 4 * q);
#pragma unroll
            for (int e = 0; e < 4; ++e) ST[(dv0 + 4 * q + e) * GL_LD + dk] = (bf16)f2bf(s4[e]); } }
    LDS_WAIT(); __builtin_amdgcn_s_barrier(); asm volatile("" ::: "memory");
#pragma unroll
    for (int q = 0; q < 2; ++q) { const int id = wave * 2 + q, tt = id >> 2, st = id & 3; f32x4 acc = {0.f, 0.f, 0.f, 0.f};
#pragma unroll
        for (int k0 = 0; k0 < 64; k0 += 32) acc = __builtin_amdgcn_mfma_f32_16x16x32_bf16(gl_frag(lds, GL_KI, st * 16 + fr, k0, fq), gl_frag(lds, GL_QI, tt * 16 + fr, k0, fq), acc, 0, 0, 0);
        const int t = tt * 16 + fr, s0 = st * 16 + 4 * fq;
#pragma unroll
        for (int e = 0; e < 4; ++e) if (s0 + e > t) acc[e] = 0.f;
        *(LAS unsigned long long*)(lds + GL_SC + (t * GL_LD + s0) * 2) = (unsigned long long)pk2(acc[0], acc[1]) | ((unsigned long long)pk2(acc[2], acc[3]) << 32); }
    LDS_WAIT(); __builtin_amdgcn_s_barrier(); asm volatile("" ::: "memory");
    const int tt = wave & 3, hv = wave >> 2; f32x4 o[4]; float ssq = 0.f;
#pragma unroll
    for (int dt = 0; dt < 4; ++dt) { f32x4 acc = {0.f, 0.f, 0.f, 0.f}; const int dvr = (hv * 4 + dt) * 16 + fr;
#pragma unroll
        for (int k0 = 0; k0 < 64; k0 += 32) { acc = __builtin_amdgcn_mfma_f32_16x16x32_bf16(gl_frag(lds, GL_VT, dvr, k0, fq), gl_frag(lds, GL_SC, tt * 16 + fr, k0, fq), acc, 0, 0, 0);
            acc = __builtin_amdgcn_mfma_f32_16x16x32_bf16(gl_frag(lds, GL_ST, dvr, k0, fq), gl_frag(lds, GL_QI, tt * 16 + fr, k0, fq), acc, 0, 0, 0); }
        o[dt] = acc; ssq += (acc[0] * acc[0] + acc[1] * acc[1]) + (acc[2] * acc[2] + acc[3] * acc[3]); }
    ssq += __shfl_xor(ssq, 16); ssq += __shfl_xor(ssq, 32);
    LAS float* RS = (LAS float*)(lds + GL_RS);
    if (fq == 0) RS[hv * 64 + tt * 16 + fr] = ssq;
    LDS_WAIT(); __builtin_amdgcn_s_barrier(); asm volatile("" ::: "memory");
    { const int t = tt * 16 + fr; const float rstd = rsqrtf((RS[t] + RS[64 + t]) * (1.f / 128.f) + 1e-5f); const size_t tok = tok0 + t;
#pragma unroll
        for (int dt = 0; dt < 4; ++dt) { const int dv = (hv * 4 + dt) * 16 + 4 * fq; const uint2 gg = *(const uint2*)(P + tok * NINP + 1024 + h * 128 + dv); const f32x4 ng = *(const f32x4*)(norm_g + dv);
            const float g0 = __uint_as_float(gg.x << 16), g1 = __uint_as_float(gg.x & 0xffff0000u), g2 = __uint_as_float(gg.y << 16), g3 = __uint_as_float(gg.y & 0xffff0000u);
            uint2 ov; ov.x = pk2(o[dt][0] * rstd * ng[0] * siluf_(g0), o[dt][1] * rstd * ng[1] * siluf_(g1)); ov.y = pk2(o[dt][2] * rstd * ng[2] * siluf_(g2), o[dt][3] * rstd * ng[3] * siluf_(g3));
            *(uint2*)(O + tok * D + h * 128 + dv) = ov; } }
    LDS_WAIT(); __builtin_amdgcn_s_barrier(); asm volatile("" ::: "memory");
}

__global__ void __launch_bounds__(NWAVES * 64, 2) mk_fwd(Args args) {
    extern __shared__ __attribute__((aligned(16))) unsigned char lds_raw[];
    LAS unsigned char* lds = (LAS unsigned char*)lds_raw;
    volatile LAS unsigned* MISC = (volatile LAS unsigned*)(lds + MISC_OFF);
    const int tid = threadIdx.x, lane = tid & 63, wave = __builtin_amdgcn_readfirstlane(tid >> 6), G = gridDim.x, blk = blockIdx.x;
#define LW() ({ unsigned char* p_ = args.ws; asm volatile("" : "+s"(p_)); p_; })
#define LO() ({ float* p_ = args.out; asm volatile("" : "+s"(p_)); p_; })
#define PTRS unsigned char* ws = LW(); float* out = LO(); float* MODS = (float*)(ws + WS_MODS); float* SP = (float*)(ws + WS_SP); bf16* H = (bf16*)(ws + WS_H); float* Z = (float*)(ws + WS_Z); bf16* ACT = (bf16*)(ws + WS_ACT); float* X = out; \
    (void)MODS; (void)SP; (void)H; (void)Z; (void)ACT; (void)X
    for (int u = tid; u < (LDS_BYTES - LDSCTL_OFF) / 4; u += NWAVES * 64) ((LAS unsigned*)(lds + LDSCTL_OFF))[u] = 0u;
    __syncthreads();
    { XcdBarrier b0_ = xcd_barrier_post((unsigned*)(LW() + WS_CTL) + CW_BAR, MISC + 8); (void)b0_; }
#define GRID_BAR() do { XcdBarrier b_; b_.bar = (unsigned*)(LW() + WS_CTL) + CW_BAR; b_.x = xb_xcc_id(); b_.st = MISC + 8; xcd_barrier(b_); } while (0)
    const int gw = blk * NWAVES + wave, NGW = G * NWAVES;
    const int gws = wave * G + blk;
    LAS float* wscr = (LAS float*)(lds + RING_OFF + wave * 16384);

    { PTRS;
        constexpr int I_UP = (D / 64) * (NUP / 32), I_DN = (FFP / 64) * (D / 32), I_IN = (D / 64) * (NINP / 32), I_GLU = (512 / 64) * (512 / 32), I_SQ = (D / 64) * (D / 32), I_RK = (KRK / 64) * (NRK / 32), I_L2 = (NL1 / 64) * (3072 / 32);
        constexpr int NITEMS = 4 * I_UP + 4 * I_DN + I_IN + I_GLU + 2 * I_SQ + I_RK + I_L2;
        for (int it = gw; it < NITEMS; it += NGW) {
            int r = it;
            if (r < 4 * I_UP) { const int q = r / I_UP, l = q >> 1, f = q & 1; r -= q * I_UP;
                const int kb = r / (NUP / 32), nb = r % (NUP / 32), pn = nb >> 3, half = (nb >> 2) & 1, c0 = pn * 128 + (nb & 3) * 32;
                bf16* dst = (bf16*)(ws + (l ? WS_WUP_L1 : WS_WUP_L0) + f * SZ_WUP) + (size_t)(nb * 32) * D;
                if (c0 >= FF) { SrcZero s; cvt_item(s, dst, D, 1, wscr, kb, lane); }
                else if (half) { SrcPlain s{INPD(f ? 17 : 14) + (size_t)l * D * FF + c0, D, FF - c0, FF}; cvt_item(s, dst, D, 1, wscr, kb, lane); }
                else { SrcPlain s{INPD(f ? 16 : 13) + (size_t)l * D * FF + c0, D, FF - c0, FF}; cvt_item(s, dst, D, 1, wscr, kb, lane); }
                continue; } r -= 4 * I_UP;
            if (r < 4 * I_DN) { const int q = r / I_DN, l = q >> 1, f = q & 1; r -= q * I_DN;
                SrcPlain s{INPD(f ? 18 : 15) + (size_t)l * FF * D, FF, D, D};
                cvt_item(s, (bf16*)(ws + (l ? WS_WDN_L1 : WS_WDN_L0) + f * SZ_WDN), FFP, D / 32, wscr, r, lane); continue; } r -= 4 * I_DN;
            if (r < I_IN) { SrcPlain s{INPD(19), D, NIN, NIN}; cvt_item(s, (bf16*)(ws + WS_WIN), D, NINP / 32, wscr, r, lane); continue; } r -= I_IN;
            if (r < I_GLU) { SrcPlain s{INPD(32), 512, 512, 512}; cvt_item(s, (bf16*)(ws + WS_WGLU), 512, 512 / 32, wscr, r, lane); continue; } r -= I_GLU;
            if (r < I_SQ) { SrcPlain s{INPD(20), D, D, D}; cvt_item(s, (bf16*)(ws + WS_WOUT), D, D / 32, wscr, r, lane); continue; } r -= I_SQ;
            if (r < I_SQ) { SrcPlain s{INPD(38), D, D, D}; cvt_item(s, (bf16*)(ws + WS_WO), D, D / 32, wscr, r, lane); continue; } r -= I_SQ;
            if (r < I_RK) { const int kb = r / (NRK / 32), nb = r % (NRK / 32), n0 = nb * 32; bf16* dst = (bf16*)(ws + WS_WRK) + (size_t)n0 * KRK;
                if (n0 < 1024) { SrcFold s{INPD(35) + n0, INPD(34) + 0 * 1024, 1024}; cvt_item(s, dst, KRK, 1, wscr, kb, lane); }
                else if (n0 < 2048) { SrcFold s{INPD(36) + (n0 - 1024), INPD(34) + 2 * 1024, 1024}; cvt_item(s, dst, KRK, 1, wscr, kb, lane); }
                else if (n0 < 3072) { SrcFold s{INPD(37) + (n0 - 2048), INPD(34) + 3 * 1024, 1024}; cvt_item(s, dst, KRK, 1, wscr, kb, lane); }
                else if (n0 < 3136) { SrcFold s{INPD(40) + (n0 - 3072), INPD(34) + 1 * 1024, 64}; cvt_item(s, dst, KRK, 1, wscr, kb, lane); }
                else if (n0 < 3200) { SrcFold s{INPD(43) + (n0 - 3136), INPD(34) + 4 * 1024, 64}; cvt_item(s, dst, KRK, 1, wscr, kb, lane); }
                else if (n0 < 3360) { SrcFold s{INPD(45) + (n0 - 3200), INPD(34) + 5 * 1024, 160}; cvt_item(s, dst, KRK, 1, wscr, kb, lane); }
                else { SrcZero s; cvt_item(s, dst, KRK, 1, wscr, kb, lane); }
                continue; } r -= I_RK;
            { const int kb = r / (3072 / 32), nb = r % (3072 / 32), n0 = nb * 32; bf16* dst = (bf16*)(ws + WS_WL2) + (size_t)n0 * NL1;
                if (n0 < 1024) { SrcBlk s{INPD(41) + n0, 0, 64}; cvt_item(s, dst, NL1, 1, wscr, kb, lane); }
                else if (n0 < 2048) { SrcBlk s{INPD(44) + (n0 - 1024), 64, 128}; cvt_item(s, dst, NL1, 1, wscr, kb, lane); }
                else { SrcBlk s{INPD(46) + (n0 - 2048), 128, 288}; cvt_item(s, dst, NL1, 1, wscr, kb, lane); } }
        }
        __syncthreads();
        {
            const int vb = tid >> 8, t8 = tid & 255; LAS float* sc = (LAS float*)(lds + vb * 32768);
            for (int j0 = blk * 2; j0 < 1224; j0 += G * 2) { const int j = j0 + vb; const bool act = j < 1224;
                const int l = j / 612, rem = j % 612, ry = rem / 36, nx = rem % 36, r0 = ry * 8, n = nx * 256 + t8;
                __syncthreads();
                if (act) for (int i = t8; i < 8 * 1024; i += 256) { const int r = r0 + (i >> 10), k = i & 1023; const float v = r < 8 ? INP(7)[r * 1024 + k] : INP(8)[(r - 8) * 1024 + k]; sc[i] = siluf_(v); }
                __syncthreads();
                if (act) { float acc[8];
#pragma unroll
                    for (int q = 0; q < 8; ++q) acc[q] = 0.f;
                    const float* w = INP(9) + (size_t)l * 1024 * 9216 + n;
                    for (int k = 0; k < 1024; k += 4) { const float w0 = w[(size_t)k * 9216], w1 = w[(size_t)(k + 1) * 9216], w2 = w[(size_t)(k + 2) * 9216], w3 = w[(size_t)(k + 3) * 9216];
#pragma unroll
                        for (int q = 0; q < 8; ++q) { const f32x4 s4 = *(const LAS f32x4*)(sc + q * 1024 + k); acc[q] += s4[0] * w0 + s4[1] * w1 + s4[2] * w2 + s4[3] * w3; } }
                    const float bb = INP(10)[l * 9216 + n];
#pragma unroll
                    for (int q = 0; q < 8; ++q) MODS[((size_t)l * NMODROW + r0 + q) * 9216 + n] = acc[q] + bb; }
            }
            __syncthreads();
        }
        if (blk == G - 1) for (int i = tid; i < 2048; i += NWAVES * 64) s5prep_one(i, INP(24), INP(25), INP(26), INP(27), INP(28), SP);
        if (blk >= G - 5 && blk < G - 1) { const int i = (G - 2 - blk) * 512 + tid; s5prep_pw(i, INP(24), INP(25), INP(26), SP); }
    }
    GRID_BAR();
    { PTRS; for (int row = gw; row < MTP; row += NGW) init_row(row, lane, INP(0), INP(1), MODS, X, H);
        bf16* TM = (bf16*)(ws + WS_TM); bf16* HM = (bf16*)(ws + WS_HM);
        for (int j = gws; j < 32 * 17 + 32 * 16; j += NGW) { if (j < 544) s5_tm_job(j / 17, j % 17, lane, SP, INPD(29), INPD(30), INPD(31), TM); else s5_hm_job((j - 544) >> 4, (j - 544) & 15, lane, SP, HM); }
        for (int i = gw * 64 + lane; i < 32 * 128 * 256 / 8; i += NGW * 64) { const int g = i >> 12, r = i & 4095; *(v4u*)(HM + ((size_t)g * 256 + 128) * 256 + (size_t)r * 8) = (v4u){0u, 0u, 0u, 0u}; } }
    GRID_BAR();

#define GEMM_PHASE(EPI, Aptr, Bptr, NN, KK, ...) do { pg8::GemmX g_{(const pg8::bf16_t*)(Aptr), (const pg8::bf16_t*)(Bptr), MTP, NN, KK, KK, KK, -1}; pg8::StaticOrder S_; S_.init(MTP, NN, G, blk); pg8::EPI E_{__VA_ARGS__}; \
        pg8::gemm_phase<pg8::EPI, pg8::StaticOrder, true, true>(lds + RING_OFF, g_, S_, E_); } while (0)
#define GEMMX_PHASE(EPI, Aptr, Bptr, MM, NN, KK, LDA, LDB, GSH, ...) do { pg8::GemmX g_{(const pg8::bf16_t*)(Aptr), (const pg8::bf16_t*)(Bptr), MM, NN, KK, LDA, LDB, GSH}; pg8::StaticOrder S_; S_.init(MM, NN, G, blk); pg8::EPI E_{__VA_ARGS__}; \
        pg8::gemm_phase<pg8::EPI, pg8::StaticOrder, true, true>(lds + RING_OFF, g_, S_, E_); } while (0)
#define LN_PASS(l, idx, Hout, nsh, nsc) do { PTRS; for (int row = gw; row < MT; row += NGW) ln_row(row, lane, Z, INP(11) + ((l) * 3 + (idx)) * D, INP(12) + ((l) * 3 + (idx)) * D, X, Hout, nsh, nsc); } while (0)
#define FFN(l, f, which0, lnidx, HOUT, nshw, nscw) do { \
        { PTRS; GEMM_PHASE(EpiSwiglu, H, ws + ((l) ? WS_WUP_L1 : WS_WUP_L0) + (f) * SZ_WUP, NUP, D, (pg8::bf16_t*)ACT); } GRID_BAR(); \
        { PTRS; GEMM_PHASE(EpiResid, ACT, ws + ((l) ? WS_WDN_L1 : WS_WDN_L0) + (f) * SZ_WDN, D, FFP, X, Z, modp(MODS, l, (which0) + 2), 0.5f, 0); } GRID_BAR(); \
        LN_PASS(l, lnidx, HOUT, nshw, nscw); GRID_BAR(); } while (0)

    FFN(0, 0, 0, 0, H, modp(MODS, 0, 3), modp(MODS, 0, 4));
#define L0PTRS PTRS; bf16* P = (bf16*)(ws + WS_P); float* GKL = (float*)(ws + WS_GKL); float* OGS = (float*)(ws + WS_OGS) - (size_t)NP * 512; bf16* Z5 = (bf16*)(ws + WS_Z5); bf16* O = (bf16*)(ws + WS_O); \
        bf16* UB = (bf16*)(ws + WS_UBUF); float* HL = (float*)(ws + WS_HLOC); float* KV = (float*)(ws + WS_KV); float* DEC = (float*)(ws + WS_DEC); (void)P; (void)GKL; (void)OGS; (void)Z5; (void)O; (void)UB; (void)HL; (void)KV; (void)DEC
    { L0PTRS; GEMM_PHASE(EpiInproj, H, ws + WS_WIN, NINP, D, (pg8::bf16_t*)P, GKL, (pg8::bf16_t*)UB); } GRID_BAR();
    { L0PTRS;
        GEMMX_PHASE(EpiHloc, UB, ws + WS_HM, 32768, 256, 256, 384, 256, 2, HL);
        for (int u = (blk + 128) & 255; u < 1024; u += 256) gla_unit_a(lds + RING_OFF, tid, u, P, GKL, INPD(21), INPD(22), KV, DEC);
        for (int s = gws; s < 1536; s += NGW) {
            if (s < 1024) gla_job(wscr, lane, s >> 3, (s >> 1) & 3, s & 1, P, GKL, INPD(21), INPD(22), NP, 1, INPD(2), out + O_GLA_S, OGS);
            else { const int j = s - 1024; s5_job(wscr, lane, j & 31, (j >> 5) * 8, 8, P, SP, INPD(29), INPD(30), INPD(31), NP, 1, INPD(3), INPD(4), out + O_S5RE_S, out + O_S5IM_S, Z5); } }
    }
    GRID_BAR();
    { L0PTRS;
        if (gws < 256) s5_carry_job(gws >> 5, gws & 31, lane, SP, HL, UB, out + O_S5RE_P, out + O_S5IM_P);
        if (blk >= 128) gla_scan_b((blk - 128) * 512 + tid, KV, DEC, out + O_GLA_P);
    } GRID_BAR();
    { L0PTRS;
        GEMMX_PHASE(EpiS5Y, UB, ws + WS_TM, 32768, 256, 384, 384, 384, 2, (pg8::bf16_t*)Z5);
        for (int u = (blk + 128) & 255; u < 1024; u += 256) gla_unit_c(lds + RING_OFF, tid, u, P, GKL, INPD(21), INPD(22), KV, INPD(23), O);
        for (int w = NP * 4 + gw; w < MT * 4; w += NGW) gla_post_one(w, lane, OGS, P, INP(23), O); } GRID_BAR();
    { L0PTRS; GEMM_PHASE(EpiGlu, Z5, ws + WS_WGLU, 512, 512, (const pg8::bf16_t*)Z5, (pg8::bf16_t*)O, INP(33)); } GRID_BAR();
    { L0PTRS; GEMM_PHASE(EpiResid, O, ws + WS_WOUT, D, D, X, Z, modp(MODS, 0, 5), 1.0f, 0); } GRID_BAR();
    LN_PASS(0, 1, H, modp(MODS, 0, 6), modp(MODS, 0, 7)); GRID_BAR();
    FFN(0, 1, 6, 2, H, modp(MODS, 1, 0), modp(MODS, 1, 1));
    FFN(1, 0, 0, 0, (bf16*)nullptr, (const float*)nullptr, (const float*)nullptr);
#define L1PTRS PTRS; bf16* A2 = (bf16*)(ws + WS_A2); bf16* R = (bf16*)(ws + WS_R); bf16* Kb = (bf16*)(ws + WS_K); bf16* V = (bf16*)(ws + WS_V); bf16* L1 = (bf16*)(ws + WS_L1A); \
        float* WD = (float*)(ws + WS_WD); bf16* AS = (bf16*)(ws + WS_AS); bf16* Gt = (bf16*)(ws + WS_G); (void)A2; (void)R; (void)Kb; (void)V; (void)L1; (void)WD; (void)AS; (void)Gt
    { L1PTRS; for (int row = gw; row < MTP; row += NGW) shiftcat_row(row, lane, X, MODS, INP(5), A2, out); } GRID_BAR();
    { L1PTRS; GEMM_PHASE(EpiRk, A2, ws + WS_WRK, NRK, KRK, (pg8::bf16_t*)R, (size_t)MTP * D, (pg8::bf16_t*)L1); } GRID_BAR();
    { L1PTRS; GEMM_PHASE(EpiLora2, L1, ws + WS_WL2, 3072, NL1, WD, (pg8::bf16_t*)AS, (pg8::bf16_t*)Gt, INP(39), INP(42)); } GRID_BAR();
    { L1PTRS;
        if (blk < 128) wkv_chain((LAS float*)(lds + RING_OFF), tid, blk >> 4, blk & 15, R, Kb, V, WD, AS, Gt, INPD(47), INPD(48), INPD(49), INPD(50), INPD(51), out + O_WKV_P);
        else { const int sw = (blk - 128) * NWAVES + wave, nsw = (G - 128) * NWAVES;
            for (int s = sw; s < 2048; s += nsw) wkv_job(wscr, lane, s >> 4, s & 15, R, Kb, V, WD, AS, Gt, INPD(47), INPD(48), INPD(49), INPD(50), INPD(51), NP, 1, INPD(6), out + O_WKV_S); }
    }
    GRID_BAR();
    { L1PTRS; GEMM_PHASE(EpiResid, Gt, ws + WS_WO, D, D, X, Z, modp(MODS, 1, 5), 1.0f, 0); } GRID_BAR();
    LN_PASS(1, 1, H, modp(MODS, 1, 6), modp(MODS, 1, 7)); GRID_BAR();
    { PTRS; GEMM_PHASE(EpiSwiglu, H, ws + WS_WUP_L1 + SZ_WUP, NUP, D, (pg8::bf16_t*)ACT); } GRID_BAR();
    { PTRS; GEMM_PHASE(EpiResid, ACT, ws + WS_WDN_L1 + SZ_WDN, D, FFP, X, Z, modp(MODS, 1, 8), 0.5f, 0); } GRID_BAR();
    LN_PASS(1, 2, (bf16*)nullptr, (const float*)nullptr, (const float*)nullptr);
}

extern "C" void kernel_launch(void* const* d_in, const int* in_sizes, int n_in, void* d_out, int out_size, void* d_ws, size_t ws_size, hipStream_t stream) {
    static int grid = 0;
    if (grid == 0) {
        if (n_in != 52 || ws_size < WS_END) { fprintf(stderr, "kernel_launch: unexpected n_in %d or ws %zu\n", n_in, ws_size); grid = -1; return; }
        int dev = 0, cus = 0, per_cu = 0;
        if (hipGetDevice(&dev) != hipSuccess || hipDeviceGetAttribute(&cus, hipDeviceAttributeMultiprocessorCount, dev) != hipSuccess) { grid = -1; return; }
        if (hipFuncSetAttribute((const void*)mk_fwd, hipFuncAttributeMaxDynamicSharedMemorySize, LDS_BYTES) != hipSuccess) { fprintf(stderr, "hipFuncSetAttribute failed\n"); grid = -1; return; }
        if (hipOccupancyMaxActiveBlocksPerMultiprocessor(&per_cu, (const void*)mk_fwd, NWAVES * 64, LDS_BYTES) != hipSuccess || per_cu < 1) { fprintf(stderr, "occupancy query: %d\n", per_cu); per_cu = 1; }
        (void)hipGetLastError();
        grid = cus;
    }
    if (grid < 0) return;
    (void)hipMemsetAsync((char*)d_ws + WS_CTL, 0, CTL_ZERO_BYTES, stream);
    Args a{};
    for (int i = 0; i < 52; ++i) a.in[i] = (const float*)d_in[i];
    a.out = (float*)d_out; a.ws = (unsigned char*)d_ws;
    hipLaunchKernelGGL(mk_fwd, dim3(grid), dim3(NWAVES * 64), LDS_BYTES, stream, a);
}
```

```cpp
#include <hip/hip_runtime.h>
#include <cstdint>
#include <cstdio>

#ifndef PROBE
#define PROBE 0
#endif
#define XP 0
#define PROBE_A0 63
#define PROBE_A1 1
#define PROBE_B0 1
#define PROBE_B1 4
typedef unsigned short bf16;
typedef short bf16x8 __attribute__((ext_vector_type(8)));
typedef float f32x4 __attribute__((ext_vector_type(4)));
#define DEVI __device__ __forceinline__

constexpr int D = 1024, NP = 16384, NS = 128, MT = NP + NS, MTP = 16640, TP = 2048, BP = 8;
constexpr int FF = 2752, FFP = 2816, NUP = 2 * FFP;
constexpr int NIN = 2064, NINP = 2304;
constexpr int NRK = 3584, KRK = 2048, NL1 = 384;
constexpr int NMODROW = 136;
constexpr float ALPHA = 1.41421356237309515f;

constexpr size_t O_Y = 0, O_GLA_P = 16908288, O_S5RE_P = 17170432, O_S5IM_P = 17186816, O_SHIFT_P = 17203200, O_WKV_P = 17211392,
                 O_GLA_S = 17735680, O_S5RE_S = 21929984, O_S5IM_S = 22192128, O_SHIFT_S = 22454272, O_WKV_S = 22585344;

constexpr size_t MiB = 1u << 20;
constexpr size_t WS_CTL = 0, CTL_ZERO_BYTES = 1 * MiB;
constexpr size_t WS_MODS = 1 * MiB, WS_SP = 12 * MiB, WS_ST = 344 * MiB;
constexpr size_t WS_W = 13 * MiB;
constexpr size_t SZ_WUP = (size_t)NUP * D * 2;
constexpr size_t SZ_WDN = (size_t)D * FFP * 2;
constexpr size_t WS_L0 = WS_W;
constexpr size_t WS_WUP_L0 = WS_L0, WS_WDN_L0 = WS_L0 + 22 * MiB, WS_WIN = WS_L0 + 33 * MiB, WS_WGLU = WS_WIN + 4608 * 1024, WS_WOUT = WS_WGLU + 512 * 1024;
constexpr size_t WS_L1 = WS_L0 + 40 * MiB;
constexpr size_t WS_WUP_L1 = WS_L1, WS_WDN_L1 = WS_L1 + 22 * MiB, WS_WRK = WS_L1 + 33 * MiB, WS_WL2 = WS_WRK + 14 * MiB, WS_WO = WS_WL2 + 2304 * 1024;
static_assert(WS_WO + 2 * MiB <= 105 * MiB, "W region");
constexpr size_t WS_H = 105 * MiB, WS_Z = 138 * MiB, WS_ACT = 203 * MiB, WS_S2 = 293 * MiB, WS_END = 345 * MiB;
constexpr size_t WS_P = WS_ACT, WS_GKL = 277 * MiB, WS_Z5 = WS_Z, WS_O = WS_H, WS_DEC = 195 * MiB, WS_OGS = 196 * MiB, WS_KV = WS_S2;
constexpr size_t WS_UBUF = 155 * MiB, WS_HLOC = 179 * MiB, WS_HM = 326 * MiB, WS_TM = 330 * MiB;
constexpr size_t WS_A2 = WS_ACT, WS_K = WS_Z, WS_R = WS_Z - (size_t)MTP * D * 2, WS_V = WS_Z + (size_t)MTP * D * 2, WS_L1A = WS_L0, WS_WD = WS_ACT, WS_AS = 268 * MiB, WS_G = WS_AS + (size_t)MTP * D * 2;
static_assert(WS_G + (size_t)MTP * D * 2 <= WS_END, "ws");
constexpr int CW_TMO = 0, CW_BAR = 4096;

#define GAS __attribute__((address_space(1)))
#define LAS __attribute__((address_space(3)))
typedef unsigned short bf16;
typedef unsigned v4u __attribute__((ext_vector_type(4)));
typedef float f32x4 __attribute__((ext_vector_type(4)));
typedef short bf16x8 __attribute__((ext_vector_type(8)));
typedef GAS unsigned gu32;
typedef GAS unsigned long long gu64;
#define RLX_AGENT __ATOMIC_RELAXED, __HIP_MEMORY_SCOPE_AGENT
#define LDS_WAIT() asm volatile("s_waitcnt lgkmcnt(0)" ::: "memory")
#define VM_WAIT() asm volatile("s_waitcnt vmcnt(0)" ::: "memory")
__device__ __forceinline__ unsigned long long rt() { return __builtin_amdgcn_s_memrealtime(); }
__device__ __forceinline__ unsigned f2bf(float f) { unsigned u = __builtin_bit_cast(unsigned, f); return (u + 0x7fffu + ((u >> 16) & 1u)) >> 16; }
__device__ __forceinline__ unsigned pk2(float lo, float hi) { return f2bf(lo) | (f2bf(hi) << 16); }

#define XB_TMO      128
#define XB_XCNT(j)  (256  + 64 * (j))
#define XB_XSUB(j)  (1280 + 64 * (j))
#define XB_XGEN(j)  (2304 + 64 * (j))
#define XB_TOP      3328
#define XB_TOPGEN   3392
#define XCD_BAR_WORDS 3456
#define XB_SPIN_CAP (1u << 18)

__device__ __forceinline__ unsigned xb_ld(unsigned* p)              { return __hip_atomic_load(p, __ATOMIC_RELAXED, __HIP_MEMORY_SCOPE_AGENT); }
__device__ __forceinline__ unsigned xb_add(unsigned* p, unsigned v) { return __hip_atomic_fetch_add(p, v, __ATOMIC_RELAXED, __HIP_MEMORY_SCOPE_AGENT); }
__device__ __forceinline__ unsigned xb_xcc_id() { return (unsigned)__builtin_amdgcn_s_getreg((3 << 11) | 20) & 0xFu; }
#define XB_SPIN(cond, bar) do { unsigned _sp = 0; while (cond) { __builtin_amdgcn_s_sleep(1); \
    if ((++_sp & 255u) == 0u) { if (xb_ld(&(bar)[XB_TMO])) break; if (_sp > XB_SPIN_CAP) { atomicAdd(&(bar)[XB_TMO], 1u); break; } } } } while (0)

struct XcdBarrier {
    unsigned* bar; unsigned x;
    volatile LAS unsigned* st;
};

__device__ __forceinline__ XcdBarrier xcd_barrier_post(unsigned* bar, volatile LAS unsigned* st) {
    XcdBarrier b; b.bar = bar; b.x = xb_xcc_id(); b.st = st;
    if (threadIdx.x == 0) (void)xb_add(&bar[XB_XCNT(b.x)], 1u);
    return b;
}
__device__ __forceinline__ void xcd_barrier_complete(unsigned* bar, unsigned x, unsigned& nloc, unsigned& nx) {
    const unsigned G = gridDim.x * gridDim.y * gridDim.z;
    unsigned sum, cnt, mine, sp = 0u;
    for (;;) {
        sum = 0u; cnt = 0u; mine = 0u;
#pragma unroll
        for (unsigned j = 0; j < 16; ++j) { const unsigned c = xb_ld(&bar[XB_XCNT(j)]); sum += c; cnt += (c > 0u) ? 1u : 0u; mine = (j == x) ? c : mine; }
        if (sum == G) break;
        __builtin_amdgcn_s_sleep(1);
        if ((++sp & 255u) == 0u) { if (xb_ld(&bar[XB_TMO])) break; if (sp > XB_SPIN_CAP) { atomicAdd(&bar[XB_TMO], 1u); break; } }
    }
    nloc = mine > 0u ? mine : 1u; nx = cnt > 0u ? cnt : 1u;
}

__device__ __forceinline__ void xcd_barrier(const XcdBarrier& b) {
    asm volatile("s_waitcnt vmcnt(0)" ::: "memory");
    __syncthreads();
    if (threadIdx.x == 0) {
        unsigned* bar = b.bar;
        __builtin_amdgcn_s_waitcnt(0);
        unsigned nloc = b.st[0], nx = b.st[1];
        if (nloc == 0u) { xcd_barrier_complete(bar, b.x, nloc, nx); b.st[0] = nloc; b.st[1] = nx; }
        const unsigned old = xb_add(&bar[XB_XSUB(b.x)], 1u);
        const unsigned gen = old / nloc;
        if (old + 1u == (gen + 1u) * nloc) {
            __builtin_amdgcn_fence(__ATOMIC_RELEASE, "agent");
            asm volatile("s_waitcnt vmcnt(0)" ::: "memory");
            const unsigned og = xb_add(&bar[XB_TOP], 1u);
            const unsigned tg = og / nx;
            if (og + 1u == (tg + 1u) * nx) xb_add(&bar[XB_TOPGEN], 1u);
            else XB_SPIN(xb_ld(&bar[XB_TOPGEN]) == tg, bar);
            __builtin_amdgcn_fence(__ATOMIC_ACQUIRE, "agent");
            xb_add(&bar[XB_XGEN(b.x)], 1u);
            asm volatile("s_waitcnt vmcnt(0)" ::: "memory");
        } else {
            XB_SPIN(xb_ld(&bar[XB_XGEN(b.x)]) == gen, bar);
            __builtin_amdgcn_fence(__ATOMIC_ACQUIRE, "agent");
            asm volatile("s_waitcnt vmcnt(0)" ::: "memory");
        }
    }
    __syncthreads();
}

DEVI float bf2f(unsigned short h) { return __uint_as_float(((unsigned)h) << 16); }
DEVI int mrow(int i) { return i < NP ? (i >> 11) : (8 + i - NP); }
DEVI float sigmoidf_(float x) { return 1.0f / (1.0f + __expf(-x)); }
DEVI float siluf_(float x) { return x / (1.0f + __expf(-x)); }
DEVI float softplusf_(float x) { return fmaxf(x, 0.f) + log1pf(__expf(-fabsf(x))); }
DEVI float gelu_tanh(float x) { const float u = 0.7978845608028654f * (x + 0.044715f * x * x * x); return 0.5f * x * (1.0f + tanhf(u)); }
DEVI float wave_sum(float v) {
#pragma unroll
    for (int o = 1; o < 64; o <<= 1) v += __shfl_xor(v, o);
    return v;
}
__host__ __device__ __forceinline__ const float* modp(const float* mods, int l, int which) { return mods + (size_t)l * NMODROW * 9216 + which * 1024; }

namespace pg8 {
#define PG8_LAS __attribute__((address_space(3)))
typedef unsigned short bf16_t;
typedef short bf16x8 __attribute__((ext_vector_type(8)));
typedef float f32x4 __attribute__((ext_vector_type(4)));
typedef unsigned u32x4 __attribute__((ext_vector_type(4)));
constexpr int BM = 256, BK = 64, HALF = 128, HTB = HALF * BK * 2  , STAGE_BYTES = 8 * HTB, NXCD = 8, WGM = 8;

__host__ __device__ __forceinline__ int lds_byte(int r, int c) { const int st = (r >> 4) * 2 + (c >> 5), rr = r & 15, cc = c & 31, ob = rr * 64 + cc * 2; return st * 1024 + (ob ^ (((ob >> 9) & 1) << 5)); }
__host__ __device__ __forceinline__ void stage_rc(int b, int& R, int& C) { const int st = b / 1024, sb = b % 1024, swz = sb ^ (((sb >> 9) & 1) << 5); R = (st >> 1) * 16 + swz / 64; C = (st & 1) * 32 + (swz % 64) / 2; }
__host__ __device__ __forceinline__ int perm32(int rho) { const int n = rho >> 4, i = rho & 15; return 8 * (i >> 2) + 4 * n + (i & 3); }

struct Unit { int pm, pn; };
struct Gemm { const bf16_t* A; const bf16_t* Bt; int M, N, K; };
struct GemmX { const bf16_t* A; const bf16_t* Bt; int M, N, K, lda, ldb, gsh; };

struct StaticOrder {
    int nM, nN, nwg, G, c;
    __host__ __device__ void init(int M, int N, int G_, int c_) { nM = M / BM; nN = N / BM; nwg = nM * nN; G = G_; c = c_; }
    __host__ __device__ bool next(int i, Unit& u) const {
        const long L = (long)i * G + c; if (L >= nwg) return false;
        int wgid = (int)L; { const int q = nwg / NXCD, r = nwg % NXCD, xcd = wgid % NXCD, off = wgid / NXCD; wgid = (xcd < r ? xcd * (q + 1) : r * (q + 1) + (xcd - r) * q) + off; }
        const int nig = WGM * nN, gid = wgid / nig, fm = gid * WGM, gsz = (nM - fm) < WGM ? (nM - fm) : WGM;
        u.pm = fm + ((wgid % nig) % gsz); u.pn = (wgid % nig) / gsz; return true;
    }
    __device__ __forceinline__ void a_ready(const Unit&) const {}
    __device__ __forceinline__ void done(const Unit&) const {}
};


__device__ __forceinline__ unsigned cvt_pk_bf16(float lo, float hi) { unsigned r; asm volatile("v_cvt_pk_bf16_f32 %0, %1, %2" : "=v"(r) : "v"(lo), "v"(hi)); return r; }
__device__ __forceinline__ float fsilu(float x) { return x * __builtin_amdgcn_rcpf(1.0f + __builtin_amdgcn_exp2f(-1.44269504089f * x)); }
__device__ __forceinline__ float fsigm(float x) { return __builtin_amdgcn_rcpf(1.0f + __builtin_amdgcn_exp2f(-1.44269504089f * x)); }
__device__ __forceinline__ u32x4 pack8(const f32x4 a, const f32x4 b) { u32x4 w; w.x = cvt_pk_bf16(a[0], a[1]); w.y = cvt_pk_bf16(a[2], a[3]); w.z = cvt_pk_bf16(b[0], b[1]); w.w = cvt_pk_bf16(b[2], b[3]); return w; }
struct EpiSwiglu { static constexpr bool PERM = true, AFTER_DRAIN = false; bf16_t* ACT;
    __device__ __forceinline__ void operator()(const f32x4 (&acc)[2][2][4][2], const Unit& u, int wr, int wc, int fr, int fq) const {
        const int row0 = u.pm * BM + wr * 64 + fr, col0 = u.pn * 128 + wc * 32 + 8 * fq;
#pragma unroll
        for (int ai = 0; ai < 2; ++ai)
#pragma unroll
            for (int m = 0; m < 4; ++m) { f32x4 o0, o1;
#pragma unroll
                for (int e = 0; e < 4; ++e) { o0[e] = fsilu(acc[ai][0][m][0][e]) * acc[ai][1][m][0][e]; o1[e] = fsilu(acc[ai][0][m][1][e]) * acc[ai][1][m][1][e]; }
                *(u32x4*)(ACT + (size_t)(row0 + ai * HALF + m * 16) * 2816 + col0) = pack8(o0, o1); }
    } };
struct EpiResid { static constexpr bool PERM = true, AFTER_DRAIN = false; const float* X; float* Z; const float* gate; float rc; int pad;
    __device__ __forceinline__ void operator()(const f32x4 (&acc)[2][2][4][2], const Unit& u, int wr, int wc, int fr, int fq) const {
        const int row0 = u.pm * BM + wr * 64 + fr;
#pragma unroll
        for (int ai = 0; ai < 2; ++ai) { if (u.pm == 64 && ai == 1) break;
#pragma unroll
            for (int m = 0; m < 4; ++m) { const int row = row0 + ai * HALF + m * 16; const int mr = row < 16384 ? (row >> 11) : (8 + row - 16384);
#pragma unroll
                for (int bj = 0; bj < 2; ++bj)
#pragma unroll
                    for (int n = 0; n < 2; ++n) { const int c = u.pn * BM + bj * HALF + wc * 32 + 8 * fq + 4 * n;
                        const f32x4 x = *(const f32x4*)(X + (size_t)row * 1024 + c), g = *(const f32x4*)(gate + (size_t)mr * 9216 + c);
                        *(f32x4*)(Z + (size_t)row * 1024 + c) = x * 1.41421356237309515f + (g + 1.0f) * rc * acc[ai][bj][m][n]; } } }
    } };
struct EpiInproj { static constexpr bool PERM = true, AFTER_DRAIN = false; bf16_t* P; float* GKL; bf16_t* UB;
    __device__ __forceinline__ void operator()(const f32x4 (&acc)[2][2][4][2], const Unit& u, int wr, int wc, int fr, int fq) const {
        const int row0 = u.pm * BM + wr * 64 + fr;
#pragma unroll
        for (int ai = 0; ai < 2; ++ai)
#pragma unroll
            for (int m = 0; m < 4; ++m) { const int row = row0 + ai * HALF + m * 16;
#pragma unroll
                for (int bj = 0; bj < 2; ++bj) { const int c = u.pn * BM + bj * HALF + wc * 32 + 8 * fq;
                    const u32x4 pk = pack8(acc[ai][bj][m][0], acc[ai][bj][m][1]);
                    *(u32x4*)(P + (size_t)row * 2304 + c) = pk;
                    if (c >= 1552 && c < 2064 && row < 16384) { const int cu = c - 1552; *(u32x4*)(UB + ((size_t)((cu >> 4) * 1024 + (row >> 4))) * 384 + (row & 15) * 16 + (cu & 15)) = pk; }
                    if (c >= 1536 && c < 1552) { *(f32x4*)(GKL + (size_t)row * 16 + (c - 1536)) = acc[ai][bj][m][0]; *(f32x4*)(GKL + (size_t)row * 16 + (c - 1536) + 4) = acc[ai][bj][m][1]; } } }
    } };
struct EpiGlu { static constexpr bool PERM = true, AFTER_DRAIN = false; const bf16_t* Z5; bf16_t* O; const float* bg;
    __device__ __forceinline__ void operator()(const f32x4 (&acc)[2][2][4][2], const Unit& u, int wr, int wc, int fr, int fq) const {
        const int row0 = u.pm * BM + wr * 64 + fr;
#pragma unroll
        for (int ai = 0; ai < 2; ++ai)
#pragma unroll
            for (int m = 0; m < 4; ++m) { const int row = row0 + ai * HALF + m * 16;
#pragma unroll
                for (int bj = 0; bj < 2; ++bj) { const int c = u.pn * BM + bj * HALF + wc * 32 + 8 * fq;
                    const u32x4 zz = *(const u32x4*)(Z5 + (size_t)row * 512 + c); const f32x4 b0 = *(const f32x4*)(bg + c), b1 = *(const f32x4*)(bg + c + 4);
                    f32x4 o0, o1;
#pragma unroll
                    for (int e = 0; e < 4; ++e) { const unsigned w0 = zz[e >> 1], w1 = zz[2 + (e >> 1)];
                        const float z0 = __uint_as_float((e & 1) ? (w0 & 0xffff0000u) : (w0 << 16)), z1 = __uint_as_float((e & 1) ? (w1 & 0xffff0000u) : (w1 << 16));
                        o0[e] = z0 * fsigm(acc[ai][bj][m][0][e] + b0[e]); o1[e] = z1 * fsigm(acc[ai][bj][m][1][e] + b1[e]); }
                    *(u32x4*)(O + (size_t)row * 1024 + 512 + c) = pack8(o0, o1); } }
    } };
__device__ __forceinline__ float ftanh(float x) { const float e = __builtin_amdgcn_exp2f(-2.88539008178f * fabsf(x)); const float t = (1.0f - e) * __builtin_amdgcn_rcpf(1.0f + e); return x < 0.f ? -t : t; }
struct EpiRk { static constexpr bool PERM = true, AFTER_DRAIN = false; bf16_t* R; size_t rkv_stride; bf16_t* L1;
    __device__ __forceinline__ void operator()(const f32x4 (&acc)[2][2][4][2], const Unit& u, int wr, int wc, int fr, int fq) const {
        const int row0 = u.pm * BM + wr * 64 + fr;
#pragma unroll
        for (int ai = 0; ai < 2; ++ai)
#pragma unroll
            for (int m = 0; m < 4; ++m) { const int row = row0 + ai * HALF + m * 16;
#pragma unroll
                for (int bj = 0; bj < 2; ++bj) { const int c = u.pn * BM + bj * HALF + wc * 32 + 8 * fq;
                    if (c < 3072) { bf16_t* dst = R + (size_t)(c >> 10) * rkv_stride; *(u32x4*)(dst + (size_t)row * 1024 + (c & 1023)) = pack8(acc[ai][bj][m][0], acc[ai][bj][m][1]); }
                    else { const int cc = c - 3072; if (cc < 384) { f32x4 o0 = acc[ai][bj][m][0], o1 = acc[ai][bj][m][1];
                        if (cc < 64) {
#pragma unroll
                            for (int e = 0; e < 4; ++e) { o0[e] = ftanh(o0[e]); o1[e] = ftanh(o1[e]); } }
                        else if (cc >= 128 && cc < 288) {
#pragma unroll
                            for (int e = 0; e < 4; ++e) { o0[e] = fsigm(o0[e]); o1[e] = fsigm(o1[e]); } }
                        else if (cc >= 288) { o0 = (f32x4){0.f, 0.f, 0.f, 0.f}; o1 = o0; }
                        *(u32x4*)(L1 + (size_t)row * 384 + cc) = pack8(o0, o1); } } } }
    } };
struct EpiLora2 { static constexpr bool PERM = true, AFTER_DRAIN = false; float* WD; bf16_t* AS; bf16_t* G; const float* w0; const float* a0;
    __device__ __forceinline__ void operator()(const f32x4 (&acc)[2][2][4][2], const Unit& u, int wr, int wc, int fr, int fq) const {
        const int row0 = u.pm * BM + wr * 64 + fr;
#pragma unroll
        for (int ai = 0; ai < 2; ++ai)
#pragma unroll
            for (int m = 0; m < 4; ++m) { const int row = row0 + ai * HALF + m * 16;
#pragma unroll
                for (int bj = 0; bj < 2; ++bj) { const int c = u.pn * BM + bj * HALF + wc * 32 + 8 * fq;
                    if (c < 1024) {
#pragma unroll
                        for (int n = 0; n < 2; ++n) { const f32x4 wv = *(const f32x4*)(w0 + c + 4 * n); f32x4 o;
#pragma unroll
                            for (int e = 0; e < 4; ++e) { const float x = -(wv[e] + acc[ai][bj][m][n][e]); const float sp = fmaxf(x, 0.f) + 0.69314718056f * __builtin_amdgcn_logf(1.0f + __builtin_amdgcn_exp2f(-1.44269504089f * fabsf(x)));
                                const float ee = __builtin_amdgcn_exp2f(-1.44269504089f * (sp + 0.5f)); o[e] = __builtin_amdgcn_exp2f(-1.44269504089f * ee); }
                            *(f32x4*)(WD + (size_t)row * 1024 + c + 4 * n) = o; } }
                    else if (c < 2048) { const f32x4 a0v = *(const f32x4*)(a0 + c - 1024), a1v = *(const f32x4*)(a0 + c - 1024 + 4); f32x4 o0, o1;
#pragma unroll
                        for (int e = 0; e < 4; ++e) { o0[e] = fsigm(a0v[e] + acc[ai][bj][m][0][e]); o1[e] = fsigm(a1v[e] + acc[ai][bj][m][1][e]); }
                        *(u32x4*)(AS + (size_t)row * 1024 + c - 1024) = pack8(o0, o1); }
                    else *(u32x4*)(G + (size_t)row * 1024 + c - 2048) = pack8(acc[ai][bj][m][0], acc[ai][bj][m][1]); } }
    } };

struct EpiHloc { static constexpr bool PERM = true, AFTER_DRAIN = false; float* HL;
    __device__ __forceinline__ void operator()(const f32x4 (&acc)[2][2][4][2], const Unit& u, int wr, int wc, int fr, int fq) const {
        const int row0 = u.pm * BM + wr * 64 + fr, c = wc * 32 + 8 * fq;
#pragma unroll
        for (int ai = 0; ai < 2; ++ai)
#pragma unroll
            for (int m = 0; m < 4; ++m) { float* p = HL + (size_t)(row0 + ai * HALF + m * 16) * 128 + c; *(f32x4*)p = acc[ai][0][m][0]; *(f32x4*)(p + 4) = acc[ai][0][m][1]; }
    } };
__device__ __forceinline__ float fgelu(float x) { const float u2 = 1.5957691216057308f * (x + 0.044715f * x * x * x); return x * fsigm(u2); }
struct EpiS5Y { static constexpr bool PERM = true, AFTER_DRAIN = false; bf16_t* Z5;
    __device__ __forceinline__ void operator()(const f32x4 (&acc)[2][2][4][2], const Unit& u, int wr, int wc, int fr, int fq) const {
        const int row0 = u.pm * BM + wr * 64 + fr;
#pragma unroll
        for (int ai = 0; ai < 2; ++ai)
#pragma unroll
            for (int m = 0; m < 4; ++m) { const int row = row0 + ai * HALF + m * 16, g = row >> 10, chunk = row & 1023;
#pragma unroll
                for (int bj = 0; bj < 2; ++bj) { const int c = bj * HALF + wc * 32 + 8 * fq, t = c >> 4, co = c & 15; f32x4 o0, o1;
#pragma unroll
                    for (int e = 0; e < 4; ++e) { o0[e] = fgelu(acc[ai][bj][m][0][e]); o1[e] = fgelu(acc[ai][bj][m][1][e]); }
                    *(u32x4*)(Z5 + (size_t)(chunk * 16 + t) * 512 + g * 16 + co) = pack8(o0, o1); } }
    } };

template <class Epi, class Sched, bool ALIGN_EPI = false, bool SP2 = false>
__device__ __forceinline__ void gemm_phase(PG8_LAS unsigned char* lds, const GemmX g, const Sched& S, const Epi& E) {
    int tid_ = threadIdx.x; asm volatile("" : "+v"(tid_));
    const int tid = tid_, wid = __builtin_amdgcn_readfirstlane(tid >> 6), lane = tid & 63, wr = wid >> 2, wc = wid & 3, fr = lane & 15, fq = lane >> 4;
    int K_ = g.K; asm volatile("" : "+s"(K_));
    const int K = K_, nt = K / BK;
    int lda_ = g.lda, ldb_ = g.ldb; asm volatile("" : "+s"(lda_), "+s"(ldb_)); const int lda = lda_, ldb = ldb_, gsh = g.gsh, nNb = g.N / BM;
    unsigned voffA[2], voffB[2];
#pragma unroll
    for (int i = 0; i < 2; ++i) { int R, C; stage_rc(tid * 16 + i * 8192, R, C); const int Rb = Epi::PERM ? ((R & ~31) + perm32(R & 31)) : R;
        voffA[i] = (unsigned)(R * lda + C) * 2u; voffB[i] = (unsigned)(Rb * ldb + C) * 2u; }
    const size_t kstep = (size_t)(BK * 2);
    const size_t hstepA = (size_t)HALF * lda * 2, hstepB = (size_t)HALF * ldb * 2;
    const size_t tstepA = 2 * hstepA, tstepB = 2 * hstepB;
#define PG8_BTILE(u_) ((size_t)(gsh >= 0 ? ((u_).pm >> gsh) * nNb + (u_).pn : (u_).pn))
    const unsigned ldsw = (unsigned)wid * 1024u;
    const int aoff = lds_byte(wr * 64 + fr, fq * 8), boff = lds_byte(wc * 32 + fr, fq * 8);
#define PG8_SA(b, h) (((b) * 2 + (h)) * HTB)
#define PG8_SB(b, h) ((4 + (b) * 2 + (h)) * HTB)
#define PG8_STAGE(bufoff, gbase, voff) do { _Pragma("unroll") for (int _i = 0; _i < 2; ++_i) \
        __builtin_amdgcn_global_load_lds((const unsigned*)((const char*)(gbase) + (voff)[_i]), (PG8_LAS unsigned*)(lds + (bufoff) + ldsw + _i * 8192), 16, 0, 0); } while (0)
#define PG8_LDA(dst, b, h) do { _Pragma("unroll") for (int m = 0; m < 4; ++m) _Pragma("unroll") for (int k = 0; k < 2; ++k) dst[m][k] = *(const PG8_LAS bf16x8*)(lds + PG8_SA(b, h) + aoff + m * 2048 + k * 1024); } while (0)
#define PG8_LDB(dst, b, h) do { _Pragma("unroll") for (int n = 0; n < 2; ++n) _Pragma("unroll") for (int k = 0; k < 2; ++k) dst[n][k] = *(const PG8_LAS bf16x8*)(lds + PG8_SB(b, h) + boff + n * 2048 + k * 1024); } while (0)
#define PG8_MMA(ai, bj, At, Bt) do { __builtin_amdgcn_s_setprio(1); _Pragma("unroll") for (int m = 0; m < 4; ++m) _Pragma("unroll") for (int n = 0; n < 2; ++n) _Pragma("unroll") for (int k = 0; k < 2; ++k) \
        acc[ai][bj][m][n] = __builtin_amdgcn_mfma_f32_16x16x32_bf16(Bt[n][k], At[m][k], acc[ai][bj][m][n], 0, 0, 0); __builtin_amdgcn_s_setprio(0); } while (0)
#define PG8_WAIT_V(n) asm volatile("s_waitcnt vmcnt(" #n ")" ::: "memory")
#define PG8_WAIT_L(n) asm volatile("s_waitcnt lgkmcnt(" #n ")" ::: "memory")
#define PG8_BAR __builtin_amdgcn_s_barrier()
#define PG8_SCHED __builtin_amdgcn_sched_barrier(0)
    Unit cur, nxt; int ui = 0;
    if (!S.next(0, cur)) return;
    f32x4 acc[2][2][4][2];
#pragma unroll
    for (int a = 0; a < 2; ++a)
#pragma unroll
        for (int b = 0; b < 2; ++b)
#pragma unroll
            for (int m = 0; m < 4; ++m)
#pragma unroll
                for (int n = 0; n < 2; ++n) acc[a][b][m][n] = (f32x4){0.f, 0.f, 0.f, 0.f};
    bf16x8 At[4][2], B0[2][2], B1[2][2];
    const char* cA = (const char*)g.A + (size_t)cur.pm * tstepA; const char* cB = (const char*)g.Bt + PG8_BTILE(cur) * tstepB;
    S.a_ready(cur);
    if constexpr (SP2) {
        PG8_STAGE(PG8_SB(0, 0), cB, voffB); PG8_STAGE(PG8_SB(0, 1), cB + hstepB, voffB); PG8_STAGE(PG8_SA(0, 0), cA, voffA); PG8_STAGE(PG8_SA(0, 1), cA + hstepA, voffA);
        if (wr == 1) PG8_BAR;
        PG8_WAIT_V(2); PG8_BAR;
        PG8_STAGE(PG8_SB(1, 0), cB + kstep, voffB); PG8_STAGE(PG8_SA(1, 0), cA + kstep, voffA); PG8_STAGE(PG8_SB(1, 1), cB + hstepB + kstep, voffB);
        PG8_WAIT_V(6); PG8_BAR;
    } else {
        PG8_STAGE(PG8_SB(0, 0), cB, voffB); PG8_STAGE(PG8_SA(0, 0), cA, voffA); PG8_STAGE(PG8_SB(0, 1), cB + hstepB, voffB); PG8_STAGE(PG8_SA(0, 1), cA + hstepA, voffA);
        if (wr == 1) PG8_BAR;
        PG8_WAIT_V(4); PG8_BAR;
        PG8_STAGE(PG8_SB(1, 0), cB + kstep, voffB); PG8_STAGE(PG8_SA(1, 0), cA + kstep, voffA); PG8_STAGE(PG8_SB(1, 1), cB + hstepB + kstep, voffB);
        PG8_WAIT_V(6); PG8_BAR;
    }
    for (;;) {
        const bool has_next = S.next(ui + 1, nxt);
        const char* nA = has_next ? (const char*)g.A + (size_t)nxt.pm * tstepA : cA; const char* nB = has_next ? (const char*)g.Bt + PG8_BTILE(nxt) * tstepB : cB;
        for (int t = 0; t < nt; t += 2) {
            const bool last = (t == nt - 2);
            const char* a1 = cA + (size_t)(t + 1) * kstep;
            const char* a2 = last ? nA : cA + (size_t)(t + 2) * kstep; const char* b2 = last ? nB : cB + (size_t)(t + 2) * kstep;
            const char* a3 = a2 + kstep; const char* b3 = b2 + kstep;
            if (last && has_next) S.a_ready(nxt);
            if constexpr (SP2) {
            PG8_LDB(B0, 0, 0); PG8_LDB(B1, 0, 1); PG8_SCHED; PG8_LDA(At, 0, 0); PG8_STAGE(PG8_SA(1, 1), a1 + hstepA, voffA);
            PG8_WAIT_V(8); PG8_WAIT_L(0); PG8_BAR; PG8_MMA(0, 0, At, B0); PG8_MMA(0, 1, At, B1); PG8_BAR; PG8_SCHED;
            PG8_LDA(At, 0, 1); PG8_STAGE(PG8_SB(0, 0), b2, voffB); PG8_STAGE(PG8_SB(0, 1), b2 + hstepB, voffB); PG8_STAGE(PG8_SA(0, 0), a2, voffA);
            PG8_WAIT_V(8); PG8_WAIT_L(0); PG8_BAR; PG8_MMA(1, 0, At, B0); PG8_MMA(1, 1, At, B1); PG8_BAR; PG8_SCHED;
            PG8_LDB(B0, 1, 0); PG8_LDB(B1, 1, 1); PG8_SCHED; PG8_LDA(At, 1, 0); PG8_STAGE(PG8_SA(0, 1), a2 + hstepA, voffA);
            PG8_WAIT_V(8); PG8_WAIT_L(0); PG8_BAR; PG8_MMA(0, 0, At, B0); PG8_MMA(0, 1, At, B1); PG8_BAR; PG8_SCHED;
            PG8_LDA(At, 1, 1); PG8_STAGE(PG8_SB(1, 0), b3, voffB); PG8_STAGE(PG8_SB(1, 1), b3 + hstepB, voffB); PG8_STAGE(PG8_SA(1, 0), a3, voffA);
            PG8_WAIT_V(8); PG8_WAIT_L(0); PG8_BAR; PG8_MMA(1, 0, At, B0); PG8_MMA(1, 1, At, B1); PG8_BAR; PG8_SCHED;
            } else {
            PG8_LDB(B0, 0, 0); PG8_SCHED; PG8_LDA(At, 0, 0); PG8_STAGE(PG8_SA(1, 1), a1 + hstepA, voffA);
            PG8_WAIT_L(8); PG8_BAR; PG8_WAIT_L(0); PG8_MMA(0, 0, At, B0); PG8_BAR; PG8_SCHED;
            PG8_LDB(B1, 0, 1); PG8_STAGE(PG8_SB(0, 0), b2, voffB);
            PG8_BAR; PG8_WAIT_L(0); PG8_MMA(0, 1, At, B1); PG8_BAR;
            PG8_LDA(At, 0, 1); PG8_STAGE(PG8_SA(0, 0), a2, voffA);
            PG8_BAR; PG8_WAIT_L(0); PG8_MMA(1, 0, At, B0); PG8_BAR; PG8_SCHED;
            PG8_STAGE(PG8_SB(0, 1), b2 + hstepB, voffB);
            PG8_WAIT_V(6); PG8_BAR; PG8_MMA(1, 1, At, B1); PG8_BAR;
            PG8_LDB(B0, 1, 0); PG8_SCHED; PG8_LDA(At, 1, 0); PG8_STAGE(PG8_SA(0, 1), a2 + hstepA, voffA);
            PG8_WAIT_L(8); PG8_BAR; PG8_WAIT_L(0); PG8_MMA(0, 0, At, B0); PG8_BAR; PG8_SCHED;
            PG8_LDB(B1, 1, 1); PG8_STAGE(PG8_SB(1, 0), b3, voffB);
            PG8_BAR; PG8_WAIT_L(0); PG8_MMA(0, 1, At, B1); PG8_BAR;
            PG8_LDA(At, 1, 1); PG8_STAGE(PG8_SA(1, 0), a3, voffA);
            PG8_BAR; PG8_WAIT_L(0); PG8_MMA(1, 0, At, B0); PG8_BAR; PG8_SCHED;
            PG8_STAGE(PG8_SB(1, 1), b3 + hstepB, voffB);
            PG8_WAIT_V(6); PG8_BAR; PG8_MMA(1, 1, At, B1); PG8_BAR;
            }
        }
        if constexpr (ALIGN_EPI) { if (wr == 0) PG8_BAR; }
        if constexpr (!Epi::AFTER_DRAIN) { E(acc, cur, wr, wc, fr, fq); S.done(cur); }
        if (!has_next) break;
#pragma unroll
        for (int a = 0; a < 2; ++a)
#pragma unroll
            for (int b = 0; b < 2; ++b)
#pragma unroll
                for (int m = 0; m < 4; ++m)
#pragma unroll
                    for (int n = 0; n < 2; ++n) acc[a][b][m][n] = (f32x4){0.f, 0.f, 0.f, 0.f};
        cur = nxt; cA = nA; cB = nB; ++ui;
        if constexpr (ALIGN_EPI) { if (wr == 1) PG8_BAR; }
    }
    PG8_WAIT_V(0);
    if constexpr (!ALIGN_EPI) { if (wr == 0) PG8_BAR; }
    PG8_BAR;
    if constexpr (Epi::AFTER_DRAIN) { E.fused(acc, cur, wr, wc, fr, fq, lds, wid, lane); S.done(cur); }
#undef PG8_BTILE
#undef PG8_SA
#undef PG8_SB
#undef PG8_STAGE
#undef PG8_LDA
#undef PG8_LDB
#undef PG8_MMA
#undef PG8_WAIT_V
#undef PG8_WAIT_L
#undef PG8_BAR
#undef PG8_SCHED
}
}

constexpr int NWAVES = 8;
constexpr int RING_OFF = 0, RING_BYTES = 131072;
constexpr int LDSCTL_OFF = RING_BYTES, MISC_OFF = LDSCTL_OFF + 320;
constexpr int LDS_BYTES = 147456;

struct Args { const float* in[52]; float* out; unsigned char* ws; };

struct Frame {
    LAS unsigned char* lds; int tid, lane, wave, G, blk;
    const float* const* in; float* out; unsigned char* ws;
};
#define INP(i) (args.in[i])
#define INPD(i) ({ int i_ = (i); asm volatile("" : "+s"(i_)); args.in[i_]; })

template <class Src>
DEVI void cvt_item(const Src src, bf16* WT, int Kd, int nblk, LAS float* scr, int item, int lane) {
    const int kb = item / nblk, nb = item % nblk, k0 = 64 * kb, n0 = 32 * nb;
    const int kr = lane >> 3, nq = (lane & 7) * 4;
    f32x4 v[8];
#pragma unroll
    for (int i = 0; i < 8; ++i) v[i] = src.load4(k0 + 8 * i + kr, n0 + nq);
#pragma unroll
    for (int i = 0; i < 8; ++i) { LAS float* s = scr + (8 * i + kr) * 33 + nq; s[0] = v[i][0]; s[1] = v[i][1]; s[2] = v[i][2]; s[3] = v[i][3]; }
    LDS_WAIT(); asm volatile("" ::: "memory");
    const int c = lane & 7;
#pragma unroll
    for (int j = 0; j < 4; ++j) { const int n = (lane >> 3) + 8 * j; const LAS float* s = scr + (8 * c) * 33 + n;
        v4u o; o.x = pk2(s[0 * 33], s[1 * 33]); o.y = pk2(s[2 * 33], s[3 * 33]); o.z = pk2(s[4 * 33], s[5 * 33]); o.w = pk2(s[6 * 33], s[7 * 33]);
        *(GAS v4u*)(WT + (size_t)(n0 + n) * Kd + k0 + 8 * c) = o; }
    LDS_WAIT(); asm volatile("" ::: "memory");
}
struct SrcPlain { const float* W; int K, N, ld; DEVI f32x4 load4(int k, int n) const { return (k < K && n < N) ? *(const f32x4*)(W + (size_t)k * ld + n) : (f32x4){0.f, 0.f, 0.f, 0.f}; } };
struct SrcFold { const float* W; const float* mu; int ld; DEVI f32x4 load4(int k, int n) const { const int kk = k & 1023; const float m = mu[kk]; return *(const f32x4*)(W + (size_t)kk * ld + n) * (k < 1024 ? m : (1.0f - m)); } };
struct SrcBlk { const float* W; int k0, k1; DEVI f32x4 load4(int k, int n) const { return (k >= k0 && k < k1) ? *(const f32x4*)(W + (size_t)(k - k0) * 1024 + n) : (f32x4){0.f, 0.f, 0.f, 0.f}; } };
struct SrcZero { DEVI f32x4 load4(int, int) const { return (f32x4){0.f, 0.f, 0.f, 0.f}; } };

DEVI void sincos_d(double x, double& s, double& c) {
    const double n = rint(x * 0.63661977236758134308);
    double r = fma(-n, 1.57079632679489655800e+00, x); r = fma(-n, 6.12323399573676603587e-17, r);
    const double r2 = r * r;
    double sp = -7.6471637318198164759e-13; sp = fma(sp, r2, 1.6059043836821614599e-10); sp = fma(sp, r2, -2.5052108385441718775e-08); sp = fma(sp, r2, 2.7557319223985890653e-06);
    sp = fma(sp, r2, -1.9841269841269841270e-04); sp = fma(sp, r2, 8.3333333333333333333e-03); sp = fma(sp, r2, -1.6666666666666666667e-01); const double sr = fma(sp * r2, r, r);
    double cp = 4.7794773323873852974e-14; cp = fma(cp, r2, -1.1470745597729724714e-11); cp = fma(cp, r2, 2.0876756987868098979e-09); cp = fma(cp, r2, -2.7557319223985890653e-07);
    cp = fma(cp, r2, 2.4801587301587301587e-05); cp = fma(cp, r2, -1.3888888888888888889e-03); cp = fma(cp, r2, 4.1666666666666666667e-02); cp = fma(cp, r2, -0.5); const double cr = fma(cp, r2, 1.0);
    const int q = ((int)n) & 3;
    s = (q == 0) ? sr : (q == 1) ? cr : (q == 2) ? -sr : -cr;
    c = (q == 0) ? cr : (q == 1) ? -sr : (q == 2) ? -cr : sr;
}
DEVI void s5prep_one(int i, const float* a_re, const float* a_im, const float* log_step, const float* b_re, const float* b_im, float* sp) {
    const int g = i >> 6;
    const double dt = exp((double)log_step[g]), ar = a_re[i], ai = a_im[i];
    const double mag = exp(ar * dt); double s, c; sincos_d(ai * dt, s, c);
    const double abr = mag * c, abi = mag * s, den = ar * ar + ai * ai, nr = abr - 1.0;
    const double zr = (nr * ar + abi * ai) / den, zi = (abi * ar - nr * ai) / den;
    sp[i] = (float)abr; sp[2048 + i] = (float)abi;
    for (int cc = 0; cc < 16; ++cc) { const double br = b_re[i * 16 + cc], bi = b_im[i * 16 + cc];
        sp[4096 + i * 16 + cc] = (float)(zr * br - zi * bi); sp[4096 + 32768 + i * 16 + cc] = (float)(zr * bi + zi * br); }
}


constexpr int SP_PW = 4096 + 65536;
DEVI void s5prep_pw(int i, const float* a_re, const float* a_im, const float* log_step, float* sp) {
    const int g = i >> 6; const double dt = exp((double)log_step[g]), ar = a_re[i], ai = a_im[i];
    for (int tau = 0; tau <= 16; ++tau) { const double mag = exp(ar * dt * tau); double s, c; sincos_d(ai * dt * tau, s, c); sp[SP_PW + i * 34 + tau * 2] = (float)(mag * c); sp[SP_PW + i * 34 + tau * 2 + 1] = (float)(mag * s); }
}
DEVI void s5_tm_job(int g, int tau, int lane, const float* sp, const float* c_re, const float* c_im, const float* dd, bf16* TM) {
    bf16* tm = TM + (size_t)g * 256 * 384;
    if (tau <= 15) {
        const int co = lane >> 2, ci0 = (lane & 3) * 4; float kv[4] = {0.f, 0.f, 0.f, 0.f};
        for (int p = 0; p < 64; ++p) { const float pr = sp[SP_PW + (g * 64 + p) * 34 + tau * 2], pi = sp[SP_PW + (g * 64 + p) * 34 + tau * 2 + 1];
            const float cr = c_re[(g * 16 + co) * 64 + p], ci = c_im[(g * 16 + co) * 64 + p];
            const f32x4 br = *(const f32x4*)(sp + 4096 + (g * 64 + p) * 16 + ci0), bi = *(const f32x4*)(sp + 4096 + 32768 + (g * 64 + p) * 16 + ci0);
#pragma unroll
            for (int q = 0; q < 4; ++q) { const float wr = pr * br[q] - pi * bi[q], wi = pr * bi[q] + pi * br[q]; kv[q] += cr * wr - ci * wi; } }
        if (tau == 0) {
#pragma unroll
            for (int q = 0; q < 4; ++q) if (ci0 + q == co) kv[q] += dd[g * 16 + co]; }
        const unsigned long long pk = (unsigned long long)pk2(kv[0], kv[1]) | ((unsigned long long)pk2(kv[2], kv[3]) << 32);
        for (int t = tau; t < 16; ++t) *(unsigned long long*)(tm + (size_t)(t * 16 + co) * 384 + (t - tau) * 16 + ci0) = pk;
        if (tau >= 1) for (int t = 0; t + tau < 16; ++t) *(unsigned long long*)(tm + (size_t)(t * 16 + co) * 384 + (t + tau) * 16 + ci0) = 0ull;
    }
    if (tau >= 1) { const int t = tau - 1, p = lane; const float pr = sp[SP_PW + (g * 64 + p) * 34 + tau * 2], pi = sp[SP_PW + (g * 64 + p) * 34 + tau * 2 + 1];
        for (int co = 0; co < 16; ++co) { const float cr = c_re[(g * 16 + co) * 64 + p], ci = c_im[(g * 16 + co) * 64 + p];
            tm[(size_t)(t * 16 + co) * 384 + 256 + p] = (bf16)f2bf(cr * pr - ci * pi); tm[(size_t)(t * 16 + co) * 384 + 320 + p] = (bf16)f2bf(-(cr * pi + ci * pr)); } }
}
DEVI void s5_hm_job(int g, int s, int lane, const float* sp, bf16* HM) {
    const int p = lane; const float pr = sp[SP_PW + (g * 64 + p) * 34 + (15 - s) * 2], pi = sp[SP_PW + (g * 64 + p) * 34 + (15 - s) * 2 + 1];
    bf16* hr = HM + ((size_t)g * 256 + p) * 256 + s * 16; bf16* hi = hr + 64 * 256;
#pragma unroll
    for (int h8 = 0; h8 < 2; ++h8) { float wr[8], wi[8];
#pragma unroll
        for (int q = 0; q < 8; ++q) { const float br = sp[4096 + (g * 64 + p) * 16 + h8 * 8 + q], bi = sp[4096 + 32768 + (g * 64 + p) * 16 + h8 * 8 + q]; wr[q] = pr * br - pi * bi; wi[q] = pr * bi + pi * br; }
        v4u a, b; a.x = pk2(wr[0], wr[1]); a.y = pk2(wr[2], wr[3]); a.z = pk2(wr[4], wr[5]); a.w = pk2(wr[6], wr[7]); b.x = pk2(wi[0], wi[1]); b.y = pk2(wi[2], wi[3]); b.z = pk2(wi[4], wi[5]); b.w = pk2(wi[6], wi[7]);
        *(v4u*)(hr + h8 * 8) = a; *(v4u*)(hi + h8 * 8) = b; }
}
DEVI void s5_carry_job(int b, int g, int lane, const float* sp, const float* HL, bf16* UB, float* ore, float* oim) {
    const int p = lane; const float ar = sp[SP_PW + (g * 64 + p) * 34 + 32], ai = sp[SP_PW + (g * 64 + p) * 34 + 33];
    float cr = 0.f, ci = 0.f;
#pragma unroll 8
    for (int n = 0; n < 128; ++n) { const size_t row = (size_t)g * 1024 + b * 128 + n;
        UB[row * 384 + 256 + p] = (bf16)f2bf(cr); UB[row * 384 + 320 + p] = (bf16)f2bf(ci);
        const float hr = HL[row * 128 + p], hi = HL[row * 128 + 64 + p];
        const float nr = ar * cr - ai * ci + hr, ni = ar * ci + ai * cr + hi; cr = nr; ci = ni; }
    ore[((size_t)b * 32 + g) * 64 + p] = cr; oim[((size_t)b * 32 + g) * 64 + p] = ci;
}


DEVI void mods_job(int job, int lane, const float* __restrict__ ST, const float* __restrict__ ada_w, const float* __restrict__ ada_b, float* MODS) {
    asm volatile("" : "+v"(lane));
    const int l = job / 576, n0 = (job % 576) * 16, i16 = lane & 15, kq = lane >> 4;
    f32x4 acc[9];
#pragma unroll
    for (int m = 0; m < 9; ++m) acc[m] = (f32x4){0.f, 0.f, 0.f, 0.f};
    const float* w = ada_w + (size_t)l * 1024 * 9216 + (size_t)kq * 9216 + n0 + i16; const float* st = ST + kq * 144 + i16;
#pragma unroll 4
    for (int k0 = 0; k0 < 1024; k0 += 4) { const float bv = w[(size_t)k0 * 9216];
#pragma unroll
        for (int m = 0; m < 9; ++m) acc[m] = __builtin_amdgcn_mfma_f32_16x16x4f32(st[k0 * 144 + m * 16], bv, acc[m], 0, 0, 0); }
    const float bb = ada_b[l * 9216 + n0 + i16];
#pragma unroll
    for (int m = 0; m < 9; ++m)
#pragma unroll
        for (int q = 0; q < 4; ++q) { const int r = m * 16 + kq * 4 + q; if (r < NMODROW) MODS[((size_t)l * NMODROW + r) * 9216 + n0 + i16] = acc[m][q] + bb; }
}

DEVI void init_row(int row, int lane, const float* xp, const float* xs, const float* mods, float* X, bf16* H) {
    if (row >= MT) { for (int j = 0; j < 16; ++j) H[(size_t)row * D + j * 64 + lane] = 0; return; }
    const float* src = row < NP ? xp + (size_t)row * D : xs + (size_t)(row - NP) * D;
    const float* sh = modp(mods, 0, 0) + (size_t)mrow(row) * 9216; const float* sc = modp(mods, 0, 1) + (size_t)mrow(row) * 9216;
#pragma unroll
    for (int j = 0; j < 4; ++j) { const int c = j * 256 + lane * 4; const f32x4 v = *(const f32x4*)(src + c), a = *(const f32x4*)(sc + c), b = *(const f32x4*)(sh + c);
        *(f32x4*)(X + (size_t)row * D + c) = v; const f32x4 h = v * (a + 1.0f) + b;
        *(unsigned long long*)(H + (size_t)row * D + c) = (unsigned long long)pk2(h[0], h[1]) | ((unsigned long long)pk2(h[2], h[3]) << 32); }
}
DEVI void ln_row(int row, int lane, const float* Z, const float* g, const float* b, float* X, bf16* H, const float* sh, const float* sc) {
    const float* z = Z + (size_t)row * D; f32x4 v[4]; float s = 0.f;
#pragma unroll
    for (int j = 0; j < 4; ++j) { v[j] = *(const f32x4*)(z + j * 256 + lane * 4); s += (v[j][0] + v[j][1]) + (v[j][2] + v[j][3]); }
    const float mean = wave_sum(s) * (1.f / D); float q = 0.f;
#pragma unroll
    for (int j = 0; j < 4; ++j) { v[j] = v[j] - mean; q += (v[j][0] * v[j][0] + v[j][1] * v[j][1]) + (v[j][2] * v[j][2] + v[j][3] * v[j][3]); }
    const float rstd = rsqrtf(wave_sum(q) * (1.f / D) + 1e-5f);
    const int mr = mrow(row);
#pragma unroll
    for (int j = 0; j < 4; ++j) { const int c = j * 256 + lane * 4; const f32x4 x = v[j] * rstd * *(const f32x4*)(g + c) + *(const f32x4*)(b + c); *(f32x4*)(X + (size_t)row * D + c) = x;
        if (H) { const f32x4 h = x * (*(const f32x4*)(sc + (size_t)mr * 9216 + c) + 1.0f) + *(const f32x4*)(sh + (size_t)mr * 9216 + c);
            *(unsigned long long*)(H + (size_t)row * D + c) = (unsigned long long)pk2(h[0], h[1]) | ((unsigned long long)pk2(h[2], h[3]) << 32); } }
}
DEVI void shiftcat_row(int row, int lane, const float* X, const float* mods, const float* shift_in, bf16* A2, float* out) {
    if (row >= MT) { for (int j = 0; j < 32; ++j) A2[(size_t)row * KRK + j * 64 + lane] = 0; return; }
    const int mr = mrow(row); const float* sh = modp(mods, 1, 3) + (size_t)mr * 9216; const float* sc = modp(mods, 1, 4) + (size_t)mr * 9216;
    const bool prompt = row < NP; const int t = row & 2047;
    for (int j = 0; j < 16; ++j) { const int c = j * 64 + lane; const float h = X[(size_t)row * D + c] * (1.f + sc[c]) + sh[c];
        float pv; if (prompt) pv = t == 0 ? 0.f : X[(size_t)(row - 1) * D + c] * (1.f + sc[c]) + sh[c]; else pv = shift_in[(size_t)(row - NP) * D + c];
        A2[(size_t)row * KRK + c] = (bf16)f2bf(pv); A2[(size_t)row * KRK + 1024 + c] = (bf16)f2bf(h);
        if (prompt) { if (t == 2047) out[O_SHIFT_P + (size_t)(row >> 11) * D + c] = h; } else out[O_SHIFT_S + (size_t)(row - NP) * D + c] = h; }
}
DEVI void gla_post_one(int w, int lane, const float* OG, const bf16* P, const float* norm_g, bf16* O) {
    const int tok = w >> 2, h = w & 3;
    const float o0 = OG[(size_t)tok * 512 + h * 128 + lane], o1 = OG[(size_t)tok * 512 + h * 128 + 64 + lane];
    const float ms = wave_sum(o0 * o0 + o1 * o1) * (1.f / 128.f), r = rsqrtf(ms + 1e-5f);
    const float g0 = bf2f(P[(size_t)tok * NINP + 1024 + h * 128 + lane]), g1 = bf2f(P[(size_t)tok * NINP + 1024 + h * 128 + 64 + lane]);
    O[(size_t)tok * D + h * 128 + lane] = (bf16)f2bf(o0 * r * norm_g[lane] * siluf_(g0));
    O[(size_t)tok * D + h * 128 + 64 + lane] = (bf16)f2bf(o1 * r * norm_g[64 + lane] * siluf_(g1));
}

DEVI void gla_job(LAS float* scr, int lane, int b, int h, int half, const bf16* P, const float* GKL, const float* w_gk, const float* b_gk, int tok_base, int T, const float* s0, float* s_out, float* OG) {
    LAS float* sdec = scr; LAS float* sq = scr + 1024; LAS float* sk = scr + 2048;
    const int dv = half * 64 + lane;
    float S[64];
#pragma unroll
    for (int i = 0; i < 64; ++i) S[i] = s0 ? s0[(((size_t)b * 4 + h) * 64 + i) * 128 + dv] : 0.f;
    float wg[16];
#pragma unroll
    for (int r = 0; r < 16; ++r) wg[r] = w_gk[r * 256 + h * 64 + lane];
    const float bg = b_gk[h * 64 + lane];
    for (int t0 = 0; t0 < T; t0 += 16) { const int nt = (T - t0) < 16 ? (T - t0) : 16;
        for (int tt = 0; tt < nt; ++tt) { const size_t tok = (size_t)tok_base + (size_t)b * T + t0 + tt; float x = bg;
#pragma unroll
            for (int r = 0; r < 16; ++r) x += GKL[tok * 16 + r] * wg[r];
            const float ls = fminf(x, 0.f) - log1pf(__expf(-fabsf(x)));
            sdec[tt * 64 + lane] = __expf(ls * (1.f / 16.f)); sq[tt * 64 + lane] = bf2f(P[tok * NINP + h * 64 + lane]) * 0.125f; sk[tt * 64 + lane] = bf2f(P[tok * NINP + 256 + h * 64 + lane]); }
        LDS_WAIT(); asm volatile("" ::: "memory");
        for (int tt = 0; tt < nt; ++tt) { const size_t tok = (size_t)tok_base + (size_t)b * T + t0 + tt;
            const float v = bf2f(P[tok * NINP + 512 + h * 128 + dv]); float o = 0.f;
#pragma unroll
            for (int i = 0; i < 64; ++i) { S[i] = S[i] * sdec[tt * 64 + i] + sk[tt * 64 + i] * v; o += sq[tt * 64 + i] * S[i]; }
            OG[tok * 512 + h * 128 + dv] = o; }
        LDS_WAIT(); asm volatile("" ::: "memory");
    }
#pragma unroll
    for (int i = 0; i < 64; ++i) s_out[(((size_t)b * 4 + h) * 64 + i) * 128 + dv] = S[i];
}
DEVI void s5_job(LAS float* scr, int lane, int g, int b0, int nb, const bf16* P, const float* sp, const float* c_re, const float* c_im, const float* dd, int tok_base, int T,
                 const float* h0re, const float* h0im, float* ore, float* oim, bf16* Z5) {
    const int p = lane, c = p & 15, pq = p >> 4;
    const float abr = sp[g * 64 + p], abi = sp[2048 + g * 64 + p];
    float bbr[16], bbi[16], cr[16], ci[16];
#pragma unroll
    for (int i = 0; i < 16; ++i) { bbr[i] = sp[4096 + (g * 64 + p) * 16 + i]; bbi[i] = sp[4096 + 32768 + (g * 64 + p) * 16 + i];
        cr[i] = c_re[(g * 16 + c) * 64 + pq * 16 + i]; ci[i] = c_im[(g * 16 + c) * 64 + pq * 16 + i]; }
    const float dv = dd[g * 16 + c];
    for (int b = b0; b < b0 + nb; ++b) {
        float hr = h0re ? h0re[((size_t)b * 32 + g) * 64 + p] : 0.f, hi = h0im ? h0im[((size_t)b * 32 + g) * 64 + p] : 0.f;
        for (int t = 0; t < T; ++t) { const size_t tok = (size_t)tok_base + (size_t)b * T + t;
            const bf16* up = P + tok * NINP + 1552 + g * 16; float u[16];
#pragma unroll
            for (int i = 0; i < 16; ++i) u[i] = bf2f(up[i]);
            const float uc = bf2f(up[c]);
            float br = 0.f, bi = 0.f;
#pragma unroll
            for (int i = 0; i < 16; ++i) { br += u[i] * bbr[i]; bi += u[i] * bbi[i]; }
            const float nr = abr * hr - abi * hi + br, ni = abr * hi + abi * hr + bi; hr = nr; hi = ni;
            LAS float* hs = scr + (t & 1) * 128;
            hs[p] = hr; hs[64 + p] = hi;
            LDS_WAIT(); asm volatile("" ::: "memory");
            float y = 0.f;
#pragma unroll
            for (int i = 0; i < 16; ++i) y += cr[i] * hs[pq * 16 + i] - ci[i] * hs[64 + pq * 16 + i];
            y += __shfl_xor(y, 16); y += __shfl_xor(y, 32);
            if (p < 16) { y += dv * uc; Z5[tok * 512 + g * 16 + c] = (bf16)f2bf(gelu_tanh(y)); }
        }
        ore[((size_t)b * 32 + g) * 64 + p] = hr; oim[((size_t)b * 32 + g) * 64 + p] = hi;
        LDS_WAIT(); asm volatile("" ::: "memory");
    }
}
DEVI void wkv_job(LAS float* scr, int lane, int b, int h, const bf16* R, const bf16* Kb, const bf16* V, const float* WD, const bf16* AS, bf16* GO, const float* k_k, const float* k_a, const float* r_k, const float* lnx_g, const float* lnx_b,
                  int tok_base, int T, const float* s0, float* s_out) {
    LAS float* sw = scr; LAS float* skm = scr + 512; LAS float* sa_ = scr + 1024; LAS float* sb = scr + 1536; LAS float* sr = scr + 2048; LAS float* sbon = scr + 2560;
    const int i = lane, ch = h * 64 + i;
    float S[64];
#pragma unroll
    for (int j = 0; j < 64; ++j) S[j] = s0 ? s0[(((size_t)b * 16 + h) * 64 + i) * 64 + j] : 0.f;
    const float kkc = k_k[ch], kac = k_a[ch], rkc = r_k[ch], lg = lnx_g[ch], lb = lnx_b[ch];
    for (int t0 = 0; t0 < T; t0 += 8) { const int nt = (T - t0) < 8 ? (T - t0) : 8;
        for (int tt = 0; tt < nt; ++tt) { const size_t tok = (size_t)tok_base + (size_t)b * T + t0 + tt;
            const float k = bf2f(Kb[tok * D + ch]), r = bf2f(R[tok * D + ch]), a = bf2f(AS[tok * D + ch]), w = WD[tok * D + ch];
            float kk = k * kkc; const float nrm = sqrtf(wave_sum(kk * kk)); kk = kk / fmaxf(nrm, 1e-12f);
            const float km = k * (1.f + (a - 1.f) * kac);
            sw[tt * 64 + i] = w; skm[tt * 64 + i] = km; sa_[tt * 64 + i] = -kk; sb[tt * 64 + i] = kk * a; sr[tt * 64 + i] = r;
            const float bon = wave_sum(r * km * rkc); if (i == 0) sbon[tt] = bon; }
        LDS_WAIT(); asm volatile("" ::: "memory");
        for (int tt = 0; tt < nt; ++tt) { const size_t tok = (size_t)tok_base + (size_t)b * T + t0 + tt;
            const float v = bf2f(V[tok * D + ch]); float sa = 0.f;
#pragma unroll
            for (int j = 0; j < 64; ++j) sa += S[j] * sa_[tt * 64 + j];
            float y = 0.f;
#pragma unroll
            for (int j = 0; j < 64; ++j) { S[j] = S[j] * sw[tt * 64 + j] + sa * sb[tt * 64 + j] + v * skm[tt * 64 + j]; y += S[j] * sr[tt * 64 + j]; }
            const float mean = wave_sum(y) * (1.f / 64.f), dy = y - mean, var = wave_sum(dy * dy) * (1.f / 64.f);
            float yn = dy * rsqrtf(var + 64e-5f) * lg + lb; yn += sbon[tt] * v;
            const float gt = bf2f(GO[tok * D + ch]); GO[tok * D + ch] = (bf16)f2bf(yn * gt); }
        LDS_WAIT(); asm volatile("" ::: "memory");
    }
#pragma unroll
    for (int j = 0; j < 64; ++j) s_out[(((size_t)b * 16 + h) * 64 + i) * 64 + j] = S[j];
}

DEVI float dpp_add(float v, const int ctrl_sel) {
    int r;
    switch (ctrl_sel) {
    case 0: r = __builtin_amdgcn_update_dpp(0, __builtin_bit_cast(int, v), 0xB1, 0xF, 0xF, true); break;
    case 1: r = __builtin_amdgcn_update_dpp(0, __builtin_bit_cast(int, v), 0x4E, 0xF, 0xF, true); break;
    case 2: r = __builtin_amdgcn_update_dpp(0, __builtin_bit_cast(int, v), 0x141, 0xF, 0xF, true); break;
    default: r = __builtin_amdgcn_update_dpp(0, __builtin_bit_cast(int, v), 0x140, 0xF, 0xF, true); break;
    }
    return v + __builtin_bit_cast(float, r);
}
DEVI float red16(float v) { v = dpp_add(v, 0); v = dpp_add(v, 1); v = dpp_add(v, 2); v = dpp_add(v, 3); return v; }
constexpr int WK_TB = 32;
constexpr int WK_W = 0, WK_KM = 2048, WK_NA = 4096, WK_BB = 6144, WK_WR = 8192, WK_V = 10240, WK_BON = 12288, WK_BR = 12320, WK_KR = 12352, WK_PB = 12416;
constexpr int WK_Y = 2 * WK_PB;
static_assert((WK_Y + 2048) * 4 <= RING_BYTES, "wkv lds");
struct WkvLoad { uint2 k, r, a, v, g; f32x4 w; };
struct WkvOps { f32x4 na, wr, w4, bb, km; float v0, v1, br, kr; };
template <bool DRY> DEVI void wkv_chain(LAS float* L, int tid, int b, int h, const bf16* R, const bf16* Kb, const bf16* V, const float* WD, const bf16* AS, bf16* GO,
                    const float* k_k, const float* k_a, const float* r_k, const float* lnx_g, const float* lnx_b, float* s_out) {
    asm volatile("" : "+v"(tid));
    const int rp = tid >> 4, jq = tid & 15, tt = tid >> 4;
    const int ch = h * 64 + 4 * jq;
    const f32x4 kkc = *(const f32x4*)(k_k + ch), kac = *(const f32x4*)(k_a + ch), rkc = *(const f32x4*)(r_k + ch), lg = *(const f32x4*)(lnx_g + ch), lb = *(const f32x4*)(lnx_b + ch);
    f32x4 S0 = {0.f, 0.f, 0.f, 0.f}, S1 = {0.f, 0.f, 0.f, 0.f};
    const size_t tokb = (size_t)b * TP;
    WkvLoad ld; uint2 gcur;
    auto bf4 = [](uint2 u) -> f32x4 { f32x4 o; o[0] = __uint_as_float(u.x << 16); o[1] = __uint_as_float(u.x & 0xffff0000u); o[2] = __uint_as_float(u.y << 16); o[3] = __uint_as_float(u.y & 0xffff0000u); return o; };
#define WK_ISSUE(blkidx) do { const size_t o_ = (tokb + (size_t)(blkidx) * WK_TB + tt) * D + ch; ld.k = *(const uint2*)(Kb + o_); ld.r = *(const uint2*)(R + o_); ld.a = *(const uint2*)(AS + o_); ld.v = *(const uint2*)(V + o_); \
        ld.g = *(const uint2*)(GO + o_); ld.w = *(const f32x4*)(WD + o_); } while (0)
#define WK_PREP(bufidx) do { LAS float* pb_ = L + (bufidx) * WK_PB; const f32x4 k4 = bf4(ld.k), r4 = bf4(ld.r), a4 = bf4(ld.a), v4 = bf4(ld.v); \
        f32x4 kk = k4 * kkc; float ss = red16((kk[0] * kk[0] + kk[1] * kk[1]) + (kk[2] * kk[2] + kk[3] * kk[3])); const float inv = 1.0f / fmaxf(sqrtf(ss), 1e-12f); kk = kk * inv; \
        const f32x4 km = k4 * ((a4 - 1.0f) * kac + 1.0f); const f32x4 pr = r4 * km; const f32x4 prk = pr * rkc; const float bon = red16((prk[0] + prk[1]) + (prk[2] + prk[3])); \
        const f32x4 bbv = kk * a4; const f32x4 pb2 = bbv * r4; const float brs = red16((pb2[0] + pb2[1]) + (pb2[2] + pb2[3])), krs = red16((pr[0] + pr[1]) + (pr[2] + pr[3])); \
        *(LAS f32x4*)(pb_ + WK_W + tt * 64 + 4 * jq) = ld.w; *(LAS f32x4*)(pb_ + WK_KM + tt * 64 + 4 * jq) = km; *(LAS f32x4*)(pb_ + WK_NA + tt * 64 + 4 * jq) = -kk; \
        *(LAS f32x4*)(pb_ + WK_BB + tt * 64 + 4 * jq) = bbv; *(LAS f32x4*)(pb_ + WK_WR + tt * 64 + 4 * jq) = ld.w * r4; *(LAS f32x4*)(pb_ + WK_V + tt * 64 + 4 * jq) = v4; \
        if (jq == 0) { pb_[WK_BON + tt] = bon; pb_[WK_BR + tt] = brs; pb_[WK_KR + tt] = krs; } } while (0)
#define WK_LOADOPS(o_, pbase, t_) do { const LAS float* q_ = (pbase) + (t_) * 64 + 4 * jq; (o_).na = *(const LAS f32x4*)(q_ + WK_NA); (o_).wr = *(const LAS f32x4*)(q_ + WK_WR); (o_).w4 = *(const LAS f32x4*)(q_ + WK_W); \
        (o_).bb = *(const LAS f32x4*)(q_ + WK_BB); (o_).km = *(const LAS f32x4*)(q_ + WK_KM); const LAS float* v_ = (pbase) + WK_V + (t_) * 64 + 2 * rp; (o_).v0 = v_[0]; (o_).v1 = v_[1]; (o_).br = (pbase)[WK_BR + (t_)]; (o_).kr = (pbase)[WK_KR + (t_)]; } while (0)
#define WK_STEP(o_, t_) do { \
        float sa0 = (S0[0] * (o_).na[0] + S0[1] * (o_).na[1]) + (S0[2] * (o_).na[2] + S0[3] * (o_).na[3]), sa1 = (S1[0] * (o_).na[0] + S1[1] * (o_).na[1]) + (S1[2] * (o_).na[2] + S1[3] * (o_).na[3]); \
        float y0 = (S0[0] * (o_).wr[0] + S0[1] * (o_).wr[1]) + (S0[2] * (o_).wr[2] + S0[3] * (o_).wr[3]), y1 = (S1[0] * (o_).wr[0] + S1[1] * (o_).wr[1]) + (S1[2] * (o_).wr[2] + S1[3] * (o_).wr[3]); \
        sa0 = dpp_add(sa0, 0); sa1 = dpp_add(sa1, 0); y0 = dpp_add(y0, 0); y1 = dpp_add(y1, 0); sa0 = dpp_add(sa0, 1); sa1 = dpp_add(sa1, 1); y0 = dpp_add(y0, 1); y1 = dpp_add(y1, 1); \
        sa0 = dpp_add(sa0, 2); sa1 = dpp_add(sa1, 2); y0 = dpp_add(y0, 2); y1 = dpp_add(y1, 2); sa0 = dpp_add(sa0, 3); sa1 = dpp_add(sa1, 3); y0 = dpp_add(y0, 3); y1 = dpp_add(y1, 3); \
        S0 = S0 * (o_).w4 + ((o_).bb * sa0 + (o_).km * (o_).v0); S1 = S1 * (o_).w4 + ((o_).bb * sa1 + (o_).km * (o_).v1); \
        y0 += sa0 * (o_).br + (o_).v0 * (o_).kr; y1 += sa1 * (o_).br + (o_).v1 * (o_).kr; \
        if (jq == 0) { L[WK_Y + (t_) * 64 + 2 * rp] = y0; L[WK_Y + (t_) * 64 + 2 * rp + 1] = y1; } } while (0)
    WK_ISSUE(0); WK_PREP(0); gcur = ld.g;
    LDS_WAIT(); __builtin_amdgcn_s_barrier(); asm volatile("" ::: "memory");
    constexpr int NB = TP / WK_TB;
    for (int n = 0; n < NB; ++n) {
        const int cur = n & 1; const LAS float* pb = L + cur * WK_PB;
        if (n + 1 < NB) WK_ISSUE(n + 1);
        WkvOps oa, ob; WK_LOADOPS(oa, pb, 0);
#pragma unroll 2
        for (int t = 0; t < WK_TB; t += 2) {
            WK_LOADOPS(ob, pb, t + 1); WK_STEP(oa, t);
            WK_LOADOPS(oa, pb, t + 2); WK_STEP(ob, t + 1);
        }
        const uint2 gnext = ld.g;
        if (n + 1 < NB) WK_PREP(cur ^ 1);
        LDS_WAIT(); __builtin_amdgcn_s_barrier(); asm volatile("" ::: "memory");
        {
            const f32x4 y4 = *(const LAS f32x4*)(L + WK_Y + tt * 64 + 4 * jq), v4 = *(const LAS f32x4*)(pb + WK_V + tt * 64 + 4 * jq); const float bon = pb[WK_BON + tt];
            const float mean = red16((y4[0] + y4[1]) + (y4[2] + y4[3])) * (1.f / 64.f); const f32x4 dy = y4 - mean;
            const float var = red16((dy[0] * dy[0] + dy[1] * dy[1]) + (dy[2] * dy[2] + dy[3] * dy[3])) * (1.f / 64.f);
            const f32x4 yn = dy * rsqrtf(var + 64e-5f) * lg + lb + v4 * bon; const f32x4 o = yn * bf4(gcur);
            uint2 ov; ov.x = pk2(o[0], o[1]); ov.y = pk2(o[2], o[3]);
            *(uint2*)((DRY ? (bf16*)s_out : GO) + (DRY ? (size_t)tid * 4 : (tokb + (size_t)n * WK_TB + tt) * D + ch)) = ov;
        }
        gcur = gnext;
        LDS_WAIT(); __builtin_amdgcn_s_barrier(); asm volatile("" ::: "memory");
    }
#undef WK_LOADOPS
#undef WK_STEP
#undef WK_ISSUE
#undef WK_PREP
    float* so = s_out + (((size_t)b * 16 + h) * 64 + 2 * rp) * 64 + 4 * jq;
    *(f32x4*)so = S0; *(f32x4*)(so + 64) = S1;
}

constexpr int GL_BF = 0, GL_QI = 16384, GL_KI = 25600, GL_SC = 34816, GL_VT = 44032, GL_ST = 62464, GL_RS = 80896, GL_WG = 81920, GL_GKL = 86016, GL_SEG = 90112;
constexpr int GL_LD = 72;
DEVI bf16x8 gl_frag(LAS unsigned char* lds, int base, int row, int k0, int fq) { return *(const LAS bf16x8*)(lds + base + (row * GL_LD + k0 + 8 * fq) * 2); }
DEVI void gla_cumdecay(LAS unsigned char* lds, int tid, int h, size_t tok0, const float* GKL, const float* w_gk, const float* b_gk) {
    asm volatile("" : "+v"(tid));
    LAS float* BF = (LAS float*)(lds + GL_BF); LAS float* WG = (LAS float*)(lds + GL_WG); LAS float* GK = (LAS float*)(lds + GL_GKL); LAS float* SEG = (LAS float*)(lds + GL_SEG);
    for (int i = tid; i < 1024; i += 512) { WG[i] = w_gk[(i >> 6) * 256 + h * 64 + (i & 63)]; GK[i] = GKL[tok0 * 16 + i]; }
    LDS_WAIT(); __builtin_amdgcn_s_barrier(); asm volatile("" ::: "memory");
    { const int t = tid >> 3, d0 = (tid & 7) * 8; float x[8];
#pragma unroll
        for (int e = 0; e < 8; ++e) x[e] = b_gk[h * 64 + d0 + e];
#pragma unroll
        for (int r = 0; r < 16; ++r) { const float gv = GK[t * 16 + r]; const f32x4 w0 = *(const LAS f32x4*)(WG + r * 64 + d0), w1 = *(const LAS f32x4*)(WG + r * 64 + d0 + 4);
#pragma unroll
            for (int e = 0; e < 4; ++e) { x[e] += gv * w0[e]; x[4 + e] += gv * w1[e]; } }
#pragma unroll
        for (int e = 0; e < 8; ++e) { const float xx = x[e]; x[e] = (fminf(xx, 0.f) - log1pf(__expf(-fabsf(xx)))) * (1.f / 16.f); }
        *(LAS f32x4*)(BF + t * 64 + d0) = (f32x4){x[0], x[1], x[2], x[3]}; *(LAS f32x4*)(BF + t * 64 + d0 + 4) = (f32x4){x[4], x[5], x[6], x[7]}; }
    LDS_WAIT(); __builtin_amdgcn_s_barrier(); asm volatile("" ::: "memory");
    { const int dk = tid & 63, sg = tid >> 6; float a = 0.f;
#pragma unroll
        for (int i = 0; i < 8; ++i) { a += BF[(sg * 8 + i) * 64 + dk]; BF[(sg * 8 + i) * 64 + dk] = a; }
        SEG[sg * 64 + dk] = a; }
    LDS_WAIT(); __builtin_amdgcn_s_barrier(); asm volatile("" ::: "memory");
    { const int dk = tid & 63, sg = tid >> 6; float off = 0.f;
        for (int s = 0; s < sg; ++s) off += SEG[s * 64 + dk];
#pragma unroll
        for (int i = 0; i < 8; ++i) BF[(sg * 8 + i) * 64 + dk] += off; }
    LDS_WAIT(); __builtin_amdgcn_s_barrier(); asm volatile("" ::: "memory");
}
DEVI void gla_stage_vt(LAS unsigned char* lds, int tid, int h, size_t tok0, const bf16* P) {
    const int t = tid >> 3, dv0 = (tid & 7) * 16; const bf16* vp = P + (tok0 + t) * NINP + 512 + h * 128 + dv0;
    const v4u a = *(const v4u*)vp, b = *(const v4u*)(vp + 8); LAS bf16* VT = (LAS bf16*)(lds + GL_VT);
    const unsigned w[8] = {a.x, a.y, a.z, a.w, b.x, b.y, b.z, b.w};
#pragma unroll
    for (int e = 0; e < 8; ++e) { VT[(dv0 + 2 * e) * GL_LD + t] = (bf16)(w[e] & 0xffffu); VT[(dv0 + 2 * e + 1) * GL_LD + t] = (bf16)(w[e] >> 16); }
}
DEVI void gla_unit_a(LAS unsigned char* lds, int tid, int u, const bf16* P, const float* GKL, const float* w_gk, const float* b_gk, float* KV, float* DEC) {
    asm volatile("" : "+v"(tid));
    const int bh = u >> 5, ck = u & 31, b = bh >> 2, h = bh & 3; const size_t tok0 = (size_t)b * TP + ck * 64;
    const int lane = tid & 63, wave = tid >> 6, fr = lane & 15, fq = lane >> 4;
    gla_cumdecay(lds, tid, h, tok0, GKL, w_gk, b_gk);
    LAS float* BF = (LAS float*)(lds + GL_BF);
    { const int t = tid >> 3, d0 = (tid & 7) * 8; const v4u kq = *(const v4u*)(P + (tok0 + t) * NINP + 256 + h * 64 + d0); LAS bf16* KST = (LAS bf16*)(lds + GL_QI);
        const unsigned w[4] = {kq.x, kq.y, kq.z, kq.w};
#pragma unroll
        for (int e = 0; e < 8; ++e) { const float kv = __uint_as_float((e & 1) ? (w[e >> 1] & 0xffff0000u) : (w[e >> 1] << 16)); const float sc = __expf(BF[63 * 64 + d0 + e] - BF[t * 64 + d0 + e]);
            KST[(d0 + e) * GL_LD + t] = (bf16)f2bf(kv * sc); } }
    gla_stage_vt(lds, tid, h, tok0, P);
    if (tid < 64) DEC[(size_t)u * 64 + tid] = __expf(BF[63 * 64 + tid]);
    LDS_WAIT(); __builtin_amdgcn_s_barrier(); asm volatile("" ::: "memory");
#pragma unroll
    for (int dt = 0; dt < 4; ++dt) { f32x4 acc = {0.f, 0.f, 0.f, 0.f};
#pragma unroll
        for (int k0 = 0; k0 < 64; k0 += 32) acc = __builtin_amdgcn_mfma_f32_16x16x32_bf16(gl_frag(lds, GL_VT, wave * 16 + fr, k0, fq), gl_frag(lds, GL_QI, dt * 16 + fr, k0, fq), acc, 0, 0, 0);
        *(f32x4*)(KV + ((size_t)u * 64 + dt * 16 + fr) * 128 + wave * 16 + 4 * fq) = acc; }
    LDS_WAIT(); __builtin_amdgcn_s_barrier(); asm volatile("" ::: "memory");
}
DEVI void gla_scan_b(int gtid, float* KV, const float* DEC, float* s_out) {
    const int dv = gtid & 127, dkq = (gtid >> 7) & 15, bh = gtid >> 11; float S[4] = {0.f, 0.f, 0.f, 0.f};
#pragma unroll 4
    for (int c = 0; c < 32; ++c) { const size_t u = (size_t)bh * 32 + c; float* kp = KV + (u * 64 + dkq * 4) * 128 + dv;
#pragma unroll
        for (int e = 0; e < 4; ++e) { const float kv = kp[e * 128], dc = DEC[u * 64 + dkq * 4 + e]; kp[e * 128] = S[e]; S[e] = dc * S[e] + kv; } }
#pragma unroll
    for (int e = 0; e < 4; ++e) s_out[((size_t)bh * 64 + dkq * 4 + e) * 128 + dv] = S[e];
}
DEVI void gla_unit_c(LAS unsigned char* lds, int tid, int u, const bf16* P, const float* GKL, const float* w_gk, const float* b_gk, const float* KV, const float* norm_g, bf16* O) {
    asm volatile("" : "+v"(tid));
    const int bh = u >> 5, ck = u & 31, b = bh >> 2, h = bh & 3; const size_t tok0 = (size_t)b * TP + ck * 64;
    const int lane = tid & 63, wave = tid >> 6, fr = lane & 15, fq = lane >> 4;
    gla_cumdecay(lds, tid, h, tok0, GKL, w_gk, b_gk);
    LAS float* BF = (LAS float*)(lds + GL_BF);
    { const int t = tid >> 3, d0 = (tid & 7) * 8; const v4u qq = *(const v4u*)(P + (tok0 + t) * NINP + h * 64 + d0), kq = *(const v4u*)(P + (tok0 + t) * NINP + 256 + h * 64 + d0);
        const unsigned wq[4] = {qq.x, qq.y, qq.z, qq.w}, wk[4] = {kq.x, kq.y, kq.z, kq.w}; float qo[8], ko[8];
#pragma unroll
        for (int e = 0; e < 8; ++e) { const float qv = __uint_as_float((e & 1) ? (wq[e >> 1] & 0xffff0000u) : (wq[e >> 1] << 16)), kv = __uint_as_float((e & 1) ? (wk[e >> 1] & 0xffff0000u) : (wk[e >> 1] << 16));
            const float bb = BF[t * 64 + d0 + e]; qo[e] = qv * 0.125f * __expf(bb); ko[e] = kv * __expf(-bb); }
        v4u a, c; a.x = pk2(qo[0], qo[1]); a.y = pk2(qo[2], qo[3]); a.z = pk2(qo[4], qo[5]); a.w = pk2(qo[6], qo[7]); c.x = pk2(ko[0], ko[1]); c.y = pk2(ko[2], ko[3]); c.z = pk2(ko[4], ko[5]); c.w = pk2(ko[6], ko[7]);
        *(LAS v4u*)(lds + GL_QI + (t * GL_LD + d0) * 2) = a; *(LAS v4u*)(lds + GL_KI + (t * GL_LD + d0) * 2) = c; }
    gla_stage_vt(lds, tid, h, tok0, P);
    { const int dk = tid >> 3, dv0 = (tid & 7) * 16; const float* sp = KV + ((size_t)u * 64 + dk) * 128 + dv0; LAS bf16* ST = (LAS bf16*)(lds + GL_ST);
#pragma unroll
        for (int q = 0; q < 4; ++q) { const f32x4 s4 = *(const f32x4*)(sp + 4 * q);
#pragma unroll
            for (int e = 0; e < 4; ++e) ST[(dv0 + 4 * q + e) * GL_LD + dk] = (bf16)f2bf(s4[e]); } }
    LDS_WAIT(); __builtin_amdgcn_s_barrier(); asm volatile("" ::: "memory");
#pragma unroll
    for (int q = 0; q < 2; ++q) { const int id = wave * 2 + q, tt = id >> 2, st = id & 3; f32x4 acc = {0.f, 0.f, 0.f, 0.f};
#pragma unroll
        for (int k0 = 0; k0 < 64; k0 += 32) acc = __builtin_amdgcn_mfma_f32_16x16x32_bf16(gl_frag(lds, GL_KI, st * 16 + fr, k0, fq), gl_frag(lds, GL_QI, tt * 16 + fr, k0, fq), acc, 0, 0, 0);
        const int t = tt * 16 + fr, s0 = st * 16 + 4 * fq;
#pragma unroll
        for (int e = 0; e < 4; ++e) if (s0 + e > t) acc[e] = 0.f;
        *(LAS unsigned long long*)(lds + GL_SC + (t * GL_LD + s0) * 2) = (unsigned long long)pk2(acc[0], acc[1]) | ((unsigned long long)pk2(acc[2], acc[3]) << 32); }
    LDS_WAIT(); __builtin_amdgcn_s_barrier(); asm volatile("" ::: "memory");
    const int tt = wave & 3, hv = wave >> 2; f32x4 o[4]; float ssq = 0.f;
#pragma unroll
    for (int dt = 0; dt < 4; ++dt) { f32x4 acc = {0.f, 0.f, 0.f, 0.f}; const int dvr = (hv * 4 + dt) * 16 + fr;
#pragma unroll
        for (int k0 = 0; k0 < 64; k0 += 32) { acc = __builtin_amdgcn_mfma_f32_16x16x32_bf16(gl_frag(lds, GL_VT, dvr, k0, fq), gl_frag(lds, GL_SC, tt * 16 + fr, k0, fq), acc, 0, 0, 0);
            acc = __builtin_amdgcn_mfma_f32_16x16x32_bf16(gl_frag(lds, GL_ST, dvr, k0, fq), gl_frag(lds, GL_QI, tt * 16 + fr, k0, fq), acc, 0, 0, 0); }
        o[dt] = acc; ssq += (acc[0] * acc[0] + acc[1] * acc[1]) + (acc[2] * acc[2] + acc[3] * acc[3]); }
    ssq += __shfl_xor(ssq, 16); ssq += __shfl_xor(ssq, 32);
    LAS float* RS = (LAS float*)(lds + GL_RS);
    if (fq == 0) RS[hv * 64 + tt * 16 + fr] = ssq;
    LDS_WAIT(); __builtin_amdgcn_s_barrier(); asm volatile("" ::: "memory");
    { const int t = tt * 16 + fr; const float rstd = rsqrtf((RS[t] + RS[64 + t]) * (1.f / 128.f) + 1e-5f); const size_t tok = tok0 + t;
#pragma unroll
        for (int dt = 0; dt < 4; ++dt) { const int dv = (hv * 4 + dt) * 16 + 4 * fq; const uint2 gg = *(const uint2*)(P + tok * NINP + 1024 + h * 128 + dv); const f32x4 ng = *(const f32x4*)(norm_g + dv);
            const float g0 = __uint_as_float(gg.x << 16), g1 = __uint_as_float(gg.x & 0xffff0000u), g2 = __uint_as_float(gg.y << 16), g3 = __uint_as_float(gg.y & 0xffff0000u);
            uint2 ov; ov.x = pk2(o[dt][0] * rstd * ng[0] * siluf_(g0), o[dt][1] * rstd * ng[1] * siluf_(g1)); ov.y = pk2(o[dt][2] * rstd * ng[2] * siluf_(g2), o[dt][3] * rstd * ng[3] * siluf_(g3));
            *(uint2*)(O + tok * D + h * 128 + dv) = ov; } }
    LDS_WAIT(); __builtin_amdgcn_s_barrier(); asm volatile("" ::: "memory");
}

__global__ void __launch_bounds__(NWAVES * 64, 2) mk_fwd(Args args) {
    extern __shared__ __attribute__((aligned(16))) unsigned char lds_raw[];
    LAS unsigned char* lds = (LAS unsigned char*)lds_raw;
    volatile LAS unsigned* MISC = (volatile LAS unsigned*)(lds + MISC_OFF);
    const int tid = threadIdx.x, lane = tid & 63, wave = __builtin_amdgcn_readfirstlane(tid >> 6), G = gridDim.x, blk = blockIdx.x;
#define LW() ({ unsigned char* p_ = args.ws; asm volatile("" : "+s"(p_)); p_; })
#define LO() ({ float* p_ = args.out; asm volatile("" : "+s"(p_)); p_; })
#define PTRS unsigned char* ws = LW(); float* out = LO(); float* MODS = (float*)(ws + WS_MODS); float* SP = (float*)(ws + WS_SP); bf16* H = (bf16*)(ws + WS_H); float* Z = (float*)(ws + WS_Z); bf16* ACT = (bf16*)(ws + WS_ACT); float* X = out; \
    (void)MODS; (void)SP; (void)H; (void)Z; (void)ACT; (void)X
    for (int u = tid; u < (LDS_BYTES - LDSCTL_OFF) / 4; u += NWAVES * 64) ((LAS unsigned*)(lds + LDSCTL_OFF))[u] = 0u;
    __syncthreads();
    { XcdBarrier b0_ = xcd_barrier_post((unsigned*)(LW() + WS_CTL) + CW_BAR, MISC + 8); (void)b0_; }
#define GRID_BAR() do { XcdBarrier b_; b_.bar = (unsigned*)(LW() + WS_CTL) + CW_BAR; b_.x = xb_xcc_id(); b_.st = MISC + 8; xcd_barrier(b_); if (XP == 6) xcd_barrier(b_); \
        if (PROBE && blk == 0 && tid == 0) ((unsigned long long*)(LW() + WS_CTL + 524288))[nst] = rt(); ++nst; } while (0)
    int nst = 0;
    if (PROBE && blk == 0 && tid == 0) ((unsigned long long*)(LW() + WS_CTL + 524288))[63] = rt();
    const int gw = blk * NWAVES + wave, NGW = G * NWAVES;
    const int gws = wave * G + blk;
    LAS float* wscr = (LAS float*)(lds + RING_OFF + wave * 16384);

    for (int xrep = 0; xrep < (XP == 1 ? 2 : 1); ++xrep) { PTRS;
        constexpr int I_UP = (D / 64) * (NUP / 32), I_DN = (FFP / 64) * (D / 32), I_IN = (D / 64) * (NINP / 32), I_GLU = (512 / 64) * (512 / 32), I_SQ = (D / 64) * (D / 32), I_RK = (KRK / 64) * (NRK / 32), I_L2 = (NL1 / 64) * (3072 / 32);
        constexpr int NITEMS = 4 * I_UP + 4 * I_DN + I_IN + I_GLU + 2 * I_SQ + I_RK + I_L2;
        for (int it = gw; it < NITEMS; it += NGW) {
            int r = it;
            if (r < 4 * I_UP) { const int q = r / I_UP, l = q >> 1, f = q & 1; r -= q * I_UP;
                const int kb = r / (NUP / 32), nb = r % (NUP / 32), pn = nb >> 3, half = (nb >> 2) & 1, c0 = pn * 128 + (nb & 3) * 32;
                bf16* dst = (bf16*)(ws + (l ? WS_WUP_L1 : WS_WUP_L0) + f * SZ_WUP) + (size_t)(nb * 32) * D;
                if (c0 >= FF) { SrcZero s; cvt_item(s, dst, D, 1, wscr, kb, lane); }
                else if (half) { SrcPlain s{INPD(f ? 17 : 14) + (size_t)l * D * FF + c0, D, FF - c0, FF}; cvt_item(s, dst, D, 1, wscr, kb, lane); }
                else { SrcPlain s{INPD(f ? 16 : 13) + (size_t)l * D * FF + c0, D, FF - c0, FF}; cvt_item(s, dst, D, 1, wscr, kb, lane); }
                continue; } r -= 4 * I_UP;
            if (r < 4 * I_DN) { const int q = r / I_DN, l = q >> 1, f = q & 1; r -= q * I_DN;
                SrcPlain s{INPD(f ? 18 : 15) + (size_t)l * FF * D, FF, D, D};
                cvt_item(s, (bf16*)(ws + (l ? WS_WDN_L1 : WS_WDN_L0) + f * SZ_WDN), FFP, D / 32, wscr, r, lane); continue; } r -= 4 * I_DN;
            if (r < I_IN) { SrcPlain s{INPD(19), D, NIN, NIN}; cvt_item(s, (bf16*)(ws + WS_WIN), D, NINP / 32, wscr, r, lane); continue; } r -= I_IN;
            if (r < I_GLU) { SrcPlain s{INPD(32), 512, 512, 512}; cvt_item(s, (bf16*)(ws + WS_WGLU), 512, 512 / 32, wscr, r, lane); continue; } r -= I_GLU;
            if (r < I_SQ) { SrcPlain s{INPD(20), D, D, D}; cvt_item(s, (bf16*)(ws + WS_WOUT), D, D / 32, wscr, r, lane); continue; } r -= I_SQ;
            if (r < I_SQ) { SrcPlain s{INPD(38), D, D, D}; cvt_item(s, (bf16*)(ws + WS_WO), D, D / 32, wscr, r, lane); continue; } r -= I_SQ;
            if (r < I_RK) { const int kb = r / (NRK / 32), nb = r % (NRK / 32), n0 = nb * 32; bf16* dst = (bf16*)(ws + WS_WRK) + (size_t)n0 * KRK;
                if (n0 < 1024) { SrcFold s{INPD(35) + n0, INPD(34) + 0 * 1024, 1024}; cvt_item(s, dst, KRK, 1, wscr, kb, lane); }
                else if (n0 < 2048) { SrcFold s{INPD(36) + (n0 - 1024), INPD(34) + 2 * 1024, 1024}; cvt_item(s, dst, KRK, 1, wscr, kb, lane); }
                else if (n0 < 3072) { SrcFold s{INPD(37) + (n0 - 2048), INPD(34) + 3 * 1024, 1024}; cvt_item(s, dst, KRK, 1, wscr, kb, lane); }
                else if (n0 < 3136) { SrcFold s{INPD(40) + (n0 - 3072), INPD(34) + 1 * 1024, 64}; cvt_item(s, dst, KRK, 1, wscr, kb, lane); }
                else if (n0 < 3200) { SrcFold s{INPD(43) + (n0 - 3136), INPD(34) + 4 * 1024, 64}; cvt_item(s, dst, KRK, 1, wscr, kb, lane); }
                else if (n0 < 3360) { SrcFold s{INPD(45) + (n0 - 3200), INPD(34) + 5 * 1024, 160}; cvt_item(s, dst, KRK, 1, wscr, kb, lane); }
                else { SrcZero s; cvt_item(s, dst, KRK, 1, wscr, kb, lane); }
                continue; } r -= I_RK;
            { const int kb = r / (3072 / 32), nb = r % (3072 / 32), n0 = nb * 32; bf16* dst = (bf16*)(ws + WS_WL2) + (size_t)n0 * NL1;
                if (n0 < 1024) { SrcBlk s{INPD(41) + n0, 0, 64}; cvt_item(s, dst, NL1, 1, wscr, kb, lane); }
                else if (n0 < 2048) { SrcBlk s{INPD(44) + (n0 - 1024), 64, 128}; cvt_item(s, dst, NL1, 1, wscr, kb, lane); }
                else { SrcBlk s{INPD(46) + (n0 - 2048), 128, 288}; cvt_item(s, dst, NL1, 1, wscr, kb, lane); } }
        }
        { float* STt = (float*)(ws + WS_ST); for (int i = blk * 512 + tid; i < 144 * 1024; i += G * 512) { const int r = i >> 10, k = i & 1023; float v = 0.f; if (r < 8) v = siluf_(INP(7)[r * 1024 + k]); else if (r < 136) v = siluf_(INP(8)[(r - 8) * 1024 + k]); STt[k * 144 + r] = v; } }
        if (blk == G - 1) for (int i = tid; i < 2048; i += NWAVES * 64) s5prep_one(i, INP(24), INP(25), INP(26), INP(27), INP(28), SP);
        if (blk >= G - 5 && blk < G - 1) { const int i = (G - 2 - blk) * 512 + tid; s5prep_pw(i, INP(24), INP(25), INP(26), SP); }
    }
    GRID_BAR();
    { PTRS; bf16* TM = (bf16*)(ws + WS_TM); bf16* HM = (bf16*)(ws + WS_HM);
        for (int xr = 0; xr < (XP == 10 ? 2 : 1); ++xr) for (int j = gws; j < 1152; j += NGW) mods_job(__builtin_amdgcn_readfirstlane(j), lane, (const float*)(ws + WS_ST), INPD(9), INPD(10), MODS);
        for (int j = NGW - 1 - gws; j < 32 * 17 + 32 * 16; j += NGW) { if (j < 544) s5_tm_job(j / 17, j % 17, lane, SP, INPD(29), INPD(30), INPD(31), TM); else s5_hm_job((j - 544) >> 4, (j - 544) & 15, lane, SP, HM); }
        for (int i = gw * 64 + lane; i < 32 * 128 * 256 / 8; i += NGW * 64) { const int g = i >> 12, r = i & 4095; *(v4u*)(HM + ((size_t)g * 256 + 128) * 256 + (size_t)r * 8) = (v4u){0u, 0u, 0u, 0u}; } }
    GRID_BAR();
    { PTRS; for (int row = gw; row < MTP; row += NGW) init_row(row, lane, INP(0), INP(1), MODS, X, H); }
    GRID_BAR();

#define GEMM_PHASE(EPI, Aptr, Bptr, NN, KK, ...) do { pg8::GemmX g_{(const pg8::bf16_t*)(Aptr), (const pg8::bf16_t*)(Bptr), MTP, NN, KK, KK, KK, -1}; pg8::StaticOrder S_; S_.init(MTP, NN, G, blk); pg8::EPI E_{__VA_ARGS__}; \
        pg8::gemm_phase<pg8::EPI, pg8::StaticOrder, true, true>(lds + RING_OFF, g_, S_, E_); } while (0)
#define GEMMX_PHASE(EPI, Aptr, Bptr, MM, NN, KK, LDA, LDB, GSH, ...) do { pg8::GemmX g_{(const pg8::bf16_t*)(Aptr), (const pg8::bf16_t*)(Bptr), MM, NN, KK, LDA, LDB, GSH}; pg8::StaticOrder S_; S_.init(MM, NN, G, blk); pg8::EPI E_{__VA_ARGS__}; \
        pg8::gemm_phase<pg8::EPI, pg8::StaticOrder, true, true>(lds + RING_OFF, g_, S_, E_); } while (0)
#define LN_PASS(l, idx, Hout, nsh, nsc) do { PTRS; for (int row = gw; row < MT; row += NGW) ln_row(row, lane, Z, INP(11) + ((l) * 3 + (idx)) * D, INP(12) + ((l) * 3 + (idx)) * D, X, Hout, nsh, nsc); } while (0)
#define FFN(l, f, which0, lnidx, HOUT, nshw, nscw) do { \
        { PTRS; GEMM_PHASE(EpiSwiglu, H, ws + ((l) ? WS_WUP_L1 : WS_WUP_L0) + (f) * SZ_WUP, NUP, D, (pg8::bf16_t*)ACT); if (XP == 2) { GEMM_PHASE(EpiSwiglu, H, ws + ((l) ? WS_WUP_L1 : WS_WUP_L0) + (f) * SZ_WUP, NUP, D, (pg8::bf16_t*)ACT); } } GRID_BAR(); \
        { PTRS; GEMM_PHASE(EpiResid, ACT, ws + ((l) ? WS_WDN_L1 : WS_WDN_L0) + (f) * SZ_WDN, D, FFP, X, Z, modp(MODS, l, (which0) + 2), 0.5f, 0); if (XP == 3) { GEMM_PHASE(EpiResid, ACT, ws + ((l) ? WS_WDN_L1 : WS_WDN_L0) + (f) * SZ_WDN, D, FFP, X, Z, modp(MODS, l, (which0) + 2), 0.5f, 0); } } GRID_BAR(); \
        LN_PASS(l, lnidx, HOUT, nshw, nscw); if (XP == 4) { LN_PASS(l, lnidx, HOUT, nshw, nscw); } GRID_BAR(); } while (0)

    FFN(0, 0, 0, 0, H, modp(MODS, 0, 3), modp(MODS, 0, 4));
#define L0PTRS PTRS; bf16* P = (bf16*)(ws + WS_P); float* GKL = (float*)(ws + WS_GKL); float* OGS = (float*)(ws + WS_OGS) - (size_t)NP * 512; bf16* Z5 = (bf16*)(ws + WS_Z5); bf16* O = (bf16*)(ws + WS_O); \
        bf16* UB = (bf16*)(ws + WS_UBUF); float* HL = (float*)(ws + WS_HLOC); float* KV = (float*)(ws + WS_KV); float* DEC = (float*)(ws + WS_DEC); (void)P; (void)GKL; (void)OGS; (void)Z5; (void)O; (void)UB; (void)HL; (void)KV; (void)DEC
    { L0PTRS; GEMM_PHASE(EpiInproj, H, ws + WS_WIN, NINP, D, (pg8::bf16_t*)P, GKL, (pg8::bf16_t*)UB); } GRID_BAR();
    { L0PTRS;
        GEMMX_PHASE(EpiHloc, UB, ws + WS_HM, 32768, 256, 256, 384, 256, 2, HL);
        for (int u = (blk + 128) & 255; u < 1024; u += 256) gla_unit_a(lds + RING_OFF, tid, u, P, GKL, INPD(21), INPD(22), KV, DEC);
        for (int s = gws; s < 1536; s += NGW) {
            if (s < 1024) gla_job(wscr, lane, s >> 3, (s >> 1) & 3, s & 1, P, GKL, INPD(21), INPD(22), NP, 1, INPD(2), out + O_GLA_S, OGS);
            else { const int j = s - 1024; s5_job(wscr, lane, j & 31, (j >> 5) * 8, 8, P, SP, INPD(29), INPD(30), INPD(31), NP, 1, INPD(3), INPD(4), out + O_S5RE_S, out + O_S5IM_S, Z5); } }
    }
    GRID_BAR();
    { L0PTRS;
        if (gws < 256) s5_carry_job(gws >> 5, gws & 31, lane, SP, HL, UB, out + O_S5RE_P, out + O_S5IM_P);
        if (blk >= 128) gla_scan_b((blk - 128) * 512 + tid, KV, DEC, out + O_GLA_P);
    } GRID_BAR();
    { L0PTRS;
        GEMMX_PHASE(EpiS5Y, UB, ws + WS_TM, 32768, 256, 384, 384, 384, 2, (pg8::bf16_t*)Z5);
        for (int u = (blk + 128) & 255; u < 1024; u += 256) gla_unit_c(lds + RING_OFF, tid, u, P, GKL, INPD(21), INPD(22), KV, INPD(23), O);
        for (int w = NP * 4 + gw; w < MT * 4; w += NGW) gla_post_one(w, lane, OGS, P, INP(23), O); } GRID_BAR();
    { L0PTRS; GEMM_PHASE(EpiGlu, Z5, ws + WS_WGLU, 512, 512, (const pg8::bf16_t*)Z5, (pg8::bf16_t*)O, INP(33)); } GRID_BAR();
    { L0PTRS; GEMM_PHASE(EpiResid, O, ws + WS_WOUT, D, D, X, Z, modp(MODS, 0, 5), 1.0f, 0); } GRID_BAR();
    LN_PASS(0, 1, H, modp(MODS, 0, 6), modp(MODS, 0, 7)); GRID_BAR();
    FFN(0, 1, 6, 2, H, modp(MODS, 1, 0), modp(MODS, 1, 1));
    FFN(1, 0, 0, 0, (bf16*)nullptr, (const float*)nullptr, (const float*)nullptr);
#define L1PTRS PTRS; bf16* A2 = (bf16*)(ws + WS_A2); bf16* R = (bf16*)(ws + WS_R); bf16* Kb = (bf16*)(ws + WS_K); bf16* V = (bf16*)(ws + WS_V); bf16* L1 = (bf16*)(ws + WS_L1A); \
        float* WD = (float*)(ws + WS_WD); bf16* AS = (bf16*)(ws + WS_AS); bf16* Gt = (bf16*)(ws + WS_G); (void)A2; (void)R; (void)Kb; (void)V; (void)L1; (void)WD; (void)AS; (void)Gt
    { L1PTRS; for (int row = gw; row < MTP; row += NGW) shiftcat_row(row, lane, X, MODS, INP(5), A2, out); } GRID_BAR();
    { L1PTRS; GEMM_PHASE(EpiRk, A2, ws + WS_WRK, NRK, KRK, (pg8::bf16_t*)R, (size_t)MTP * D, (pg8::bf16_t*)L1); if (XP == 7) { GEMM_PHASE(EpiRk, A2, ws + WS_WRK, NRK, KRK, (pg8::bf16_t*)R, (size_t)MTP * D, (pg8::bf16_t*)L1); } } GRID_BAR();
    { L1PTRS; GEMM_PHASE(EpiLora2, L1, ws + WS_WL2, 3072, NL1, WD, (pg8::bf16_t*)AS, (pg8::bf16_t*)Gt, INP(39), INP(42)); if (XP == 9) { GEMM_PHASE(EpiLora2, L1, ws + WS_WL2, 3072, NL1, WD, (pg8::bf16_t*)AS, (pg8::bf16_t*)Gt, INP(39), INP(42)); } } GRID_BAR();
    { L1PTRS;
        if (XP == 5 && blk < 128) wkv_chain<true>((LAS float*)(lds + RING_OFF), tid, blk >> 4, blk & 15, R, Kb, V, WD, AS, Gt, INPD(47), INPD(48), INPD(49), INPD(50), INPD(51), (float*)(ws + WS_L0 + 30 * MiB) + (size_t)blk * 8192);
        if (blk < 128) wkv_chain<false>((LAS float*)(lds + RING_OFF), tid, blk >> 4, blk & 15, R, Kb, V, WD, AS, Gt, INPD(47), INPD(48), INPD(49), INPD(50), INPD(51), out + O_WKV_P);
        else { const int sw = (blk - 128) * NWAVES + wave, nsw = (G - 128) * NWAVES;
            for (int s = sw; s < 2048; s += nsw) wkv_job(wscr, lane, s >> 4, s & 15, R, Kb, V, WD, AS, Gt, INPD(47), INPD(48), INPD(49), INPD(50), INPD(51), NP, 1, INPD(6), out + O_WKV_S); }
    }
    GRID_BAR();
    { L1PTRS; GEMM_PHASE(EpiResid, Gt, ws + WS_WO, D, D, X, Z, modp(MODS, 1, 5), 1.0f, 0); } GRID_BAR();
    LN_PASS(1, 1, H, modp(MODS, 1, 6), modp(MODS, 1, 7)); GRID_BAR();
    { PTRS; GEMM_PHASE(EpiSwiglu, H, ws + WS_WUP_L1 + SZ_WUP, NUP, D, (pg8::bf16_t*)ACT); if (XP == 2) { GEMM_PHASE(EpiSwiglu, H, ws + WS_WUP_L1 + SZ_WUP, NUP, D, (pg8::bf16_t*)ACT); } } GRID_BAR();
    { PTRS; GEMM_PHASE(EpiResid, ACT, ws + WS_WDN_L1 + SZ_WDN, D, FFP, X, Z, modp(MODS, 1, 8), 0.5f, 0); if (XP == 3) { GEMM_PHASE(EpiResid, ACT, ws + WS_WDN_L1 + SZ_WDN, D, FFP, X, Z, modp(MODS, 1, 8), 0.5f, 0); } } GRID_BAR();
    LN_PASS(1, 2, (bf16*)nullptr, (const float*)nullptr, (const float*)nullptr); if (XP == 4) { LN_PASS(1, 2, (bf16*)nullptr, (const float*)nullptr, (const float*)nullptr); }
#if PROBE
    {
        __syncthreads();
        PTRS; const unsigned long long* TS = (const unsigned long long*)(ws + WS_CTL + 524288);
        const float v1 = (float)(TS[PROBE_A1] - TS[PROBE_A0]) * 0.01f, v2 = (float)(TS[PROBE_B1] - TS[PROBE_B0]) * 0.01f * 10.0f;
        for (int row = NP + gw; row < MT; row += NGW) for (int j = 0; j < 16; ++j) X[(size_t)row * D + j * 64 + lane] = v1;
        if (blk == 0 && tid == 0) out[O_WKV_S] = v2;
    }
#endif
}

extern "C" void kernel_launch(void* const* d_in, const int* in_sizes, int n_in, void* d_out, int out_size, void* d_ws, size_t ws_size, hipStream_t stream) {
    static int grid = 0;
    if (grid == 0) {
        if (n_in != 52 || ws_size < WS_END) { fprintf(stderr, "kernel_launch: unexpected n_in %d or ws %zu\n", n_in, ws_size); grid = -1; return; }
        int dev = 0, cus = 0, per_cu = 0;
        if (hipGetDevice(&dev) != hipSuccess || hipDeviceGetAttribute(&cus, hipDeviceAttributeMultiprocessorCount, dev) != hipSuccess) { grid = -1; return; }
        if (hipFuncSetAttribute((const void*)mk_fwd, hipFuncAttributeMaxDynamicSharedMemorySize, LDS_BYTES) != hipSuccess) { fprintf(stderr, "hipFuncSetAttribute failed\n"); grid = -1; return; }
        if (hipOccupancyMaxActiveBlocksPerMultiprocessor(&per_cu, (const void*)mk_fwd, NWAVES * 64, LDS_BYTES) != hipSuccess || per_cu < 1) { fprintf(stderr, "occupancy query: %d\n", per_cu); per_cu = 1; }
        (void)hipGetLastError();
        grid = cus;
    }
    if (grid < 0) return;
    (void)hipMemsetAsync((char*)d_ws + WS_CTL, 0, CTL_ZERO_BYTES, stream);
    Args a{};
    for (int i = 0; i < 52; ++i) a.in[i] = (const float*)d_in[i];
    a.out = (float*)d_out; a.ws = (unsigned char*)d_ws;
    hipLaunchKernelGGL(mk_fwd, dim3(grid), dim3(NWAVES * 64), LDS_BYTES, stream, a);
}
```

```cpp
#include <hip/hip_runtime.h>
#include <cstdint>
#include <cstdio>

#ifndef PROBE
#define PROBE 0
#endif
#define XP 0
#define PROBE_A0 63
#define PROBE_A1 1
#define PROBE_B0 1
#define PROBE_B1 4
typedef unsigned short bf16;
typedef short bf16x8 __attribute__((ext_vector_type(8)));
typedef float f32x4 __attribute__((ext_vector_type(4)));
#define DEVI __device__ __forceinline__
__device__ __forceinline__ void mk_syncthreads() { asm volatile("s_waitcnt vmcnt(0) lgkmcnt(0)" ::: "memory"); __builtin_amdgcn_s_barrier(); asm volatile("" ::: "memory"); }
#define __syncthreads() mk_syncthreads()

constexpr int D = 1024, NP = 16384, NS = 128, MT = NP + NS, MTP = 16640, TP = 2048, BP = 8;
constexpr int FF = 2752, FFP = 2816, NUP = 2 * FFP;
constexpr int NIN = 2064, NINP = 2304;
constexpr int NRK = 3584, KRK = 2048, NL1 = 384;
constexpr int NMODROW = 136;
constexpr float ALPHA = 1.41421356237309515f;

constexpr size_t O_Y = 0, O_GLA_P = 16908288, O_S5RE_P = 17170432, O_S5IM_P = 17186816, O_SHIFT_P = 17203200, O_WKV_P = 17211392,
                 O_GLA_S = 17735680, O_S5RE_S = 21929984, O_S5IM_S = 22192128, O_SHIFT_S = 22454272, O_WKV_S = 22585344;

constexpr size_t MiB = 1u << 20;
constexpr size_t WS_CTL = 0, CTL_ZERO_BYTES = 1 * MiB;
constexpr size_t WS_MODS = 1 * MiB, WS_SP = 12 * MiB, WS_ST = 344 * MiB, WS_ZS = 345 * MiB;
constexpr size_t WS_W = 13 * MiB;
constexpr size_t SZ_WUP = (size_t)NUP * D * 2;
constexpr size_t SZ_WDN = (size_t)D * FFP * 2;
constexpr size_t WS_L0 = WS_W;
constexpr size_t WS_WUP_L0 = WS_L0, WS_WDN_L0 = WS_L0 + 22 * MiB, WS_WIN = WS_L0 + 33 * MiB, WS_WGLU = WS_WIN + 4608 * 1024, WS_WOUT = WS_WGLU + 512 * 1024;
constexpr size_t WS_L1 = WS_L0 + 40 * MiB;
constexpr size_t WS_WUP_L1 = WS_L1, WS_WDN_L1 = WS_L1 + 22 * MiB, WS_WRK = WS_L1 + 33 * MiB, WS_WL2 = WS_WRK + 14 * MiB, WS_WO = WS_WL2 + 2304 * 1024;
static_assert(WS_WO + 2 * MiB <= 105 * MiB, "W region");
constexpr size_t WS_H = 105 * MiB, WS_Z = 138 * MiB, WS_ACT = 203 * MiB, WS_S2 = 293 * MiB, WS_END = 346 * MiB;
constexpr size_t WS_P = WS_ACT, WS_GKL = 277 * MiB, WS_Z5 = WS_Z, WS_O = WS_H, WS_DEC = 195 * MiB, WS_OGS = 196 * MiB, WS_KV = WS_S2;
constexpr size_t WS_UBUF = 155 * MiB, WS_HLOC = 179 * MiB, WS_HM = 326 * MiB, WS_TM = 330 * MiB;
constexpr size_t WS_A2 = WS_ACT, WS_K = WS_Z, WS_R = WS_Z - (size_t)MTP * D * 2, WS_V = WS_Z + (size_t)MTP * D * 2, WS_L1A = WS_L0, WS_WRAW = WS_ACT, WS_YB = WS_ACT + (size_t)MTP * D * 2, WS_BON = WS_L0 + 30 * MiB, WS_AS = 268 * MiB, WS_G = WS_AS + (size_t)MTP * D * 2;
static_assert(WS_G + (size_t)MTP * D * 2 <= WS_END, "ws");
constexpr int CW_TMO = 0, CW_BAR = 4096;

#define GAS __attribute__((address_space(1)))
#define LAS __attribute__((address_space(3)))
typedef unsigned short bf16;
typedef unsigned v4u __attribute__((ext_vector_type(4)));
typedef float f32x4 __attribute__((ext_vector_type(4)));
typedef short bf16x8 __attribute__((ext_vector_type(8)));
typedef GAS unsigned gu32;
typedef GAS unsigned long long gu64;
#define RLX_AGENT __ATOMIC_RELAXED, __HIP_MEMORY_SCOPE_AGENT
#define LDS_WAIT() asm volatile("s_waitcnt lgkmcnt(0)" ::: "memory")
#define VM_WAIT() asm volatile("s_waitcnt vmcnt(0)" ::: "memory")
__device__ __forceinline__ unsigned long long rt() { return __builtin_amdgcn_s_memrealtime(); }
__device__ __forceinline__ unsigned f2bf(float f) { unsigned u = __builtin_bit_cast(unsigned, f); return (u + 0x7fffu + ((u >> 16) & 1u)) >> 16; }
__device__ __forceinline__ unsigned pk2(float lo, float hi) { return f2bf(lo) | (f2bf(hi) << 16); }

#define XB_TMO      128
#define XB_XCNT(j)  (256  + 64 * (j))
#define XB_XSUB(j)  (1280 + 64 * (j))
#define XB_XGEN(j)  (2304 + 64 * (j))
#define XB_TOP      3328
#define XB_TOPGEN   3392
#define XCD_BAR_WORDS 3456
#define XB_SPIN_CAP (1u << 18)

__device__ __forceinline__ unsigned xb_ld(unsigned* p)              { return __hip_atomic_load(p, __ATOMIC_RELAXED, __HIP_MEMORY_SCOPE_AGENT); }
__device__ __forceinline__ unsigned xb_add(unsigned* p, unsigned v) { return __hip_atomic_fetch_add(p, v, __ATOMIC_RELAXED, __HIP_MEMORY_SCOPE_AGENT); }
__device__ __forceinline__ unsigned xb_xcc_id() { return (unsigned)__builtin_amdgcn_s_getreg((3 << 11) | 20) & 0xFu; }
#define XB_SPIN(cond, bar) do { unsigned _sp = 0; while (cond) { __builtin_amdgcn_s_sleep(1); \
    if ((++_sp & 255u) == 0u) { if (xb_ld(&(bar)[XB_TMO])) break; if (_sp > XB_SPIN_CAP) { atomicAdd(&(bar)[XB_TMO], 1u); break; } } } } while (0)

struct XcdBarrier {
    unsigned* bar; unsigned x;
    volatile LAS unsigned* st;
};

__device__ __forceinline__ XcdBarrier xcd_barrier_post(unsigned* bar, volatile LAS unsigned* st) {
    XcdBarrier b; b.bar = bar; b.x = xb_xcc_id(); b.st = st;
    if (threadIdx.x == 0) (void)xb_add(&bar[XB_XCNT(b.x)], 1u);
    return b;
}
__device__ __forceinline__ void xcd_barrier_complete(unsigned* bar, unsigned x, unsigned& nloc, unsigned& nx) {
    const unsigned G = gridDim.x * gridDim.y * gridDim.z;
    unsigned sum, cnt, mine, sp = 0u;
    for (;;) {
        sum = 0u; cnt = 0u; mine = 0u;
#pragma unroll
        for (unsigned j = 0; j < 16; ++j) { const unsigned c = xb_ld(&bar[XB_XCNT(j)]); sum += c; cnt += (c > 0u) ? 1u : 0u; mine = (j == x) ? c : mine; }
        if (sum == G) break;
        __builtin_amdgcn_s_sleep(1);
        if ((++sp & 255u) == 0u) { if (xb_ld(&bar[XB_TMO])) break; if (sp > XB_SPIN_CAP) { atomicAdd(&bar[XB_TMO], 1u); break; } }
    }
    nloc = mine > 0u ? mine : 1u; nx = cnt > 0u ? cnt : 1u;
}

__device__ __forceinline__ void xcd_barrier(const XcdBarrier& b) {
    asm volatile("s_waitcnt vmcnt(0)" ::: "memory");
    __syncthreads();
    if (threadIdx.x == 0) {
        unsigned* bar = b.bar;
        __builtin_amdgcn_s_waitcnt(0);
        unsigned nloc = b.st[0], nx = b.st[1];
        if (nloc == 0u) { xcd_barrier_complete(bar, b.x, nloc, nx); b.st[0] = nloc; b.st[1] = nx; }
        const unsigned old = xb_add(&bar[XB_XSUB(b.x)], 1u);
        const unsigned gen = old / nloc;
        if (old + 1u == (gen + 1u) * nloc) {
            __builtin_amdgcn_fence(__ATOMIC_RELEASE, "agent");
            asm volatile("s_waitcnt vmcnt(0)" ::: "memory");
            const unsigned og = xb_add(&bar[XB_TOP], 1u);
            const unsigned tg = og / nx;
            if (og + 1u == (tg + 1u) * nx) xb_add(&bar[XB_TOPGEN], 1u);
            else XB_SPIN(xb_ld(&bar[XB_TOPGEN]) == tg, bar);
            __builtin_amdgcn_fence(__ATOMIC_ACQUIRE, "agent");
            xb_add(&bar[XB_XGEN(b.x)], 1u);
            asm volatile("s_waitcnt vmcnt(0)" ::: "memory");
        } else {
            XB_SPIN(xb_ld(&bar[XB_XGEN(b.x)]) == gen, bar);
            __builtin_amdgcn_fence(__ATOMIC_ACQUIRE, "agent");
            asm volatile("s_waitcnt vmcnt(0)" ::: "memory");
        }
    }
    __syncthreads();
}

DEVI float bf2f(unsigned short h) { return __uint_as_float(((unsigned)h) << 16); }
DEVI int mrow(int i) { return i < NP ? (i >> 11) : (8 + i - NP); }
DEVI float sigmoidf_(float x) { return 1.0f / (1.0f + __expf(-x)); }
DEVI float siluf_(float x) { return x / (1.0f + __expf(-x)); }
DEVI float softplusf_(float x) { return fmaxf(x, 0.f) + log1pf(__expf(-fabsf(x))); }
DEVI float gelu_tanh(float x) { const float u = 0.7978845608028654f * (x + 0.044715f * x * x * x); return 0.5f * x * (1.0f + tanhf(u)); }
DEVI float wave_sum(float v) {
#pragma unroll
    for (int o = 1; o < 64; o <<= 1) v += __shfl_xor(v, o);
    return v;
}
__host__ __device__ __forceinline__ const float* modp(const float* mods, int l, int which) { return mods + (size_t)l * NMODROW * 9216 + which * 1024; }

namespace pg8 {
#define PG8_LAS __attribute__((address_space(3)))
typedef unsigned short bf16_t;
typedef short bf16x8 __attribute__((ext_vector_type(8)));
typedef float f32x4 __attribute__((ext_vector_type(4)));
typedef unsigned u32x4 __attribute__((ext_vector_type(4)));
constexpr int BM = 256, BK = 64, HALF = 128, HTB = HALF * BK * 2  , STAGE_BYTES = 8 * HTB, NXCD = 8, WGM = 8;

__host__ __device__ __forceinline__ int lds_byte(int r, int c) { const int st = (r >> 4) * 2 + (c >> 5), rr = r & 15, cc = c & 31, ob = rr * 64 + cc * 2; return st * 1024 + (ob ^ (((ob >> 9) & 1) << 5)); }
__host__ __device__ __forceinline__ void stage_rc(int b, int& R, int& C) { const int st = b / 1024, sb = b % 1024, swz = sb ^ (((sb >> 9) & 1) << 5); R = (st >> 1) * 16 + swz / 64; C = (st & 1) * 32 + (swz % 64) / 2; }
__host__ __device__ __forceinline__ int perm32(int rho) { const int n = rho >> 4, i = rho & 15; return 8 * (i >> 2) + 4 * n + (i & 3); }

struct Unit { int pm, pn, ko; };
struct Gemm { const bf16_t* A; const bf16_t* Bt; int M, N, K; };
struct GemmX { const bf16_t* A; const bf16_t* Bt; int M, N, K, lda, ldb, gsh; };

struct StaticOrder {
    int nM, nN, nwg, G, c;
    __host__ __device__ __forceinline__ void init(int M, int N, int G_, int c_) { nM = M / BM; nN = N / BM; nwg = nM * nN; G = G_; c = c_; }
    __host__ __device__ __forceinline__ bool next(int i, Unit& u) const {
        const long L = (long)i * G + c; if (L >= nwg) return false;
        int wgid = (int)L; { const int q = nwg / NXCD, r = nwg % NXCD, xcd = wgid % NXCD, off = wgid / NXCD; wgid = (xcd < r ? xcd * (q + 1) : r * (q + 1) + (xcd - r) * q) + off; }
        const int nig = WGM * nN, gid = wgid / nig, fm = gid * WGM, gsz = (nM - fm) < WGM ? (nM - fm) : WGM;
        u.pm = fm + ((wgid % nig) % gsz); u.pn = (wgid % nig) / gsz; u.ko = 0; return true;
    }
    __device__ __forceinline__ void a_ready(const Unit&) const {}
    __device__ __forceinline__ void done(const Unit&) const {}
};

struct SplitOrder {
    int pm0, nN, nsplit, kspl, G, c;
    __host__ __device__ __forceinline__ bool next(int i, Unit& u) const { const int L = i * G + c; if (L >= nsplit * nN) return false; u.pm = pm0; u.pn = L % nN; u.ko = (L / nN) * kspl; return true; }
    __device__ __forceinline__ void a_ready(const Unit&) const {}
    __device__ __forceinline__ void done(const Unit&) const {}
};

__device__ __forceinline__ unsigned cvt_pk_bf16(float lo, float hi) { unsigned r; asm volatile("v_cvt_pk_bf16_f32 %0, %1, %2" : "=v"(r) : "v"(lo), "v"(hi)); return r; }
__device__ __forceinline__ float fsilu(float x) { return x * __builtin_amdgcn_rcpf(1.0f + __builtin_amdgcn_exp2f(-1.44269504089f * x)); }
__device__ __forceinline__ float fsigm(float x) { return __builtin_amdgcn_rcpf(1.0f + __builtin_amdgcn_exp2f(-1.44269504089f * x)); }
__device__ __forceinline__ u32x4 pack8(const f32x4 a, const f32x4 b) { u32x4 w; w.x = cvt_pk_bf16(a[0], a[1]); w.y = cvt_pk_bf16(a[2], a[3]); w.z = cvt_pk_bf16(b[0], b[1]); w.w = cvt_pk_bf16(b[2], b[3]); return w; }
struct EpiSwiglu { static constexpr bool PERM = true, AFTER_DRAIN = false; bf16_t* ACT;
    __device__ __forceinline__ void operator()(const f32x4 (&acc)[2][2][4][2], const Unit& u, int wr, int wc, int fr, int fq) const {
        const int row0 = u.pm * BM + wr * 64 + fr, col0 = u.pn * 128 + wc * 32 + 8 * fq;
#pragma unroll
        for (int ai = 0; ai < 2; ++ai)
#pragma unroll
            for (int m = 0; m < 4; ++m) { f32x4 o0, o1;
#pragma unroll
                for (int e = 0; e < 4; ++e) { o0[e] = fsilu(acc[ai][0][m][0][e]) * acc[ai][1][m][0][e]; o1[e] = fsilu(acc[ai][0][m][1][e]) * acc[ai][1][m][1][e]; }
                *(u32x4*)(ACT + (size_t)(row0 + ai * HALF + m * 16) * 2816 + col0) = pack8(o0, o1); }
    } };
struct EpiResid { static constexpr bool PERM = true, AFTER_DRAIN = false; const float* X; float* Z; const float* gate; float rc; int pad;
    __device__ __forceinline__ void operator()(const f32x4 (&acc)[2][2][4][2], const Unit& u, int wr, int wc, int fr, int fq) const {
        const int row0 = u.pm * BM + wr * 64 + fr;
#pragma unroll
        for (int ai = 0; ai < 2; ++ai) {
#pragma unroll
            for (int m = 0; m < 4; ++m) { const int row = row0 + ai * HALF + m * 16; const int mr = row < 16384 ? (row >> 11) : (8 + row - 16384);
#pragma unroll
                for (int bj = 0; bj < 2; ++bj)
#pragma unroll
                    for (int n = 0; n < 2; ++n) { const int c = u.pn * BM + bj * HALF + wc * 32 + 8 * fq + 4 * n;
                        const f32x4 x = *(const f32x4*)(X + (size_t)row * 1024 + c), g = *(const f32x4*)(gate + (size_t)mr * 9216 + c);
                        *(f32x4*)(Z + (size_t)row * 1024 + c) = x * 1.41421356237309515f + (g + 1.0f) * rc * acc[ai][bj][m][n]; } } }
    } };
struct EpiInproj { static constexpr bool PERM = true, AFTER_DRAIN = false; bf16_t* P; float* GKL; bf16_t* UB;
    __device__ __forceinline__ void operator()(const f32x4 (&acc)[2][2][4][2], const Unit& u, int wr, int wc, int fr, int fq) const {
        const int row0 = u.pm * BM + wr * 64 + fr;
#pragma unroll
        for (int ai = 0; ai < 2; ++ai)
#pragma unroll
            for (int m = 0; m < 4; ++m) { const int row = row0 + ai * HALF + m * 16;
#pragma unroll
                for (int bj = 0; bj < 2; ++bj) { const int c = u.pn * BM + bj * HALF + wc * 32 + 8 * fq;
                    const u32x4 pk = pack8(acc[ai][bj][m][0], acc[ai][bj][m][1]);
                    *(u32x4*)(P + (size_t)row * 2304 + c) = pk;
                    if (c >= 1552 && c < 2064 && row < 16384) { const int cu = c - 1552; *(u32x4*)(UB + ((size_t)((cu >> 4) * 1024 + (row >> 4))) * 384 + (row & 15) * 16 + (cu & 15)) = pk; }
                    if (c >= 1536 && c < 1552) { *(f32x4*)(GKL + (size_t)row * 16 + (c - 1536)) = acc[ai][bj][m][0]; *(f32x4*)(GKL + (size_t)row * 16 + (c - 1536) + 4) = acc[ai][bj][m][1]; } } }
    } };
struct EpiGlu { static constexpr bool PERM = true, AFTER_DRAIN = false; const bf16_t* Z5; bf16_t* O; const float* bg;
    __device__ __forceinline__ void operator()(const f32x4 (&acc)[2][2][4][2], const Unit& u, int wr, int wc, int fr, int fq) const {
        const int row0 = u.pm * BM + wr * 64 + fr;
#pragma unroll
        for (int ai = 0; ai < 2; ++ai)
#pragma unroll
            for (int m = 0; m < 4; ++m) { const int row = row0 + ai * HALF + m * 16;
#pragma unroll
                for (int bj = 0; bj < 2; ++bj) { const int c = u.pn * BM + bj * HALF + wc * 32 + 8 * fq;
                    const u32x4 zz = *(const u32x4*)(Z5 + (size_t)row * 512 + c); const f32x4 b0 = *(const f32x4*)(bg + c), b1 = *(const f32x4*)(bg + c + 4);
                    f32x4 o0, o1;
#pragma unroll
                    for (int e = 0; e < 4; ++e) { const unsigned w0 = zz[e >> 1], w1 = zz[2 + (e >> 1)];
                        const float z0 = __uint_as_float((e & 1) ? (w0 & 0xffff0000u) : (w0 << 16)), z1 = __uint_as_float((e & 1) ? (w1 & 0xffff0000u) : (w1 << 16));
                        o0[e] = z0 * fsigm(acc[ai][bj][m][0][e] + b0[e]); o1[e] = z1 * fsigm(acc[ai][bj][m][1][e] + b1[e]); }
                    *(u32x4*)(O + (size_t)row * 1024 + 512 + c) = pack8(o0, o1); } }
    } };
__device__ __forceinline__ float ftanh(float x) { const float e = __builtin_amdgcn_exp2f(-2.88539008178f * fabsf(x)); const float t = (1.0f - e) * __builtin_amdgcn_rcpf(1.0f + e); return x < 0.f ? -t : t; }
struct EpiRk { static constexpr bool PERM = true, AFTER_DRAIN = false; bf16_t* R; size_t rkv_stride; bf16_t* L1;
    __device__ __forceinline__ void operator()(const f32x4 (&acc)[2][2][4][2], const Unit& u, int wr, int wc, int fr, int fq) const {
        const int row0 = u.pm * BM + wr * 64 + fr;
#pragma unroll
        for (int ai = 0; ai < 2; ++ai)
#pragma unroll
            for (int m = 0; m < 4; ++m) { const int row = row0 + ai * HALF + m * 16;
#pragma unroll
                for (int bj = 0; bj < 2; ++bj) { const int c = u.pn * BM + bj * HALF + wc * 32 + 8 * fq;
                    if (c < 3072) { bf16_t* dst = R + (size_t)(c >> 10) * rkv_stride; *(u32x4*)(dst + (size_t)row * 1024 + (c & 1023)) = pack8(acc[ai][bj][m][0], acc[ai][bj][m][1]); }
                    else { const int cc = c - 3072; if (cc < 384) { f32x4 o0 = acc[ai][bj][m][0], o1 = acc[ai][bj][m][1];
                        if (cc < 64) {
#pragma unroll
                            for (int e = 0; e < 4; ++e) { o0[e] = ftanh(o0[e]); o1[e] = ftanh(o1[e]); } }
                        else if (cc >= 128 && cc < 288) {
#pragma unroll
                            for (int e = 0; e < 4; ++e) { o0[e] = fsigm(o0[e]); o1[e] = fsigm(o1[e]); } }
                        else if (cc >= 288) { o0 = (f32x4){0.f, 0.f, 0.f, 0.f}; o1 = o0; }
                        *(u32x4*)(L1 + (size_t)row * 384 + cc) = pack8(o0, o1); } } } }
    } };
struct EpiLora2 { static constexpr bool PERM = true, AFTER_DRAIN = false; bf16_t* WRAW; bf16_t* AS; bf16_t* G; const float* a0;
    __device__ __forceinline__ void operator()(const f32x4 (&acc)[2][2][4][2], const Unit& u, int wr, int wc, int fr, int fq) const {
        const int row0 = u.pm * BM + wr * 64 + fr;
#pragma unroll
        for (int ai = 0; ai < 2; ++ai)
#pragma unroll
            for (int m = 0; m < 4; ++m) { const int row = row0 + ai * HALF + m * 16;
#pragma unroll
                for (int bj = 0; bj < 2; ++bj) { const int c = u.pn * BM + bj * HALF + wc * 32 + 8 * fq;
                    if (c < 1024) *(u32x4*)(WRAW + (size_t)row * 1024 + c) = pack8(acc[ai][bj][m][0], acc[ai][bj][m][1]);
                    else if (c < 2048) { const f32x4 a0v = *(const f32x4*)(a0 + c - 1024), a1v = *(const f32x4*)(a0 + c - 1024 + 4); f32x4 o0, o1;
#pragma unroll
                        for (int e = 0; e < 4; ++e) { o0[e] = fsigm(a0v[e] + acc[ai][bj][m][0][e]); o1[e] = fsigm(a1v[e] + acc[ai][bj][m][1][e]); }
                        *(u32x4*)(AS + (size_t)row * 1024 + c - 1024) = pack8(o0, o1); }
                    else *(u32x4*)(G + (size_t)row * 1024 + c - 2048) = pack8(acc[ai][bj][m][0], acc[ai][bj][m][1]); } }
    } };
struct EpiHloc { static constexpr bool PERM = true, AFTER_DRAIN = false; float* HL;
    __device__ __forceinline__ void operator()(const f32x4 (&acc)[2][2][4][2], const Unit& u, int wr, int wc, int fr, int fq) const {
        const int row0 = u.pm * BM + wr * 64 + fr, c = wc * 32 + 8 * fq;
#pragma unroll
        for (int ai = 0; ai < 2; ++ai)
#pragma unroll
            for (int m = 0; m < 4; ++m) { float* p = HL + (size_t)(row0 + ai * HALF + m * 16) * 128 + c; *(f32x4*)p = acc[ai][0][m][0]; *(f32x4*)(p + 4) = acc[ai][0][m][1]; }
    } };
__device__ __forceinline__ float fgelu(float x) { const float u2 = 1.5957691216057308f * (x + 0.044715f * x * x * x); return x * fsigm(u2); }
struct EpiS5Y { static constexpr bool PERM = true, AFTER_DRAIN = false; bf16_t* Z5;
    __device__ __forceinline__ void operator()(const f32x4 (&acc)[2][2][4][2], const Unit& u, int wr, int wc, int fr, int fq) const {
        const int row0 = u.pm * BM + wr * 64 + fr;
#pragma unroll
        for (int ai = 0; ai < 2; ++ai)
#pragma unroll
            for (int m = 0; m < 4; ++m) { const int row = row0 + ai * HALF + m * 16, g = row >> 10, chunk = row & 1023;
#pragma unroll
                for (int bj = 0; bj < 2; ++bj) { const int c = bj * HALF + wc * 32 + 8 * fq, t = c >> 4, co = c & 15; f32x4 o0, o1;
#pragma unroll
                    for (int e = 0; e < 4; ++e) { o0[e] = fgelu(acc[ai][bj][m][0][e]); o1[e] = fgelu(acc[ai][bj][m][1][e]); }
                    *(u32x4*)(Z5 + (size_t)(chunk * 16 + t) * 512 + g * 16 + co) = pack8(o0, o1); } }
    } };

struct EpiResidS { static constexpr bool PERM = true, AFTER_DRAIN = false; float* ZS; const float* gate; float rc; int pad;
    __device__ __forceinline__ void operator()(const f32x4 (&acc)[2][2][4][2], const Unit& u, int wr, int wc, int fr, int fq) const {
        const int r0 = wr * 64 + fr;
#pragma unroll
        for (int m = 0; m < 4; ++m) { const int r = r0 + m * 16; const int mr = 8 + r;
#pragma unroll
            for (int bj = 0; bj < 2; ++bj)
#pragma unroll
                for (int n = 0; n < 2; ++n) { const int c = u.pn * BM + bj * HALF + wc * 32 + 8 * fq + 4 * n; const f32x4 g = *(const f32x4*)(gate + (size_t)mr * 9216 + c); const f32x4 v = (g + 1.0f) * rc * acc[0][bj][m][n];
#pragma unroll
                    for (int e = 0; e < 4; ++e) __hip_atomic_fetch_add(ZS + (size_t)r * 1024 + c + e, v[e], __ATOMIC_RELAXED, __HIP_MEMORY_SCOPE_AGENT); } }
    } };
template <class Epi, class Sched, bool ALIGN_EPI = false, bool SP2 = false>
__device__ __forceinline__ void gemm_phase(PG8_LAS unsigned char* lds, const GemmX g, const Sched& S, const Epi& E) {
    int tid_ = threadIdx.x; asm volatile("" : "+v"(tid_));
    const int tid = tid_, wid = __builtin_amdgcn_readfirstlane(tid >> 6), lane = tid & 63, wr = wid >> 2, wc = wid & 3, fr = lane & 15, fq = lane >> 4;
    int K_ = g.K; asm volatile("" : "+s"(K_));
    const int K = K_, nt = K / BK;
    int lda_ = g.lda, ldb_ = g.ldb; asm volatile("" : "+s"(lda_), "+s"(ldb_)); const int lda = lda_, ldb = ldb_, gsh = g.gsh, nNb = g.N / BM;
    unsigned voffA[2], voffB[2];
#pragma unroll
    for (int i = 0; i < 2; ++i) { int R, C; stage_rc(tid * 16 + i * 8192, R, C); const int Rb = Epi::PERM ? ((R & ~31) + perm32(R & 31)) : R;
        voffA[i] = (unsigned)(R * lda + C) * 2u; voffB[i] = (unsigned)(Rb * ldb + C) * 2u; }
    const size_t kstep = (size_t)(BK * 2);
    const size_t hstepA = (size_t)HALF * lda * 2, hstepB = (size_t)HALF * ldb * 2;
    const size_t tstepA = 2 * hstepA, tstepB = 2 * hstepB;
#define PG8_BTILE(u_) ((size_t)(gsh >= 0 ? ((u_).pm >> gsh) * nNb + (u_).pn : (u_).pn))
    const unsigned ldsw = (unsigned)wid * 1024u;
    const int aoff = lds_byte(wr * 64 + fr, fq * 8), boff = lds_byte(wc * 32 + fr, fq * 8);
#define PG8_SA(b, h) (((b) * 2 + (h)) * HTB)
#define PG8_SB(b, h) ((4 + (b) * 2 + (h)) * HTB)
#define PG8_STAGE(bufoff, gbase, voff) do { _Pragma("unroll") for (int _i = 0; _i < 2; ++_i) \
        __builtin_amdgcn_global_load_lds((const unsigned*)((const char*)(gbase) + (voff)[_i]), (PG8_LAS unsigned*)(lds + (bufoff) + ldsw + _i * 8192), 16, 0, 0); } while (0)
#define PG8_LDA(dst, b, h) do { _Pragma("unroll") for (int m = 0; m < 4; ++m) _Pragma("unroll") for (int k = 0; k < 2; ++k) dst[m][k] = *(const PG8_LAS bf16x8*)(lds + PG8_SA(b, h) + aoff + m * 2048 + k * 1024); } while (0)
#define PG8_LDB(dst, b, h) do { _Pragma("unroll") for (int n = 0; n < 2; ++n) _Pragma("unroll") for (int k = 0; k < 2; ++k) dst[n][k] = *(const PG8_LAS bf16x8*)(lds + PG8_SB(b, h) + boff + n * 2048 + k * 1024); } while (0)
#define PG8_MMA(ai, bj, At, Bt) do { __builtin_amdgcn_s_setprio(1); _Pragma("unroll") for (int m = 0; m < 4; ++m) _Pragma("unroll") for (int n = 0; n < 2; ++n) _Pragma("unroll") for (int k = 0; k < 2; ++k) \
        acc[ai][bj][m][n] = __builtin_amdgcn_mfma_f32_16x16x32_bf16(Bt[n][k], At[m][k], acc[ai][bj][m][n], 0, 0, 0); __builtin_amdgcn_s_setprio(0); } while (0)
#define PG8_WAIT_V(n) asm volatile("s_waitcnt vmcnt(" #n ")" ::: "memory")
#define PG8_WAIT_L(n) asm volatile("s_waitcnt lgkmcnt(" #n ")" ::: "memory")
#define PG8_BAR __builtin_amdgcn_s_barrier()
#define PG8_SCHED __builtin_amdgcn_sched_barrier(0)
    Unit cur, nxt; int ui = 0;
    if (!S.next(0, cur)) return;
    f32x4 acc[2][2][4][2];
#pragma unroll
    for (int a = 0; a < 2; ++a)
#pragma unroll
        for (int b = 0; b < 2; ++b)
#pragma unroll
            for (int m = 0; m < 4; ++m)
#pragma unroll
                for (int n = 0; n < 2; ++n) acc[a][b][m][n] = (f32x4){0.f, 0.f, 0.f, 0.f};
    bf16x8 At[4][2], B0[2][2], B1[2][2];
    const char* cA = (const char*)g.A + (size_t)cur.pm * tstepA + (size_t)cur.ko * 2; const char* cB = (const char*)g.Bt + PG8_BTILE(cur) * tstepB + (size_t)cur.ko * 2;
    S.a_ready(cur);
    if constexpr (SP2) {
        PG8_STAGE(PG8_SB(0, 0), cB, voffB); PG8_STAGE(PG8_SB(0, 1), cB + hstepB, voffB); PG8_STAGE(PG8_SA(0, 0), cA, voffA); PG8_STAGE(PG8_SA(0, 1), cA + hstepA, voffA);
        if (wr == 1) PG8_BAR;
        PG8_WAIT_V(2); PG8_BAR;
        PG8_STAGE(PG8_SB(1, 0), cB + kstep, voffB); PG8_STAGE(PG8_SA(1, 0), cA + kstep, voffA); PG8_STAGE(PG8_SB(1, 1), cB + hstepB + kstep, voffB);
        PG8_WAIT_V(6); PG8_BAR;
    } else {
        PG8_STAGE(PG8_SB(0, 0), cB, voffB); PG8_STAGE(PG8_SA(0, 0), cA, voffA); PG8_STAGE(PG8_SB(0, 1), cB + hstepB, voffB); PG8_STAGE(PG8_SA(0, 1), cA + hstepA, voffA);
        if (wr == 1) PG8_BAR;
        PG8_WAIT_V(4); PG8_BAR;
        PG8_STAGE(PG8_SB(1, 0), cB + kstep, voffB); PG8_STAGE(PG8_SA(1, 0), cA + kstep, voffA); PG8_STAGE(PG8_SB(1, 1), cB + hstepB + kstep, voffB);
        PG8_WAIT_V(6); PG8_BAR;
    }
    for (;;) {
        const bool has_next = S.next(ui + 1, nxt);
        const char* nA = has_next ? (const char*)g.A + (size_t)nxt.pm * tstepA + (size_t)nxt.ko * 2 : cA; const char* nB = has_next ? (const char*)g.Bt + PG8_BTILE(nxt) * tstepB + (size_t)nxt.ko * 2 : cB;
        for (int t = 0; t < nt; t += 2) {
            const bool last = (t == nt - 2);
            const char* a1 = cA + (size_t)(t + 1) * kstep;
            const char* a2 = last ? nA : cA + (size_t)(t + 2) * kstep; const char* b2 = last ? nB : cB + (size_t)(t + 2) * kstep;
            const char* a3 = a2 + kstep; const char* b3 = b2 + kstep;
            if (last && has_next) S.a_ready(nxt);
            if constexpr (SP2) {
            PG8_LDB(B0, 0, 0); PG8_LDB(B1, 0, 1); PG8_SCHED; PG8_LDA(At, 0, 0); PG8_STAGE(PG8_SA(1, 1), a1 + hstepA, voffA);
            PG8_WAIT_V(8); PG8_WAIT_L(0); PG8_BAR; PG8_MMA(0, 0, At, B0); PG8_MMA(0, 1, At, B1); PG8_BAR; PG8_SCHED;
            PG8_LDA(At, 0, 1); PG8_STAGE(PG8_SB(0, 0), b2, voffB); PG8_STAGE(PG8_SB(0, 1), b2 + hstepB, voffB); PG8_STAGE(PG8_SA(0, 0), a2, voffA);
            PG8_WAIT_V(8); PG8_WAIT_L(0); PG8_BAR; PG8_MMA(1, 0, At, B0); PG8_MMA(1, 1, At, B1); PG8_BAR; PG8_SCHED;
            PG8_LDB(B0, 1, 0); PG8_LDB(B1, 1, 1); PG8_SCHED; PG8_LDA(At, 1, 0); PG8_STAGE(PG8_SA(0, 1), a2 + hstepA, voffA);
            PG8_WAIT_V(8); PG8_WAIT_L(0); PG8_BAR; PG8_MMA(0, 0, At, B0); PG8_MMA(0, 1, At, B1); PG8_BAR; PG8_SCHED;
            PG8_LDA(At, 1, 1); PG8_STAGE(PG8_SB(1, 0), b3, voffB); PG8_STAGE(PG8_SB(1, 1), b3 + hstepB, voffB); PG8_STAGE(PG8_SA(1, 0), a3, voffA);
            PG8_WAIT_V(8); PG8_WAIT_L(0); PG8_BAR; PG8_MMA(1, 0, At, B0); PG8_MMA(1, 1, At, B1); PG8_BAR; PG8_SCHED;
            } else {
            PG8_LDB(B0, 0, 0); PG8_SCHED; PG8_LDA(At, 0, 0); PG8_STAGE(PG8_SA(1, 1), a1 + hstepA, voffA);
            PG8_WAIT_L(8); PG8_BAR; PG8_WAIT_L(0); PG8_MMA(0, 0, At, B0); PG8_BAR; PG8_SCHED;
            PG8_LDB(B1, 0, 1); PG8_STAGE(PG8_SB(0, 0), b2, voffB);
            PG8_BAR; PG8_WAIT_L(0); PG8_MMA(0, 1, At, B1); PG8_BAR;
            PG8_LDA(At, 0, 1); PG8_STAGE(PG8_SA(0, 0), a2, voffA);
            PG8_BAR; PG8_WAIT_L(0); PG8_MMA(1, 0, At, B0); PG8_BAR; PG8_SCHED;
            PG8_STAGE(PG8_SB(0, 1), b2 + hstepB, voffB);
            PG8_WAIT_V(6); PG8_BAR; PG8_MMA(1, 1, At, B1); PG8_BAR;
            PG8_LDB(B0, 1, 0); PG8_SCHED; PG8_LDA(At, 1, 0); PG8_STAGE(PG8_SA(0, 1), a2 + hstepA, voffA);
            PG8_WAIT_L(8); PG8_BAR; PG8_WAIT_L(0); PG8_MMA(0, 0, At, B0); PG8_BAR; PG8_SCHED;
            PG8_LDB(B1, 1, 1); PG8_STAGE(PG8_SB(1, 0), b3, voffB);
            PG8_BAR; PG8_WAIT_L(0); PG8_MMA(0, 1, At, B1); PG8_BAR;
            PG8_LDA(At, 1, 1); PG8_STAGE(PG8_SA(1, 0), a3, voffA);
            PG8_BAR; PG8_WAIT_L(0); PG8_MMA(1, 0, At, B0); PG8_BAR; PG8_SCHED;
            PG8_STAGE(PG8_SB(1, 1), b3 + hstepB, voffB);
            PG8_WAIT_V(6); PG8_BAR; PG8_MMA(1, 1, At, B1); PG8_BAR;
            }
        }
        if constexpr (ALIGN_EPI) { if (wr == 0) PG8_BAR; }
        if constexpr (!Epi::AFTER_DRAIN) { E(acc, cur, wr, wc, fr, fq); S.done(cur); }
        if (!has_next) break;
#pragma unroll
        for (int a = 0; a < 2; ++a)
#pragma unroll
            for (int b = 0; b < 2; ++b)
#pragma unroll
                for (int m = 0; m < 4; ++m)
#pragma unroll
                    for (int n = 0; n < 2; ++n) acc[a][b][m][n] = (f32x4){0.f, 0.f, 0.f, 0.f};
        cur = nxt; cA = nA; cB = nB; ++ui;
        if constexpr (ALIGN_EPI) { if (wr == 1) PG8_BAR; }
    }
    PG8_WAIT_V(0);
    if constexpr (!ALIGN_EPI) { if (wr == 0) PG8_BAR; }
    PG8_BAR;
    if constexpr (Epi::AFTER_DRAIN) { E.fused(acc, cur, wr, wc, fr, fq, lds, wid, lane); S.done(cur); }
#undef PG8_BTILE
#undef PG8_SA
#undef PG8_SB
#undef PG8_STAGE
#undef PG8_LDA
#undef PG8_LDB
#undef PG8_MMA
#undef PG8_WAIT_V
#undef PG8_WAIT_L
#undef PG8_BAR
#undef PG8_SCHED
}
}

constexpr int NWAVES = 8;
constexpr int RING_OFF = 0, RING_BYTES = 131072;
constexpr int LDSCTL_OFF = RING_BYTES, MISC_OFF = LDSCTL_OFF + 320;
constexpr int LDS_BYTES = 147456;

struct Args { const float* in[52]; float* out; unsigned char* ws; };
static_assert(sizeof(Args) == 432, "kernarg layout");

struct Frame {
    LAS unsigned char* lds; int tid, lane, wave, G, blk;
    const float* const* in; float* out; unsigned char* ws;
};
#define INP(i) INPD(i)
#define KARG() ({ const unsigned char __attribute__((address_space(4)))* k_ = (const unsigned char __attribute__((address_space(4)))*)__builtin_amdgcn_kernarg_segment_ptr(); asm volatile("" : "+s"(k_)); k_; })
#define INPD(i) (*(const float* const __attribute__((address_space(4)))*)(KARG() + 8 * (i)))

template <class Src>
DEVI void cvt_item(const Src src, bf16* WT, int Kd, int nblk, LAS float* scr, int item, int lane) {
    const int kb = item / nblk, nb = item % nblk, k0 = 64 * kb, n0 = 32 * nb;
    const int kr = lane >> 3, nq = (lane & 7) * 4;
    f32x4 v[8];
#pragma unroll
    for (int i = 0; i < 8; ++i) v[i] = src.load4(k0 + 8 * i + kr, n0 + nq);
#pragma unroll
    for (int i = 0; i < 8; ++i) { LAS float* s = scr + (8 * i + kr) * 33 + nq; s[0] = v[i][0]; s[1] = v[i][1]; s[2] = v[i][2]; s[3] = v[i][3]; }
    LDS_WAIT(); asm volatile("" ::: "memory");
    const int c = lane & 7;
#pragma unroll
    for (int j = 0; j < 4; ++j) { const int n = (lane >> 3) + 8 * j; const LAS float* s = scr + (8 * c) * 33 + n;
        v4u o; o.x = pk2(s[0 * 33], s[1 * 33]); o.y = pk2(s[2 * 33], s[3 * 33]); o.z = pk2(s[4 * 33], s[5 * 33]); o.w = pk2(s[6 * 33], s[7 * 33]);
        *(GAS v4u*)(WT + (size_t)(n0 + n) * Kd + k0 + 8 * c) = o; }
    LDS_WAIT(); asm volatile("" ::: "memory");
}
struct SrcPlain { const float* W; int K, N, ld; DEVI f32x4 load4(int k, int n) const { return (k < K && n < N) ? *(const f32x4*)(W + (size_t)k * ld + n) : (f32x4){0.f, 0.f, 0.f, 0.f}; } };
struct SrcFold { const float* W; const float* mu; int ld; DEVI f32x4 load4(int k, int n) const { const int kk = k & 1023; const float m = mu[kk]; return *(const f32x4*)(W + (size_t)kk * ld + n) * (k < 1024 ? m : (1.0f - m)); } };
struct SrcBlk { const float* W; int k0, k1; DEVI f32x4 load4(int k, int n) const { return (k >= k0 && k < k1) ? *(const f32x4*)(W + (size_t)(k - k0) * 1024 + n) : (f32x4){0.f, 0.f, 0.f, 0.f}; } };
struct SrcZero { DEVI f32x4 load4(int, int) const { return (f32x4){0.f, 0.f, 0.f, 0.f}; } };

DEVI void sincos_d(double x, double& s, double& c) {
    const double n = rint(x * 0.63661977236758134308);
    double r = fma(-n, 1.57079632679489655800e+00, x); r = fma(-n, 6.12323399573676603587e-17, r);
    const double r2 = r * r;
    double sp = -7.6471637318198164759e-13; sp = fma(sp, r2, 1.6059043836821614599e-10); sp = fma(sp, r2, -2.5052108385441718775e-08); sp = fma(sp, r2, 2.7557319223985890653e-06);
    sp = fma(sp, r2, -1.9841269841269841270e-04); sp = fma(sp, r2, 8.3333333333333333333e-03); sp = fma(sp, r2, -1.6666666666666666667e-01); const double sr = fma(sp * r2, r, r);
    double cp = 4.7794773323873852974e-14; cp = fma(cp, r2, -1.1470745597729724714e-11); cp = fma(cp, r2, 2.0876756987868098979e-09); cp = fma(cp, r2, -2.7557319223985890653e-07);
    cp = fma(cp, r2, 2.4801587301587301587e-05); cp = fma(cp, r2, -1.3888888888888888889e-03); cp = fma(cp, r2, 4.1666666666666666667e-02); cp = fma(cp, r2, -0.5); const double cr = fma(cp, r2, 1.0);
    const int q = ((int)n) & 3;
    s = (q == 0) ? sr : (q == 1) ? cr : (q == 2) ? -sr : -cr;
    c = (q == 0) ? cr : (q == 1) ? -sr : (q == 2) ? -cr : sr;
}
DEVI void s5prep_one(int i, const float* a_re, const float* a_im, const float* log_step, const float* b_re, const float* b_im, float* sp) {
    const int g = i >> 6;
    const double dt = exp((double)log_step[g]), ar = a_re[i], ai = a_im[i];
    const double mag = exp(ar * dt); double s, c; sincos_d(ai * dt, s, c);
    const double abr = mag * c, abi = mag * s, den = ar * ar + ai * ai, nr = abr - 1.0;
    const double zr = (nr * ar + abi * ai) / den, zi = (abi * ar - nr * ai) / den;
    sp[i] = (float)abr; sp[2048 + i] = (float)abi;
    for (int cc = 0; cc < 16; ++cc) { const double br = b_re[i * 16 + cc], bi = b_im[i * 16 + cc];
        sp[4096 + i * 16 + cc] = (float)(zr * br - zi * bi); sp[4096 + 32768 + i * 16 + cc] = (float)(zr * bi + zi * br); }
}


constexpr int SP_PW = 4096 + 65536;
DEVI void s5prep_pw(int i, int tau, const float* a_re, const float* a_im, const float* log_step, float* sp) {
    const int g = i >> 6; const double dt = exp((double)log_step[g]), ar = a_re[i], ai = a_im[i];
    const double mag = exp(ar * dt * tau); double s, c; sincos_d(ai * dt * tau, s, c); sp[SP_PW + i * 34 + tau * 2] = (float)(mag * c); sp[SP_PW + i * 34 + tau * 2 + 1] = (float)(mag * s);
}
DEVI void s5_tm_job(int g, int tau, int lane, const float* sp, const float* c_re, const float* c_im, const float* dd, bf16* TM) {
    bf16* tm = TM + (size_t)g * 256 * 384;
    if (tau <= 15) {
        const int co = lane >> 2, ci0 = (lane & 3) * 4; float kv[4] = {0.f, 0.f, 0.f, 0.f};
#pragma unroll 8
        for (int p = 0; p < 64; ++p) { const float pr = sp[SP_PW + (g * 64 + p) * 34 + tau * 2], pi = sp[SP_PW + (g * 64 + p) * 34 + tau * 2 + 1];
            const float cr = c_re[(g * 16 + co) * 64 + p], ci = c_im[(g * 16 + co) * 64 + p];
            const f32x4 br = *(const f32x4*)(sp + 4096 + (g * 64 + p) * 16 + ci0), bi = *(const f32x4*)(sp + 4096 + 32768 + (g * 64 + p) * 16 + ci0);
#pragma unroll
            for (int q = 0; q < 4; ++q) { const float wr = pr * br[q] - pi * bi[q], wi = pr * bi[q] + pi * br[q]; kv[q] += cr * wr - ci * wi; } }
        if (tau == 0) {
#pragma unroll
            for (int q = 0; q < 4; ++q) if (ci0 + q == co) kv[q] += dd[g * 16 + co]; }
        const unsigned long long pk = (unsigned long long)pk2(kv[0], kv[1]) | ((unsigned long long)pk2(kv[2], kv[3]) << 32);
        for (int t = tau; t < 16; ++t) *(unsigned long long*)(tm + (size_t)(t * 16 + co) * 384 + (t - tau) * 16 + ci0) = pk;
        if (tau >= 1) for (int t = 0; t + tau < 16; ++t) *(unsigned long long*)(tm + (size_t)(t * 16 + co) * 384 + (t + tau) * 16 + ci0) = 0ull;
    }
    if (tau >= 1) { const int t = tau - 1, p = lane; const float pr = sp[SP_PW + (g * 64 + p) * 34 + tau * 2], pi = sp[SP_PW + (g * 64 + p) * 34 + tau * 2 + 1];
#pragma unroll
        for (int co = 0; co < 16; ++co) { const float cr = c_re[(g * 16 + co) * 64 + p], ci = c_im[(g * 16 + co) * 64 + p];
            tm[(size_t)(t * 16 + co) * 384 + 256 + p] = (bf16)f2bf(cr * pr - ci * pi); tm[(size_t)(t * 16 + co) * 384 + 320 + p] = (bf16)f2bf(-(cr * pi + ci * pr)); } }
}
DEVI void s5_hm_job(int g, int s, int lane, const float* sp, bf16* HM) {
    const int p = lane; const float pr = sp[SP_PW + (g * 64 + p) * 34 + (15 - s) * 2], pi = sp[SP_PW + (g * 64 + p) * 34 + (15 - s) * 2 + 1];
    bf16* hr = HM + ((size_t)g * 256 + p) * 256 + s * 16; bf16* hi = hr + 64 * 256;
#pragma unroll
    for (int h8 = 0; h8 < 2; ++h8) { float wr[8], wi[8];
#pragma unroll
        for (int q = 0; q < 8; ++q) { const float br = sp[4096 + (g * 64 + p) * 16 + h8 * 8 + q], bi = sp[4096 + 32768 + (g * 64 + p) * 16 + h8 * 8 + q]; wr[q] = pr * br - pi * bi; wi[q] = pr * bi + pi * br; }
        v4u a, b; a.x = pk2(wr[0], wr[1]); a.y = pk2(wr[2], wr[3]); a.z = pk2(wr[4], wr[5]); a.w = pk2(wr[6], wr[7]); b.x = pk2(wi[0], wi[1]); b.y = pk2(wi[2], wi[3]); b.z = pk2(wi[4], wi[5]); b.w = pk2(wi[6], wi[7]);
        *(v4u*)(hr + h8 * 8) = a; *(v4u*)(hi + h8 * 8) = b; }
}
DEVI void s5_carry_job(int b, int g, int lane, const float* sp, const float* HL, bf16* UB, float* ore, float* oim) {
    const int p = lane; const float ar = sp[SP_PW + (g * 64 + p) * 34 + 32], ai = sp[SP_PW + (g * 64 + p) * 34 + 33];
    float cr = 0.f, ci = 0.f;
#pragma unroll 8
    for (int n = 0; n < 128; ++n) { const size_t row = (size_t)g * 1024 + b * 128 + n;
        UB[row * 384 + 256 + p] = (bf16)f2bf(cr); UB[row * 384 + 320 + p] = (bf16)f2bf(ci);
        const float hr = HL[row * 128 + p], hi = HL[row * 128 + 64 + p];
        const float nr = ar * cr - ai * ci + hr, ni = ar * ci + ai * cr + hi; cr = nr; ci = ni; }
    ore[((size_t)b * 32 + g) * 64 + p] = cr; oim[((size_t)b * 32 + g) * 64 + p] = ci;
}


DEVI void mods_job(int job, int lane, const float* __restrict__ ST, const float* __restrict__ ada_w, const float* __restrict__ ada_b, float* MODS) {
    asm volatile("" : "+v"(lane));
    const int l = job / 576, n0 = (job % 576) * 16, i16 = lane & 15, kq = lane >> 4;
    f32x4 acc[9];
#pragma unroll
    for (int m = 0; m < 9; ++m) acc[m] = (f32x4){0.f, 0.f, 0.f, 0.f};
    const float* w = ada_w + (size_t)l * 1024 * 9216 + (size_t)kq * 9216 + n0 + i16; const float* st = ST + kq * 144 + i16;
#pragma unroll 4
    for (int k0 = 0; k0 < 1024; k0 += 4) { const float bv = w[(size_t)k0 * 9216];
#pragma unroll
        for (int m = 0; m < 9; ++m) acc[m] = __builtin_amdgcn_mfma_f32_16x16x4f32(st[k0 * 144 + m * 16], bv, acc[m], 0, 0, 0); }
    const float bb = ada_b[l * 9216 + n0 + i16];
#pragma unroll
    for (int m = 0; m < 9; ++m)
#pragma unroll
        for (int q = 0; q < 4; ++q) { const int r = m * 16 + kq * 4 + q; if (r < NMODROW) MODS[((size_t)l * NMODROW + r) * 9216 + n0 + i16] = acc[m][q] + bb; }
}

DEVI void init_row(int row, int lane, const float* xp, const float* xs, const float* mods, float* X, bf16* H, float* ZS) {
    if (row >= MT) { for (int j = 0; j < 16; ++j) H[(size_t)row * D + j * 64 + lane] = 0; return; }
    const float* src = row < NP ? xp + (size_t)row * D : xs + (size_t)(row - NP) * D;
    const float* sh = modp(mods, 0, 0) + (size_t)mrow(row) * 9216; const float* sc = modp(mods, 0, 1) + (size_t)mrow(row) * 9216;
#pragma unroll
    for (int j = 0; j < 4; ++j) { const int c = j * 256 + lane * 4; const f32x4 v = *(const f32x4*)(src + c), a = *(const f32x4*)(sc + c), b = *(const f32x4*)(sh + c);
        *(f32x4*)(X + (size_t)row * D + c) = v; if (row >= NP) *(f32x4*)(ZS + (size_t)(row - NP) * D + c) = v * ALPHA; const f32x4 h = v * (a + 1.0f) + b;
        *(unsigned long long*)(H + (size_t)row * D + c) = (unsigned long long)pk2(h[0], h[1]) | ((unsigned long long)pk2(h[2], h[3]) << 32); }
}
DEVI void ln_row(int row, int lane, const float* Z, float* ZS, const float* g, const float* b, float* X, bf16* H, const float* sh, const float* sc) {
    const float* z = row < NP ? Z + (size_t)row * D : ZS + (size_t)(row - NP) * D; f32x4 v[4]; float s = 0.f;
#pragma unroll
    for (int j = 0; j < 4; ++j) { v[j] = *(const f32x4*)(z + j * 256 + lane * 4); s += (v[j][0] + v[j][1]) + (v[j][2] + v[j][3]); }
    const float mean = wave_sum(s) * (1.f / D); float q = 0.f;
#pragma unroll
    for (int j = 0; j < 4; ++j) { v[j] = v[j] - mean; q += (v[j][0] * v[j][0] + v[j][1] * v[j][1]) + (v[j][2] * v[j][2] + v[j][3] * v[j][3]); }
    const float rstd = rsqrtf(wave_sum(q) * (1.f / D) + 1e-5f);
    const int mr = mrow(row);
#pragma unroll
    for (int j = 0; j < 4; ++j) { const int c = j * 256 + lane * 4; const f32x4 x = v[j] * rstd * *(const f32x4*)(g + c) + *(const f32x4*)(b + c); *(f32x4*)(X + (size_t)row * D + c) = x; if (row >= NP) *(f32x4*)(ZS + (size_t)(row - NP) * D + c) = x * ALPHA;
        if (H) { const f32x4 h = x * (*(const f32x4*)(sc + (size_t)mr * 9216 + c) + 1.0f) + *(const f32x4*)(sh + (size_t)mr * 9216 + c);
            *(unsigned long long*)(H + (size_t)row * D + c) = (unsigned long long)pk2(h[0], h[1]) | ((unsigned long long)pk2(h[2], h[3]) << 32); } }
}
DEVI void shiftcat_row(int row, int lane, const float* X, const float* mods, const float* shift_in, bf16* A2, float* out) {
    if (row >= MT) { for (int j = 0; j < 8; ++j) *(unsigned long long*)(A2 + (size_t)row * KRK + j * 256 + lane * 4) = 0ull; return; }
    const int mr = mrow(row); const float* sh = modp(mods, 1, 3) + (size_t)mr * 9216; const float* sc = modp(mods, 1, 4) + (size_t)mr * 9216;
    const bool prompt = row < NP; const int t = row & 2047;
#pragma unroll
    for (int j = 0; j < 4; ++j) { const int c = j * 256 + lane * 4; const f32x4 a = *(const f32x4*)(sc + c) + 1.0f, b = *(const f32x4*)(sh + c);
        const f32x4 h = *(const f32x4*)(X + (size_t)row * D + c) * a + b; f32x4 pv;
        if (prompt) pv = t == 0 ? (f32x4){0.f, 0.f, 0.f, 0.f} : *(const f32x4*)(X + (size_t)(row - 1) * D + c) * a + b; else pv = *(const f32x4*)(shift_in + (size_t)(row - NP) * D + c);
        *(unsigned long long*)(A2 + (size_t)row * KRK + c) = (unsigned long long)pk2(pv[0], pv[1]) | ((unsigned long long)pk2(pv[2], pv[3]) << 32);
        *(unsigned long long*)(A2 + (size_t)row * KRK + 1024 + c) = (unsigned long long)pk2(h[0], h[1]) | ((unsigned long long)pk2(h[2], h[3]) << 32);
        if (prompt) { if (t == 2047) *(f32x4*)(out + O_SHIFT_P + (size_t)(row >> 11) * D + c) = h; } else *(f32x4*)(out + O_SHIFT_S + (size_t)(row - NP) * D + c) = h; }
}
DEVI void gla_post_one(int w, int lane, const float* OG, const bf16* P, const float* norm_g, bf16* O) {
    const int tok = w >> 2, h = w & 3;
    const float o0 = OG[(size_t)tok * 512 + h * 128 + lane], o1 = OG[(size_t)tok * 512 + h * 128 + 64 + lane];
    const float ms = wave_sum(o0 * o0 + o1 * o1) * (1.f / 128.f), r = rsqrtf(ms + 1e-5f);
    const float g0 = bf2f(P[(size_t)tok * NINP + 1024 + h * 128 + lane]), g1 = bf2f(P[(size_t)tok * NINP + 1024 + h * 128 + 64 + lane]);
    O[(size_t)tok * D + h * 128 + lane] = (bf16)f2bf(o0 * r * norm_g[lane] * siluf_(g0));
    O[(size_t)tok * D + h * 128 + 64 + lane] = (bf16)f2bf(o1 * r * norm_g[64 + lane] * siluf_(g1));
}

DEVI void gla_job(LAS float* scr, int lane, int b, int h, int half, const bf16* P, const float* GKL, const float* w_gk, const float* b_gk, int tok_base, int T, const float* s0, float* s_out, float* OG) {
    LAS float* sdec = scr; LAS float* sq = scr + 1024; LAS float* sk = scr + 2048;
    const int dv = half * 64 + lane;
    float S[64];
#pragma unroll
    for (int i = 0; i < 64; ++i) S[i] = s0 ? s0[(((size_t)b * 4 + h) * 64 + i) * 128 + dv] : 0.f;
    float wg[16];
#pragma unroll
    for (int r = 0; r < 16; ++r) wg[r] = w_gk[r * 256 + h * 64 + lane];
    const float bg = b_gk[h * 64 + lane];
    for (int t0 = 0; t0 < T; t0 += 16) { const int nt = (T - t0) < 16 ? (T - t0) : 16;
        for (int tt = 0; tt < nt; ++tt) { const size_t tok = (size_t)tok_base + (size_t)b * T + t0 + tt; float x = bg;
#pragma unroll
            for (int r = 0; r < 16; ++r) x += GKL[tok * 16 + r] * wg[r];
            const float ls = fminf(x, 0.f) - log1pf(__expf(-fabsf(x)));
            sdec[tt * 64 + lane] = __expf(ls * (1.f / 16.f)); sq[tt * 64 + lane] = bf2f(P[tok * NINP + h * 64 + lane]) * 0.125f; sk[tt * 64 + lane] = bf2f(P[tok * NINP + 256 + h * 64 + lane]); }
        LDS_WAIT(); asm volatile("" ::: "memory");
        for (int tt = 0; tt < nt; ++tt) { const size_t tok = (size_t)tok_base + (size_t)b * T + t0 + tt;
            const float v = bf2f(P[tok * NINP + 512 + h * 128 + dv]); float o = 0.f;
#pragma unroll
            for (int i = 0; i < 64; ++i) { S[i] = S[i] * sdec[tt * 64 + i] + sk[tt * 64 + i] * v; o += sq[tt * 64 + i] * S[i]; }
            OG[tok * 512 + h * 128 + dv] = o; }
        LDS_WAIT(); asm volatile("" ::: "memory");
    }
#pragma unroll
    for (int i = 0; i < 64; ++i) s_out[(((size_t)b * 4 + h) * 64 + i) * 128 + dv] = S[i];
}
DEVI void s5_job(LAS float* scr, int lane, int g, int b0, int nb, const bf16* P, const float* sp, const float* c_re, const float* c_im, const float* dd, int tok_base, int T,
                 const float* h0re, const float* h0im, float* ore, float* oim, bf16* Z5) {
    const int p = lane, c = p & 15, pq = p >> 4;
    const float abr = sp[g * 64 + p], abi = sp[2048 + g * 64 + p];
    float bbr[16], bbi[16], cr[16], ci[16];
#pragma unroll
    for (int i = 0; i < 16; ++i) { bbr[i] = sp[4096 + (g * 64 + p) * 16 + i]; bbi[i] = sp[4096 + 32768 + (g * 64 + p) * 16 + i];
        cr[i] = c_re[(g * 16 + c) * 64 + pq * 16 + i]; ci[i] = c_im[(g * 16 + c) * 64 + pq * 16 + i]; }
    const float dv = dd[g * 16 + c];
    for (int b = b0; b < b0 + nb; ++b) {
        float hr = h0re ? h0re[((size_t)b * 32 + g) * 64 + p] : 0.f, hi = h0im ? h0im[((size_t)b * 32 + g) * 64 + p] : 0.f;
        for (int t = 0; t < T; ++t) { const size_t tok = (size_t)tok_base + (size_t)b * T + t;
            const bf16* up = P + tok * NINP + 1552 + g * 16; float u[16];
#pragma unroll
            for (int i = 0; i < 16; ++i) u[i] = bf2f(up[i]);
            const float uc = bf2f(up[c]);
            float br = 0.f, bi = 0.f;
#pragma unroll
            for (int i = 0; i < 16; ++i) { br += u[i] * bbr[i]; bi += u[i] * bbi[i]; }
            const float nr = abr * hr - abi * hi + br, ni = abr * hi + abi * hr + bi; hr = nr; hi = ni;
            LAS float* hs = scr + (t & 1) * 128;
            hs[p] = hr; hs[64 + p] = hi;
            LDS_WAIT(); asm volatile("" ::: "memory");
            float y = 0.f;
#pragma unroll
            for (int i = 0; i < 16; ++i) y += cr[i] * hs[pq * 16 + i] - ci[i] * hs[64 + pq * 16 + i];
            y += __shfl_xor(y, 16); y += __shfl_xor(y, 32);
            if (p < 16) { y += dv * uc; Z5[tok * 512 + g * 16 + c] = (bf16)f2bf(gelu_tanh(y)); }
        }
        ore[((size_t)b * 32 + g) * 64 + p] = hr; oim[((size_t)b * 32 + g) * 64 + p] = hi;
        LDS_WAIT(); asm volatile("" ::: "memory");
    }
}
DEVI float wkv_decay(float w0, float raw) { const float x = -(w0 + raw); const float sp = fmaxf(x, 0.f) + log1pf(__expf(-fabsf(x))); return __expf(-__expf(-sp - 0.5f)); }
DEVI void wkv_job(LAS float* scr, int lane, int b, int h, const bf16* R, const bf16* Kb, const bf16* V, const bf16* WRAW, const float* w0p, const bf16* AS, bf16* GO, const float* k_k, const float* k_a, const float* r_k, const float* lnx_g, const float* lnx_b,
                  int tok_base, int T, const float* s0, float* s_out) {
    LAS float* sw = scr; LAS float* skm = scr + 512; LAS float* sa_ = scr + 1024; LAS float* sb = scr + 1536; LAS float* sr = scr + 2048; LAS float* sbon = scr + 2560;
    const int i = lane, ch = h * 64 + i;
    float S[64];
#pragma unroll
    for (int j = 0; j < 64; ++j) S[j] = s0 ? s0[(((size_t)b * 16 + h) * 64 + i) * 64 + j] : 0.f;
    const float kkc = k_k[ch], kac = k_a[ch], rkc = r_k[ch], lg = lnx_g[ch], lb = lnx_b[ch];
    for (int t0 = 0; t0 < T; t0 += 8) { const int nt = (T - t0) < 8 ? (T - t0) : 8;
        for (int tt = 0; tt < nt; ++tt) { const size_t tok = (size_t)tok_base + (size_t)b * T + t0 + tt;
            const float k = bf2f(Kb[tok * D + ch]), r = bf2f(R[tok * D + ch]), a = bf2f(AS[tok * D + ch]), w = wkv_decay(w0p[ch], bf2f(WRAW[tok * D + ch]));
            float kk = k * kkc; const float nrm = sqrtf(wave_sum(kk * kk)); kk = kk / fmaxf(nrm, 1e-12f);
            const float km = k * (1.f + (a - 1.f) * kac);
            sw[tt * 64 + i] = w; skm[tt * 64 + i] = km; sa_[tt * 64 + i] = -kk; sb[tt * 64 + i] = kk * a; sr[tt * 64 + i] = r;
            const float bon = wave_sum(r * km * rkc); if (i == 0) sbon[tt] = bon; }
        LDS_WAIT(); asm volatile("" ::: "memory");
        for (int tt = 0; tt < nt; ++tt) { const size_t tok = (size_t)tok_base + (size_t)b * T + t0 + tt;
            const float v = bf2f(V[tok * D + ch]); float sa = 0.f;
#pragma unroll
            for (int j = 0; j < 64; ++j) sa += S[j] * sa_[tt * 64 + j];
            float y = 0.f;
#pragma unroll
            for (int j = 0; j < 64; ++j) { S[j] = S[j] * sw[tt * 64 + j] + sa * sb[tt * 64 + j] + v * skm[tt * 64 + j]; y += S[j] * sr[tt * 64 + j]; }
            const float mean = wave_sum(y) * (1.f / 64.f), dy = y - mean, var = wave_sum(dy * dy) * (1.f / 64.f);
            float yn = dy * rsqrtf(var + 64e-5f) * lg + lb; yn += sbon[tt] * v;
            const float gt = bf2f(GO[tok * D + ch]); GO[tok * D + ch] = (bf16)f2bf(yn * gt); }
        LDS_WAIT(); asm volatile("" ::: "memory");
    }
#pragma unroll
    for (int j = 0; j < 64; ++j) s_out[(((size_t)b * 16 + h) * 64 + i) * 64 + j] = S[j];
}

DEVI float dpp_add(float v, const int ctrl_sel) {
    int r;
    switch (ctrl_sel) {
    case 0: r = __builtin_amdgcn_update_dpp(0, __builtin_bit_cast(int, v), 0xB1, 0xF, 0xF, true); break;
    case 1: r = __builtin_amdgcn_update_dpp(0, __builtin_bit_cast(int, v), 0x4E, 0xF, 0xF, true); break;
    case 2: r = __builtin_amdgcn_update_dpp(0, __builtin_bit_cast(int, v), 0x141, 0xF, 0xF, true); break;
    default: r = __builtin_amdgcn_update_dpp(0, __builtin_bit_cast(int, v), 0x140, 0xF, 0xF, true); break;
    }
    return v + __builtin_bit_cast(float, r);
}
DEVI float red16(float v) { v = dpp_add(v, 0); v = dpp_add(v, 1); v = dpp_add(v, 2); v = dpp_add(v, 3); return v; }
constexpr int WK_TB = 32;
constexpr int WK_W = 0, WK_KM = 2048, WK_NA = 4096, WK_BB = 6144, WK_WR = 8192, WK_V = 10240, WK_PB = 12800;
constexpr int WK_Y = 2 * WK_PB, WK_YB = 1024;
static_assert((WK_Y + 2 * WK_YB + 512 + 1200) * 4 <= RING_BYTES, "wkv lds");
struct WkvLoad { uint2 k, r, a, v, w; };
typedef float f32x2_t __attribute__((ext_vector_type(2)));
struct WkvOps { f32x4 na, wr, w4, bb, km, vv; };
DEVI float wkv_decay_fast(float w0, float raw) { const float x = -(w0 + raw); const float sp = fmaxf(x, 0.f) + 0.69314718056f * __builtin_amdgcn_logf(1.0f + __builtin_amdgcn_exp2f(-1.44269504089f * fabsf(x)));
    const float ee = __builtin_amdgcn_exp2f(-1.44269504089f * (sp + 0.5f)); return __builtin_amdgcn_exp2f(-1.44269504089f * ee); }
template <int MODE> DEVI void wkv_half(LAS float* L, int tid, int b, int h, int half, const bf16* R, const bf16* Kb, const bf16* V, const bf16* WRAW, const bf16* AS, const float* w0p,
                   const float* k_k, const float* k_a, const float* r_k, bf16* Y, float* BON, float* s_out) {
    asm volatile("" : "+v"(tid));
    const int rp = (tid >> 4) & 15, jq = tid & 15; const bool stepper = tid < 256;
    const int ch = h * 64 + 4 * jq, chv = h * 64 + half * 32 + 4 * (jq & 7);
    f32x4 S0 = {0.f, 0.f, 0.f, 0.f}, S1 = {0.f, 0.f, 0.f, 0.f};
    const size_t tokb = (size_t)b * TP;
    auto bf4 = [](uint2 u) -> f32x4 { f32x4 o; o[0] = __uint_as_float(u.x << 16); o[1] = __uint_as_float(u.x & 0xffff0000u); o[2] = __uint_as_float(u.y << 16); o[3] = __uint_as_float(u.y & 0xffff0000u); return o; };
#define WK_PREP1(bufidx, blkidx, tt_) do { LAS float* pb_ = L + (bufidx) * WK_PB; const size_t t_ = tokb + (size_t)(blkidx) * WK_TB + (tt_); const size_t o_ = t_ * D + ch; \
        const f32x4 k4 = bf4(*(const uint2*)(Kb + o_)), r4 = bf4(*(const uint2*)(R + o_)), a4 = bf4(*(const uint2*)(AS + o_)), wraw = bf4(*(const uint2*)(WRAW + o_)), v4 = bf4(*(const uint2*)(V + t_ * D + chv)); f32x4 w4; \
        _Pragma("unroll") for (int e_ = 0; e_ < 4; ++e_) w4[e_] = wkv_decay_fast(w0c[e_], wraw[e_]); \
        f32x4 kk = k4 * kkc; float ss = red16((kk[0] * kk[0] + kk[1] * kk[1]) + (kk[2] * kk[2] + kk[3] * kk[3])); const float inv = 1.0f / fmaxf(sqrtf(ss), 1e-12f); kk = kk * inv; \
        const f32x4 km = k4 * ((a4 - 1.0f) * kac + 1.0f); const f32x4 pr = r4 * km; const f32x4 prk = pr * rkc; const float bon = red16((prk[0] + prk[1]) + (prk[2] + prk[3])); \
        const f32x4 bbv = kk * a4; const f32x4 pb2 = bbv * r4; const float brs = red16((pb2[0] + pb2[1]) + (pb2[2] + pb2[3])), krs = red16((pr[0] + pr[1]) + (pr[2] + pr[3])); \
        *(LAS f32x4*)(pb_ + WK_W + (tt_) * 64 + 4 * jq) = w4; *(LAS f32x4*)(pb_ + WK_KM + (tt_) * 64 + 4 * jq) = km; *(LAS f32x4*)(pb_ + WK_NA + (tt_) * 64 + 4 * jq) = -kk; \
        *(LAS f32x4*)(pb_ + WK_BB + (tt_) * 64 + 4 * jq) = bbv; *(LAS f32x4*)(pb_ + WK_WR + (tt_) * 64 + 4 * jq) = w4 * r4 - kk * brs; \
        if (jq < 8) { *(LAS f32x4*)(pb_ + WK_V + (tt_) * 64 + 8 * jq) = (f32x4){v4[0], v4[1], v4[0] * krs, v4[1] * krs}; *(LAS f32x4*)(pb_ + WK_V + (tt_) * 64 + 8 * jq + 4) = (f32x4){v4[2], v4[3], v4[2] * krs, v4[3] * krs}; } \
        if (jq == 0 && half == 0) BON[t_ * 16 + h] = bon; } while (0)
#define WK_RD128(dst, ad, off) asm volatile("ds_read_b128 %0, %1 offset:%2" : "=v"(dst) : "v"(ad), "i"(off))
#define WK_LOADOPS(o_, dt_) do { WK_RD128((o_).na, aop, WK_NA * 4 + (dt_) * 256); WK_RD128((o_).wr, aop, WK_WR * 4 + (dt_) * 256); WK_RD128((o_).w4, aop, WK_W * 4 + (dt_) * 256); \
        WK_RD128((o_).bb, aop, WK_BB * 4 + (dt_) * 256); WK_RD128((o_).km, aop, WK_KM * 4 + (dt_) * 256); WK_RD128((o_).vv, av, (dt_) * 256); } while (0)
#define WK_WAIT(n_, o_) asm volatile("s_waitcnt lgkmcnt(" #n_ ")" : "+v"((o_).na), "+v"((o_).wr), "+v"((o_).w4), "+v"((o_).bb), "+v"((o_).km), "+v"((o_).vv))
#define WK_STEP(o_, dt_) do { \
        float sa0 = (S0[0] * (o_).na[0] + S0[1] * (o_).na[1]) + (S0[2] * (o_).na[2] + S0[3] * (o_).na[3]), sa1 = (S1[0] * (o_).na[0] + S1[1] * (o_).na[1]) + (S1[2] * (o_).na[2] + S1[3] * (o_).na[3]); \
        float y0 = (S0[0] * (o_).wr[0] + S0[1] * (o_).wr[1]) + (S0[2] * (o_).wr[2] + S0[3] * (o_).wr[3]), y1 = (S1[0] * (o_).wr[0] + S1[1] * (o_).wr[1]) + (S1[2] * (o_).wr[2] + S1[3] * (o_).wr[3]); \
        sa0 = dpp_add(sa0, 0); sa1 = dpp_add(sa1, 0); y0 = dpp_add(y0, 0); y1 = dpp_add(y1, 0); sa0 = dpp_add(sa0, 1); sa1 = dpp_add(sa1, 1); y0 = dpp_add(y0, 1); y1 = dpp_add(y1, 1); \
        sa0 = dpp_add(sa0, 2); sa1 = dpp_add(sa1, 2); y0 = dpp_add(y0, 2); y1 = dpp_add(y1, 2); sa0 = dpp_add(sa0, 3); sa1 = dpp_add(sa1, 3); y0 = dpp_add(y0, 3); y1 = dpp_add(y1, 3); \
        S0 = S0 * (o_).w4 + ((o_).bb * sa0 + (o_).km * (o_).vv[0]); S1 = S1 * (o_).w4 + ((o_).bb * sa1 + (o_).km * (o_).vv[1]); \
        f32x2_t yy; yy[0] = y0 + (o_).vv[2]; yy[1] = y1 + (o_).vv[3]; \
        asm volatile("ds_write_b64 %0, %1 offset:%2" :: "v"(ay), "v"(yy), "i"((dt_) * 128) : "memory"); } while (0)
    constexpr int NB = TP / WK_TB;
    if (!stepper) {
        const int ht = (tid - 256) >> 4;
        const f32x4 kkc = *(const f32x4*)(k_k + ch), kac = *(const f32x4*)(k_a + ch), rkc = *(const f32x4*)(r_k + ch), w0c = *(const f32x4*)(w0p + ch);
        WK_PREP1(0, 0, ht); WK_PREP1(0, 0, ht + 16);
        LDS_WAIT(); __builtin_amdgcn_s_barrier(); asm volatile("" ::: "memory");
        for (int n = 0; n < NB; ++n) { const int cur = n & 1;
            if (n + 1 < NB) { WK_PREP1(cur ^ 1, n + 1, ht); WK_PREP1(cur ^ 1, n + 1, ht + 16); }
            if (n >= 1) {
                const int yt = (tid - 256) >> 3, yq = (tid & 7) * 4; const f32x4 y4 = *(const LAS f32x4*)(L + WK_Y + (cur ^ 1) * WK_YB + yt * 32 + yq);
                uint2 ov; ov.x = pk2(y4[0], y4[1]); ov.y = pk2(y4[2], y4[3]);
                *(uint2*)(Y + (tokb + (size_t)(n - 1) * WK_TB + yt) * D + h * 64 + half * 32 + yq) = ov; }
            LDS_WAIT(); __builtin_amdgcn_s_barrier(); asm volatile("" ::: "memory");
        }
        { const int yt = (tid - 256) >> 3, yq = (tid & 7) * 4; const f32x4 y4 = *(const LAS f32x4*)(L + WK_Y + ((NB - 1) & 1) * WK_YB + yt * 32 + yq);
            uint2 ov; ov.x = pk2(y4[0], y4[1]); ov.y = pk2(y4[2], y4[3]); *(uint2*)(Y + (tokb + (size_t)(NB - 1) * WK_TB + yt) * D + h * 64 + half * 32 + yq) = ov; }
    } else {
        LDS_WAIT(); __builtin_amdgcn_s_barrier(); asm volatile("" ::: "memory");
        const unsigned lbase = (unsigned)(size_t)L;
        for (int n = 0; n < NB; ++n) { const int cur = n & 1;
            unsigned aop = lbase + (unsigned)(cur * WK_PB + 4 * jq) * 4u, av = lbase + (unsigned)(cur * WK_PB + WK_V + 4 * rp) * 4u;
            unsigned ay = lbase + (unsigned)(jq == 0 ? WK_Y + cur * WK_YB + 2 * rp : WK_Y + 2 * WK_YB + 2 * tid) * 4u;
            WkvOps o0, o1, o2, o3;
            asm volatile("s_waitcnt lgkmcnt(0)" ::: "memory");
            WK_LOADOPS(o0, 0); WK_LOADOPS(o1, 1);
            WK_LOADOPS(o2, 2); WK_WAIT(12, o0); WK_STEP(o0, 0);
            WK_LOADOPS(o3, 3); WK_WAIT(13, o1); WK_STEP(o1, 1);
            for (int t4 = 0; t4 < 7; ++t4) {
                WK_LOADOPS(o0, 4); WK_WAIT(14, o2); WK_STEP(o2, 2);
                WK_LOADOPS(o1, 5); WK_WAIT(14, o3); WK_STEP(o3, 3);
                aop += 1024; av += 1024; ay += 512;
                WK_LOADOPS(o2, 2); WK_WAIT(14, o0); WK_STEP(o0, 0);
                WK_LOADOPS(o3, 3); WK_WAIT(14, o1); WK_STEP(o1, 1);
            }
            WK_WAIT(8, o2); WK_STEP(o2, 2);
            WK_WAIT(2, o3); WK_STEP(o3, 3);
            asm volatile("s_waitcnt lgkmcnt(0)" ::: "memory");
            __builtin_amdgcn_s_barrier(); asm volatile("" ::: "memory");
        }
        float* so = s_out + (((size_t)b * 16 + h) * 64 + half * 32 + 2 * rp) * 64 + 4 * jq; *(f32x4*)so = S0; *(f32x4*)(so + 64) = S1;
    }
#undef WK_LOADOPS
#undef WK_STEP
#undef WK_WAIT
#undef WK_RD128
#undef WK_PREP1
}
DEVI void wkv_ypass_row(size_t tok, int lane, const bf16* Y, const bf16* V, bf16* GO, const float* BON, const float* lnx_g, const float* lnx_b) {
    const int c0 = lane * 16; const size_t o = tok * D + c0;
    const v4u ya = *(const v4u*)(Y + o), yb = *(const v4u*)(Y + o + 8), va = *(const v4u*)(V + o), vb = *(const v4u*)(V + o + 8), ga = *(const v4u*)(GO + o), gb = *(const v4u*)(GO + o + 8);
    const unsigned yw[8] = {ya.x, ya.y, ya.z, ya.w, yb.x, yb.y, yb.z, yb.w}, vw[8] = {va.x, va.y, va.z, va.w, vb.x, vb.y, vb.z, vb.w}, gw_[8] = {ga.x, ga.y, ga.z, ga.w, gb.x, gb.y, gb.z, gb.w};
    float y[16]; float s = 0.f;
#pragma unroll
    for (int e = 0; e < 8; ++e) { y[2 * e] = __uint_as_float(yw[e] << 16); y[2 * e + 1] = __uint_as_float(yw[e] & 0xffff0000u); s += y[2 * e] + y[2 * e + 1]; }
    s = dpp_add(s, 0); s = dpp_add(s, 1); const float mean = s * (1.f / 64.f); float q = 0.f;
#pragma unroll
    for (int e = 0; e < 16; ++e) { y[e] -= mean; q += y[e] * y[e]; }
    q = dpp_add(q, 0); q = dpp_add(q, 1); const float rstd = rsqrtf(q * (1.f / 64.f) + 64e-5f), bon = BON[tok * 16 + (lane >> 2)];
    unsigned ow[8];
#pragma unroll
    for (int e = 0; e < 8; ++e) { const float v0 = __uint_as_float(vw[e] << 16), v1 = __uint_as_float(vw[e] & 0xffff0000u), g0 = __uint_as_float(gw_[e] << 16), g1 = __uint_as_float(gw_[e] & 0xffff0000u);
        const float o0 = (y[2 * e] * rstd * lnx_g[c0 + 2 * e] + lnx_b[c0 + 2 * e] + bon * v0) * g0, o1 = (y[2 * e + 1] * rstd * lnx_g[c0 + 2 * e + 1] + lnx_b[c0 + 2 * e + 1] + bon * v1) * g1; ow[e] = pk2(o0, o1); }
    *(v4u*)(GO + o) = (v4u){ow[0], ow[1], ow[2], ow[3]}; *(v4u*)(GO + o + 8) = (v4u){ow[4], ow[5], ow[6], ow[7]};
}

constexpr int GL_BF = 0, GL_QI = 16384, GL_KI = 25600, GL_SC = 34816, GL_VT = 44032, GL_ST = 62464, GL_RS = 80896, GL_WG = 81920, GL_GKL = 86016, GL_SEG = 90112;
constexpr int GL_LD = 72;
DEVI bf16x8 gl_frag(LAS unsigned char* lds, int base, int row, int k0, int fq) { return *(const LAS bf16x8*)(lds + base + (row * GL_LD + k0 + 8 * fq) * 2); }
DEVI void gla_cumdecay(LAS unsigned char* lds, int tid, int h, size_t tok0, const float* GKL, const float* w_gk, const float* b_gk) {
    asm volatile("" : "+v"(tid));
    LAS float* BF = (LAS float*)(lds + GL_BF); LAS float* WG = (LAS float*)(lds + GL_WG); LAS float* GK = (LAS float*)(lds + GL_GKL); LAS float* SEG = (LAS float*)(lds + GL_SEG);
    for (int i = tid; i < 1024; i += 512) { WG[i] = w_gk[(i >> 6) * 256 + h * 64 + (i & 63)]; GK[i] = GKL[tok0 * 16 + i]; }
    LDS_WAIT(); __builtin_amdgcn_s_barrier(); asm volatile("" ::: "memory");
    { const int t = tid >> 3, d0 = (tid & 7) * 8; float x[8];
#pragma unroll
        for (int e = 0; e < 8; ++e) x[e] = b_gk[h * 64 + d0 + e];
#pragma unroll
        for (int r = 0; r < 16; ++r) { const float gv = GK[t * 16 + r]; const f32x4 w0 = *(const LAS f32x4*)(WG + r * 64 + d0), w1 = *(const LAS f32x4*)(WG + r * 64 + d0 + 4);
#pragma unroll
            for (int e = 0; e < 4; ++e) { x[e] += gv * w0[e]; x[4 + e] += gv * w1[e]; } }
#pragma unroll
        for (int e = 0; e < 8; ++e) { const float xx = x[e]; x[e] = (fminf(xx, 0.f) - log1pf(__expf(-fabsf(xx)))) * (1.f / 16.f); }
        *(LAS f32x4*)(BF + t * 64 + d0) = (f32x4){x[0], x[1], x[2], x[3]}; *(LAS f32x4*)(BF + t * 64 + d0 + 4) = (f32x4){x[4], x[5], x[6], x[7]}; }
    LDS_WAIT(); __builtin_amdgcn_s_barrier(); asm volatile("" ::: "memory");
    { const int dk = tid & 63, sg = tid >> 6; float a = 0.f;
#pragma unroll
        for (int i = 0; i < 8; ++i) { a += BF[(sg * 8 + i) * 64 + dk]; BF[(sg * 8 + i) * 64 + dk] = a; }
        SEG[sg * 64 + dk] = a; }
    LDS_WAIT(); __builtin_amdgcn_s_barrier(); asm volatile("" ::: "memory");
    { const int dk = tid & 63, sg = tid >> 6; float off = 0.f;
        for (int s = 0; s < sg; ++s) off += SEG[s * 64 + dk];
#pragma unroll
        for (int i = 0; i < 8; ++i) BF[(sg * 8 + i) * 64 + dk] += off; }
    LDS_WAIT(); __builtin_amdgcn_s_barrier(); asm volatile("" ::: "memory");
}
DEVI void gla_stage_vt(LAS unsigned char* lds, int tid, int h, size_t tok0, const bf16* P) {
    const int t = tid >> 3, dv0 = (tid & 7) * 16; const bf16* vp = P + (tok0 + t) * NINP + 512 + h * 128 + dv0;
    const v4u a = *(const v4u*)vp, b = *(const v4u*)(vp + 8); LAS bf16* VT = (LAS bf16*)(lds + GL_VT);
    const unsigned w[8] = {a.x, a.y, a.z, a.w, b.x, b.y, b.z, b.w};
#pragma unroll
    for (int e = 0; e < 8; ++e) { VT[(dv0 + 2 * e) * GL_LD + t] = (bf16)(w[e] & 0xffffu); VT[(dv0 + 2 * e + 1) * GL_LD + t] = (bf16)(w[e] >> 16); }
}
DEVI void gla_unit_a(LAS unsigned char* lds, int tid, int u, const bf16* P, const float* GKL, const float* w_gk, const float* b_gk, float* KV, float* DEC) {
    asm volatile("" : "+v"(tid));
    const int bh = u >> 5, ck = u & 31, b = bh >> 2, h = bh & 3; const size_t tok0 = (size_t)b * TP + ck * 64;
    const int lane = tid & 63, wave = tid >> 6, fr = lane & 15, fq = lane >> 4;
    gla_cumdecay(lds, tid, h, tok0, GKL, w_gk, b_gk);
    LAS float* BF = (LAS float*)(lds + GL_BF);
    { const int t = tid >> 3, d0 = (tid & 7) * 8; const v4u kq = *(const v4u*)(P + (tok0 + t) * NINP + 256 + h * 64 + d0); LAS bf16* KST = (LAS bf16*)(lds + GL_QI);
        const unsigned w[4] = {kq.x, kq.y, kq.z, kq.w};
#pragma unroll
        for (int e = 0; e < 8; ++e) { const float kv = __uint_as_float((e & 1) ? (w[e >> 1] & 0xffff0000u) : (w[e >> 1] << 16)); const float sc = __expf(BF[63 * 64 + d0 + e] - BF[t * 64 + d0 + e]);
            KST[(d0 + e) * GL_LD + t] = (bf16)f2bf(kv * sc); } }
    gla_stage_vt(lds, tid, h, tok0, P);
    if (tid < 64) DEC[(size_t)u * 64 + tid] = __expf(BF[63 * 64 + tid]);
    LDS_WAIT(); __builtin_amdgcn_s_barrier(); asm volatile("" ::: "memory");
#pragma unroll
    for (int dt = 0; dt < 4; ++dt) { f32x4 acc = {0.f, 0.f, 0.f, 0.f};
#pragma unroll
        for (int k0 = 0; k0 < 64; k0 += 32) acc = __builtin_amdgcn_mfma_f32_16x16x32_bf16(gl_frag(lds, GL_VT, wave * 16 + fr, k0, fq), gl_frag(lds, GL_QI, dt * 16 + fr, k0, fq), acc, 0, 0, 0);
        *(f32x4*)(KV + ((size_t)u * 64 + dt * 16 + fr) * 128 + wave * 16 + 4 * fq) = acc; }
    LDS_WAIT(); __builtin_amdgcn_s_barrier(); asm volatile("" ::: "memory");
}
DEVI void gla_scan_b(int gtid, float* KV, const float* DEC, float* s_out) {
    const int dv = gtid & 127, dkq = (gtid >> 7) & 15, bh = gtid >> 11; float S[4] = {0.f, 0.f, 0.f, 0.f};
#pragma unroll 4
    for (int c = 0; c < 32; ++c) { const size_t u = (size_t)bh * 32 + c; float* kp = KV + (u * 64 + dkq * 4) * 128 + dv;
#pragma unroll
        for (int e = 0; e < 4; ++e) { const float kv = kp[e * 128], dc = DEC[u * 64 + dkq * 4 + e]; kp[e * 128] = S[e]; S[e] = dc * S[e] + kv; } }
#pragma unroll
    for (int e = 0; e < 4; ++e) s_out[((size_t)bh * 64 + dkq * 4 + e) * 128 + dv] = S[e];
}
DEVI void gla_unit_c(LAS unsigned char* lds, int tid, int u, const bf16* P, const float* GKL, const float* w_gk, const float* b_gk, const float* KV, const float* norm_g, bf16* O) {
    asm volatile("" : "+v"(tid));
    const int bh = u >> 5, ck = u & 31, b = bh >> 2, h = bh & 3; const size_t tok0 = (size_t)b * TP + ck * 64;
    const int lane = tid & 63, wave = tid >> 6, fr = lane & 15, fq = lane >> 4;
    gla_cumdecay(lds, tid, h, tok0, GKL, w_gk, b_gk);
    LAS float* BF = (LAS float*)(lds + GL_BF);
    { const int t = tid >> 3, d0 = (tid & 7) * 8; const v4u qq = *(const v4u*)(P + (tok0 + t) * NINP + h * 64 + d0), kq = *(const v4u*)(P + (tok0 + t) * NINP + 256 + h * 64 + d0);
        const unsigned wq[4] = {qq.x, qq.y, qq.z, qq.w}, wk[4] = {kq.x, kq.y, kq.z, kq.w}; float qo[8], ko[8];
#pragma unroll
        for (int e = 0; e < 8; ++e) { const float qv = __uint_as_float((e & 1) ? (wq[e >> 1] & 0xffff0000u) : (wq[e >> 1] << 16)), kv = __uint_as_float((e & 1) ? (wk[e >> 1] & 0xffff0000u) : (wk[e >> 1] << 16));
            const float bb = BF[t * 64 + d0 + e]; qo[e] = qv * 0.125f * __expf(bb); ko[e] = kv * __expf(-bb); }
        v4u a, c; a.x = pk2(qo[0], qo[1]); a.y = pk2(qo[2], qo[3]); a.z = pk2(qo[4], qo[5]); a.w = pk2(qo[6], qo[7]); c.x = pk2(ko[0], ko[1]); c.y = pk2(ko[2], ko[3]); c.z = pk2(ko[4], ko[5]); c.w = pk2(ko[6], ko[7]);
        *(LAS v4u*)(lds + GL_QI + (t * GL_LD + d0) * 2) = a; *(LAS v4u*)(lds + GL_KI + (t * GL_LD + d0) * 2) = c; }
    gla_stage_vt(lds, tid, h, tok0, P);
    { const int dk = tid >> 3, dv0 = (tid & 7) * 16; const float* sp = KV + ((size_t)u * 64 + dk) * 128 + dv0; LAS bf16* ST = (LAS bf16*)(lds + GL_ST);
#pragma unroll
        for (int q = 0; q < 4; ++q) { const f32x4 s4 = *(const f32x4*)(sp + 4 * q);
#pragma unroll
            for (int e = 0; e < 4; ++e) ST[(dv0 + 4 * q + e) * GL_LD + dk] = (bf16)f2bf(s4[e]); } }
    LDS_WAIT(); __builtin_amdgcn_s_barrier(); asm volatile("" ::: "memory");
#pragma unroll
    for (int q = 0; q < 2; ++q) { const int id = wave * 2 + q, tt = id >> 2, st = id & 3; f32x4 acc = {0.f, 0.f, 0.f, 0.f};
#pragma unroll
        for (int k0 = 0; k0 < 64; k0 += 32) acc = __builtin_amdgcn_mfma_f32_16x16x32_bf16(gl_frag(lds, GL_KI, st * 16 + fr, k0, fq), gl_frag(lds, GL_QI, tt * 16 + fr, k0, fq), acc, 0, 0, 0);
        const int t = tt * 16 + fr, s0 = st * 16 + 4 * fq;
#pragma unroll
        for (int e = 0; e < 4; ++e) if (s0 + e > t) acc[e] = 0.f;
        *(LAS unsigned long long*)(lds + GL_SC + (t * GL_LD + s0) * 2) = (unsigned long long)pk2(acc[0], acc[1]) | ((unsigned long long)pk2(acc[2], acc[3]) << 32); }
    LDS_WAIT(); __builtin_amdgcn_s_barrier(); asm volatile("" ::: "memory");
    const int tt = wave & 3, hv = wave >> 2; f32x4 o[4]; float ssq = 0.f;
#pragma unroll
    for (int dt = 0; dt < 4; ++dt) { f32x4 acc = {0.f, 0.f, 0.f, 0.f}; const int dvr = (hv * 4 + dt) * 16 + fr;
#pragma unroll
        for (int k0 = 0; k0 < 64; k0 += 32) { acc = __builtin_amdgcn_mfma_f32_16x16x32_bf16(gl_frag(lds, GL_VT, dvr, k0, fq), gl_frag(lds, GL_SC, tt * 16 + fr, k0, fq), acc, 0, 0, 0);
            acc = __builtin_amdgcn_mfma_f32_16x16x32_bf16(gl_frag(lds, GL_ST, dvr, k0, fq), gl_frag(lds, GL_QI, tt * 16 + fr, k0, fq), acc, 0, 0, 0); }
        o[dt] = acc; ssq += (acc[0] * acc[0] + acc[1] * acc[1]) + (acc[2] * acc[2] + acc[3] * acc[3]); }
    ssq += __shfl_xor(ssq, 16); ssq += __shfl_xor(ssq, 32);
    LAS float* RS = (LAS float*)(lds + GL_RS);
    if (fq == 0) RS[hv * 64 + tt * 16 + fr] = ssq;
    LDS_WAIT(); __builtin_amdgcn_s_barrier(); asm volatile("" ::: "memory");
    { const int t = tt * 16 + fr; const float rstd = rsqrtf((RS[t] + RS[64 + t]) * (1.f / 128.f) + 1e-5f); const size_t tok = tok0 + t;
#pragma unroll
        for (int dt = 0; dt < 4; ++dt) { const int dv = (hv * 4 + dt) * 16 + 4 * fq; const uint2 gg = *(const uint2*)(P + tok * NINP + 1024 + h * 128 + dv); const f32x4 ng = *(const f32x4*)(norm_g + dv);
            const float g0 = __uint_as_float(gg.x << 16), g1 = __uint_as_float(gg.x & 0xffff0000u), g2 = __uint_as_float(gg.y << 16), g3 = __uint_as_float(gg.y & 0xffff0000u);
            uint2 ov; ov.x = pk2(o[dt][0] * rstd * ng[0] * siluf_(g0), o[dt][1] * rstd * ng[1] * siluf_(g1)); ov.y = pk2(o[dt][2] * rstd * ng[2] * siluf_(g2), o[dt][3] * rstd * ng[3] * siluf_(g3));
            *(uint2*)(O + tok * D + h * 128 + dv) = ov; } }
    LDS_WAIT(); __builtin_amdgcn_s_barrier(); asm volatile("" ::: "memory");
}

__global__ void __launch_bounds__(NWAVES * 64, 2) __attribute__((target("no-packed-fp32-ops"))) mk_fwd(Args args) {
    extern __shared__ __attribute__((aligned(16))) unsigned char lds_raw[];
    LAS unsigned char* lds = (LAS unsigned char*)lds_raw;
    volatile LAS unsigned* MISC = (volatile LAS unsigned*)(lds + MISC_OFF);
    const int tid = threadIdx.x, lane = tid & 63, wave = __builtin_amdgcn_readfirstlane(tid >> 6), G = gridDim.x, blk = blockIdx.x;
#define LW() (*(unsigned char* const __attribute__((address_space(4)))*)(KARG() + 424))
#define LO() (*(float* const __attribute__((address_space(4)))*)(KARG() + 416))
#define PTRS unsigned char* ws = LW(); float* out = LO(); float* MODS = (float*)(ws + WS_MODS); float* SP = (float*)(ws + WS_SP); bf16* H = (bf16*)(ws + WS_H); float* Z = (float*)(ws + WS_Z); bf16* ACT = (bf16*)(ws + WS_ACT); float* X = out; \
    (void)MODS; (void)SP; (void)H; (void)Z; (void)ACT; (void)X
    for (int u = tid; u < (LDS_BYTES - LDSCTL_OFF) / 4; u += NWAVES * 64) ((LAS unsigned*)(lds + LDSCTL_OFF))[u] = 0u;
    __syncthreads();
    { XcdBarrier b0_ = xcd_barrier_post((unsigned*)(LW() + WS_CTL) + CW_BAR, MISC + 8); (void)b0_; }
#define GRID_BAR() do { XcdBarrier b_; b_.bar = (unsigned*)(LW() + WS_CTL) + CW_BAR; b_.x = xb_xcc_id(); b_.st = MISC + 8; xcd_barrier(b_); if (XP == 6) xcd_barrier(b_); \
        if (PROBE && blk == 0 && tid == 0) ((unsigned long long*)(LW() + WS_CTL + 524288))[nst] = rt(); ++nst; } while (0)
    int nst = 0;
    if (PROBE && blk == 0 && tid == 0) ((unsigned long long*)(LW() + WS_CTL + 524288))[63] = rt();
    const int gw = blk * NWAVES + wave, NGW = G * NWAVES;
    const int gws = wave * G + blk;
    LAS float* wscr = (LAS float*)(lds + RING_OFF + wave * 16384);

    for (int xrep = 0; xrep < (XP == 1 ? 2 : 1); ++xrep) { PTRS;
        constexpr int I_UP = (D / 64) * (NUP / 32), I_DN = (FFP / 64) * (D / 32), I_IN = (D / 64) * (NINP / 32), I_GLU = (512 / 64) * (512 / 32), I_SQ = (D / 64) * (D / 32), I_RK = (KRK / 64) * (NRK / 32), I_L2 = (NL1 / 64) * (3072 / 32);
        constexpr int NITEMS = 4 * I_UP + 4 * I_DN + I_IN + I_GLU + 2 * I_SQ + I_RK + I_L2;
        for (int xc = 0; xc < (XP == 19 ? 2 : 1); ++xc) for (int it = gw; it < NITEMS; it += NGW) {
            int r = it;
            if (r < 4 * I_UP) { const int q = r / I_UP, l = q >> 1, f = q & 1; r -= q * I_UP;
                const int kb = r / (NUP / 32), nb = r % (NUP / 32), pn = nb >> 3, half = (nb >> 2) & 1, c0 = pn * 128 + (nb & 3) * 32;
                bf16* dst = (bf16*)(ws + (l ? WS_WUP_L1 : WS_WUP_L0) + f * SZ_WUP) + (size_t)(nb * 32) * D;
                if (c0 >= FF) { SrcZero s; cvt_item(s, dst, D, 1, wscr, kb, lane); }
                else if (half) { SrcPlain s{INPD(f ? 17 : 14) + (size_t)l * D * FF + c0, D, FF - c0, FF}; cvt_item(s, dst, D, 1, wscr, kb, lane); }
                else { SrcPlain s{INPD(f ? 16 : 13) + (size_t)l * D * FF + c0, D, FF - c0, FF}; cvt_item(s, dst, D, 1, wscr, kb, lane); }
                continue; } r -= 4 * I_UP;
            if (r < 4 * I_DN) { const int q = r / I_DN, l = q >> 1, f = q & 1; r -= q * I_DN;
                SrcPlain s{INPD(f ? 18 : 15) + (size_t)l * FF * D, FF, D, D};
                cvt_item(s, (bf16*)(ws + (l ? WS_WDN_L1 : WS_WDN_L0) + f * SZ_WDN), FFP, D / 32, wscr, r, lane); continue; } r -= 4 * I_DN;
            if (r < I_IN) { SrcPlain s{INPD(19), D, NIN, NIN}; cvt_item(s, (bf16*)(ws + WS_WIN), D, NINP / 32, wscr, r, lane); continue; } r -= I_IN;
            if (r < I_GLU) { SrcPlain s{INPD(32), 512, 512, 512}; cvt_item(s, (bf16*)(ws + WS_WGLU), 512, 512 / 32, wscr, r, lane); continue; } r -= I_GLU;
            if (r < I_SQ) { SrcPlain s{INPD(20), D, D, D}; cvt_item(s, (bf16*)(ws + WS_WOUT), D, D / 32, wscr, r, lane); continue; } r -= I_SQ;
            if (r < I_SQ) { SrcPlain s{INPD(38), D, D, D}; cvt_item(s, (bf16*)(ws + WS_WO), D, D / 32, wscr, r, lane); continue; } r -= I_SQ;
            if (r < I_RK) { const int kb = r / (NRK / 32), nb = r % (NRK / 32), n0 = nb * 32; bf16* dst = (bf16*)(ws + WS_WRK) + (size_t)n0 * KRK;
                if (n0 < 1024) { SrcFold s{INPD(35) + n0, INPD(34) + 0 * 1024, 1024}; cvt_item(s, dst, KRK, 1, wscr, kb, lane); }
                else if (n0 < 2048) { SrcFold s{INPD(36) + (n0 - 1024), INPD(34) + 2 * 1024, 1024}; cvt_item(s, dst, KRK, 1, wscr, kb, lane); }
                else if (n0 < 3072) { SrcFold s{INPD(37) + (n0 - 2048), INPD(34) + 3 * 1024, 1024}; cvt_item(s, dst, KRK, 1, wscr, kb, lane); }
                else if (n0 < 3136) { SrcFold s{INPD(40) + (n0 - 3072), INPD(34) + 1 * 1024, 64}; cvt_item(s, dst, KRK, 1, wscr, kb, lane); }
                else if (n0 < 3200) { SrcFold s{INPD(43) + (n0 - 3136), INPD(34) + 4 * 1024, 64}; cvt_item(s, dst, KRK, 1, wscr, kb, lane); }
                else if (n0 < 3360) { SrcFold s{INPD(45) + (n0 - 3200), INPD(34) + 5 * 1024, 160}; cvt_item(s, dst, KRK, 1, wscr, kb, lane); }
                else { SrcZero s; cvt_item(s, dst, KRK, 1, wscr, kb, lane); }
                continue; } r -= I_RK;
            { const int kb = r / (3072 / 32), nb = r % (3072 / 32), n0 = nb * 32; bf16* dst = (bf16*)(ws + WS_WL2) + (size_t)n0 * NL1;
                if (n0 < 1024) { SrcBlk s{INPD(41) + n0, 0, 64}; cvt_item(s, dst, NL1, 1, wscr, kb, lane); }
                else if (n0 < 2048) { SrcBlk s{INPD(44) + (n0 - 1024), 64, 128}; cvt_item(s, dst, NL1, 1, wscr, kb, lane); }
                else { SrcBlk s{INPD(46) + (n0 - 2048), 128, 288}; cvt_item(s, dst, NL1, 1, wscr, kb, lane); } }
        }
        { float* STt = (float*)(ws + WS_ST); for (int i = blk * 512 + tid; i < 144 * 1024; i += G * 512) { const int r = i >> 10, k = i & 1023; float v = 0.f; if (r < 8) v = siluf_(INP(7)[r * 1024 + k]); else if (r < 136) v = siluf_(INP(8)[(r - 8) * 1024 + k]); STt[k * 144 + r] = v; } }
        for (int it = blk * 512 + tid; it < 2048 * 18; it += G * 512) { const int i = it & 2047, tau = it >> 11;
            if (tau == 17) s5prep_one(i, INP(24), INP(25), INP(26), INP(27), INP(28), SP); else s5prep_pw(i, tau, INP(24), INP(25), INP(26), SP); }
    }
    GRID_BAR();
    for (int xq = 0; xq < (XP == 17 ? 2 : 1); ++xq) { PTRS; bf16* TM = (bf16*)(ws + WS_TM); bf16* HM = (bf16*)(ws + WS_HM);
        for (int xr = 0; xr < (XP == 10 ? 2 : 1); ++xr) for (int j = gws; j < 1152; j += NGW) mods_job(__builtin_amdgcn_readfirstlane(j), lane, (const float*)(ws + WS_ST), INPD(9), INPD(10), MODS);
        for (int j = NGW - 1 - gws; j < 32 * 17 + 32 * 16; j += NGW) { if (j < 544) s5_tm_job(j / 17, j % 17, lane, SP, INPD(29), INPD(30), INPD(31), TM); else s5_hm_job((j - 544) >> 4, (j - 544) & 15, lane, SP, HM); }
        for (int i = gw * 64 + lane; i < 32 * 128 * 256 / 8; i += NGW * 64) { const int g = i >> 12, r = i & 4095; *(v4u*)(HM + ((size_t)g * 256 + 128) * 256 + (size_t)r * 8) = (v4u){0u, 0u, 0u, 0u}; } }
    GRID_BAR();
    { PTRS; for (int xr = 0; xr < (XP == 18 ? 2 : 1); ++xr) for (int row = gw; row < MTP; row += NGW) init_row(row, lane, INP(0), INP(1), MODS, X, H, (float*)(ws + WS_ZS)); }
    GRID_BAR();

#define GEMM_PHASE(EPI, Aptr, Bptr, NN, KK, ...) do { pg8::GemmX g_{(const pg8::bf16_t*)(Aptr), (const pg8::bf16_t*)(Bptr), MTP, NN, KK, KK, KK, -1}; pg8::StaticOrder S_; S_.init(MTP, NN, G, blk); pg8::EPI E_{__VA_ARGS__}; \
        pg8::gemm_phase<pg8::EPI, pg8::StaticOrder, true, true>(lds + RING_OFF, g_, S_, E_); } while (0)
#define GEMMX_PHASE(EPI, Aptr, Bptr, MM, NN, KK, LDA, LDB, GSH, ...) do { pg8::GemmX g_{(const pg8::bf16_t*)(Aptr), (const pg8::bf16_t*)(Bptr), MM, NN, KK, LDA, LDB, GSH}; pg8::StaticOrder S_; S_.init(MM, NN, G, blk); pg8::EPI E_{__VA_ARGS__}; \
        pg8::gemm_phase<pg8::EPI, pg8::StaticOrder, true, true>(lds + RING_OFF, g_, S_, E_); } while (0)
#define RESID_PHASE(Aptr, Bptr, KK, gatep, rcv) do { \
        { pg8::GemmX g_{(const pg8::bf16_t*)(Aptr), (const pg8::bf16_t*)(Bptr), NP, D, KK, KK, KK, -1}; pg8::StaticOrder S_; S_.init(NP, D, G, blk); pg8::EpiResid E_{X, Z, gatep, rcv, 0}; \
          pg8::gemm_phase<pg8::EpiResid, pg8::StaticOrder, true, true>(lds + RING_OFF, g_, S_, E_); } \
        { pg8::GemmX g_{(const pg8::bf16_t*)(Aptr), (const pg8::bf16_t*)(Bptr), MTP, D, 256, KK, KK, -1}; pg8::SplitOrder S_{64, 4, (KK) / 256, 256, G, blk}; pg8::EpiResidS E_{(float*)(ws + WS_ZS), gatep, rcv, 0}; \
          pg8::gemm_phase<pg8::EpiResidS, pg8::SplitOrder, true, true>(lds + RING_OFF, g_, S_, E_); } } while (0)
#define LN_PASS(l, idx, Hout, nsh, nsc) do { PTRS; for (int row = gw; row < MT; row += NGW) ln_row(row, lane, Z, (float*)(ws + WS_ZS), INP(11) + ((l) * 3 + (idx)) * D, INP(12) + ((l) * 3 + (idx)) * D, X, Hout, nsh, nsc); } while (0)
#define FFN(l, f, which0, lnidx, HOUT, nshw, nscw) do { \
        { PTRS; GEMM_PHASE(EpiSwiglu, H, ws + ((l) ? WS_WUP_L1 : WS_WUP_L0) + (f) * SZ_WUP, NUP, D, (pg8::bf16_t*)ACT); if (XP == 2) { GEMM_PHASE(EpiSwiglu, H, ws + ((l) ? WS_WUP_L1 : WS_WUP_L0) + (f) * SZ_WUP, NUP, D, (pg8::bf16_t*)ACT); } } GRID_BAR(); \
        { PTRS; RESID_PHASE(ACT, ws + ((l) ? WS_WDN_L1 : WS_WDN_L0) + (f) * SZ_WDN, FFP, modp(MODS, l, (which0) + 2), 0.5f); if (XP == 3) { RESID_PHASE(ACT, ws + ((l) ? WS_WDN_L1 : WS_WDN_L0) + (f) * SZ_WDN, FFP, modp(MODS, l, (which0) + 2), 0.5f); } } GRID_BAR(); \
        LN_PASS(l, lnidx, HOUT, nshw, nscw); if (XP == 4) { LN_PASS(l, lnidx, HOUT, nshw, nscw); } GRID_BAR(); } while (0)

    FFN(0, 0, 0, 0, H, modp(MODS, 0, 3), modp(MODS, 0, 4));
#define L0PTRS PTRS; bf16* P = (bf16*)(ws + WS_P); float* GKL = (float*)(ws + WS_GKL); float* OGS = (float*)(ws + WS_OGS) - (size_t)NP * 512; bf16* Z5 = (bf16*)(ws + WS_Z5); bf16* O = (bf16*)(ws + WS_O); \
        bf16* UB = (bf16*)(ws + WS_UBUF); float* HL = (float*)(ws + WS_HLOC); float* KV = (float*)(ws + WS_KV); float* DEC = (float*)(ws + WS_DEC); (void)P; (void)GKL; (void)OGS; (void)Z5; (void)O; (void)UB; (void)HL; (void)KV; (void)DEC
    { L0PTRS; for (int xr = 0; xr < (XP == 11 ? 2 : 1); ++xr) GEMM_PHASE(EpiInproj, H, ws + WS_WIN, NINP, D, (pg8::bf16_t*)P, GKL, (pg8::bf16_t*)UB); } GRID_BAR();
    for (int xr = 0; xr < (XP == 12 ? 2 : 1); ++xr) { L0PTRS;
        GEMMX_PHASE(EpiHloc, UB, ws + WS_HM, 32768, 256, 256, 384, 256, 2, HL);
        for (int u = (blk + 128) & 255; u < 1024; u += 256) gla_unit_a(lds + RING_OFF, tid, u, P, GKL, INPD(21), INPD(22), KV, DEC);
        for (int s = gws; s < 1536; s += NGW) {
            if (s < 1024) gla_job(wscr, lane, s >> 3, (s >> 1) & 3, s & 1, P, GKL, INPD(21), INPD(22), NP, 1, INPD(2), out + O_GLA_S, OGS);
            else { const int j = s - 1024; s5_job(wscr, lane, j & 31, (j >> 5) * 8, 8, P, SP, INPD(29), INPD(30), INPD(31), NP, 1, INPD(3), INPD(4), out + O_S5RE_S, out + O_S5IM_S, Z5); } }
    }
    GRID_BAR();
    { L0PTRS;
        for (int xr = 0; xr < (XP == 13 ? 2 : 1); ++xr) if (gws < 256) s5_carry_job(gws >> 5, gws & 31, lane, SP, HL, UB, out + O_S5RE_P, out + O_S5IM_P);
        if (blk >= 128) gla_scan_b((blk - 128) * 512 + tid, KV, DEC, out + O_GLA_P);
    } GRID_BAR();
    for (int xr = 0; xr < (XP == 14 ? 2 : 1); ++xr) { L0PTRS;
        GEMMX_PHASE(EpiS5Y, UB, ws + WS_TM, 32768, 256, 384, 384, 384, 2, (pg8::bf16_t*)Z5);
        for (int u = (blk + 128) & 255; u < 1024; u += 256) gla_unit_c(lds + RING_OFF, tid, u, P, GKL, INPD(21), INPD(22), KV, INPD(23), O);
        for (int w = NP * 4 + gw; w < MT * 4; w += NGW) gla_post_one(w, lane, OGS, P, INP(23), O); } GRID_BAR();
    { L0PTRS; GEMM_PHASE(EpiGlu, Z5, ws + WS_WGLU, 512, 512, (const pg8::bf16_t*)Z5, (pg8::bf16_t*)O, INP(33)); } GRID_BAR();
    { L0PTRS; RESID_PHASE(O, ws + WS_WOUT, D, modp(MODS, 0, 5), 1.0f); } GRID_BAR();
    LN_PASS(0, 1, H, modp(MODS, 0, 6), modp(MODS, 0, 7)); GRID_BAR();
    FFN(0, 1, 6, 2, H, modp(MODS, 1, 0), modp(MODS, 1, 1));
    FFN(1, 0, 0, 0, (bf16*)nullptr, (const float*)nullptr, (const float*)nullptr);
#define L1PTRS PTRS; bf16* A2 = (bf16*)(ws + WS_A2); bf16* R = (bf16*)(ws + WS_R); bf16* Kb = (bf16*)(ws + WS_K); bf16* V = (bf16*)(ws + WS_V); bf16* L1 = (bf16*)(ws + WS_L1A); \
        bf16* WRAW = (bf16*)(ws + WS_WRAW); bf16* YB = (bf16*)(ws + WS_YB); float* BON = (float*)(ws + WS_BON); bf16* AS = (bf16*)(ws + WS_AS); bf16* Gt = (bf16*)(ws + WS_G); (void)A2; (void)R; (void)Kb; (void)V; (void)L1; (void)WRAW; (void)YB; (void)BON; (void)AS; (void)Gt
    { L1PTRS; for (int xr = 0; xr < (XP == 16 ? 2 : 1); ++xr) for (int row = gw; row < MTP; row += NGW) shiftcat_row(row, lane, X, MODS, INP(5), A2, out); } GRID_BAR();
    { L1PTRS; GEMM_PHASE(EpiRk, A2, ws + WS_WRK, NRK, KRK, (pg8::bf16_t*)R, (size_t)MTP * D, (pg8::bf16_t*)L1); if (XP == 7) { GEMM_PHASE(EpiRk, A2, ws + WS_WRK, NRK, KRK, (pg8::bf16_t*)R, (size_t)MTP * D, (pg8::bf16_t*)L1); } } GRID_BAR();
    { L1PTRS; GEMM_PHASE(EpiLora2, L1, ws + WS_WL2, 3072, NL1, (pg8::bf16_t*)WRAW, (pg8::bf16_t*)AS, (pg8::bf16_t*)Gt, INP(42)); } GRID_BAR();
    if (XP == 21 || XP == 22) { L1PTRS; bf16* dY = (bf16*)(ws + WS_L0 + 32 * MiB); float* dB = (float*)(ws + WS_L0 + 26 * MiB); float* dS = (float*)(ws + WS_L0 + 25 * MiB + 524288);
        if (XP == 21) wkv_half<1>((LAS float*)(lds + RING_OFF), tid, 0, 0, 0, R, Kb, V, WRAW, AS, INPD(39), INPD(47), INPD(48), INPD(49), dY, dB, dS);
        else wkv_half<2>((LAS float*)(lds + RING_OFF), tid, 0, 0, 0, R, Kb, V, WRAW, AS, INPD(39), INPD(47), INPD(48), INPD(49), dY, dB, dS); __syncthreads(); }
    for (int xr = 0; xr < (XP == 5 ? 2 : 1); ++xr) { L1PTRS; wkv_half<0>((LAS float*)(lds + RING_OFF), tid, blk >> 5, (blk >> 1) & 15, blk & 1, R, Kb, V, WRAW, AS, INPD(39), INPD(47), INPD(48), INPD(49), YB, BON, out + O_WKV_P); if (XP == 5) __syncthreads(); } GRID_BAR();
    { L1PTRS;
        for (int t = gw; t < NP; t += NGW) wkv_ypass_row((size_t)t, lane, YB, V, Gt, BON, INPD(50), INPD(51));
        for (int s = gws; s < 2048; s += NGW) wkv_job(wscr, lane, s >> 4, s & 15, R, Kb, V, WRAW, INPD(39), AS, Gt, INPD(47), INPD(48), INPD(49), INPD(50), INPD(51), NP, 1, INPD(6), out + O_WKV_S); }
    GRID_BAR();
    { L1PTRS; RESID_PHASE(Gt, ws + WS_WO, D, modp(MODS, 1, 5), 1.0f); } GRID_BAR();
    LN_PASS(1, 1, H, modp(MODS, 1, 6), modp(MODS, 1, 7)); GRID_BAR();
    { PTRS; GEMM_PHASE(EpiSwiglu, H, ws + WS_WUP_L1 + SZ_WUP, NUP, D, (pg8::bf16_t*)ACT); if (XP == 2) { GEMM_PHASE(EpiSwiglu, H, ws + WS_WUP_L1 + SZ_WUP, NUP, D, (pg8::bf16_t*)ACT); } } GRID_BAR();
    { PTRS; RESID_PHASE(ACT, ws + WS_WDN_L1 + SZ_WDN, FFP, modp(MODS, 1, 8), 0.5f); if (XP == 3) { RESID_PHASE(ACT, ws + WS_WDN_L1 + SZ_WDN, FFP, modp(MODS, 1, 8), 0.5f); } } GRID_BAR();
    LN_PASS(1, 2, (bf16*)nullptr, (const float*)nullptr, (const float*)nullptr); if (XP == 4) { LN_PASS(1, 2, (bf16*)nullptr, (const float*)nullptr, (const float*)nullptr); }
#if PROBE
    {
        __syncthreads();
        PTRS; const unsigned long long* TS = (const unsigned long long*)(ws + WS_CTL + 524288);
        const float v1 = (float)(TS[PROBE_A1] - TS[PROBE_A0]) * 0.01f, v2 = (float)(TS[PROBE_B1] - TS[PROBE_B0]) * 0.01f * 10.0f;
        for (int row = NP + gw; row < MT; row += NGW) for (int j = 0; j < 16; ++j) X[(size_t)row * D + j * 64 + lane] = v1;
        if (blk == 0 && tid == 0) out[O_WKV_S] = v2;
    }
#endif
}

extern "C" void kernel_launch(void* const* d_in, const int* in_sizes, int n_in, void* d_out, int out_size, void* d_ws, size_t ws_size, hipStream_t stream) {
    static int grid = 0;
    if (grid == 0) {
        if (n_in != 52 || ws_size < WS_END) { fprintf(stderr, "kernel_launch: unexpected n_in %d or ws %zu\n", n_in, ws_size); grid = -1; return; }
        int dev = 0, cus = 0, per_cu = 0;
        if (hipGetDevice(&dev) != hipSuccess || hipDeviceGetAttribute(&cus, hipDeviceAttributeMultiprocessorCount, dev) != hipSuccess) { grid = -1; return; }
        if (hipFuncSetAttribute((const void*)mk_fwd, hipFuncAttributeMaxDynamicSharedMemorySize, LDS_BYTES) != hipSuccess) { fprintf(stderr, "hipFuncSetAttribute failed\n"); grid = -1; return; }
        if (hipOccupancyMaxActiveBlocksPerMultiprocessor(&per_cu, (const void*)mk_fwd, NWAVES * 64, LDS_BYTES) != hipSuccess || per_cu < 1) { fprintf(stderr, "occupancy query: %d\n", per_cu); per_cu = 1; }
        (void)hipGetLastError();
        grid = cus;
    }
    if (grid < 0) return;
    (void)hipMemsetAsync((char*)d_ws + WS_CTL, 0, CTL_ZERO_BYTES, stream);
    Args a{};
    for (int i = 0; i < 52; ++i) a.in[i] = (const float*)d_in[i];
    a.out = (float*)d_out; a.ws = (unsigned char*)d_ws;
    hipLaunchKernelGGL(mk_fwd, dim3(grid), dim3(NWAVES * 64), LDS_BYTES, stream, a);
}
```

```cpp
#include <hip/hip_runtime.h>
#include <cstdint>
#include <cstdio>

#ifndef PROBE
#define PROBE 0
#endif
#ifndef XP
#define XP 0
#endif
#define PROBE_A0 63
#define PROBE_A1 1
#define PROBE_B0 1
#define PROBE_B1 4
typedef unsigned short bf16;
typedef short bf16x8 __attribute__((ext_vector_type(8)));
typedef float f32x4 __attribute__((ext_vector_type(4)));
#define DEVI __device__ __forceinline__
__device__ __forceinline__ void mk_syncthreads() { asm volatile("s_waitcnt vmcnt(0) lgkmcnt(0)" ::: "memory"); __builtin_amdgcn_s_barrier(); asm volatile("" ::: "memory"); }
#define __syncthreads() mk_syncthreads()

constexpr int D = 1024, NP = 16384, NS = 128, MT = NP + NS, MTP = 16640, TP = 2048, BP = 8;
constexpr int FF = 2752, FFP = 2816, NUP = 2 * FFP;
constexpr int NIN = 2064, NINP = 2304;
constexpr int NRK = 3584, KRK = 2048, NL1 = 384;
constexpr int NMODROW = 136;
constexpr float ALPHA = 1.41421356237309515f;

constexpr size_t O_Y = 0, O_GLA_P = 16908288, O_S5RE_P = 17170432, O_S5IM_P = 17186816, O_SHIFT_P = 17203200, O_WKV_P = 17211392,
                 O_GLA_S = 17735680, O_S5RE_S = 21929984, O_S5IM_S = 22192128, O_SHIFT_S = 22454272, O_WKV_S = 22585344;

constexpr size_t MiB = 1u << 20;
constexpr size_t WS_CTL = 0, CTL_ZERO_BYTES = 1 * MiB;
constexpr size_t WS_MODS = 1 * MiB, WS_SP = 12 * MiB, WS_ST = 344 * MiB, WS_ZS = 345 * MiB;
constexpr size_t WS_W = 13 * MiB;
constexpr size_t SZ_WUP = (size_t)NUP * D * 2;
constexpr size_t SZ_WDN = (size_t)D * FFP * 2;
constexpr size_t WS_L0 = WS_W;
constexpr size_t WS_WUP_L0 = WS_L0, WS_WDN_L0 = WS_L0 + 22 * MiB, WS_WIN = WS_L0 + 33 * MiB, WS_WGLU = WS_WIN + 4608 * 1024, WS_WOUT = WS_WGLU + 512 * 1024;
constexpr size_t WS_L1 = WS_L0 + 40 * MiB;
constexpr size_t WS_WUP_L1 = WS_L1, WS_WDN_L1 = WS_L1 + 22 * MiB, WS_WRK = WS_L1 + 33 * MiB, WS_WL2 = WS_WRK + 14 * MiB, WS_WO = WS_WL2 + 2304 * 1024;
static_assert(WS_WO + 2 * MiB <= 105 * MiB, "W region");
constexpr size_t WS_H = 105 * MiB, WS_Z = 138 * MiB, WS_ACT = 203 * MiB, WS_S2 = 293 * MiB, WS_END = 346 * MiB;
constexpr size_t WS_P = WS_ACT, WS_GKL = 277 * MiB, WS_Z5 = WS_Z, WS_O = WS_H, WS_DEC = 195 * MiB, WS_OGS = 196 * MiB, WS_KV = WS_S2;
constexpr size_t WS_UBUF = 155 * MiB, WS_HLOC = 179 * MiB, WS_HM = 326 * MiB, WS_TM = 330 * MiB;
constexpr size_t WS_A2 = WS_ACT, WS_K = WS_Z, WS_R = WS_Z - (size_t)MTP * D * 2, WS_V = WS_Z + (size_t)MTP * D * 2, WS_L1A = WS_L0, WS_WRAW = WS_ACT, WS_YB = WS_ACT + (size_t)MTP * D * 2, WS_BON = WS_L0 + 30 * MiB, WS_AS = 268 * MiB, WS_G = WS_AS + (size_t)MTP * D * 2;
static_assert(WS_G + (size_t)MTP * D * 2 <= WS_END, "ws");
constexpr int CW_TMO = 0, CW_BAR = 4096;

#define GAS __attribute__((address_space(1)))
#define LAS __attribute__((address_space(3)))
typedef unsigned short bf16;
typedef unsigned v4u __attribute__((ext_vector_type(4)));
typedef float f32x4 __attribute__((ext_vector_type(4)));
typedef short bf16x8 __attribute__((ext_vector_type(8)));
typedef GAS unsigned gu32;
typedef GAS unsigned long long gu64;
#define RLX_AGENT __ATOMIC_RELAXED, __HIP_MEMORY_SCOPE_AGENT
#define LDS_WAIT() asm volatile("s_waitcnt lgkmcnt(0)" ::: "memory")
#define VM_WAIT() asm volatile("s_waitcnt vmcnt(0)" ::: "memory")
__device__ __forceinline__ unsigned long long rt() { return __builtin_amdgcn_s_memrealtime(); }
__device__ __forceinline__ unsigned f2bf(float f) { unsigned u = __builtin_bit_cast(unsigned, f); return (u + 0x7fffu + ((u >> 16) & 1u)) >> 16; }
__device__ __forceinline__ unsigned pk2(float lo, float hi) { return f2bf(lo) | (f2bf(hi) << 16); }

#define XB_TMO      128
#define XB_XCNT(j)  (256  + 64 * (j))
#define XB_XSUB(j)  (1280 + 64 * (j))
#define XB_XGEN(j)  (2304 + 64 * (j))
#define XB_TOP      3328
#define XB_TOPGEN   3392
#define XCD_BAR_WORDS 3456
#define XB_SPIN_CAP (1u << 18)

__device__ __forceinline__ unsigned xb_ld(unsigned* p)              { return __hip_atomic_load(p, __ATOMIC_RELAXED, __HIP_MEMORY_SCOPE_AGENT); }
__device__ __forceinline__ unsigned xb_add(unsigned* p, unsigned v) { return __hip_atomic_fetch_add(p, v, __ATOMIC_RELAXED, __HIP_MEMORY_SCOPE_AGENT); }
__device__ __forceinline__ unsigned xb_xcc_id() { return (unsigned)__builtin_amdgcn_s_getreg((3 << 11) | 20) & 0xFu; }
#define XB_SPIN(cond, bar) do { unsigned _sp = 0; while (cond) { __builtin_amdgcn_s_sleep(1); \
    if ((++_sp & 255u) == 0u) { if (xb_ld(&(bar)[XB_TMO])) break; if (_sp > XB_SPIN_CAP) { atomicAdd(&(bar)[XB_TMO], 1u); break; } } } } while (0)

struct XcdBarrier {
    unsigned* bar; unsigned x;
    volatile LAS unsigned* st;
};

__device__ __forceinline__ XcdBarrier xcd_barrier_post(unsigned* bar, volatile LAS unsigned* st) {
    XcdBarrier b; b.bar = bar; b.x = xb_xcc_id(); b.st = st;
    if (threadIdx.x == 0) (void)xb_add(&bar[XB_XCNT(b.x)], 1u);
    return b;
}
__device__ __forceinline__ void xcd_barrier_complete(unsigned* bar, unsigned x, unsigned& nloc, unsigned& nx) {
    const unsigned G = gridDim.x * gridDim.y * gridDim.z;
    unsigned sum, cnt, mine, sp = 0u;
    for (;;) {
        sum = 0u; cnt = 0u; mine = 0u;
#pragma unroll
        for (unsigned j = 0; j < 16; ++j) { const unsigned c = xb_ld(&bar[XB_XCNT(j)]); sum += c; cnt += (c > 0u) ? 1u : 0u; mine = (j == x) ? c : mine; }
        if (sum == G) break;
        __builtin_amdgcn_s_sleep(1);
        if ((++sp & 255u) == 0u) { if (xb_ld(&bar[XB_TMO])) break; if (sp > XB_SPIN_CAP) { atomicAdd(&bar[XB_TMO], 1u); break; } }
    }
    nloc = mine > 0u ? mine : 1u; nx = cnt > 0u ? cnt : 1u;
}

__device__ __forceinline__ void xcd_barrier(const XcdBarrier& b) {
    asm volatile("s_waitcnt vmcnt(0)" ::: "memory");
    __syncthreads();
    if (threadIdx.x == 0) {
        unsigned* bar = b.bar;
        __builtin_amdgcn_s_waitcnt(0);
        unsigned nloc = b.st[0], nx = b.st[1];
        if (nloc == 0u) { xcd_barrier_complete(bar, b.x, nloc, nx); b.st[0] = nloc; b.st[1] = nx; }
        const unsigned old = xb_add(&bar[XB_XSUB(b.x)], 1u);
        const unsigned gen = old / nloc;
        if (old + 1u == (gen + 1u) * nloc) {
            __builtin_amdgcn_fence(__ATOMIC_RELEASE, "agent");
            asm volatile("s_waitcnt vmcnt(0)" ::: "memory");
            const unsigned og = xb_add(&bar[XB_TOP], 1u);
            const unsigned tg = og / nx;
            if (og + 1u == (tg + 1u) * nx) xb_add(&bar[XB_TOPGEN], 1u);
            else XB_SPIN(xb_ld(&bar[XB_TOPGEN]) == tg, bar);
            __builtin_amdgcn_fence(__ATOMIC_ACQUIRE, "agent");
            xb_add(&bar[XB_XGEN(b.x)], 1u);
            asm volatile("s_waitcnt vmcnt(0)" ::: "memory");
        } else {
            XB_SPIN(xb_ld(&bar[XB_XGEN(b.x)]) == gen, bar);
            __builtin_amdgcn_fence(__ATOMIC_ACQUIRE, "agent");
            asm volatile("s_waitcnt vmcnt(0)" ::: "memory");
        }
    }
    __syncthreads();
}

DEVI float bf2f(unsigned short h) { return __uint_as_float(((unsigned)h) << 16); }
DEVI int mrow(int i) { return i < NP ? (i >> 11) : (8 + i - NP); }
DEVI float sigmoidf_(float x) { return 1.0f / (1.0f + __expf(-x)); }
DEVI float siluf_(float x) { return x / (1.0f + __expf(-x)); }
DEVI float softplusf_(float x) { return fmaxf(x, 0.f) + log1pf(__expf(-fabsf(x))); }
DEVI float gelu_tanh(float x) { const float u = 0.7978845608028654f * (x + 0.044715f * x * x * x); return 0.5f * x * (1.0f + tanhf(u)); }
DEVI float wave_sum(float v) {
#pragma unroll
    for (int o = 1; o < 64; o <<= 1) v += __shfl_xor(v, o);
    return v;
}
__host__ __device__ __forceinline__ const float* modp(const float* mods, int l, int which) { return mods + (size_t)l * NMODROW * 9216 + which * 1024; }

namespace pg8 {
#define PG8_LAS __attribute__((address_space(3)))
typedef unsigned short bf16_t;
typedef short bf16x8 __attribute__((ext_vector_type(8)));
typedef float f32x4 __attribute__((ext_vector_type(4)));
typedef unsigned u32x4 __attribute__((ext_vector_type(4)));
constexpr int BM = 256, BK = 64, HALF = 128, HTB = HALF * BK * 2  , STAGE_BYTES = 8 * HTB, NXCD = 8, WGM = 8;

__host__ __device__ __forceinline__ int lds_byte(int r, int c) { const int st = (r >> 4) * 2 + (c >> 5), rr = r & 15, cc = c & 31, ob = rr * 64 + cc * 2; return st * 1024 + (ob ^ (((ob >> 9) & 1) << 5)); }
__host__ __device__ __forceinline__ void stage_rc(int b, int& R, int& C) { const int st = b / 1024, sb = b % 1024, swz = sb ^ (((sb >> 9) & 1) << 5); R = (st >> 1) * 16 + swz / 64; C = (st & 1) * 32 + (swz % 64) / 2; }
__host__ __device__ __forceinline__ int perm32(int rho) { const int n = rho >> 4, i = rho & 15; return 8 * (i >> 2) + 4 * n + (i & 3); }

struct Unit { int pm, pn, ko; };
struct Gemm { const bf16_t* A; const bf16_t* Bt; int M, N, K; };
struct GemmX { const bf16_t* A; const bf16_t* Bt; int M, N, K, lda, ldb, gsh; };

struct StaticOrder {
    int nM, nN, nwg, G, c;
    __host__ __device__ __forceinline__ void init(int M, int N, int G_, int c_) { nM = M / BM; nN = N / BM; nwg = nM * nN; G = G_; c = c_; }
    __host__ __device__ __forceinline__ bool next(int i, Unit& u) const {
        const long L = (long)i * G + c; if (L >= nwg) return false;
        int wgid = (int)L; { const int q = nwg / NXCD, r = nwg % NXCD, xcd = wgid % NXCD, off = wgid / NXCD; wgid = (xcd < r ? xcd * (q + 1) : r * (q + 1) + (xcd - r) * q) + off; }
        const int nig = WGM * nN, gid = wgid / nig, fm = gid * WGM, gsz = (nM - fm) < WGM ? (nM - fm) : WGM;
        u.pm = fm + ((wgid % nig) % gsz); u.pn = (wgid % nig) / gsz; u.ko = 0; return true;
    }
    __device__ __forceinline__ void a_ready(const Unit&) const {}
    __device__ __forceinline__ void done(const Unit&) const {}
};

struct SplitOrder {
    int pm0, nN, nsplit, kspl, G, c;
    __host__ __device__ __forceinline__ bool next(int i, Unit& u) const { const int L = i * G + c; if (L >= nsplit * nN) return false; u.pm = pm0; u.pn = L % nN; u.ko = (L / nN) * kspl; return true; }
    __device__ __forceinline__ void a_ready(const Unit&) const {}
    __device__ __forceinline__ void done(const Unit&) const {}
};

__device__ __forceinline__ unsigned cvt_pk_bf16(float lo, float hi) { unsigned r; asm volatile("v_cvt_pk_bf16_f32 %0, %1, %2" : "=v"(r) : "v"(lo), "v"(hi)); return r; }
__device__ __forceinline__ float fsilu(float x) { return x * __builtin_amdgcn_rcpf(1.0f + __builtin_amdgcn_exp2f(-1.44269504089f * x)); }
__device__ __forceinline__ float fsigm(float x) { return __builtin_amdgcn_rcpf(1.0f + __builtin_amdgcn_exp2f(-1.44269504089f * x)); }
__device__ __forceinline__ u32x4 pack8(const f32x4 a, const f32x4 b) { u32x4 w; w.x = cvt_pk_bf16(a[0], a[1]); w.y = cvt_pk_bf16(a[2], a[3]); w.z = cvt_pk_bf16(b[0], b[1]); w.w = cvt_pk_bf16(b[2], b[3]); return w; }
struct EpiSwiglu { static constexpr bool PERM = true, AFTER_DRAIN = false; bf16_t* ACT;
    __device__ __forceinline__ void operator()(const f32x4 (&acc)[2][2][4][2], const Unit& u, int wr, int wc, int fr, int fq) const {
        const int row0 = u.pm * BM + wr * 64 + fr, col0 = u.pn * 128 + wc * 32 + 8 * fq;
#pragma unroll
        for (int ai = 0; ai < 2; ++ai)
#pragma unroll
            for (int m = 0; m < 4; ++m) { f32x4 o0, o1;
#pragma unroll
                for (int e = 0; e < 4; ++e) { o0[e] = fsilu(acc[ai][0][m][0][e]) * acc[ai][1][m][0][e]; o1[e] = fsilu(acc[ai][0][m][1][e]) * acc[ai][1][m][1][e]; }
                *(u32x4*)(ACT + (size_t)(row0 + ai * HALF + m * 16) * 2816 + col0) = pack8(o0, o1); }
    } };
struct EpiResid { static constexpr bool PERM = true, AFTER_DRAIN = false; const float* X; float* Z; const float* gate; float rc; int pad;
    __device__ __forceinline__ void operator()(const f32x4 (&acc)[2][2][4][2], const Unit& u, int wr, int wc, int fr, int fq) const {
        const float* __restrict__ xp = X + (size_t)(u.pm * BM + wr * 64 + fr) * 1024 + u.pn * BM + wc * 32 + 8 * fq; float* __restrict__ zp = Z + (size_t)(u.pm * BM + wr * 64 + fr) * 1024 + u.pn * BM + wc * 32 + 8 * fq;
        const float* __restrict__ gp = gate + (size_t)(u.pm >> 3) * 9216 + u.pn * BM + wc * 32 + 8 * fq;
        f32x4 g[2][2], xa[2][2], xb[2][2];
#pragma unroll
        for (int bj = 0; bj < 2; ++bj)
#pragma unroll
            for (int n = 0; n < 2; ++n) { g[bj][n] = (*(const f32x4*)(gp + bj * HALF + 4 * n) + 1.0f) * rc; xa[bj][n] = *(const f32x4*)(xp + bj * HALF + 4 * n); }
#pragma unroll
        for (int i = 0; i < 8; ++i) { const int ai = i >> 2, m = i & 3; const size_t ro = (size_t)(ai * HALF + m * 16) * 1024;
            if (i + 1 < 8) { const size_t rn = (size_t)(((i + 1) >> 2) * HALF + ((i + 1) & 3) * 16) * 1024;
#pragma unroll
                for (int bj = 0; bj < 2; ++bj)
#pragma unroll
                    for (int n = 0; n < 2; ++n) { if (i & 1) xa[bj][n] = *(const f32x4*)(xp + rn + bj * HALF + 4 * n); else xb[bj][n] = *(const f32x4*)(xp + rn + bj * HALF + 4 * n); } }
#pragma unroll
            for (int bj = 0; bj < 2; ++bj)
#pragma unroll
                for (int n = 0; n < 2; ++n) { const f32x4 x = (i & 1) ? xb[bj][n] : xa[bj][n]; *(f32x4*)(zp + ro + bj * HALF + 4 * n) = x * 1.41421356237309515f + g[bj][n] * acc[ai][bj][m][n]; } }
    } };
struct EpiInproj { static constexpr bool PERM = true, AFTER_DRAIN = false; bf16_t* P; float* GKL; bf16_t* UB;
    __device__ __forceinline__ void operator()(const f32x4 (&acc)[2][2][4][2], const Unit& u, int wr, int wc, int fr, int fq) const {
        const int row0 = u.pm * BM + wr * 64 + fr;
#pragma unroll
        for (int ai = 0; ai < 2; ++ai)
#pragma unroll
            for (int m = 0; m < 4; ++m) { const int row = row0 + ai * HALF + m * 16;
#pragma unroll
                for (int bj = 0; bj < 2; ++bj) { const int c = u.pn * BM + bj * HALF + wc * 32 + 8 * fq;
                    const u32x4 pk = pack8(acc[ai][bj][m][0], acc[ai][bj][m][1]);
                    *(u32x4*)(P + (size_t)row * 2304 + c) = pk;
                    if (c >= 1552 && c < 2064 && row < 16384) { const int cu = c - 1552; *(u32x4*)(UB + ((size_t)((cu >> 4) * 1024 + (row >> 4))) * 384 + (row & 15) * 16 + (cu & 15)) = pk; }
                    if (c >= 1536 && c < 1552) { *(f32x4*)(GKL + (size_t)row * 16 + (c - 1536)) = acc[ai][bj][m][0]; *(f32x4*)(GKL + (size_t)row * 16 + (c - 1536) + 4) = acc[ai][bj][m][1]; } } }
    } };
struct EpiGlu { static constexpr bool PERM = true, AFTER_DRAIN = false; const bf16_t* Z5; bf16_t* O; const float* bg;
    __device__ __forceinline__ void operator()(const f32x4 (&acc)[2][2][4][2], const Unit& u, int wr, int wc, int fr, int fq) const {
        const int cb = u.pn * BM + wc * 32 + 8 * fq;
        const bf16_t* __restrict__ zp = Z5 + (size_t)(u.pm * BM + wr * 64 + fr) * 512 + cb; bf16_t* __restrict__ op = O + (size_t)(u.pm * BM + wr * 64 + fr) * 1024 + 512 + cb;
        f32x4 b[2][2]; u32x4 za[2], zb[2];
#pragma unroll
        for (int bj = 0; bj < 2; ++bj) { b[bj][0] = *(const f32x4*)(bg + cb + bj * HALF); b[bj][1] = *(const f32x4*)(bg + cb + bj * HALF + 4); za[bj] = *(const u32x4*)(zp + bj * HALF); }
#pragma unroll
        for (int i = 0; i < 8; ++i) { const int ai = i >> 2, m = i & 3; const size_t rr = (size_t)(ai * HALF + m * 16);
            if (i + 1 < 8) { const size_t rn = (size_t)(((i + 1) >> 2) * HALF + ((i + 1) & 3) * 16) * 512;
#pragma unroll
                for (int bj = 0; bj < 2; ++bj) { if (i & 1) za[bj] = *(const u32x4*)(zp + rn + bj * HALF); else zb[bj] = *(const u32x4*)(zp + rn + bj * HALF); } }
#pragma unroll
            for (int bj = 0; bj < 2; ++bj) { const u32x4 zz = (i & 1) ? zb[bj] : za[bj]; f32x4 o0, o1;
#pragma unroll
                for (int e = 0; e < 4; ++e) { const unsigned w0 = zz[e >> 1], w1 = zz[2 + (e >> 1)];
                    const float z0 = __uint_as_float((e & 1) ? (w0 & 0xffff0000u) : (w0 << 16)), z1 = __uint_as_float((e & 1) ? (w1 & 0xffff0000u) : (w1 << 16));
                    o0[e] = z0 * fsigm(acc[ai][bj][m][0][e] + b[bj][0][e]); o1[e] = z1 * fsigm(acc[ai][bj][m][1][e] + b[bj][1][e]); }
                *(u32x4*)(op + rr * 1024 + bj * HALF) = pack8(o0, o1); } }
    } };
__device__ __forceinline__ float ftanh(float x) { const float e = __builtin_amdgcn_exp2f(-2.88539008178f * fabsf(x)); const float t = (1.0f - e) * __builtin_amdgcn_rcpf(1.0f + e); return x < 0.f ? -t : t; }
struct EpiRk { static constexpr bool PERM = true, AFTER_DRAIN = false; bf16_t* R; size_t rkv_stride; bf16_t* L1;
    __device__ __forceinline__ void operator()(const f32x4 (&acc)[2][2][4][2], const Unit& u, int wr, int wc, int fr, int fq) const {
        const int row0 = u.pm * BM + wr * 64 + fr;
#pragma unroll
        for (int ai = 0; ai < 2; ++ai)
#pragma unroll
            for (int m = 0; m < 4; ++m) { const int row = row0 + ai * HALF + m * 16;
#pragma unroll
                for (int bj = 0; bj < 2; ++bj) { const int c = u.pn * BM + bj * HALF + wc * 32 + 8 * fq;
                    if (c < 3072) { bf16_t* dst = R + (size_t)(c >> 10) * rkv_stride; *(u32x4*)(dst + (size_t)row * 1024 + (c & 1023)) = pack8(acc[ai][bj][m][0], acc[ai][bj][m][1]); }
                    else { const int cc = c - 3072; if (cc < 384) { f32x4 o0 = acc[ai][bj][m][0], o1 = acc[ai][bj][m][1];
                        if (cc < 64) {
#pragma unroll
                            for (int e = 0; e < 4; ++e) { o0[e] = ftanh(o0[e]); o1[e] = ftanh(o1[e]); } }
                        else if (cc >= 128 && cc < 288) {
#pragma unroll
                            for (int e = 0; e < 4; ++e) { o0[e] = fsigm(o0[e]); o1[e] = fsigm(o1[e]); } }
                        else if (cc >= 288) { o0 = (f32x4){0.f, 0.f, 0.f, 0.f}; o1 = o0; }
                        *(u32x4*)(L1 + (size_t)row * 384 + cc) = pack8(o0, o1); } } } }
    } };
struct EpiLora2 { static constexpr bool PERM = true, AFTER_DRAIN = false; bf16_t* WRAW; bf16_t* AS; bf16_t* G; const float* a0;
    __device__ __forceinline__ void operator()(const f32x4 (&acc)[2][2][4][2], const Unit& u, int wr, int wc, int fr, int fq) const {
        const int row0 = u.pm * BM + wr * 64 + fr;
#pragma unroll
        for (int ai = 0; ai < 2; ++ai)
#pragma unroll
            for (int m = 0; m < 4; ++m) { const int row = row0 + ai * HALF + m * 16;
#pragma unroll
                for (int bj = 0; bj < 2; ++bj) { const int c = u.pn * BM + bj * HALF + wc * 32 + 8 * fq;
                    if (c < 1024) *(u32x4*)(WRAW + (size_t)row * 1024 + c) = pack8(acc[ai][bj][m][0], acc[ai][bj][m][1]);
                    else if (c < 2048) { const f32x4 a0v = *(const f32x4*)(a0 + c - 1024), a1v = *(const f32x4*)(a0 + c - 1024 + 4); f32x4 o0, o1;
#pragma unroll
                        for (int e = 0; e < 4; ++e) { o0[e] = fsigm(a0v[e] + acc[ai][bj][m][0][e]); o1[e] = fsigm(a1v[e] + acc[ai][bj][m][1][e]); }
                        *(u32x4*)(AS + (size_t)row * 1024 + c - 1024) = pack8(o0, o1); }
                    else *(u32x4*)(G + (size_t)row * 1024 + c - 2048) = pack8(acc[ai][bj][m][0], acc[ai][bj][m][1]); } }
    } };
struct EpiHloc { static constexpr bool PERM = true, AFTER_DRAIN = false; float* HL;
    __device__ __forceinline__ void operator()(const f32x4 (&acc)[2][2][4][2], const Unit& u, int wr, int wc, int fr, int fq) const {
        const int row0 = u.pm * BM + wr * 64 + fr, c = wc * 32 + 8 * fq;
#pragma unroll
        for (int ai = 0; ai < 2; ++ai)
#pragma unroll
            for (int m = 0; m < 4; ++m) { float* p = HL + (size_t)(row0 + ai * HALF + m * 16) * 128 + c; *(f32x4*)p = acc[ai][0][m][0]; *(f32x4*)(p + 4) = acc[ai][0][m][1]; }
    } };
__device__ __forceinline__ float fgelu(float x) { const float u2 = 1.5957691216057308f * (x + 0.044715f * x * x * x); return x * fsigm(u2); }
struct EpiS5Y { static constexpr bool PERM = true, AFTER_DRAIN = false; bf16_t* Z5;
    __device__ __forceinline__ void operator()(const f32x4 (&acc)[2][2][4][2], const Unit& u, int wr, int wc, int fr, int fq) const {
        const int row0 = u.pm * BM + wr * 64 + fr;
#pragma unroll
        for (int ai = 0; ai < 2; ++ai)
#pragma unroll
            for (int m = 0; m < 4; ++m) { const int row = row0 + ai * HALF + m * 16, g = row >> 10, chunk = row & 1023;
#pragma unroll
                for (int bj = 0; bj < 2; ++bj) { const int c = bj * HALF + wc * 32 + 8 * fq, t = c >> 4, co = c & 15; f32x4 o0, o1;
#pragma unroll
                    for (int e = 0; e < 4; ++e) { o0[e] = fgelu(acc[ai][bj][m][0][e]); o1[e] = fgelu(acc[ai][bj][m][1][e]); }
                    *(u32x4*)(Z5 + (size_t)(chunk * 16 + t) * 512 + g * 16 + co) = pack8(o0, o1); } }
    } };

struct EpiResidS { static constexpr bool PERM = true, AFTER_DRAIN = false; float* ZS; const float* gate; float rc; int pad;
    __device__ __forceinline__ void operator()(const f32x4 (&acc)[2][2][4][2], const Unit& u, int wr, int wc, int fr, int fq) const {
        const int r0 = wr * 64 + fr;
#pragma unroll
        for (int m = 0; m < 4; ++m) { const int r = r0 + m * 16; const int mr = 8 + r;
#pragma unroll
            for (int bj = 0; bj < 2; ++bj)
#pragma unroll
                for (int n = 0; n < 2; ++n) { const int c = u.pn * BM + bj * HALF + wc * 32 + 8 * fq + 4 * n; const f32x4 g = *(const f32x4*)(gate + (size_t)mr * 9216 + c); const f32x4 v = (g + 1.0f) * rc * acc[0][bj][m][n];
#pragma unroll
                    for (int e = 0; e < 4; ++e) __hip_atomic_fetch_add(ZS + (size_t)r * 1024 + c + e, v[e], __ATOMIC_RELAXED, __HIP_MEMORY_SCOPE_AGENT); } }
    } };
enum { EK_SWIGLU = 0, EK_RESID, EK_RESIDS, EK_INPROJ, EK_GLU, EK_RK, EK_LORA2, EK_HLOC, EK_S5Y };
struct EpiAny { static constexpr bool PERM = true, AFTER_DRAIN = false; int kind; void* p0; void* p1; const void* p2; const void* p3; float f0;
    __device__ __forceinline__ void operator()(const f32x4 (&acc)[2][2][4][2], const Unit& u, int wr, int wc, int fr, int fq) const {
        asm volatile("" : "+v"(fr), "+v"(fq));
        switch (kind) {
        case EK_SWIGLU: { EpiSwiglu e{(bf16_t*)p0}; e(acc, u, wr, wc, fr, fq); break; }
        case EK_RESID: { EpiResid e{(const float*)p0, (float*)p1, (const float*)p2, f0, 0}; e(acc, u, wr, wc, fr, fq); break; }
        case EK_RESIDS: { EpiResidS e{(float*)p0, (const float*)p2, f0, 0}; e(acc, u, wr, wc, fr, fq); break; }
        case EK_INPROJ: { EpiInproj e{(bf16_t*)p0, (float*)p1, (bf16_t*)p2}; e(acc, u, wr, wc, fr, fq); break; }
        case EK_GLU: { EpiGlu e{(const bf16_t*)p0, (bf16_t*)p1, (const float*)p2}; e(acc, u, wr, wc, fr, fq); break; }
        case EK_RK: { EpiRk e{(bf16_t*)p0, (size_t)16640 * 1024, (bf16_t*)p1}; e(acc, u, wr, wc, fr, fq); break; }
        case EK_LORA2: { EpiLora2 e{(bf16_t*)p0, (bf16_t*)p1, (bf16_t*)p2, (const float*)p3}; e(acc, u, wr, wc, fr, fq); break; }
        case EK_HLOC: { EpiHloc e{(float*)p0}; e(acc, u, wr, wc, fr, fq); break; }
        default: { EpiS5Y e{(bf16_t*)p0}; e(acc, u, wr, wc, fr, fq); break; }
        }
    } };
struct AnyOrder { StaticOrder so; SplitOrder sp; int split;
    __device__ __forceinline__ bool next(int i, Unit& u) const { return split ? sp.next(i, u) : so.next(i, u); }
    __device__ __forceinline__ void a_ready(const Unit&) const {}
    __device__ __forceinline__ void done(const Unit&) const {} };
template <class Epi, class Sched, bool ALIGN_EPI = false, bool SP2 = false>
__device__ __forceinline__ void gemm_phase(PG8_LAS unsigned char* lds, const GemmX g, const Sched& S, const Epi& E) {
    int tid_ = threadIdx.x; asm volatile("" : "+v"(tid_));
    const int tid = tid_, wid = __builtin_amdgcn_readfirstlane(tid >> 6), lane = tid & 63, wr = wid >> 2, wc = wid & 3, fr = lane & 15, fq = lane >> 4;
    int K_ = g.K; asm volatile("" : "+s"(K_));
    const int K = K_, nt = K / BK;
    int lda_ = g.lda, ldb_ = g.ldb; asm volatile("" : "+s"(lda_), "+s"(ldb_)); const int lda = lda_, ldb = ldb_, gsh = g.gsh, nNb = g.N / BM;
    unsigned voffA[2], voffB[2];
#pragma unroll
    for (int i = 0; i < 2; ++i) { int R, C; stage_rc(tid * 16 + i * 8192, R, C); const int Rb = Epi::PERM ? ((R & ~31) + perm32(R & 31)) : R;
        voffA[i] = (unsigned)(R * lda + C) * 2u; voffB[i] = (unsigned)(Rb * ldb + C) * 2u; }
    const size_t kstep = (size_t)(BK * 2);
    const size_t hstepA = (size_t)HALF * lda * 2, hstepB = (size_t)HALF * ldb * 2;
    const size_t tstepA = 2 * hstepA, tstepB = 2 * hstepB;
#define PG8_BTILE(u_) ((size_t)(gsh >= 0 ? ((u_).pm >> gsh) * nNb + (u_).pn : (u_).pn))
    const unsigned ldsw = (unsigned)wid * 1024u;
    const int aoff = lds_byte(wr * 64 + fr, fq * 8), boff = lds_byte(wc * 32 + fr, fq * 8);
#define PG8_SA(b, h) (((b) * 2 + (h)) * HTB)
#define PG8_SB(b, h) ((4 + (b) * 2 + (h)) * HTB)
#define PG8_STAGE(bufoff, gbase, voff) do { _Pragma("unroll") for (int _i = 0; _i < 2; ++_i) \
        __builtin_amdgcn_global_load_lds((const unsigned*)((const char*)(gbase) + (voff)[_i]), (PG8_LAS unsigned*)(lds + (bufoff) + ldsw + _i * 8192), 16, 0, 0); } while (0)
#define PG8_LDA(dst, b, h) do { _Pragma("unroll") for (int m = 0; m < 4; ++m) _Pragma("unroll") for (int k = 0; k < 2; ++k) dst[m][k] = *(const PG8_LAS bf16x8*)(lds + PG8_SA(b, h) + aoff + m * 2048 + k * 1024); } while (0)
#define PG8_LDB(dst, b, h) do { _Pragma("unroll") for (int n = 0; n < 2; ++n) _Pragma("unroll") for (int k = 0; k < 2; ++k) dst[n][k] = *(const PG8_LAS bf16x8*)(lds + PG8_SB(b, h) + boff + n * 2048 + k * 1024); } while (0)
#define PG8_MMA(ai, bj, At, Bt) do { __builtin_amdgcn_s_setprio(1); _Pragma("unroll") for (int m = 0; m < 4; ++m) _Pragma("unroll") for (int n = 0; n < 2; ++n) _Pragma("unroll") for (int k = 0; k < 2; ++k) \
        acc[ai][bj][m][n] = __builtin_amdgcn_mfma_f32_16x16x32_bf16(Bt[n][k], At[m][k], acc[ai][bj][m][n], 0, 0, 0); __builtin_amdgcn_s_setprio(0); } while (0)
#define PG8_WAIT_V(n) asm volatile("s_waitcnt vmcnt(" #n ")" ::: "memory")
#define PG8_WAIT_L(n) asm volatile("s_waitcnt lgkmcnt(" #n ")" ::: "memory")
#define PG8_BAR __builtin_amdgcn_s_barrier()
#define PG8_SCHED __builtin_amdgcn_sched_barrier(0)
    Unit cur, nxt; int ui = 0;
    if (!S.next(0, cur)) return;
    f32x4 acc[2][2][4][2];
#pragma unroll
    for (int a = 0; a < 2; ++a)
#pragma unroll
        for (int b = 0; b < 2; ++b)
#pragma unroll
            for (int m = 0; m < 4; ++m)
#pragma unroll
                for (int n = 0; n < 2; ++n) acc[a][b][m][n] = (f32x4){0.f, 0.f, 0.f, 0.f};
    bf16x8 At[4][2], B0[2][2], B1[2][2];
    const char* cA = (const char*)g.A + (size_t)cur.pm * tstepA + (size_t)cur.ko * 2; const char* cB = (const char*)g.Bt + PG8_BTILE(cur) * tstepB + (size_t)cur.ko * 2;
    S.a_ready(cur);
    if constexpr (SP2) {
        PG8_STAGE(PG8_SB(0, 0), cB, voffB); PG8_STAGE(PG8_SB(0, 1), cB + hstepB, voffB); PG8_STAGE(PG8_SA(0, 0), cA, voffA); PG8_STAGE(PG8_SA(0, 1), cA + hstepA, voffA);
        if (wr == 1) PG8_BAR;
        PG8_WAIT_V(2); PG8_BAR;
        PG8_STAGE(PG8_SB(1, 0), cB + kstep, voffB); PG8_STAGE(PG8_SA(1, 0), cA + kstep, voffA); PG8_STAGE(PG8_SB(1, 1), cB + hstepB + kstep, voffB);
        PG8_WAIT_V(6); PG8_BAR;
    } else {
        PG8_STAGE(PG8_SB(0, 0), cB, voffB); PG8_STAGE(PG8_SA(0, 0), cA, voffA); PG8_STAGE(PG8_SB(0, 1), cB + hstepB, voffB); PG8_STAGE(PG8_SA(0, 1), cA + hstepA, voffA);
        if (wr == 1) PG8_BAR;
        PG8_WAIT_V(4); PG8_BAR;
        PG8_STAGE(PG8_SB(1, 0), cB + kstep, voffB); PG8_STAGE(PG8_SA(1, 0), cA + kstep, voffA); PG8_STAGE(PG8_SB(1, 1), cB + hstepB + kstep, voffB);
        PG8_WAIT_V(6); PG8_BAR;
    }
    for (;;) {
        const bool has_next = S.next(ui + 1, nxt);
        const char* nA = has_next ? (const char*)g.A + (size_t)nxt.pm * tstepA + (size_t)nxt.ko * 2 : cA; const char* nB = has_next ? (const char*)g.Bt + PG8_BTILE(nxt) * tstepB + (size_t)nxt.ko * 2 : cB;
        for (int t = 0; t < nt; t += 2) {
            const bool last = (t == nt - 2);
            const char* a1 = cA + (size_t)(t + 1) * kstep;
            const char* a2 = last ? nA : cA + (size_t)(t + 2) * kstep; const char* b2 = last ? nB : cB + (size_t)(t + 2) * kstep;
            const char* a3 = a2 + kstep; const char* b3 = b2 + kstep;
            if (last && has_next) S.a_ready(nxt);
            if constexpr (SP2) {
            PG8_LDB(B0, 0, 0); PG8_LDB(B1, 0, 1); PG8_SCHED; PG8_LDA(At, 0, 0); PG8_STAGE(PG8_SA(1, 1), a1 + hstepA, voffA);
            PG8_WAIT_V(8); PG8_WAIT_L(0); PG8_BAR; PG8_MMA(0, 0, At, B0); PG8_MMA(0, 1, At, B1); PG8_BAR; PG8_SCHED;
            PG8_LDA(At, 0, 1); PG8_STAGE(PG8_SB(0, 0), b2, voffB); PG8_STAGE(PG8_SB(0, 1), b2 + hstepB, voffB); PG8_STAGE(PG8_SA(0, 0), a2, voffA);
            PG8_WAIT_V(8); PG8_WAIT_L(0); PG8_BAR; PG8_MMA(1, 0, At, B0); PG8_MMA(1, 1, At, B1); PG8_BAR; PG8_SCHED;
            PG8_LDB(B0, 1, 0); PG8_LDB(B1, 1, 1); PG8_SCHED; PG8_LDA(At, 1, 0); PG8_STAGE(PG8_SA(0, 1), a2 + hstepA, voffA);
            PG8_WAIT_V(8); PG8_WAIT_L(0); PG8_BAR; PG8_MMA(0, 0, At, B0); PG8_MMA(0, 1, At, B1); PG8_BAR; PG8_SCHED;
            PG8_LDA(At, 1, 1); PG8_STAGE(PG8_SB(1, 0), b3, voffB); PG8_STAGE(PG8_SB(1, 1), b3 + hstepB, voffB); PG8_STAGE(PG8_SA(1, 0), a3, voffA);
            PG8_WAIT_V(8); PG8_WAIT_L(0); PG8_BAR; PG8_MMA(1, 0, At, B0); PG8_MMA(1, 1, At, B1); PG8_BAR; PG8_SCHED;
            } else {
            PG8_LDB(B0, 0, 0); PG8_SCHED; PG8_LDA(At, 0, 0); PG8_STAGE(PG8_SA(1, 1), a1 + hstepA, voffA);
            PG8_WAIT_L(8); PG8_BAR; PG8_WAIT_L(0); PG8_MMA(0, 0, At, B0); PG8_BAR; PG8_SCHED;
            PG8_LDB(B1, 0, 1); PG8_STAGE(PG8_SB(0, 0), b2, voffB);
            PG8_BAR; PG8_WAIT_L(0); PG8_MMA(0, 1, At, B1); PG8_BAR;
            PG8_LDA(At, 0, 1); PG8_STAGE(PG8_SA(0, 0), a2, voffA);
            PG8_BAR; PG8_WAIT_L(0); PG8_MMA(1, 0, At, B0); PG8_BAR; PG8_SCHED;
            PG8_STAGE(PG8_SB(0, 1), b2 + hstepB, voffB);
            PG8_WAIT_V(6); PG8_BAR; PG8_MMA(1, 1, At, B1); PG8_BAR;
            PG8_LDB(B0, 1, 0); PG8_SCHED; PG8_LDA(At, 1, 0); PG8_STAGE(PG8_SA(0, 1), a2 + hstepA, voffA);
            PG8_WAIT_L(8); PG8_BAR; PG8_WAIT_L(0); PG8_MMA(0, 0, At, B0); PG8_BAR; PG8_SCHED;
            PG8_LDB(B1, 1, 1); PG8_STAGE(PG8_SB(1, 0), b3, voffB);
            PG8_BAR; PG8_WAIT_L(0); PG8_MMA(0, 1, At, B1); PG8_BAR;
            PG8_LDA(At, 1, 1); PG8_STAGE(PG8_SA(1, 0), a3, voffA);
            PG8_BAR; PG8_WAIT_L(0); PG8_MMA(1, 0, At, B0); PG8_BAR; PG8_SCHED;
            PG8_STAGE(PG8_SB(1, 1), b3 + hstepB, voffB);
            PG8_WAIT_V(6); PG8_BAR; PG8_MMA(1, 1, At, B1); PG8_BAR;
            }
        }
        if constexpr (ALIGN_EPI) { if (wr == 0) PG8_BAR; }
        if constexpr (!Epi::AFTER_DRAIN) { E(acc, cur, wr, wc, fr, fq); S.done(cur); }
        if (!has_next) break;
#pragma unroll
        for (int a = 0; a < 2; ++a)
#pragma unroll
            for (int b = 0; b < 2; ++b)
#pragma unroll
                for (int m = 0; m < 4; ++m)
#pragma unroll
                    for (int n = 0; n < 2; ++n) acc[a][b][m][n] = (f32x4){0.f, 0.f, 0.f, 0.f};
        cur = nxt; cA = nA; cB = nB; ++ui;
        if constexpr (ALIGN_EPI) { if (wr == 1) PG8_BAR; }
    }
    PG8_WAIT_V(0);
    if constexpr (!ALIGN_EPI) { if (wr == 0) PG8_BAR; }
    PG8_BAR;
    if constexpr (Epi::AFTER_DRAIN) { E.fused(acc, cur, wr, wc, fr, fq, lds, wid, lane); S.done(cur); }
#undef PG8_BTILE
#undef PG8_SA
#undef PG8_SB
#undef PG8_STAGE
#undef PG8_LDA
#undef PG8_LDB
#undef PG8_MMA
#undef PG8_WAIT_V
#undef PG8_WAIT_L
#undef PG8_BAR
#undef PG8_SCHED
}
}

constexpr int NWAVES = 8;
constexpr int RING_OFF = 0, RING_BYTES = 131072;
constexpr int LDSCTL_OFF = RING_BYTES, MISC_OFF = LDSCTL_OFF + 320;
constexpr int LDS_BYTES = 147456;

struct Args { const float* in[52]; float* out; unsigned char* ws; };
static_assert(sizeof(Args) == 432, "kernarg layout");

struct Frame {
    LAS unsigned char* lds; int tid, lane, wave, G, blk;
    const float* const* in; float* out; unsigned char* ws;
};
#define INP(i) INPD(i)
#define KARG() ({ const unsigned char __attribute__((address_space(4)))* k_ = (const unsigned char __attribute__((address_space(4)))*)__builtin_amdgcn_kernarg_segment_ptr(); asm volatile("" : "+s"(k_)); k_; })
#define INPD(i) (*(const float* const __attribute__((address_space(4)))*)(KARG() + 8 * (i)))

template <class Src>
DEVI void cvt_item(const Src src, bf16* WT, int Kd, int nblk, LAS float* scr, int item, int lane) {
    const int kb = item / nblk, nb = item % nblk, k0 = 64 * kb, n0 = 32 * nb;
    const int kr = lane >> 3, nq = (lane & 7) * 4;
    f32x4 v[8];
#pragma unroll
    for (int i = 0; i < 8; ++i) v[i] = src.load4(k0 + 8 * i + kr, n0 + nq);
#pragma unroll
    for (int i = 0; i < 8; ++i) { LAS float* s = scr + (8 * i + kr) * 33 + nq; s[0] = v[i][0]; s[1] = v[i][1]; s[2] = v[i][2]; s[3] = v[i][3]; }
    LDS_WAIT(); asm volatile("" ::: "memory");
    const int c = lane & 7;
#pragma unroll
    for (int j = 0; j < 4; ++j) { const int n = (lane >> 3) + 8 * j; const LAS float* s = scr + (8 * c) * 33 + n;
        v4u o; o.x = pk2(s[0 * 33], s[1 * 33]); o.y = pk2(s[2 * 33], s[3 * 33]); o.z = pk2(s[4 * 33], s[5 * 33]); o.w = pk2(s[6 * 33], s[7 * 33]);
        *(GAS v4u*)(WT + (size_t)(n0 + n) * Kd + k0 + 8 * c) = o; }
    LDS_WAIT(); asm volatile("" ::: "memory");
}
struct SrcPlain { const float* W; int K, N, ld; DEVI f32x4 load4(int k, int n) const { return (k < K && n < N) ? *(const f32x4*)(W + (size_t)k * ld + n) : (f32x4){0.f, 0.f, 0.f, 0.f}; } };
struct SrcFold { const float* W; const float* mu; int ld; DEVI f32x4 load4(int k, int n) const { const int kk = k & 1023; const float m = mu[kk]; return *(const f32x4*)(W + (size_t)kk * ld + n) * (k < 1024 ? m : (1.0f - m)); } };
struct SrcBlk { const float* W; int k0, k1; DEVI f32x4 load4(int k, int n) const { return (k >= k0 && k < k1) ? *(const f32x4*)(W + (size_t)(k - k0) * 1024 + n) : (f32x4){0.f, 0.f, 0.f, 0.f}; } };
struct SrcZero { DEVI f32x4 load4(int, int) const { return (f32x4){0.f, 0.f, 0.f, 0.f}; } };

DEVI void sincos_d(double x, double& s, double& c) {
    const double n = rint(x * 0.63661977236758134308);
    double r = fma(-n, 1.57079632679489655800e+00, x); r = fma(-n, 6.12323399573676603587e-17, r);
    const double r2 = r * r;
    double sp = -7.6471637318198164759e-13; sp = fma(sp, r2, 1.6059043836821614599e-10); sp = fma(sp, r2, -2.5052108385441718775e-08); sp = fma(sp, r2, 2.7557319223985890653e-06);
    sp = fma(sp, r2, -1.9841269841269841270e-04); sp = fma(sp, r2, 8.3333333333333333333e-03); sp = fma(sp, r2, -1.6666666666666666667e-01); const double sr = fma(sp * r2, r, r);
    double cp = 4.7794773323873852974e-14; cp = fma(cp, r2, -1.1470745597729724714e-11); cp = fma(cp, r2, 2.0876756987868098979e-09); cp = fma(cp, r2, -2.7557319223985890653e-07);
    cp = fma(cp, r2, 2.4801587301587301587e-05); cp = fma(cp, r2, -1.3888888888888888889e-03); cp = fma(cp, r2, 4.1666666666666666667e-02); cp = fma(cp, r2, -0.5); const double cr = fma(cp, r2, 1.0);
    const int q = ((int)n) & 3;
    s = (q == 0) ? sr : (q == 1) ? cr : (q == 2) ? -sr : -cr;
    c = (q == 0) ? cr : (q == 1) ? -sr : (q == 2) ? -cr : sr;
}
DEVI void s5prep_one(int i, const float* a_re, const float* a_im, const float* log_step, const float* b_re, const float* b_im, float* sp) {
    const int g = i >> 6;
    const double dt = exp((double)log_step[g]), ar = a_re[i], ai = a_im[i];
    const double mag = exp(ar * dt); double s, c; sincos_d(ai * dt, s, c);
    const double abr = mag * c, abi = mag * s, den = ar * ar + ai * ai, nr = abr - 1.0;
    const double zr = (nr * ar + abi * ai) / den, zi = (abi * ar - nr * ai) / den;
    sp[i] = (float)abr; sp[2048 + i] = (float)abi;
    for (int cc = 0; cc < 16; ++cc) { const double br = b_re[i * 16 + cc], bi = b_im[i * 16 + cc];
        sp[4096 + i * 16 + cc] = (float)(zr * br - zi * bi); sp[4096 + 32768 + i * 16 + cc] = (float)(zr * bi + zi * br); }
}


constexpr int SP_PW = 4096 + 65536;
DEVI void s5prep_pw(int i, int tau, const float* a_re, const float* a_im, const float* log_step, float* sp) {
    const int g = i >> 6; const double dt = exp((double)log_step[g]), ar = a_re[i], ai = a_im[i];
    const double mag = exp(ar * dt * tau); double s, c; sincos_d(ai * dt * tau, s, c); sp[SP_PW + i * 34 + tau * 2] = (float)(mag * c); sp[SP_PW + i * 34 + tau * 2 + 1] = (float)(mag * s);
}
DEVI void s5_tm_job(int g, int tau, int lane, const float* sp, const float* c_re, const float* c_im, const float* dd, bf16* TM) {
    bf16* tm = TM + (size_t)g * 256 * 384;
    if (tau <= 15) {
        const int co = lane >> 2, ci0 = (lane & 3) * 4; float kv[4] = {0.f, 0.f, 0.f, 0.f};
#pragma unroll 8
        for (int p = 0; p < 64; ++p) { const float pr = sp[SP_PW + (g * 64 + p) * 34 + tau * 2], pi = sp[SP_PW + (g * 64 + p) * 34 + tau * 2 + 1];
            const float cr = c_re[(g * 16 + co) * 64 + p], ci = c_im[(g * 16 + co) * 64 + p];
            const f32x4 br = *(const f32x4*)(sp + 4096 + (g * 64 + p) * 16 + ci0), bi = *(const f32x4*)(sp + 4096 + 32768 + (g * 64 + p) * 16 + ci0);
#pragma unroll
            for (int q = 0; q < 4; ++q) { const float wr = pr * br[q] - pi * bi[q], wi = pr * bi[q] + pi * br[q]; kv[q] += cr * wr - ci * wi; } }
        if (tau == 0) {
#pragma unroll
            for (int q = 0; q < 4; ++q) if (ci0 + q == co) kv[q] += dd[g * 16 + co]; }
        const unsigned long long pk = (unsigned long long)pk2(kv[0], kv[1]) | ((unsigned long long)pk2(kv[2], kv[3]) << 32);
        for (int t = tau; t < 16; ++t) *(unsigned long long*)(tm + (size_t)(t * 16 + co) * 384 + (t - tau) * 16 + ci0) = pk;
        if (tau >= 1) for (int t = 0; t + tau < 16; ++t) *(unsigned long long*)(tm + (size_t)(t * 16 + co) * 384 + (t + tau) * 16 + ci0) = 0ull;
    }
    if (tau >= 1) { const int t = tau - 1, p = lane; const float pr = sp[SP_PW + (g * 64 + p) * 34 + tau * 2], pi = sp[SP_PW + (g * 64 + p) * 34 + tau * 2 + 1];
#pragma unroll
        for (int co = 0; co < 16; ++co) { const float cr = c_re[(g * 16 + co) * 64 + p], ci = c_im[(g * 16 + co) * 64 + p];
            tm[(size_t)(t * 16 + co) * 384 + 256 + p] = (bf16)f2bf(cr * pr - ci * pi); tm[(size_t)(t * 16 + co) * 384 + 320 + p] = (bf16)f2bf(-(cr * pi + ci * pr)); } }
}
DEVI void s5_hm_job(int g, int s, int lane, const float* sp, bf16* HM) {
    const int p = lane; const float pr = sp[SP_PW + (g * 64 + p) * 34 + (15 - s) * 2], pi = sp[SP_PW + (g * 64 + p) * 34 + (15 - s) * 2 + 1];
    bf16* hr = HM + ((size_t)g * 256 + p) * 256 + s * 16; bf16* hi = hr + 64 * 256;
#pragma unroll
    for (int h8 = 0; h8 < 2; ++h8) { float wr[8], wi[8];
#pragma unroll
        for (int q = 0; q < 8; ++q) { const float br = sp[4096 + (g * 64 + p) * 16 + h8 * 8 + q], bi = sp[4096 + 32768 + (g * 64 + p) * 16 + h8 * 8 + q]; wr[q] = pr * br - pi * bi; wi[q] = pr * bi + pi * br; }
        v4u a, b; a.x = pk2(wr[0], wr[1]); a.y = pk2(wr[2], wr[3]); a.z = pk2(wr[4], wr[5]); a.w = pk2(wr[6], wr[7]); b.x = pk2(wi[0], wi[1]); b.y = pk2(wi[2], wi[3]); b.z = pk2(wi[4], wi[5]); b.w = pk2(wi[6], wi[7]);
        *(v4u*)(hr + h8 * 8) = a; *(v4u*)(hi + h8 * 8) = b; }
}
DEVI void s5_carry_job(int b, int g, int lane, const float* sp, const float* HL, bf16* UB, float* ore, float* oim) {
    const int p = lane; const float ar = sp[SP_PW + (g * 64 + p) * 34 + 32], ai = sp[SP_PW + (g * 64 + p) * 34 + 33];
    float cr = 0.f, ci = 0.f;
#pragma unroll 8
    for (int n = 0; n < 128; ++n) { const size_t row = (size_t)g * 1024 + b * 128 + n;
        UB[row * 384 + 256 + p] = (bf16)f2bf(cr); UB[row * 384 + 320 + p] = (bf16)f2bf(ci);
        const float hr = HL[row * 128 + p], hi = HL[row * 128 + 64 + p];
        const float nr = ar * cr - ai * ci + hr, ni = ar * ci + ai * cr + hi; cr = nr; ci = ni; }
    ore[((size_t)b * 32 + g) * 64 + p] = cr; oim[((size_t)b * 32 + g) * 64 + p] = ci;
}


template <int NT> DEVI void mods_half(int m0, int l, int n0, int lane, const float* __restrict__ ST, const float* __restrict__ ada_w, const float* __restrict__ ada_b, float* MODS) {
    const int i16 = lane & 15, kq = lane >> 4;
    f32x4 acc[NT];
#pragma unroll
    for (int m = 0; m < NT; ++m) acc[m] = (f32x4){0.f, 0.f, 0.f, 0.f};
    const float* w = ada_w + (size_t)l * 1024 * 9216 + (size_t)kq * 9216 + n0 + i16; const float* st = ST + kq * 144 + i16 + m0 * 16;
    float a[4][NT], bv[4];
#pragma unroll
    for (int s = 0; s < 4; ++s) { bv[s] = w[(size_t)(4 * s) * 9216];
#pragma unroll
        for (int m = 0; m < NT; ++m) a[s][m] = st[(4 * s) * 144 + m * 16]; }
    for (int k0 = 0; k0 < 1024; k0 += 16) {
#pragma unroll
        for (int s = 0; s < 4; ++s) {
#pragma unroll
            for (int m = 0; m < NT; ++m) acc[m] = __builtin_amdgcn_mfma_f32_16x16x4f32(a[s][m], bv[s], acc[m], 0, 0, 0);
            const int kn = k0 + 16 + 4 * s; if (kn < 1024) { bv[s] = w[(size_t)kn * 9216];
#pragma unroll
                for (int m = 0; m < NT; ++m) a[s][m] = st[kn * 144 + m * 16]; } } }
    const float bb = ada_b[l * 9216 + n0 + i16];
#pragma unroll
    for (int m = 0; m < NT; ++m)
#pragma unroll
        for (int q = 0; q < 4; ++q) { const int r = (m0 + m) * 16 + kq * 4 + q; if (r < NMODROW) MODS[((size_t)l * NMODROW + r) * 9216 + n0 + i16] = acc[m][q] + bb; }
}
DEVI void mods_job(int job, int lane, const float* __restrict__ ST, const float* __restrict__ ada_w, const float* __restrict__ ada_b, float* MODS) {
    asm volatile("" : "+v"(lane));
    const int mh = job & 1, jb = job >> 1, l = jb / 576, n0 = (jb % 576) * 16;
    if (mh) mods_half<4>(5, l, n0, lane, ST, ada_w, ada_b, MODS); else mods_half<5>(0, l, n0, lane, ST, ada_w, ada_b, MODS);
}

DEVI void init_row(int row, int lane, const float* xp, const float* xs, const float* mods, float* X, bf16* H, float* ZS) {
    if (row >= MT) { for (int j = 0; j < 16; ++j) H[(size_t)row * D + j * 64 + lane] = 0; return; }
    const float* src = row < NP ? xp + (size_t)row * D : xs + (size_t)(row - NP) * D;
    const float* sh = modp(mods, 0, 0) + (size_t)mrow(row) * 9216; const float* sc = modp(mods, 0, 1) + (size_t)mrow(row) * 9216;
#pragma unroll
    for (int j = 0; j < 4; ++j) { const int c = j * 256 + lane * 4; const f32x4 v = *(const f32x4*)(src + c), a = *(const f32x4*)(sc + c), b = *(const f32x4*)(sh + c);
        *(f32x4*)(X + (size_t)row * D + c) = v; if (row >= NP) *(f32x4*)(ZS + (size_t)(row - NP) * D + c) = v * ALPHA; const f32x4 h = v * (a + 1.0f) + b;
        *(unsigned long long*)(H + (size_t)row * D + c) = (unsigned long long)pk2(h[0], h[1]) | ((unsigned long long)pk2(h[2], h[3]) << 32); }
}
DEVI void ln_row(int row, int lane, const float* Z, float* ZS, const float* g, const float* b, float* X, bf16* H, const float* sh, const float* sc) {
    const float* z = row < NP ? Z + (size_t)row * D : ZS + (size_t)(row - NP) * D; f32x4 v[4]; float s = 0.f;
#pragma unroll
    for (int j = 0; j < 4; ++j) { v[j] = *(const f32x4*)(z + j * 256 + lane * 4); s += (v[j][0] + v[j][1]) + (v[j][2] + v[j][3]); }
    const float mean = wave_sum(s) * (1.f / D); float q = 0.f;
#pragma unroll
    for (int j = 0; j < 4; ++j) { v[j] = v[j] - mean; q += (v[j][0] * v[j][0] + v[j][1] * v[j][1]) + (v[j][2] * v[j][2] + v[j][3] * v[j][3]); }
    const float rstd = rsqrtf(wave_sum(q) * (1.f / D) + 1e-5f);
    const int mr = mrow(row);
#pragma unroll
    for (int j = 0; j < 4; ++j) { const int c = j * 256 + lane * 4; const f32x4 x = v[j] * rstd * *(const f32x4*)(g + c) + *(const f32x4*)(b + c); *(f32x4*)(X + (size_t)row * D + c) = x; if (row >= NP) *(f32x4*)(ZS + (size_t)(row - NP) * D + c) = x * ALPHA;
        if (H) { const f32x4 h = x * (*(const f32x4*)(sc + (size_t)mr * 9216 + c) + 1.0f) + *(const f32x4*)(sh + (size_t)mr * 9216 + c);
            *(unsigned long long*)(H + (size_t)row * D + c) = (unsigned long long)pk2(h[0], h[1]) | ((unsigned long long)pk2(h[2], h[3]) << 32); } }
}
DEVI void ln_shift_rows(int row0, int n, int lane, const float* Z, float* ZS, const float* g, const float* b, float* X, const float* mods, const float* shift_in, bf16* A2, float* out) {
    f32x4 prev[4], gg[4], bb[4];
#pragma unroll
    for (int j = 0; j < 4; ++j) { gg[j] = *(const f32x4*)(g + j * 256 + lane * 4); bb[j] = *(const f32x4*)(b + j * 256 + lane * 4); prev[j] = (f32x4){0.f, 0.f, 0.f, 0.f}; }
    for (int r = ((row0 < NP && (row0 & 2047) != 0) ? row0 - 1 : row0); r < row0 + n; ++r) {
        const bool warm = r < row0;
        const float* z = r < NP ? Z + (size_t)r * D : ZS + (size_t)(r - NP) * D; f32x4 v[4]; float s = 0.f;
#pragma unroll
        for (int j = 0; j < 4; ++j) { v[j] = *(const f32x4*)(z + j * 256 + lane * 4); s += (v[j][0] + v[j][1]) + (v[j][2] + v[j][3]); }
        const float mean = wave_sum(s) * (1.f / D); float q = 0.f;
#pragma unroll
        for (int j = 0; j < 4; ++j) { v[j] = v[j] - mean; q += (v[j][0] * v[j][0] + v[j][1] * v[j][1]) + (v[j][2] * v[j][2] + v[j][3] * v[j][3]); }
        const float rstd = rsqrtf(wave_sum(q) * (1.f / D) + 1e-5f);
        const int mr = mrow(r); const float* sh = modp(mods, 1, 3) + (size_t)mr * 9216; const float* sc = modp(mods, 1, 4) + (size_t)mr * 9216;
        const bool prompt = r < NP; const int t = r & 2047;
#pragma unroll
        for (int j = 0; j < 4; ++j) { const int c = j * 256 + lane * 4; const f32x4 x = v[j] * rstd * gg[j] + bb[j]; const f32x4 h = x * (*(const f32x4*)(sc + c) + 1.0f) + *(const f32x4*)(sh + c);
            if (!warm) { *(f32x4*)(X + (size_t)r * D + c) = x; if (r >= NP) *(f32x4*)(ZS + (size_t)(r - NP) * D + c) = x * ALPHA;
                f32x4 pv = prev[j]; if (!prompt) pv = *(const f32x4*)(shift_in + (size_t)(r - NP) * D + c); else if (t == 0) pv = (f32x4){0.f, 0.f, 0.f, 0.f};
                *(unsigned long long*)(A2 + (size_t)r * KRK + c) = (unsigned long long)pk2(pv[0], pv[1]) | ((unsigned long long)pk2(pv[2], pv[3]) << 32);
                *(unsigned long long*)(A2 + (size_t)r * KRK + 1024 + c) = (unsigned long long)pk2(h[0], h[1]) | ((unsigned long long)pk2(h[2], h[3]) << 32);
                if (prompt) { if (t == 2047) *(f32x4*)(out + O_SHIFT_P + (size_t)(r >> 11) * D + c) = h; } else *(f32x4*)(out + O_SHIFT_S + (size_t)(r - NP) * D + c) = h; }
            prev[j] = h; }
    }
}
DEVI void shiftcat_row(int row, int lane, const float* X, const float* mods, const float* shift_in, bf16* A2, float* out) {
    if (row >= MT) { for (int j = 0; j < 8; ++j) *(unsigned long long*)(A2 + (size_t)row * KRK + j * 256 + lane * 4) = 0ull; return; }
    const int mr = mrow(row); const float* sh = modp(mods, 1, 3) + (size_t)mr * 9216; const float* sc = modp(mods, 1, 4) + (size_t)mr * 9216;
    const bool prompt = row < NP; const int t = row & 2047;
#pragma unroll
    for (int j = 0; j < 4; ++j) { const int c = j * 256 + lane * 4; const f32x4 a = *(const f32x4*)(sc + c) + 1.0f, b = *(const f32x4*)(sh + c);
        const f32x4 h = *(const f32x4*)(X + (size_t)row * D + c) * a + b; f32x4 pv;
        if (prompt) pv = t == 0 ? (f32x4){0.f, 0.f, 0.f, 0.f} : *(const f32x4*)(X + (size_t)(row - 1) * D + c) * a + b; else pv = *(const f32x4*)(shift_in + (size_t)(row - NP) * D + c);
        *(unsigned long long*)(A2 + (size_t)row * KRK + c) = (unsigned long long)pk2(pv[0], pv[1]) | ((unsigned long long)pk2(pv[2], pv[3]) << 32);
        *(unsigned long long*)(A2 + (size_t)row * KRK + 1024 + c) = (unsigned long long)pk2(h[0], h[1]) | ((unsigned long long)pk2(h[2], h[3]) << 32);
        if (prompt) { if (t == 2047) *(f32x4*)(out + O_SHIFT_P + (size_t)(row >> 11) * D + c) = h; } else *(f32x4*)(out + O_SHIFT_S + (size_t)(row - NP) * D + c) = h; }
}
DEVI void gla_post_one(int w, int lane, const float* OG, const bf16* P, const float* norm_g, bf16* O) {
    const int tok = w >> 2, h = w & 3;
    const float o0 = OG[(size_t)tok * 512 + h * 128 + lane], o1 = OG[(size_t)tok * 512 + h * 128 + 64 + lane];
    const float ms = wave_sum(o0 * o0 + o1 * o1) * (1.f / 128.f), r = rsqrtf(ms + 1e-5f);
    const float g0 = bf2f(P[(size_t)tok * NINP + 1024 + h * 128 + lane]), g1 = bf2f(P[(size_t)tok * NINP + 1024 + h * 128 + 64 + lane]);
    O[(size_t)tok * D + h * 128 + lane] = (bf16)f2bf(o0 * r * norm_g[lane] * siluf_(g0));
    O[(size_t)tok * D + h * 128 + 64 + lane] = (bf16)f2bf(o1 * r * norm_g[64 + lane] * siluf_(g1));
}

DEVI void gla_job(LAS float* scr, int lane, int b, int h, int half, const bf16* P, const float* GKL, const float* w_gk, const float* b_gk, int tok_base, int T, const float* s0, float* s_out, float* OG) {
    LAS float* sdec = scr; LAS float* sq = scr + 1024; LAS float* sk = scr + 2048;
    const int dv = half * 64 + lane;
    float S[64];
#pragma unroll
    for (int i = 0; i < 64; ++i) S[i] = s0 ? s0[(((size_t)b * 4 + h) * 64 + i) * 128 + dv] : 0.f;
    float wg[16];
#pragma unroll
    for (int r = 0; r < 16; ++r) wg[r] = w_gk[r * 256 + h * 64 + lane];
    const float bg = b_gk[h * 64 + lane];
    for (int t0 = 0; t0 < T; t0 += 16) { const int nt = (T - t0) < 16 ? (T - t0) : 16;
        for (int tt = 0; tt < nt; ++tt) { const size_t tok = (size_t)tok_base + (size_t)b * T + t0 + tt; float x = bg;
#pragma unroll
            for (int r = 0; r < 16; ++r) x += GKL[tok * 16 + r] * wg[r];
            const float ls = fminf(x, 0.f) - log1pf(__expf(-fabsf(x)));
            sdec[tt * 64 + lane] = __expf(ls * (1.f / 16.f)); sq[tt * 64 + lane] = bf2f(P[tok * NINP + h * 64 + lane]) * 0.125f; sk[tt * 64 + lane] = bf2f(P[tok * NINP + 256 + h * 64 + lane]); }
        LDS_WAIT(); asm volatile("" ::: "memory");
        for (int tt = 0; tt < nt; ++tt) { const size_t tok = (size_t)tok_base + (size_t)b * T + t0 + tt;
            const float v = bf2f(P[tok * NINP + 512 + h * 128 + dv]); float o = 0.f;
#pragma unroll
            for (int i = 0; i < 64; ++i) { S[i] = S[i] * sdec[tt * 64 + i] + sk[tt * 64 + i] * v; o += sq[tt * 64 + i] * S[i]; }
            OG[tok * 512 + h * 128 + dv] = o; }
        LDS_WAIT(); asm volatile("" ::: "memory");
    }
#pragma unroll
    for (int i = 0; i < 64; ++i) s_out[(((size_t)b * 4 + h) * 64 + i) * 128 + dv] = S[i];
}
DEVI void s5_job(LAS float* scr, int lane, int g, int b0, int nb, const bf16* P, const float* sp, const float* c_re, const float* c_im, const float* dd, int tok_base, int T,
                 const float* h0re, const float* h0im, float* ore, float* oim, bf16* Z5) {
    const int p = lane, c = p & 15, pq = p >> 4;
    const float abr = sp[g * 64 + p], abi = sp[2048 + g * 64 + p];
    float bbr[16], bbi[16], cr[16], ci[16];
#pragma unroll
    for (int i = 0; i < 16; ++i) { bbr[i] = sp[4096 + (g * 64 + p) * 16 + i]; bbi[i] = sp[4096 + 32768 + (g * 64 + p) * 16 + i];
        cr[i] = c_re[(g * 16 + c) * 64 + pq * 16 + i]; ci[i] = c_im[(g * 16 + c) * 64 + pq * 16 + i]; }
    const float dv = dd[g * 16 + c];
    for (int b = b0; b < b0 + nb; ++b) {
        float hr = h0re ? h0re[((size_t)b * 32 + g) * 64 + p] : 0.f, hi = h0im ? h0im[((size_t)b * 32 + g) * 64 + p] : 0.f;
        for (int t = 0; t < T; ++t) { const size_t tok = (size_t)tok_base + (size_t)b * T + t;
            const bf16* up = P + tok * NINP + 1552 + g * 16; float u[16];
#pragma unroll
            for (int i = 0; i < 16; ++i) u[i] = bf2f(up[i]);
            const float uc = bf2f(up[c]);
            float br = 0.f, bi = 0.f;
#pragma unroll
            for (int i = 0; i < 16; ++i) { br += u[i] * bbr[i]; bi += u[i] * bbi[i]; }
            const float nr = abr * hr - abi * hi + br, ni = abr * hi + abi * hr + bi; hr = nr; hi = ni;
            LAS float* hs = scr + (t & 1) * 128;
            hs[p] = hr; hs[64 + p] = hi;
            LDS_WAIT(); asm volatile("" ::: "memory");
            float y = 0.f;
#pragma unroll
            for (int i = 0; i < 16; ++i) y += cr[i] * hs[pq * 16 + i] - ci[i] * hs[64 + pq * 16 + i];
            y += __shfl_xor(y, 16); y += __shfl_xor(y, 32);
            if (p < 16) { y += dv * uc; Z5[tok * 512 + g * 16 + c] = (bf16)f2bf(gelu_tanh(y)); }
        }
        ore[((size_t)b * 32 + g) * 64 + p] = hr; oim[((size_t)b * 32 + g) * 64 + p] = hi;
        LDS_WAIT(); asm volatile("" ::: "memory");
    }
}
DEVI float wkv_decay(float w0, float raw) { const float x = -(w0 + raw); const float sp = fmaxf(x, 0.f) + log1pf(__expf(-fabsf(x))); return __expf(-__expf(-sp - 0.5f)); }
DEVI void wkv_job(LAS float* scr, int lane, int b, int h, const bf16* R, const bf16* Kb, const bf16* V, const bf16* WRAW, const float* w0p, const bf16* AS, bf16* GO, const float* k_k, const float* k_a, const float* r_k, const float* lnx_g, const float* lnx_b,
                  int tok_base, int T, const float* s0, float* s_out) {
    LAS float* sw = scr; LAS float* skm = scr + 512; LAS float* sa_ = scr + 1024; LAS float* sb = scr + 1536; LAS float* sr = scr + 2048; LAS float* sbon = scr + 2560;
    const int i = lane, ch = h * 64 + i;
    float S[64];
#pragma unroll
    for (int j = 0; j < 64; ++j) S[j] = s0 ? s0[(((size_t)b * 16 + h) * 64 + i) * 64 + j] : 0.f;
    const float kkc = k_k[ch], kac = k_a[ch], rkc = r_k[ch], lg = lnx_g[ch], lb = lnx_b[ch];
    for (int t0 = 0; t0 < T; t0 += 8) { const int nt = (T - t0) < 8 ? (T - t0) : 8;
        for (int tt = 0; tt < nt; ++tt) { const size_t tok = (size_t)tok_base + (size_t)b * T + t0 + tt;
            const float k = bf2f(Kb[tok * D + ch]), r = bf2f(R[tok * D + ch]), a = bf2f(AS[tok * D + ch]), w = wkv_decay(w0p[ch], bf2f(WRAW[tok * D + ch]));
            float kk = k * kkc; const float nrm = sqrtf(wave_sum(kk * kk)); kk = kk / fmaxf(nrm, 1e-12f);
            const float km = k * (1.f + (a - 1.f) * kac);
            sw[tt * 64 + i] = w; skm[tt * 64 + i] = km; sa_[tt * 64 + i] = -kk; sb[tt * 64 + i] = kk * a; sr[tt * 64 + i] = r;
            const float bon = wave_sum(r * km * rkc); if (i == 0) sbon[tt] = bon; }
        LDS_WAIT(); asm volatile("" ::: "memory");
        for (int tt = 0; tt < nt; ++tt) { const size_t tok = (size_t)tok_base + (size_t)b * T + t0 + tt;
            const float v = bf2f(V[tok * D + ch]); float sa = 0.f;
#pragma unroll
            for (int j = 0; j < 64; ++j) sa += S[j] * sa_[tt * 64 + j];
            float y = 0.f;
#pragma unroll
            for (int j = 0; j < 64; ++j) { S[j] = S[j] * sw[tt * 64 + j] + sa * sb[tt * 64 + j] + v * skm[tt * 64 + j]; y += S[j] * sr[tt * 64 + j]; }
            const float mean = wave_sum(y) * (1.f / 64.f), dy = y - mean, var = wave_sum(dy * dy) * (1.f / 64.f);
            float yn = dy * rsqrtf(var + 64e-5f) * lg + lb; yn += sbon[tt] * v;
            const float gt = bf2f(GO[tok * D + ch]); GO[tok * D + ch] = (bf16)f2bf(yn * gt); }
        LDS_WAIT(); asm volatile("" ::: "memory");
    }
#pragma unroll
    for (int j = 0; j < 64; ++j) s_out[(((size_t)b * 16 + h) * 64 + i) * 64 + j] = S[j];
}

DEVI float dpp_add(float v, const int ctrl_sel) {
    int r;
    switch (ctrl_sel) {
    case 0: r = __builtin_amdgcn_update_dpp(0, __builtin_bit_cast(int, v), 0xB1, 0xF, 0xF, true); break;
    case 1: r = __builtin_amdgcn_update_dpp(0, __builtin_bit_cast(int, v), 0x4E, 0xF, 0xF, true); break;
    case 2: r = __builtin_amdgcn_update_dpp(0, __builtin_bit_cast(int, v), 0x141, 0xF, 0xF, true); break;
    default: r = __builtin_amdgcn_update_dpp(0, __builtin_bit_cast(int, v), 0x140, 0xF, 0xF, true); break;
    }
    return v + __builtin_bit_cast(float, r);
}
DEVI float red16(float v) { v = dpp_add(v, 0); v = dpp_add(v, 1); v = dpp_add(v, 2); v = dpp_add(v, 3); return v; }
constexpr int WK_TB = 32;
constexpr int WK_W = 0, WK_KM = 2048, WK_NA = 4096, WK_BB = 6144, WK_WR = 8192, WK_V = 10240, WK_PB = 12800;
constexpr int WK_Y = 2 * WK_PB, WK_YB = 1024;
static_assert((WK_Y + 2 * WK_YB + 512 + 1200) * 4 <= RING_BYTES, "wkv lds");
struct WkvLoad { uint2 k, r, a, v, w; };
typedef float f32x2_t __attribute__((ext_vector_type(2)));
struct WkvOps { f32x4 na, wr, w4, bb, km, vv; };
DEVI float wkv_decay_fast(float w0, float raw) { const float x = -(w0 + raw); const float sp = fmaxf(x, 0.f) + 0.69314718056f * __builtin_amdgcn_logf(1.0f + __builtin_amdgcn_exp2f(-1.44269504089f * fabsf(x)));
    const float ee = __builtin_amdgcn_exp2f(-1.44269504089f * (sp + 0.5f)); return __builtin_amdgcn_exp2f(-1.44269504089f * ee); }
template <int MODE> DEVI void wkv_half(LAS float* L, int tid, int b, int h, int half, const bf16* R, const bf16* Kb, const bf16* V, const bf16* WRAW, const bf16* AS, const float* w0p,
                   const float* k_k, const float* k_a, const float* r_k, bf16* Y, float* BON, float* s_out) {
    asm volatile("" : "+v"(tid));
    const int rp = (tid >> 4) & 15, jq = tid & 15; const bool stepper = tid < 256;
    const int ch = h * 64 + 4 * jq, chv = h * 64 + half * 32 + 4 * (jq & 7);
    f32x4 S0 = {0.f, 0.f, 0.f, 0.f}, S1 = {0.f, 0.f, 0.f, 0.f};
    const size_t tokb = (size_t)b * TP;
    auto bf4 = [](uint2 u) -> f32x4 { f32x4 o; o[0] = __uint_as_float(u.x << 16); o[1] = __uint_as_float(u.x & 0xffff0000u); o[2] = __uint_as_float(u.y << 16); o[3] = __uint_as_float(u.y & 0xffff0000u); return o; };
#define WK_PREP1(bufidx, blkidx, tt_) do { LAS float* pb_ = L + (bufidx) * WK_PB; const size_t t_ = tokb + (size_t)(blkidx) * WK_TB + (tt_); const size_t o_ = t_ * D + ch; \
        const f32x4 k4 = bf4(*(const uint2*)(Kb + o_)), r4 = bf4(*(const uint2*)(R + o_)), a4 = bf4(*(const uint2*)(AS + o_)), wraw = bf4(*(const uint2*)(WRAW + o_)), v4 = bf4(*(const uint2*)(V + t_ * D + chv)); f32x4 w4; \
        _Pragma("unroll") for (int e_ = 0; e_ < 4; ++e_) w4[e_] = wkv_decay_fast(w0c[e_], wraw[e_]); \
        f32x4 kk = k4 * kkc; float ss = red16((kk[0] * kk[0] + kk[1] * kk[1]) + (kk[2] * kk[2] + kk[3] * kk[3])); const float inv = 1.0f / fmaxf(sqrtf(ss), 1e-12f); kk = kk * inv; \
        const f32x4 km = k4 * ((a4 - 1.0f) * kac + 1.0f); const f32x4 pr = r4 * km; const f32x4 prk = pr * rkc; const float bon = red16((prk[0] + prk[1]) + (prk[2] + prk[3])); \
        const f32x4 bbv = kk * a4; const f32x4 pb2 = bbv * r4; const float brs = red16((pb2[0] + pb2[1]) + (pb2[2] + pb2[3])), krs = red16((pr[0] + pr[1]) + (pr[2] + pr[3])); \
        *(LAS f32x4*)(pb_ + WK_W + (tt_) * 64 + 4 * jq) = w4; *(LAS f32x4*)(pb_ + WK_KM + (tt_) * 64 + 4 * jq) = km; *(LAS f32x4*)(pb_ + WK_NA + (tt_) * 64 + 4 * jq) = -kk; \
        *(LAS f32x4*)(pb_ + WK_BB + (tt_) * 64 + 4 * jq) = bbv; *(LAS f32x4*)(pb_ + WK_WR + (tt_) * 64 + 4 * jq) = w4 * r4 - kk * brs; \
        if (jq < 8) { *(LAS f32x4*)(pb_ + WK_V + (tt_) * 64 + 8 * jq) = (f32x4){v4[0], v4[1], v4[0] * krs, v4[1] * krs}; *(LAS f32x4*)(pb_ + WK_V + (tt_) * 64 + 8 * jq + 4) = (f32x4){v4[2], v4[3], v4[2] * krs, v4[3] * krs}; } \
        if (jq == 0 && half == 0) BON[t_ * 16 + h] = bon; } while (0)
#define WK_RD128(dst, ad, off) asm volatile("ds_read_b128 %0, %1 offset:%2" : "=v"(dst) : "v"(ad), "i"(off))
#define WK_LOADOPS(o_, dt_) do { WK_RD128((o_).na, aop, WK_NA * 4 + (dt_) * 256); WK_RD128((o_).wr, aop, WK_WR * 4 + (dt_) * 256); WK_RD128((o_).w4, aop, WK_W * 4 + (dt_) * 256); \
        WK_RD128((o_).bb, aop, WK_BB * 4 + (dt_) * 256); WK_RD128((o_).km, aop, WK_KM * 4 + (dt_) * 256); WK_RD128((o_).vv, av, (dt_) * 256); } while (0)
#define WK_WAIT(n_, o_) asm volatile("s_waitcnt lgkmcnt(" #n_ ")" : "+v"((o_).na), "+v"((o_).wr), "+v"((o_).w4), "+v"((o_).bb), "+v"((o_).km), "+v"((o_).vv))
#define WK_STEP(o_, dt_) do { \
        float sa0 = (S0[0] * (o_).na[0] + S0[1] * (o_).na[1]) + (S0[2] * (o_).na[2] + S0[3] * (o_).na[3]), sa1 = (S1[0] * (o_).na[0] + S1[1] * (o_).na[1]) + (S1[2] * (o_).na[2] + S1[3] * (o_).na[3]); \
        float y0 = (S0[0] * (o_).wr[0] + S0[1] * (o_).wr[1]) + (S0[2] * (o_).wr[2] + S0[3] * (o_).wr[3]), y1 = (S1[0] * (o_).wr[0] + S1[1] * (o_).wr[1]) + (S1[2] * (o_).wr[2] + S1[3] * (o_).wr[3]); \
        sa0 = dpp_add(sa0, 0); sa1 = dpp_add(sa1, 0); y0 = dpp_add(y0, 0); y1 = dpp_add(y1, 0); sa0 = dpp_add(sa0, 1); sa1 = dpp_add(sa1, 1); y0 = dpp_add(y0, 1); y1 = dpp_add(y1, 1); \
        sa0 = dpp_add(sa0, 2); sa1 = dpp_add(sa1, 2); y0 = dpp_add(y0, 2); y1 = dpp_add(y1, 2); sa0 = dpp_add(sa0, 3); sa1 = dpp_add(sa1, 3); y0 = dpp_add(y0, 3); y1 = dpp_add(y1, 3); \
        S0 = S0 * (o_).w4 + ((o_).bb * sa0 + (o_).km * (o_).vv[0]); S1 = S1 * (o_).w4 + ((o_).bb * sa1 + (o_).km * (o_).vv[1]); \
        f32x2_t yy; yy[0] = y0 + (o_).vv[2]; yy[1] = y1 + (o_).vv[3]; \
        asm volatile("ds_write_b64 %0, %1 offset:%2" :: "v"(ay), "v"(yy), "i"((dt_) * 128) : "memory"); } while (0)
    constexpr int NB = TP / WK_TB;
    if (!stepper) {
        const int ht = (tid - 256) >> 4;
        const f32x4 kkc = *(const f32x4*)(k_k + ch), kac = *(const f32x4*)(k_a + ch), rkc = *(const f32x4*)(r_k + ch), w0c = *(const f32x4*)(w0p + ch);
        WK_PREP1(0, 0, ht); WK_PREP1(0, 0, ht + 16);
        LDS_WAIT(); __builtin_amdgcn_s_barrier(); asm volatile("" ::: "memory");
        for (int n = 0; n < NB; ++n) { const int cur = n & 1;
            if (n + 1 < NB) { WK_PREP1(cur ^ 1, n + 1, ht); WK_PREP1(cur ^ 1, n + 1, ht + 16); }
            if (n >= 1) {
                const int yt = (tid - 256) >> 3, yq = (tid & 7) * 4; const f32x4 y4 = *(const LAS f32x4*)(L + WK_Y + (cur ^ 1) * WK_YB + yt * 32 + yq);
                uint2 ov; ov.x = pk2(y4[0], y4[1]); ov.y = pk2(y4[2], y4[3]);
                *(uint2*)(Y + (tokb + (size_t)(n - 1) * WK_TB + yt) * D + h * 64 + half * 32 + yq) = ov; }
            LDS_WAIT(); __builtin_amdgcn_s_barrier(); asm volatile("" ::: "memory");
        }
        { const int yt = (tid - 256) >> 3, yq = (tid & 7) * 4; const f32x4 y4 = *(const LAS f32x4*)(L + WK_Y + ((NB - 1) & 1) * WK_YB + yt * 32 + yq);
            uint2 ov; ov.x = pk2(y4[0], y4[1]); ov.y = pk2(y4[2], y4[3]); *(uint2*)(Y + (tokb + (size_t)(NB - 1) * WK_TB + yt) * D + h * 64 + half * 32 + yq) = ov; }
    } else {
        LDS_WAIT(); __builtin_amdgcn_s_barrier(); asm volatile("" ::: "memory");
        const unsigned lbase = (unsigned)(size_t)L;
        for (int n = 0; n < NB; ++n) { const int cur = n & 1;
            unsigned aop = lbase + (unsigned)(cur * WK_PB + 4 * jq) * 4u, av = lbase + (unsigned)(cur * WK_PB + WK_V + 4 * rp) * 4u;
            unsigned ay = lbase + (unsigned)(jq == 0 ? WK_Y + cur * WK_YB + 2 * rp : WK_Y + 2 * WK_YB + 2 * tid) * 4u;
            WkvOps o0, o1, o2, o3;
            asm volatile("s_waitcnt lgkmcnt(0)" ::: "memory");
            WK_LOADOPS(o0, 0); WK_LOADOPS(o1, 1);
            WK_LOADOPS(o2, 2); WK_WAIT(12, o0); WK_STEP(o0, 0);
            WK_LOADOPS(o3, 3); WK_WAIT(13, o1); WK_STEP(o1, 1);
            for (int t4 = 0; t4 < 7; ++t4) {
                WK_LOADOPS(o0, 4); WK_WAIT(14, o2); WK_STEP(o2, 2);
                WK_LOADOPS(o1, 5); WK_WAIT(14, o3); WK_STEP(o3, 3);
                aop += 1024; av += 1024; ay += 512;
                WK_LOADOPS(o2, 2); WK_WAIT(14, o0); WK_STEP(o0, 0);
                WK_LOADOPS(o3, 3); WK_WAIT(14, o1); WK_STEP(o1, 1);
            }
            WK_WAIT(8, o2); WK_STEP(o2, 2);
            WK_WAIT(2, o3); WK_STEP(o3, 3);
            asm volatile("s_waitcnt lgkmcnt(0)" ::: "memory");
            __builtin_amdgcn_s_barrier(); asm volatile("" ::: "memory");
        }
        float* so = s_out + (((size_t)b * 16 + h) * 64 + half * 32 + 2 * rp) * 64 + 4 * jq; *(f32x4*)so = S0; *(f32x4*)(so + 64) = S1;
    }
#undef WK_LOADOPS
#undef WK_STEP
#undef WK_WAIT
#undef WK_RD128
#undef WK_PREP1
}
DEVI void wkv_ypass_row(size_t tok, int lane, const bf16* Y, const bf16* V, bf16* GO, const float* BON, const float* lnx_g, const float* lnx_b) {
    const int c0 = lane * 16; const size_t o = tok * D + c0;
    const v4u ya = *(const v4u*)(Y + o), yb = *(const v4u*)(Y + o + 8), va = *(const v4u*)(V + o), vb = *(const v4u*)(V + o + 8), ga = *(const v4u*)(GO + o), gb = *(const v4u*)(GO + o + 8);
    const unsigned yw[8] = {ya.x, ya.y, ya.z, ya.w, yb.x, yb.y, yb.z, yb.w}, vw[8] = {va.x, va.y, va.z, va.w, vb.x, vb.y, vb.z, vb.w}, gw_[8] = {ga.x, ga.y, ga.z, ga.w, gb.x, gb.y, gb.z, gb.w};
    float y[16]; float s = 0.f;
#pragma unroll
    for (int e = 0; e < 8; ++e) { y[2 * e] = __uint_as_float(yw[e] << 16); y[2 * e + 1] = __uint_as_float(yw[e] & 0xffff0000u); s += y[2 * e] + y[2 * e + 1]; }
    s = dpp_add(s, 0); s = dpp_add(s, 1); const float mean = s * (1.f / 64.f); float q = 0.f;
#pragma unroll
    for (int e = 0; e < 16; ++e) { y[e] -= mean; q += y[e] * y[e]; }
    q = dpp_add(q, 0); q = dpp_add(q, 1); const float rstd = rsqrtf(q * (1.f / 64.f) + 64e-5f), bon = BON[tok * 16 + (lane >> 2)];
    unsigned ow[8];
#pragma unroll
    for (int e = 0; e < 8; ++e) { const float v0 = __uint_as_float(vw[e] << 16), v1 = __uint_as_float(vw[e] & 0xffff0000u), g0 = __uint_as_float(gw_[e] << 16), g1 = __uint_as_float(gw_[e] & 0xffff0000u);
        const float o0 = (y[2 * e] * rstd * lnx_g[c0 + 2 * e] + lnx_b[c0 + 2 * e] + bon * v0) * g0, o1 = (y[2 * e + 1] * rstd * lnx_g[c0 + 2 * e + 1] + lnx_b[c0 + 2 * e + 1] + bon * v1) * g1; ow[e] = pk2(o0, o1); }
    *(v4u*)(GO + o) = (v4u){ow[0], ow[1], ow[2], ow[3]}; *(v4u*)(GO + o + 8) = (v4u){ow[4], ow[5], ow[6], ow[7]};
}

constexpr int GL_BF = 0, GL_QI = 16384, GL_KI = 25600, GL_SC = 34816, GL_VT = 44032, GL_ST = 62464, GL_RS = 80896, GL_WG = 81920, GL_GKL = 86016, GL_SEG = 90112;
constexpr int GL_LD = 72;
DEVI bf16x8 gl_frag(LAS unsigned char* lds, int base, int row, int k0, int fq) { return *(const LAS bf16x8*)(lds + base + (row * GL_LD + k0 + 8 * fq) * 2); }
DEVI void gla_cumdecay(LAS unsigned char* lds, int tid, int h, size_t tok0, const float* GKL, const float* w_gk, const float* b_gk) {
    asm volatile("" : "+v"(tid));
    LAS float* BF = (LAS float*)(lds + GL_BF); LAS float* WG = (LAS float*)(lds + GL_WG); LAS float* GK = (LAS float*)(lds + GL_GKL); LAS float* SEG = (LAS float*)(lds + GL_SEG);
    for (int i = tid; i < 1024; i += 512) { WG[i] = w_gk[(i >> 6) * 256 + h * 64 + (i & 63)]; GK[i] = GKL[tok0 * 16 + i]; }
    LDS_WAIT(); __builtin_amdgcn_s_barrier(); asm volatile("" ::: "memory");
    { const int t = tid >> 3, d0 = (tid & 7) * 8; float x[8];
#pragma unroll
        for (int e = 0; e < 8; ++e) x[e] = b_gk[h * 64 + d0 + e];
#pragma unroll
        for (int r = 0; r < 16; ++r) { const float gv = GK[t * 16 + r]; const f32x4 w0 = *(const LAS f32x4*)(WG + r * 64 + d0), w1 = *(const LAS f32x4*)(WG + r * 64 + d0 + 4);
#pragma unroll
            for (int e = 0; e < 4; ++e) { x[e] += gv * w0[e]; x[4 + e] += gv * w1[e]; } }
#pragma unroll
        for (int e = 0; e < 8; ++e) { const float xx = x[e]; x[e] = (fminf(xx, 0.f) - log1pf(__expf(-fabsf(xx)))) * (1.f / 16.f); }
        *(LAS f32x4*)(BF + t * 64 + d0) = (f32x4){x[0], x[1], x[2], x[3]}; *(LAS f32x4*)(BF + t * 64 + d0 + 4) = (f32x4){x[4], x[5], x[6], x[7]}; }
    LDS_WAIT(); __builtin_amdgcn_s_barrier(); asm volatile("" ::: "memory");
    { const int dk = tid & 63, sg = tid >> 6; float a = 0.f;
#pragma unroll
        for (int i = 0; i < 8; ++i) { a += BF[(sg * 8 + i) * 64 + dk]; BF[(sg * 8 + i) * 64 + dk] = a; }
        SEG[sg * 64 + dk] = a; }
    LDS_WAIT(); __builtin_amdgcn_s_barrier(); asm volatile("" ::: "memory");
    { const int dk = tid & 63, sg = tid >> 6; float off = 0.f;
        for (int s = 0; s < sg; ++s) off += SEG[s * 64 + dk];
#pragma unroll
        for (int i = 0; i < 8; ++i) BF[(sg * 8 + i) * 64 + dk] += off; }
    LDS_WAIT(); __builtin_amdgcn_s_barrier(); asm volatile("" ::: "memory");
}
DEVI void gla_stage_vt(LAS unsigned char* lds, int tid, int h, size_t tok0, const bf16* P) {
    const int t = tid >> 3, dv0 = (tid & 7) * 16; const bf16* vp = P + (tok0 + t) * NINP + 512 + h * 128 + dv0;
    const v4u a = *(const v4u*)vp, b = *(const v4u*)(vp + 8); LAS bf16* VT = (LAS bf16*)(lds + GL_VT);
    const unsigned w[8] = {a.x, a.y, a.z, a.w, b.x, b.y, b.z, b.w};
#pragma unroll
    for (int e = 0; e < 8; ++e) { VT[(dv0 + 2 * e) * GL_LD + t] = (bf16)(w[e] & 0xffffu); VT[(dv0 + 2 * e + 1) * GL_LD + t] = (bf16)(w[e] >> 16); }
}
DEVI void gla_unit_a(LAS unsigned char* lds, int tid, int u, const bf16* P, const float* GKL, const float* w_gk, const float* b_gk, float* KV, float* DEC) {
    asm volatile("" : "+v"(tid));
    const int bh = u >> 5, ck = u & 31, b = bh >> 2, h = bh & 3; const size_t tok0 = (size_t)b * TP + ck * 64;
    const int lane = tid & 63, wave = tid >> 6, fr = lane & 15, fq = lane >> 4;
    gla_cumdecay(lds, tid, h, tok0, GKL, w_gk, b_gk);
    LAS float* BF = (LAS float*)(lds + GL_BF);
    { const int t = tid >> 3, d0 = (tid & 7) * 8; const v4u kq = *(const v4u*)(P + (tok0 + t) * NINP + 256 + h * 64 + d0); LAS bf16* KST = (LAS bf16*)(lds + GL_QI);
        const unsigned w[4] = {kq.x, kq.y, kq.z, kq.w};
#pragma unroll
        for (int e = 0; e < 8; ++e) { const float kv = __uint_as_float((e & 1) ? (w[e >> 1] & 0xffff0000u) : (w[e >> 1] << 16)); const float sc = __expf(BF[63 * 64 + d0 + e] - BF[t * 64 + d0 + e]);
            KST[(d0 + e) * GL_LD + t] = (bf16)f2bf(kv * sc); } }
    gla_stage_vt(lds, tid, h, tok0, P);
    if (tid < 64) DEC[(size_t)u * 64 + tid] = __expf(BF[63 * 64 + tid]);
    LDS_WAIT(); __builtin_amdgcn_s_barrier(); asm volatile("" ::: "memory");
#pragma unroll
    for (int dt = 0; dt < 4; ++dt) { f32x4 acc = {0.f, 0.f, 0.f, 0.f};
#pragma unroll
        for (int k0 = 0; k0 < 64; k0 += 32) acc = __builtin_amdgcn_mfma_f32_16x16x32_bf16(gl_frag(lds, GL_VT, wave * 16 + fr, k0, fq), gl_frag(lds, GL_QI, dt * 16 + fr, k0, fq), acc, 0, 0, 0);
        *(f32x4*)(KV + ((size_t)u * 64 + dt * 16 + fr) * 128 + wave * 16 + 4 * fq) = acc; }
    LDS_WAIT(); __builtin_amdgcn_s_barrier(); asm volatile("" ::: "memory");
}
DEVI void gla_scan_b(int gtid, float* KV, const float* DEC, float* s_out) {
    const int dv = gtid & 127, dkq = (gtid >> 7) & 15, bh = gtid >> 11; float S[4] = {0.f, 0.f, 0.f, 0.f};
#pragma unroll 4
    for (int c = 0; c < 32; ++c) { const size_t u = (size_t)bh * 32 + c; float* kp = KV + (u * 64 + dkq * 4) * 128 + dv;
#pragma unroll
        for (int e = 0; e < 4; ++e) { const float kv = kp[e * 128], dc = DEC[u * 64 + dkq * 4 + e]; kp[e * 128] = S[e]; S[e] = dc * S[e] + kv; } }
#pragma unroll
    for (int e = 0; e < 4; ++e) s_out[((size_t)bh * 64 + dkq * 4 + e) * 128 + dv] = S[e];
}
DEVI void gla_unit_c(LAS unsigned char* lds, int tid, int u, const bf16* P, const float* GKL, const float* w_gk, const float* b_gk, const float* KV, const float* norm_g, bf16* O) {
    asm volatile("" : "+v"(tid));
    const int bh = u >> 5, ck = u & 31, b = bh >> 2, h = bh & 3; const size_t tok0 = (size_t)b * TP + ck * 64;
    const int lane = tid & 63, wave = tid >> 6, fr = lane & 15, fq = lane >> 4;
    gla_cumdecay(lds, tid, h, tok0, GKL, w_gk, b_gk);
    LAS float* BF = (LAS float*)(lds + GL_BF);
    { const int t = tid >> 3, d0 = (tid & 7) * 8; const v4u qq = *(const v4u*)(P + (tok0 + t) * NINP + h * 64 + d0), kq = *(const v4u*)(P + (tok0 + t) * NINP + 256 + h * 64 + d0);
        const unsigned wq[4] = {qq.x, qq.y, qq.z, qq.w}, wk[4] = {kq.x, kq.y, kq.z, kq.w}; float qo[8], ko[8];
#pragma unroll
        for (int e = 0; e < 8; ++e) { const float qv = __uint_as_float((e & 1) ? (wq[e >> 1] & 0xffff0000u) : (wq[e >> 1] << 16)), kv = __uint_as_float((e & 1) ? (wk[e >> 1] & 0xffff0000u) : (wk[e >> 1] << 16));
            const float bb = BF[t * 64 + d0 + e]; qo[e] = qv * 0.125f * __expf(bb); ko[e] = kv * __expf(-bb); }
        v4u a, c; a.x = pk2(qo[0], qo[1]); a.y = pk2(qo[2], qo[3]); a.z = pk2(qo[4], qo[5]); a.w = pk2(qo[6], qo[7]); c.x = pk2(ko[0], ko[1]); c.y = pk2(ko[2], ko[3]); c.z = pk2(ko[4], ko[5]); c.w = pk2(ko[6], ko[7]);
        *(LAS v4u*)(lds + GL_QI + (t * GL_LD + d0) * 2) = a; *(LAS v4u*)(lds + GL_KI + (t * GL_LD + d0) * 2) = c; }
    gla_stage_vt(lds, tid, h, tok0, P);
    { const int dk = tid >> 3, dv0 = (tid & 7) * 16; const float* sp = KV + ((size_t)u * 64 + dk) * 128 + dv0; LAS bf16* ST = (LAS bf16*)(lds + GL_ST);
#pragma unroll
        for (int q = 0; q < 4; ++q) { const f32x4 s4 = *(const f32x4*)(sp + 4 * q);
#pragma unroll
            for (int e = 0; e < 4; ++e) ST[(dv0 + 4 * q + e) * GL_LD + dk] = (bf16)f2bf(s4[e]); } }
    LDS_WAIT(); __builtin_amdgcn_s_barrier(); asm volatile("" ::: "memory");
#pragma unroll
    for (int q = 0; q < 2; ++q) { const int id = wave * 2 + q, tt = id >> 2, st = id & 3; f32x4 acc = {0.f, 0.f, 0.f, 0.f};
#pragma unroll
        for (int k0 = 0; k0 < 64; k0 += 32) acc = __builtin_amdgcn_mfma_f32_16x16x32_bf16(gl_frag(lds, GL_KI, st * 16 + fr, k0, fq), gl_frag(lds, GL_QI, tt * 16 + fr, k0, fq), acc, 0, 0, 0);
        const int t = tt * 16 + fr, s0 = st * 16 + 4 * fq;
#pragma unroll
        for (int e = 0; e < 4; ++e) if (s0 + e > t) acc[e] = 0.f;
        *(LAS unsigned long long*)(lds + GL_SC + (t * GL_LD + s0) * 2) = (unsigned long long)pk2(acc[0], acc[1]) | ((unsigned long long)pk2(acc[2], acc[3]) << 32); }
    LDS_WAIT(); __builtin_amdgcn_s_barrier(); asm volatile("" ::: "memory");
    const int tt = wave & 3, hv = wave >> 2; f32x4 o[4]; float ssq = 0.f;
#pragma unroll
    for (int dt = 0; dt < 4; ++dt) { f32x4 acc = {0.f, 0.f, 0.f, 0.f}; const int dvr = (hv * 4 + dt) * 16 + fr;
#pragma unroll
        for (int k0 = 0; k0 < 64; k0 += 32) { acc = __builtin_amdgcn_mfma_f32_16x16x32_bf16(gl_frag(lds, GL_VT, dvr, k0, fq), gl_frag(lds, GL_SC, tt * 16 + fr, k0, fq), acc, 0, 0, 0);
            acc = __builtin_amdgcn_mfma_f32_16x16x32_bf16(gl_frag(lds, GL_ST, dvr, k0, fq), gl_frag(lds, GL_QI, tt * 16 + fr, k0, fq), acc, 0, 0, 0); }
        o[dt] = acc; ssq += (acc[0] * acc[0] + acc[1] * acc[1]) + (acc[2] * acc[2] + acc[3] * acc[3]); }
    ssq += __shfl_xor(ssq, 16); ssq += __shfl_xor(ssq, 32);
    LAS float* RS = (LAS float*)(lds + GL_RS);
    if (fq == 0) RS[hv * 64 + tt * 16 + fr] = ssq;
    LDS_WAIT(); __builtin_amdgcn_s_barrier(); asm volatile("" ::: "memory");
    { const int t = tt * 16 + fr; const float rstd = rsqrtf((RS[t] + RS[64 + t]) * (1.f / 128.f) + 1e-5f); const size_t tok = tok0 + t;
#pragma unroll
        for (int dt = 0; dt < 4; ++dt) { const int dv = (hv * 4 + dt) * 16 + 4 * fq; const uint2 gg = *(const uint2*)(P + tok * NINP + 1024 + h * 128 + dv); const f32x4 ng = *(const f32x4*)(norm_g + dv);
            const float g0 = __uint_as_float(gg.x << 16), g1 = __uint_as_float(gg.x & 0xffff0000u), g2 = __uint_as_float(gg.y << 16), g3 = __uint_as_float(gg.y & 0xffff0000u);
            uint2 ov; ov.x = pk2(o[dt][0] * rstd * ng[0] * siluf_(g0), o[dt][1] * rstd * ng[1] * siluf_(g1)); ov.y = pk2(o[dt][2] * rstd * ng[2] * siluf_(g2), o[dt][3] * rstd * ng[3] * siluf_(g3));
            *(uint2*)(O + tok * D + h * 128 + dv) = ov; } }
    LDS_WAIT(); __builtin_amdgcn_s_barrier(); asm volatile("" ::: "memory");
}

__global__ void __launch_bounds__(NWAVES * 64, 2) __attribute__((target("no-packed-fp32-ops"))) mk_fwd(Args args) {
    extern __shared__ __attribute__((aligned(16))) unsigned char lds_raw[];
    LAS unsigned char* lds = (LAS unsigned char*)lds_raw;
    volatile LAS unsigned* MISC = (volatile LAS unsigned*)(lds + MISC_OFF);
    const int tid = threadIdx.x, lane = tid & 63, wave = __builtin_amdgcn_readfirstlane(tid >> 6), G = gridDim.x, blk = blockIdx.x;
#define LW() (*(unsigned char* const __attribute__((address_space(4)))*)(KARG() + 424))
#define LO() (*(float* const __attribute__((address_space(4)))*)(KARG() + 416))
#define PTRS unsigned char* ws = LW(); float* out = LO(); float* MODS = (float*)(ws + WS_MODS); float* SP = (float*)(ws + WS_SP); bf16* H = (bf16*)(ws + WS_H); float* Z = (float*)(ws + WS_Z); bf16* ACT = (bf16*)(ws + WS_ACT); float* X = out; \
    (void)MODS; (void)SP; (void)H; (void)Z; (void)ACT; (void)X
    for (int u = tid; u < (LDS_BYTES - LDSCTL_OFF) / 4; u += NWAVES * 64) ((LAS unsigned*)(lds + LDSCTL_OFF))[u] = 0u;
    __syncthreads();
    { XcdBarrier b0_ = xcd_barrier_post((unsigned*)(LW() + WS_CTL) + CW_BAR, MISC + 8); (void)b0_; }
#define GRID_BAR() do { XcdBarrier b_; b_.bar = (unsigned*)(LW() + WS_CTL) + CW_BAR; b_.x = xb_xcc_id(); b_.st = MISC + 8; xcd_barrier(b_); if (XP == 6) xcd_barrier(b_); \
        if (PROBE && blk == 0 && tid == 0) ((unsigned long long*)(LW() + WS_CTL + 524288))[nst] = rt(); ++nst; } while (0)
    int nst = 0;
    if (PROBE && blk == 0 && tid == 0) ((unsigned long long*)(LW() + WS_CTL + 524288))[63] = rt();
    const int gw = blk * NWAVES + wave, NGW = G * NWAVES;
    const int gws = wave * G + blk;
    LAS float* wscr = (LAS float*)(lds + RING_OFF + wave * 16384);

    for (int xrep = 0; xrep < (XP == 1 ? 2 : 1); ++xrep) { PTRS;
        { float* STt = (float*)(ws + WS_ST); for (int i = blk * 512 + tid; i < 144 * 1024; i += G * 512) { const int r = i >> 10, k = i & 1023; float v = 0.f; if (r < 8) v = siluf_(INP(7)[r * 1024 + k]); else if (r < 136) v = siluf_(INP(8)[(r - 8) * 1024 + k]); STt[k * 144 + r] = v; } }
        for (int it = blk * 512 + tid; it < 2048 * 18; it += G * 512) { const int i = it & 2047, tau = it >> 11;
            if (tau == 17) s5prep_one(i, INP(24), INP(25), INP(26), INP(27), INP(28), SP); else s5prep_pw(i, tau, INP(24), INP(25), INP(26), SP); }
    }
    GRID_BAR();
    for (int xq = 0; xq < (XP == 17 ? 2 : 1); ++xq) { PTRS; bf16* TM = (bf16*)(ws + WS_TM); bf16* HM = (bf16*)(ws + WS_HM);
        constexpr int I_UP = (D / 64) * (NUP / 32), I_DN = (FFP / 64) * (D / 32), I_IN = (D / 64) * (NINP / 32), I_GLU = (512 / 64) * (512 / 32), I_SQ = (D / 64) * (D / 32), I_RK = (KRK / 64) * (NRK / 32), I_L2 = (NL1 / 64) * (3072 / 32);
        constexpr int NITEMS = 4 * I_UP + 4 * I_DN + I_IN + I_GLU + 2 * I_SQ + I_RK + I_L2;
        for (int it = NGW - 1 - gws; it < NITEMS; it += NGW) {
            int r = it;
            if (r < 4 * I_UP) { const int q = r / I_UP, l = q >> 1, f = q & 1; r -= q * I_UP;
                const int kb = r / (NUP / 32), nb = r % (NUP / 32), pn = nb >> 3, half = (nb >> 2) & 1, c0 = pn * 128 + (nb & 3) * 32;
                bf16* dst = (bf16*)(ws + (l ? WS_WUP_L1 : WS_WUP_L0) + f * SZ_WUP) + (size_t)(nb * 32) * D;
                if (c0 >= FF) { SrcZero s; cvt_item(s, dst, D, 1, wscr, kb, lane); }
                else if (half) { SrcPlain s{INPD(f ? 17 : 14) + (size_t)l * D * FF + c0, D, FF - c0, FF}; cvt_item(s, dst, D, 1, wscr, kb, lane); }
                else { SrcPlain s{INPD(f ? 16 : 13) + (size_t)l * D * FF + c0, D, FF - c0, FF}; cvt_item(s, dst, D, 1, wscr, kb, lane); }
                continue; } r -= 4 * I_UP;
            if (r < 4 * I_DN) { const int q = r / I_DN, l = q >> 1, f = q & 1; r -= q * I_DN;
                SrcPlain s{INPD(f ? 18 : 15) + (size_t)l * FF * D, FF, D, D};
                cvt_item(s, (bf16*)(ws + (l ? WS_WDN_L1 : WS_WDN_L0) + f * SZ_WDN), FFP, D / 32, wscr, r, lane); continue; } r -= 4 * I_DN;
            if (r < I_IN) { SrcPlain s{INPD(19), D, NIN, NIN}; cvt_item(s, (bf16*)(ws + WS_WIN), D, NINP / 32, wscr, r, lane); continue; } r -= I_IN;
            if (r < I_GLU) { SrcPlain s{INPD(32), 512, 512, 512}; cvt_item(s, (bf16*)(ws + WS_WGLU), 512, 512 / 32, wscr, r, lane); continue; } r -= I_GLU;
            if (r < I_SQ) { SrcPlain s{INPD(20), D, D, D}; cvt_item(s, (bf16*)(ws + WS_WOUT), D, D / 32, wscr, r, lane); continue; } r -= I_SQ;
            if (r < I_SQ) { SrcPlain s{INPD(38), D, D, D}; cvt_item(s, (bf16*)(ws + WS_WO), D, D / 32, wscr, r, lane); continue; } r -= I_SQ;
            if (r < I_RK) { const int kb = r / (NRK / 32), nb = r % (NRK / 32), n0 = nb * 32; bf16* dst = (bf16*)(ws + WS_WRK) + (size_t)n0 * KRK;
                if (n0 < 1024) { SrcFold s{INPD(35) + n0, INPD(34) + 0 * 1024, 1024}; cvt_item(s, dst, KRK, 1, wscr, kb, lane); }
                else if (n0 < 2048) { SrcFold s{INPD(36) + (n0 - 1024), INPD(34) + 2 * 1024, 1024}; cvt_item(s, dst, KRK, 1, wscr, kb, lane); }
                else if (n0 < 3072) { SrcFold s{INPD(37) + (n0 - 2048), INPD(34) + 3 * 1024, 1024}; cvt_item(s, dst, KRK, 1, wscr, kb, lane); }
                else if (n0 < 3136) { SrcFold s{INPD(40) + (n0 - 3072), INPD(34) + 1 * 1024, 64}; cvt_item(s, dst, KRK, 1, wscr, kb, lane); }
                else if (n0 < 3200) { SrcFold s{INPD(43) + (n0 - 3136), INPD(34) + 4 * 1024, 64}; cvt_item(s, dst, KRK, 1, wscr, kb, lane); }
                else if (n0 < 3360) { SrcFold s{INPD(45) + (n0 - 3200), INPD(34) + 5 * 1024, 160}; cvt_item(s, dst, KRK, 1, wscr, kb, lane); }
                else { SrcZero s; cvt_item(s, dst, KRK, 1, wscr, kb, lane); }
                continue; } r -= I_RK;
            { const int kb = r / (3072 / 32), nb = r % (3072 / 32), n0 = nb * 32; bf16* dst = (bf16*)(ws + WS_WL2) + (size_t)n0 * NL1;
                if (n0 < 1024) { SrcBlk s{INPD(41) + n0, 0, 64}; cvt_item(s, dst, NL1, 1, wscr, kb, lane); }
                else if (n0 < 2048) { SrcBlk s{INPD(44) + (n0 - 1024), 64, 128}; cvt_item(s, dst, NL1, 1, wscr, kb, lane); }
                else { SrcBlk s{INPD(46) + (n0 - 2048), 128, 288}; cvt_item(s, dst, NL1, 1, wscr, kb, lane); } }
        }
        for (int xr = 0; xr < (XP == 10 ? 2 : 1); ++xr) for (int j = gws; j < 2304; j += NGW) mods_job(__builtin_amdgcn_readfirstlane(j), lane, (const float*)(ws + WS_ST), INPD(9), INPD(10), MODS);
        for (int j = NGW - 1 - gws; j < 32 * 17 + 32 * 16; j += NGW) { if (j < 544) s5_tm_job(j / 17, j % 17, lane, SP, INPD(29), INPD(30), INPD(31), TM); else s5_hm_job((j - 544) >> 4, (j - 544) & 15, lane, SP, HM); }
        for (int i = gw * 64 + lane; i < 32 * 128 * 256 / 8; i += NGW * 64) { const int g = i >> 12, r = i & 4095; *(v4u*)(HM + ((size_t)g * 256 + 128) * 256 + (size_t)r * 8) = (v4u){0u, 0u, 0u, 0u}; } }
    GRID_BAR();
    { PTRS; for (int xr = 0; xr < (XP == 18 ? 2 : 1); ++xr) for (int row = gw; row < MTP; row += NGW) init_row(row, lane, INP(0), INP(1), MODS, X, H, (float*)(ws + WS_ZS)); }
    GRID_BAR();

#define GEMM_PHASE(EPI, Aptr, Bptr, NN, KK, ...) do { pg8::GemmX g_{(const pg8::bf16_t*)(Aptr), (const pg8::bf16_t*)(Bptr), MTP, NN, KK, KK, KK, -1}; pg8::StaticOrder S_; S_.init(MTP, NN, G, blk); pg8::EPI E_{__VA_ARGS__}; \
        pg8::gemm_phase<pg8::EPI, pg8::StaticOrder, true, true>(lds + RING_OFF, g_, S_, E_); } while (0)
#define GEMMX_PHASE(EPI, Aptr, Bptr, MM, NN, KK, LDA, LDB, GSH, ...) do { pg8::GemmX g_{(const pg8::bf16_t*)(Aptr), (const pg8::bf16_t*)(Bptr), MM, NN, KK, LDA, LDB, GSH}; pg8::StaticOrder S_; S_.init(MM, NN, G, blk); pg8::EPI E_{__VA_ARGS__}; \
        pg8::gemm_phase<pg8::EPI, pg8::StaticOrder, true, true>(lds + RING_OFF, g_, S_, E_); } while (0)
#define RESID_PHASE(Aptr, Bptr, KK, gatep, rcv) do { \
        { pg8::GemmX g_{(const pg8::bf16_t*)(Aptr), (const pg8::bf16_t*)(Bptr), NP, D, KK, KK, KK, -1}; pg8::StaticOrder S_; S_.init(NP, D, G, blk); pg8::EpiResid E_{X, Z, gatep, rcv, 0}; \
          pg8::gemm_phase<pg8::EpiResid, pg8::StaticOrder, true, true>(lds + RING_OFF, g_, S_, E_); } \
        { pg8::GemmX g_{(const pg8::bf16_t*)(Aptr), (const pg8::bf16_t*)(Bptr), MTP, D, 256, KK, KK, -1}; pg8::SplitOrder S_{64, 4, (KK) / 256, 256, G, blk}; pg8::EpiResidS E_{(float*)(ws + WS_ZS), gatep, rcv, 0}; \
          pg8::gemm_phase<pg8::EpiResidS, pg8::SplitOrder, true, true>(lds + RING_OFF, g_, S_, E_); } } while (0)
#define LN_PASS(l, idx, Hout, nsh, nsc) do { PTRS; for (int row = gw; row < MT; row += NGW) ln_row(row, lane, Z, (float*)(ws + WS_ZS), INP(11) + ((l) * 3 + (idx)) * D, INP(12) + ((l) * 3 + (idx)) * D, X, Hout, nsh, nsc); } while (0)
#define FFN(l, f, which0, lnidx, HOUT, nshw, nscw) do { \
        { PTRS; { int ru_ = (XP == 41 ? 2 : 1); asm volatile("" : "+s"(ru_)); for (int xu = 0; xu < ru_; ++xu) GEMM_PHASE(EpiSwiglu, H, ws + ((l) ? WS_WUP_L1 : WS_WUP_L0) + (f) * SZ_WUP, NUP, D, (pg8::bf16_t*)ACT); } if (XP == 2) { GEMM_PHASE(EpiSwiglu, H, ws + ((l) ? WS_WUP_L1 : WS_WUP_L0) + (f) * SZ_WUP, NUP, D, (pg8::bf16_t*)ACT); } if (XP == 42) { GEMM_PHASE(EpiHloc, H, ws + ((l) ? WS_WUP_L1 : WS_WUP_L0) + (f) * SZ_WUP, NUP, D, (float*)(ws + WS_Z)); } } GRID_BAR(); \
        { PTRS; RESID_PHASE(ACT, ws + ((l) ? WS_WDN_L1 : WS_WDN_L0) + (f) * SZ_WDN, FFP, modp(MODS, l, (which0) + 2), 0.5f); if (XP == 3) { RESID_PHASE(ACT, ws + ((l) ? WS_WDN_L1 : WS_WDN_L0) + (f) * SZ_WDN, FFP, modp(MODS, l, (which0) + 2), 0.5f); } } GRID_BAR(); \
        LN_PASS(l, lnidx, HOUT, nshw, nscw); if (XP == 4) { LN_PASS(l, lnidx, HOUT, nshw, nscw); } GRID_BAR(); } while (0)

    FFN(0, 0, 0, 0, H, modp(MODS, 0, 3), modp(MODS, 0, 4));
#define L0PTRS PTRS; bf16* P = (bf16*)(ws + WS_P); float* GKL = (float*)(ws + WS_GKL); float* OGS = (float*)(ws + WS_OGS) - (size_t)NP * 512; bf16* Z5 = (bf16*)(ws + WS_Z5); bf16* O = (bf16*)(ws + WS_O); \
        bf16* UB = (bf16*)(ws + WS_UBUF); float* HL = (float*)(ws + WS_HLOC); float* KV = (float*)(ws + WS_KV); float* DEC = (float*)(ws + WS_DEC); (void)P; (void)GKL; (void)OGS; (void)Z5; (void)O; (void)UB; (void)HL; (void)KV; (void)DEC
    { L0PTRS; for (int xr = 0; xr < (XP == 11 ? 2 : 1); ++xr) GEMM_PHASE(EpiInproj, H, ws + WS_WIN, NINP, D, (pg8::bf16_t*)P, GKL, (pg8::bf16_t*)UB); } GRID_BAR();
    for (int xr = 0; xr < (XP == 12 ? 2 : 1); ++xr) { if (xr) { GRID_BAR(); --nst; } L0PTRS;
        { int reps_ = (XP == 25 ? 2 : (XP == 26 ? 5 : 1)); asm volatile("" : "+s"(reps_)); for (int xh = 0; xh < reps_; ++xh) GEMMX_PHASE(EpiHloc, UB, ws + WS_HM, 32768, 256, 256, 384, 256, 2, HL); }
        for (int u = (blk + 128) & 255; u < 1024; u += 256) gla_unit_a(lds + RING_OFF, tid, u, P, GKL, INPD(21), INPD(22), KV, DEC);
    }
    GRID_BAR();
    { L0PTRS;
        for (int xr = 0; xr < (XP == 13 ? 2 : 1); ++xr) if (gws < 256) s5_carry_job(gws >> 5, gws & 31, lane, SP, HL, UB, out + O_S5RE_P, out + O_S5IM_P);
        if (blk >= 128) gla_scan_b((blk - 128) * 512 + tid, KV, DEC, out + O_GLA_P);
        for (int s = gws; s < 1536; s += NGW) {
            if (s < 1024) gla_job(wscr, lane, s >> 3, (s >> 1) & 3, s & 1, P, GKL, INPD(21), INPD(22), NP, 1, INPD(2), out + O_GLA_S, OGS);
            else { const int j = s - 1024; s5_job(wscr, lane, j & 31, (j >> 5) * 8, 8, P, SP, INPD(29), INPD(30), INPD(31), NP, 1, INPD(3), INPD(4), out + O_S5RE_S, out + O_S5IM_S, Z5); } }
    } GRID_BAR();
    for (int xr = 0; xr < (XP == 14 ? 2 : 1); ++xr) { L0PTRS;
        GEMMX_PHASE(EpiS5Y, UB, ws + WS_TM, 32768, 256, 384, 384, 384, 2, (pg8::bf16_t*)Z5);
        for (int u = (blk + 128) & 255; u < 1024; u += 256) gla_unit_c(lds + RING_OFF, tid, u, P, GKL, INPD(21), INPD(22), KV, INPD(23), O);
        for (int w = NP * 4 + gw; w < MT * 4; w += NGW) gla_post_one(w, lane, OGS, P, INP(23), O); } GRID_BAR();
    { L0PTRS; { int rg_ = (XP == 24 ? 2 : 1); asm volatile("" : "+s"(rg_)); for (int xr = 0; xr < rg_; ++xr) GEMM_PHASE(EpiGlu, Z5, ws + WS_WGLU, 512, 512, (const pg8::bf16_t*)Z5, (pg8::bf16_t*)O, INP(33)); }
        if (XP == 40) { int rh_ = 2; asm volatile("" : "+s"(rh_)); for (int xr = 0; xr < rh_; ++xr) GEMM_PHASE(EpiHloc, Z5, ws + WS_WGLU, 512, 512, HL); } } GRID_BAR();
    { L0PTRS; RESID_PHASE(O, ws + WS_WOUT, D, modp(MODS, 0, 5), 1.0f); } GRID_BAR();
    LN_PASS(0, 1, H, modp(MODS, 0, 6), modp(MODS, 0, 7)); GRID_BAR();
    FFN(0, 1, 6, 2, H, modp(MODS, 1, 0), modp(MODS, 1, 1));
    FFN(1, 0, 0, 0, (bf16*)nullptr, (const float*)nullptr, (const float*)nullptr);
#define L1PTRS PTRS; bf16* A2 = (bf16*)(ws + WS_A2); bf16* R = (bf16*)(ws + WS_R); bf16* Kb = (bf16*)(ws + WS_K); bf16* V = (bf16*)(ws + WS_V); bf16* L1 = (bf16*)(ws + WS_L1A); \
        bf16* WRAW = (bf16*)(ws + WS_WRAW); bf16* YB = (bf16*)(ws + WS_YB); float* BON = (float*)(ws + WS_BON); bf16* AS = (bf16*)(ws + WS_AS); bf16* Gt = (bf16*)(ws + WS_G); (void)A2; (void)R; (void)Kb; (void)V; (void)L1; (void)WRAW; (void)YB; (void)BON; (void)AS; (void)Gt
    { L1PTRS; for (int row = gw; row < MTP; row += NGW) shiftcat_row(row, lane, X, MODS, INP(5), A2, out); } GRID_BAR();
    { L1PTRS; GEMM_PHASE(EpiRk, A2, ws + WS_WRK, NRK, KRK, (pg8::bf16_t*)R, (size_t)MTP * D, (pg8::bf16_t*)L1); if (XP == 7) { GEMM_PHASE(EpiRk, A2, ws + WS_WRK, NRK, KRK, (pg8::bf16_t*)R, (size_t)MTP * D, (pg8::bf16_t*)L1); } } GRID_BAR();
    { L1PTRS; GEMM_PHASE(EpiLora2, L1, ws + WS_WL2, 3072, NL1, (pg8::bf16_t*)WRAW, (pg8::bf16_t*)AS, (pg8::bf16_t*)Gt, INP(42)); } GRID_BAR();
    if (XP == 21 || XP == 22) { L1PTRS; bf16* dY = (bf16*)(ws + WS_L0 + 32 * MiB); float* dB = (float*)(ws + WS_L0 + 26 * MiB); float* dS = (float*)(ws + WS_L0 + 25 * MiB + 524288);
        if (XP == 21) wkv_half<1>((LAS float*)(lds + RING_OFF), tid, 0, 0, 0, R, Kb, V, WRAW, AS, INPD(39), INPD(47), INPD(48), INPD(49), dY, dB, dS);
        else wkv_half<2>((LAS float*)(lds + RING_OFF), tid, 0, 0, 0, R, Kb, V, WRAW, AS, INPD(39), INPD(47), INPD(48), INPD(49), dY, dB, dS); __syncthreads(); }
    for (int xr = 0; xr < (XP == 5 ? 2 : 1); ++xr) { L1PTRS; wkv_half<0>((LAS float*)(lds + RING_OFF), tid, blk >> 5, (blk >> 1) & 15, blk & 1, R, Kb, V, WRAW, AS, INPD(39), INPD(47), INPD(48), INPD(49), YB, BON, out + O_WKV_P); if (XP == 5) __syncthreads(); } GRID_BAR();
    { L1PTRS;
        for (int t = gw; t < NP; t += NGW) wkv_ypass_row((size_t)t, lane, YB, V, Gt, BON, INPD(50), INPD(51));
        for (int s = gws; s < 2048; s += NGW) wkv_job(wscr, lane, s >> 4, s & 15, R, Kb, V, WRAW, INPD(39), AS, Gt, INPD(47), INPD(48), INPD(49), INPD(50), INPD(51), NP, 1, INPD(6), out + O_WKV_S); }
    GRID_BAR();
    { L1PTRS; RESID_PHASE(Gt, ws + WS_WO, D, modp(MODS, 1, 5), 1.0f); } GRID_BAR();
    LN_PASS(1, 1, H, modp(MODS, 1, 6), modp(MODS, 1, 7)); GRID_BAR();
    { PTRS; GEMM_PHASE(EpiSwiglu, H, ws + WS_WUP_L1 + SZ_WUP, NUP, D, (pg8::bf16_t*)ACT); if (XP == 2) { GEMM_PHASE(EpiSwiglu, H, ws + WS_WUP_L1 + SZ_WUP, NUP, D, (pg8::bf16_t*)ACT); } } GRID_BAR();
    { PTRS; RESID_PHASE(ACT, ws + WS_WDN_L1 + SZ_WDN, FFP, modp(MODS, 1, 8), 0.5f); if (XP == 3) { RESID_PHASE(ACT, ws + WS_WDN_L1 + SZ_WDN, FFP, modp(MODS, 1, 8), 0.5f); } } GRID_BAR();
    LN_PASS(1, 2, (bf16*)nullptr, (const float*)nullptr, (const float*)nullptr); if (XP == 4) { LN_PASS(1, 2, (bf16*)nullptr, (const float*)nullptr, (const float*)nullptr); }
#if PROBE
    {
        __syncthreads();
        PTRS; const unsigned long long* TS = (const unsigned long long*)(ws + WS_CTL + 524288);
        const float v1 = (float)(TS[PROBE_A1] - TS[PROBE_A0]) * 0.01f, v2 = (float)(TS[PROBE_B1] - TS[PROBE_B0]) * 0.01f * 10.0f;
        for (int row = NP + gw; row < MT; row += NGW) for (int j = 0; j < 16; ++j) X[(size_t)row * D + j * 64 + lane] = v1;
        if (blk == 0 && tid == 0) out[O_WKV_S] = v2;
    }
#endif
}

extern "C" void kernel_launch(void* const* d_in, const int* in_sizes, int n_in, void* d_out, int out_size, void* d_ws, size_t ws_size, hipStream_t stream) {
    static int grid = 0;
    if (grid == 0) {
        if (n_in != 52 || ws_size < WS_END) { fprintf(stderr, "kernel_launch: unexpected n_in %d or ws %zu\n", n_in, ws_size); grid = -1; return; }
        int dev = 0, cus = 0, per_cu = 0;
        if (hipGetDevice(&dev) != hipSuccess || hipDeviceGetAttribute(&cus, hipDeviceAttributeMultiprocessorCount, dev) != hipSuccess) { grid = -1; return; }
        if (hipFuncSetAttribute((const void*)mk_fwd, hipFuncAttributeMaxDynamicSharedMemorySize, LDS_BYTES) != hipSuccess) { fprintf(stderr, "hipFuncSetAttribute failed\n"); grid = -1; return; }
        if (hipOccupancyMaxActiveBlocksPerMultiprocessor(&per_cu, (const void*)mk_fwd, NWAVES * 64, LDS_BYTES) != hipSuccess || per_cu < 1) { fprintf(stderr, "occupancy query: %d\n", per_cu); per_cu = 1; }
        (void)hipGetLastError();
        grid = cus;
    }
    if (grid < 0) return;
    (void)hipMemsetAsync((char*)d_ws + WS_CTL, 0, CTL_ZERO_BYTES, stream);
    Args a{};
    for (int i = 0; i < 52; ++i) a.in[i] = (const float*)d_in[i];
    a.out = (float*)d_out; a.ws = (unsigned char*)d_ws;
    hipLaunchKernelGGL(mk_fwd, dim3(grid), dim3(NWAVES * 64), LDS_BYTES, stream, a);
}
```

```cpp
#include <hip/hip_runtime.h>
#include <cstdint>
#include <cstdio>

#ifndef PROBE
#define PROBE 0
#endif
#ifndef XP
#define XP 0
#endif
#define PROBE_A0 63
#define PROBE_A1 1
#define PROBE_B0 1
#define PROBE_B1 4
typedef unsigned short bf16;
typedef short bf16x8 __attribute__((ext_vector_type(8)));
typedef float f32x4 __attribute__((ext_vector_type(4)));
#define DEVI __device__ __forceinline__
__device__ __forceinline__ void mk_syncthreads() { asm volatile("s_waitcnt vmcnt(0) lgkmcnt(0)" ::: "memory"); __builtin_amdgcn_s_barrier(); asm volatile("" ::: "memory"); }
#define __syncthreads() mk_syncthreads()

constexpr int D = 1024, NP = 16384, NS = 128, MT = NP + NS, MTP = 16640, TP = 2048, BP = 8;
constexpr int FF = 2752, FFP = 2816, NUP = 2 * FFP;
constexpr int NIN = 2064, NINP = 2304;
constexpr int NRK = 3584, KRK = 2048, NL1 = 384;
constexpr int NMODROW = 136;
constexpr float ALPHA = 1.41421356237309515f;

constexpr size_t O_Y = 0, O_GLA_P = 16908288, O_S5RE_P = 17170432, O_S5IM_P = 17186816, O_SHIFT_P = 17203200, O_WKV_P = 17211392,
                 O_GLA_S = 17735680, O_S5RE_S = 21929984, O_S5IM_S = 22192128, O_SHIFT_S = 22454272, O_WKV_S = 22585344;

constexpr size_t MiB = 1u << 20;
constexpr size_t WS_CTL = 0, CTL_ZERO_BYTES = 1 * MiB;
constexpr size_t WS_MODS = 1 * MiB, WS_SP = 12 * MiB, WS_ST = 344 * MiB, WS_ZS = 345 * MiB, WS_SL = 336 * MiB;
constexpr size_t WS_W = 13 * MiB;
constexpr size_t SZ_WUP = (size_t)NUP * D * 2;
constexpr size_t SZ_WDN = (size_t)D * FFP * 2;
constexpr size_t WS_L0 = WS_W;
constexpr size_t WS_WUP_L0 = WS_L0, WS_WDN_L0 = WS_L0 + 22 * MiB, WS_WIN = WS_L0 + 33 * MiB, WS_WGLU = WS_WIN + 4608 * 1024, WS_WOUT = WS_WGLU + 512 * 1024;
constexpr size_t WS_L1 = WS_L0 + 40 * MiB;
constexpr size_t WS_WUP_L1 = WS_L1, WS_WDN_L1 = WS_L1 + 22 * MiB, WS_WRK = WS_L1 + 33 * MiB, WS_WL2 = WS_WRK + 14 * MiB, WS_WO = WS_WL2 + 2304 * 1024;
static_assert(WS_WO + 2 * MiB <= 105 * MiB, "W region");
constexpr size_t WS_H = 105 * MiB, WS_Z = 138 * MiB, WS_ACT = 203 * MiB, WS_S2 = 293 * MiB, WS_END = 346 * MiB;
constexpr size_t WS_P = WS_ACT, WS_GKL = 277 * MiB, WS_Z5 = WS_Z, WS_O = WS_H, WS_DEC = 195 * MiB, WS_OGS = 196 * MiB, WS_KV = WS_S2;
constexpr size_t WS_UBUF = 155 * MiB, WS_HLOC = 179 * MiB, WS_HM = 326 * MiB, WS_TM = 330 * MiB;
constexpr size_t WS_A2 = WS_ACT, WS_K = WS_Z, WS_R = WS_Z - (size_t)MTP * D * 2, WS_V = WS_Z + (size_t)MTP * D * 2, WS_L1A = WS_L0, WS_WRAW = WS_ACT, WS_YB = WS_ACT + (size_t)MTP * D * 2, WS_BON = WS_L0 + 30 * MiB, WS_AS = 268 * MiB, WS_G = WS_AS + (size_t)MTP * D * 2;
static_assert(WS_G + (size_t)MTP * D * 2 <= WS_END, "ws");
constexpr int CW_TMO = 0, CW_BAR = 4096;

#define GAS __attribute__((address_space(1)))
#define LAS __attribute__((address_space(3)))
typedef unsigned short bf16;
typedef unsigned v4u __attribute__((ext_vector_type(4)));
typedef float f32x4 __attribute__((ext_vector_type(4)));
typedef short bf16x8 __attribute__((ext_vector_type(8)));
typedef GAS unsigned gu32;
typedef GAS unsigned long long gu64;
#define RLX_AGENT __ATOMIC_RELAXED, __HIP_MEMORY_SCOPE_AGENT
#define LDS_WAIT() asm volatile("s_waitcnt lgkmcnt(0)" ::: "memory")
#define VM_WAIT() asm volatile("s_waitcnt vmcnt(0)" ::: "memory")
__device__ __forceinline__ unsigned long long rt() { return __builtin_amdgcn_s_memrealtime(); }
__device__ __forceinline__ unsigned f2bf(float f) { unsigned u = __builtin_bit_cast(unsigned, f); return (u + 0x7fffu + ((u >> 16) & 1u)) >> 16; }
__device__ __forceinline__ unsigned pk2(float lo, float hi) { return f2bf(lo) | (f2bf(hi) << 16); }

#define XB_TMO      128
#define XB_XCNT(j)  (256  + 64 * (j))
#define XB_XSUB(j)  (1280 + 64 * (j))
#define XB_XGEN(j)  (2304 + 64 * (j))
#define XB_TOP      3328
#define XB_TOPGEN   3392
#define XCD_BAR_WORDS 3456
#define XB_SPIN_CAP (1u << 18)

__device__ __forceinline__ unsigned xb_ld(unsigned* p)              { return __hip_atomic_load(p, __ATOMIC_RELAXED, __HIP_MEMORY_SCOPE_AGENT); }
__device__ __forceinline__ unsigned xb_add(unsigned* p, unsigned v) { return __hip_atomic_fetch_add(p, v, __ATOMIC_RELAXED, __HIP_MEMORY_SCOPE_AGENT); }
__device__ __forceinline__ unsigned xb_xcc_id() { return (unsigned)__builtin_amdgcn_s_getreg((3 << 11) | 20) & 0xFu; }
#define XB_SPIN(cond, bar) do { unsigned _sp = 0; while (cond) { __builtin_amdgcn_s_sleep(1); \
    if ((++_sp & 255u) == 0u) { if (xb_ld(&(bar)[XB_TMO])) break; if (_sp > XB_SPIN_CAP) { atomicAdd(&(bar)[XB_TMO], 1u); break; } } } } while (0)

struct XcdBarrier {
    unsigned* bar; unsigned x;
    volatile LAS unsigned* st;
};

__device__ __forceinline__ XcdBarrier xcd_barrier_post(unsigned* bar, volatile LAS unsigned* st) {
    XcdBarrier b; b.bar = bar; b.x = xb_xcc_id(); b.st = st;
    if (threadIdx.x == 0) (void)xb_add(&bar[XB_XCNT(b.x)], 1u);
    return b;
}
__device__ __forceinline__ void xcd_barrier_complete(unsigned* bar, unsigned x, unsigned& nloc, unsigned& nx) {
    const unsigned G = gridDim.x * gridDim.y * gridDim.z;
    unsigned sum, cnt, mine, sp = 0u;
    for (;;) {
        sum = 0u; cnt = 0u; mine = 0u;
#pragma unroll
        for (unsigned j = 0; j < 16; ++j) { const unsigned c = xb_ld(&bar[XB_XCNT(j)]); sum += c; cnt += (c > 0u) ? 1u : 0u; mine = (j == x) ? c : mine; }
        if (sum == G) break;
        __builtin_amdgcn_s_sleep(1);
        if ((++sp & 255u) == 0u) { if (xb_ld(&bar[XB_TMO])) break; if (sp > XB_SPIN_CAP) { atomicAdd(&bar[XB_TMO], 1u); break; } }
    }
    nloc = mine > 0u ? mine : 1u; nx = cnt > 0u ? cnt : 1u;
}

__device__ __forceinline__ void xcd_barrier(const XcdBarrier& b) {
    asm volatile("s_waitcnt vmcnt(0)" ::: "memory");
    __syncthreads();
    if (threadIdx.x == 0) {
        unsigned* bar = b.bar;
        __builtin_amdgcn_s_waitcnt(0);
        unsigned nloc = b.st[0], nx = b.st[1];
        if (nloc == 0u) { xcd_barrier_complete(bar, b.x, nloc, nx); b.st[0] = nloc; b.st[1] = nx; }
        const unsigned old = xb_add(&bar[XB_XSUB(b.x)], 1u);
        const unsigned gen = old / nloc;
        if (old + 1u == (gen + 1u) * nloc) {
            __builtin_amdgcn_fence(__ATOMIC_RELEASE, "agent");
            asm volatile("s_waitcnt vmcnt(0)" ::: "memory");
            const unsigned og = xb_add(&bar[XB_TOP], 1u);
            const unsigned tg = og / nx;
            if (og + 1u == (tg + 1u) * nx) xb_add(&bar[XB_TOPGEN], 1u);
            else XB_SPIN(xb_ld(&bar[XB_TOPGEN]) == tg, bar);
            __builtin_amdgcn_fence(__ATOMIC_ACQUIRE, "agent");
            xb_add(&bar[XB_XGEN(b.x)], 1u);
            asm volatile("s_waitcnt vmcnt(0)" ::: "memory");
        } else {
            XB_SPIN(xb_ld(&bar[XB_XGEN(b.x)]) == gen, bar);
            __builtin_amdgcn_fence(__ATOMIC_ACQUIRE, "agent");
            asm volatile("s_waitcnt vmcnt(0)" ::: "memory");
        }
    }
    __syncthreads();
}

DEVI float bf2f(unsigned short h) { return __uint_as_float(((unsigned)h) << 16); }
DEVI int mrow(int i) { return i < NP ? (i >> 11) : (8 + i - NP); }
DEVI float sigmoidf_(float x) { return 1.0f / (1.0f + __expf(-x)); }
DEVI float siluf_(float x) { return x / (1.0f + __expf(-x)); }
DEVI float softplusf_(float x) { return fmaxf(x, 0.f) + log1pf(__expf(-fabsf(x))); }
DEVI float gelu_tanh(float x) { const float u = 0.7978845608028654f * (x + 0.044715f * x * x * x); return 0.5f * x * (1.0f + tanhf(u)); }
DEVI float wave_sum(float v) {
#pragma unroll
    for (int o = 1; o < 64; o <<= 1) v += __shfl_xor(v, o);
    return v;
}
__host__ __device__ __forceinline__ const float* modp(const float* mods, int l, int which) { return mods + (size_t)l * NMODROW * 9216 + which * 1024; }

namespace pg8 {
#define PG8_LAS __attribute__((address_space(3)))
typedef unsigned short bf16_t;
typedef short bf16x8 __attribute__((ext_vector_type(8)));
typedef float f32x4 __attribute__((ext_vector_type(4)));
typedef unsigned u32x4 __attribute__((ext_vector_type(4)));
constexpr int BM = 256, BK = 64, HALF = 128, HTB = HALF * BK * 2  , STAGE_BYTES = 8 * HTB, NXCD = 8, WGM = 8;

__host__ __device__ __forceinline__ int lds_byte(int r, int c) { const int st = (r >> 4) * 2 + (c >> 5), rr = r & 15, cc = c & 31, ob = rr * 64 + cc * 2; return st * 1024 + (ob ^ (((ob >> 9) & 1) << 5)); }
__host__ __device__ __forceinline__ void stage_rc(int b, int& R, int& C) { const int st = b / 1024, sb = b % 1024, swz = sb ^ (((sb >> 9) & 1) << 5); R = (st >> 1) * 16 + swz / 64; C = (st & 1) * 32 + (swz % 64) / 2; }
__host__ __device__ __forceinline__ int perm32(int rho) { const int n = rho >> 4, i = rho & 15; return 8 * (i >> 2) + 4 * n + (i & 3); }

struct Unit { int pm, pn, ko; };
struct Gemm { const bf16_t* A; const bf16_t* Bt; int M, N, K; };
struct GemmX { const bf16_t* A; const bf16_t* Bt; int M, N, K, lda, ldb, gsh; };

struct StaticOrder {
    int nM, nN, nwg, G, c;
    __host__ __device__ __forceinline__ void init(int M, int N, int G_, int c_) { nM = M / BM; nN = N / BM; nwg = nM * nN; G = G_; c = c_; }
    __host__ __device__ __forceinline__ bool next(int i, Unit& u) const {
        const long L = (long)i * G + c; if (L >= nwg) return false;
        int wgid = (int)L; { const int q = nwg / NXCD, r = nwg % NXCD, xcd = wgid % NXCD, off = wgid / NXCD; wgid = (xcd < r ? xcd * (q + 1) : r * (q + 1) + (xcd - r) * q) + off; }
        const int nig = WGM * nN, gid = wgid / nig, fm = gid * WGM, gsz = (nM - fm) < WGM ? (nM - fm) : WGM;
        u.pm = fm + ((wgid % nig) % gsz); u.pn = (wgid % nig) / gsz; u.ko = 0; return true;
    }
    __device__ __forceinline__ void a_ready(const Unit&) const {}
    __device__ __forceinline__ void done(const Unit&) const {}
};

struct SplitOrder {
    int pm0, nN, nsplit, kspl, G, c;
    __host__ __device__ __forceinline__ bool next(int i, Unit& u) const { const int L = i * G + c; if (L >= nsplit * nN) return false; u.pm = pm0; u.pn = L % nN; u.ko = (L / nN) * kspl; return true; }
    __device__ __forceinline__ void a_ready(const Unit&) const {}
    __device__ __forceinline__ void done(const Unit&) const {}
};

__device__ __forceinline__ unsigned cvt_pk_bf16(float lo, float hi) { unsigned r; asm volatile("v_cvt_pk_bf16_f32 %0, %1, %2" : "=v"(r) : "v"(lo), "v"(hi)); return r; }
__device__ __forceinline__ float fsilu(float x) { return x * __builtin_amdgcn_rcpf(1.0f + __builtin_amdgcn_exp2f(-1.44269504089f * x)); }
__device__ __forceinline__ float fsigm(float x) { return __builtin_amdgcn_rcpf(1.0f + __builtin_amdgcn_exp2f(-1.44269504089f * x)); }
__device__ __forceinline__ u32x4 pack8(const f32x4 a, const f32x4 b) { u32x4 w; w.x = cvt_pk_bf16(a[0], a[1]); w.y = cvt_pk_bf16(a[2], a[3]); w.z = cvt_pk_bf16(b[0], b[1]); w.w = cvt_pk_bf16(b[2], b[3]); return w; }
struct EpiSwiglu { static constexpr bool PERM = true, AFTER_DRAIN = false; bf16_t* ACT;
    __device__ __forceinline__ void operator()(const f32x4 (&acc)[2][2][4][2], const Unit& u, int wr, int wc, int fr, int fq) const {
        const int row0 = u.pm * BM + wr * 64 + fr, col0 = u.pn * 128 + wc * 32 + 8 * fq;
#pragma unroll
        for (int ai = 0; ai < 2; ++ai)
#pragma unroll
            for (int m = 0; m < 4; ++m) { f32x4 o0, o1;
#pragma unroll
                for (int e = 0; e < 4; ++e) { o0[e] = fsilu(acc[ai][0][m][0][e]) * acc[ai][1][m][0][e]; o1[e] = fsilu(acc[ai][0][m][1][e]) * acc[ai][1][m][1][e]; }
                *(u32x4*)(ACT + (size_t)(row0 + ai * HALF + m * 16) * 2816 + col0) = pack8(o0, o1); }
    } };
struct EpiResid { static constexpr bool PERM = true, AFTER_DRAIN = false; const float* X; float* Z; const float* gate; float rc; int pad;
    __device__ __forceinline__ void operator()(const f32x4 (&acc)[2][2][4][2], const Unit& u, int wr, int wc, int fr, int fq) const {
        const float* __restrict__ xp = X + (size_t)(u.pm * BM + wr * 64 + fr) * 1024 + u.pn * BM + wc * 32 + 8 * fq; float* __restrict__ zp = Z + (size_t)(u.pm * BM + wr * 64 + fr) * 1024 + u.pn * BM + wc * 32 + 8 * fq;
        const float* __restrict__ gp = gate + (size_t)(u.pm >> 3) * 9216 + u.pn * BM + wc * 32 + 8 * fq;
        f32x4 g[2][2], xa[2][2], xb[2][2];
#pragma unroll
        for (int bj = 0; bj < 2; ++bj)
#pragma unroll
            for (int n = 0; n < 2; ++n) { g[bj][n] = (*(const f32x4*)(gp + bj * HALF + 4 * n) + 1.0f) * rc; xa[bj][n] = *(const f32x4*)(xp + bj * HALF + 4 * n); }
#pragma unroll
        for (int i = 0; i < 8; ++i) { const int ai = i >> 2, m = i & 3; const size_t ro = (size_t)(ai * HALF + m * 16) * 1024;
            if (i + 1 < 8) { const size_t rn = (size_t)(((i + 1) >> 2) * HALF + ((i + 1) & 3) * 16) * 1024;
#pragma unroll
                for (int bj = 0; bj < 2; ++bj)
#pragma unroll
                    for (int n = 0; n < 2; ++n) { if (i & 1) xa[bj][n] = *(const f32x4*)(xp + rn + bj * HALF + 4 * n); else xb[bj][n] = *(const f32x4*)(xp + rn + bj * HALF + 4 * n); } }
#pragma unroll
            for (int bj = 0; bj < 2; ++bj)
#pragma unroll
                for (int n = 0; n < 2; ++n) { const f32x4 x = (i & 1) ? xb[bj][n] : xa[bj][n]; *(f32x4*)(zp + ro + bj * HALF + 4 * n) = x * 1.41421356237309515f + g[bj][n] * acc[ai][bj][m][n]; } }
    } };
struct EpiInproj { static constexpr bool PERM = true, AFTER_DRAIN = false; bf16_t* P; float* GKL; bf16_t* UB;
    __device__ __forceinline__ void operator()(const f32x4 (&acc)[2][2][4][2], const Unit& u, int wr, int wc, int fr, int fq) const {
        const int row0 = u.pm * BM + wr * 64 + fr;
#pragma unroll
        for (int ai = 0; ai < 2; ++ai)
#pragma unroll
            for (int m = 0; m < 4; ++m) { const int row = row0 + ai * HALF + m * 16;
#pragma unroll
                for (int bj = 0; bj < 2; ++bj) { const int c = u.pn * BM + bj * HALF + wc * 32 + 8 * fq;
                    const u32x4 pk = pack8(acc[ai][bj][m][0], acc[ai][bj][m][1]);
                    *(u32x4*)(P + (size_t)row * 2304 + c) = pk;
                    if (c >= 1552 && c < 2064 && row < 16384) { const int cu = c - 1552; *(u32x4*)(UB + ((size_t)((cu >> 4) * 1024 + (row >> 4))) * 384 + (row & 15) * 16 + (cu & 15)) = pk; }
                    if (c >= 1536 && c < 1552) { *(f32x4*)(GKL + (size_t)row * 16 + (c - 1536)) = acc[ai][bj][m][0]; *(f32x4*)(GKL + (size_t)row * 16 + (c - 1536) + 4) = acc[ai][bj][m][1]; } } }
    } };
struct EpiGlu { static constexpr bool PERM = true, AFTER_DRAIN = false; const bf16_t* Z5; bf16_t* O; const float* bg;
    __device__ __forceinline__ void operator()(const f32x4 (&acc)[2][2][4][2], const Unit& u, int wr, int wc, int fr, int fq) const {
        const int cb = u.pn * BM + wc * 32 + 8 * fq;
        const bf16_t* __restrict__ zp = Z5 + (size_t)(u.pm * BM + wr * 64 + fr) * 512 + cb; bf16_t* __restrict__ op = O + (size_t)(u.pm * BM + wr * 64 + fr) * 1024 + 512 + cb;
        f32x4 b[2][2]; u32x4 za[2], zb[2];
#pragma unroll
        for (int bj = 0; bj < 2; ++bj) { b[bj][0] = *(const f32x4*)(bg + cb + bj * HALF); b[bj][1] = *(const f32x4*)(bg + cb + bj * HALF + 4); za[bj] = *(const u32x4*)(zp + bj * HALF); }
#pragma unroll
        for (int i = 0; i < 8; ++i) { const int ai = i >> 2, m = i & 3; const size_t rr = (size_t)(ai * HALF + m * 16);
            if (i + 1 < 8) { const size_t rn = (size_t)(((i + 1) >> 2) * HALF + ((i + 1) & 3) * 16) * 512;
#pragma unroll
                for (int bj = 0; bj < 2; ++bj) { if (i & 1) za[bj] = *(const u32x4*)(zp + rn + bj * HALF); else zb[bj] = *(const u32x4*)(zp + rn + bj * HALF); } }
#pragma unroll
            for (int bj = 0; bj < 2; ++bj) { const u32x4 zz = (i & 1) ? zb[bj] : za[bj]; f32x4 o0, o1;
#pragma unroll
                for (int e = 0; e < 4; ++e) { const unsigned w0 = zz[e >> 1], w1 = zz[2 + (e >> 1)];
                    const float z0 = __uint_as_float((e & 1) ? (w0 & 0xffff0000u) : (w0 << 16)), z1 = __uint_as_float((e & 1) ? (w1 & 0xffff0000u) : (w1 << 16));
                    o0[e] = z0 * fsigm(acc[ai][bj][m][0][e] + b[bj][0][e]); o1[e] = z1 * fsigm(acc[ai][bj][m][1][e] + b[bj][1][e]); }
                *(u32x4*)(op + rr * 1024 + bj * HALF) = pack8(o0, o1); } }
    } };
__device__ __forceinline__ float ftanh(float x) { const float e = __builtin_amdgcn_exp2f(-2.88539008178f * fabsf(x)); const float t = (1.0f - e) * __builtin_amdgcn_rcpf(1.0f + e); return x < 0.f ? -t : t; }
struct EpiRk { static constexpr bool PERM = true, AFTER_DRAIN = false; bf16_t* R; size_t rkv_stride; bf16_t* L1;
    __device__ __forceinline__ void operator()(const f32x4 (&acc)[2][2][4][2], const Unit& u, int wr, int wc, int fr, int fq) const {
        const int row0 = u.pm * BM + wr * 64 + fr;
#pragma unroll
        for (int ai = 0; ai < 2; ++ai)
#pragma unroll
            for (int m = 0; m < 4; ++m) { const int row = row0 + ai * HALF + m * 16;
#pragma unroll
                for (int bj = 0; bj < 2; ++bj) { const int c = u.pn * BM + bj * HALF + wc * 32 + 8 * fq;
                    if (c < 3072) { bf16_t* dst = R + (size_t)(c >> 10) * rkv_stride; *(u32x4*)(dst + (size_t)row * 1024 + (c & 1023)) = pack8(acc[ai][bj][m][0], acc[ai][bj][m][1]); }
                    else { const int cc = c - 3072; if (cc < 384) { f32x4 o0 = acc[ai][bj][m][0], o1 = acc[ai][bj][m][1];
                        if (cc < 64) {
#pragma unroll
                            for (int e = 0; e < 4; ++e) { o0[e] = ftanh(o0[e]); o1[e] = ftanh(o1[e]); } }
                        else if (cc >= 128 && cc < 288) {
#pragma unroll
                            for (int e = 0; e < 4; ++e) { o0[e] = fsigm(o0[e]); o1[e] = fsigm(o1[e]); } }
                        else if (cc >= 288) { o0 = (f32x4){0.f, 0.f, 0.f, 0.f}; o1 = o0; }
                        *(u32x4*)(L1 + (size_t)row * 384 + cc) = pack8(o0, o1); } } } }
    } };
struct EpiLora2 { static constexpr bool PERM = true, AFTER_DRAIN = false; bf16_t* WRAW; bf16_t* AS; bf16_t* G; const float* a0;
    __device__ __forceinline__ void operator()(const f32x4 (&acc)[2][2][4][2], const Unit& u, int wr, int wc, int fr, int fq) const {
        const int row0 = u.pm * BM + wr * 64 + fr;
#pragma unroll
        for (int ai = 0; ai < 2; ++ai)
#pragma unroll
            for (int m = 0; m < 4; ++m) { const int row = row0 + ai * HALF + m * 16;
#pragma unroll
                for (int bj = 0; bj < 2; ++bj) { const int c = u.pn * BM + bj * HALF + wc * 32 + 8 * fq;
                    if (c < 1024) *(u32x4*)(WRAW + (size_t)row * 1024 + c) = pack8(acc[ai][bj][m][0], acc[ai][bj][m][1]);
                    else if (c < 2048) { const f32x4 a0v = *(const f32x4*)(a0 + c - 1024), a1v = *(const f32x4*)(a0 + c - 1024 + 4); f32x4 o0, o1;
#pragma unroll
                        for (int e = 0; e < 4; ++e) { o0[e] = fsigm(a0v[e] + acc[ai][bj][m][0][e]); o1[e] = fsigm(a1v[e] + acc[ai][bj][m][1][e]); }
                        *(u32x4*)(AS + (size_t)row * 1024 + c - 1024) = pack8(o0, o1); }
                    else *(u32x4*)(G + (size_t)row * 1024 + c - 2048) = pack8(acc[ai][bj][m][0], acc[ai][bj][m][1]); } }
    } };
struct EpiHloc { static constexpr bool PERM = true, AFTER_DRAIN = false; float* HL;
    __device__ __forceinline__ void operator()(const f32x4 (&acc)[2][2][4][2], const Unit& u, int wr, int wc, int fr, int fq) const {
        const int row0 = u.pm * BM + wr * 64 + fr, c = wc * 32 + 8 * fq;
#pragma unroll
        for (int ai = 0; ai < 2; ++ai)
#pragma unroll
            for (int m = 0; m < 4; ++m) { float* p = HL + (size_t)(row0 + ai * HALF + m * 16) * 128 + c; *(f32x4*)p = acc[ai][0][m][0]; *(f32x4*)(p + 4) = acc[ai][0][m][1]; }
    } };
__device__ __forceinline__ float fgelu(float x) { const float u2 = 1.5957691216057308f * (x + 0.044715f * x * x * x); return x * fsigm(u2); }
struct EpiS5Y { static constexpr bool PERM = true, AFTER_DRAIN = false; bf16_t* Z5;
    __device__ __forceinline__ void operator()(const f32x4 (&acc)[2][2][4][2], const Unit& u, int wr, int wc, int fr, int fq) const {
        const int row0 = u.pm * BM + wr * 64 + fr;
#pragma unroll
        for (int ai = 0; ai < 2; ++ai)
#pragma unroll
            for (int m = 0; m < 4; ++m) { const int row = row0 + ai * HALF + m * 16, g = row >> 10, chunk = row & 1023;
#pragma unroll
                for (int bj = 0; bj < 2; ++bj) { const int c = bj * HALF + wc * 32 + 8 * fq, t = c >> 4, co = c & 15; f32x4 o0, o1;
#pragma unroll
                    for (int e = 0; e < 4; ++e) { o0[e] = fgelu(acc[ai][bj][m][0][e]); o1[e] = fgelu(acc[ai][bj][m][1][e]); }
                    *(u32x4*)(Z5 + (size_t)(chunk * 16 + t) * 512 + g * 16 + co) = pack8(o0, o1); } }
    } };

struct EpiResidS { static constexpr bool PERM = true, AFTER_DRAIN = false; float* SL; const float* gate; float rc; int pad;
    __device__ __forceinline__ void operator()(const f32x4 (&acc)[2][2][4][2], const Unit& u, int wr, int wc, int fr, int fq) const {
        const int r0 = wr * 64 + fr; float* __restrict__ sl = SL + (size_t)(u.ko >> 8) * 128 * 1024;
#pragma unroll
        for (int m = 0; m < 4; ++m) { const int r = r0 + m * 16; const int mr = 8 + r;
#pragma unroll
            for (int bj = 0; bj < 2; ++bj)
#pragma unroll
                for (int n = 0; n < 2; ++n) { const int c = u.pn * BM + bj * HALF + wc * 32 + 8 * fq + 4 * n; const f32x4 g = *(const f32x4*)(gate + (size_t)mr * 9216 + c);
                    *(f32x4*)(sl + (size_t)r * 1024 + c) = (g + 1.0f) * rc * acc[0][bj][m][n]; } }
    } };
enum { EK_SWIGLU = 0, EK_RESID, EK_RESIDS, EK_INPROJ, EK_GLU, EK_RK, EK_LORA2, EK_HLOC, EK_S5Y };
struct EpiAny { static constexpr bool PERM = true, AFTER_DRAIN = false; int kind; void* p0; void* p1; const void* p2; const void* p3; float f0;
    __device__ __forceinline__ void operator()(const f32x4 (&acc)[2][2][4][2], const Unit& u, int wr, int wc, int fr, int fq) const {
        asm volatile("" : "+v"(fr), "+v"(fq));
        switch (kind) {
        case EK_SWIGLU: { EpiSwiglu e{(bf16_t*)p0}; e(acc, u, wr, wc, fr, fq); break; }
        case EK_RESID: { EpiResid e{(const float*)p0, (float*)p1, (const float*)p2, f0, 0}; e(acc, u, wr, wc, fr, fq); break; }
        case EK_RESIDS: { EpiResidS e{(float*)p0, (const float*)p2, f0, 0}; e(acc, u, wr, wc, fr, fq); break; }
        case EK_INPROJ: { EpiInproj e{(bf16_t*)p0, (float*)p1, (bf16_t*)p2}; e(acc, u, wr, wc, fr, fq); break; }
        case EK_GLU: { EpiGlu e{(const bf16_t*)p0, (bf16_t*)p1, (const float*)p2}; e(acc, u, wr, wc, fr, fq); break; }
        case EK_RK: { EpiRk e{(bf16_t*)p0, (size_t)16640 * 1024, (bf16_t*)p1}; e(acc, u, wr, wc, fr, fq); break; }
        case EK_LORA2: { EpiLora2 e{(bf16_t*)p0, (bf16_t*)p1, (bf16_t*)p2, (const float*)p3}; e(acc, u, wr, wc, fr, fq); break; }
        case EK_HLOC: { EpiHloc e{(float*)p0}; e(acc, u, wr, wc, fr, fq); break; }
        default: { EpiS5Y e{(bf16_t*)p0}; e(acc, u, wr, wc, fr, fq); break; }
        }
    } };
struct AnyOrder { StaticOrder so; SplitOrder sp; int split;
    __device__ __forceinline__ bool next(int i, Unit& u) const { return split ? sp.next(i, u) : so.next(i, u); }
    __device__ __forceinline__ void a_ready(const Unit&) const {}
    __device__ __forceinline__ void done(const Unit&) const {} };
template <class Epi, class Sched, bool ALIGN_EPI = false, bool SP2 = false>
__device__ __forceinline__ void gemm_phase(PG8_LAS unsigned char* lds, const GemmX g, const Sched& S, const Epi& E) {
    int tid_ = threadIdx.x; asm volatile("" : "+v"(tid_));
    const int tid = tid_, wid = __builtin_amdgcn_readfirstlane(tid >> 6), lane = tid & 63, wr = wid >> 2, wc = wid & 3, fr = lane & 15, fq = lane >> 4;
    int K_ = g.K; asm volatile("" : "+s"(K_));
    const int K = K_, nt = K / BK;
    int lda_ = g.lda, ldb_ = g.ldb; asm volatile("" : "+s"(lda_), "+s"(ldb_)); const int lda = lda_, ldb = ldb_, gsh = g.gsh, nNb = g.N / BM;
    unsigned voffA[2], voffB[2];
#pragma unroll
    for (int i = 0; i < 2; ++i) { int R, C; stage_rc(tid * 16 + i * 8192, R, C); const int Rb = Epi::PERM ? ((R & ~31) + perm32(R & 31)) : R;
        voffA[i] = (unsigned)(R * lda + C) * 2u; voffB[i] = (unsigned)(Rb * ldb + C) * 2u; }
    const size_t kstep = (size_t)(BK * 2);
    const size_t hstepA = (size_t)HALF * lda * 2, hstepB = (size_t)HALF * ldb * 2;
    const size_t tstepA = 2 * hstepA, tstepB = 2 * hstepB;
#define PG8_BTILE(u_) ((size_t)(gsh >= 0 ? ((u_).pm >> gsh) * nNb + (u_).pn : (u_).pn))
    const unsigned ldsw = (unsigned)wid * 1024u;
    const int aoff = lds_byte(wr * 64 + fr, fq * 8), boff = lds_byte(wc * 32 + fr, fq * 8);
#define PG8_SA(b, h) (((b) * 2 + (h)) * HTB)
#define PG8_SB(b, h) ((4 + (b) * 2 + (h)) * HTB)
#define PG8_STAGE(bufoff, gbase, voff) do { _Pragma("unroll") for (int _i = 0; _i < 2; ++_i) \
        __builtin_amdgcn_global_load_lds((const unsigned*)((const char*)(gbase) + (voff)[_i]), (PG8_LAS unsigned*)(lds + (bufoff) + ldsw + _i * 8192), 16, 0, 0); } while (0)
#define PG8_LDA(dst, b, h) do { _Pragma("unroll") for (int m = 0; m < 4; ++m) _Pragma("unroll") for (int k = 0; k < 2; ++k) dst[m][k] = *(const PG8_LAS bf16x8*)(lds + PG8_SA(b, h) + aoff + m * 2048 + k * 1024); } while (0)
#define PG8_LDB(dst, b, h) do { _Pragma("unroll") for (int n = 0; n < 2; ++n) _Pragma("unroll") for (int k = 0; k < 2; ++k) dst[n][k] = *(const PG8_LAS bf16x8*)(lds + PG8_SB(b, h) + boff + n * 2048 + k * 1024); } while (0)
#define PG8_MMA(ai, bj, At, Bt) do { __builtin_amdgcn_s_setprio(1); _Pragma("unroll") for (int m = 0; m < 4; ++m) _Pragma("unroll") for (int n = 0; n < 2; ++n) _Pragma("unroll") for (int k = 0; k < 2; ++k) \
        acc[ai][bj][m][n] = __builtin_amdgcn_mfma_f32_16x16x32_bf16(Bt[n][k], At[m][k], acc[ai][bj][m][n], 0, 0, 0); __builtin_amdgcn_s_setprio(0); } while (0)
#define PG8_WAIT_V(n) asm volatile("s_waitcnt vmcnt(" #n ")" ::: "memory")
#define PG8_WAIT_L(n) asm volatile("s_waitcnt lgkmcnt(" #n ")" ::: "memory")
#define PG8_BAR __builtin_amdgcn_s_barrier()
#define PG8_SCHED __builtin_amdgcn_sched_barrier(0)
    Unit cur, nxt; int ui = 0;
    if (!S.next(0, cur)) return;
    f32x4 acc[2][2][4][2];
#pragma unroll
    for (int a = 0; a < 2; ++a)
#pragma unroll
        for (int b = 0; b < 2; ++b)
#pragma unroll
            for (int m = 0; m < 4; ++m)
#pragma unroll
                for (int n = 0; n < 2; ++n) acc[a][b][m][n] = (f32x4){0.f, 0.f, 0.f, 0.f};
    bf16x8 At[4][2], B0[2][2], B1[2][2];
    const char* cA = (const char*)g.A + (size_t)cur.pm * tstepA + (size_t)cur.ko * 2; const char* cB = (const char*)g.Bt + PG8_BTILE(cur) * tstepB + (size_t)cur.ko * 2;
    S.a_ready(cur);
    if constexpr (SP2) {
        PG8_STAGE(PG8_SB(0, 0), cB, voffB); PG8_STAGE(PG8_SB(0, 1), cB + hstepB, voffB); PG8_STAGE(PG8_SA(0, 0), cA, voffA); PG8_STAGE(PG8_SA(0, 1), cA + hstepA, voffA);
        if (wr == 1) PG8_BAR;
        PG8_WAIT_V(2); PG8_BAR;
        PG8_STAGE(PG8_SB(1, 0), cB + kstep, voffB); PG8_STAGE(PG8_SA(1, 0), cA + kstep, voffA); PG8_STAGE(PG8_SB(1, 1), cB + hstepB + kstep, voffB);
        PG8_WAIT_V(6); PG8_BAR;
    } else {
        PG8_STAGE(PG8_SB(0, 0), cB, voffB); PG8_STAGE(PG8_SA(0, 0), cA, voffA); PG8_STAGE(PG8_SB(0, 1), cB + hstepB, voffB); PG8_STAGE(PG8_SA(0, 1), cA + hstepA, voffA);
        if (wr == 1) PG8_BAR;
        PG8_WAIT_V(4); PG8_BAR;
        PG8_STAGE(PG8_SB(1, 0), cB + kstep, voffB); PG8_STAGE(PG8_SA(1, 0), cA + kstep, voffA); PG8_STAGE(PG8_SB(1, 1), cB + hstepB + kstep, voffB);
        PG8_WAIT_V(6); PG8_BAR;
    }
    for (;;) {
        const bool has_next = S.next(ui + 1, nxt);
        const char* nA = has_next ? (const char*)g.A + (size_t)nxt.pm * tstepA + (size_t)nxt.ko * 2 : cA; const char* nB = has_next ? (const char*)g.Bt + PG8_BTILE(nxt) * tstepB + (size_t)nxt.ko * 2 : cB;
        for (int t = 0; t < nt; t += 2) {
            const bool last = (t == nt - 2);
            const char* a1 = cA + (size_t)(t + 1) * kstep;
            const char* a2 = last ? nA : cA + (size_t)(t + 2) * kstep; const char* b2 = last ? nB : cB + (size_t)(t + 2) * kstep;
            const char* a3 = a2 + kstep; const char* b3 = b2 + kstep;
            if (last && has_next) S.a_ready(nxt);
            if constexpr (SP2) {
            PG8_LDB(B0, 0, 0); PG8_LDB(B1, 0, 1); PG8_SCHED; PG8_LDA(At, 0, 0); PG8_STAGE(PG8_SA(1, 1), a1 + hstepA, voffA);
            PG8_WAIT_V(8); PG8_WAIT_L(0); PG8_BAR; PG8_MMA(0, 0, At, B0); PG8_MMA(0, 1, At, B1); PG8_BAR; PG8_SCHED;
            PG8_LDA(At, 0, 1); PG8_STAGE(PG8_SB(0, 0), b2, voffB); PG8_STAGE(PG8_SB(0, 1), b2 + hstepB, voffB); PG8_STAGE(PG8_SA(0, 0), a2, voffA);
            PG8_WAIT_V(8); PG8_WAIT_L(0); PG8_BAR; PG8_MMA(1, 0, At, B0); PG8_MMA(1, 1, At, B1); PG8_BAR; PG8_SCHED;
            PG8_LDB(B0, 1, 0); PG8_LDB(B1, 1, 1); PG8_SCHED; PG8_LDA(At, 1, 0); PG8_STAGE(PG8_SA(0, 1), a2 + hstepA, voffA);
            PG8_WAIT_V(8); PG8_WAIT_L(0); PG8_BAR; PG8_MMA(0, 0, At, B0); PG8_MMA(0, 1, At, B1); PG8_BAR; PG8_SCHED;
            PG8_LDA(At, 1, 1); PG8_STAGE(PG8_SB(1, 0), b3, voffB); PG8_STAGE(PG8_SB(1, 1), b3 + hstepB, voffB); PG8_STAGE(PG8_SA(1, 0), a3, voffA);
            PG8_WAIT_V(8); PG8_WAIT_L(0); PG8_BAR; PG8_MMA(1, 0, At, B0); PG8_MMA(1, 1, At, B1); PG8_BAR; PG8_SCHED;
            } else {
            PG8_LDB(B0, 0, 0); PG8_SCHED; PG8_LDA(At, 0, 0); PG8_STAGE(PG8_SA(1, 1), a1 + hstepA, voffA);
            PG8_WAIT_L(8); PG8_BAR; PG8_WAIT_L(0); PG8_MMA(0, 0, At, B0); PG8_BAR; PG8_SCHED;
            PG8_LDB(B1, 0, 1); PG8_STAGE(PG8_SB(0, 0), b2, voffB);
            PG8_BAR; PG8_WAIT_L(0); PG8_MMA(0, 1, At, B1); PG8_BAR;
            PG8_LDA(At, 0, 1); PG8_STAGE(PG8_SA(0, 0), a2, voffA);
            PG8_BAR; PG8_WAIT_L(0); PG8_MMA(1, 0, At, B0); PG8_BAR; PG8_SCHED;
            PG8_STAGE(PG8_SB(0, 1), b2 + hstepB, voffB);
            PG8_WAIT_V(6); PG8_BAR; PG8_MMA(1, 1, At, B1); PG8_BAR;
            PG8_LDB(B0, 1, 0); PG8_SCHED; PG8_LDA(At, 1, 0); PG8_STAGE(PG8_SA(0, 1), a2 + hstepA, voffA);
            PG8_WAIT_L(8); PG8_BAR; PG8_WAIT_L(0); PG8_MMA(0, 0, At, B0); PG8_BAR; PG8_SCHED;
            PG8_LDB(B1, 1, 1); PG8_STAGE(PG8_SB(1, 0), b3, voffB);
            PG8_BAR; PG8_WAIT_L(0); PG8_MMA(0, 1, At, B1); PG8_BAR;
            PG8_LDA(At, 1, 1); PG8_STAGE(PG8_SA(1, 0), a3, voffA);
            PG8_BAR; PG8_WAIT_L(0); PG8_MMA(1, 0, At, B0); PG8_BAR; PG8_SCHED;
            PG8_STAGE(PG8_SB(1, 1), b3 + hstepB, voffB);
            PG8_WAIT_V(6); PG8_BAR; PG8_MMA(1, 1, At, B1); PG8_BAR;
            }
        }
        if constexpr (ALIGN_EPI) { if (wr == 0) PG8_BAR; }
        if constexpr (!Epi::AFTER_DRAIN) { E(acc, cur, wr, wc, fr, fq); S.done(cur); }
        if (!has_next) break;
#pragma unroll
        for (int a = 0; a < 2; ++a)
#pragma unroll
            for (int b = 0; b < 2; ++b)
#pragma unroll
                for (int m = 0; m < 4; ++m)
#pragma unroll
                    for (int n = 0; n < 2; ++n) acc[a][b][m][n] = (f32x4){0.f, 0.f, 0.f, 0.f};
        cur = nxt; cA = nA; cB = nB; ++ui;
        if constexpr (ALIGN_EPI) { if (wr == 1) PG8_BAR; }
    }
    PG8_WAIT_V(0);
    if constexpr (!ALIGN_EPI) { if (wr == 0) PG8_BAR; }
    PG8_BAR;
    if constexpr (Epi::AFTER_DRAIN) { E.fused(acc, cur, wr, wc, fr, fq, lds, wid, lane); S.done(cur); }
#undef PG8_BTILE
#undef PG8_SA
#undef PG8_SB
#undef PG8_STAGE
#undef PG8_LDA
#undef PG8_LDB
#undef PG8_MMA
#undef PG8_WAIT_V
#undef PG8_WAIT_L
#undef PG8_BAR
#undef PG8_SCHED
}
}

constexpr int NWAVES = 8;
constexpr int RING_OFF = 0, RING_BYTES = 131072;
constexpr int LDSCTL_OFF = RING_BYTES, MISC_OFF = LDSCTL_OFF + 320;
constexpr int LDS_BYTES = 147456;

struct Args { const float* in[52]; float* out; unsigned char* ws; };
static_assert(sizeof(Args) == 432, "kernarg layout");

struct Frame {
    LAS unsigned char* lds; int tid, lane, wave, G, blk;
    const float* const* in; float* out; unsigned char* ws;
};
#define INP(i) INPD(i)
#define KARG() ({ const unsigned char __attribute__((address_space(4)))* k_ = (const unsigned char __attribute__((address_space(4)))*)__builtin_amdgcn_kernarg_segment_ptr(); asm volatile("" : "+s"(k_)); k_; })
#define INPD(i) (*(const float* const __attribute__((address_space(4)))*)(KARG() + 8 * (i)))

template <class Src>
DEVI void cvt_item(const Src src, bf16* WT, int Kd, int nblk, LAS float* scr, int item, int lane) {
    const int kb = item / nblk, nb = item % nblk, k0 = 64 * kb, n0 = 32 * nb;
    const int kr = lane >> 3, nq = (lane & 7) * 4;
    f32x4 v[8];
#pragma unroll
    for (int i = 0; i < 8; ++i) v[i] = src.load4(k0 + 8 * i + kr, n0 + nq);
#pragma unroll
    for (int i = 0; i < 8; ++i) { LAS float* s = scr + (8 * i + kr) * 33 + nq; s[0] = v[i][0]; s[1] = v[i][1]; s[2] = v[i][2]; s[3] = v[i][3]; }
    LDS_WAIT(); asm volatile("" ::: "memory");
    const int c = lane & 7;
#pragma unroll
    for (int j = 0; j < 4; ++j) { const int n = (lane >> 3) + 8 * j; const LAS float* s = scr + (8 * c) * 33 + n;
        v4u o; o.x = pk2(s[0 * 33], s[1 * 33]); o.y = pk2(s[2 * 33], s[3 * 33]); o.z = pk2(s[4 * 33], s[5 * 33]); o.w = pk2(s[6 * 33], s[7 * 33]);
        *(GAS v4u*)(WT + (size_t)(n0 + n) * Kd + k0 + 8 * c) = o; }
    LDS_WAIT(); asm volatile("" ::: "memory");
}
struct SrcPlain { const float* W; int K, N, ld; DEVI f32x4 load4(int k, int n) const { return (k < K && n < N) ? *(const f32x4*)(W + (size_t)k * ld + n) : (f32x4){0.f, 0.f, 0.f, 0.f}; } };
struct SrcFold { const float* W; const float* mu; int ld; DEVI f32x4 load4(int k, int n) const { const int kk = k & 1023; const float m = mu[kk]; return *(const f32x4*)(W + (size_t)kk * ld + n) * (k < 1024 ? m : (1.0f - m)); } };
struct SrcBlk { const float* W; int k0, k1; DEVI f32x4 load4(int k, int n) const { return (k >= k0 && k < k1) ? *(const f32x4*)(W + (size_t)(k - k0) * 1024 + n) : (f32x4){0.f, 0.f, 0.f, 0.f}; } };
struct SrcZero { DEVI f32x4 load4(int, int) const { return (f32x4){0.f, 0.f, 0.f, 0.f}; } };

DEVI void sincos_d(double x, double& s, double& c) {
    const double n = rint(x * 0.63661977236758134308);
    double r = fma(-n, 1.57079632679489655800e+00, x); r = fma(-n, 6.12323399573676603587e-17, r);
    const double r2 = r * r;
    double sp = -7.6471637318198164759e-13; sp = fma(sp, r2, 1.6059043836821614599e-10); sp = fma(sp, r2, -2.5052108385441718775e-08); sp = fma(sp, r2, 2.7557319223985890653e-06);
    sp = fma(sp, r2, -1.9841269841269841270e-04); sp = fma(sp, r2, 8.3333333333333333333e-03); sp = fma(sp, r2, -1.6666666666666666667e-01); const double sr = fma(sp * r2, r, r);
    double cp = 4.7794773323873852974e-14; cp = fma(cp, r2, -1.1470745597729724714e-11); cp = fma(cp, r2, 2.0876756987868098979e-09); cp = fma(cp, r2, -2.7557319223985890653e-07);
    cp = fma(cp, r2, 2.4801587301587301587e-05); cp = fma(cp, r2, -1.3888888888888888889e-03); cp = fma(cp, r2, 4.1666666666666666667e-02); cp = fma(cp, r2, -0.5); const double cr = fma(cp, r2, 1.0);
    const int q = ((int)n) & 3;
    s = (q == 0) ? sr : (q == 1) ? cr : (q == 2) ? -sr : -cr;
    c = (q == 0) ? cr : (q == 1) ? -sr : (q == 2) ? -cr : sr;
}
DEVI void s5prep_one(int i, const float* a_re, const float* a_im, const float* log_step, const float* b_re, const float* b_im, float* sp) {
    const int g = i >> 6;
    const double dt = exp((double)log_step[g]), ar = a_re[i], ai = a_im[i];
    const double mag = exp(ar * dt); double s, c; sincos_d(ai * dt, s, c);
    const double abr = mag * c, abi = mag * s, den = ar * ar + ai * ai, nr = abr - 1.0;
    const double zr = (nr * ar + abi * ai) / den, zi = (abi * ar - nr * ai) / den;
    sp[i] = (float)abr; sp[2048 + i] = (float)abi;
    for (int cc = 0; cc < 16; ++cc) { const double br = b_re[i * 16 + cc], bi = b_im[i * 16 + cc];
        sp[4096 + i * 16 + cc] = (float)(zr * br - zi * bi); sp[4096 + 32768 + i * 16 + cc] = (float)(zr * bi + zi * br); }
}


constexpr int SP_PW = 4096 + 65536;
DEVI void s5prep_pw(int i, int tau, const float* a_re, const float* a_im, const float* log_step, float* sp) {
    const int g = i >> 6; const double dt = exp((double)log_step[g]), ar = a_re[i], ai = a_im[i];
    const double mag = exp(ar * dt * tau); double s, c; sincos_d(ai * dt * tau, s, c); sp[SP_PW + i * 34 + tau * 2] = (float)(mag * c); sp[SP_PW + i * 34 + tau * 2 + 1] = (float)(mag * s);
}
DEVI void s5_tm_job(int g, int tau, int lane, const float* sp, const float* c_re, const float* c_im, const float* dd, bf16* TM) {
    bf16* tm = TM + (size_t)g * 256 * 384;
    if (tau <= 15) {
        const int co = lane >> 2, ci0 = (lane & 3) * 4; float kv[4] = {0.f, 0.f, 0.f, 0.f};
#pragma unroll 8
        for (int p = 0; p < 64; ++p) { const float pr = sp[SP_PW + (g * 64 + p) * 34 + tau * 2], pi = sp[SP_PW + (g * 64 + p) * 34 + tau * 2 + 1];
            const float cr = c_re[(g * 16 + co) * 64 + p], ci = c_im[(g * 16 + co) * 64 + p];
            const f32x4 br = *(const f32x4*)(sp + 4096 + (g * 64 + p) * 16 + ci0), bi = *(const f32x4*)(sp + 4096 + 32768 + (g * 64 + p) * 16 + ci0);
#pragma unroll
            for (int q = 0; q < 4; ++q) { const float wr = pr * br[q] - pi * bi[q], wi = pr * bi[q] + pi * br[q]; kv[q] += cr * wr - ci * wi; } }
        if (tau == 0) {
#pragma unroll
            for (int q = 0; q < 4; ++q) if (ci0 + q == co) kv[q] += dd[g * 16 + co]; }
        const unsigned long long pk = (unsigned long long)pk2(kv[0], kv[1]) | ((unsigned long long)pk2(kv[2], kv[3]) << 32);
        for (int t = tau; t < 16; ++t) *(unsigned long long*)(tm + (size_t)(t * 16 + co) * 384 + (t - tau) * 16 + ci0) = pk;
        if (tau >= 1) for (int t = 0; t + tau < 16; ++t) *(unsigned long long*)(tm + (size_t)(t * 16 + co) * 384 + (t + tau) * 16 + ci0) = 0ull;
    }
    if (tau >= 1) { const int t = tau - 1, p = lane; const float pr = sp[SP_PW + (g * 64 + p) * 34 + tau * 2], pi = sp[SP_PW + (g * 64 + p) * 34 + tau * 2 + 1];
#pragma unroll
        for (int co = 0; co < 16; ++co) { const float cr = c_re[(g * 16 + co) * 64 + p], ci = c_im[(g * 16 + co) * 64 + p];
            tm[(size_t)(t * 16 + co) * 384 + 256 + p] = (bf16)f2bf(cr * pr - ci * pi); tm[(size_t)(t * 16 + co) * 384 + 320 + p] = (bf16)f2bf(-(cr * pi + ci * pr)); } }
}
DEVI void s5_hm_job(int g, int s, int lane, const float* sp, bf16* HM) {
    const int p = lane; const float pr = sp[SP_PW + (g * 64 + p) * 34 + (15 - s) * 2], pi = sp[SP_PW + (g * 64 + p) * 34 + (15 - s) * 2 + 1];
    bf16* hr = HM + ((size_t)g * 256 + p) * 256 + s * 16; bf16* hi = hr + 64 * 256;
#pragma unroll
    for (int h8 = 0; h8 < 2; ++h8) { float wr[8], wi[8];
#pragma unroll
        for (int q = 0; q < 8; ++q) { const float br = sp[4096 + (g * 64 + p) * 16 + h8 * 8 + q], bi = sp[4096 + 32768 + (g * 64 + p) * 16 + h8 * 8 + q]; wr[q] = pr * br - pi * bi; wi[q] = pr * bi + pi * br; }
        v4u a, b; a.x = pk2(wr[0], wr[1]); a.y = pk2(wr[2], wr[3]); a.z = pk2(wr[4], wr[5]); a.w = pk2(wr[6], wr[7]); b.x = pk2(wi[0], wi[1]); b.y = pk2(wi[2], wi[3]); b.z = pk2(wi[4], wi[5]); b.w = pk2(wi[6], wi[7]);
        *(v4u*)(hr + h8 * 8) = a; *(v4u*)(hi + h8 * 8) = b; }
}
DEVI void s5_carry_job(int b, int g, int lane, const float* sp, const float* HL, bf16* UB, float* ore, float* oim) {
    const int p = lane; const float ar = sp[SP_PW + (g * 64 + p) * 34 + 32], ai = sp[SP_PW + (g * 64 + p) * 34 + 33];
    float cr = 0.f, ci = 0.f;
#pragma unroll 8
    for (int n = 0; n < 128; ++n) { const size_t row = (size_t)g * 1024 + b * 128 + n;
        UB[row * 384 + 256 + p] = (bf16)f2bf(cr); UB[row * 384 + 320 + p] = (bf16)f2bf(ci);
        const float hr = HL[row * 128 + p], hi = HL[row * 128 + 64 + p];
        const float nr = ar * cr - ai * ci + hr, ni = ar * ci + ai * cr + hi; cr = nr; ci = ni; }
    ore[((size_t)b * 32 + g) * 64 + p] = cr; oim[((size_t)b * 32 + g) * 64 + p] = ci;
}


template <int NT> DEVI void mods_half(int m0, int l, int n0, int lane, const float* __restrict__ ST, const float* __restrict__ ada_w, const float* __restrict__ ada_b, float* MODS) {
    const int i16 = lane & 15, kq = lane >> 4;
    f32x4 acc[NT];
#pragma unroll
    for (int m = 0; m < NT; ++m) acc[m] = (f32x4){0.f, 0.f, 0.f, 0.f};
    const float* w = ada_w + (size_t)l * 1024 * 9216 + (size_t)kq * 9216 + n0 + i16; const float* st = ST + kq * 144 + i16 + m0 * 16;
    float a[4][NT], bv[4];
#pragma unroll
    for (int s = 0; s < 4; ++s) { bv[s] = w[(size_t)(4 * s) * 9216];
#pragma unroll
        for (int m = 0; m < NT; ++m) a[s][m] = st[(4 * s) * 144 + m * 16]; }
    for (int k0 = 0; k0 < 1024; k0 += 16) {
#pragma unroll
        for (int s = 0; s < 4; ++s) {
#pragma unroll
            for (int m = 0; m < NT; ++m) acc[m] = __builtin_amdgcn_mfma_f32_16x16x4f32(a[s][m], bv[s], acc[m], 0, 0, 0);
            const int kn = k0 + 16 + 4 * s; if (kn < 1024) { bv[s] = w[(size_t)kn * 9216];
#pragma unroll
                for (int m = 0; m < NT; ++m) a[s][m] = st[kn * 144 + m * 16]; } } }
    const float bb = ada_b[l * 9216 + n0 + i16];
#pragma unroll
    for (int m = 0; m < NT; ++m)
#pragma unroll
        for (int q = 0; q < 4; ++q) { const int r = (m0 + m) * 16 + kq * 4 + q; if (r < NMODROW) MODS[((size_t)l * NMODROW + r) * 9216 + n0 + i16] = acc[m][q] + bb; }
}
DEVI void mods_job(int job, int lane, const float* __restrict__ ST, const float* __restrict__ ada_w, const float* __restrict__ ada_b, float* MODS) {
    asm volatile("" : "+v"(lane));
    const int mh = job & 1, jb = job >> 1, l = jb / 576, n0 = (jb % 576) * 16;
    if (mh) mods_half<4>(5, l, n0, lane, ST, ada_w, ada_b, MODS); else mods_half<5>(0, l, n0, lane, ST, ada_w, ada_b, MODS);
}

DEVI void init_row(int row, int lane, const float* xp, const float* xs, const float* mods, float* X, bf16* H, float* ZS) {
    if (row >= MT) { for (int j = 0; j < 16; ++j) H[(size_t)row * D + j * 64 + lane] = 0; return; }
    const float* src = row < NP ? xp + (size_t)row * D : xs + (size_t)(row - NP) * D;
    const float* sh = modp(mods, 0, 0) + (size_t)mrow(row) * 9216; const float* sc = modp(mods, 0, 1) + (size_t)mrow(row) * 9216;
#pragma unroll
    for (int j = 0; j < 4; ++j) { const int c = j * 256 + lane * 4; const f32x4 v = *(const f32x4*)(src + c), a = *(const f32x4*)(sc + c), b = *(const f32x4*)(sh + c);
        *(f32x4*)(X + (size_t)row * D + c) = v; if (row >= NP) *(f32x4*)(ZS + (size_t)(row - NP) * D + c) = v * ALPHA; const f32x4 h = v * (a + 1.0f) + b;
        *(unsigned long long*)(H + (size_t)row * D + c) = (unsigned long long)pk2(h[0], h[1]) | ((unsigned long long)pk2(h[2], h[3]) << 32); }
}
DEVI void ln_row(int row, int lane, const float* Z, float* ZS, const float* SL, int nsl, const float* g, const float* b, float* X, bf16* H, const float* sh, const float* sc) {
    const float* z = row < NP ? Z + (size_t)row * D : ZS + (size_t)(row - NP) * D; f32x4 v[4]; float s = 0.f;
#pragma unroll
    for (int j = 0; j < 4; ++j) v[j] = *(const f32x4*)(z + j * 256 + lane * 4);
    if (row >= NP) for (int q = 0; q < nsl; ++q) {
#pragma unroll
        for (int j = 0; j < 4; ++j) v[j] = v[j] + *(const f32x4*)(SL + ((size_t)q * 128 + (row - NP)) * D + j * 256 + lane * 4); }
#pragma unroll
    for (int j = 0; j < 4; ++j) s += (v[j][0] + v[j][1]) + (v[j][2] + v[j][3]);
    const float mean = wave_sum(s) * (1.f / D); float q = 0.f;
#pragma unroll
    for (int j = 0; j < 4; ++j) { v[j] = v[j] - mean; q += (v[j][0] * v[j][0] + v[j][1] * v[j][1]) + (v[j][2] * v[j][2] + v[j][3] * v[j][3]); }
    const float rstd = rsqrtf(wave_sum(q) * (1.f / D) + 1e-5f);
    const int mr = mrow(row);
#pragma unroll
    for (int j = 0; j < 4; ++j) { const int c = j * 256 + lane * 4; const f32x4 x = v[j] * rstd * *(const f32x4*)(g + c) + *(const f32x4*)(b + c); *(f32x4*)(X + (size_t)row * D + c) = x; if (row >= NP) *(f32x4*)(ZS + (size_t)(row - NP) * D + c) = x * ALPHA;
        if (H) { const f32x4 h = x * (*(const f32x4*)(sc + (size_t)mr * 9216 + c) + 1.0f) + *(const f32x4*)(sh + (size_t)mr * 9216 + c);
            *(unsigned long long*)(H + (size_t)row * D + c) = (unsigned long long)pk2(h[0], h[1]) | ((unsigned long long)pk2(h[2], h[3]) << 32); } }
}
DEVI void ln_shift_rows(int row0, int n, int lane, const float* Z, float* ZS, const float* g, const float* b, float* X, const float* mods, const float* shift_in, bf16* A2, float* out) {
    f32x4 prev[4], gg[4], bb[4];
#pragma unroll
    for (int j = 0; j < 4; ++j) { gg[j] = *(const f32x4*)(g + j * 256 + lane * 4); bb[j] = *(const f32x4*)(b + j * 256 + lane * 4); prev[j] = (f32x4){0.f, 0.f, 0.f, 0.f}; }
    for (int r = ((row0 < NP && (row0 & 2047) != 0) ? row0 - 1 : row0); r < row0 + n; ++r) {
        const bool warm = r < row0;
        const float* z = r < NP ? Z + (size_t)r * D : ZS + (size_t)(r - NP) * D; f32x4 v[4]; float s = 0.f;
#pragma unroll
        for (int j = 0; j < 4; ++j) { v[j] = *(const f32x4*)(z + j * 256 + lane * 4); s += (v[j][0] + v[j][1]) + (v[j][2] + v[j][3]); }
        const float mean = wave_sum(s) * (1.f / D); float q = 0.f;
#pragma unroll
        for (int j = 0; j < 4; ++j) { v[j] = v[j] - mean; q += (v[j][0] * v[j][0] + v[j][1] * v[j][1]) + (v[j][2] * v[j][2] + v[j][3] * v[j][3]); }
        const float rstd = rsqrtf(wave_sum(q) * (1.f / D) + 1e-5f);
        const int mr = mrow(r); const float* sh = modp(mods, 1, 3) + (size_t)mr * 9216; const float* sc = modp(mods, 1, 4) + (size_t)mr * 9216;
        const bool prompt = r < NP; const int t = r & 2047;
#pragma unroll
        for (int j = 0; j < 4; ++j) { const int c = j * 256 + lane * 4; const f32x4 x = v[j] * rstd * gg[j] + bb[j]; const f32x4 h = x * (*(const f32x4*)(sc + c) + 1.0f) + *(const f32x4*)(sh + c);
            if (!warm) { *(f32x4*)(X + (size_t)r * D + c) = x; if (r >= NP) *(f32x4*)(ZS + (size_t)(r - NP) * D + c) = x * ALPHA;
                f32x4 pv = prev[j]; if (!prompt) pv = *(const f32x4*)(shift_in + (size_t)(r - NP) * D + c); else if (t == 0) pv = (f32x4){0.f, 0.f, 0.f, 0.f};
                *(unsigned long long*)(A2 + (size_t)r * KRK + c) = (unsigned long long)pk2(pv[0], pv[1]) | ((unsigned long long)pk2(pv[2], pv[3]) << 32);
                *(unsigned long long*)(A2 + (size_t)r * KRK + 1024 + c) = (unsigned long long)pk2(h[0], h[1]) | ((unsigned long long)pk2(h[2], h[3]) << 32);
                if (prompt) { if (t == 2047) *(f32x4*)(out + O_SHIFT_P + (size_t)(r >> 11) * D + c) = h; } else *(f32x4*)(out + O_SHIFT_S + (size_t)(r - NP) * D + c) = h; }
            prev[j] = h; }
    }
}
DEVI void shiftcat_row(int row, int lane, const float* X, const float* mods, const float* shift_in, bf16* A2, float* out) {
    if (row >= MT) { for (int j = 0; j < 8; ++j) *(unsigned long long*)(A2 + (size_t)row * KRK + j * 256 + lane * 4) = 0ull; return; }
    const int mr = mrow(row); const float* sh = modp(mods, 1, 3) + (size_t)mr * 9216; const float* sc = modp(mods, 1, 4) + (size_t)mr * 9216;
    const bool prompt = row < NP; const int t = row & 2047;
#pragma unroll
    for (int j = 0; j < 4; ++j) { const int c = j * 256 + lane * 4; const f32x4 a = *(const f32x4*)(sc + c) + 1.0f, b = *(const f32x4*)(sh + c);
        const f32x4 h = *(const f32x4*)(X + (size_t)row * D + c) * a + b; f32x4 pv;
        if (prompt) pv = t == 0 ? (f32x4){0.f, 0.f, 0.f, 0.f} : *(const f32x4*)(X + (size_t)(row - 1) * D + c) * a + b; else pv = *(const f32x4*)(shift_in + (size_t)(row - NP) * D + c);
        *(unsigned long long*)(A2 + (size_t)row * KRK + c) = (unsigned long long)pk2(pv[0], pv[1]) | ((unsigned long long)pk2(pv[2], pv[3]) << 32);
        *(unsigned long long*)(A2 + (size_t)row * KRK + 1024 + c) = (unsigned long long)pk2(h[0], h[1]) | ((unsigned long long)pk2(h[2], h[3]) << 32);
        if (prompt) { if (t == 2047) *(f32x4*)(out + O_SHIFT_P + (size_t)(row >> 11) * D + c) = h; } else *(f32x4*)(out + O_SHIFT_S + (size_t)(row - NP) * D + c) = h; }
}
DEVI void gla_post_one(int w, int lane, const float* OG, const bf16* P, const float* norm_g, bf16* O) {
    const int tok = w >> 2, h = w & 3;
    const float o0 = OG[(size_t)tok * 512 + h * 128 + lane], o1 = OG[(size_t)tok * 512 + h * 128 + 64 + lane];
    const float ms = wave_sum(o0 * o0 + o1 * o1) * (1.f / 128.f), r = rsqrtf(ms + 1e-5f);
    const float g0 = bf2f(P[(size_t)tok * NINP + 1024 + h * 128 + lane]), g1 = bf2f(P[(size_t)tok * NINP + 1024 + h * 128 + 64 + lane]);
    O[(size_t)tok * D + h * 128 + lane] = (bf16)f2bf(o0 * r * norm_g[lane] * siluf_(g0));
    O[(size_t)tok * D + h * 128 + 64 + lane] = (bf16)f2bf(o1 * r * norm_g[64 + lane] * siluf_(g1));
}

DEVI void gla_job(LAS float* scr, int lane, int b, int h, int half, const bf16* P, const float* GKL, const float* w_gk, const float* b_gk, int tok_base, int T, const float* s0, float* s_out, float* OG) {
    LAS float* sdec = scr; LAS float* sq = scr + 1024; LAS float* sk = scr + 2048;
    const int dv = half * 64 + lane;
    float S[64];
#pragma unroll
    for (int i = 0; i < 64; ++i) S[i] = s0 ? s0[(((size_t)b * 4 + h) * 64 + i) * 128 + dv] : 0.f;
    float wg[16];
#pragma unroll
    for (int r = 0; r < 16; ++r) wg[r] = w_gk[r * 256 + h * 64 + lane];
    const float bg = b_gk[h * 64 + lane];
    for (int t0 = 0; t0 < T; t0 += 16) { const int nt = (T - t0) < 16 ? (T - t0) : 16;
        for (int tt = 0; tt < nt; ++tt) { const size_t tok = (size_t)tok_base + (size_t)b * T + t0 + tt; float x = bg;
#pragma unroll
            for (int r = 0; r < 16; ++r) x += GKL[tok * 16 + r] * wg[r];
            const float ls = fminf(x, 0.f) - log1pf(__expf(-fabsf(x)));
            sdec[tt * 64 + lane] = __expf(ls * (1.f / 16.f)); sq[tt * 64 + lane] = bf2f(P[tok * NINP + h * 64 + lane]) * 0.125f; sk[tt * 64 + lane] = bf2f(P[tok * NINP + 256 + h * 64 + lane]); }
        LDS_WAIT(); asm volatile("" ::: "memory");
        for (int tt = 0; tt < nt; ++tt) { const size_t tok = (size_t)tok_base + (size_t)b * T + t0 + tt;
            const float v = bf2f(P[tok * NINP + 512 + h * 128 + dv]); float o = 0.f;
#pragma unroll
            for (int i = 0; i < 64; ++i) { S[i] = S[i] * sdec[tt * 64 + i] + sk[tt * 64 + i] * v; o += sq[tt * 64 + i] * S[i]; }
            OG[tok * 512 + h * 128 + dv] = o; }
        LDS_WAIT(); asm volatile("" ::: "memory");
    }
#pragma unroll
    for (int i = 0; i < 64; ++i) s_out[(((size_t)b * 4 + h) * 64 + i) * 128 + dv] = S[i];
}
DEVI void s5_job(LAS float* scr, int lane, int g, int b0, int nb, const bf16* P, const float* sp, const float* c_re, const float* c_im, const float* dd, int tok_base, int T,
                 const float* h0re, const float* h0im, float* ore, float* oim, bf16* Z5) {
    const int p = lane, c = p & 15, pq = p >> 4;
    const float abr = sp[g * 64 + p], abi = sp[2048 + g * 64 + p];
    float bbr[16], bbi[16], cr[16], ci[16];
#pragma unroll
    for (int i = 0; i < 16; ++i) { bbr[i] = sp[4096 + (g * 64 + p) * 16 + i]; bbi[i] = sp[4096 + 32768 + (g * 64 + p) * 16 + i];
        cr[i] = c_re[(g * 16 + c) * 64 + pq * 16 + i]; ci[i] = c_im[(g * 16 + c) * 64 + pq * 16 + i]; }
    const float dv = dd[g * 16 + c];
    for (int b = b0; b < b0 + nb; ++b) {
        float hr = h0re ? h0re[((size_t)b * 32 + g) * 64 + p] : 0.f, hi = h0im ? h0im[((size_t)b * 32 + g) * 64 + p] : 0.f;
        for (int t = 0; t < T; ++t) { const size_t tok = (size_t)tok_base + (size_t)b * T + t;
            const bf16* up = P + tok * NINP + 1552 + g * 16; float u[16];
#pragma unroll
            for (int i = 0; i < 16; ++i) u[i] = bf2f(up[i]);
            const float uc = bf2f(up[c]);
            float br = 0.f, bi = 0.f;
#pragma unroll
            for (int i = 0; i < 16; ++i) { br += u[i] * bbr[i]; bi += u[i] * bbi[i]; }
            const float nr = abr * hr - abi * hi + br, ni = abr * hi + abi * hr + bi; hr = nr; hi = ni;
            LAS float* hs = scr + (t & 1) * 128;
            hs[p] = hr; hs[64 + p] = hi;
            LDS_WAIT(); asm volatile("" ::: "memory");
            float y = 0.f;
#pragma unroll
            for (int i = 0; i < 16; ++i) y += cr[i] * hs[pq * 16 + i] - ci[i] * hs[64 + pq * 16 + i];
            y += __shfl_xor(y, 16); y += __shfl_xor(y, 32);
            if (p < 16) { y += dv * uc; Z5[tok * 512 + g * 16 + c] = (bf16)f2bf(gelu_tanh(y)); }
        }
        ore[((size_t)b * 32 + g) * 64 + p] = hr; oim[((size_t)b * 32 + g) * 64 + p] = hi;
        LDS_WAIT(); asm volatile("" ::: "memory");
    }
}
DEVI float wkv_decay(float w0, float raw) { const float x = -(w0 + raw); const float sp = fmaxf(x, 0.f) + log1pf(__expf(-fabsf(x))); return __expf(-__expf(-sp - 0.5f)); }
DEVI void wkv_job(LAS float* scr, int lane, int b, int h, const bf16* R, const bf16* Kb, const bf16* V, const bf16* WRAW, const float* w0p, const bf16* AS, bf16* GO, const float* k_k, const float* k_a, const float* r_k, const float* lnx_g, const float* lnx_b,
                  int tok_base, int T, const float* s0, float* s_out) {
    LAS float* sw = scr; LAS float* skm = scr + 512; LAS float* sa_ = scr + 1024; LAS float* sb = scr + 1536; LAS float* sr = scr + 2048; LAS float* sbon = scr + 2560;
    const int i = lane, ch = h * 64 + i;
    float S[64];
#pragma unroll
    for (int j = 0; j < 64; ++j) S[j] = s0 ? s0[(((size_t)b * 16 + h) * 64 + i) * 64 + j] : 0.f;
    const float kkc = k_k[ch], kac = k_a[ch], rkc = r_k[ch], lg = lnx_g[ch], lb = lnx_b[ch];
    for (int t0 = 0; t0 < T; t0 += 8) { const int nt = (T - t0) < 8 ? (T - t0) : 8;
        for (int tt = 0; tt < nt; ++tt) { const size_t tok = (size_t)tok_base + (size_t)b * T + t0 + tt;
            const float k = bf2f(Kb[tok * D + ch]), r = bf2f(R[tok * D + ch]), a = bf2f(AS[tok * D + ch]), w = wkv_decay(w0p[ch], bf2f(WRAW[tok * D + ch]));
            float kk = k * kkc; const float nrm = sqrtf(wave_sum(kk * kk)); kk = kk / fmaxf(nrm, 1e-12f);
            const float km = k * (1.f + (a - 1.f) * kac);
            sw[tt * 64 + i] = w; skm[tt * 64 + i] = km; sa_[tt * 64 + i] = -kk; sb[tt * 64 + i] = kk * a; sr[tt * 64 + i] = r;
            const float bon = wave_sum(r * km * rkc); if (i == 0) sbon[tt] = bon; }
        LDS_WAIT(); asm volatile("" ::: "memory");
        for (int tt = 0; tt < nt; ++tt) { const size_t tok = (size_t)tok_base + (size_t)b * T + t0 + tt;
            const float v = bf2f(V[tok * D + ch]); float sa = 0.f;
#pragma unroll
            for (int j = 0; j < 64; ++j) sa += S[j] * sa_[tt * 64 + j];
            float y = 0.f;
#pragma unroll
            for (int j = 0; j < 64; ++j) { S[j] = S[j] * sw[tt * 64 + j] + sa * sb[tt * 64 + j] + v * skm[tt * 64 + j]; y += S[j] * sr[tt * 64 + j]; }
            const float mean = wave_sum(y) * (1.f / 64.f), dy = y - mean, var = wave_sum(dy * dy) * (1.f / 64.f);
            float yn = dy * rsqrtf(var + 64e-5f) * lg + lb; yn += sbon[tt] * v;
            const float gt = bf2f(GO[tok * D + ch]); GO[tok * D + ch] = (bf16)f2bf(yn * gt); }
        LDS_WAIT(); asm volatile("" ::: "memory");
    }
#pragma unroll
    for (int j = 0; j < 64; ++j) s_out[(((size_t)b * 16 + h) * 64 + i) * 64 + j] = S[j];
}

DEVI float dpp_add(float v, const int ctrl_sel) {
    int r;
    switch (ctrl_sel) {
    case 0: r = __builtin_amdgcn_update_dpp(0, __builtin_bit_cast(int, v), 0xB1, 0xF, 0xF, true); break;
    case 1: r = __builtin_amdgcn_update_dpp(0, __builtin_bit_cast(int, v), 0x4E, 0xF, 0xF, true); break;
    case 2: r = __builtin_amdgcn_update_dpp(0, __builtin_bit_cast(int, v), 0x141, 0xF, 0xF, true); break;
    default: r = __builtin_amdgcn_update_dpp(0, __builtin_bit_cast(int, v), 0x140, 0xF, 0xF, true); break;
    }
    return v + __builtin_bit_cast(float, r);
}
DEVI float red16(float v) { v = dpp_add(v, 0); v = dpp_add(v, 1); v = dpp_add(v, 2); v = dpp_add(v, 3); return v; }
constexpr int WK_TB = 32;
constexpr int WK_W = 0, WK_KM = 2048, WK_NA = 4096, WK_BB = 6144, WK_WR = 8192, WK_V = 10240, WK_PB = 12800;
constexpr int WK_Y = 2 * WK_PB, WK_YB = 1024;
static_assert((WK_Y + 2 * WK_YB + 512 + 1200) * 4 <= RING_BYTES, "wkv lds");
struct WkvLoad { uint2 k, r, a, v, w; };
typedef float f32x2_t __attribute__((ext_vector_type(2)));
struct WkvOps { f32x4 na, wr, w4, bb, km, vv; };
DEVI float wkv_decay_fast(float w0, float raw) { const float x = -(w0 + raw); const float sp = fmaxf(x, 0.f) + 0.69314718056f * __builtin_amdgcn_logf(1.0f + __builtin_amdgcn_exp2f(-1.44269504089f * fabsf(x)));
    const float ee = __builtin_amdgcn_exp2f(-1.44269504089f * (sp + 0.5f)); return __builtin_amdgcn_exp2f(-1.44269504089f * ee); }
template <int MODE> DEVI void wkv_half(LAS float* L, int tid, int b, int h, int half, const bf16* R, const bf16* Kb, const bf16* V, const bf16* WRAW, const bf16* AS, const float* w0p,
                   const float* k_k, const float* k_a, const float* r_k, bf16* Y, float* BON, float* s_out) {
    asm volatile("" : "+v"(tid));
    const int rp = (tid >> 4) & 15, jq = tid & 15; const bool stepper = tid < 256;
    const int ch = h * 64 + 4 * jq, chv = h * 64 + half * 32 + 4 * (jq & 7);
    f32x4 S0 = {0.f, 0.f, 0.f, 0.f}, S1 = {0.f, 0.f, 0.f, 0.f};
    const size_t tokb = (size_t)b * TP;
    auto bf4 = [](uint2 u) -> f32x4 { f32x4 o; o[0] = __uint_as_float(u.x << 16); o[1] = __uint_as_float(u.x & 0xffff0000u); o[2] = __uint_as_float(u.y << 16); o[3] = __uint_as_float(u.y & 0xffff0000u); return o; };
#define WK_PREP1(bufidx, blkidx, tt_) do { LAS float* pb_ = L + (bufidx) * WK_PB; const size_t t_ = tokb + (size_t)(blkidx) * WK_TB + (tt_); const size_t o_ = t_ * D + ch; \
        const f32x4 k4 = bf4(*(const uint2*)(Kb + o_)), r4 = bf4(*(const uint2*)(R + o_)), a4 = bf4(*(const uint2*)(AS + o_)), wraw = bf4(*(const uint2*)(WRAW + o_)), v4 = bf4(*(const uint2*)(V + t_ * D + chv)); f32x4 w4; \
        _Pragma("unroll") for (int e_ = 0; e_ < 4; ++e_) w4[e_] = wkv_decay_fast(w0c[e_], wraw[e_]); \
        f32x4 kk = k4 * kkc; float ss = red16((kk[0] * kk[0] + kk[1] * kk[1]) + (kk[2] * kk[2] + kk[3] * kk[3])); const float inv = 1.0f / fmaxf(sqrtf(ss), 1e-12f); kk = kk * inv; \
        const f32x4 km = k4 * ((a4 - 1.0f) * kac + 1.0f); const f32x4 pr = r4 * km; const f32x4 prk = pr * rkc; const float bon = red16((prk[0] + prk[1]) + (prk[2] + prk[3])); \
        const f32x4 bbv = kk * a4; const f32x4 pb2 = bbv * r4; const float brs = red16((pb2[0] + pb2[1]) + (pb2[2] + pb2[3])), krs = red16((pr[0] + pr[1]) + (pr[2] + pr[3])); \
        *(LAS f32x4*)(pb_ + WK_W + (tt_) * 64 + 4 * jq) = w4; *(LAS f32x4*)(pb_ + WK_KM + (tt_) * 64 + 4 * jq) = km; *(LAS f32x4*)(pb_ + WK_NA + (tt_) * 64 + 4 * jq) = -kk; \
        *(LAS f32x4*)(pb_ + WK_BB + (tt_) * 64 + 4 * jq) = bbv; *(LAS f32x4*)(pb_ + WK_WR + (tt_) * 64 + 4 * jq) = w4 * r4 - kk * brs; \
        if (jq < 8) { *(LAS f32x4*)(pb_ + WK_V + (tt_) * 64 + 8 * jq) = (f32x4){v4[0], v4[1], v4[0] * krs, v4[1] * krs}; *(LAS f32x4*)(pb_ + WK_V + (tt_) * 64 + 8 * jq + 4) = (f32x4){v4[2], v4[3], v4[2] * krs, v4[3] * krs}; } \
        if (jq == 0 && half == 0) BON[t_ * 16 + h] = bon; } while (0)
#define WK_RD128(dst, ad, off) asm volatile("ds_read_b128 %0, %1 offset:%2" : "=v"(dst) : "v"(ad), "i"(off))
#define WK_LOADOPS(o_, dt_) do { WK_RD128((o_).na, aop, WK_NA * 4 + (dt_) * 256); WK_RD128((o_).wr, aop, WK_WR * 4 + (dt_) * 256); WK_RD128((o_).w4, aop, WK_W * 4 + (dt_) * 256); \
        WK_RD128((o_).bb, aop, WK_BB * 4 + (dt_) * 256); WK_RD128((o_).km, aop, WK_KM * 4 + (dt_) * 256); WK_RD128((o_).vv, av, (dt_) * 256); } while (0)
#define WK_WAIT(n_, o_) asm volatile("s_waitcnt lgkmcnt(" #n_ ")" : "+v"((o_).na), "+v"((o_).wr), "+v"((o_).w4), "+v"((o_).bb), "+v"((o_).km), "+v"((o_).vv))
#define WK_STEP(o_, dt_) do { \
        float sa0 = (S0[0] * (o_).na[0] + S0[1] * (o_).na[1]) + (S0[2] * (o_).na[2] + S0[3] * (o_).na[3]), sa1 = (S1[0] * (o_).na[0] + S1[1] * (o_).na[1]) + (S1[2] * (o_).na[2] + S1[3] * (o_).na[3]); \
        float y0 = (S0[0] * (o_).wr[0] + S0[1] * (o_).wr[1]) + (S0[2] * (o_).wr[2] + S0[3] * (o_).wr[3]), y1 = (S1[0] * (o_).wr[0] + S1[1] * (o_).wr[1]) + (S1[2] * (o_).wr[2] + S1[3] * (o_).wr[3]); \
        sa0 = dpp_add(sa0, 0); sa1 = dpp_add(sa1, 0); y0 = dpp_add(y0, 0); y1 = dpp_add(y1, 0); sa0 = dpp_add(sa0, 1); sa1 = dpp_add(sa1, 1); y0 = dpp_add(y0, 1); y1 = dpp_add(y1, 1); \
        sa0 = dpp_add(sa0, 2); sa1 = dpp_add(sa1, 2); y0 = dpp_add(y0, 2); y1 = dpp_add(y1, 2); sa0 = dpp_add(sa0, 3); sa1 = dpp_add(sa1, 3); y0 = dpp_add(y0, 3); y1 = dpp_add(y1, 3); \
        S0 = S0 * (o_).w4 + ((o_).bb * sa0 + (o_).km * (o_).vv[0]); S1 = S1 * (o_).w4 + ((o_).bb * sa1 + (o_).km * (o_).vv[1]); \
        f32x2_t yy; yy[0] = y0 + (o_).vv[2]; yy[1] = y1 + (o_).vv[3]; \
        asm volatile("ds_write_b64 %0, %1 offset:%2" :: "v"(ay), "v"(yy), "i"((dt_) * 128) : "memory"); } while (0)
    constexpr int NB = TP / WK_TB;
    if (!stepper) {
        const int ht = (tid - 256) >> 4;
        const f32x4 kkc = *(const f32x4*)(k_k + ch), kac = *(const f32x4*)(k_a + ch), rkc = *(const f32x4*)(r_k + ch), w0c = *(const f32x4*)(w0p + ch);
        WK_PREP1(0, 0, ht); WK_PREP1(0, 0, ht + 16);
        LDS_WAIT(); __builtin_amdgcn_s_barrier(); asm volatile("" ::: "memory");
        for (int n = 0; n < NB; ++n) { const int cur = n & 1;
            if (n + 1 < NB) { WK_PREP1(cur ^ 1, n + 1, ht); WK_PREP1(cur ^ 1, n + 1, ht + 16); }
            if (n >= 1) {
                const int yt = (tid - 256) >> 3, yq = (tid & 7) * 4; const f32x4 y4 = *(const LAS f32x4*)(L + WK_Y + (cur ^ 1) * WK_YB + yt * 32 + yq);
                uint2 ov; ov.x = pk2(y4[0], y4[1]); ov.y = pk2(y4[2], y4[3]);
                *(uint2*)(Y + (tokb + (size_t)(n - 1) * WK_TB + yt) * D + h * 64 + half * 32 + yq) = ov; }
            LDS_WAIT(); __builtin_amdgcn_s_barrier(); asm volatile("" ::: "memory");
        }
        { const int yt = (tid - 256) >> 3, yq = (tid & 7) * 4; const f32x4 y4 = *(const LAS f32x4*)(L + WK_Y + ((NB - 1) & 1) * WK_YB + yt * 32 + yq);
            uint2 ov; ov.x = pk2(y4[0], y4[1]); ov.y = pk2(y4[2], y4[3]); *(uint2*)(Y + (tokb + (size_t)(NB - 1) * WK_TB + yt) * D + h * 64 + half * 32 + yq) = ov; }
    } else {
        LDS_WAIT(); __builtin_amdgcn_s_barrier(); asm volatile("" ::: "memory");
        const unsigned lbase = (unsigned)(size_t)L;
        for (int n = 0; n < NB; ++n) { const int cur = n & 1;
            unsigned aop = lbase + (unsigned)(cur * WK_PB + 4 * jq) * 4u, av = lbase + (unsigned)(cur * WK_PB + WK_V + 4 * rp) * 4u;
            unsigned ay = lbase + (unsigned)(jq == 0 ? WK_Y + cur * WK_YB + 2 * rp : WK_Y + 2 * WK_YB + 2 * tid) * 4u;
            WkvOps o0, o1, o2, o3;
            asm volatile("s_waitcnt lgkmcnt(0)" ::: "memory");
            WK_LOADOPS(o0, 0); WK_LOADOPS(o1, 1);
            WK_LOADOPS(o2, 2); WK_WAIT(12, o0); WK_STEP(o0, 0);
            WK_LOADOPS(o3, 3); WK_WAIT(13, o1); WK_STEP(o1, 1);
            for (int t4 = 0; t4 < 7; ++t4) {
                WK_LOADOPS(o0, 4); WK_WAIT(14, o2); WK_STEP(o2, 2);
                WK_LOADOPS(o1, 5); WK_WAIT(14, o3); WK_STEP(o3, 3);
                aop += 1024; av += 1024; ay += 512;
                WK_LOADOPS(o2, 2); WK_WAIT(14, o0); WK_STEP(o0, 0);
                WK_LOADOPS(o3, 3); WK_WAIT(14, o1); WK_STEP(o1, 1);
            }
            WK_WAIT(8, o2); WK_STEP(o2, 2);
            WK_WAIT(2, o3); WK_STEP(o3, 3);
            asm volatile("s_waitcnt lgkmcnt(0)" ::: "memory");
            __builtin_amdgcn_s_barrier(); asm volatile("" ::: "memory");
        }
        float* so = s_out + (((size_t)b * 16 + h) * 64 + half * 32 + 2 * rp) * 64 + 4 * jq; *(f32x4*)so = S0; *(f32x4*)(so + 64) = S1;
    }
#undef WK_LOADOPS
#undef WK_STEP
#undef WK_WAIT
#undef WK_RD128
#undef WK_PREP1
}
DEVI void wkv_ypass_row(size_t tok, int lane, const bf16* Y, const bf16* V, bf16* GO, const float* BON, const float* lnx_g, const float* lnx_b) {
    const int c0 = lane * 16; const size_t o = tok * D + c0;
    const v4u ya = *(const v4u*)(Y + o), yb = *(const v4u*)(Y + o + 8), va = *(const v4u*)(V + o), vb = *(const v4u*)(V + o + 8), ga = *(const v4u*)(GO + o), gb = *(const v4u*)(GO + o + 8);
    const unsigned yw[8] = {ya.x, ya.y, ya.z, ya.w, yb.x, yb.y, yb.z, yb.w}, vw[8] = {va.x, va.y, va.z, va.w, vb.x, vb.y, vb.z, vb.w}, gw_[8] = {ga.x, ga.y, ga.z, ga.w, gb.x, gb.y, gb.z, gb.w};
    float y[16]; float s = 0.f;
#pragma unroll
    for (int e = 0; e < 8; ++e) { y[2 * e] = __uint_as_float(yw[e] << 16); y[2 * e + 1] = __uint_as_float(yw[e] & 0xffff0000u); s += y[2 * e] + y[2 * e + 1]; }
    s = dpp_add(s, 0); s = dpp_add(s, 1); const float mean = s * (1.f / 64.f); float q = 0.f;
#pragma unroll
    for (int e = 0; e < 16; ++e) { y[e] -= mean; q += y[e] * y[e]; }
    q = dpp_add(q, 0); q = dpp_add(q, 1); const float rstd = rsqrtf(q * (1.f / 64.f) + 64e-5f), bon = BON[tok * 16 + (lane >> 2)];
    unsigned ow[8];
#pragma unroll
    for (int e = 0; e < 8; ++e) { const float v0 = __uint_as_float(vw[e] << 16), v1 = __uint_as_float(vw[e] & 0xffff0000u), g0 = __uint_as_float(gw_[e] << 16), g1 = __uint_as_float(gw_[e] & 0xffff0000u);
        const float o0 = (y[2 * e] * rstd * lnx_g[c0 + 2 * e] + lnx_b[c0 + 2 * e] + bon * v0) * g0, o1 = (y[2 * e + 1] * rstd * lnx_g[c0 + 2 * e + 1] + lnx_b[c0 + 2 * e + 1] + bon * v1) * g1; ow[e] = pk2(o0, o1); }
    *(v4u*)(GO + o) = (v4u){ow[0], ow[1], ow[2], ow[3]}; *(v4u*)(GO + o + 8) = (v4u){ow[4], ow[5], ow[6], ow[7]};
}

constexpr int GL_BF = 0, GL_QI = 16384, GL_KI = 25600, GL_SC = 34816, GL_VT = 44032, GL_ST = 62464, GL_RS = 80896, GL_WG = 81920, GL_GKL = 86016, GL_SEG = 90112;
constexpr int GL_LD = 72;
DEVI bf16x8 gl_frag(LAS unsigned char* lds, int base, int row, int k0, int fq) { return *(const LAS bf16x8*)(lds + base + (row * GL_LD + k0 + 8 * fq) * 2); }
DEVI void gla_cumdecay(LAS unsigned char* lds, int tid, int h, size_t tok0, const float* GKL, const float* w_gk, const float* b_gk) {
    asm volatile("" : "+v"(tid));
    LAS float* BF = (LAS float*)(lds + GL_BF); LAS float* WG = (LAS float*)(lds + GL_WG); LAS float* GK = (LAS float*)(lds + GL_GKL); LAS float* SEG = (LAS float*)(lds + GL_SEG);
    for (int i = tid; i < 1024; i += 512) { WG[i] = w_gk[(i >> 6) * 256 + h * 64 + (i & 63)]; GK[i] = GKL[tok0 * 16 + i]; }
    LDS_WAIT(); __builtin_amdgcn_s_barrier(); asm volatile("" ::: "memory");
    { const int t = tid >> 3, d0 = (tid & 7) * 8; float x[8];
#pragma unroll
        for (int e = 0; e < 8; ++e) x[e] = b_gk[h * 64 + d0 + e];
#pragma unroll
        for (int r = 0; r < 16; ++r) { const float gv = GK[t * 16 + r]; const f32x4 w0 = *(const LAS f32x4*)(WG + r * 64 + d0), w1 = *(const LAS f32x4*)(WG + r * 64 + d0 + 4);
#pragma unroll
            for (int e = 0; e < 4; ++e) { x[e] += gv * w0[e]; x[4 + e] += gv * w1[e]; } }
#pragma unroll
        for (int e = 0; e < 8; ++e) { const float xx = x[e]; x[e] = (fminf(xx, 0.f) - log1pf(__expf(-fabsf(xx)))) * (1.f / 16.f); }
        *(LAS f32x4*)(BF + t * 64 + d0) = (f32x4){x[0], x[1], x[2], x[3]}; *(LAS f32x4*)(BF + t * 64 + d0 + 4) = (f32x4){x[4], x[5], x[6], x[7]}; }
    LDS_WAIT(); __builtin_amdgcn_s_barrier(); asm volatile("" ::: "memory");
    { const int dk = tid & 63, sg = tid >> 6; float a = 0.f;
#pragma unroll
        for (int i = 0; i < 8; ++i) { a += BF[(sg * 8 + i) * 64 + dk]; BF[(sg * 8 + i) * 64 + dk] = a; }
        SEG[sg * 64 + dk] = a; }
    LDS_WAIT(); __builtin_amdgcn_s_barrier(); asm volatile("" ::: "memory");
    { const int dk = tid & 63, sg = tid >> 6; float off = 0.f;
        for (int s = 0; s < sg; ++s) off += SEG[s * 64 + dk];
#pragma unroll
        for (int i = 0; i < 8; ++i) BF[(sg * 8 + i) * 64 + dk] += off; }
    LDS_WAIT(); __builtin_amdgcn_s_barrier(); asm volatile("" ::: "memory");
}
DEVI void gla_stage_vt(LAS unsigned char* lds, int tid, int h, size_t tok0, const bf16* P) {
    const int t = tid >> 3, dv0 = (tid & 7) * 16; const bf16* vp = P + (tok0 + t) * NINP + 512 + h * 128 + dv0;
    const v4u a = *(const v4u*)vp, b = *(const v4u*)(vp + 8); LAS bf16* VT = (LAS bf16*)(lds + GL_VT);
    const unsigned w[8] = {a.x, a.y, a.z, a.w, b.x, b.y, b.z, b.w};
#pragma unroll
    for (int e = 0; e < 8; ++e) { VT[(dv0 + 2 * e) * GL_LD + t] = (bf16)(w[e] & 0xffffu); VT[(dv0 + 2 * e + 1) * GL_LD + t] = (bf16)(w[e] >> 16); }
}
DEVI void gla_unit_a(LAS unsigned char* lds, int tid, int u, const bf16* P, const float* GKL, const float* w_gk, const float* b_gk, float* KV, float* DEC) {
    asm volatile("" : "+v"(tid));
    const int bh = u >> 5, ck = u & 31, b = bh >> 2, h = bh & 3; const size_t tok0 = (size_t)b * TP + ck * 64;
    const int lane = tid & 63, wave = tid >> 6, fr = lane & 15, fq = lane >> 4;
    gla_cumdecay(lds, tid, h, tok0, GKL, w_gk, b_gk);
    LAS float* BF = (LAS float*)(lds + GL_BF);
    { const int t = tid >> 3, d0 = (tid & 7) * 8; const v4u kq = *(const v4u*)(P + (tok0 + t) * NINP + 256 + h * 64 + d0); LAS bf16* KST = (LAS bf16*)(lds + GL_QI);
        const unsigned w[4] = {kq.x, kq.y, kq.z, kq.w};
#pragma unroll
        for (int e = 0; e < 8; ++e) { const float kv = __uint_as_float((e & 1) ? (w[e >> 1] & 0xffff0000u) : (w[e >> 1] << 16)); const float sc = __expf(BF[63 * 64 + d0 + e] - BF[t * 64 + d0 + e]);
            KST[(d0 + e) * GL_LD + t] = (bf16)f2bf(kv * sc); } }
    gla_stage_vt(lds, tid, h, tok0, P);
    if (tid < 64) DEC[(size_t)u * 64 + tid] = __expf(BF[63 * 64 + tid]);
    LDS_WAIT(); __builtin_amdgcn_s_barrier(); asm volatile("" ::: "memory");
#pragma unroll
    for (int dt = 0; dt < 4; ++dt) { f32x4 acc = {0.f, 0.f, 0.f, 0.f};
#pragma unroll
        for (int k0 = 0; k0 < 64; k0 += 32) acc = __builtin_amdgcn_mfma_f32_16x16x32_bf16(gl_frag(lds, GL_VT, wave * 16 + fr, k0, fq), gl_frag(lds, GL_QI, dt * 16 + fr, k0, fq), acc, 0, 0, 0);
        *(f32x4*)(KV + ((size_t)u * 64 + dt * 16 + fr) * 128 + wave * 16 + 4 * fq) = acc; }
    LDS_WAIT(); __builtin_amdgcn_s_barrier(); asm volatile("" ::: "memory");
}
DEVI void gla_scan_b(int gtid, float* KV, const float* DEC, float* s_out) {
    const int dv = gtid & 127, dkq = (gtid >> 7) & 15, bh = gtid >> 11; float S[4] = {0.f, 0.f, 0.f, 0.f};
#pragma unroll 4
    for (int c = 0; c < 32; ++c) { const size_t u = (size_t)bh * 32 + c; float* kp = KV + (u * 64 + dkq * 4) * 128 + dv;
#pragma unroll
        for (int e = 0; e < 4; ++e) { const float kv = kp[e * 128], dc = DEC[u * 64 + dkq * 4 + e]; kp[e * 128] = S[e]; S[e] = dc * S[e] + kv; } }
#pragma unroll
    for (int e = 0; e < 4; ++e) s_out[((size_t)bh * 64 + dkq * 4 + e) * 128 + dv] = S[e];
}
DEVI void gla_unit_c(LAS unsigned char* lds, int tid, int u, const bf16* P, const float* GKL, const float* w_gk, const float* b_gk, const float* KV, const float* norm_g, bf16* O) {
    asm volatile("" : "+v"(tid));
    const int bh = u >> 5, ck = u & 31, b = bh >> 2, h = bh & 3; const size_t tok0 = (size_t)b * TP + ck * 64;
    const int lane = tid & 63, wave = tid >> 6, fr = lane & 15, fq = lane >> 4;
    gla_cumdecay(lds, tid, h, tok0, GKL, w_gk, b_gk);
    LAS float* BF = (LAS float*)(lds + GL_BF);
    { const int t = tid >> 3, d0 = (tid & 7) * 8; const v4u qq = *(const v4u*)(P + (tok0 + t) * NINP + h * 64 + d0), kq = *(const v4u*)(P + (tok0 + t) * NINP + 256 + h * 64 + d0);
        const unsigned wq[4] = {qq.x, qq.y, qq.z, qq.w}, wk[4] = {kq.x, kq.y, kq.z, kq.w}; float qo[8], ko[8];
#pragma unroll
        for (int e = 0; e < 8; ++e) { const float qv = __uint_as_float((e & 1) ? (wq[e >> 1] & 0xffff0000u) : (wq[e >> 1] << 16)), kv = __uint_as_float((e & 1) ? (wk[e >> 1] & 0xffff0000u) : (wk[e >> 1] << 16));
            const float bb = BF[t * 64 + d0 + e]; qo[e] = qv * 0.125f * __expf(bb); ko[e] = kv * __expf(-bb); }
        v4u a, c; a.x = pk2(qo[0], qo[1]); a.y = pk2(qo[2], qo[3]); a.z = pk2(qo[4], qo[5]); a.w = pk2(qo[6], qo[7]); c.x = pk2(ko[0], ko[1]); c.y = pk2(ko[2], ko[3]); c.z = pk2(ko[4], ko[5]); c.w = pk2(ko[6], ko[7]);
        *(LAS v4u*)(lds + GL_QI + (t * GL_LD + d0) * 2) = a; *(LAS v4u*)(lds + GL_KI + (t * GL_LD + d0) * 2) = c; }
    gla_stage_vt(lds, tid, h, tok0, P);
    { const int dk = tid >> 3, dv0 = (tid & 7) * 16; const float* sp = KV + ((size_t)u * 64 + dk) * 128 + dv0; LAS bf16* ST = (LAS bf16*)(lds + GL_ST);
#pragma unroll
        for (int q = 0; q < 4; ++q) { const f32x4 s4 = *(const f32x4*)(sp + 4 * q);
#pragma unroll
            for (int e = 0; e < 4; ++e) ST[(dv0 + 4 * q + e) * GL_LD + dk] = (bf16)f2bf(s4[e]); } }
    LDS_WAIT(); __builtin_amdgcn_s_barrier(); asm volatile("" ::: "memory");
#pragma unroll
    for (int q = 0; q < 2; ++q) { const int id = wave * 2 + q, tt = id >> 2, st = id & 3; f32x4 acc = {0.f, 0.f, 0.f, 0.f};
#pragma unroll
        for (int k0 = 0; k0 < 64; k0 += 32) acc = __builtin_amdgcn_mfma_f32_16x16x32_bf16(gl_frag(lds, GL_KI, st * 16 + fr, k0, fq), gl_frag(lds, GL_QI, tt * 16 + fr, k0, fq), acc, 0, 0, 0);
        const int t = tt * 16 + fr, s0 = st * 16 + 4 * fq;
#pragma unroll
        for (int e = 0; e < 4; ++e) if (s0 + e > t) acc[e] = 0.f;
        *(LAS unsigned long long*)(lds + GL_SC + (t * GL_LD + s0) * 2) = (unsigned long long)pk2(acc[0], acc[1]) | ((unsigned long long)pk2(acc[2], acc[3]) << 32); }
    LDS_WAIT(); __builtin_amdgcn_s_barrier(); asm volatile("" ::: "memory");
    const int tt = wave & 3, hv = wave >> 2; f32x4 o[4]; float ssq = 0.f;
#pragma unroll
    for (int dt = 0; dt < 4; ++dt) { f32x4 acc = {0.f, 0.f, 0.f, 0.f}; const int dvr = (hv * 4 + dt) * 16 + fr;
#pragma unroll
        for (int k0 = 0; k0 < 64; k0 += 32) { acc = __builtin_amdgcn_mfma_f32_16x16x32_bf16(gl_frag(lds, GL_VT, dvr, k0, fq), gl_frag(lds, GL_SC, tt * 16 + fr, k0, fq), acc, 0, 0, 0);
            acc = __builtin_amdgcn_mfma_f32_16x16x32_bf16(gl_frag(lds, GL_ST, dvr, k0, fq), gl_frag(lds, GL_QI, tt * 16 + fr, k0, fq), acc, 0, 0, 0); }
        o[dt] = acc; ssq += (acc[0] * acc[0] + acc[1] * acc[1]) + (acc[2] * acc[2] + acc[3] * acc[3]); }
    ssq += __shfl_xor(ssq, 16); ssq += __shfl_xor(ssq, 32);
    LAS float* RS = (LAS float*)(lds + GL_RS);
    if (fq == 0) RS[hv * 64 + tt * 16 + fr] = ssq;
    LDS_WAIT(); __builtin_amdgcn_s_barrier(); asm volatile("" ::: "memory");
    { const int t = tt * 16 + fr; const float rstd = rsqrtf((RS[t] + RS[64 + t]) * (1.f / 128.f) + 1e-5f); const size_t tok = tok0 + t;
#pragma unroll
        for (int dt = 0; dt < 4; ++dt) { const int dv = (hv * 4 + dt) * 16 + 4 * fq; const uint2 gg = *(const uint2*)(P + tok * NINP + 1024 + h * 128 + dv); const f32x4 ng = *(const f32x4*)(norm_g + dv);
            const float g0 = __uint_as_float(gg.x << 16), g1 = __uint_as_float(gg.x & 0xffff0000u), g2 = __uint_as_float(gg.y << 16), g3 = __uint_as_float(gg.y & 0xffff0000u);
            uint2 ov; ov.x = pk2(o[dt][0] * rstd * ng[0] * siluf_(g0), o[dt][1] * rstd * ng[1] * siluf_(g1)); ov.y = pk2(o[dt][2] * rstd * ng[2] * siluf_(g2), o[dt][3] * rstd * ng[3] * siluf_(g3));
            *(uint2*)(O + tok * D + h * 128 + dv) = ov; } }
    LDS_WAIT(); __builtin_amdgcn_s_barrier(); asm volatile("" ::: "memory");
}

__global__ void __launch_bounds__(NWAVES * 64, 2) __attribute__((target("no-packed-fp32-ops"))) mk_fwd(Args args) {
    extern __shared__ __attribute__((aligned(16))) unsigned char lds_raw[];
    LAS unsigned char* lds = (LAS unsigned char*)lds_raw;
    volatile LAS unsigned* MISC = (volatile LAS unsigned*)(lds + MISC_OFF);
    const int tid = threadIdx.x, lane = tid & 63, wave = __builtin_amdgcn_readfirstlane(tid >> 6), G = gridDim.x, blk = blockIdx.x;
#define LW() (*(unsigned char* const __attribute__((address_space(4)))*)(KARG() + 424))
#define LO() (*(float* const __attribute__((address_space(4)))*)(KARG() + 416))
#define PTRS unsigned char* ws = LW(); float* out = LO(); float* MODS = (float*)(ws + WS_MODS); float* SP = (float*)(ws + WS_SP); bf16* H = (bf16*)(ws + WS_H); float* Z = (float*)(ws + WS_Z); bf16* ACT = (bf16*)(ws + WS_ACT); float* X = out; \
    (void)MODS; (void)SP; (void)H; (void)Z; (void)ACT; (void)X
    for (int u = tid; u < (LDS_BYTES - LDSCTL_OFF) / 4; u += NWAVES * 64) ((LAS unsigned*)(lds + LDSCTL_OFF))[u] = 0u;
    __syncthreads();
    { XcdBarrier b0_ = xcd_barrier_post((unsigned*)(LW() + WS_CTL) + CW_BAR, MISC + 8); (void)b0_; }
#define GRID_BAR() do { XcdBarrier b_; b_.bar = (unsigned*)(LW() + WS_CTL) + CW_BAR; b_.x = xb_xcc_id(); b_.st = MISC + 8; xcd_barrier(b_); if (XP == 6) xcd_barrier(b_); \
        if (PROBE && blk == 0 && tid == 0) ((unsigned long long*)(LW() + WS_CTL + 524288))[nst] = rt(); ++nst; } while (0)
    int nst = 0;
    if (PROBE && blk == 0 && tid == 0) ((unsigned long long*)(LW() + WS_CTL + 524288))[63] = rt();
    const int gw = blk * NWAVES + wave, NGW = G * NWAVES;
    const int gws = wave * G + blk;
    LAS float* wscr = (LAS float*)(lds + RING_OFF + wave * 16384);

    for (int xrep = 0; xrep < (XP == 1 ? 2 : 1); ++xrep) { PTRS;
        { float* STt = (float*)(ws + WS_ST); for (int i = blk * 512 + tid; i < 144 * 1024; i += G * 512) { const int r = i >> 10, k = i & 1023; float v = 0.f; if (r < 8) v = siluf_(INP(7)[r * 1024 + k]); else if (r < 136) v = siluf_(INP(8)[(r - 8) * 1024 + k]); STt[k * 144 + r] = v; } }
        for (int it = blk * 512 + tid; it < 2048 * 18; it += G * 512) { const int i = it & 2047, tau = it >> 11;
            if (tau == 17) s5prep_one(i, INP(24), INP(25), INP(26), INP(27), INP(28), SP); else s5prep_pw(i, tau, INP(24), INP(25), INP(26), SP); }
    }
    GRID_BAR();
    for (int xq = 0; xq < (XP == 17 ? 2 : 1); ++xq) { PTRS; bf16* TM = (bf16*)(ws + WS_TM); bf16* HM = (bf16*)(ws + WS_HM);
        constexpr int I_UP = (D / 64) * (NUP / 32), I_DN = (FFP / 64) * (D / 32), I_IN = (D / 64) * (NINP / 32), I_GLU = (512 / 64) * (512 / 32), I_SQ = (D / 64) * (D / 32), I_RK = (KRK / 64) * (NRK / 32), I_L2 = (NL1 / 64) * (3072 / 32);
        constexpr int NITEMS = 4 * I_UP + 4 * I_DN + I_IN + I_GLU + 2 * I_SQ + I_RK + I_L2;
        for (int it = NGW - 1 - gws; it < NITEMS; it += NGW) {
            int r = it;
            if (r < 4 * I_UP) { const int q = r / I_UP, l = q >> 1, f = q & 1; r -= q * I_UP;
                const int kb = r / (NUP / 32), nb = r % (NUP / 32), pn = nb >> 3, half = (nb >> 2) & 1, c0 = pn * 128 + (nb & 3) * 32;
                bf16* dst = (bf16*)(ws + (l ? WS_WUP_L1 : WS_WUP_L0) + f * SZ_WUP) + (size_t)(nb * 32) * D;
                if (c0 >= FF) { SrcZero s; cvt_item(s, dst, D, 1, wscr, kb, lane); }
                else if (half) { SrcPlain s{INPD(f ? 17 : 14) + (size_t)l * D * FF + c0, D, FF - c0, FF}; cvt_item(s, dst, D, 1, wscr, kb, lane); }
                else { SrcPlain s{INPD(f ? 16 : 13) + (size_t)l * D * FF + c0, D, FF - c0, FF}; cvt_item(s, dst, D, 1, wscr, kb, lane); }
                continue; } r -= 4 * I_UP;
            if (r < 4 * I_DN) { const int q = r / I_DN, l = q >> 1, f = q & 1; r -= q * I_DN;
                SrcPlain s{INPD(f ? 18 : 15) + (size_t)l * FF * D, FF, D, D};
                cvt_item(s, (bf16*)(ws + (l ? WS_WDN_L1 : WS_WDN_L0) + f * SZ_WDN), FFP, D / 32, wscr, r, lane); continue; } r -= 4 * I_DN;
            if (r < I_IN) { SrcPlain s{INPD(19), D, NIN, NIN}; cvt_item(s, (bf16*)(ws + WS_WIN), D, NINP / 32, wscr, r, lane); continue; } r -= I_IN;
            if (r < I_GLU) { SrcPlain s{INPD(32), 512, 512, 512}; cvt_item(s, (bf16*)(ws + WS_WGLU), 512, 512 / 32, wscr, r, lane); continue; } r -= I_GLU;
            if (r < I_SQ) { SrcPlain s{INPD(20), D, D, D}; cvt_item(s, (bf16*)(ws + WS_WOUT), D, D / 32, wscr, r, lane); continue; } r -= I_SQ;
            if (r < I_SQ) { SrcPlain s{INPD(38), D, D, D}; cvt_item(s, (bf16*)(ws + WS_WO), D, D / 32, wscr, r, lane); continue; } r -= I_SQ;
            if (r < I_RK) { const int kb = r / (NRK / 32), nb = r % (NRK / 32), n0 = nb * 32; bf16* dst = (bf16*)(ws + WS_WRK) + (size_t)n0 * KRK;
                if (n0 < 1024) { SrcFold s{INPD(35) + n0, INPD(34) + 0 * 1024, 1024}; cvt_item(s, dst, KRK, 1, wscr, kb, lane); }
                else if (n0 < 2048) { SrcFold s{INPD(36) + (n0 - 1024), INPD(34) + 2 * 1024, 1024}; cvt_item(s, dst, KRK, 1, wscr, kb, lane); }
                else if (n0 < 3072) { SrcFold s{INPD(37) + (n0 - 2048), INPD(34) + 3 * 1024, 1024}; cvt_item(s, dst, KRK, 1, wscr, kb, lane); }
                else if (n0 < 3136) { SrcFold s{INPD(40) + (n0 - 3072), INPD(34) + 1 * 1024, 64}; cvt_item(s, dst, KRK, 1, wscr, kb, lane); }
                else if (n0 < 3200) { SrcFold s{INPD(43) + (n0 - 3136), INPD(34) + 4 * 1024, 64}; cvt_item(s, dst, KRK, 1, wscr, kb, lane); }
                else if (n0 < 3360) { SrcFold s{INPD(45) + (n0 - 3200), INPD(34) + 5 * 1024, 160}; cvt_item(s, dst, KRK, 1, wscr, kb, lane); }
                else { SrcZero s; cvt_item(s, dst, KRK, 1, wscr, kb, lane); }
                continue; } r -= I_RK;
            { const int kb = r / (3072 / 32), nb = r % (3072 / 32), n0 = nb * 32; bf16* dst = (bf16*)(ws + WS_WL2) + (size_t)n0 * NL1;
                if (n0 < 1024) { SrcBlk s{INPD(41) + n0, 0, 64}; cvt_item(s, dst, NL1, 1, wscr, kb, lane); }
                else if (n0 < 2048) { SrcBlk s{INPD(44) + (n0 - 1024), 64, 128}; cvt_item(s, dst, NL1, 1, wscr, kb, lane); }
                else { SrcBlk s{INPD(46) + (n0 - 2048), 128, 288}; cvt_item(s, dst, NL1, 1, wscr, kb, lane); } }
        }
        for (int xr = 0; xr < (XP == 10 ? 2 : 1); ++xr) for (int j = gws; j < 2304; j += NGW) mods_job(__builtin_amdgcn_readfirstlane(j), lane, (const float*)(ws + WS_ST), INPD(9), INPD(10), MODS);
        for (int j = NGW - 1 - gws; j < 32 * 17 + 32 * 16; j += NGW) { if (j < 544) s5_tm_job(j / 17, j % 17, lane, SP, INPD(29), INPD(30), INPD(31), TM); else s5_hm_job((j - 544) >> 4, (j - 544) & 15, lane, SP, HM); }
        for (int i = gw * 64 + lane; i < 32 * 128 * 256 / 8; i += NGW * 64) { const int g = i >> 12, r = i & 4095; *(v4u*)(HM + ((size_t)g * 256 + 128) * 256 + (size_t)r * 8) = (v4u){0u, 0u, 0u, 0u}; } }
    GRID_BAR();
    { PTRS; for (int xr = 0; xr < (XP == 18 ? 2 : 1); ++xr) for (int row = gw; row < MTP; row += NGW) init_row(row, lane, INP(0), INP(1), MODS, X, H, (float*)(ws + WS_ZS)); }
    GRID_BAR();

#define GEMM_PHASE(EPI, Aptr, Bptr, NN, KK, ...) do { pg8::GemmX g_{(const pg8::bf16_t*)(Aptr), (const pg8::bf16_t*)(Bptr), MTP, NN, KK, KK, KK, -1}; pg8::StaticOrder S_; S_.init(MTP, NN, G, blk); pg8::EPI E_{__VA_ARGS__}; \
        pg8::gemm_phase<pg8::EPI, pg8::StaticOrder, true, true>(lds + RING_OFF, g_, S_, E_); } while (0)
#define GEMMX_PHASE(EPI, Aptr, Bptr, MM, NN, KK, LDA, LDB, GSH, ...) do { pg8::GemmX g_{(const pg8::bf16_t*)(Aptr), (const pg8::bf16_t*)(Bptr), MM, NN, KK, LDA, LDB, GSH}; pg8::StaticOrder S_; S_.init(MM, NN, G, blk); pg8::EPI E_{__VA_ARGS__}; \
        pg8::gemm_phase<pg8::EPI, pg8::StaticOrder, true, true>(lds + RING_OFF, g_, S_, E_); } while (0)
#define RESID_PHASE(Aptr, Bptr, KK, gatep, rcv) do { \
        { pg8::GemmX g_{(const pg8::bf16_t*)(Aptr), (const pg8::bf16_t*)(Bptr), NP, D, KK, KK, KK, -1}; pg8::StaticOrder S_; S_.init(NP, D, G, blk); pg8::EpiResid E_{X, Z, gatep, rcv, 0}; \
          pg8::gemm_phase<pg8::EpiResid, pg8::StaticOrder, true, true>(lds + RING_OFF, g_, S_, E_); } \
        { pg8::GemmX g_{(const pg8::bf16_t*)(Aptr), (const pg8::bf16_t*)(Bptr), MTP, D, 256, KK, KK, -1}; pg8::SplitOrder S_{64, 4, (KK) / 256, 256, G, blk}; pg8::EpiResidS E_{(float*)(ws + WS_SL), gatep, rcv, 0}; \
          pg8::gemm_phase<pg8::EpiResidS, pg8::SplitOrder, true, true>(lds + RING_OFF, g_, S_, E_); } } while (0)
#define LN_PASS(l, idx, Hout, nsh, nsc) do { PTRS; const int nsl_ = ((idx) == 1) ? 4 : 11; for (int row = gw; row < MT; row += NGW) ln_row(row, lane, Z, (float*)(ws + WS_ZS), (const float*)(ws + WS_SL), nsl_, INP(11) + ((l) * 3 + (idx)) * D, INP(12) + ((l) * 3 + (idx)) * D, X, Hout, nsh, nsc); } while (0)
#define FFN(l, f, which0, lnidx, HOUT, nshw, nscw) do { \
        { PTRS; { int ru_ = (XP == 41 ? 2 : 1); asm volatile("" : "+s"(ru_)); for (int xu = 0; xu < ru_; ++xu) GEMM_PHASE(EpiSwiglu, H, ws + ((l) ? WS_WUP_L1 : WS_WUP_L0) + (f) * SZ_WUP, NUP, D, (pg8::bf16_t*)ACT); } if (XP == 2) { GEMM_PHASE(EpiSwiglu, H, ws + ((l) ? WS_WUP_L1 : WS_WUP_L0) + (f) * SZ_WUP, NUP, D, (pg8::bf16_t*)ACT); } if (XP == 42) { GEMM_PHASE(EpiHloc, H, ws + ((l) ? WS_WUP_L1 : WS_WUP_L0) + (f) * SZ_WUP, NUP, D, (float*)(ws + WS_Z)); } } GRID_BAR(); \
        { PTRS; RESID_PHASE(ACT, ws + ((l) ? WS_WDN_L1 : WS_WDN_L0) + (f) * SZ_WDN, FFP, modp(MODS, l, (which0) + 2), 0.5f); if (XP == 3) { RESID_PHASE(ACT, ws + ((l) ? WS_WDN_L1 : WS_WDN_L0) + (f) * SZ_WDN, FFP, modp(MODS, l, (which0) + 2), 0.5f); } } GRID_BAR(); \
        LN_PASS(l, lnidx, HOUT, nshw, nscw); if (XP == 4) { LN_PASS(l, lnidx, HOUT, nshw, nscw); } GRID_BAR(); } while (0)

    FFN(0, 0, 0, 0, H, modp(MODS, 0, 3), modp(MODS, 0, 4));
#define L0PTRS PTRS; bf16* P = (bf16*)(ws + WS_P); float* GKL = (float*)(ws + WS_GKL); float* OGS = (float*)(ws + WS_OGS) - (size_t)NP * 512; bf16* Z5 = (bf16*)(ws + WS_Z5); bf16* O = (bf16*)(ws + WS_O); \
        bf16* UB = (bf16*)(ws + WS_UBUF); float* HL = (float*)(ws + WS_HLOC); float* KV = (float*)(ws + WS_KV); float* DEC = (float*)(ws + WS_DEC); (void)P; (void)GKL; (void)OGS; (void)Z5; (void)O; (void)UB; (void)HL; (void)KV; (void)DEC
    { L0PTRS; for (int xr = 0; xr < (XP == 11 ? 2 : 1); ++xr) GEMM_PHASE(EpiInproj, H, ws + WS_WIN, NINP, D, (pg8::bf16_t*)P, GKL, (pg8::bf16_t*)UB); } GRID_BAR();
    for (int xr = 0; xr < (XP == 12 ? 2 : 1); ++xr) { if (xr) { GRID_BAR(); --nst; } L0PTRS;
        { int reps_ = (XP == 25 ? 2 : (XP == 26 ? 5 : 1)); asm volatile("" : "+s"(reps_)); for (int xh = 0; xh < reps_; ++xh) GEMMX_PHASE(EpiHloc, UB, ws + WS_HM, 32768, 256, 256, 384, 256, 2, HL); }
        for (int u = (blk + 128) & 255; u < 1024; u += 256) gla_unit_a(lds + RING_OFF, tid, u, P, GKL, INPD(21), INPD(22), KV, DEC);
    }
    GRID_BAR();
    { L0PTRS;
        for (int xr = 0; xr < (XP == 13 ? 2 : 1); ++xr) if (gws < 256) s5_carry_job(gws >> 5, gws & 31, lane, SP, HL, UB, out + O_S5RE_P, out + O_S5IM_P);
        if (blk >= 128) gla_scan_b((blk - 128) * 512 + tid, KV, DEC, out + O_GLA_P);
        for (int s = gws; s < 1536; s += NGW) {
            if (s < 1024) gla_job(wscr, lane, s >> 3, (s >> 1) & 3, s & 1, P, GKL, INPD(21), INPD(22), NP, 1, INPD(2), out + O_GLA_S, OGS);
            else { const int j = s - 1024; s5_job(wscr, lane, j & 31, (j >> 5) * 8, 8, P, SP, INPD(29), INPD(30), INPD(31), NP, 1, INPD(3), INPD(4), out + O_S5RE_S, out + O_S5IM_S, Z5); } }
    } GRID_BAR();
    for (int xr = 0; xr < (XP == 14 ? 2 : 1); ++xr) { L0PTRS;
        GEMMX_PHASE(EpiS5Y, UB, ws + WS_TM, 32768, 256, 384, 384, 384, 2, (pg8::bf16_t*)Z5);
        for (int u = (blk + 128) & 255; u < 1024; u += 256) gla_unit_c(lds + RING_OFF, tid, u, P, GKL, INPD(21), INPD(22), KV, INPD(23), O);
        for (int w = NP * 4 + gw; w < MT * 4; w += NGW) gla_post_one(w, lane, OGS, P, INP(23), O); } GRID_BAR();
    { L0PTRS; { int rg_ = (XP == 24 ? 2 : 1); asm volatile("" : "+s"(rg_)); for (int xr = 0; xr < rg_; ++xr) GEMM_PHASE(EpiGlu, Z5, ws + WS_WGLU, 512, 512, (const pg8::bf16_t*)Z5, (pg8::bf16_t*)O, INP(33)); }
        if (XP == 40) { int rh_ = 2; asm volatile("" : "+s"(rh_)); for (int xr = 0; xr < rh_; ++xr) GEMM_PHASE(EpiHloc, Z5, ws + WS_WGLU, 512, 512, HL); } } GRID_BAR();
    { L0PTRS; RESID_PHASE(O, ws + WS_WOUT, D, modp(MODS, 0, 5), 1.0f); } GRID_BAR();
    LN_PASS(0, 1, H, modp(MODS, 0, 6), modp(MODS, 0, 7)); GRID_BAR();
    FFN(0, 1, 6, 2, H, modp(MODS, 1, 0), modp(MODS, 1, 1));
    FFN(1, 0, 0, 0, (bf16*)nullptr, (const float*)nullptr, (const float*)nullptr);
#define L1PTRS PTRS; bf16* A2 = (bf16*)(ws + WS_A2); bf16* R = (bf16*)(ws + WS_R); bf16* Kb = (bf16*)(ws + WS_K); bf16* V = (bf16*)(ws + WS_V); bf16* L1 = (bf16*)(ws + WS_L1A); \
        bf16* WRAW = (bf16*)(ws + WS_WRAW); bf16* YB = (bf16*)(ws + WS_YB); float* BON = (float*)(ws + WS_BON); bf16* AS = (bf16*)(ws + WS_AS); bf16* Gt = (bf16*)(ws + WS_G); (void)A2; (void)R; (void)Kb; (void)V; (void)L1; (void)WRAW; (void)YB; (void)BON; (void)AS; (void)Gt
    { L1PTRS; for (int row = gw; row < MTP; row += NGW) shiftcat_row(row, lane, X, MODS, INP(5), A2, out); } GRID_BAR();
    { L1PTRS; GEMM_PHASE(EpiRk, A2, ws + WS_WRK, NRK, KRK, (pg8::bf16_t*)R, (size_t)MTP * D, (pg8::bf16_t*)L1); if (XP == 7) { GEMM_PHASE(EpiRk, A2, ws + WS_WRK, NRK, KRK, (pg8::bf16_t*)R, (size_t)MTP * D, (pg8::bf16_t*)L1); } } GRID_BAR();
    { L1PTRS; GEMM_PHASE(EpiLora2, L1, ws + WS_WL2, 3072, NL1, (pg8::bf16_t*)WRAW, (pg8::bf16_t*)AS, (pg8::bf16_t*)Gt, INP(42)); } GRID_BAR();
    if (XP == 21 || XP == 22) { L1PTRS; bf16* dY = (bf16*)(ws + WS_L0 + 32 * MiB); float* dB = (float*)(ws + WS_L0 + 26 * MiB); float* dS = (float*)(ws + WS_L0 + 25 * MiB + 524288);
        if (XP == 21) wkv_half<1>((LAS float*)(lds + RING_OFF), tid, 0, 0, 0, R, Kb, V, WRAW, AS, INPD(39), INPD(47), INPD(48), INPD(49), dY, dB, dS);
        else wkv_half<2>((LAS float*)(lds + RING_OFF), tid, 0, 0, 0, R, Kb, V, WRAW, AS, INPD(39), INPD(47), INPD(48), INPD(49), dY, dB, dS); __syncthreads(); }
    for (int xr = 0; xr < (XP == 5 ? 2 : 1); ++xr) { L1PTRS; wkv_half<0>((LAS float*)(lds + RING_OFF), tid, blk >> 5, (blk >> 1) & 15, blk & 1, R, Kb, V, WRAW, AS, INPD(39), INPD(47), INPD(48), INPD(49), YB, BON, out + O_WKV_P); if (XP == 5) __syncthreads(); } GRID_BAR();
    { L1PTRS;
        for (int t = gw; t < NP; t += NGW) wkv_ypass_row((size_t)t, lane, YB, V, Gt, BON, INPD(50), INPD(51));
        for (int s = gws; s < 2048; s += NGW) wkv_job(wscr, lane, s >> 4, s & 15, R, Kb, V, WRAW, INPD(39), AS, Gt, INPD(47), INPD(48), INPD(49), INPD(50), INPD(51), NP, 1, INPD(6), out + O_WKV_S); }
    GRID_BAR();
    { L1PTRS; RESID_PHASE(Gt, ws + WS_WO, D, modp(MODS, 1, 5), 1.0f); } GRID_BAR();
    LN_PASS(1, 1, H, modp(MODS, 1, 6), modp(MODS, 1, 7)); GRID_BAR();
    { PTRS; GEMM_PHASE(EpiSwiglu, H, ws + WS_WUP_L1 + SZ_WUP, NUP, D, (pg8::bf16_t*)ACT); if (XP == 2) { GEMM_PHASE(EpiSwiglu, H, ws + WS_WUP_L1 + SZ_WUP, NUP, D, (pg8::bf16_t*)ACT); } } GRID_BAR();
    { PTRS; RESID_PHASE(ACT, ws + WS_WDN_L1 + SZ_WDN, FFP, modp(MODS, 1, 8), 0.5f); if (XP == 3) { RESID_PHASE(ACT, ws + WS_WDN_L1 + SZ_WDN, FFP, modp(MODS, 1, 8), 0.5f); } } GRID_BAR();
    LN_PASS(1, 2, (bf16*)nullptr, (const float*)nullptr, (const float*)nullptr); if (XP == 4) { LN_PASS(1, 2, (bf16*)nullptr, (const float*)nullptr, (const float*)nullptr); }
#if PROBE
    {
        __syncthreads();
        PTRS; const unsigned long long* TS = (const unsigned long long*)(ws + WS_CTL + 524288);
        const float v1 = (float)(TS[PROBE_A1] - TS[PROBE_A0]) * 0.01f, v2 = (float)(TS[PROBE_B1] - TS[PROBE_B0]) * 0.01f * 10.0f;
        for (int row = NP + gw; row < MT; row += NGW) for (int j = 0; j < 16; ++j) X[(size_t)row * D + j * 64 + lane] = v1;
        if (blk == 0 && tid == 0) out[O_WKV_S] = v2;
    }
#endif
}

extern "C" void kernel_launch(void* const* d_in, const int* in_sizes, int n_in, void* d_out, int out_size, void* d_ws, size_t ws_size, hipStream_t stream) {
    static int grid = 0;
    if (grid == 0) {
        if (n_in != 52 || ws_size < WS_END) { fprintf(stderr, "kernel_launch: unexpected n_in %d or ws %zu\n", n_in, ws_size); grid = -1; return; }
        int dev = 0, cus = 0, per_cu = 0;
        if (hipGetDevice(&dev) != hipSuccess || hipDeviceGetAttribute(&cus, hipDeviceAttributeMultiprocessorCount, dev) != hipSuccess) { grid = -1; return; }
        if (hipFuncSetAttribute((const void*)mk_fwd, hipFuncAttributeMaxDynamicSharedMemorySize, LDS_BYTES) != hipSuccess) { fprintf(stderr, "hipFuncSetAttribute failed\n"); grid = -1; return; }
        if (hipOccupancyMaxActiveBlocksPerMultiprocessor(&per_cu, (const void*)mk_fwd, NWAVES * 64, LDS_BYTES) != hipSuccess || per_cu < 1) { fprintf(stderr, "occupancy query: %d\n", per_cu); per_cu = 1; }
        (void)hipGetLastError();
        grid = cus;
    }
    if (grid < 0) return;
    (void)hipMemsetAsync((char*)d_ws + WS_CTL, 0, CTL_ZERO_BYTES, stream);
    Args a{};
    for (int i = 0; i < 52; ++i) a.in[i] = (const float*)d_in[i];
    a.out = (float*)d_out; a.ws = (unsigned char*)d_ws;
    hipLaunchKernelGGL(mk_fwd, dim3(grid), dim3(NWAVES * 64), LDS_BYTES, stream, a);
}
```

```cpp
#include <hip/hip_runtime.h>
#include <cstdint>
#include <cstdio>

#ifndef PROBE
#define PROBE 0
#endif
#define XP 0
#ifndef MODS_HS
#define MODS_HS 12
#endif
#define PROBE_A0 63
#define PROBE_A1 1
#define PROBE_B0 1
#define PROBE_B1 4
typedef unsigned short bf16;
typedef short bf16x8 __attribute__((ext_vector_type(8)));
typedef float f32x4 __attribute__((ext_vector_type(4)));
#define DEVI __device__ __forceinline__
__device__ __forceinline__ void mk_syncthreads() { asm volatile("s_waitcnt vmcnt(0) lgkmcnt(0)" ::: "memory"); __builtin_amdgcn_s_barrier(); asm volatile("" ::: "memory"); }
#define __syncthreads() mk_syncthreads()

constexpr int D = 1024, NP = 16384, NS = 128, MT = NP + NS, MTP = 16640, TP = 2048, BP = 8;
constexpr int FF = 2752, FFP = 2816, NUP = 2 * FFP;
constexpr int NIN = 2064, NINP = 2304;
constexpr int NRK = 3584, KRK = 2048, NL1 = 384;
constexpr int NMODROW = 136;
constexpr float ALPHA = 1.41421356237309515f;

constexpr size_t O_Y = 0, O_GLA_P = 16908288, O_S5RE_P = 17170432, O_S5IM_P = 17186816, O_SHIFT_P = 17203200, O_WKV_P = 17211392,
                 O_GLA_S = 17735680, O_S5RE_S = 21929984, O_S5IM_S = 22192128, O_SHIFT_S = 22454272, O_WKV_S = 22585344;

constexpr size_t MiB = 1u << 20;
constexpr size_t WS_CTL = 0, CTL_ZERO_BYTES = 1 * MiB;
constexpr size_t WS_MODS = 1 * MiB, WS_SP = 12 * MiB, WS_ST = 344 * MiB, WS_ZS = 345 * MiB, WS_SL = 336 * MiB;
constexpr size_t WS_W = 13 * MiB;
constexpr size_t SZ_WUP = (size_t)NUP * D * 2;
constexpr size_t SZ_WDN = (size_t)D * FFP * 2;
constexpr size_t WS_L0 = WS_W;
constexpr size_t WS_WUP_L0 = WS_L0, WS_WDN_L0 = WS_L0 + 22 * MiB, WS_WIN = WS_L0 + 33 * MiB, WS_WGLU = WS_WIN + 4608 * 1024, WS_WOUT = WS_WGLU + 512 * 1024;
constexpr size_t WS_L1 = WS_L0 + 40 * MiB;
constexpr size_t WS_WUP_L1 = WS_L1, WS_WDN_L1 = WS_L1 + 22 * MiB, WS_WRK = WS_L1 + 33 * MiB, WS_WL2 = WS_WRK + 14 * MiB, WS_WO = WS_WL2 + 2304 * 1024;
static_assert(WS_WO + 2 * MiB <= 105 * MiB, "W region");
constexpr size_t WS_H = 105 * MiB, WS_Z = 138 * MiB, WS_ACT = 203 * MiB, WS_S2 = 293 * MiB, WS_END = 346 * MiB;
constexpr size_t WS_P = WS_ACT, WS_GKL = 277 * MiB, WS_Z5 = WS_Z, WS_O = WS_H, WS_DEC = 195 * MiB, WS_OGS = 196 * MiB, WS_KV = WS_S2;
constexpr size_t WS_UBUF = 155 * MiB, WS_HLOC = 179 * MiB, WS_HM = 326 * MiB, WS_TM = 330 * MiB;
constexpr size_t WS_A2 = WS_ACT, WS_K = WS_Z, WS_R = WS_Z - (size_t)MTP * D * 2, WS_V = WS_Z + (size_t)MTP * D * 2, WS_L1A = WS_L0, WS_WRAW = WS_ACT, WS_YB = WS_ACT + (size_t)MTP * D * 2, WS_BON = WS_L0 + 30 * MiB, WS_AS = 268 * MiB, WS_G = WS_AS + (size_t)MTP * D * 2;
static_assert(WS_G + (size_t)MTP * D * 2 <= WS_END, "ws");
constexpr int CW_TMO = 0, CW_BAR = 4096;

#define GAS __attribute__((address_space(1)))
#define LAS __attribute__((address_space(3)))
typedef unsigned short bf16;
typedef unsigned v4u __attribute__((ext_vector_type(4)));
typedef float f32x4 __attribute__((ext_vector_type(4)));
typedef short bf16x8 __attribute__((ext_vector_type(8)));
typedef GAS unsigned gu32;
typedef GAS unsigned long long gu64;
#define RLX_AGENT __ATOMIC_RELAXED, __HIP_MEMORY_SCOPE_AGENT
#define LDS_WAIT() asm volatile("s_waitcnt lgkmcnt(0)" ::: "memory")
#define VM_WAIT() asm volatile("s_waitcnt vmcnt(0)" ::: "memory")
__device__ __forceinline__ unsigned long long rt() { return __builtin_amdgcn_s_memrealtime(); }
__device__ __forceinline__ unsigned f2bf(float f) { unsigned u = __builtin_bit_cast(unsigned, f); return (u + 0x7fffu + ((u >> 16) & 1u)) >> 16; }
__device__ __forceinline__ unsigned pk2(float lo, float hi) { return f2bf(lo) | (f2bf(hi) << 16); }

#define XB_TMO      128
#define XB_XCNT(j)  (256  + 64 * (j))
#define XB_XSUB(j)  (1280 + 64 * (j))
#define XB_XGEN(j)  (2304 + 64 * (j))
#define XB_TOP      3328
#define XB_TOPGEN   3392
#define XCD_BAR_WORDS 3456
#define XB_SPIN_CAP (1u << 18)

__device__ __forceinline__ unsigned xb_ld(unsigned* p)              { return __hip_atomic_load(p, __ATOMIC_RELAXED, __HIP_MEMORY_SCOPE_AGENT); }
__device__ __forceinline__ unsigned xb_add(unsigned* p, unsigned v) { return __hip_atomic_fetch_add(p, v, __ATOMIC_RELAXED, __HIP_MEMORY_SCOPE_AGENT); }
__device__ __forceinline__ unsigned xb_xcc_id() { return (unsigned)__builtin_amdgcn_s_getreg((3 << 11) | 20) & 0xFu; }
#define XB_SPIN(cond, bar) do { unsigned _sp = 0; while (cond) { __builtin_amdgcn_s_sleep(1); \
    if ((++_sp & 255u) == 0u) { if (xb_ld(&(bar)[XB_TMO])) break; if (_sp > XB_SPIN_CAP) { atomicAdd(&(bar)[XB_TMO], 1u); break; } } } } while (0)

struct XcdBarrier {
    unsigned* bar; unsigned x;
    volatile LAS unsigned* st;
};

__device__ __forceinline__ XcdBarrier xcd_barrier_post(unsigned* bar, volatile LAS unsigned* st) {
    XcdBarrier b; b.bar = bar; b.x = xb_xcc_id(); b.st = st;
    if (threadIdx.x == 0) (void)xb_add(&bar[XB_XCNT(b.x)], 1u);
    return b;
}
__device__ __forceinline__ void xcd_barrier_complete(unsigned* bar, unsigned x, unsigned& nloc, unsigned& nx) {
    const unsigned G = gridDim.x * gridDim.y * gridDim.z;
    unsigned sum, cnt, mine, sp = 0u;
    for (;;) {
        sum = 0u; cnt = 0u; mine = 0u;
#pragma unroll
        for (unsigned j = 0; j < 16; ++j) { const unsigned c = xb_ld(&bar[XB_XCNT(j)]); sum += c; cnt += (c > 0u) ? 1u : 0u; mine = (j == x) ? c : mine; }
        if (sum == G) break;
        __builtin_amdgcn_s_sleep(1);
        if ((++sp & 255u) == 0u) { if (xb_ld(&bar[XB_TMO])) break; if (sp > XB_SPIN_CAP) { atomicAdd(&bar[XB_TMO], 1u); break; } }
    }
    nloc = mine > 0u ? mine : 1u; nx = cnt > 0u ? cnt : 1u;
}

__device__ __forceinline__ void xcd_barrier(const XcdBarrier& b) {
    asm volatile("s_waitcnt vmcnt(0)" ::: "memory");
    __syncthreads();
    if (threadIdx.x == 0) {
        unsigned* bar = b.bar;
        __builtin_amdgcn_s_waitcnt(0);
        unsigned nloc = b.st[0], nx = b.st[1];
        if (nloc == 0u) { xcd_barrier_complete(bar, b.x, nloc, nx); b.st[0] = nloc; b.st[1] = nx; }
        const unsigned old = xb_add(&bar[XB_XSUB(b.x)], 1u);
        const unsigned gen = old / nloc;
        if (old + 1u == (gen + 1u) * nloc) {
            __builtin_amdgcn_fence(__ATOMIC_RELEASE, "agent");
            asm volatile("s_waitcnt vmcnt(0)" ::: "memory");
            const unsigned og = xb_add(&bar[XB_TOP], 1u);
            const unsigned tg = og / nx;
            if (og + 1u == (tg + 1u) * nx) xb_add(&bar[XB_TOPGEN], 1u);
            else XB_SPIN(xb_ld(&bar[XB_TOPGEN]) == tg, bar);
            __builtin_amdgcn_fence(__ATOMIC_ACQUIRE, "agent");
            xb_add(&bar[XB_XGEN(b.x)], 1u);
            asm volatile("s_waitcnt vmcnt(0)" ::: "memory");
        } else {
            XB_SPIN(xb_ld(&bar[XB_XGEN(b.x)]) == gen, bar);
            __builtin_amdgcn_fence(__ATOMIC_ACQUIRE, "agent");
            asm volatile("s_waitcnt vmcnt(0)" ::: "memory");
        }
    }
    __syncthreads();
}

DEVI float bf2f(unsigned short h) { return __uint_as_float(((unsigned)h) << 16); }
DEVI int mrow(int i) { return i < NP ? (i >> 11) : (8 + i - NP); }
DEVI float sigmoidf_(float x) { return 1.0f / (1.0f + __expf(-x)); }
DEVI float siluf_(float x) { return x / (1.0f + __expf(-x)); }
DEVI float softplusf_(float x) { return fmaxf(x, 0.f) + log1pf(__expf(-fabsf(x))); }
DEVI float gelu_tanh(float x) { const float u = 0.7978845608028654f * (x + 0.044715f * x * x * x); return 0.5f * x * (1.0f + tanhf(u)); }
DEVI float wave_sum(float v) {
#pragma unroll
    for (int o = 1; o < 64; o <<= 1) v += __shfl_xor(v, o);
    return v;
}
__host__ __device__ __forceinline__ const float* modp(const float* mods, int l, int which) { return mods + (size_t)l * NMODROW * 9216 + which * 1024; }

namespace pg8 {
#define PG8_LAS __attribute__((address_space(3)))
typedef unsigned short bf16_t;
typedef short bf16x8 __attribute__((ext_vector_type(8)));
typedef float f32x4 __attribute__((ext_vector_type(4)));
typedef unsigned u32x4 __attribute__((ext_vector_type(4)));
constexpr int BM = 256, BK = 64, HALF = 128, HTB = HALF * BK * 2  , STAGE_BYTES = 8 * HTB, NXCD = 8, WGM = 8;

__host__ __device__ __forceinline__ int lds_byte(int r, int c) { const int st = (r >> 4) * 2 + (c >> 5), rr = r & 15, cc = c & 31, ob = rr * 64 + cc * 2; return st * 1024 + (ob ^ (((ob >> 9) & 1) << 5)); }
__host__ __device__ __forceinline__ void stage_rc(int b, int& R, int& C) { const int st = b / 1024, sb = b % 1024, swz = sb ^ (((sb >> 9) & 1) << 5); R = (st >> 1) * 16 + swz / 64; C = (st & 1) * 32 + (swz % 64) / 2; }
__host__ __device__ __forceinline__ int perm32(int rho) { const int n = rho >> 4, i = rho & 15; return 8 * (i >> 2) + 4 * n + (i & 3); }

struct Unit { int pm, pn, ko; };
struct Gemm { const bf16_t* A; const bf16_t* Bt; int M, N, K; };
struct GemmX { const bf16_t* A; const bf16_t* Bt; int M, N, K, lda, ldb, gsh; };

struct StaticOrder {
    int nM, nN, nwg, G, c;
    __host__ __device__ __forceinline__ void init(int M, int N, int G_, int c_) { nM = M / BM; nN = N / BM; nwg = nM * nN; G = G_; c = c_; }
    __host__ __device__ __forceinline__ bool next(int i, Unit& u) const {
        const long L = (long)i * G + c; if (L >= nwg) return false;
        int wgid = (int)L; { const int q = nwg / NXCD, r = nwg % NXCD, xcd = wgid % NXCD, off = wgid / NXCD; wgid = (xcd < r ? xcd * (q + 1) : r * (q + 1) + (xcd - r) * q) + off; }
        const int nig = WGM * nN, gid = wgid / nig, fm = gid * WGM, gsz = (nM - fm) < WGM ? (nM - fm) : WGM;
        u.pm = fm + ((wgid % nig) % gsz); u.pn = (wgid % nig) / gsz; u.ko = 0; return true;
    }
    __device__ __forceinline__ void a_ready(const Unit&) const {}
    __device__ __forceinline__ void done(const Unit&) const {}
};

struct SplitOrder {
    int pm0, nN, nsplit, kspl, G, c;
    __host__ __device__ __forceinline__ bool next(int i, Unit& u) const { const int L = i * G + c; if (L >= nsplit * nN) return false; u.pm = pm0; u.pn = L % nN; u.ko = (L / nN) * kspl; return true; }
    __device__ __forceinline__ void a_ready(const Unit&) const {}
    __device__ __forceinline__ void done(const Unit&) const {}
};

__device__ __forceinline__ unsigned cvt_pk_bf16(float lo, float hi) { unsigned r; asm volatile("v_cvt_pk_bf16_f32 %0, %1, %2" : "=v"(r) : "v"(lo), "v"(hi)); return r; }
__device__ __forceinline__ float fsilu(float x) { return x * __builtin_amdgcn_rcpf(1.0f + __builtin_amdgcn_exp2f(-1.44269504089f * x)); }
__device__ __forceinline__ float fsigm(float x) { return __builtin_amdgcn_rcpf(1.0f + __builtin_amdgcn_exp2f(-1.44269504089f * x)); }
__device__ __forceinline__ u32x4 pack8(const f32x4 a, const f32x4 b) { u32x4 w; w.x = cvt_pk_bf16(a[0], a[1]); w.y = cvt_pk_bf16(a[2], a[3]); w.z = cvt_pk_bf16(b[0], b[1]); w.w = cvt_pk_bf16(b[2], b[3]); return w; }
struct EpiSwiglu { static constexpr bool PERM = true, AFTER_DRAIN = false; bf16_t* ACT;
    __device__ __forceinline__ void operator()(const f32x4 (&acc)[2][2][4][2], const Unit& u, int wr, int wc, int fr, int fq) const {
        const int row0 = u.pm * BM + wr * 64 + fr, col0 = u.pn * 128 + wc * 32 + 8 * fq;
#pragma unroll
        for (int ai = 0; ai < 2; ++ai)
#pragma unroll
            for (int m = 0; m < 4; ++m) { f32x4 o0, o1;
#pragma unroll
                for (int e = 0; e < 4; ++e) { o0[e] = fsilu(acc[ai][0][m][0][e]) * acc[ai][1][m][0][e]; o1[e] = fsilu(acc[ai][0][m][1][e]) * acc[ai][1][m][1][e]; }
                *(u32x4*)(ACT + (size_t)(row0 + ai * HALF + m * 16) * 2816 + col0) = pack8(o0, o1); }
    } };
struct EpiResid { static constexpr bool PERM = true, AFTER_DRAIN = false; const float* X; float* Z; const float* gate; float rc; int pad;
    __device__ __forceinline__ void operator()(const f32x4 (&acc)[2][2][4][2], const Unit& u, int wr, int wc, int fr, int fq) const {
        const float* __restrict__ xp = X + (size_t)(u.pm * BM + wr * 64 + fr) * 1024 + u.pn * BM + wc * 32 + 8 * fq; float* __restrict__ zp = Z + (size_t)(u.pm * BM + wr * 64 + fr) * 1024 + u.pn * BM + wc * 32 + 8 * fq;
        const float* __restrict__ gp = gate + (size_t)(u.pm >> 3) * 9216 + u.pn * BM + wc * 32 + 8 * fq;
        f32x4 g[2][2], xa[2][2], xb[2][2];
#pragma unroll
        for (int bj = 0; bj < 2; ++bj)
#pragma unroll
            for (int n = 0; n < 2; ++n) { g[bj][n] = (*(const f32x4*)(gp + bj * HALF + 4 * n) + 1.0f) * rc; xa[bj][n] = *(const f32x4*)(xp + bj * HALF + 4 * n); }
#pragma unroll
        for (int i = 0; i < 8; ++i) { const int ai = i >> 2, m = i & 3; const size_t ro = (size_t)(ai * HALF + m * 16) * 1024;
            if (i + 1 < 8) { const size_t rn = (size_t)(((i + 1) >> 2) * HALF + ((i + 1) & 3) * 16) * 1024;
#pragma unroll
                for (int bj = 0; bj < 2; ++bj)
#pragma unroll
                    for (int n = 0; n < 2; ++n) { if (i & 1) xa[bj][n] = *(const f32x4*)(xp + rn + bj * HALF + 4 * n); else xb[bj][n] = *(const f32x4*)(xp + rn + bj * HALF + 4 * n); } }
#pragma unroll
            for (int bj = 0; bj < 2; ++bj)
#pragma unroll
                for (int n = 0; n < 2; ++n) { const f32x4 x = (i & 1) ? xb[bj][n] : xa[bj][n]; *(f32x4*)(zp + ro + bj * HALF + 4 * n) = x * 1.41421356237309515f + g[bj][n] * acc[ai][bj][m][n]; } }
    } };
struct EpiInproj { static constexpr bool PERM = true, AFTER_DRAIN = false; bf16_t* P; float* GKL; bf16_t* UB;
    __device__ __forceinline__ void operator()(const f32x4 (&acc)[2][2][4][2], const Unit& u, int wr, int wc, int fr, int fq) const {
        const int row0 = u.pm * BM + wr * 64 + fr;
#pragma unroll
        for (int ai = 0; ai < 2; ++ai)
#pragma unroll
            for (int m = 0; m < 4; ++m) { const int row = row0 + ai * HALF + m * 16;
#pragma unroll
                for (int bj = 0; bj < 2; ++bj) { const int c = u.pn * BM + bj * HALF + wc * 32 + 8 * fq;
                    const u32x4 pk = pack8(acc[ai][bj][m][0], acc[ai][bj][m][1]);
                    *(u32x4*)(P + (size_t)row * 2304 + c) = pk;
                    if (c >= 1552 && c < 2064 && row < 16384) { const int cu = c - 1552; *(u32x4*)(UB + ((size_t)((cu >> 4) * 1024 + (row >> 4))) * 384 + (row & 15) * 16 + (cu & 15)) = pk; }
                    if (c >= 1536 && c < 1552) { *(f32x4*)(GKL + (size_t)row * 16 + (c - 1536)) = acc[ai][bj][m][0]; *(f32x4*)(GKL + (size_t)row * 16 + (c - 1536) + 4) = acc[ai][bj][m][1]; } } }
    } };
struct EpiGlu { static constexpr bool PERM = true, AFTER_DRAIN = false; const bf16_t* Z5; bf16_t* O; const float* bg;
    __device__ __forceinline__ void operator()(const f32x4 (&acc)[2][2][4][2], const Unit& u, int wr, int wc, int fr, int fq) const {
        const int cb = u.pn * BM + wc * 32 + 8 * fq;
        const bf16_t* __restrict__ zp = Z5 + (size_t)(u.pm * BM + wr * 64 + fr) * 512 + cb; bf16_t* __restrict__ op = O + (size_t)(u.pm * BM + wr * 64 + fr) * 1024 + 512 + cb;
        f32x4 b[2][2]; u32x4 za[2], zb[2];
#pragma unroll
        for (int bj = 0; bj < 2; ++bj) { b[bj][0] = *(const f32x4*)(bg + cb + bj * HALF); b[bj][1] = *(const f32x4*)(bg + cb + bj * HALF + 4); za[bj] = *(const u32x4*)(zp + bj * HALF); }
#pragma unroll
        for (int i = 0; i < 8; ++i) { const int ai = i >> 2, m = i & 3; const size_t rr = (size_t)(ai * HALF + m * 16);
            if (i + 1 < 8) { const size_t rn = (size_t)(((i + 1) >> 2) * HALF + ((i + 1) & 3) * 16) * 512;
#pragma unroll
                for (int bj = 0; bj < 2; ++bj) { if (i & 1) za[bj] = *(const u32x4*)(zp + rn + bj * HALF); else zb[bj] = *(const u32x4*)(zp + rn + bj * HALF); } }
#pragma unroll
            for (int bj = 0; bj < 2; ++bj) { const u32x4 zz = (i & 1) ? zb[bj] : za[bj]; f32x4 o0, o1;
#pragma unroll
                for (int e = 0; e < 4; ++e) { const unsigned w0 = zz[e >> 1], w1 = zz[2 + (e >> 1)];
                    const float z0 = __uint_as_float((e & 1) ? (w0 & 0xffff0000u) : (w0 << 16)), z1 = __uint_as_float((e & 1) ? (w1 & 0xffff0000u) : (w1 << 16));
                    o0[e] = z0 * fsigm(acc[ai][bj][m][0][e] + b[bj][0][e]); o1[e] = z1 * fsigm(acc[ai][bj][m][1][e] + b[bj][1][e]); }
                *(u32x4*)(op + rr * 1024 + bj * HALF) = pack8(o0, o1); } }
    } };
__device__ __forceinline__ float ftanh(float x) { const float e = __builtin_amdgcn_exp2f(-2.88539008178f * fabsf(x)); const float t = (1.0f - e) * __builtin_amdgcn_rcpf(1.0f + e); return x < 0.f ? -t : t; }
struct EpiRk { static constexpr bool PERM = true, AFTER_DRAIN = false; bf16_t* R; size_t rkv_stride; bf16_t* L1;
    __device__ __forceinline__ void operator()(const f32x4 (&acc)[2][2][4][2], const Unit& u, int wr, int wc, int fr, int fq) const {
        const int row0 = u.pm * BM + wr * 64 + fr;
#pragma unroll
        for (int ai = 0; ai < 2; ++ai)
#pragma unroll
            for (int m = 0; m < 4; ++m) { const int row = row0 + ai * HALF + m * 16;
#pragma unroll
                for (int bj = 0; bj < 2; ++bj) { const int c = u.pn * BM + bj * HALF + wc * 32 + 8 * fq;
                    if (c < 3072) { bf16_t* dst = R + (size_t)(c >> 10) * rkv_stride; *(u32x4*)(dst + (size_t)row * 1024 + (c & 1023)) = pack8(acc[ai][bj][m][0], acc[ai][bj][m][1]); }
                    else { const int cc = c - 3072; if (cc < 384) { f32x4 o0 = acc[ai][bj][m][0], o1 = acc[ai][bj][m][1];
                        if (cc < 64) {
#pragma unroll
                            for (int e = 0; e < 4; ++e) { o0[e] = ftanh(o0[e]); o1[e] = ftanh(o1[e]); } }
                        else if (cc >= 128 && cc < 288) {
#pragma unroll
                            for (int e = 0; e < 4; ++e) { o0[e] = fsigm(o0[e]); o1[e] = fsigm(o1[e]); } }
                        else if (cc >= 288) { o0 = (f32x4){0.f, 0.f, 0.f, 0.f}; o1 = o0; }
                        *(u32x4*)(L1 + (size_t)row * 384 + cc) = pack8(o0, o1); } } } }
    } };
struct EpiLora2 { static constexpr bool PERM = true, AFTER_DRAIN = false; bf16_t* WRAW; bf16_t* AS; bf16_t* G; const float* a0;
    __device__ __forceinline__ void operator()(const f32x4 (&acc)[2][2][4][2], const Unit& u, int wr, int wc, int fr, int fq) const {
        const int row0 = u.pm * BM + wr * 64 + fr;
#pragma unroll
        for (int ai = 0; ai < 2; ++ai)
#pragma unroll
            for (int m = 0; m < 4; ++m) { const int row = row0 + ai * HALF + m * 16;
#pragma unroll
                for (int bj = 0; bj < 2; ++bj) { const int c = u.pn * BM + bj * HALF + wc * 32 + 8 * fq;
                    if (c < 1024) *(u32x4*)(WRAW + (size_t)row * 1024 + c) = pack8(acc[ai][bj][m][0], acc[ai][bj][m][1]);
                    else if (c < 2048) { const f32x4 a0v = *(const f32x4*)(a0 + c - 1024), a1v = *(const f32x4*)(a0 + c - 1024 + 4); f32x4 o0, o1;
#pragma unroll
                        for (int e = 0; e < 4; ++e) { o0[e] = fsigm(a0v[e] + acc[ai][bj][m][0][e]); o1[e] = fsigm(a1v[e] + acc[ai][bj][m][1][e]); }
                        *(u32x4*)(AS + (size_t)row * 1024 + c - 1024) = pack8(o0, o1); }
                    else *(u32x4*)(G + (size_t)row * 1024 + c - 2048) = pack8(acc[ai][bj][m][0], acc[ai][bj][m][1]); } }
    } };
struct EpiHloc { static constexpr bool PERM = true, AFTER_DRAIN = false; float* HL;
    __device__ __forceinline__ void operator()(const f32x4 (&acc)[2][2][4][2], const Unit& u, int wr, int wc, int fr, int fq) const {
        const int row0 = u.pm * BM + wr * 64 + fr, c = wc * 32 + 8 * fq;
#pragma unroll
        for (int ai = 0; ai < 2; ++ai)
#pragma unroll
            for (int m = 0; m < 4; ++m) { float* p = HL + (size_t)(row0 + ai * HALF + m * 16) * 128 + c; *(f32x4*)p = acc[ai][0][m][0]; *(f32x4*)(p + 4) = acc[ai][0][m][1]; }
    } };
__device__ __forceinline__ float fgelu(float x) { const float u2 = 1.5957691216057308f * (x + 0.044715f * x * x * x); return x * fsigm(u2); }
struct EpiS5Y { static constexpr bool PERM = true, AFTER_DRAIN = false; bf16_t* Z5;
    __device__ __forceinline__ void operator()(const f32x4 (&acc)[2][2][4][2], const Unit& u, int wr, int wc, int fr, int fq) const {
        const int row0 = u.pm * BM + wr * 64 + fr;
#pragma unroll
        for (int ai = 0; ai < 2; ++ai)
#pragma unroll
            for (int m = 0; m < 4; ++m) { const int row = row0 + ai * HALF + m * 16, g = row >> 10, chunk = row & 1023;
#pragma unroll
                for (int bj = 0; bj < 2; ++bj) { const int c = bj * HALF + wc * 32 + 8 * fq, t = c >> 4, co = c & 15; f32x4 o0, o1;
#pragma unroll
                    for (int e = 0; e < 4; ++e) { o0[e] = fgelu(acc[ai][bj][m][0][e]); o1[e] = fgelu(acc[ai][bj][m][1][e]); }
                    *(u32x4*)(Z5 + (size_t)(chunk * 16 + t) * 512 + g * 16 + co) = pack8(o0, o1); } }
    } };

struct EpiResidS { static constexpr bool PERM = true, AFTER_DRAIN = false; float* SL; const float* gate; float rc; int pad;
    __device__ __forceinline__ void operator()(const f32x4 (&acc)[2][2][4][2], const Unit& u, int wr, int wc, int fr, int fq) const {
        const int r0 = wr * 64 + fr; float* __restrict__ sl = SL + (size_t)(u.ko >> 8) * 128 * 1024;
#pragma unroll
        for (int m = 0; m < 4; ++m) { const int r = r0 + m * 16; const int mr = 8 + r;
#pragma unroll
            for (int bj = 0; bj < 2; ++bj)
#pragma unroll
                for (int n = 0; n < 2; ++n) { const int c = u.pn * BM + bj * HALF + wc * 32 + 8 * fq + 4 * n; const f32x4 g = *(const f32x4*)(gate + (size_t)mr * 9216 + c);
                    *(f32x4*)(sl + (size_t)r * 1024 + c) = (g + 1.0f) * rc * acc[0][bj][m][n]; } }
    } };
enum { EK_SWIGLU = 0, EK_RESID, EK_RESIDS, EK_INPROJ, EK_GLU, EK_RK, EK_LORA2, EK_HLOC, EK_S5Y };
struct EpiAny { static constexpr bool PERM = true, AFTER_DRAIN = false; int kind; void* p0; void* p1; const void* p2; const void* p3; float f0;
    __device__ __forceinline__ void operator()(const f32x4 (&acc)[2][2][4][2], const Unit& u, int wr, int wc, int fr, int fq) const {
        asm volatile("" : "+v"(fr), "+v"(fq));
        switch (kind) {
        case EK_SWIGLU: { EpiSwiglu e{(bf16_t*)p0}; e(acc, u, wr, wc, fr, fq); break; }
        case EK_RESID: { EpiResid e{(const float*)p0, (float*)p1, (const float*)p2, f0, 0}; e(acc, u, wr, wc, fr, fq); break; }
        case EK_RESIDS: { EpiResidS e{(float*)p0, (const float*)p2, f0, 0}; e(acc, u, wr, wc, fr, fq); break; }
        case EK_INPROJ: { EpiInproj e{(bf16_t*)p0, (float*)p1, (bf16_t*)p2}; e(acc, u, wr, wc, fr, fq); break; }
        case EK_GLU: { EpiGlu e{(const bf16_t*)p0, (bf16_t*)p1, (const float*)p2}; e(acc, u, wr, wc, fr, fq); break; }
        case EK_RK: { EpiRk e{(bf16_t*)p0, (size_t)16640 * 1024, (bf16_t*)p1}; e(acc, u, wr, wc, fr, fq); break; }
        case EK_LORA2: { EpiLora2 e{(bf16_t*)p0, (bf16_t*)p1, (bf16_t*)p2, (const float*)p3}; e(acc, u, wr, wc, fr, fq); break; }
        case EK_HLOC: { EpiHloc e{(float*)p0}; e(acc, u, wr, wc, fr, fq); break; }
        default: { EpiS5Y e{(bf16_t*)p0}; e(acc, u, wr, wc, fr, fq); break; }
        }
    } };
struct AnyOrder { StaticOrder so; SplitOrder sp; int split;
    __device__ __forceinline__ bool next(int i, Unit& u) const { return split ? sp.next(i, u) : so.next(i, u); }
    __device__ __forceinline__ void a_ready(const Unit&) const {}
    __device__ __forceinline__ void done(const Unit&) const {} };
template <class Epi, class Sched, bool ALIGN_EPI = false, bool SP2 = false>
__device__ __forceinline__ void gemm_phase(PG8_LAS unsigned char* lds, const GemmX g, const Sched& S, const Epi& E) {
    int tid_ = threadIdx.x; asm volatile("" : "+v"(tid_));
    const int tid = tid_, wid = __builtin_amdgcn_readfirstlane(tid >> 6), lane = tid & 63, wr = wid >> 2, wc = wid & 3, fr = lane & 15, fq = lane >> 4;
    int K_ = g.K; asm volatile("" : "+s"(K_));
    const int K = K_, nt = K / BK;
    int lda_ = g.lda, ldb_ = g.ldb; asm volatile("" : "+s"(lda_), "+s"(ldb_)); const int lda = lda_, ldb = ldb_, gsh = g.gsh, nNb = g.N / BM;
    unsigned voffA[2], voffB[2];
#pragma unroll
    for (int i = 0; i < 2; ++i) { int R, C; stage_rc(tid * 16 + i * 8192, R, C); const int Rb = Epi::PERM ? ((R & ~31) + perm32(R & 31)) : R;
        voffA[i] = (unsigned)(R * lda + C) * 2u; voffB[i] = (unsigned)(Rb * ldb + C) * 2u; }
    const size_t kstep = (size_t)(BK * 2);
    const size_t hstepA = (size_t)HALF * lda * 2, hstepB = (size_t)HALF * ldb * 2;
    const size_t tstepA = 2 * hstepA, tstepB = 2 * hstepB;
#define PG8_BTILE(u_) ((size_t)(gsh >= 0 ? ((u_).pm >> gsh) * nNb + (u_).pn : (u_).pn))
    const unsigned ldsw = (unsigned)wid * 1024u;
    const int aoff = lds_byte(wr * 64 + fr, fq * 8), boff = lds_byte(wc * 32 + fr, fq * 8);
#define PG8_SA(b, h) (((b) * 2 + (h)) * HTB)
#define PG8_SB(b, h) ((4 + (b) * 2 + (h)) * HTB)
#define PG8_STAGE(bufoff, gbase, voff) do { _Pragma("unroll") for (int _i = 0; _i < 2; ++_i) \
        __builtin_amdgcn_global_load_lds((const unsigned*)((const char*)(gbase) + (voff)[_i]), (PG8_LAS unsigned*)(lds + (bufoff) + ldsw + _i * 8192), 16, 0, 0); } while (0)
#define PG8_LDA(dst, b, h) do { _Pragma("unroll") for (int m = 0; m < 4; ++m) _Pragma("unroll") for (int k = 0; k < 2; ++k) dst[m][k] = *(const PG8_LAS bf16x8*)(lds + PG8_SA(b, h) + aoff + m * 2048 + k * 1024); } while (0)
#define PG8_LDB(dst, b, h) do { _Pragma("unroll") for (int n = 0; n < 2; ++n) _Pragma("unroll") for (int k = 0; k < 2; ++k) dst[n][k] = *(const PG8_LAS bf16x8*)(lds + PG8_SB(b, h) + boff + n * 2048 + k * 1024); } while (0)
#define PG8_MMA(ai, bj, At, Bt) do { __builtin_amdgcn_s_setprio(1); _Pragma("unroll") for (int m = 0; m < 4; ++m) _Pragma("unroll") for (int n = 0; n < 2; ++n) _Pragma("unroll") for (int k = 0; k < 2; ++k) \
        acc[ai][bj][m][n] = __builtin_amdgcn_mfma_f32_16x16x32_bf16(Bt[n][k], At[m][k], acc[ai][bj][m][n], 0, 0, 0); __builtin_amdgcn_s_setprio(0); } while (0)
#define PG8_WAIT_V(n) asm volatile("s_waitcnt vmcnt(" #n ")" ::: "memory")
#define PG8_WAIT_L(n) asm volatile("s_waitcnt lgkmcnt(" #n ")" ::: "memory")
#define PG8_BAR __builtin_amdgcn_s_barrier()
#define PG8_SCHED __builtin_amdgcn_sched_barrier(0)
    Unit cur, nxt; int ui = 0;
    if (!S.next(0, cur)) return;
    f32x4 acc[2][2][4][2];
#pragma unroll
    for (int a = 0; a < 2; ++a)
#pragma unroll
        for (int b = 0; b < 2; ++b)
#pragma unroll
            for (int m = 0; m < 4; ++m)
#pragma unroll
                for (int n = 0; n < 2; ++n) acc[a][b][m][n] = (f32x4){0.f, 0.f, 0.f, 0.f};
    bf16x8 At[4][2], B0[2][2], B1[2][2];
    const char* cA = (const char*)g.A + (size_t)cur.pm * tstepA + (size_t)cur.ko * 2; const char* cB = (const char*)g.Bt + PG8_BTILE(cur) * tstepB + (size_t)cur.ko * 2;
    S.a_ready(cur);
    if constexpr (SP2) {
        PG8_STAGE(PG8_SB(0, 0), cB, voffB); PG8_STAGE(PG8_SB(0, 1), cB + hstepB, voffB); PG8_STAGE(PG8_SA(0, 0), cA, voffA); PG8_STAGE(PG8_SA(0, 1), cA + hstepA, voffA);
        if (wr == 1) PG8_BAR;
        PG8_WAIT_V(2); PG8_BAR;
        PG8_STAGE(PG8_SB(1, 0), cB + kstep, voffB); PG8_STAGE(PG8_SA(1, 0), cA + kstep, voffA); PG8_STAGE(PG8_SB(1, 1), cB + hstepB + kstep, voffB);
        PG8_WAIT_V(6); PG8_BAR;
    } else {
        PG8_STAGE(PG8_SB(0, 0), cB, voffB); PG8_STAGE(PG8_SA(0, 0), cA, voffA); PG8_STAGE(PG8_SB(0, 1), cB + hstepB, voffB); PG8_STAGE(PG8_SA(0, 1), cA + hstepA, voffA);
        if (wr == 1) PG8_BAR;
        PG8_WAIT_V(4); PG8_BAR;
        PG8_STAGE(PG8_SB(1, 0), cB + kstep, voffB); PG8_STAGE(PG8_SA(1, 0), cA + kstep, voffA); PG8_STAGE(PG8_SB(1, 1), cB + hstepB + kstep, voffB);
        PG8_WAIT_V(6); PG8_BAR;
    }
    for (;;) {
        const bool has_next = S.next(ui + 1, nxt);
        const char* nA = has_next ? (const char*)g.A + (size_t)nxt.pm * tstepA + (size_t)nxt.ko * 2 : cA; const char* nB = has_next ? (const char*)g.Bt + PG8_BTILE(nxt) * tstepB + (size_t)nxt.ko * 2 : cB;
        for (int t = 0; t < nt; t += 2) {
            const bool last = (t == nt - 2);
            const char* a1 = cA + (size_t)(t + 1) * kstep;
            const char* a2 = last ? nA : cA + (size_t)(t + 2) * kstep; const char* b2 = last ? nB : cB + (size_t)(t + 2) * kstep;
            const char* a3 = a2 + kstep; const char* b3 = b2 + kstep;
            if (last && has_next) S.a_ready(nxt);
            if constexpr (SP2) {
            PG8_LDB(B0, 0, 0); PG8_LDB(B1, 0, 1); PG8_SCHED; PG8_LDA(At, 0, 0); PG8_STAGE(PG8_SA(1, 1), a1 + hstepA, voffA);
            PG8_WAIT_V(8); PG8_WAIT_L(0); PG8_BAR; PG8_MMA(0, 0, At, B0); PG8_MMA(0, 1, At, B1); PG8_BAR; PG8_SCHED;
            PG8_LDA(At, 0, 1); PG8_STAGE(PG8_SB(0, 0), b2, voffB); PG8_STAGE(PG8_SB(0, 1), b2 + hstepB, voffB); PG8_STAGE(PG8_SA(0, 0), a2, voffA);
            PG8_WAIT_V(8); PG8_WAIT_L(0); PG8_BAR; PG8_MMA(1, 0, At, B0); PG8_MMA(1, 1, At, B1); PG8_BAR; PG8_SCHED;
            PG8_LDB(B0, 1, 0); PG8_LDB(B1, 1, 1); PG8_SCHED; PG8_LDA(At, 1, 0); PG8_STAGE(PG8_SA(0, 1), a2 + hstepA, voffA);
            PG8_WAIT_V(8); PG8_WAIT_L(0); PG8_BAR; PG8_MMA(0, 0, At, B0); PG8_MMA(0, 1, At, B1); PG8_BAR; PG8_SCHED;
            PG8_LDA(At, 1, 1); PG8_STAGE(PG8_SB(1, 0), b3, voffB); PG8_STAGE(PG8_SB(1, 1), b3 + hstepB, voffB); PG8_STAGE(PG8_SA(1, 0), a3, voffA);
            PG8_WAIT_V(8); PG8_WAIT_L(0); PG8_BAR; PG8_MMA(1, 0, At, B0); PG8_MMA(1, 1, At, B1); PG8_BAR; PG8_SCHED;
            } else {
            PG8_LDB(B0, 0, 0); PG8_SCHED; PG8_LDA(At, 0, 0); PG8_STAGE(PG8_SA(1, 1), a1 + hstepA, voffA);
            PG8_WAIT_L(8); PG8_BAR; PG8_WAIT_L(0); PG8_MMA(0, 0, At, B0); PG8_BAR; PG8_SCHED;
            PG8_LDB(B1, 0, 1); PG8_STAGE(PG8_SB(0, 0), b2, voffB);
            PG8_BAR; PG8_WAIT_L(0); PG8_MMA(0, 1, At, B1); PG8_BAR;
            PG8_LDA(At, 0, 1); PG8_STAGE(PG8_SA(0, 0), a2, voffA);
            PG8_BAR; PG8_WAIT_L(0); PG8_MMA(1, 0, At, B0); PG8_BAR; PG8_SCHED;
            PG8_STAGE(PG8_SB(0, 1), b2 + hstepB, voffB);
            PG8_WAIT_V(6); PG8_BAR; PG8_MMA(1, 1, At, B1); PG8_BAR;
            PG8_LDB(B0, 1, 0); PG8_SCHED; PG8_LDA(At, 1, 0); PG8_STAGE(PG8_SA(0, 1), a2 + hstepA, voffA);
            PG8_WAIT_L(8); PG8_BAR; PG8_WAIT_L(0); PG8_MMA(0, 0, At, B0); PG8_BAR; PG8_SCHED;
            PG8_LDB(B1, 1, 1); PG8_STAGE(PG8_SB(1, 0), b3, voffB);
            PG8_BAR; PG8_WAIT_L(0); PG8_MMA(0, 1, At, B1); PG8_BAR;
            PG8_LDA(At, 1, 1); PG8_STAGE(PG8_SA(1, 0), a3, voffA);
            PG8_BAR; PG8_WAIT_L(0); PG8_MMA(1, 0, At, B0); PG8_BAR; PG8_SCHED;
            PG8_STAGE(PG8_SB(1, 1), b3 + hstepB, voffB);
            PG8_WAIT_V(6); PG8_BAR; PG8_MMA(1, 1, At, B1); PG8_BAR;
            }
        }
        if constexpr (ALIGN_EPI) { if (wr == 0) PG8_BAR; }
        if constexpr (!Epi::AFTER_DRAIN) { E(acc, cur, wr, wc, fr, fq); S.done(cur); }
        if (!has_next) break;
#pragma unroll
        for (int a = 0; a < 2; ++a)
#pragma unroll
            for (int b = 0; b < 2; ++b)
#pragma unroll
                for (int m = 0; m < 4; ++m)
#pragma unroll
                    for (int n = 0; n < 2; ++n) acc[a][b][m][n] = (f32x4){0.f, 0.f, 0.f, 0.f};
        cur = nxt; cA = nA; cB = nB; ++ui;
        if constexpr (ALIGN_EPI) { if (wr == 1) PG8_BAR; }
    }
    PG8_WAIT_V(0);
    if constexpr (!ALIGN_EPI) { if (wr == 0) PG8_BAR; }
    PG8_BAR;
    if constexpr (Epi::AFTER_DRAIN) { E.fused(acc, cur, wr, wc, fr, fq, lds, wid, lane); S.done(cur); }
#undef PG8_BTILE
#undef PG8_SA
#undef PG8_SB
#undef PG8_STAGE
#undef PG8_LDA
#undef PG8_LDB
#undef PG8_MMA
#undef PG8_WAIT_V
#undef PG8_WAIT_L
#undef PG8_BAR
#undef PG8_SCHED
}
}

constexpr int NWAVES = 8;
constexpr int RING_OFF = 0, RING_BYTES = 131072;
constexpr int LDSCTL_OFF = RING_BYTES, MISC_OFF = LDSCTL_OFF + 320;
constexpr int LDS_BYTES = 147456;

struct Args { const float* in[52]; float* out; unsigned char* ws; };
static_assert(sizeof(Args) == 432, "kernarg layout");

struct Frame {
    LAS unsigned char* lds; int tid, lane, wave, G, blk;
    const float* const* in; float* out; unsigned char* ws;
};
#define INP(i) INPD(i)
#define KARG() ({ const unsigned char __attribute__((address_space(4)))* k_ = (const unsigned char __attribute__((address_space(4)))*)__builtin_amdgcn_kernarg_segment_ptr(); asm volatile("" : "+s"(k_)); k_; })
#define INPD(i) (*(const float* const __attribute__((address_space(4)))*)(KARG() + 8 * (i)))

template <class Src>
DEVI void cvt_item(const Src src, bf16* WT, int Kd, int nblk, LAS float* scr, int item, int lane) {
    const int kb = item / nblk, nb = item % nblk, k0 = 64 * kb, n0 = 32 * nb;
    const int kr = lane >> 3, nq = (lane & 7) * 4;
    f32x4 v[8];
#pragma unroll
    for (int i = 0; i < 8; ++i) v[i] = src.load4(k0 + 8 * i + kr, n0 + nq);
#pragma unroll
    for (int i = 0; i < 8; ++i) { LAS float* s = scr + (8 * i + kr) * 33 + nq; s[0] = v[i][0]; s[1] = v[i][1]; s[2] = v[i][2]; s[3] = v[i][3]; }
    LDS_WAIT(); asm volatile("" ::: "memory");
    const int c = lane & 7;
#pragma unroll
    for (int j = 0; j < 4; ++j) { const int n = (lane >> 3) + 8 * j; const LAS float* s = scr + (8 * c) * 33 + n;
        v4u o; o.x = pk2(s[0 * 33], s[1 * 33]); o.y = pk2(s[2 * 33], s[3 * 33]); o.z = pk2(s[4 * 33], s[5 * 33]); o.w = pk2(s[6 * 33], s[7 * 33]);
        *(GAS v4u*)(WT + (size_t)(n0 + n) * Kd + k0 + 8 * c) = o; }
    LDS_WAIT(); asm volatile("" ::: "memory");
}
struct SrcPlain { const float* W; int K, N, ld; DEVI f32x4 load4(int k, int n) const { return (k < K && n < N) ? *(const f32x4*)(W + (size_t)k * ld + n) : (f32x4){0.f, 0.f, 0.f, 0.f}; } };
struct SrcFold { const float* W; const float* mu; int ld; DEVI f32x4 load4(int k, int n) const { const int kk = k & 1023; const float m = mu[kk]; return *(const f32x4*)(W + (size_t)kk * ld + n) * (k < 1024 ? m : (1.0f - m)); } };
struct SrcBlk { const float* W; int k0, k1; DEVI f32x4 load4(int k, int n) const { return (k >= k0 && k < k1) ? *(const f32x4*)(W + (size_t)(k - k0) * 1024 + n) : (f32x4){0.f, 0.f, 0.f, 0.f}; } };
struct SrcZero { DEVI f32x4 load4(int, int) const { return (f32x4){0.f, 0.f, 0.f, 0.f}; } };

DEVI void sincos_d(double x, double& s, double& c) {
    const double n = rint(x * 0.63661977236758134308);
    double r = fma(-n, 1.57079632679489655800e+00, x); r = fma(-n, 6.12323399573676603587e-17, r);
    const double r2 = r * r;
    double sp = -7.6471637318198164759e-13; sp = fma(sp, r2, 1.6059043836821614599e-10); sp = fma(sp, r2, -2.5052108385441718775e-08); sp = fma(sp, r2, 2.7557319223985890653e-06);
    sp = fma(sp, r2, -1.9841269841269841270e-04); sp = fma(sp, r2, 8.3333333333333333333e-03); sp = fma(sp, r2, -1.6666666666666666667e-01); const double sr = fma(sp * r2, r, r);
    double cp = 4.7794773323873852974e-14; cp = fma(cp, r2, -1.1470745597729724714e-11); cp = fma(cp, r2, 2.0876756987868098979e-09); cp = fma(cp, r2, -2.7557319223985890653e-07);
    cp = fma(cp, r2, 2.4801587301587301587e-05); cp = fma(cp, r2, -1.3888888888888888889e-03); cp = fma(cp, r2, 4.1666666666666666667e-02); cp = fma(cp, r2, -0.5); const double cr = fma(cp, r2, 1.0);
    const int q = ((int)n) & 3;
    s = (q == 0) ? sr : (q == 1) ? cr : (q == 2) ? -sr : -cr;
    c = (q == 0) ? cr : (q == 1) ? -sr : (q == 2) ? -cr : sr;
}
DEVI void s5prep_one(int i, const float* a_re, const float* a_im, const float* log_step, const float* b_re, const float* b_im, float* sp) {
    const int g = i >> 6;
    const double dt = exp((double)log_step[g]), ar = a_re[i], ai = a_im[i];
    const double mag = exp(ar * dt); double s, c; sincos_d(ai * dt, s, c);
    const double abr = mag * c, abi = mag * s, den = ar * ar + ai * ai, nr = abr - 1.0;
    const double zr = (nr * ar + abi * ai) / den, zi = (abi * ar - nr * ai) / den;
    sp[i] = (float)abr; sp[2048 + i] = (float)abi;
    for (int cc = 0; cc < 16; ++cc) { const double br = b_re[i * 16 + cc], bi = b_im[i * 16 + cc];
        sp[4096 + i * 16 + cc] = (float)(zr * br - zi * bi); sp[4096 + 32768 + i * 16 + cc] = (float)(zr * bi + zi * br); }
}


constexpr int SP_PW = 4096 + 65536;
DEVI void s5prep_pw(int i, int tau, const float* a_re, const float* a_im, const float* log_step, float* sp) {
    const int g = i >> 6; const double dt = exp((double)log_step[g]), ar = a_re[i], ai = a_im[i];
    const double mag = exp(ar * dt * tau); double s, c; sincos_d(ai * dt * tau, s, c); sp[SP_PW + i * 34 + tau * 2] = (float)(mag * c); sp[SP_PW + i * 34 + tau * 2 + 1] = (float)(mag * s);
}
DEVI void s5_tm_job(int g, int tau, int lane, const float* sp, const float* c_re, const float* c_im, const float* dd, bf16* TM) {
    bf16* tm = TM + (size_t)g * 256 * 384;
    if (tau <= 15) {
        const int co = lane >> 2, ci0 = (lane & 3) * 4; float kv[4] = {0.f, 0.f, 0.f, 0.f};
#pragma unroll 8
        for (int p = 0; p < 64; ++p) { const float pr = sp[SP_PW + (g * 64 + p) * 34 + tau * 2], pi = sp[SP_PW + (g * 64 + p) * 34 + tau * 2 + 1];
            const float cr = c_re[(g * 16 + co) * 64 + p], ci = c_im[(g * 16 + co) * 64 + p];
            const f32x4 br = *(const f32x4*)(sp + 4096 + (g * 64 + p) * 16 + ci0), bi = *(const f32x4*)(sp + 4096 + 32768 + (g * 64 + p) * 16 + ci0);
#pragma unroll
            for (int q = 0; q < 4; ++q) { const float wr = pr * br[q] - pi * bi[q], wi = pr * bi[q] + pi * br[q]; kv[q] += cr * wr - ci * wi; } }
        if (tau == 0) {
#pragma unroll
            for (int q = 0; q < 4; ++q) if (ci0 + q == co) kv[q] += dd[g * 16 + co]; }
        const unsigned long long pk = (unsigned long long)pk2(kv[0], kv[1]) | ((unsigned long long)pk2(kv[2], kv[3]) << 32);
        for (int t = tau; t < 16; ++t) *(unsigned long long*)(tm + (size_t)(t * 16 + co) * 384 + (t - tau) * 16 + ci0) = pk;
        if (tau >= 1) for (int t = 0; t + tau < 16; ++t) *(unsigned long long*)(tm + (size_t)(t * 16 + co) * 384 + (t + tau) * 16 + ci0) = 0ull;
    }
    if (tau >= 1) { const int t = tau - 1, p = lane; const float pr = sp[SP_PW + (g * 64 + p) * 34 + tau * 2], pi = sp[SP_PW + (g * 64 + p) * 34 + tau * 2 + 1];
#pragma unroll
        for (int co = 0; co < 16; ++co) { const float cr = c_re[(g * 16 + co) * 64 + p], ci = c_im[(g * 16 + co) * 64 + p];
            tm[(size_t)(t * 16 + co) * 384 + 256 + p] = (bf16)f2bf(cr * pr - ci * pi); tm[(size_t)(t * 16 + co) * 384 + 320 + p] = (bf16)f2bf(-(cr * pi + ci * pr)); } }
}
DEVI void s5_hm_job(int g, int s, int lane, const float* sp, bf16* HM) {
    const int p = lane; const float pr = sp[SP_PW + (g * 64 + p) * 34 + (15 - s) * 2], pi = sp[SP_PW + (g * 64 + p) * 34 + (15 - s) * 2 + 1];
    bf16* hr = HM + ((size_t)g * 256 + p) * 256 + s * 16; bf16* hi = hr + 64 * 256;
#pragma unroll
    for (int h8 = 0; h8 < 2; ++h8) { float wr[8], wi[8];
#pragma unroll
        for (int q = 0; q < 8; ++q) { const float br = sp[4096 + (g * 64 + p) * 16 + h8 * 8 + q], bi = sp[4096 + 32768 + (g * 64 + p) * 16 + h8 * 8 + q]; wr[q] = pr * br - pi * bi; wi[q] = pr * bi + pi * br; }
        v4u a, b; a.x = pk2(wr[0], wr[1]); a.y = pk2(wr[2], wr[3]); a.z = pk2(wr[4], wr[5]); a.w = pk2(wr[6], wr[7]); b.x = pk2(wi[0], wi[1]); b.y = pk2(wi[2], wi[3]); b.z = pk2(wi[4], wi[5]); b.w = pk2(wi[6], wi[7]);
        *(v4u*)(hr + h8 * 8) = a; *(v4u*)(hi + h8 * 8) = b; }
}
DEVI void s5_carry_job(int b, int g, int lane, const float* sp, const float* HL, bf16* UB, float* ore, float* oim) {
    const int p = lane; const float ar = sp[SP_PW + (g * 64 + p) * 34 + 32], ai = sp[SP_PW + (g * 64 + p) * 34 + 33];
    float cr = 0.f, ci = 0.f;
#pragma unroll 8
    for (int n = 0; n < 128; ++n) { const size_t row = (size_t)g * 1024 + b * 128 + n;
        UB[row * 384 + 256 + p] = (bf16)f2bf(cr); UB[row * 384 + 320 + p] = (bf16)f2bf(ci);
        const float hr = HL[row * 128 + p], hi = HL[row * 128 + 64 + p];
        const float nr = ar * cr - ai * ci + hr, ni = ar * ci + ai * cr + hi; cr = nr; ci = ni; }
    ore[((size_t)b * 32 + g) * 64 + p] = cr; oim[((size_t)b * 32 + g) * 64 + p] = ci;
}


template <int NT> DEVI void mods_half(int m0, int l, int n0, int lane, const float* __restrict__ ST, const float* __restrict__ ada_w, const float* __restrict__ ada_b, float* MODS) {
    const int i16 = lane & 15, kq = lane >> 4;
    f32x4 acc[NT];
#pragma unroll
    for (int m = 0; m < NT; ++m) acc[m] = (f32x4){0.f, 0.f, 0.f, 0.f};
    const float* w = ada_w + (size_t)l * 1024 * 9216 + (size_t)kq * 9216 + n0 + i16; const float* st = ST + kq * 144 + i16 + m0 * 16;
    float a[4][NT], bv[4];
#pragma unroll
    for (int s = 0; s < 4; ++s) { bv[s] = w[(size_t)(4 * s) * 9216];
#pragma unroll
        for (int m = 0; m < NT; ++m) a[s][m] = st[(4 * s) * 144 + m * 16]; }
    for (int k0 = 0; k0 < 1024; k0 += 16) {
#pragma unroll
        for (int s = 0; s < 4; ++s) {
#pragma unroll
            for (int m = 0; m < NT; ++m) acc[m] = __builtin_amdgcn_mfma_f32_16x16x4f32(a[s][m], bv[s], acc[m], 0, 0, 0);
            const int kn = k0 + 16 + 4 * s; if (kn < 1024) { bv[s] = w[(size_t)kn * 9216];
#pragma unroll
                for (int m = 0; m < NT; ++m) a[s][m] = st[kn * 144 + m * 16]; } } }
    const float bb = ada_b[l * 9216 + n0 + i16];
#pragma unroll
    for (int m = 0; m < NT; ++m)
#pragma unroll
        for (int q = 0; q < 4; ++q) { const int r = (m0 + m) * 16 + kq * 4 + q; if (r < NMODROW) MODS[((size_t)l * NMODROW + r) * 9216 + n0 + i16] = acc[m][q] + bb; }
}
DEVI void mods_job(int job, int lane, const float* __restrict__ ST, const float* __restrict__ ada_w, const float* __restrict__ ada_b, float* MODS) {
    asm volatile("" : "+v"(lane));
    const int mh = job & 1, jb = job >> 1, l = jb / 576, n0 = (jb % 576) * 16;
    if (mh) mods_half<4>(5, l, n0, lane, ST, ada_w, ada_b, MODS); else mods_half<5>(0, l, n0, lane, ST, ada_w, ada_b, MODS);
}

DEVI void mods_job3(int cg, int rs, int lane, const float* __restrict__ ST, const float* __restrict__ ada_w, const float* __restrict__ ada_b, float* MODS) {
    asm volatile("" : "+v"(lane));
    const int l = cg / 144, n0 = (cg % 144) * 64, i16 = lane & 15, kq = lane >> 4;
    f32x4 acc[3][4];
#pragma unroll
    for (int m = 0; m < 3; ++m)
#pragma unroll
        for (int c = 0; c < 4; ++c) acc[m][c] = (f32x4){0.f, 0.f, 0.f, 0.f};
    const float* w = ada_w + (size_t)l * 1024 * 9216 + (size_t)kq * 9216 + n0 + 4 * i16; const float* st = ST + kq * 144 + rs * 48 + i16;
    constexpr int DEP = 8;
    f32x4 bv[DEP]; float a[DEP][3];
#define MODS_LD(s, kn) do { const float* wp_ = w + (size_t)(kn) * 9216; const float* sp_ = st + (kn) * 144; \
        asm volatile("global_load_dwordx4 %0, %1, off" : "=v"(bv[s]) : "v"(wp_) : "memory"); \
        asm volatile("global_load_dword %0, %1, off" : "=v"(a[s][0]) : "v"(sp_) : "memory"); \
        asm volatile("global_load_dword %0, %1, off offset:64" : "=v"(a[s][1]) : "v"(sp_) : "memory"); \
        asm volatile("global_load_dword %0, %1, off offset:128" : "=v"(a[s][2]) : "v"(sp_) : "memory"); } while (0)
#define MODS_MM(s) do { _Pragma("unroll") for (int m = 0; m < 3; ++m) _Pragma("unroll") for (int c = 0; c < 4; ++c) acc[m][c] = __builtin_amdgcn_mfma_f32_16x16x4f32(a[s][m], bv[s][c], acc[m][c], 0, 0, 0); } while (0)
#define MODS_WAIT(s, n) asm volatile("s_waitcnt vmcnt(" #n ")" : "+v"(bv[s]), "+v"(a[s][0]), "+v"(a[s][1]), "+v"(a[s][2]) :: "memory")
#pragma unroll
    for (int s = 0; s < DEP; ++s) MODS_LD(s, 4 * s);
    for (int k0 = 0; k0 < 1024 - 4 * DEP; k0 += 4 * DEP) {
#pragma unroll
        for (int s = 0; s < DEP; ++s) { MODS_WAIT(s, 28); MODS_MM(s); MODS_LD(s, k0 + 4 * DEP + 4 * s); } }
    MODS_WAIT(0, 28); MODS_MM(0); MODS_WAIT(1, 24); MODS_MM(1); MODS_WAIT(2, 20); MODS_MM(2); MODS_WAIT(3, 16); MODS_MM(3);
    MODS_WAIT(4, 12); MODS_MM(4); MODS_WAIT(5, 8); MODS_MM(5); MODS_WAIT(6, 4); MODS_MM(6); MODS_WAIT(7, 0); MODS_MM(7);
#undef MODS_LD
#undef MODS_MM
#undef MODS_WAIT
    const f32x4 bb = *(const f32x4*)(ada_b + l * 9216 + n0 + 4 * i16);
#pragma unroll
    for (int m = 0; m < 3; ++m)
#pragma unroll
        for (int q = 0; q < 4; ++q) { const int r = (rs * 3 + m) * 16 + kq * 4 + q;
            if (r < NMODROW) *(f32x4*)(MODS + ((size_t)l * NMODROW + r) * 9216 + n0 + 4 * i16) = (f32x4){acc[m][0][q] + bb[0], acc[m][1][q] + bb[1], acc[m][2][q] + bb[2], acc[m][3][q] + bb[3]}; }
}

DEVI void init_row(int row, int lane, const float* xp, const float* xs, const float* mods, float* X, bf16* H, float* ZS) {
    if (row >= MT) { for (int j = 0; j < 16; ++j) H[(size_t)row * D + j * 64 + lane] = 0; return; }
    const float* src = row < NP ? xp + (size_t)row * D : xs + (size_t)(row - NP) * D;
    const float* sh = modp(mods, 0, 0) + (size_t)mrow(row) * 9216; const float* sc = modp(mods, 0, 1) + (size_t)mrow(row) * 9216;
#pragma unroll
    for (int j = 0; j < 4; ++j) { const int c = j * 256 + lane * 4; const f32x4 v = *(const f32x4*)(src + c), a = *(const f32x4*)(sc + c), b = *(const f32x4*)(sh + c);
        *(f32x4*)(X + (size_t)row * D + c) = v; if (row >= NP) *(f32x4*)(ZS + (size_t)(row - NP) * D + c) = v * ALPHA; const f32x4 h = v * (a + 1.0f) + b;
        *(unsigned long long*)(H + (size_t)row * D + c) = (unsigned long long)pk2(h[0], h[1]) | ((unsigned long long)pk2(h[2], h[3]) << 32); }
}
DEVI void ln_row(int row, int lane, const float* Z, float* ZS, const float* SL, int nsl, const float* g, const float* b, float* X, bf16* H, const float* sh, const float* sc) {
    const float* z = row < NP ? Z + (size_t)row * D : ZS + (size_t)(row - NP) * D; f32x4 v[4]; float s = 0.f;
#pragma unroll
    for (int j = 0; j < 4; ++j) v[j] = *(const f32x4*)(z + j * 256 + lane * 4);
    if (row >= NP) for (int q = 0; q < nsl; ++q) {
#pragma unroll
        for (int j = 0; j < 4; ++j) v[j] = v[j] + *(const f32x4*)(SL + ((size_t)q * 128 + (row - NP)) * D + j * 256 + lane * 4); }
#pragma unroll
    for (int j = 0; j < 4; ++j) s += (v[j][0] + v[j][1]) + (v[j][2] + v[j][3]);
    const float mean = wave_sum(s) * (1.f / D); float q = 0.f;
#pragma unroll
    for (int j = 0; j < 4; ++j) { v[j] = v[j] - mean; q += (v[j][0] * v[j][0] + v[j][1] * v[j][1]) + (v[j][2] * v[j][2] + v[j][3] * v[j][3]); }
    const float rstd = rsqrtf(wave_sum(q) * (1.f / D) + 1e-5f);
    const int mr = mrow(row);
#pragma unroll
    for (int j = 0; j < 4; ++j) { const int c = j * 256 + lane * 4; const f32x4 x = v[j] * rstd * *(const f32x4*)(g + c) + *(const f32x4*)(b + c); *(f32x4*)(X + (size_t)row * D + c) = x; if (row >= NP) *(f32x4*)(ZS + (size_t)(row - NP) * D + c) = x * ALPHA;
        if (H) { const f32x4 h = x * (*(const f32x4*)(sc + (size_t)mr * 9216 + c) + 1.0f) + *(const f32x4*)(sh + (size_t)mr * 9216 + c);
            *(unsigned long long*)(H + (size_t)row * D + c) = (unsigned long long)pk2(h[0], h[1]) | ((unsigned long long)pk2(h[2], h[3]) << 32); } }
}
DEVI void ln_shift_rows(int row0, int n, int lane, const float* Z, float* ZS, const float* g, const float* b, float* X, const float* mods, const float* shift_in, bf16* A2, float* out) {
    f32x4 prev[4], gg[4], bb[4];
#pragma unroll
    for (int j = 0; j < 4; ++j) { gg[j] = *(const f32x4*)(g + j * 256 + lane * 4); bb[j] = *(const f32x4*)(b + j * 256 + lane * 4); prev[j] = (f32x4){0.f, 0.f, 0.f, 0.f}; }
    for (int r = ((row0 < NP && (row0 & 2047) != 0) ? row0 - 1 : row0); r < row0 + n; ++r) {
        const bool warm = r < row0;
        const float* z = r < NP ? Z + (size_t)r * D : ZS + (size_t)(r - NP) * D; f32x4 v[4]; float s = 0.f;
#pragma unroll
        for (int j = 0; j < 4; ++j) { v[j] = *(const f32x4*)(z + j * 256 + lane * 4); s += (v[j][0] + v[j][1]) + (v[j][2] + v[j][3]); }
        const float mean = wave_sum(s) * (1.f / D); float q = 0.f;
#pragma unroll
        for (int j = 0; j < 4; ++j) { v[j] = v[j] - mean; q += (v[j][0] * v[j][0] + v[j][1] * v[j][1]) + (v[j][2] * v[j][2] + v[j][3] * v[j][3]); }
        const float rstd = rsqrtf(wave_sum(q) * (1.f / D) + 1e-5f);
        const int mr = mrow(r); const float* sh = modp(mods, 1, 3) + (size_t)mr * 9216; const float* sc = modp(mods, 1, 4) + (size_t)mr * 9216;
        const bool prompt = r < NP; const int t = r & 2047;
#pragma unroll
        for (int j = 0; j < 4; ++j) { const int c = j * 256 + lane * 4; const f32x4 x = v[j] * rstd * gg[j] + bb[j]; const f32x4 h = x * (*(const f32x4*)(sc + c) + 1.0f) + *(const f32x4*)(sh + c);
            if (!warm) { *(f32x4*)(X + (size_t)r * D + c) = x; if (r >= NP) *(f32x4*)(ZS + (size_t)(r - NP) * D + c) = x * ALPHA;
                f32x4 pv = prev[j]; if (!prompt) pv = *(const f32x4*)(shift_in + (size_t)(r - NP) * D + c); else if (t == 0) pv = (f32x4){0.f, 0.f, 0.f, 0.f};
                *(unsigned long long*)(A2 + (size_t)r * KRK + c) = (unsigned long long)pk2(pv[0], pv[1]) | ((unsigned long long)pk2(pv[2], pv[3]) << 32);
                *(unsigned long long*)(A2 + (size_t)r * KRK + 1024 + c) = (unsigned long long)pk2(h[0], h[1]) | ((unsigned long long)pk2(h[2], h[3]) << 32);
                if (prompt) { if (t == 2047) *(f32x4*)(out + O_SHIFT_P + (size_t)(r >> 11) * D + c) = h; } else *(f32x4*)(out + O_SHIFT_S + (size_t)(r - NP) * D + c) = h; }
            prev[j] = h; }
    }
}
DEVI void shiftcat_row(int row, int lane, const float* X, const float* mods, const float* shift_in, bf16* A2, float* out) {
    if (row >= MT) { for (int j = 0; j < 8; ++j) *(unsigned long long*)(A2 + (size_t)row * KRK + j * 256 + lane * 4) = 0ull; return; }
    const int mr = mrow(row); const float* sh = modp(mods, 1, 3) + (size_t)mr * 9216; const float* sc = modp(mods, 1, 4) + (size_t)mr * 9216;
    const bool prompt = row < NP; const int t = row & 2047;
#pragma unroll
    for (int j = 0; j < 4; ++j) { const int c = j * 256 + lane * 4; const f32x4 a = *(const f32x4*)(sc + c) + 1.0f, b = *(const f32x4*)(sh + c);
        const f32x4 h = *(const f32x4*)(X + (size_t)row * D + c) * a + b; f32x4 pv;
        if (prompt) pv = t == 0 ? (f32x4){0.f, 0.f, 0.f, 0.f} : *(const f32x4*)(X + (size_t)(row - 1) * D + c) * a + b; else pv = *(const f32x4*)(shift_in + (size_t)(row - NP) * D + c);
        *(unsigned long long*)(A2 + (size_t)row * KRK + c) = (unsigned long long)pk2(pv[0], pv[1]) | ((unsigned long long)pk2(pv[2], pv[3]) << 32);
        *(unsigned long long*)(A2 + (size_t)row * KRK + 1024 + c) = (unsigned long long)pk2(h[0], h[1]) | ((unsigned long long)pk2(h[2], h[3]) << 32);
        if (prompt) { if (t == 2047) *(f32x4*)(out + O_SHIFT_P + (size_t)(row >> 11) * D + c) = h; } else *(f32x4*)(out + O_SHIFT_S + (size_t)(row - NP) * D + c) = h; }
}
DEVI void gla_post_one(int w, int lane, const float* OG, const bf16* P, const float* norm_g, bf16* O) {
    const int tok = w >> 2, h = w & 3;
    const float o0 = OG[(size_t)tok * 512 + h * 128 + lane], o1 = OG[(size_t)tok * 512 + h * 128 + 64 + lane];
    const float ms = wave_sum(o0 * o0 + o1 * o1) * (1.f / 128.f), r = rsqrtf(ms + 1e-5f);
    const float g0 = bf2f(P[(size_t)tok * NINP + 1024 + h * 128 + lane]), g1 = bf2f(P[(size_t)tok * NINP + 1024 + h * 128 + 64 + lane]);
    O[(size_t)tok * D + h * 128 + lane] = (bf16)f2bf(o0 * r * norm_g[lane] * siluf_(g0));
    O[(size_t)tok * D + h * 128 + 64 + lane] = (bf16)f2bf(o1 * r * norm_g[64 + lane] * siluf_(g1));
}

DEVI void gla_job(LAS float* scr, int lane, int b, int h, int half, const bf16* P, const float* GKL, const float* w_gk, const float* b_gk, int tok_base, int T, const float* s0, float* s_out, float* OG) {
    LAS float* sdec = scr; LAS float* sq = scr + 1024; LAS float* sk = scr + 2048;
    const int dv = half * 64 + lane;
    float S[64];
#pragma unroll
    for (int i = 0; i < 64; ++i) S[i] = s0 ? s0[(((size_t)b * 4 + h) * 64 + i) * 128 + dv] : 0.f;
    float wg[16];
#pragma unroll
    for (int r = 0; r < 16; ++r) wg[r] = w_gk[r * 256 + h * 64 + lane];
    const float bg = b_gk[h * 64 + lane];
    for (int t0 = 0; t0 < T; t0 += 16) { const int nt = (T - t0) < 16 ? (T - t0) : 16;
        for (int tt = 0; tt < nt; ++tt) { const size_t tok = (size_t)tok_base + (size_t)b * T + t0 + tt; float x = bg;
#pragma unroll
            for (int r = 0; r < 16; ++r) x += GKL[tok * 16 + r] * wg[r];
            const float ls = fminf(x, 0.f) - log1pf(__expf(-fabsf(x)));
            sdec[tt * 64 + lane] = __expf(ls * (1.f / 16.f)); sq[tt * 64 + lane] = bf2f(P[tok * NINP + h * 64 + lane]) * 0.125f; sk[tt * 64 + lane] = bf2f(P[tok * NINP + 256 + h * 64 + lane]); }
        LDS_WAIT(); asm volatile("" ::: "memory");
        for (int tt = 0; tt < nt; ++tt) { const size_t tok = (size_t)tok_base + (size_t)b * T + t0 + tt;
            const float v = bf2f(P[tok * NINP + 512 + h * 128 + dv]); float o = 0.f;
#pragma unroll
            for (int i = 0; i < 64; ++i) { S[i] = S[i] * sdec[tt * 64 + i] + sk[tt * 64 + i] * v; o += sq[tt * 64 + i] * S[i]; }
            OG[tok * 512 + h * 128 + dv] = o; }
        LDS_WAIT(); asm volatile("" ::: "memory");
    }
#pragma unroll
    for (int i = 0; i < 64; ++i) s_out[(((size_t)b * 4 + h) * 64 + i) * 128 + dv] = S[i];
}
DEVI void s5_job(LAS float* scr, int lane, int g, int b0, int nb, const bf16* P, const float* sp, const float* c_re, const float* c_im, const float* dd, int tok_base, int T,
                 const float* h0re, const float* h0im, float* ore, float* oim, bf16* Z5) {
    const int p = lane, c = p & 15, pq = p >> 4;
    const float abr = sp[g * 64 + p], abi = sp[2048 + g * 64 + p];
    float bbr[16], bbi[16], cr[16], ci[16];
#pragma unroll
    for (int i = 0; i < 16; ++i) { bbr[i] = sp[4096 + (g * 64 + p) * 16 + i]; bbi[i] = sp[4096 + 32768 + (g * 64 + p) * 16 + i];
        cr[i] = c_re[(g * 16 + c) * 64 + pq * 16 + i]; ci[i] = c_im[(g * 16 + c) * 64 + pq * 16 + i]; }
    const float dv = dd[g * 16 + c];
    for (int b = b0; b < b0 + nb; ++b) {
        float hr = h0re ? h0re[((size_t)b * 32 + g) * 64 + p] : 0.f, hi = h0im ? h0im[((size_t)b * 32 + g) * 64 + p] : 0.f;
        for (int t = 0; t < T; ++t) { const size_t tok = (size_t)tok_base + (size_t)b * T + t;
            const bf16* up = P + tok * NINP + 1552 + g * 16; float u[16];
#pragma unroll
            for (int i = 0; i < 16; ++i) u[i] = bf2f(up[i]);
            const float uc = bf2f(up[c]);
            float br = 0.f, bi = 0.f;
#pragma unroll
            for (int i = 0; i < 16; ++i) { br += u[i] * bbr[i]; bi += u[i] * bbi[i]; }
            const float nr = abr * hr - abi * hi + br, ni = abr * hi + abi * hr + bi; hr = nr; hi = ni;
            LAS float* hs = scr + (t & 1) * 128;
            hs[p] = hr; hs[64 + p] = hi;
            LDS_WAIT(); asm volatile("" ::: "memory");
            float y = 0.f;
#pragma unroll
            for (int i = 0; i < 16; ++i) y += cr[i] * hs[pq * 16 + i] - ci[i] * hs[64 + pq * 16 + i];
            y += __shfl_xor(y, 16); y += __shfl_xor(y, 32);
            if (p < 16) { y += dv * uc; Z5[tok * 512 + g * 16 + c] = (bf16)f2bf(gelu_tanh(y)); }
        }
        ore[((size_t)b * 32 + g) * 64 + p] = hr; oim[((size_t)b * 32 + g) * 64 + p] = hi;
        LDS_WAIT(); asm volatile("" ::: "memory");
    }
}
DEVI float wkv_decay(float w0, float raw) { const float x = -(w0 + raw); const float sp = fmaxf(x, 0.f) + log1pf(__expf(-fabsf(x))); return __expf(-__expf(-sp - 0.5f)); }
DEVI void wkv_job(LAS float* scr, int lane, int b, int h, const bf16* R, const bf16* Kb, const bf16* V, const bf16* WRAW, const float* w0p, const bf16* AS, bf16* GO, const float* k_k, const float* k_a, const float* r_k, const float* lnx_g, const float* lnx_b,
                  int tok_base, int T, const float* s0, float* s_out) {
    LAS float* sw = scr; LAS float* skm = scr + 512; LAS float* sa_ = scr + 1024; LAS float* sb = scr + 1536; LAS float* sr = scr + 2048; LAS float* sbon = scr + 2560;
    const int i = lane, ch = h * 64 + i;
    float S[64];
#pragma unroll
    for (int j = 0; j < 64; ++j) S[j] = s0 ? s0[(((size_t)b * 16 + h) * 64 + i) * 64 + j] : 0.f;
    const float kkc = k_k[ch], kac = k_a[ch], rkc = r_k[ch], lg = lnx_g[ch], lb = lnx_b[ch];
    for (int t0 = 0; t0 < T; t0 += 8) { const int nt = (T - t0) < 8 ? (T - t0) : 8;
        for (int tt = 0; tt < nt; ++tt) { const size_t tok = (size_t)tok_base + (size_t)b * T + t0 + tt;
            const float k = bf2f(Kb[tok * D + ch]), r = bf2f(R[tok * D + ch]), a = bf2f(AS[tok * D + ch]), w = wkv_decay(w0p[ch], bf2f(WRAW[tok * D + ch]));
            float kk = k * kkc; const float nrm = sqrtf(wave_sum(kk * kk)); kk = kk / fmaxf(nrm, 1e-12f);
            const float km = k * (1.f + (a - 1.f) * kac);
            sw[tt * 64 + i] = w; skm[tt * 64 + i] = km; sa_[tt * 64 + i] = -kk; sb[tt * 64 + i] = kk * a; sr[tt * 64 + i] = r;
            const float bon = wave_sum(r * km * rkc); if (i == 0) sbon[tt] = bon; }
        LDS_WAIT(); asm volatile("" ::: "memory");
        for (int tt = 0; tt < nt; ++tt) { const size_t tok = (size_t)tok_base + (size_t)b * T + t0 + tt;
            const float v = bf2f(V[tok * D + ch]); float sa = 0.f;
#pragma unroll
            for (int j = 0; j < 64; ++j) sa += S[j] * sa_[tt * 64 + j];
            float y = 0.f;
#pragma unroll
            for (int j = 0; j < 64; ++j) { S[j] = S[j] * sw[tt * 64 + j] + sa * sb[tt * 64 + j] + v * skm[tt * 64 + j]; y += S[j] * sr[tt * 64 + j]; }
            const float mean = wave_sum(y) * (1.f / 64.f), dy = y - mean, var = wave_sum(dy * dy) * (1.f / 64.f);
            float yn = dy * rsqrtf(var + 64e-5f) * lg + lb; yn += sbon[tt] * v;
            const float gt = bf2f(GO[tok * D + ch]); GO[tok * D + ch] = (bf16)f2bf(yn * gt); }
        LDS_WAIT(); asm volatile("" ::: "memory");
    }
#pragma unroll
    for (int j = 0; j < 64; ++j) s_out[(((size_t)b * 16 + h) * 64 + i) * 64 + j] = S[j];
}

DEVI float dpp_add(float v, const int ctrl_sel) {
    int r;
    switch (ctrl_sel) {
    case 0: r = __builtin_amdgcn_update_dpp(0, __builtin_bit_cast(int, v), 0xB1, 0xF, 0xF, true); break;
    case 1: r = __builtin_amdgcn_update_dpp(0, __builtin_bit_cast(int, v), 0x4E, 0xF, 0xF, true); break;
    case 2: r = __builtin_amdgcn_update_dpp(0, __builtin_bit_cast(int, v), 0x141, 0xF, 0xF, true); break;
    default: r = __builtin_amdgcn_update_dpp(0, __builtin_bit_cast(int, v), 0x140, 0xF, 0xF, true); break;
    }
    return v + __builtin_bit_cast(float, r);
}
DEVI float red16(float v) { v = dpp_add(v, 0); v = dpp_add(v, 1); v = dpp_add(v, 2); v = dpp_add(v, 3); return v; }
constexpr int WK_TB = 32;
constexpr int WK_W = 0, WK_KM = 2048, WK_NA = 4096, WK_BB = 6144, WK_WR = 8192, WK_V = 10240, WK_PB = 12800;
constexpr int WK_Y = 2 * WK_PB, WK_YB = 1024;
static_assert((WK_Y + 2 * WK_YB + 512 + 1200) * 4 <= RING_BYTES, "wkv lds");
struct WkvLoad { uint2 k, r, a, v, w; };
typedef float f32x2_t __attribute__((ext_vector_type(2)));
struct WkvOps { f32x4 na, wr, w4, bb, km, vv; };
DEVI float wkv_decay_fast(float w0, float raw) { const float x = -(w0 + raw); const float sp = fmaxf(x, 0.f) + 0.69314718056f * __builtin_amdgcn_logf(1.0f + __builtin_amdgcn_exp2f(-1.44269504089f * fabsf(x)));
    const float ee = __builtin_amdgcn_exp2f(-1.44269504089f * (sp + 0.5f)); return __builtin_amdgcn_exp2f(-1.44269504089f * ee); }
template <int MODE> DEVI void wkv_half(LAS float* L, int tid, int b, int h, int half, const bf16* R, const bf16* Kb, const bf16* V, const bf16* WRAW, const bf16* AS, const float* w0p,
                   const float* k_k, const float* k_a, const float* r_k, bf16* Y, float* BON, float* s_out) {
    asm volatile("" : "+v"(tid));
    const int rp = (tid >> 4) & 15, jq = tid & 15; const bool stepper = tid < 256;
    const int ch = h * 64 + 4 * jq, chv = h * 64 + half * 32 + 4 * (jq & 7);
    f32x4 S0 = {0.f, 0.f, 0.f, 0.f}, S1 = {0.f, 0.f, 0.f, 0.f};
    const size_t tokb = (size_t)b * TP;
    auto bf4 = [](uint2 u) -> f32x4 { f32x4 o; o[0] = __uint_as_float(u.x << 16); o[1] = __uint_as_float(u.x & 0xffff0000u); o[2] = __uint_as_float(u.y << 16); o[3] = __uint_as_float(u.y & 0xffff0000u); return o; };
#define WK_PREP1(bufidx, blkidx, tt_) do { LAS float* pb_ = L + (bufidx) * WK_PB; const size_t t_ = tokb + (size_t)(blkidx) * WK_TB + (tt_); const size_t o_ = t_ * D + ch; \
        const f32x4 k4 = bf4(*(const uint2*)(Kb + o_)), r4 = bf4(*(const uint2*)(R + o_)), a4 = bf4(*(const uint2*)(AS + o_)), wraw = bf4(*(const uint2*)(WRAW + o_)), v4 = bf4(*(const uint2*)(V + t_ * D + chv)); f32x4 w4; \
        _Pragma("unroll") for (int e_ = 0; e_ < 4; ++e_) w4[e_] = wkv_decay_fast(w0c[e_], wraw[e_]); \
        f32x4 kk = k4 * kkc; float ss = red16((kk[0] * kk[0] + kk[1] * kk[1]) + (kk[2] * kk[2] + kk[3] * kk[3])); const float inv = 1.0f / fmaxf(sqrtf(ss), 1e-12f); kk = kk * inv; \
        const f32x4 km = k4 * ((a4 - 1.0f) * kac + 1.0f); const f32x4 pr = r4 * km; const f32x4 prk = pr * rkc; const float bon = red16((prk[0] + prk[1]) + (prk[2] + prk[3])); \
        const f32x4 bbv = kk * a4; const f32x4 pb2 = bbv * r4; const float brs = red16((pb2[0] + pb2[1]) + (pb2[2] + pb2[3])), krs = red16((pr[0] + pr[1]) + (pr[2] + pr[3])); \
        *(LAS f32x4*)(pb_ + WK_W + (tt_) * 64 + 4 * jq) = w4; *(LAS f32x4*)(pb_ + WK_KM + (tt_) * 64 + 4 * jq) = km; *(LAS f32x4*)(pb_ + WK_NA + (tt_) * 64 + 4 * jq) = -kk; \
        *(LAS f32x4*)(pb_ + WK_BB + (tt_) * 64 + 4 * jq) = bbv; *(LAS f32x4*)(pb_ + WK_WR + (tt_) * 64 + 4 * jq) = w4 * r4 - kk * brs; \
        if (jq < 8) { *(LAS f32x4*)(pb_ + WK_V + (tt_) * 64 + 8 * jq) = (f32x4){v4[0], v4[1], v4[0] * krs, v4[1] * krs}; *(LAS f32x4*)(pb_ + WK_V + (tt_) * 64 + 8 * jq + 4) = (f32x4){v4[2], v4[3], v4[2] * krs, v4[3] * krs}; } \
        if (jq == 0 && half == 0) BON[t_ * 16 + h] = bon; } while (0)
#define WK_RD128(dst, ad, off) asm volatile("ds_read_b128 %0, %1 offset:%2" : "=v"(dst) : "v"(ad), "i"(off))
#define WK_LOADOPS(o_, dt_) do { WK_RD128((o_).na, aop, WK_NA * 4 + (dt_) * 256); WK_RD128((o_).wr, aop, WK_WR * 4 + (dt_) * 256); WK_RD128((o_).w4, aop, WK_W * 4 + (dt_) * 256); \
        WK_RD128((o_).bb, aop, WK_BB * 4 + (dt_) * 256); WK_RD128((o_).km, aop, WK_KM * 4 + (dt_) * 256); WK_RD128((o_).vv, av, (dt_) * 256); } while (0)
#define WK_WAIT(n_, o_) asm volatile("s_waitcnt lgkmcnt(" #n_ ")" : "+v"((o_).na), "+v"((o_).wr), "+v"((o_).w4), "+v"((o_).bb), "+v"((o_).km), "+v"((o_).vv))
#define WK_STEP(o_, dt_) do { \
        float sa0 = (S0[0] * (o_).na[0] + S0[1] * (o_).na[1]) + (S0[2] * (o_).na[2] + S0[3] * (o_).na[3]), sa1 = (S1[0] * (o_).na[0] + S1[1] * (o_).na[1]) + (S1[2] * (o_).na[2] + S1[3] * (o_).na[3]); \
        float y0 = (S0[0] * (o_).wr[0] + S0[1] * (o_).wr[1]) + (S0[2] * (o_).wr[2] + S0[3] * (o_).wr[3]), y1 = (S1[0] * (o_).wr[0] + S1[1] * (o_).wr[1]) + (S1[2] * (o_).wr[2] + S1[3] * (o_).wr[3]); \
        sa0 = dpp_add(sa0, 0); sa1 = dpp_add(sa1, 0); y0 = dpp_add(y0, 0); y1 = dpp_add(y1, 0); sa0 = dpp_add(sa0, 1); sa1 = dpp_add(sa1, 1); y0 = dpp_add(y0, 1); y1 = dpp_add(y1, 1); \
        sa0 = dpp_add(sa0, 2); sa1 = dpp_add(sa1, 2); y0 = dpp_add(y0, 2); y1 = dpp_add(y1, 2); sa0 = dpp_add(sa0, 3); sa1 = dpp_add(sa1, 3); y0 = dpp_add(y0, 3); y1 = dpp_add(y1, 3); \
        S0 = S0 * (o_).w4 + ((o_).bb * sa0 + (o_).km * (o_).vv[0]); S1 = S1 * (o_).w4 + ((o_).bb * sa1 + (o_).km * (o_).vv[1]); \
        f32x2_t yy; yy[0] = y0 + (o_).vv[2]; yy[1] = y1 + (o_).vv[3]; \
        asm volatile("ds_write_b64 %0, %1 offset:%2" :: "v"(ay), "v"(yy), "i"((dt_) * 128) : "memory"); } while (0)
    constexpr int NB = TP / WK_TB;
    if (!stepper) {
        const int ht = (tid - 256) >> 4;
        const f32x4 kkc = *(const f32x4*)(k_k + ch), kac = *(const f32x4*)(k_a + ch), rkc = *(const f32x4*)(r_k + ch), w0c = *(const f32x4*)(w0p + ch);
        WK_PREP1(0, 0, ht); WK_PREP1(0, 0, ht + 16);
        LDS_WAIT(); __builtin_amdgcn_s_barrier(); asm volatile("" ::: "memory");
        for (int n = 0; n < NB; ++n) { const int cur = n & 1;
            if (n + 1 < NB) { WK_PREP1(cur ^ 1, n + 1, ht); WK_PREP1(cur ^ 1, n + 1, ht + 16); }
            if (n >= 1) {
                const int yt = (tid - 256) >> 3, yq = (tid & 7) * 4; const f32x4 y4 = *(const LAS f32x4*)(L + WK_Y + (cur ^ 1) * WK_YB + yt * 32 + yq);
                uint2 ov; ov.x = pk2(y4[0], y4[1]); ov.y = pk2(y4[2], y4[3]);
                *(uint2*)(Y + (tokb + (size_t)(n - 1) * WK_TB + yt) * D + h * 64 + half * 32 + yq) = ov; }
            LDS_WAIT(); __builtin_amdgcn_s_barrier(); asm volatile("" ::: "memory");
        }
        { const int yt = (tid - 256) >> 3, yq = (tid & 7) * 4; const f32x4 y4 = *(const LAS f32x4*)(L + WK_Y + ((NB - 1) & 1) * WK_YB + yt * 32 + yq);
            uint2 ov; ov.x = pk2(y4[0], y4[1]); ov.y = pk2(y4[2], y4[3]); *(uint2*)(Y + (tokb + (size_t)(NB - 1) * WK_TB + yt) * D + h * 64 + half * 32 + yq) = ov; }
    } else {
        LDS_WAIT(); __builtin_amdgcn_s_barrier(); asm volatile("" ::: "memory");
        const unsigned lbase = (unsigned)(size_t)L;
        for (int n = 0; n < NB; ++n) { const int cur = n & 1;
            unsigned aop = lbase + (unsigned)(cur * WK_PB + 4 * jq) * 4u, av = lbase + (unsigned)(cur * WK_PB + WK_V + 4 * rp) * 4u;
            unsigned ay = lbase + (unsigned)(jq == 0 ? WK_Y + cur * WK_YB + 2 * rp : WK_Y + 2 * WK_YB + 2 * tid) * 4u;
            WkvOps o0, o1, o2, o3;
            asm volatile("s_waitcnt lgkmcnt(0)" ::: "memory");
            WK_LOADOPS(o0, 0); WK_LOADOPS(o1, 1);
            WK_LOADOPS(o2, 2); WK_WAIT(12, o0); WK_STEP(o0, 0);
            WK_LOADOPS(o3, 3); WK_WAIT(13, o1); WK_STEP(o1, 1);
            for (int t4 = 0; t4 < 7; ++t4) {
                WK_LOADOPS(o0, 4); WK_WAIT(14, o2); WK_STEP(o2, 2);
                WK_LOADOPS(o1, 5); WK_WAIT(14, o3); WK_STEP(o3, 3);
                aop += 1024; av += 1024; ay += 512;
                WK_LOADOPS(o2, 2); WK_WAIT(14, o0); WK_STEP(o0, 0);
                WK_LOADOPS(o3, 3); WK_WAIT(14, o1); WK_STEP(o1, 1);
            }
            WK_WAIT(8, o2); WK_STEP(o2, 2);
            WK_WAIT(2, o3); WK_STEP(o3, 3);
            asm volatile("s_waitcnt lgkmcnt(0)" ::: "memory");
            __builtin_amdgcn_s_barrier(); asm volatile("" ::: "memory");
        }
        float* so = s_out + (((size_t)b * 16 + h) * 64 + half * 32 + 2 * rp) * 64 + 4 * jq; *(f32x4*)so = S0; *(f32x4*)(so + 64) = S1;
    }
#undef WK_LOADOPS
#undef WK_STEP
#undef WK_WAIT
#undef WK_RD128
#undef WK_PREP1
}
DEVI void wkv_ypass_row(size_t tok, int lane, const bf16* Y, const bf16* V, bf16* GO, const float* BON, const float* lnx_g, const float* lnx_b) {
    const int c0 = lane * 16; const size_t o = tok * D + c0;
    const v4u ya = *(const v4u*)(Y + o), yb = *(const v4u*)(Y + o + 8), va = *(const v4u*)(V + o), vb = *(const v4u*)(V + o + 8), ga = *(const v4u*)(GO + o), gb = *(const v4u*)(GO + o + 8);
    const unsigned yw[8] = {ya.x, ya.y, ya.z, ya.w, yb.x, yb.y, yb.z, yb.w}, vw[8] = {va.x, va.y, va.z, va.w, vb.x, vb.y, vb.z, vb.w}, gw_[8] = {ga.x, ga.y, ga.z, ga.w, gb.x, gb.y, gb.z, gb.w};
    float y[16]; float s = 0.f;
#pragma unroll
    for (int e = 0; e < 8; ++e) { y[2 * e] = __uint_as_float(yw[e] << 16); y[2 * e + 1] = __uint_as_float(yw[e] & 0xffff0000u); s += y[2 * e] + y[2 * e + 1]; }
    s = dpp_add(s, 0); s = dpp_add(s, 1); const float mean = s * (1.f / 64.f); float q = 0.f;
#pragma unroll
    for (int e = 0; e < 16; ++e) { y[e] -= mean; q += y[e] * y[e]; }
    q = dpp_add(q, 0); q = dpp_add(q, 1); const float rstd = rsqrtf(q * (1.f / 64.f) + 64e-5f), bon = BON[tok * 16 + (lane >> 2)];
    unsigned ow[8];
#pragma unroll
    for (int e = 0; e < 8; ++e) { const float v0 = __uint_as_float(vw[e] << 16), v1 = __uint_as_float(vw[e] & 0xffff0000u), g0 = __uint_as_float(gw_[e] << 16), g1 = __uint_as_float(gw_[e] & 0xffff0000u);
        const float o0 = (y[2 * e] * rstd * lnx_g[c0 + 2 * e] + lnx_b[c0 + 2 * e] + bon * v0) * g0, o1 = (y[2 * e + 1] * rstd * lnx_g[c0 + 2 * e + 1] + lnx_b[c0 + 2 * e + 1] + bon * v1) * g1; ow[e] = pk2(o0, o1); }
    *(v4u*)(GO + o) = (v4u){ow[0], ow[1], ow[2], ow[3]}; *(v4u*)(GO + o + 8) = (v4u){ow[4], ow[5], ow[6], ow[7]};
}

constexpr int GL_BF = 0, GL_QI = 16384, GL_KI = 25600, GL_SC = 34816, GL_VT = 44032, GL_ST = 62464, GL_RS = 80896, GL_WG = 81920, GL_GKL = 86016, GL_SEG = 90112;
constexpr int GL_LD = 72;
DEVI bf16x8 gl_frag(LAS unsigned char* lds, int base, int row, int k0, int fq) { return *(const LAS bf16x8*)(lds + base + (row * GL_LD + k0 + 8 * fq) * 2); }
DEVI void gla_cumdecay(LAS unsigned char* lds, int tid, int h, size_t tok0, const float* GKL, const float* w_gk, const float* b_gk) {
    asm volatile("" : "+v"(tid));
    LAS float* BF = (LAS float*)(lds + GL_BF); LAS float* WG = (LAS float*)(lds + GL_WG); LAS float* GK = (LAS float*)(lds + GL_GKL); LAS float* SEG = (LAS float*)(lds + GL_SEG);
    for (int i = tid; i < 1024; i += 512) { WG[i] = w_gk[(i >> 6) * 256 + h * 64 + (i & 63)]; GK[i] = GKL[tok0 * 16 + i]; }
    LDS_WAIT(); __builtin_amdgcn_s_barrier(); asm volatile("" ::: "memory");
    { const int t = tid >> 3, d0 = (tid & 7) * 8; float x[8];
#pragma unroll
        for (int e = 0; e < 8; ++e) x[e] = b_gk[h * 64 + d0 + e];
#pragma unroll
        for (int r = 0; r < 16; ++r) { const float gv = GK[t * 16 + r]; const f32x4 w0 = *(const LAS f32x4*)(WG + r * 64 + d0), w1 = *(const LAS f32x4*)(WG + r * 64 + d0 + 4);
#pragma unroll
            for (int e = 0; e < 4; ++e) { x[e] += gv * w0[e]; x[4 + e] += gv * w1[e]; } }
#pragma unroll
        for (int e = 0; e < 8; ++e) { const float xx = x[e]; x[e] = (fminf(xx, 0.f) - log1pf(__expf(-fabsf(xx)))) * (1.f / 16.f); }
        *(LAS f32x4*)(BF + t * 64 + d0) = (f32x4){x[0], x[1], x[2], x[3]}; *(LAS f32x4*)(BF + t * 64 + d0 + 4) = (f32x4){x[4], x[5], x[6], x[7]}; }
    LDS_WAIT(); __builtin_amdgcn_s_barrier(); asm volatile("" ::: "memory");
    { const int dk = tid & 63, sg = tid >> 6; float a = 0.f;
#pragma unroll
        for (int i = 0; i < 8; ++i) { a += BF[(sg * 8 + i) * 64 + dk]; BF[(sg * 8 + i) * 64 + dk] = a; }
        SEG[sg * 64 + dk] = a; }
    LDS_WAIT(); __builtin_amdgcn_s_barrier(); asm volatile("" ::: "memory");
    { const int dk = tid & 63, sg = tid >> 6; float off = 0.f;
        for (int s = 0; s < sg; ++s) off += SEG[s * 64 + dk];
#pragma unroll
        for (int i = 0; i < 8; ++i) BF[(sg * 8 + i) * 64 + dk] += off; }
    LDS_WAIT(); __builtin_amdgcn_s_barrier(); asm volatile("" ::: "memory");
}
DEVI void gla_stage_vt(LAS unsigned char* lds, int tid, int h, size_t tok0, const bf16* P) {
    const int t = tid >> 3, dv0 = (tid & 7) * 16; const bf16* vp = P + (tok0 + t) * NINP + 512 + h * 128 + dv0;
    const v4u a = *(const v4u*)vp, b = *(const v4u*)(vp + 8); LAS bf16* VT = (LAS bf16*)(lds + GL_VT);
    const unsigned w[8] = {a.x, a.y, a.z, a.w, b.x, b.y, b.z, b.w};
#pragma unroll
    for (int e = 0; e < 8; ++e) { VT[(dv0 + 2 * e) * GL_LD + t] = (bf16)(w[e] & 0xffffu); VT[(dv0 + 2 * e + 1) * GL_LD + t] = (bf16)(w[e] >> 16); }
}
DEVI void gla_unit_a(LAS unsigned char* lds, int tid, int u, const bf16* P, const float* GKL, const float* w_gk, const float* b_gk, float* KV, float* DEC) {
    asm volatile("" : "+v"(tid));
    const int bh = u >> 5, ck = u & 31, b = bh >> 2, h = bh & 3; const size_t tok0 = (size_t)b * TP + ck * 64;
    const int lane = tid & 63, wave = tid >> 6, fr = lane & 15, fq = lane >> 4;
    gla_cumdecay(lds, tid, h, tok0, GKL, w_gk, b_gk);
    LAS float* BF = (LAS float*)(lds + GL_BF);
    { const int t = tid >> 3, d0 = (tid & 7) * 8; const v4u kq = *(const v4u*)(P + (tok0 + t) * NINP + 256 + h * 64 + d0); LAS bf16* KST = (LAS bf16*)(lds + GL_QI);
        const unsigned w[4] = {kq.x, kq.y, kq.z, kq.w};
#pragma unroll
        for (int e = 0; e < 8; ++e) { const float kv = __uint_as_float((e & 1) ? (w[e >> 1] & 0xffff0000u) : (w[e >> 1] << 16)); const float sc = __expf(BF[63 * 64 + d0 + e] - BF[t * 64 + d0 + e]);
            KST[(d0 + e) * GL_LD + t] = (bf16)f2bf(kv * sc); } }
    gla_stage_vt(lds, tid, h, tok0, P);
    if (tid < 64) DEC[(size_t)u * 64 + tid] = __expf(BF[63 * 64 + tid]);
    LDS_WAIT(); __builtin_amdgcn_s_barrier(); asm volatile("" ::: "memory");
#pragma unroll
    for (int dt = 0; dt < 4; ++dt) { f32x4 acc = {0.f, 0.f, 0.f, 0.f};
#pragma unroll
        for (int k0 = 0; k0 < 64; k0 += 32) acc = __builtin_amdgcn_mfma_f32_16x16x32_bf16(gl_frag(lds, GL_VT, wave * 16 + fr, k0, fq), gl_frag(lds, GL_QI, dt * 16 + fr, k0, fq), acc, 0, 0, 0);
        *(f32x4*)(KV + ((size_t)u * 64 + dt * 16 + fr) * 128 + wave * 16 + 4 * fq) = acc; }
    LDS_WAIT(); __builtin_amdgcn_s_barrier(); asm volatile("" ::: "memory");
}
DEVI void gla_scan_b(int gtid, float* KV, const float* DEC, float* s_out) {
    const int dv = gtid & 127, dkq = (gtid >> 7) & 15, bh = gtid >> 11; float S[4] = {0.f, 0.f, 0.f, 0.f};
#pragma unroll 4
    for (int c = 0; c < 32; ++c) { const size_t u = (size_t)bh * 32 + c; float* kp = KV + (u * 64 + dkq * 4) * 128 + dv;
#pragma unroll
        for (int e = 0; e < 4; ++e) { const float kv = kp[e * 128], dc = DEC[u * 64 + dkq * 4 + e]; kp[e * 128] = S[e]; S[e] = dc * S[e] + kv; } }
#pragma unroll
    for (int e = 0; e < 4; ++e) s_out[((size_t)bh * 64 + dkq * 4 + e) * 128 + dv] = S[e];
}
DEVI void gla_unit_c(LAS unsigned char* lds, int tid, int u, const bf16* P, const float* GKL, const float* w_gk, const float* b_gk, const float* KV, const float* norm_g, bf16* O) {
    asm volatile("" : "+v"(tid));
    const int bh = u >> 5, ck = u & 31, b = bh >> 2, h = bh & 3; const size_t tok0 = (size_t)b * TP + ck * 64;
    const int lane = tid & 63, wave = tid >> 6, fr = lane & 15, fq = lane >> 4;
    gla_cumdecay(lds, tid, h, tok0, GKL, w_gk, b_gk);
    LAS float* BF = (LAS float*)(lds + GL_BF);
    { const int t = tid >> 3, d0 = (tid & 7) * 8; const v4u qq = *(const v4u*)(P + (tok0 + t) * NINP + h * 64 + d0), kq = *(const v4u*)(P + (tok0 + t) * NINP + 256 + h * 64 + d0);
        const unsigned wq[4] = {qq.x, qq.y, qq.z, qq.w}, wk[4] = {kq.x, kq.y, kq.z, kq.w}; float qo[8], ko[8];
#pragma unroll
        for (int e = 0; e < 8; ++e) { const float qv = __uint_as_float((e & 1) ? (wq[e >> 1] & 0xffff0000u) : (wq[e >> 1] << 16)), kv = __uint_as_float((e & 1) ? (wk[e >> 1] & 0xffff0000u) : (wk[e >> 1] << 16));
            const float bb = BF[t * 64 + d0 + e]; qo[e] = qv * 0.125f * __expf(bb); ko[e] = kv * __expf(-bb); }
        v4u a, c; a.x = pk2(qo[0], qo[1]); a.y = pk2(qo[2], qo[3]); a.z = pk2(qo[4], qo[5]); a.w = pk2(qo[6], qo[7]); c.x = pk2(ko[0], ko[1]); c.y = pk2(ko[2], ko[3]); c.z = pk2(ko[4], ko[5]); c.w = pk2(ko[6], ko[7]);
        *(LAS v4u*)(lds + GL_QI + (t * GL_LD + d0) * 2) = a; *(LAS v4u*)(lds + GL_KI + (t * GL_LD + d0) * 2) = c; }
    gla_stage_vt(lds, tid, h, tok0, P);
    { const int dk = tid >> 3, dv0 = (tid & 7) * 16; const float* sp = KV + ((size_t)u * 64 + dk) * 128 + dv0; LAS bf16* ST = (LAS bf16*)(lds + GL_ST);
#pragma unroll
        for (int q = 0; q < 4; ++q) { const f32x4 s4 = *(const f32x4*)(sp + 4 * q);
#pragma unroll
            for (int e = 0; e < 4; ++e) ST[(dv0 + 4 * q + e) * GL_LD + dk] = (bf16)f2bf(s4[e]); } }
    LDS_WAIT(); __builtin_amdgcn_s_barrier(); asm volatile("" ::: "memory");
#pragma unroll
    for (int q = 0; q < 2; ++q) { const int id = wave * 2 + q, tt = id >> 2, st = id & 3; f32x4 acc = {0.f, 0.f, 0.f, 0.f};
#pragma unroll
        for (int k0 = 0; k0 < 64; k0 += 32) acc = __builtin_amdgcn_mfma_f32_16x16x32_bf16(gl_frag(lds, GL_KI, st * 16 + fr, k0, fq), gl_frag(lds, GL_QI, tt * 16 + fr, k0, fq), acc, 0, 0, 0);
        const int t = tt * 16 + fr, s0 = st * 16 + 4 * fq;
#pragma unroll
        for (int e = 0; e < 4; ++e) if (s0 + e > t) acc[e] = 0.f;
        *(LAS unsigned long long*)(lds + GL_SC + (t * GL_LD + s0) * 2) = (unsigned long long)pk2(acc[0], acc[1]) | ((unsigned long long)pk2(acc[2], acc[3]) << 32); }
    LDS_WAIT(); __builtin_amdgcn_s_barrier(); asm volatile("" ::: "memory");
    const int tt = wave & 3, hv = wave >> 2; f32x4 o[4]; float ssq = 0.f;
#pragma unroll
    for (int dt = 0; dt < 4; ++dt) { f32x4 acc = {0.f, 0.f, 0.f, 0.f}; const int dvr = (hv * 4 + dt) * 16 + fr;
#pragma unroll
        for (int k0 = 0; k0 < 64; k0 += 32) { acc = __builtin_amdgcn_mfma_f32_16x16x32_bf16(gl_frag(lds, GL_VT, dvr, k0, fq), gl_frag(lds, GL_SC, tt * 16 + fr, k0, fq), acc, 0, 0, 0);
            acc = __builtin_amdgcn_mfma_f32_16x16x32_bf16(gl_frag(lds, GL_ST, dvr, k0, fq), gl_frag(lds, GL_QI, tt * 16 + fr, k0, fq), acc, 0, 0, 0); }
        o[dt] = acc; ssq += (acc[0] * acc[0] + acc[1] * acc[1]) + (acc[2] * acc[2] + acc[3] * acc[3]); }
    ssq += __shfl_xor(ssq, 16); ssq += __shfl_xor(ssq, 32);
    LAS float* RS = (LAS float*)(lds + GL_RS);
    if (fq == 0) RS[hv * 64 + tt * 16 + fr] = ssq;
    LDS_WAIT(); __builtin_amdgcn_s_barrier(); asm volatile("" ::: "memory");
    { const int t = tt * 16 + fr; const float rstd = rsqrtf((RS[t] + RS[64 + t]) * (1.f / 128.f) + 1e-5f); const size_t tok = tok0 + t;
#pragma unroll
        for (int dt = 0; dt < 4; ++dt) { const int dv = (hv * 4 + dt) * 16 + 4 * fq; const uint2 gg = *(const uint2*)(P + tok * NINP + 1024 + h * 128 + dv); const f32x4 ng = *(const f32x4*)(norm_g + dv);
            const float g0 = __uint_as_float(gg.x << 16), g1 = __uint_as_float(gg.x & 0xffff0000u), g2 = __uint_as_float(gg.y << 16), g3 = __uint_as_float(gg.y & 0xffff0000u);
            uint2 ov; ov.x = pk2(o[dt][0] * rstd * ng[0] * siluf_(g0), o[dt][1] * rstd * ng[1] * siluf_(g1)); ov.y = pk2(o[dt][2] * rstd * ng[2] * siluf_(g2), o[dt][3] * rstd * ng[3] * siluf_(g3));
            *(uint2*)(O + tok * D + h * 128 + dv) = ov; } }
    LDS_WAIT(); __builtin_amdgcn_s_barrier(); asm volatile("" ::: "memory");
}

__global__ void __launch_bounds__(NWAVES * 64, 2) __attribute__((target("no-packed-fp32-ops"))) mk_fwd(Args args) {
    extern __shared__ __attribute__((aligned(16))) unsigned char lds_raw[];
    LAS unsigned char* lds = (LAS unsigned char*)lds_raw;
    volatile LAS unsigned* MISC = (volatile LAS unsigned*)(lds + MISC_OFF);
    const int tid = threadIdx.x, lane = tid & 63, wave = __builtin_amdgcn_readfirstlane(tid >> 6), G = gridDim.x, blk = blockIdx.x;
#define LW() (*(unsigned char* const __attribute__((address_space(4)))*)(KARG() + 424))
#define LO() (*(float* const __attribute__((address_space(4)))*)(KARG() + 416))
#define PTRS unsigned char* ws = LW(); float* out = LO(); float* MODS = (float*)(ws + WS_MODS); float* SP = (float*)(ws + WS_SP); bf16* H = (bf16*)(ws + WS_H); float* Z = (float*)(ws + WS_Z); bf16* ACT = (bf16*)(ws + WS_ACT); float* X = out; \
    (void)MODS; (void)SP; (void)H; (void)Z; (void)ACT; (void)X
    for (int u = tid; u < (LDS_BYTES - LDSCTL_OFF) / 4; u += NWAVES * 64) ((LAS unsigned*)(lds + LDSCTL_OFF))[u] = 0u;
    __syncthreads();
    { XcdBarrier b0_ = xcd_barrier_post((unsigned*)(LW() + WS_CTL) + CW_BAR, MISC + 8); (void)b0_; }
#define GRID_BAR() do { XcdBarrier b_; b_.bar = (unsigned*)(LW() + WS_CTL) + CW_BAR; b_.x = xb_xcc_id(); b_.st = MISC + 8; xcd_barrier(b_); if (XP == 6) xcd_barrier(b_); \
        if (PROBE && blk == 0 && tid == 0) ((unsigned long long*)(LW() + WS_CTL + 524288))[nst] = rt(); ++nst; } while (0)
    int nst = 0;
    if (PROBE && blk == 0 && tid == 0) ((unsigned long long*)(LW() + WS_CTL + 524288))[63] = rt();
    const int gw = blk * NWAVES + wave, NGW = G * NWAVES;
    const int gws = wave * G + blk;
    LAS float* wscr = (LAS float*)(lds + RING_OFF + wave * 16384);

    for (int xrep = 0; xrep < (XP == 1 ? 2 : 1); ++xrep) { PTRS;
        { float* STt = (float*)(ws + WS_ST); for (int i = blk * 512 + tid; i < 144 * 1024; i += G * 512) { const int r = i >> 10, k = i & 1023; float v = 0.f; if (r < 8) v = siluf_(INP(7)[r * 1024 + k]); else if (r < 136) v = siluf_(INP(8)[(r - 8) * 1024 + k]); STt[k * 144 + r] = v; } }
        for (int it = blk * 512 + tid; it < 2048 * 18; it += G * 512) { const int i = it & 2047, tau = it >> 11;
            if (tau == 17) s5prep_one(i, INP(24), INP(25), INP(26), INP(27), INP(28), SP); else s5prep_pw(i, tau, INP(24), INP(25), INP(26), SP); }
    }
    GRID_BAR();
    for (int xq = 0; xq < (XP == 17 ? 2 : 1); ++xq) { PTRS; bf16* TM = (bf16*)(ws + WS_TM); bf16* HM = (bf16*)(ws + WS_HM);
        constexpr int I_UP = (D / 64) * (NUP / 32), I_DN = (FFP / 64) * (D / 32), I_IN = (D / 64) * (NINP / 32), I_GLU = (512 / 64) * (512 / 32), I_SQ = (D / 64) * (D / 32), I_RK = (KRK / 64) * (NRK / 32), I_L2 = (NL1 / 64) * (3072 / 32);
        constexpr int NITEMS = 4 * I_UP + 4 * I_DN + I_IN + I_GLU + 2 * I_SQ + I_RK + I_L2;
        constexpr int NMW = 864, HS = MODS_HS;
        for (int xr = 0; xr < (XP == 10 ? 2 : 1); ++xr) for (int j = gws; j < NMW; j += NGW) { int cg, rs; if (j < 768) { cg = j & 255; rs = j >> 8; } else { const int e = j - 768; cg = 256 + e / 3; rs = e - (e / 3) * 3; }
            mods_job3(__builtin_amdgcn_readfirstlane(cg), __builtin_amdgcn_readfirstlane(rs), lane, (const float*)(ws + WS_ST), INPD(9), INPD(10), MODS); }
        const int ncw = NGW - NMW, NA = ncw > 0 ? (HS * ncw < NITEMS ? HS * ncw : NITEMS) : 0;
        for (int xc = 0; xc < (XP == 19 ? 2 : 1); ++xc) { bool stA = (gws >= NMW) && NA > 0;
        for (int itn = stA ? gws - NMW : NA + (NGW - 1 - gws); itn < NITEMS; ) {
            int r = itn;
            if (stA) { itn += ncw; if (itn >= NA) { stA = false; itn = NA + (NGW - 1 - gws); } } else itn += NGW;
            if (r < 4 * I_UP) { const int q = r / I_UP, l = q >> 1, f = q & 1; r -= q * I_UP;
                const int kb = r / (NUP / 32), nb = r % (NUP / 32), pn = nb >> 3, half = (nb >> 2) & 1, c0 = pn * 128 + (nb & 3) * 32;
                bf16* dst = (bf16*)(ws + (l ? WS_WUP_L1 : WS_WUP_L0) + f * SZ_WUP) + (size_t)(nb * 32) * D;
                if (c0 >= FF) { SrcZero s; cvt_item(s, dst, D, 1, wscr, kb, lane); }
                else if (half) { SrcPlain s{INPD(f ? 17 : 14) + (size_t)l * D * FF + c0, D, FF - c0, FF}; cvt_item(s, dst, D, 1, wscr, kb, lane); }
                else { SrcPlain s{INPD(f ? 16 : 13) + (size_t)l * D * FF + c0, D, FF - c0, FF}; cvt_item(s, dst, D, 1, wscr, kb, lane); }
                continue; } r -= 4 * I_UP;
            if (r < 4 * I_DN) { const int q = r / I_DN, l = q >> 1, f = q & 1; r -= q * I_DN;
                SrcPlain s{INPD(f ? 18 : 15) + (size_t)l * FF * D, FF, D, D};
                cvt_item(s, (bf16*)(ws + (l ? WS_WDN_L1 : WS_WDN_L0) + f * SZ_WDN), FFP, D / 32, wscr, r, lane); continue; } r -= 4 * I_DN;
            if (r < I_IN) { SrcPlain s{INPD(19), D, NIN, NIN}; cvt_item(s, (bf16*)(ws + WS_WIN), D, NINP / 32, wscr, r, lane); continue; } r -= I_IN;
            if (r < I_GLU) { SrcPlain s{INPD(32), 512, 512, 512}; cvt_item(s, (bf16*)(ws + WS_WGLU), 512, 512 / 32, wscr, r, lane); continue; } r -= I_GLU;
            if (r < I_SQ) { SrcPlain s{INPD(20), D, D, D}; cvt_item(s, (bf16*)(ws + WS_WOUT), D, D / 32, wscr, r, lane); continue; } r -= I_SQ;
            if (r < I_SQ) { SrcPlain s{INPD(38), D, D, D}; cvt_item(s, (bf16*)(ws + WS_WO), D, D / 32, wscr, r, lane); continue; } r -= I_SQ;
            if (r < I_RK) { const int kb = r / (NRK / 32), nb = r % (NRK / 32), n0 = nb * 32; bf16* dst = (bf16*)(ws + WS_WRK) + (size_t)n0 * KRK;
                if (n0 < 1024) { SrcFold s{INPD(35) + n0, INPD(34) + 0 * 1024, 1024}; cvt_item(s, dst, KRK, 1, wscr, kb, lane); }
                else if (n0 < 2048) { SrcFold s{INPD(36) + (n0 - 1024), INPD(34) + 2 * 1024, 1024}; cvt_item(s, dst, KRK, 1, wscr, kb, lane); }
                else if (n0 < 3072) { SrcFold s{INPD(37) + (n0 - 2048), INPD(34) + 3 * 1024, 1024}; cvt_item(s, dst, KRK, 1, wscr, kb, lane); }
                else if (n0 < 3136) { SrcFold s{INPD(40) + (n0 - 3072), INPD(34) + 1 * 1024, 64}; cvt_item(s, dst, KRK, 1, wscr, kb, lane); }
                else if (n0 < 3200) { SrcFold s{INPD(43) + (n0 - 3136), INPD(34) + 4 * 1024, 64}; cvt_item(s, dst, KRK, 1, wscr, kb, lane); }
                else if (n0 < 3360) { SrcFold s{INPD(45) + (n0 - 3200), INPD(34) + 5 * 1024, 160}; cvt_item(s, dst, KRK, 1, wscr, kb, lane); }
                else { SrcZero s; cvt_item(s, dst, KRK, 1, wscr, kb, lane); }
                continue; } r -= I_RK;
            { const int kb = r / (3072 / 32), nb = r % (3072 / 32), n0 = nb * 32; bf16* dst = (bf16*)(ws + WS_WL2) + (size_t)n0 * NL1;
                if (n0 < 1024) { SrcBlk s{INPD(41) + n0, 0, 64}; cvt_item(s, dst, NL1, 1, wscr, kb, lane); }
                else if (n0 < 2048) { SrcBlk s{INPD(44) + (n0 - 1024), 64, 128}; cvt_item(s, dst, NL1, 1, wscr, kb, lane); }
                else { SrcBlk s{INPD(46) + (n0 - 2048), 128, 288}; cvt_item(s, dst, NL1, 1, wscr, kb, lane); } }
        } }
        for (int xr = 0; xr < (XP == 20 ? 2 : 1); ++xr) for (int j = NGW - 1 - gws; j < 32 * 17 + 32 * 16; j += NGW) { if (j < 544) s5_tm_job(j / 17, j % 17, lane, SP, INPD(29), INPD(30), INPD(31), TM); else s5_hm_job((j - 544) >> 4, (j - 544) & 15, lane, SP, HM); }
        for (int i = gw * 64 + lane; i < 32 * 128 * 256 / 8; i += NGW * 64) { const int g = i >> 12, r = i & 4095; *(v4u*)(HM + ((size_t)g * 256 + 128) * 256 + (size_t)r * 8) = (v4u){0u, 0u, 0u, 0u}; } }
    GRID_BAR();
    { PTRS; for (int xr = 0; xr < (XP == 18 ? 2 : 1); ++xr) for (int row = gw; row < MTP; row += NGW) init_row(row, lane, INP(0), INP(1), MODS, X, H, (float*)(ws + WS_ZS)); }
    GRID_BAR();

#define GEMM_PHASE(EPI, Aptr, Bptr, NN, KK, ...) do { pg8::GemmX g_{(const pg8::bf16_t*)(Aptr), (const pg8::bf16_t*)(Bptr), MTP, NN, KK, KK, KK, -1}; pg8::StaticOrder S_; S_.init(MTP, NN, G, blk); pg8::EPI E_{__VA_ARGS__}; \
        pg8::gemm_phase<pg8::EPI, pg8::StaticOrder, true, true>(lds + RING_OFF, g_, S_, E_); } while (0)
#define GEMMX_PHASE(EPI, Aptr, Bptr, MM, NN, KK, LDA, LDB, GSH, ...) do { pg8::GemmX g_{(const pg8::bf16_t*)(Aptr), (const pg8::bf16_t*)(Bptr), MM, NN, KK, LDA, LDB, GSH}; pg8::StaticOrder S_; S_.init(MM, NN, G, blk); pg8::EPI E_{__VA_ARGS__}; \
        pg8::gemm_phase<pg8::EPI, pg8::StaticOrder, true, true>(lds + RING_OFF, g_, S_, E_); } while (0)
#define RESID_PHASE(Aptr, Bptr, KK, gatep, rcv) do { \
        { pg8::GemmX g_{(const pg8::bf16_t*)(Aptr), (const pg8::bf16_t*)(Bptr), NP, D, KK, KK, KK, -1}; pg8::StaticOrder S_; S_.init(NP, D, G, blk); pg8::EpiResid E_{X, Z, gatep, rcv, 0}; \
          pg8::gemm_phase<pg8::EpiResid, pg8::StaticOrder, true, true>(lds + RING_OFF, g_, S_, E_); } \
        { pg8::GemmX g_{(const pg8::bf16_t*)(Aptr), (const pg8::bf16_t*)(Bptr), MTP, D, 256, KK, KK, -1}; pg8::SplitOrder S_{64, 4, (KK) / 256, 256, G, blk}; pg8::EpiResidS E_{(float*)(ws + WS_SL), gatep, rcv, 0}; \
          pg8::gemm_phase<pg8::EpiResidS, pg8::SplitOrder, true, true>(lds + RING_OFF, g_, S_, E_); } } while (0)
#define LN_PASS(l, idx, Hout, nsh, nsc) do { PTRS; const int nsl_ = ((idx) == 1) ? 4 : 11; for (int row = gw; row < MT; row += NGW) ln_row(row, lane, Z, (float*)(ws + WS_ZS), (const float*)(ws + WS_SL), nsl_, INP(11) + ((l) * 3 + (idx)) * D, INP(12) + ((l) * 3 + (idx)) * D, X, Hout, nsh, nsc); } while (0)
#define FFN(l, f, which0, lnidx, HOUT, nshw, nscw) do { \
        { PTRS; { int ru_ = (XP == 41 ? 2 : 1); asm volatile("" : "+s"(ru_)); for (int xu = 0; xu < ru_; ++xu) GEMM_PHASE(EpiSwiglu, H, ws + ((l) ? WS_WUP_L1 : WS_WUP_L0) + (f) * SZ_WUP, NUP, D, (pg8::bf16_t*)ACT); } if (XP == 2) { GEMM_PHASE(EpiSwiglu, H, ws + ((l) ? WS_WUP_L1 : WS_WUP_L0) + (f) * SZ_WUP, NUP, D, (pg8::bf16_t*)ACT); } if (XP == 42) { GEMM_PHASE(EpiHloc, H, ws + ((l) ? WS_WUP_L1 : WS_WUP_L0) + (f) * SZ_WUP, NUP, D, (float*)(ws + WS_Z)); } } GRID_BAR(); \
        { PTRS; RESID_PHASE(ACT, ws + ((l) ? WS_WDN_L1 : WS_WDN_L0) + (f) * SZ_WDN, FFP, modp(MODS, l, (which0) + 2), 0.5f); if (XP == 3) { RESID_PHASE(ACT, ws + ((l) ? WS_WDN_L1 : WS_WDN_L0) + (f) * SZ_WDN, FFP, modp(MODS, l, (which0) + 2), 0.5f); } } GRID_BAR(); \
        LN_PASS(l, lnidx, HOUT, nshw, nscw); if (XP == 4) { LN_PASS(l, lnidx, HOUT, nshw, nscw); } GRID_BAR(); } while (0)

    FFN(0, 0, 0, 0, H, modp(MODS, 0, 3), modp(MODS, 0, 4));
#define L0PTRS PTRS; bf16* P = (bf16*)(ws + WS_P); float* GKL = (float*)(ws + WS_GKL); float* OGS = (float*)(ws + WS_OGS) - (size_t)NP * 512; bf16* Z5 = (bf16*)(ws + WS_Z5); bf16* O = (bf16*)(ws + WS_O); \
        bf16* UB = (bf16*)(ws + WS_UBUF); float* HL = (float*)(ws + WS_HLOC); float* KV = (float*)(ws + WS_KV); float* DEC = (float*)(ws + WS_DEC); (void)P; (void)GKL; (void)OGS; (void)Z5; (void)O; (void)UB; (void)HL; (void)KV; (void)DEC
    { L0PTRS; for (int xr = 0; xr < (XP == 11 ? 2 : 1); ++xr) GEMM_PHASE(EpiInproj, H, ws + WS_WIN, NINP, D, (pg8::bf16_t*)P, GKL, (pg8::bf16_t*)UB); } GRID_BAR();
    for (int xr = 0; xr < (XP == 12 ? 2 : 1); ++xr) { if (xr) { GRID_BAR(); --nst; } L0PTRS;
        { int reps_ = (XP == 25 ? 2 : (XP == 26 ? 5 : 1)); asm volatile("" : "+s"(reps_)); for (int xh = 0; xh < reps_; ++xh) GEMMX_PHASE(EpiHloc, UB, ws + WS_HM, 32768, 256, 256, 384, 256, 2, HL); }
        for (int u = (blk + 128) & 255; u < 1024; u += 256) gla_unit_a(lds + RING_OFF, tid, u, P, GKL, INPD(21), INPD(22), KV, DEC);
    }
    GRID_BAR();
    { L0PTRS;
        for (int xr = 0; xr < (XP == 13 ? 2 : 1); ++xr) if (gws < 256) s5_carry_job(gws >> 5, gws & 31, lane, SP, HL, UB, out + O_S5RE_P, out + O_S5IM_P);
        if (blk >= 128) gla_scan_b((blk - 128) * 512 + tid, KV, DEC, out + O_GLA_P);
        for (int s = gws; s < 1536; s += NGW) {
            if (s < 1024) gla_job(wscr, lane, s >> 3, (s >> 1) & 3, s & 1, P, GKL, INPD(21), INPD(22), NP, 1, INPD(2), out + O_GLA_S, OGS);
            else { const int j = s - 1024; s5_job(wscr, lane, j & 31, (j >> 5) * 8, 8, P, SP, INPD(29), INPD(30), INPD(31), NP, 1, INPD(3), INPD(4), out + O_S5RE_S, out + O_S5IM_S, Z5); } }
    } GRID_BAR();
    for (int xr = 0; xr < (XP == 14 ? 2 : 1); ++xr) { L0PTRS;
        GEMMX_PHASE(EpiS5Y, UB, ws + WS_TM, 32768, 256, 384, 384, 384, 2, (pg8::bf16_t*)Z5);
        for (int u = (blk + 128) & 255; u < 1024; u += 256) gla_unit_c(lds + RING_OFF, tid, u, P, GKL, INPD(21), INPD(22), KV, INPD(23), O);
        for (int w = NP * 4 + gw; w < MT * 4; w += NGW) gla_post_one(w, lane, OGS, P, INP(23), O); } GRID_BAR();
    { L0PTRS; { int rg_ = (XP == 24 ? 2 : 1); asm volatile("" : "+s"(rg_)); for (int xr = 0; xr < rg_; ++xr) GEMM_PHASE(EpiGlu, Z5, ws + WS_WGLU, 512, 512, (const pg8::bf16_t*)Z5, (pg8::bf16_t*)O, INP(33)); }
        if (XP == 40) { int rh_ = 2; asm volatile("" : "+s"(rh_)); for (int xr = 0; xr < rh_; ++xr) GEMM_PHASE(EpiHloc, Z5, ws + WS_WGLU, 512, 512, HL); } } GRID_BAR();
    { L0PTRS; RESID_PHASE(O, ws + WS_WOUT, D, modp(MODS, 0, 5), 1.0f); } GRID_BAR();
    LN_PASS(0, 1, H, modp(MODS, 0, 6), modp(MODS, 0, 7)); GRID_BAR();
    FFN(0, 1, 6, 2, H, modp(MODS, 1, 0), modp(MODS, 1, 1));
    FFN(1, 0, 0, 0, (bf16*)nullptr, (const float*)nullptr, (const float*)nullptr);
#define L1PTRS PTRS; bf16* A2 = (bf16*)(ws + WS_A2); bf16* R = (bf16*)(ws + WS_R); bf16* Kb = (bf16*)(ws + WS_K); bf16* V = (bf16*)(ws + WS_V); bf16* L1 = (bf16*)(ws + WS_L1A); \
        bf16* WRAW = (bf16*)(ws + WS_WRAW); bf16* YB = (bf16*)(ws + WS_YB); float* BON = (float*)(ws + WS_BON); bf16* AS = (bf16*)(ws + WS_AS); bf16* Gt = (bf16*)(ws + WS_G); (void)A2; (void)R; (void)Kb; (void)V; (void)L1; (void)WRAW; (void)YB; (void)BON; (void)AS; (void)Gt
    { L1PTRS; for (int row = gw; row < MTP; row += NGW) shiftcat_row(row, lane, X, MODS, INP(5), A2, out); } GRID_BAR();
    { L1PTRS; GEMM_PHASE(EpiRk, A2, ws + WS_WRK, NRK, KRK, (pg8::bf16_t*)R, (size_t)MTP * D, (pg8::bf16_t*)L1); if (XP == 7) { GEMM_PHASE(EpiRk, A2, ws + WS_WRK, NRK, KRK, (pg8::bf16_t*)R, (size_t)MTP * D, (pg8::bf16_t*)L1); } } GRID_BAR();
    { L1PTRS; GEMM_PHASE(EpiLora2, L1, ws + WS_WL2, 3072, NL1, (pg8::bf16_t*)WRAW, (pg8::bf16_t*)AS, (pg8::bf16_t*)Gt, INP(42)); } GRID_BAR();
    if (XP == 21 || XP == 22) { L1PTRS; bf16* dY = (bf16*)(ws + WS_L0 + 32 * MiB); float* dB = (float*)(ws + WS_L0 + 26 * MiB); float* dS = (float*)(ws + WS_L0 + 25 * MiB + 524288);
        if (XP == 21) wkv_half<1>((LAS float*)(lds + RING_OFF), tid, 0, 0, 0, R, Kb, V, WRAW, AS, INPD(39), INPD(47), INPD(48), INPD(49), dY, dB, dS);
        else wkv_half<2>((LAS float*)(lds + RING_OFF), tid, 0, 0, 0, R, Kb, V, WRAW, AS, INPD(39), INPD(47), INPD(48), INPD(49), dY, dB, dS); __syncthreads(); }
    for (int xr = 0; xr < (XP == 5 ? 2 : 1); ++xr) { L1PTRS; wkv_half<0>((LAS float*)(lds + RING_OFF), tid, blk >> 5, (blk >> 1) & 15, blk & 1, R, Kb, V, WRAW, AS, INPD(39), INPD(47), INPD(48), INPD(49), YB, BON, out + O_WKV_P); if (XP == 5) __syncthreads(); } GRID_BAR();
    { L1PTRS;
        for (int t = gw; t < NP; t += NGW) wkv_ypass_row((size_t)t, lane, YB, V, Gt, BON, INPD(50), INPD(51));
        for (int s = gws; s < 2048; s += NGW) wkv_job(wscr, lane, s >> 4, s & 15, R, Kb, V, WRAW, INPD(39), AS, Gt, INPD(47), INPD(48), INPD(49), INPD(50), INPD(51), NP, 1, INPD(6), out + O_WKV_S); }
    GRID_BAR();
    { L1PTRS; RESID_PHASE(Gt, ws + WS_WO, D, modp(MODS, 1, 5), 1.0f); } GRID_BAR();
    LN_PASS(1, 1, H, modp(MODS, 1, 6), modp(MODS, 1, 7)); GRID_BAR();
    { PTRS; GEMM_PHASE(EpiSwiglu, H, ws + WS_WUP_L1 + SZ_WUP, NUP, D, (pg8::bf16_t*)ACT); if (XP == 2) { GEMM_PHASE(EpiSwiglu, H, ws + WS_WUP_L1 + SZ_WUP, NUP, D, (pg8::bf16_t*)ACT); } } GRID_BAR();
    { PTRS; RESID_PHASE(ACT, ws + WS_WDN_L1 + SZ_WDN, FFP, modp(MODS, 1, 8), 0.5f); if (XP == 3) { RESID_PHASE(ACT, ws + WS_WDN_L1 + SZ_WDN, FFP, modp(MODS, 1, 8), 0.5f); } } GRID_BAR();
    LN_PASS(1, 2, (bf16*)nullptr, (const float*)nullptr, (const float*)nullptr); if (XP == 4) { LN_PASS(1, 2, (bf16*)nullptr, (const float*)nullptr, (const float*)nullptr); }
#if PROBE
    {
        __syncthreads();
        PTRS; const unsigned long long* TS = (const unsigned long long*)(ws + WS_CTL + 524288);
        const float v1 = (float)(TS[PROBE_A1] - TS[PROBE_A0]) * 0.01f, v2 = (float)(TS[PROBE_B1] - TS[PROBE_B0]) * 0.01f * 10.0f;
        for (int row = NP + gw; row < MT; row += NGW) for (int j = 0; j < 16; ++j) X[(size_t)row * D + j * 64 + lane] = v1;
        if (blk == 0 && tid == 0) out[O_WKV_S] = v2;
    }
#endif
}

extern "C" void kernel_launch(void* const* d_in, const int* in_sizes, int n_in, void* d_out, int out_size, void* d_ws, size_t ws_size, hipStream_t stream) {
    static int grid = 0;
    if (grid == 0) {
        if (n_in != 52 || ws_size < WS_END) { fprintf(stderr, "kernel_launch: unexpected n_in %d or ws %zu\n", n_in, ws_size); grid = -1; return; }
        int dev = 0, cus = 0, per_cu = 0;
        if (hipGetDevice(&dev) != hipSuccess || hipDeviceGetAttribute(&cus, hipDeviceAttributeMultiprocessorCount, dev) != hipSuccess) { grid = -1; return; }
        if (hipFuncSetAttribute((const void*)mk_fwd, hipFuncAttributeMaxDynamicSharedMemorySize, LDS_BYTES) != hipSuccess) { fprintf(stderr, "hipFuncSetAttribute failed\n"); grid = -1; return; }
        if (hipOccupancyMaxActiveBlocksPerMultiprocessor(&per_cu, (const void*)mk_fwd, NWAVES * 64, LDS_BYTES) != hipSuccess || per_cu < 1) { fprintf(stderr, "occupancy query: %d\n", per_cu); per_cu = 1; }
        (void)hipGetLastError();
        grid = cus;
    }
    if (grid < 0) return;
    (void)hipMemsetAsync((char*)d_ws + WS_CTL, 0, CTL_ZERO_BYTES, stream);
    Args a{};
    for (int i = 0; i < 52; ++i) a.in[i] = (const float*)d_in[i];
    a.out = (float*)d_out; a.ws = (unsigned char*)d_ws;
    hipLaunchKernelGGL(mk_fwd, dim3(grid), dim3(NWAVES * 64), LDS_BYTES, stream, a);
}
```

```cpp
#include <hip/hip_runtime.h>
#include <cstdint>
#include <cstdio>

#ifndef PROBE
#define PROBE 0
#endif
#define XP 0
#ifndef P0_PER
#define P0_PER 8
#endif
#ifndef MODS_HS
#define MODS_HS 6
#endif
#define PROBE_A0 63
#define PROBE_A1 1
#define PROBE_B0 1
#define PROBE_B1 4
typedef unsigned short bf16;
typedef short bf16x8 __attribute__((ext_vector_type(8)));
typedef float f32x4 __attribute__((ext_vector_type(4)));
#define DEVI __device__ __forceinline__
__device__ __forceinline__ void mk_syncthreads() { asm volatile("s_waitcnt vmcnt(0) lgkmcnt(0)" ::: "memory"); __builtin_amdgcn_s_barrier(); asm volatile("" ::: "memory"); }
#define __syncthreads() mk_syncthreads()

constexpr int D = 1024, NP = 16384, NS = 128, MT = NP + NS, MTP = 16640, TP = 2048, BP = 8;
constexpr int FF = 2752, FFP = 2816, NUP = 2 * FFP;
constexpr int NIN = 2064, NINP = 2304;
constexpr int NRK = 3584, KRK = 2048, NL1 = 384;
constexpr int NMODROW = 136;
constexpr float ALPHA = 1.41421356237309515f;

constexpr size_t O_Y = 0, O_GLA_P = 16908288, O_S5RE_P = 17170432, O_S5IM_P = 17186816, O_SHIFT_P = 17203200, O_WKV_P = 17211392,
                 O_GLA_S = 17735680, O_S5RE_S = 21929984, O_S5IM_S = 22192128, O_SHIFT_S = 22454272, O_WKV_S = 22585344;

constexpr size_t MiB = 1u << 20;
constexpr size_t WS_CTL = 0, CTL_ZERO_BYTES = 1 * MiB;
constexpr size_t WS_MODS = 1 * MiB, WS_SP = 12 * MiB, WS_ST = 344 * MiB, WS_ZS = 345 * MiB, WS_SL = 336 * MiB;
constexpr size_t WS_W = 13 * MiB;
constexpr size_t SZ_WUP = (size_t)NUP * D * 2;
constexpr size_t SZ_WDN = (size_t)D * FFP * 2;
constexpr size_t WS_L0 = WS_W;
constexpr size_t WS_WUP_L0 = WS_L0, WS_WDN_L0 = WS_L0 + 22 * MiB, WS_WIN = WS_L0 + 33 * MiB, WS_WGLU = WS_WIN + 4608 * 1024, WS_WOUT = WS_WGLU + 512 * 1024;
constexpr size_t WS_L1 = WS_L0 + 40 * MiB;
constexpr size_t WS_WUP_L1 = WS_L1, WS_WDN_L1 = WS_L1 + 22 * MiB, WS_WRK = WS_L1 + 33 * MiB, WS_WL2 = WS_WRK + 14 * MiB, WS_WO = WS_WL2 + 2304 * 1024;
static_assert(WS_WO + 2 * MiB <= 105 * MiB, "W region");
constexpr size_t WS_H = 105 * MiB, WS_Z = 138 * MiB, WS_ACT = 203 * MiB, WS_S2 = 293 * MiB, WS_END = 346 * MiB;
constexpr size_t WS_P = WS_ACT, WS_GKL = 277 * MiB, WS_Z5 = WS_Z, WS_O = WS_H, WS_DEC = 195 * MiB, WS_OGS = 196 * MiB, WS_KV = WS_S2;
constexpr size_t WS_UBUF = 155 * MiB, WS_HLOC = 179 * MiB, WS_HM = 326 * MiB, WS_TM = 330 * MiB;
constexpr size_t WS_A2 = WS_ACT, WS_K = WS_Z, WS_R = WS_Z - (size_t)MTP * D * 2, WS_V = WS_Z + (size_t)MTP * D * 2, WS_L1A = WS_L0, WS_WRAW = WS_ACT, WS_YB = WS_ACT + (size_t)MTP * D * 2, WS_BON = WS_L0 + 30 * MiB, WS_AS = 268 * MiB, WS_G = WS_AS + (size_t)MTP * D * 2;
static_assert(WS_G + (size_t)MTP * D * 2 <= WS_END, "ws");
constexpr int CW_TMO = 0, CW_BAR = 4096;

#define GAS __attribute__((address_space(1)))
#define LAS __attribute__((address_space(3)))
typedef unsigned short bf16;
typedef unsigned v4u __attribute__((ext_vector_type(4)));
typedef float f32x4 __attribute__((ext_vector_type(4)));
typedef short bf16x8 __attribute__((ext_vector_type(8)));
typedef GAS unsigned gu32;
typedef GAS unsigned long long gu64;
#define RLX_AGENT __ATOMIC_RELAXED, __HIP_MEMORY_SCOPE_AGENT
#define LDS_WAIT() asm volatile("s_waitcnt lgkmcnt(0)" ::: "memory")
#define VM_WAIT() asm volatile("s_waitcnt vmcnt(0)" ::: "memory")
__device__ __forceinline__ unsigned long long rt() { return __builtin_amdgcn_s_memrealtime(); }
__device__ __forceinline__ unsigned f2bf(float f) { unsigned u = __builtin_bit_cast(unsigned, f); return (u + 0x7fffu + ((u >> 16) & 1u)) >> 16; }
__device__ __forceinline__ unsigned pk2(float lo, float hi) { return f2bf(lo) | (f2bf(hi) << 16); }

#define XB_TMO      128
#define XB_XCNT(j)  (256  + 64 * (j))
#define XB_XSUB(j)  (1280 + 64 * (j))
#define XB_XGEN(j)  (2304 + 64 * (j))
#define XB_TOP      3328
#define XB_TOPGEN   3392
#define XCD_BAR_WORDS 3456
#define XB_SPIN_CAP (1u << 18)

__device__ __forceinline__ unsigned xb_ld(unsigned* p)              { return __hip_atomic_load(p, __ATOMIC_RELAXED, __HIP_MEMORY_SCOPE_AGENT); }
__device__ __forceinline__ unsigned xb_add(unsigned* p, unsigned v) { return __hip_atomic_fetch_add(p, v, __ATOMIC_RELAXED, __HIP_MEMORY_SCOPE_AGENT); }
__device__ __forceinline__ unsigned xb_xcc_id() { return (unsigned)__builtin_amdgcn_s_getreg((3 << 11) | 20) & 0xFu; }
#define XB_SPIN(cond, bar) do { unsigned _sp = 0; while (cond) { __builtin_amdgcn_s_sleep(1); \
    if ((++_sp & 255u) == 0u) { if (xb_ld(&(bar)[XB_TMO])) break; if (_sp > XB_SPIN_CAP) { atomicAdd(&(bar)[XB_TMO], 1u); break; } } } } while (0)

struct XcdBarrier {
    unsigned* bar; unsigned x;
    volatile LAS unsigned* st;
};

__device__ __forceinline__ XcdBarrier xcd_barrier_post(unsigned* bar, volatile LAS unsigned* st) {
    XcdBarrier b; b.bar = bar; b.x = xb_xcc_id(); b.st = st;
    if (threadIdx.x == 0) (void)xb_add(&bar[XB_XCNT(b.x)], 1u);
    return b;
}
__device__ __forceinline__ void xcd_barrier_complete(unsigned* bar, unsigned x, unsigned& nloc, unsigned& nx) {
    const unsigned G = gridDim.x * gridDim.y * gridDim.z;
    unsigned sum, cnt, mine, sp = 0u;
    for (;;) {
        sum = 0u; cnt = 0u; mine = 0u;
#pragma unroll
        for (unsigned j = 0; j < 16; ++j) { const unsigned c = xb_ld(&bar[XB_XCNT(j)]); sum += c; cnt += (c > 0u) ? 1u : 0u; mine = (j == x) ? c : mine; }
        if (sum == G) break;
        __builtin_amdgcn_s_sleep(1);
        if ((++sp & 255u) == 0u) { if (xb_ld(&bar[XB_TMO])) break; if (sp > XB_SPIN_CAP) { atomicAdd(&bar[XB_TMO], 1u); break; } }
    }
    nloc = mine > 0u ? mine : 1u; nx = cnt > 0u ? cnt : 1u;
}

__device__ __forceinline__ void xcd_barrier(const XcdBarrier& b) {
    asm volatile("s_waitcnt vmcnt(0)" ::: "memory");
    __syncthreads();
    if (threadIdx.x == 0) {
        unsigned* bar = b.bar;
        __builtin_amdgcn_s_waitcnt(0);
        unsigned nloc = b.st[0], nx = b.st[1];
        if (nloc == 0u) { xcd_barrier_complete(bar, b.x, nloc, nx); b.st[0] = nloc; b.st[1] = nx; }
        const unsigned old = xb_add(&bar[XB_XSUB(b.x)], 1u);
        const unsigned gen = old / nloc;
        if (old + 1u == (gen + 1u) * nloc) {
            __builtin_amdgcn_fence(__ATOMIC_RELEASE, "agent");
            asm volatile("s_waitcnt vmcnt(0)" ::: "memory");
            const unsigned og = xb_add(&bar[XB_TOP], 1u);
            const unsigned tg = og / nx;
            if (og + 1u == (tg + 1u) * nx) xb_add(&bar[XB_TOPGEN], 1u);
            else XB_SPIN(xb_ld(&bar[XB_TOPGEN]) == tg, bar);
            __builtin_amdgcn_fence(__ATOMIC_ACQUIRE, "agent");
            xb_add(&bar[XB_XGEN(b.x)], 1u);
            asm volatile("s_waitcnt vmcnt(0)" ::: "memory");
        } else {
            XB_SPIN(xb_ld(&bar[XB_XGEN(b.x)]) == gen, bar);
            __builtin_amdgcn_fence(__ATOMIC_ACQUIRE, "agent");
            asm volatile("s_waitcnt vmcnt(0)" ::: "memory");
        }
    }
    __syncthreads();
}

DEVI float bf2f(unsigned short h) { return __uint_as_float(((unsigned)h) << 16); }
DEVI int mrow(int i) { return i < NP ? (i >> 11) : (8 + i - NP); }
DEVI float sigmoidf_(float x) { return 1.0f / (1.0f + __expf(-x)); }
DEVI float siluf_(float x) { return x / (1.0f + __expf(-x)); }
DEVI float softplusf_(float x) { return fmaxf(x, 0.f) + log1pf(__expf(-fabsf(x))); }
DEVI float gelu_tanh(float x) { const float u = 0.7978845608028654f * (x + 0.044715f * x * x * x); return 0.5f * x * (1.0f + tanhf(u)); }
DEVI float wave_sum(float v) {
#pragma unroll
    for (int o = 1; o < 64; o <<= 1) v += __shfl_xor(v, o);
    return v;
}
__host__ __device__ __forceinline__ const float* modp(const float* mods, int l, int which) { return mods + (size_t)l * NMODROW * 9216 + which * 1024; }

namespace pg8 {
#define PG8_LAS __attribute__((address_space(3)))
typedef unsigned short bf16_t;
typedef short bf16x8 __attribute__((ext_vector_type(8)));
typedef float f32x4 __attribute__((ext_vector_type(4)));
typedef unsigned u32x4 __attribute__((ext_vector_type(4)));
constexpr int BM = 256, BK = 64, HALF = 128, HTB = HALF * BK * 2  , STAGE_BYTES = 8 * HTB, NXCD = 8, WGM = 8;

__host__ __device__ __forceinline__ int lds_byte(int r, int c) { const int st = (r >> 4) * 2 + (c >> 5), rr = r & 15, cc = c & 31, ob = rr * 64 + cc * 2; return st * 1024 + (ob ^ (((ob >> 9) & 1) << 5)); }
__host__ __device__ __forceinline__ void stage_rc(int b, int& R, int& C) { const int st = b / 1024, sb = b % 1024, swz = sb ^ (((sb >> 9) & 1) << 5); R = (st >> 1) * 16 + swz / 64; C = (st & 1) * 32 + (swz % 64) / 2; }
__host__ __device__ __forceinline__ int perm32(int rho) { const int n = rho >> 4, i = rho & 15; return 8 * (i >> 2) + 4 * n + (i & 3); }

struct Unit { int pm, pn, ko; };
struct Gemm { const bf16_t* A; const bf16_t* Bt; int M, N, K; };
struct GemmX { const bf16_t* A; const bf16_t* Bt; int M, N, K, lda, ldb, gsh; };

struct StaticOrder {
    int nM, nN, nwg, G, c;
    __host__ __device__ __forceinline__ void init(int M, int N, int G_, int c_) { nM = M / BM; nN = N / BM; nwg = nM * nN; G = G_; c = c_; }
    __host__ __device__ __forceinline__ bool next(int i, Unit& u) const {
        const long L = (long)i * G + c; if (L >= nwg) return false;
        int wgid = (int)L; { const int q = nwg / NXCD, r = nwg % NXCD, xcd = wgid % NXCD, off = wgid / NXCD; wgid = (xcd < r ? xcd * (q + 1) : r * (q + 1) + (xcd - r) * q) + off; }
        const int nig = WGM * nN, gid = wgid / nig, fm = gid * WGM, gsz = (nM - fm) < WGM ? (nM - fm) : WGM;
        u.pm = fm + ((wgid % nig) % gsz); u.pn = (wgid % nig) / gsz; u.ko = 0; return true;
    }
    __device__ __forceinline__ void a_ready(const Unit&) const {}
    __device__ __forceinline__ void done(const Unit&) const {}
};

struct SplitOrder {
    int pm0, nN, nsplit, kspl, G, c;
    __host__ __device__ __forceinline__ bool next(int i, Unit& u) const { const int L = i * G + c; if (L >= nsplit * nN) return false; u.pm = pm0; u.pn = L % nN; u.ko = (L / nN) * kspl; return true; }
    __device__ __forceinline__ void a_ready(const Unit&) const {}
    __device__ __forceinline__ void done(const Unit&) const {}
};

__device__ __forceinline__ unsigned cvt_pk_bf16(float lo, float hi) { unsigned r; asm volatile("v_cvt_pk_bf16_f32 %0, %1, %2" : "=v"(r) : "v"(lo), "v"(hi)); return r; }
__device__ __forceinline__ float fsilu(float x) { return x * __builtin_amdgcn_rcpf(1.0f + __builtin_amdgcn_exp2f(-1.44269504089f * x)); }
__device__ __forceinline__ float fsigm(float x) { return __builtin_amdgcn_rcpf(1.0f + __builtin_amdgcn_exp2f(-1.44269504089f * x)); }
__device__ __forceinline__ u32x4 pack8(const f32x4 a, const f32x4 b) { u32x4 w; w.x = cvt_pk_bf16(a[0], a[1]); w.y = cvt_pk_bf16(a[2], a[3]); w.z = cvt_pk_bf16(b[0], b[1]); w.w = cvt_pk_bf16(b[2], b[3]); return w; }
struct EpiSwiglu { static constexpr bool PERM = true, AFTER_DRAIN = false; bf16_t* ACT;
    __device__ __forceinline__ void operator()(const f32x4 (&acc)[2][2][4][2], const Unit& u, int wr, int wc, int fr, int fq) const {
        const int row0 = u.pm * BM + wr * 64 + fr, col0 = u.pn * 128 + wc * 32 + 8 * fq;
#pragma unroll
        for (int ai = 0; ai < 2; ++ai)
#pragma unroll
            for (int m = 0; m < 4; ++m) { f32x4 o0, o1;
#pragma unroll
                for (int e = 0; e < 4; ++e) { o0[e] = fsilu(acc[ai][0][m][0][e]) * acc[ai][1][m][0][e]; o1[e] = fsilu(acc[ai][0][m][1][e]) * acc[ai][1][m][1][e]; }
                *(u32x4*)(ACT + (size_t)(row0 + ai * HALF + m * 16) * 2816 + col0) = pack8(o0, o1); }
    } };
struct EpiResid { static constexpr bool PERM = true, AFTER_DRAIN = false; const float* X; float* Z; const float* gate; float rc; int pad;
    __device__ __forceinline__ void operator()(const f32x4 (&acc)[2][2][4][2], const Unit& u, int wr, int wc, int fr, int fq) const {
        const float* __restrict__ xp = X + (size_t)(u.pm * BM + wr * 64 + fr) * 1024 + u.pn * BM + wc * 32 + 8 * fq; float* __restrict__ zp = Z + (size_t)(u.pm * BM + wr * 64 + fr) * 1024 + u.pn * BM + wc * 32 + 8 * fq;
        const float* __restrict__ gp = gate + (size_t)(u.pm >> 3) * 9216 + u.pn * BM + wc * 32 + 8 * fq;
        f32x4 g[2][2], xa[2][2], xb[2][2];
#pragma unroll
        for (int bj = 0; bj < 2; ++bj)
#pragma unroll
            for (int n = 0; n < 2; ++n) { g[bj][n] = (*(const f32x4*)(gp + bj * HALF + 4 * n) + 1.0f) * rc; xa[bj][n] = *(const f32x4*)(xp + bj * HALF + 4 * n); }
#pragma unroll
        for (int i = 0; i < 8; ++i) { const int ai = i >> 2, m = i & 3; const size_t ro = (size_t)(ai * HALF + m * 16) * 1024;
            if (i + 1 < 8) { const size_t rn = (size_t)(((i + 1) >> 2) * HALF + ((i + 1) & 3) * 16) * 1024;
#pragma unroll
                for (int bj = 0; bj < 2; ++bj)
#pragma unroll
                    for (int n = 0; n < 2; ++n) { if (i & 1) xa[bj][n] = *(const f32x4*)(xp + rn + bj * HALF + 4 * n); else xb[bj][n] = *(const f32x4*)(xp + rn + bj * HALF + 4 * n); } }
#pragma unroll
            for (int bj = 0; bj < 2; ++bj)
#pragma unroll
                for (int n = 0; n < 2; ++n) { const f32x4 x = (i & 1) ? xb[bj][n] : xa[bj][n]; *(f32x4*)(zp + ro + bj * HALF + 4 * n) = x * 1.41421356237309515f + g[bj][n] * acc[ai][bj][m][n]; } }
    } };
struct EpiInproj { static constexpr bool PERM = true, AFTER_DRAIN = false; bf16_t* P; float* GKL; bf16_t* UB;
    __device__ __forceinline__ void operator()(const f32x4 (&acc)[2][2][4][2], const Unit& u, int wr, int wc, int fr, int fq) const {
        const int row0 = u.pm * BM + wr * 64 + fr;
#pragma unroll
        for (int ai = 0; ai < 2; ++ai)
#pragma unroll
            for (int m = 0; m < 4; ++m) { const int row = row0 + ai * HALF + m * 16;
#pragma unroll
                for (int bj = 0; bj < 2; ++bj) { const int c = u.pn * BM + bj * HALF + wc * 32 + 8 * fq;
                    const u32x4 pk = pack8(acc[ai][bj][m][0], acc[ai][bj][m][1]);
                    *(u32x4*)(P + (size_t)row * 2304 + c) = pk;
                    if (c >= 1552 && c < 2064 && row < 16384) { const int cu = c - 1552; *(u32x4*)(UB + ((size_t)((cu >> 4) * 1024 + (row >> 4))) * 384 + (row & 15) * 16 + (cu & 15)) = pk; }
                    if (c >= 1536 && c < 1552) { *(f32x4*)(GKL + (size_t)row * 16 + (c - 1536)) = acc[ai][bj][m][0]; *(f32x4*)(GKL + (size_t)row * 16 + (c - 1536) + 4) = acc[ai][bj][m][1]; } } }
    } };
struct EpiGlu { static constexpr bool PERM = true, AFTER_DRAIN = false; const bf16_t* Z5; bf16_t* O; const float* bg;
    __device__ __forceinline__ void operator()(const f32x4 (&acc)[2][2][4][2], const Unit& u, int wr, int wc, int fr, int fq) const {
        const int cb = u.pn * BM + wc * 32 + 8 * fq;
        const bf16_t* __restrict__ zp = Z5 + (size_t)(u.pm * BM + wr * 64 + fr) * 512 + cb; bf16_t* __restrict__ op = O + (size_t)(u.pm * BM + wr * 64 + fr) * 1024 + 512 + cb;
        f32x4 b[2][2]; u32x4 za[2], zb[2];
#pragma unroll
        for (int bj = 0; bj < 2; ++bj) { b[bj][0] = *(const f32x4*)(bg + cb + bj * HALF); b[bj][1] = *(const f32x4*)(bg + cb + bj * HALF + 4); za[bj] = *(const u32x4*)(zp + bj * HALF); }
#pragma unroll
        for (int i = 0; i < 8; ++i) { const int ai = i >> 2, m = i & 3; const size_t rr = (size_t)(ai * HALF + m * 16);
            if (i + 1 < 8) { const size_t rn = (size_t)(((i + 1) >> 2) * HALF + ((i + 1) & 3) * 16) * 512;
#pragma unroll
                for (int bj = 0; bj < 2; ++bj) { if (i & 1) za[bj] = *(const u32x4*)(zp + rn + bj * HALF); else zb[bj] = *(const u32x4*)(zp + rn + bj * HALF); } }
#pragma unroll
            for (int bj = 0; bj < 2; ++bj) { const u32x4 zz = (i & 1) ? zb[bj] : za[bj]; f32x4 o0, o1;
#pragma unroll
                for (int e = 0; e < 4; ++e) { const unsigned w0 = zz[e >> 1], w1 = zz[2 + (e >> 1)];
                    const float z0 = __uint_as_float((e & 1) ? (w0 & 0xffff0000u) : (w0 << 16)), z1 = __uint_as_float((e & 1) ? (w1 & 0xffff0000u) : (w1 << 16));
                    o0[e] = z0 * fsigm(acc[ai][bj][m][0][e] + b[bj][0][e]); o1[e] = z1 * fsigm(acc[ai][bj][m][1][e] + b[bj][1][e]); }
                *(u32x4*)(op + rr * 1024 + bj * HALF) = pack8(o0, o1); } }
    } };
__device__ __forceinline__ float ftanh(float x) { const float e = __builtin_amdgcn_exp2f(-2.88539008178f * fabsf(x)); const float t = (1.0f - e) * __builtin_amdgcn_rcpf(1.0f + e); return x < 0.f ? -t : t; }
struct EpiRk { static constexpr bool PERM = true, AFTER_DRAIN = false; bf16_t* R; size_t rkv_stride; bf16_t* L1;
    __device__ __forceinline__ void operator()(const f32x4 (&acc)[2][2][4][2], const Unit& u, int wr, int wc, int fr, int fq) const {
        const int row0 = u.pm * BM + wr * 64 + fr;
#pragma unroll
        for (int ai = 0; ai < 2; ++ai)
#pragma unroll
            for (int m = 0; m < 4; ++m) { const int row = row0 + ai * HALF + m * 16;
#pragma unroll
                for (int bj = 0; bj < 2; ++bj) { const int c = u.pn * BM + bj * HALF + wc * 32 + 8 * fq;
                    if (c < 3072) { bf16_t* dst = R + (size_t)(c >> 10) * rkv_stride; *(u32x4*)(dst + (size_t)row * 1024 + (c & 1023)) = pack8(acc[ai][bj][m][0], acc[ai][bj][m][1]); }
                    else { const int cc = c - 3072; if (cc < 384) { f32x4 o0 = acc[ai][bj][m][0], o1 = acc[ai][bj][m][1];
                        if (cc < 64) {
#pragma unroll
                            for (int e = 0; e < 4; ++e) { o0[e] = ftanh(o0[e]); o1[e] = ftanh(o1[e]); } }
                        else if (cc >= 128 && cc < 288) {
#pragma unroll
                            for (int e = 0; e < 4; ++e) { o0[e] = fsigm(o0[e]); o1[e] = fsigm(o1[e]); } }
                        else if (cc >= 288) { o0 = (f32x4){0.f, 0.f, 0.f, 0.f}; o1 = o0; }
                        *(u32x4*)(L1 + (size_t)row * 384 + cc) = pack8(o0, o1); } } } }
    } };
struct EpiLora2 { static constexpr bool PERM = true, AFTER_DRAIN = false; bf16_t* WRAW; bf16_t* AS; bf16_t* G; const float* a0;
    __device__ __forceinline__ void operator()(const f32x4 (&acc)[2][2][4][2], const Unit& u, int wr, int wc, int fr, int fq) const {
        const int row0 = u.pm * BM + wr * 64 + fr;
#pragma unroll
        for (int ai = 0; ai < 2; ++ai)
#pragma unroll
            for (int m = 0; m < 4; ++m) { const int row = row0 + ai * HALF + m * 16;
#pragma unroll
                for (int bj = 0; bj < 2; ++bj) { const int c = u.pn * BM + bj * HALF + wc * 32 + 8 * fq;
                    if (c < 1024) *(u32x4*)(WRAW + (size_t)row * 1024 + c) = pack8(acc[ai][bj][m][0], acc[ai][bj][m][1]);
                    else if (c < 2048) { const f32x4 a0v = *(const f32x4*)(a0 + c - 1024), a1v = *(const f32x4*)(a0 + c - 1024 + 4); f32x4 o0, o1;
#pragma unroll
                        for (int e = 0; e < 4; ++e) { o0[e] = fsigm(a0v[e] + acc[ai][bj][m][0][e]); o1[e] = fsigm(a1v[e] + acc[ai][bj][m][1][e]); }
                        *(u32x4*)(AS + (size_t)row * 1024 + c - 1024) = pack8(o0, o1); }
                    else *(u32x4*)(G + (size_t)row * 1024 + c - 2048) = pack8(acc[ai][bj][m][0], acc[ai][bj][m][1]); } }
    } };
struct EpiHloc { static constexpr bool PERM = true, AFTER_DRAIN = false; float* HL;
    __device__ __forceinline__ void operator()(const f32x4 (&acc)[2][2][4][2], const Unit& u, int wr, int wc, int fr, int fq) const {
        const int row0 = u.pm * BM + wr * 64 + fr, c = wc * 32 + 8 * fq;
#pragma unroll
        for (int ai = 0; ai < 2; ++ai)
#pragma unroll
            for (int m = 0; m < 4; ++m) { float* p = HL + (size_t)(row0 + ai * HALF + m * 16) * 128 + c; *(f32x4*)p = acc[ai][0][m][0]; *(f32x4*)(p + 4) = acc[ai][0][m][1]; }
    } };
__device__ __forceinline__ float fgelu(float x) { const float u2 = 1.5957691216057308f * (x + 0.044715f * x * x * x); return x * fsigm(u2); }
struct EpiS5Y { static constexpr bool PERM = true, AFTER_DRAIN = false; bf16_t* Z5;
    __device__ __forceinline__ void operator()(const f32x4 (&acc)[2][2][4][2], const Unit& u, int wr, int wc, int fr, int fq) const {
        const int row0 = u.pm * BM + wr * 64 + fr;
#pragma unroll
        for (int ai = 0; ai < 2; ++ai)
#pragma unroll
            for (int m = 0; m < 4; ++m) { const int row = row0 + ai * HALF + m * 16, g = row >> 10, chunk = row & 1023;
#pragma unroll
                for (int bj = 0; bj < 2; ++bj) { const int c = bj * HALF + wc * 32 + 8 * fq, t = c >> 4, co = c & 15; f32x4 o0, o1;
#pragma unroll
                    for (int e = 0; e < 4; ++e) { o0[e] = fgelu(acc[ai][bj][m][0][e]); o1[e] = fgelu(acc[ai][bj][m][1][e]); }
                    *(u32x4*)(Z5 + (size_t)(chunk * 16 + t) * 512 + g * 16 + co) = pack8(o0, o1); } }
    } };

struct EpiResidS { static constexpr bool PERM = true, AFTER_DRAIN = false; float* SL; const float* gate; float rc; int pad;
    __device__ __forceinline__ void operator()(const f32x4 (&acc)[2][2][4][2], const Unit& u, int wr, int wc, int fr, int fq) const {
        const int r0 = wr * 64 + fr; float* __restrict__ sl = SL + (size_t)(u.ko >> 8) * 128 * 1024;
#pragma unroll
        for (int m = 0; m < 4; ++m) { const int r = r0 + m * 16; const int mr = 8 + r;
#pragma unroll
            for (int bj = 0; bj < 2; ++bj)
#pragma unroll
                for (int n = 0; n < 2; ++n) { const int c = u.pn * BM + bj * HALF + wc * 32 + 8 * fq + 4 * n; const f32x4 g = *(const f32x4*)(gate + (size_t)mr * 9216 + c);
                    *(f32x4*)(sl + (size_t)r * 1024 + c) = (g + 1.0f) * rc * acc[0][bj][m][n]; } }
    } };
enum { EK_SWIGLU = 0, EK_RESID, EK_RESIDS, EK_INPROJ, EK_GLU, EK_RK, EK_LORA2, EK_HLOC, EK_S5Y };
struct EpiAny { static constexpr bool PERM = true, AFTER_DRAIN = false; int kind; void* p0; void* p1; const void* p2; const void* p3; float f0;
    __device__ __forceinline__ void operator()(const f32x4 (&acc)[2][2][4][2], const Unit& u, int wr, int wc, int fr, int fq) const {
        asm volatile("" : "+v"(fr), "+v"(fq));
        switch (kind) {
        case EK_SWIGLU: { EpiSwiglu e{(bf16_t*)p0}; e(acc, u, wr, wc, fr, fq); break; }
        case EK_RESID: { EpiResid e{(const float*)p0, (float*)p1, (const float*)p2, f0, 0}; e(acc, u, wr, wc, fr, fq); break; }
        case EK_RESIDS: { EpiResidS e{(float*)p0, (const float*)p2, f0, 0}; e(acc, u, wr, wc, fr, fq); break; }
        case EK_INPROJ: { EpiInproj e{(bf16_t*)p0, (float*)p1, (bf16_t*)p2}; e(acc, u, wr, wc, fr, fq); break; }
        case EK_GLU: { EpiGlu e{(const bf16_t*)p0, (bf16_t*)p1, (const float*)p2}; e(acc, u, wr, wc, fr, fq); break; }
        case EK_RK: { EpiRk e{(bf16_t*)p0, (size_t)16640 * 1024, (bf16_t*)p1}; e(acc, u, wr, wc, fr, fq); break; }
        case EK_LORA2: { EpiLora2 e{(bf16_t*)p0, (bf16_t*)p1, (bf16_t*)p2, (const float*)p3}; e(acc, u, wr, wc, fr, fq); break; }
        case EK_HLOC: { EpiHloc e{(float*)p0}; e(acc, u, wr, wc, fr, fq); break; }
        default: { EpiS5Y e{(bf16_t*)p0}; e(acc, u, wr, wc, fr, fq); break; }
        }
    } };
struct AnyOrder { StaticOrder so; SplitOrder sp; int split;
    __device__ __forceinline__ bool next(int i, Unit& u) const { return split ? sp.next(i, u) : so.next(i, u); }
    __device__ __forceinline__ void a_ready(const Unit&) const {}
    __device__ __forceinline__ void done(const Unit&) const {} };
template <class Epi, class Sched, bool ALIGN_EPI = false, bool SP2 = false>
__device__ __forceinline__ void gemm_phase(PG8_LAS unsigned char* lds, const GemmX g, const Sched& S, const Epi& E) {
    int tid_ = threadIdx.x; asm volatile("" : "+v"(tid_));
    const int tid = tid_, wid = __builtin_amdgcn_readfirstlane(tid >> 6), lane = tid & 63, wr = wid >> 2, wc = wid & 3, fr = lane & 15, fq = lane >> 4;
    int K_ = g.K; asm volatile("" : "+s"(K_));
    const int K = K_, nt = K / BK;
    int lda_ = g.lda, ldb_ = g.ldb; asm volatile("" : "+s"(lda_), "+s"(ldb_)); const int lda = lda_, ldb = ldb_, gsh = g.gsh, nNb = g.N / BM;
    unsigned voffA[2], voffB[2];
#pragma unroll
    for (int i = 0; i < 2; ++i) { int R, C; stage_rc(tid * 16 + i * 8192, R, C); const int Rb = Epi::PERM ? ((R & ~31) + perm32(R & 31)) : R;
        voffA[i] = (unsigned)(R * lda + C) * 2u; voffB[i] = (unsigned)(Rb * ldb + C) * 2u; }
    const size_t kstep = (size_t)(BK * 2);
    const size_t hstepA = (size_t)HALF * lda * 2, hstepB = (size_t)HALF * ldb * 2;
    const size_t tstepA = 2 * hstepA, tstepB = 2 * hstepB;
#define PG8_BTILE(u_) ((size_t)(gsh >= 0 ? ((u_).pm >> gsh) * nNb + (u_).pn : (u_).pn))
    const unsigned ldsw = (unsigned)wid * 1024u;
    const int aoff = lds_byte(wr * 64 + fr, fq * 8), boff = lds_byte(wc * 32 + fr, fq * 8);
#define PG8_SA(b, h) (((b) * 2 + (h)) * HTB)
#define PG8_SB(b, h) ((4 + (b) * 2 + (h)) * HTB)
#define PG8_STAGE(bufoff, gbase, voff) do { _Pragma("unroll") for (int _i = 0; _i < 2; ++_i) \
        __builtin_amdgcn_global_load_lds((const unsigned*)((const char*)(gbase) + (voff)[_i]), (PG8_LAS unsigned*)(lds + (bufoff) + ldsw + _i * 8192), 16, 0, 0); } while (0)
#define PG8_LDA(dst, b, h) do { _Pragma("unroll") for (int m = 0; m < 4; ++m) _Pragma("unroll") for (int k = 0; k < 2; ++k) dst[m][k] = *(const PG8_LAS bf16x8*)(lds + PG8_SA(b, h) + aoff + m * 2048 + k * 1024); } while (0)
#define PG8_LDB(dst, b, h) do { _Pragma("unroll") for (int n = 0; n < 2; ++n) _Pragma("unroll") for (int k = 0; k < 2; ++k) dst[n][k] = *(const PG8_LAS bf16x8*)(lds + PG8_SB(b, h) + boff + n * 2048 + k * 1024); } while (0)
#define PG8_MMA(ai, bj, At, Bt) do { __builtin_amdgcn_s_setprio(1); _Pragma("unroll") for (int m = 0; m < 4; ++m) _Pragma("unroll") for (int n = 0; n < 2; ++n) _Pragma("unroll") for (int k = 0; k < 2; ++k) \
        acc[ai][bj][m][n] = __builtin_amdgcn_mfma_f32_16x16x32_bf16(Bt[n][k], At[m][k], acc[ai][bj][m][n], 0, 0, 0); __builtin_amdgcn_s_setprio(0); } while (0)
#define PG8_WAIT_V(n) asm volatile("s_waitcnt vmcnt(" #n ")" ::: "memory")
#define PG8_WAIT_L(n) asm volatile("s_waitcnt lgkmcnt(" #n ")" ::: "memory")
#define PG8_BAR __builtin_amdgcn_s_barrier()
#define PG8_SCHED __builtin_amdgcn_sched_barrier(0)
    Unit cur, nxt; int ui = 0;
    if (!S.next(0, cur)) return;
    f32x4 acc[2][2][4][2];
#pragma unroll
    for (int a = 0; a < 2; ++a)
#pragma unroll
        for (int b = 0; b < 2; ++b)
#pragma unroll
            for (int m = 0; m < 4; ++m)
#pragma unroll
                for (int n = 0; n < 2; ++n) acc[a][b][m][n] = (f32x4){0.f, 0.f, 0.f, 0.f};
    bf16x8 At[4][2], B0[2][2], B1[2][2];
    const char* cA = (const char*)g.A + (size_t)cur.pm * tstepA + (size_t)cur.ko * 2; const char* cB = (const char*)g.Bt + PG8_BTILE(cur) * tstepB + (size_t)cur.ko * 2;
    S.a_ready(cur);
    if constexpr (SP2) {
        PG8_STAGE(PG8_SB(0, 0), cB, voffB); PG8_STAGE(PG8_SB(0, 1), cB + hstepB, voffB); PG8_STAGE(PG8_SA(0, 0), cA, voffA); PG8_STAGE(PG8_SA(0, 1), cA + hstepA, voffA);
        if (wr == 1) PG8_BAR;
        PG8_WAIT_V(2); PG8_BAR;
        PG8_STAGE(PG8_SB(1, 0), cB + kstep, voffB); PG8_STAGE(PG8_SA(1, 0), cA + kstep, voffA); PG8_STAGE(PG8_SB(1, 1), cB + hstepB + kstep, voffB);
        PG8_WAIT_V(6); PG8_BAR;
    } else {
        PG8_STAGE(PG8_SB(0, 0), cB, voffB); PG8_STAGE(PG8_SA(0, 0), cA, voffA); PG8_STAGE(PG8_SB(0, 1), cB + hstepB, voffB); PG8_STAGE(PG8_SA(0, 1), cA + hstepA, voffA);
        if (wr == 1) PG8_BAR;
        PG8_WAIT_V(4); PG8_BAR;
        PG8_STAGE(PG8_SB(1, 0), cB + kstep, voffB); PG8_STAGE(PG8_SA(1, 0), cA + kstep, voffA); PG8_STAGE(PG8_SB(1, 1), cB + hstepB + kstep, voffB);
        PG8_WAIT_V(6); PG8_BAR;
    }
    for (;;) {
        const bool has_next = S.next(ui + 1, nxt);
        const char* nA = has_next ? (const char*)g.A + (size_t)nxt.pm * tstepA + (size_t)nxt.ko * 2 : cA; const char* nB = has_next ? (const char*)g.Bt + PG8_BTILE(nxt) * tstepB + (size_t)nxt.ko * 2 : cB;
        for (int t = 0; t < nt; t += 2) {
            const bool last = (t == nt - 2);
            const char* a1 = cA + (size_t)(t + 1) * kstep;
            const char* a2 = last ? nA : cA + (size_t)(t + 2) * kstep; const char* b2 = last ? nB : cB + (size_t)(t + 2) * kstep;
            const char* a3 = a2 + kstep; const char* b3 = b2 + kstep;
            if (last && has_next) S.a_ready(nxt);
            if constexpr (SP2) {
            PG8_LDB(B0, 0, 0); PG8_LDB(B1, 0, 1); PG8_SCHED; PG8_LDA(At, 0, 0); PG8_STAGE(PG8_SA(1, 1), a1 + hstepA, voffA);
            PG8_WAIT_V(8); PG8_WAIT_L(0); PG8_BAR; PG8_MMA(0, 0, At, B0); PG8_MMA(0, 1, At, B1); PG8_BAR; PG8_SCHED;
            PG8_LDA(At, 0, 1); PG8_STAGE(PG8_SB(0, 0), b2, voffB); PG8_STAGE(PG8_SB(0, 1), b2 + hstepB, voffB); PG8_STAGE(PG8_SA(0, 0), a2, voffA);
            PG8_WAIT_V(8); PG8_WAIT_L(0); PG8_BAR; PG8_MMA(1, 0, At, B0); PG8_MMA(1, 1, At, B1); PG8_BAR; PG8_SCHED;
            PG8_LDB(B0, 1, 0); PG8_LDB(B1, 1, 1); PG8_SCHED; PG8_LDA(At, 1, 0); PG8_STAGE(PG8_SA(0, 1), a2 + hstepA, voffA);
            PG8_WAIT_V(8); PG8_WAIT_L(0); PG8_BAR; PG8_MMA(0, 0, At, B0); PG8_MMA(0, 1, At, B1); PG8_BAR; PG8_SCHED;
            PG8_LDA(At, 1, 1); PG8_STAGE(PG8_SB(1, 0), b3, voffB); PG8_STAGE(PG8_SB(1, 1), b3 + hstepB, voffB); PG8_STAGE(PG8_SA(1, 0), a3, voffA);
            PG8_WAIT_V(8); PG8_WAIT_L(0); PG8_BAR; PG8_MMA(1, 0, At, B0); PG8_MMA(1, 1, At, B1); PG8_BAR; PG8_SCHED;
            } else {
            PG8_LDB(B0, 0, 0); PG8_SCHED; PG8_LDA(At, 0, 0); PG8_STAGE(PG8_SA(1, 1), a1 + hstepA, voffA);
            PG8_WAIT_L(8); PG8_BAR; PG8_WAIT_L(0); PG8_MMA(0, 0, At, B0); PG8_BAR; PG8_SCHED;
            PG8_LDB(B1, 0, 1); PG8_STAGE(PG8_SB(0, 0), b2, voffB);
            PG8_BAR; PG8_WAIT_L(0); PG8_MMA(0, 1, At, B1); PG8_BAR;
            PG8_LDA(At, 0, 1); PG8_STAGE(PG8_SA(0, 0), a2, voffA);
            PG8_BAR; PG8_WAIT_L(0); PG8_MMA(1, 0, At, B0); PG8_BAR; PG8_SCHED;
            PG8_STAGE(PG8_SB(0, 1), b2 + hstepB, voffB);
            PG8_WAIT_V(6); PG8_BAR; PG8_MMA(1, 1, At, B1); PG8_BAR;
            PG8_LDB(B0, 1, 0); PG8_SCHED; PG8_LDA(At, 1, 0); PG8_STAGE(PG8_SA(0, 1), a2 + hstepA, voffA);
            PG8_WAIT_L(8); PG8_BAR; PG8_WAIT_L(0); PG8_MMA(0, 0, At, B0); PG8_BAR; PG8_SCHED;
            PG8_LDB(B1, 1, 1); PG8_STAGE(PG8_SB(1, 0), b3, voffB);
            PG8_BAR; PG8_WAIT_L(0); PG8_MMA(0, 1, At, B1); PG8_BAR;
            PG8_LDA(At, 1, 1); PG8_STAGE(PG8_SA(1, 0), a3, voffA);
            PG8_BAR; PG8_WAIT_L(0); PG8_MMA(1, 0, At, B0); PG8_BAR; PG8_SCHED;
            PG8_STAGE(PG8_SB(1, 1), b3 + hstepB, voffB);
            PG8_WAIT_V(6); PG8_BAR; PG8_MMA(1, 1, At, B1); PG8_BAR;
            }
        }
        if constexpr (ALIGN_EPI) { if (wr == 0) PG8_BAR; }
        if constexpr (!Epi::AFTER_DRAIN) { E(acc, cur, wr, wc, fr, fq); S.done(cur); }
        if (!has_next) break;
#pragma unroll
        for (int a = 0; a < 2; ++a)
#pragma unroll
            for (int b = 0; b < 2; ++b)
#pragma unroll
                for (int m = 0; m < 4; ++m)
#pragma unroll
                    for (int n = 0; n < 2; ++n) acc[a][b][m][n] = (f32x4){0.f, 0.f, 0.f, 0.f};
        cur = nxt; cA = nA; cB = nB; ++ui;
        if constexpr (ALIGN_EPI) { if (wr == 1) PG8_BAR; }
    }
    PG8_WAIT_V(0);
    if constexpr (!ALIGN_EPI) { if (wr == 0) PG8_BAR; }
    PG8_BAR;
    if constexpr (Epi::AFTER_DRAIN) { E.fused(acc, cur, wr, wc, fr, fq, lds, wid, lane); S.done(cur); }
#undef PG8_BTILE
#undef PG8_SA
#undef PG8_SB
#undef PG8_STAGE
#undef PG8_LDA
#undef PG8_LDB
#undef PG8_MMA
#undef PG8_WAIT_V
#undef PG8_WAIT_L
#undef PG8_BAR
#undef PG8_SCHED
}
}

constexpr int NWAVES = 8;
constexpr int RING_OFF = 0, RING_BYTES = 131072;
constexpr int LDSCTL_OFF = RING_BYTES, MISC_OFF = LDSCTL_OFF + 320;
constexpr int LDS_BYTES = 147456;

struct Args { const float* in[52]; float* out; unsigned char* ws; };
static_assert(sizeof(Args) == 432, "kernarg layout");

struct Frame {
    LAS unsigned char* lds; int tid, lane, wave, G, blk;
    const float* const* in; float* out; unsigned char* ws;
};
#define INP(i) INPD(i)
#define KARG() ({ const unsigned char __attribute__((address_space(4)))* k_ = (const unsigned char __attribute__((address_space(4)))*)__builtin_amdgcn_kernarg_segment_ptr(); asm volatile("" : "+s"(k_)); k_; })
#define INPD(i) (*(const float* const __attribute__((address_space(4)))*)(KARG() + 8 * (i)))

template <class Src>
DEVI void cvt_item(const Src src, bf16* WT, int Kd, int nblk, LAS float* scr, int item, int lane) {
    const int kb = item / nblk, nb = item % nblk, k0 = 64 * kb, n0 = 32 * nb;
    const int kr = lane >> 3, nq = (lane & 7) * 4;
    f32x4 v[8];
#pragma unroll
    for (int i = 0; i < 8; ++i) v[i] = src.load4(k0 + 8 * i + kr, n0 + nq);
#pragma unroll
    for (int i = 0; i < 8; ++i) { LAS float* s = scr + (8 * i + kr) * 33 + nq; s[0] = v[i][0]; s[1] = v[i][1]; s[2] = v[i][2]; s[3] = v[i][3]; }
    LDS_WAIT(); asm volatile("" ::: "memory");
    const int c = lane & 7;
#pragma unroll
    for (int j = 0; j < 4; ++j) { const int n = (lane >> 3) + 8 * j; const LAS float* s = scr + (8 * c) * 33 + n;
        v4u o; o.x = pk2(s[0 * 33], s[1 * 33]); o.y = pk2(s[2 * 33], s[3 * 33]); o.z = pk2(s[4 * 33], s[5 * 33]); o.w = pk2(s[6 * 33], s[7 * 33]);
        *(GAS v4u*)(WT + (size_t)(n0 + n) * Kd + k0 + 8 * c) = o; }
    LDS_WAIT(); asm volatile("" ::: "memory");
}
struct SrcPlain { const float* W; int K, N, ld; DEVI f32x4 load4(int k, int n) const { return (k < K && n < N) ? *(const f32x4*)(W + (size_t)k * ld + n) : (f32x4){0.f, 0.f, 0.f, 0.f}; } };
struct SrcFold { const float* W; const float* mu; int ld; DEVI f32x4 load4(int k, int n) const { const int kk = k & 1023; const float m = mu[kk]; return *(const f32x4*)(W + (size_t)kk * ld + n) * (k < 1024 ? m : (1.0f - m)); } };
struct SrcBlk { const float* W; int k0, k1; DEVI f32x4 load4(int k, int n) const { return (k >= k0 && k < k1) ? *(const f32x4*)(W + (size_t)(k - k0) * 1024 + n) : (f32x4){0.f, 0.f, 0.f, 0.f}; } };
struct SrcZero { DEVI f32x4 load4(int, int) const { return (f32x4){0.f, 0.f, 0.f, 0.f}; } };

DEVI void sincos_d(double x, double& s, double& c) {
    const double n = rint(x * 0.63661977236758134308);
    double r = fma(-n, 1.57079632679489655800e+00, x); r = fma(-n, 6.12323399573676603587e-17, r);
    const double r2 = r * r;
    double sp = -7.6471637318198164759e-13; sp = fma(sp, r2, 1.6059043836821614599e-10); sp = fma(sp, r2, -2.5052108385441718775e-08); sp = fma(sp, r2, 2.7557319223985890653e-06);
    sp = fma(sp, r2, -1.9841269841269841270e-04); sp = fma(sp, r2, 8.3333333333333333333e-03); sp = fma(sp, r2, -1.6666666666666666667e-01); const double sr = fma(sp * r2, r, r);
    double cp = 4.7794773323873852974e-14; cp = fma(cp, r2, -1.1470745597729724714e-11); cp = fma(cp, r2, 2.0876756987868098979e-09); cp = fma(cp, r2, -2.7557319223985890653e-07);
    cp = fma(cp, r2, 2.4801587301587301587e-05); cp = fma(cp, r2, -1.3888888888888888889e-03); cp = fma(cp, r2, 4.1666666666666666667e-02); cp = fma(cp, r2, -0.5); const double cr = fma(cp, r2, 1.0);
    const int q = ((int)n) & 3;
    s = (q == 0) ? sr : (q == 1) ? cr : (q == 2) ? -sr : -cr;
    c = (q == 0) ? cr : (q == 1) ? -sr : (q == 2) ? -cr : sr;
}
DEVI void s5prep_one(int i, const float* a_re, const float* a_im, const float* log_step, const float* b_re, const float* b_im, float* sp) {
    const int g = i >> 6;
    const double dt = exp((double)log_step[g]), ar = a_re[i], ai = a_im[i];
    const double mag = exp(ar * dt); double s, c; sincos_d(ai * dt, s, c);
    const double abr = mag * c, abi = mag * s, den = ar * ar + ai * ai, nr = abr - 1.0;
    const double zr = (nr * ar + abi * ai) / den, zi = (abi * ar - nr * ai) / den;
    sp[i] = (float)abr; sp[2048 + i] = (float)abi;
    for (int cc = 0; cc < 16; ++cc) { const double br = b_re[i * 16 + cc], bi = b_im[i * 16 + cc];
        sp[4096 + i * 16 + cc] = (float)(zr * br - zi * bi); sp[4096 + 32768 + i * 16 + cc] = (float)(zr * bi + zi * br); }
}


constexpr int SP_PW = 4096 + 65536;
DEVI void s5prep_pw(int i, int tau, const float* a_re, const float* a_im, const float* log_step, float* sp) {
    const int g = i >> 6; const double dt = exp((double)log_step[g]), ar = a_re[i], ai = a_im[i];
    const double mag = exp(ar * dt * tau); double s, c; sincos_d(ai * dt * tau, s, c); sp[SP_PW + i * 34 + tau * 2] = (float)(mag * c); sp[SP_PW + i * 34 + tau * 2 + 1] = (float)(mag * s);
}
DEVI void s5_tm_job(int g, int tau, int lane, const float* sp, const float* c_re, const float* c_im, const float* dd, bf16* TM) {
    bf16* tm = TM + (size_t)g * 256 * 384;
    if (tau <= 15) {
        const int co = lane >> 2, ci0 = (lane & 3) * 4; float kv[4] = {0.f, 0.f, 0.f, 0.f};
#pragma unroll 8
        for (int p = 0; p < 64; ++p) { const float pr = sp[SP_PW + (g * 64 + p) * 34 + tau * 2], pi = sp[SP_PW + (g * 64 + p) * 34 + tau * 2 + 1];
            const float cr = c_re[(g * 16 + co) * 64 + p], ci = c_im[(g * 16 + co) * 64 + p];
            const f32x4 br = *(const f32x4*)(sp + 4096 + (g * 64 + p) * 16 + ci0), bi = *(const f32x4*)(sp + 4096 + 32768 + (g * 64 + p) * 16 + ci0);
#pragma unroll
            for (int q = 0; q < 4; ++q) { const float wr = pr * br[q] - pi * bi[q], wi = pr * bi[q] + pi * br[q]; kv[q] += cr * wr - ci * wi; } }
        if (tau == 0) {
#pragma unroll
            for (int q = 0; q < 4; ++q) if (ci0 + q == co) kv[q] += dd[g * 16 + co]; }
        const unsigned long long pk = (unsigned long long)pk2(kv[0], kv[1]) | ((unsigned long long)pk2(kv[2], kv[3]) << 32);
        for (int t = tau; t < 16; ++t) *(unsigned long long*)(tm + (size_t)(t * 16 + co) * 384 + (t - tau) * 16 + ci0) = pk;
        if (tau >= 1) for (int t = 0; t + tau < 16; ++t) *(unsigned long long*)(tm + (size_t)(t * 16 + co) * 384 + (t + tau) * 16 + ci0) = 0ull;
    }
    if (tau >= 1) { const int t = tau - 1, p = lane; const float pr = sp[SP_PW + (g * 64 + p) * 34 + tau * 2], pi = sp[SP_PW + (g * 64 + p) * 34 + tau * 2 + 1];
#pragma unroll
        for (int co = 0; co < 16; ++co) { const float cr = c_re[(g * 16 + co) * 64 + p], ci = c_im[(g * 16 + co) * 64 + p];
            tm[(size_t)(t * 16 + co) * 384 + 256 + p] = (bf16)f2bf(cr * pr - ci * pi); tm[(size_t)(t * 16 + co) * 384 + 320 + p] = (bf16)f2bf(-(cr * pi + ci * pr)); } }
}
DEVI void s5_hm_job(int g, int s, int lane, const float* sp, bf16* HM) {
    const int p = lane; const float pr = sp[SP_PW + (g * 64 + p) * 34 + (15 - s) * 2], pi = sp[SP_PW + (g * 64 + p) * 34 + (15 - s) * 2 + 1];
    bf16* hr = HM + ((size_t)g * 256 + p) * 256 + s * 16; bf16* hi = hr + 64 * 256;
#pragma unroll
    for (int h8 = 0; h8 < 2; ++h8) { float wr[8], wi[8];
#pragma unroll
        for (int q = 0; q < 8; ++q) { const float br = sp[4096 + (g * 64 + p) * 16 + h8 * 8 + q], bi = sp[4096 + 32768 + (g * 64 + p) * 16 + h8 * 8 + q]; wr[q] = pr * br - pi * bi; wi[q] = pr * bi + pi * br; }
        v4u a, b; a.x = pk2(wr[0], wr[1]); a.y = pk2(wr[2], wr[3]); a.z = pk2(wr[4], wr[5]); a.w = pk2(wr[6], wr[7]); b.x = pk2(wi[0], wi[1]); b.y = pk2(wi[2], wi[3]); b.z = pk2(wi[4], wi[5]); b.w = pk2(wi[6], wi[7]);
        *(v4u*)(hr + h8 * 8) = a; *(v4u*)(hi + h8 * 8) = b; }
}
DEVI void s5_carry_job(int b, int g, int lane, const float* sp, const float* HL, bf16* UB, float* ore, float* oim) {
    const int p = lane; const float ar = sp[SP_PW + (g * 64 + p) * 34 + 32], ai = sp[SP_PW + (g * 64 + p) * 34 + 33];
    float cr = 0.f, ci = 0.f;
#pragma unroll 8
    for (int n = 0; n < 128; ++n) { const size_t row = (size_t)g * 1024 + b * 128 + n;
        UB[row * 384 + 256 + p] = (bf16)f2bf(cr); UB[row * 384 + 320 + p] = (bf16)f2bf(ci);
        const float hr = HL[row * 128 + p], hi = HL[row * 128 + 64 + p];
        const float nr = ar * cr - ai * ci + hr, ni = ar * ci + ai * cr + hi; cr = nr; ci = ni; }
    ore[((size_t)b * 32 + g) * 64 + p] = cr; oim[((size_t)b * 32 + g) * 64 + p] = ci;
}


template <int NT> DEVI void mods_half(int m0, int l, int n0, int lane, const float* __restrict__ ST, const float* __restrict__ ada_w, const float* __restrict__ ada_b, float* MODS) {
    const int i16 = lane & 15, kq = lane >> 4;
    f32x4 acc[NT];
#pragma unroll
    for (int m = 0; m < NT; ++m) acc[m] = (f32x4){0.f, 0.f, 0.f, 0.f};
    const float* w = ada_w + (size_t)l * 1024 * 9216 + (size_t)kq * 9216 + n0 + i16; const float* st = ST + kq * 144 + i16 + m0 * 16;
    float a[4][NT], bv[4];
#pragma unroll
    for (int s = 0; s < 4; ++s) { bv[s] = w[(size_t)(4 * s) * 9216];
#pragma unroll
        for (int m = 0; m < NT; ++m) a[s][m] = st[(4 * s) * 144 + m * 16]; }
    for (int k0 = 0; k0 < 1024; k0 += 16) {
#pragma unroll
        for (int s = 0; s < 4; ++s) {
#pragma unroll
            for (int m = 0; m < NT; ++m) acc[m] = __builtin_amdgcn_mfma_f32_16x16x4f32(a[s][m], bv[s], acc[m], 0, 0, 0);
            const int kn = k0 + 16 + 4 * s; if (kn < 1024) { bv[s] = w[(size_t)kn * 9216];
#pragma unroll
                for (int m = 0; m < NT; ++m) a[s][m] = st[kn * 144 + m * 16]; } } }
    const float bb = ada_b[l * 9216 + n0 + i16];
#pragma unroll
    for (int m = 0; m < NT; ++m)
#pragma unroll
        for (int q = 0; q < 4; ++q) { const int r = (m0 + m) * 16 + kq * 4 + q; if (r < NMODROW) MODS[((size_t)l * NMODROW + r) * 9216 + n0 + i16] = acc[m][q] + bb; }
}
DEVI void mods_job(int job, int lane, const float* __restrict__ ST, const float* __restrict__ ada_w, const float* __restrict__ ada_b, float* MODS) {
    asm volatile("" : "+v"(lane));
    const int mh = job & 1, jb = job >> 1, l = jb / 576, n0 = (jb % 576) * 16;
    if (mh) mods_half<4>(5, l, n0, lane, ST, ada_w, ada_b, MODS); else mods_half<5>(0, l, n0, lane, ST, ada_w, ada_b, MODS);
}

DEVI void mods_job3(int cg, int rs, int lane, const float* __restrict__ ST, const float* __restrict__ ada_w, const float* __restrict__ ada_b, float* MODS) {
    asm volatile("" : "+v"(lane));
    const int l = cg / 144, n0 = (cg % 144) * 64, i16 = lane & 15, kq = lane >> 4;
    f32x4 acc[3][4];
#pragma unroll
    for (int m = 0; m < 3; ++m)
#pragma unroll
        for (int c = 0; c < 4; ++c) acc[m][c] = (f32x4){0.f, 0.f, 0.f, 0.f};
    const float* w = ada_w + (size_t)l * 1024 * 9216 + (size_t)kq * 9216 + n0 + 4 * i16; const float* st = ST + kq * 144 + rs * 48 + i16;
    constexpr int DEP = 8;
    f32x4 bv[DEP]; float a[DEP][3];
#define MODS_LD(s, kn) do { const float* wp_ = w + (size_t)(kn) * 9216; const float* sp_ = st + (kn) * 144; \
        asm volatile("global_load_dwordx4 %0, %1, off" : "=v"(bv[s]) : "v"(wp_) : "memory"); \
        asm volatile("global_load_dword %0, %1, off" : "=v"(a[s][0]) : "v"(sp_) : "memory"); \
        asm volatile("global_load_dword %0, %1, off offset:64" : "=v"(a[s][1]) : "v"(sp_) : "memory"); \
        asm volatile("global_load_dword %0, %1, off offset:128" : "=v"(a[s][2]) : "v"(sp_) : "memory"); } while (0)
#define MODS_MM(s) do { _Pragma("unroll") for (int m = 0; m < 3; ++m) _Pragma("unroll") for (int c = 0; c < 4; ++c) acc[m][c] = __builtin_amdgcn_mfma_f32_16x16x4f32(a[s][m], bv[s][c], acc[m][c], 0, 0, 0); } while (0)
#define MODS_WAIT(s, n) asm volatile("s_waitcnt vmcnt(" #n ")" : "+v"(bv[s]), "+v"(a[s][0]), "+v"(a[s][1]), "+v"(a[s][2]) :: "memory")
#pragma unroll
    for (int s = 0; s < DEP; ++s) MODS_LD(s, 4 * s);
    for (int k0 = 0; k0 < 1024 - 4 * DEP; k0 += 4 * DEP) {
#pragma unroll
        for (int s = 0; s < DEP; ++s) { MODS_WAIT(s, 28); MODS_MM(s); MODS_LD(s, k0 + 4 * DEP + 4 * s); } }
    MODS_WAIT(0, 28); MODS_MM(0); MODS_WAIT(1, 24); MODS_MM(1); MODS_WAIT(2, 20); MODS_MM(2); MODS_WAIT(3, 16); MODS_MM(3);
    MODS_WAIT(4, 12); MODS_MM(4); MODS_WAIT(5, 8); MODS_MM(5); MODS_WAIT(6, 4); MODS_MM(6); MODS_WAIT(7, 0); MODS_MM(7);
#undef MODS_LD
#undef MODS_MM
#undef MODS_WAIT
    const f32x4 bb = *(const f32x4*)(ada_b + l * 9216 + n0 + 4 * i16);
#pragma unroll
    for (int m = 0; m < 3; ++m)
#pragma unroll
        for (int q = 0; q < 4; ++q) { const int r = (rs * 3 + m) * 16 + kq * 4 + q;
            if (r < NMODROW) *(f32x4*)(MODS + ((size_t)l * NMODROW + r) * 9216 + n0 + 4 * i16) = (f32x4){acc[m][0][q] + bb[0], acc[m][1][q] + bb[1], acc[m][2][q] + bb[2], acc[m][3][q] + bb[3]}; }
}

DEVI void init_row(int row, int lane, const float* xp, const float* xs, const float* mods, float* X, bf16* H, float* ZS) {
    if (row >= MT) { for (int j = 0; j < 16; ++j) H[(size_t)row * D + j * 64 + lane] = 0; return; }
    const float* src = row < NP ? xp + (size_t)row * D : xs + (size_t)(row - NP) * D;
    const float* sh = modp(mods, 0, 0) + (size_t)mrow(row) * 9216; const float* sc = modp(mods, 0, 1) + (size_t)mrow(row) * 9216;
#pragma unroll
    for (int j = 0; j < 4; ++j) { const int c = j * 256 + lane * 4; const f32x4 v = *(const f32x4*)(src + c), a = *(const f32x4*)(sc + c), b = *(const f32x4*)(sh + c);
        if (row >= NP) *(f32x4*)(ZS + (size_t)(row - NP) * D + c) = v * ALPHA; const f32x4 h = v * (a + 1.0f) + b;
        *(unsigned long long*)(H + (size_t)row * D + c) = (unsigned long long)pk2(h[0], h[1]) | ((unsigned long long)pk2(h[2], h[3]) << 32); }
}
DEVI void ln_row(int row, int lane, const float* Z, float* ZS, const float* SL, int nsl, const float* g, const float* b, float* X, bf16* H, const float* sh, const float* sc) {
    const float* z = row < NP ? Z + (size_t)row * D : ZS + (size_t)(row - NP) * D; f32x4 v[4]; float s = 0.f;
#pragma unroll
    for (int j = 0; j < 4; ++j) v[j] = *(const f32x4*)(z + j * 256 + lane * 4);
    if (row >= NP) for (int q = 0; q < nsl; ++q) {
#pragma unroll
        for (int j = 0; j < 4; ++j) v[j] = v[j] + *(const f32x4*)(SL + ((size_t)q * 128 + (row - NP)) * D + j * 256 + lane * 4); }
#pragma unroll
    for (int j = 0; j < 4; ++j) s += (v[j][0] + v[j][1]) + (v[j][2] + v[j][3]);
    const float mean = wave_sum(s) * (1.f / D); float q = 0.f;
#pragma unroll
    for (int j = 0; j < 4; ++j) { v[j] = v[j] - mean; q += (v[j][0] * v[j][0] + v[j][1] * v[j][1]) + (v[j][2] * v[j][2] + v[j][3] * v[j][3]); }
    const float rstd = rsqrtf(wave_sum(q) * (1.f / D) + 1e-5f);
    const int mr = mrow(row);
#pragma unroll
    for (int j = 0; j < 4; ++j) { const int c = j * 256 + lane * 4; const f32x4 x = v[j] * rstd * *(const f32x4*)(g + c) + *(const f32x4*)(b + c); *(f32x4*)(X + (size_t)row * D + c) = x; if (row >= NP) *(f32x4*)(ZS + (size_t)(row - NP) * D + c) = x * ALPHA;
        if (H) { const f32x4 h = x * (*(const f32x4*)(sc + (size_t)mr * 9216 + c) + 1.0f) + *(const f32x4*)(sh + (size_t)mr * 9216 + c);
            *(unsigned long long*)(H + (size_t)row * D + c) = (unsigned long long)pk2(h[0], h[1]) | ((unsigned long long)pk2(h[2], h[3]) << 32); } }
}
DEVI void ln_shift_rows(int row0, int n, int lane, const float* Z, float* ZS, const float* g, const float* b, float* X, const float* mods, const float* shift_in, bf16* A2, float* out) {
    f32x4 prev[4], gg[4], bb[4];
#pragma unroll
    for (int j = 0; j < 4; ++j) { gg[j] = *(const f32x4*)(g + j * 256 + lane * 4); bb[j] = *(const f32x4*)(b + j * 256 + lane * 4); prev[j] = (f32x4){0.f, 0.f, 0.f, 0.f}; }
    for (int r = ((row0 < NP && (row0 & 2047) != 0) ? row0 - 1 : row0); r < row0 + n; ++r) {
        const bool warm = r < row0;
        const float* z = r < NP ? Z + (size_t)r * D : ZS + (size_t)(r - NP) * D; f32x4 v[4]; float s = 0.f;
#pragma unroll
        for (int j = 0; j < 4; ++j) { v[j] = *(const f32x4*)(z + j * 256 + lane * 4); s += (v[j][0] + v[j][1]) + (v[j][2] + v[j][3]); }
        const float mean = wave_sum(s) * (1.f / D); float q = 0.f;
#pragma unroll
        for (int j = 0; j < 4; ++j) { v[j] = v[j] - mean; q += (v[j][0] * v[j][0] + v[j][1] * v[j][1]) + (v[j][2] * v[j][2] + v[j][3] * v[j][3]); }
        const float rstd = rsqrtf(wave_sum(q) * (1.f / D) + 1e-5f);
        const int mr = mrow(r); const float* sh = modp(mods, 1, 3) + (size_t)mr * 9216; const float* sc = modp(mods, 1, 4) + (size_t)mr * 9216;
        const bool prompt = r < NP; const int t = r & 2047;
#pragma unroll
        for (int j = 0; j < 4; ++j) { const int c = j * 256 + lane * 4; const f32x4 x = v[j] * rstd * gg[j] + bb[j]; const f32x4 h = x * (*(const f32x4*)(sc + c) + 1.0f) + *(const f32x4*)(sh + c);
            if (!warm) { *(f32x4*)(X + (size_t)r * D + c) = x; if (r >= NP) *(f32x4*)(ZS + (size_t)(r - NP) * D + c) = x * ALPHA;
                f32x4 pv = prev[j]; if (!prompt) pv = *(const f32x4*)(shift_in + (size_t)(r - NP) * D + c); else if (t == 0) pv = (f32x4){0.f, 0.f, 0.f, 0.f};
                *(unsigned long long*)(A2 + (size_t)r * KRK + c) = (unsigned long long)pk2(pv[0], pv[1]) | ((unsigned long long)pk2(pv[2], pv[3]) << 32);
                *(unsigned long long*)(A2 + (size_t)r * KRK + 1024 + c) = (unsigned long long)pk2(h[0], h[1]) | ((unsigned long long)pk2(h[2], h[3]) << 32);
                if (prompt) { if (t == 2047) *(f32x4*)(out + O_SHIFT_P + (size_t)(r >> 11) * D + c) = h; } else *(f32x4*)(out + O_SHIFT_S + (size_t)(r - NP) * D + c) = h; }
            prev[j] = h; }
    }
}
DEVI void shiftcat_row(int row, int lane, const float* X, const float* mods, const float* shift_in, bf16* A2, float* out) {
    if (row >= MT) { for (int j = 0; j < 8; ++j) *(unsigned long long*)(A2 + (size_t)row * KRK + j * 256 + lane * 4) = 0ull; return; }
    const int mr = mrow(row); const float* sh = modp(mods, 1, 3) + (size_t)mr * 9216; const float* sc = modp(mods, 1, 4) + (size_t)mr * 9216;
    const bool prompt = row < NP; const int t = row & 2047;
#pragma unroll
    for (int j = 0; j < 4; ++j) { const int c = j * 256 + lane * 4; const f32x4 a = *(const f32x4*)(sc + c) + 1.0f, b = *(const f32x4*)(sh + c);
        const f32x4 h = *(const f32x4*)(X + (size_t)row * D + c) * a + b; f32x4 pv;
        if (prompt) pv = t == 0 ? (f32x4){0.f, 0.f, 0.f, 0.f} : *(const f32x4*)(X + (size_t)(row - 1) * D + c) * a + b; else pv = *(const f32x4*)(shift_in + (size_t)(row - NP) * D + c);
        *(unsigned long long*)(A2 + (size_t)row * KRK + c) = (unsigned long long)pk2(pv[0], pv[1]) | ((unsigned long long)pk2(pv[2], pv[3]) << 32);
        *(unsigned long long*)(A2 + (size_t)row * KRK + 1024 + c) = (unsigned long long)pk2(h[0], h[1]) | ((unsigned long long)pk2(h[2], h[3]) << 32);
        if (prompt) { if (t == 2047) *(f32x4*)(out + O_SHIFT_P + (size_t)(row >> 11) * D + c) = h; } else *(f32x4*)(out + O_SHIFT_S + (size_t)(row - NP) * D + c) = h; }
}
DEVI void gla_post_one(int w, int lane, const float* OG, const bf16* P, const float* norm_g, bf16* O) {
    const int tok = w >> 2, h = w & 3;
    const float o0 = OG[(size_t)tok * 512 + h * 128 + lane], o1 = OG[(size_t)tok * 512 + h * 128 + 64 + lane];
    const float ms = wave_sum(o0 * o0 + o1 * o1) * (1.f / 128.f), r = rsqrtf(ms + 1e-5f);
    const float g0 = bf2f(P[(size_t)tok * NINP + 1024 + h * 128 + lane]), g1 = bf2f(P[(size_t)tok * NINP + 1024 + h * 128 + 64 + lane]);
    O[(size_t)tok * D + h * 128 + lane] = (bf16)f2bf(o0 * r * norm_g[lane] * siluf_(g0));
    O[(size_t)tok * D + h * 128 + 64 + lane] = (bf16)f2bf(o1 * r * norm_g[64 + lane] * siluf_(g1));
}

DEVI void gla_job(LAS float* scr, int lane, int b, int h, int half, const bf16* P, const float* GKL, const float* w_gk, const float* b_gk, int tok_base, int T, const float* s0, float* s_out, float* OG) {
    LAS float* sdec = scr; LAS float* sq = scr + 1024; LAS float* sk = scr + 2048;
    const int dv = half * 64 + lane;
    float S[64];
#pragma unroll
    for (int i = 0; i < 64; ++i) S[i] = s0 ? s0[(((size_t)b * 4 + h) * 64 + i) * 128 + dv] : 0.f;
    float wg[16];
#pragma unroll
    for (int r = 0; r < 16; ++r) wg[r] = w_gk[r * 256 + h * 64 + lane];
    const float bg = b_gk[h * 64 + lane];
    for (int t0 = 0; t0 < T; t0 += 16) { const int nt = (T - t0) < 16 ? (T - t0) : 16;
        for (int tt = 0; tt < nt; ++tt) { const size_t tok = (size_t)tok_base + (size_t)b * T + t0 + tt; float x = bg;
#pragma unroll
            for (int r = 0; r < 16; ++r) x += GKL[tok * 16 + r] * wg[r];
            const float ls = fminf(x, 0.f) - log1pf(__expf(-fabsf(x)));
            sdec[tt * 64 + lane] = __expf(ls * (1.f / 16.f)); sq[tt * 64 + lane] = bf2f(P[tok * NINP + h * 64 + lane]) * 0.125f; sk[tt * 64 + lane] = bf2f(P[tok * NINP + 256 + h * 64 + lane]); }
        LDS_WAIT(); asm volatile("" ::: "memory");
        for (int tt = 0; tt < nt; ++tt) { const size_t tok = (size_t)tok_base + (size_t)b * T + t0 + tt;
            const float v = bf2f(P[tok * NINP + 512 + h * 128 + dv]); float o = 0.f;
#pragma unroll
            for (int i = 0; i < 64; ++i) { S[i] = S[i] * sdec[tt * 64 + i] + sk[tt * 64 + i] * v; o += sq[tt * 64 + i] * S[i]; }
            OG[tok * 512 + h * 128 + dv] = o; }
        LDS_WAIT(); asm volatile("" ::: "memory");
    }
#pragma unroll
    for (int i = 0; i < 64; ++i) s_out[(((size_t)b * 4 + h) * 64 + i) * 128 + dv] = S[i];
}
DEVI void s5_job(LAS float* scr, int lane, int g, int b0, int nb, const bf16* P, const float* sp, const float* c_re, const float* c_im, const float* dd, int tok_base, int T,
                 const float* h0re, const float* h0im, float* ore, float* oim, bf16* Z5) {
    const int p = lane, c = p & 15, pq = p >> 4;
    const float abr = sp[g * 64 + p], abi = sp[2048 + g * 64 + p];
    float bbr[16], bbi[16], cr[16], ci[16];
#pragma unroll
    for (int i = 0; i < 16; ++i) { bbr[i] = sp[4096 + (g * 64 + p) * 16 + i]; bbi[i] = sp[4096 + 32768 + (g * 64 + p) * 16 + i];
        cr[i] = c_re[(g * 16 + c) * 64 + pq * 16 + i]; ci[i] = c_im[(g * 16 + c) * 64 + pq * 16 + i]; }
    const float dv = dd[g * 16 + c];
    for (int b = b0; b < b0 + nb; ++b) {
        float hr = h0re ? h0re[((size_t)b * 32 + g) * 64 + p] : 0.f, hi = h0im ? h0im[((size_t)b * 32 + g) * 64 + p] : 0.f;
        for (int t = 0; t < T; ++t) { const size_t tok = (size_t)tok_base + (size_t)b * T + t;
            const bf16* up = P + tok * NINP + 1552 + g * 16; float u[16];
#pragma unroll
            for (int i = 0; i < 16; ++i) u[i] = bf2f(up[i]);
            const float uc = bf2f(up[c]);
            float br = 0.f, bi = 0.f;
#pragma unroll
            for (int i = 0; i < 16; ++i) { br += u[i] * bbr[i]; bi += u[i] * bbi[i]; }
            const float nr = abr * hr - abi * hi + br, ni = abr * hi + abi * hr + bi; hr = nr; hi = ni;
            LAS float* hs = scr + (t & 1) * 128;
            hs[p] = hr; hs[64 + p] = hi;
            LDS_WAIT(); asm volatile("" ::: "memory");
            float y = 0.f;
#pragma unroll
            for (int i = 0; i < 16; ++i) y += cr[i] * hs[pq * 16 + i] - ci[i] * hs[64 + pq * 16 + i];
            y += __shfl_xor(y, 16); y += __shfl_xor(y, 32);
            if (p < 16) { y += dv * uc; Z5[tok * 512 + g * 16 + c] = (bf16)f2bf(gelu_tanh(y)); }
        }
        ore[((size_t)b * 32 + g) * 64 + p] = hr; oim[((size_t)b * 32 + g) * 64 + p] = hi;
        LDS_WAIT(); asm volatile("" ::: "memory");
    }
}
DEVI float wkv_decay(float w0, float raw) { const float x = -(w0 + raw); const float sp = fmaxf(x, 0.f) + log1pf(__expf(-fabsf(x))); return __expf(-__expf(-sp - 0.5f)); }
DEVI void wkv_job(LAS float* scr, int lane, int b, int h, const bf16* R, const bf16* Kb, const bf16* V, const bf16* WRAW, const float* w0p, const bf16* AS, bf16* GO, const float* k_k, const float* k_a, const float* r_k, const float* lnx_g, const float* lnx_b,
                  int tok_base, int T, const float* s0, float* s_out) {
    LAS float* sw = scr; LAS float* skm = scr + 512; LAS float* sa_ = scr + 1024; LAS float* sb = scr + 1536; LAS float* sr = scr + 2048; LAS float* sbon = scr + 2560;
    const int i = lane, ch = h * 64 + i;
    float S[64];
#pragma unroll
    for (int j = 0; j < 64; ++j) S[j] = s0 ? s0[(((size_t)b * 16 + h) * 64 + i) * 64 + j] : 0.f;
    const float kkc = k_k[ch], kac = k_a[ch], rkc = r_k[ch], lg = lnx_g[ch], lb = lnx_b[ch];
    for (int t0 = 0; t0 < T; t0 += 8) { const int nt = (T - t0) < 8 ? (T - t0) : 8;
        for (int tt = 0; tt < nt; ++tt) { const size_t tok = (size_t)tok_base + (size_t)b * T + t0 + tt;
            const float k = bf2f(Kb[tok * D + ch]), r = bf2f(R[tok * D + ch]), a = bf2f(AS[tok * D + ch]), w = wkv_decay(w0p[ch], bf2f(WRAW[tok * D + ch]));
            float kk = k * kkc; const float nrm = sqrtf(wave_sum(kk * kk)); kk = kk / fmaxf(nrm, 1e-12f);
            const float km = k * (1.f + (a - 1.f) * kac);
            sw[tt * 64 + i] = w; skm[tt * 64 + i] = km; sa_[tt * 64 + i] = -kk; sb[tt * 64 + i] = kk * a; sr[tt * 64 + i] = r;
            const float bon = wave_sum(r * km * rkc); if (i == 0) sbon[tt] = bon; }
        LDS_WAIT(); asm volatile("" ::: "memory");
        for (int tt = 0; tt < nt; ++tt) { const size_t tok = (size_t)tok_base + (size_t)b * T + t0 + tt;
            const float v = bf2f(V[tok * D + ch]); float sa = 0.f;
#pragma unroll
            for (int j = 0; j < 64; ++j) sa += S[j] * sa_[tt * 64 + j];
            float y = 0.f;
#pragma unroll
            for (int j = 0; j < 64; ++j) { S[j] = S[j] * sw[tt * 64 + j] + sa * sb[tt * 64 + j] + v * skm[tt * 64 + j]; y += S[j] * sr[tt * 64 + j]; }
            const float mean = wave_sum(y) * (1.f / 64.f), dy = y - mean, var = wave_sum(dy * dy) * (1.f / 64.f);
            float yn = dy * rsqrtf(var + 64e-5f) * lg + lb; yn += sbon[tt] * v;
            const float gt = bf2f(GO[tok * D + ch]); GO[tok * D + ch] = (bf16)f2bf(yn * gt); }
        LDS_WAIT(); asm volatile("" ::: "memory");
    }
#pragma unroll
    for (int j = 0; j < 64; ++j) s_out[(((size_t)b * 16 + h) * 64 + i) * 64 + j] = S[j];
}

DEVI float dpp_add(float v, const int ctrl_sel) {
    int r;
    switch (ctrl_sel) {
    case 0: r = __builtin_amdgcn_update_dpp(0, __builtin_bit_cast(int, v), 0xB1, 0xF, 0xF, true); break;
    case 1: r = __builtin_amdgcn_update_dpp(0, __builtin_bit_cast(int, v), 0x4E, 0xF, 0xF, true); break;
    case 2: r = __builtin_amdgcn_update_dpp(0, __builtin_bit_cast(int, v), 0x141, 0xF, 0xF, true); break;
    default: r = __builtin_amdgcn_update_dpp(0, __builtin_bit_cast(int, v), 0x140, 0xF, 0xF, true); break;
    }
    return v + __builtin_bit_cast(float, r);
}
DEVI float red16(float v) { v = dpp_add(v, 0); v = dpp_add(v, 1); v = dpp_add(v, 2); v = dpp_add(v, 3); return v; }
constexpr int WK_TB = 32;
constexpr int WK_W = 0, WK_KM = 2048, WK_NA = 4096, WK_BB = 6144, WK_WR = 8192, WK_V = 10240, WK_PB = 12800;
constexpr int WK_Y = 2 * WK_PB, WK_YB = 1024;
static_assert((WK_Y + 2 * WK_YB + 512 + 1200) * 4 <= RING_BYTES, "wkv lds");
struct WkvLoad { uint2 k, r, a, v, w; };
typedef float f32x2_t __attribute__((ext_vector_type(2)));
struct WkvOps { f32x4 na, wr, w4, bb, km, vv; };
DEVI float wkv_decay_fast(float w0, float raw) { const float x = -(w0 + raw); const float sp = fmaxf(x, 0.f) + 0.69314718056f * __builtin_amdgcn_logf(1.0f + __builtin_amdgcn_exp2f(-1.44269504089f * fabsf(x)));
    const float ee = __builtin_amdgcn_exp2f(-1.44269504089f * (sp + 0.5f)); return __builtin_amdgcn_exp2f(-1.44269504089f * ee); }
template <int MODE> DEVI void wkv_half(LAS float* L, int tid, int b, int h, int half, const bf16* R, const bf16* Kb, const bf16* V, const bf16* WRAW, const bf16* AS, const float* w0p,
                   const float* k_k, const float* k_a, const float* r_k, bf16* Y, float* BON, float* s_out) {
    asm volatile("" : "+v"(tid));
    const int rp = (tid >> 4) & 15, jq = tid & 15; const bool stepper = tid < 256;
    const int ch = h * 64 + 4 * jq, chv = h * 64 + half * 32 + 4 * (jq & 7);
    f32x4 S0 = {0.f, 0.f, 0.f, 0.f}, S1 = {0.f, 0.f, 0.f, 0.f};
    const size_t tokb = (size_t)b * TP;
    auto bf4 = [](uint2 u) -> f32x4 { f32x4 o; o[0] = __uint_as_float(u.x << 16); o[1] = __uint_as_float(u.x & 0xffff0000u); o[2] = __uint_as_float(u.y << 16); o[3] = __uint_as_float(u.y & 0xffff0000u); return o; };
#define WK_PREP1(bufidx, blkidx, tt_) do { LAS float* pb_ = L + (bufidx) * WK_PB; const size_t t_ = tokb + (size_t)(blkidx) * WK_TB + (tt_); const size_t o_ = t_ * D + ch; \
        const f32x4 k4 = bf4(*(const uint2*)(Kb + o_)), r4 = bf4(*(const uint2*)(R + o_)), a4 = bf4(*(const uint2*)(AS + o_)), wraw = bf4(*(const uint2*)(WRAW + o_)), v4 = bf4(*(const uint2*)(V + t_ * D + chv)); f32x4 w4; \
        _Pragma("unroll") for (int e_ = 0; e_ < 4; ++e_) w4[e_] = wkv_decay_fast(w0c[e_], wraw[e_]); \
        f32x4 kk = k4 * kkc; float ss = red16((kk[0] * kk[0] + kk[1] * kk[1]) + (kk[2] * kk[2] + kk[3] * kk[3])); const float inv = 1.0f / fmaxf(sqrtf(ss), 1e-12f); kk = kk * inv; \
        const f32x4 km = k4 * ((a4 - 1.0f) * kac + 1.0f); const f32x4 pr = r4 * km; const f32x4 prk = pr * rkc; const float bon = red16((prk[0] + prk[1]) + (prk[2] + prk[3])); \
        const f32x4 bbv = kk * a4; const f32x4 pb2 = bbv * r4; const float brs = red16((pb2[0] + pb2[1]) + (pb2[2] + pb2[3])), krs = red16((pr[0] + pr[1]) + (pr[2] + pr[3])); \
        *(LAS f32x4*)(pb_ + WK_W + (tt_) * 64 + 4 * jq) = w4; *(LAS f32x4*)(pb_ + WK_KM + (tt_) * 64 + 4 * jq) = km; *(LAS f32x4*)(pb_ + WK_NA + (tt_) * 64 + 4 * jq) = -kk; \
        *(LAS f32x4*)(pb_ + WK_BB + (tt_) * 64 + 4 * jq) = bbv; *(LAS f32x4*)(pb_ + WK_WR + (tt_) * 64 + 4 * jq) = w4 * r4 - kk * brs; \
        if (jq < 8) { *(LAS f32x4*)(pb_ + WK_V + (tt_) * 64 + 8 * jq) = (f32x4){v4[0], v4[1], v4[0] * krs, v4[1] * krs}; *(LAS f32x4*)(pb_ + WK_V + (tt_) * 64 + 8 * jq + 4) = (f32x4){v4[2], v4[3], v4[2] * krs, v4[3] * krs}; } \
        if (jq == 0 && half == 0) BON[t_ * 16 + h] = bon; } while (0)
#define WK_RD128(dst, ad, off) asm volatile("ds_read_b128 %0, %1 offset:%2" : "=v"(dst) : "v"(ad), "i"(off))
#define WK_LOADOPS(o_, dt_) do { WK_RD128((o_).na, aop, WK_NA * 4 + (dt_) * 256); WK_RD128((o_).wr, aop, WK_WR * 4 + (dt_) * 256); WK_RD128((o_).w4, aop, WK_W * 4 + (dt_) * 256); \
        WK_RD128((o_).bb, aop, WK_BB * 4 + (dt_) * 256); WK_RD128((o_).km, aop, WK_KM * 4 + (dt_) * 256); WK_RD128((o_).vv, av, (dt_) * 256); } while (0)
#define WK_WAIT(n_, o_) asm volatile("s_waitcnt lgkmcnt(" #n_ ")" : "+v"((o_).na), "+v"((o_).wr), "+v"((o_).w4), "+v"((o_).bb), "+v"((o_).km), "+v"((o_).vv))
#define WK_STEP(o_, dt_) do { \
        float sa0 = (S0[0] * (o_).na[0] + S0[1] * (o_).na[1]) + (S0[2] * (o_).na[2] + S0[3] * (o_).na[3]), sa1 = (S1[0] * (o_).na[0] + S1[1] * (o_).na[1]) + (S1[2] * (o_).na[2] + S1[3] * (o_).na[3]); \
        float y0 = (S0[0] * (o_).wr[0] + S0[1] * (o_).wr[1]) + (S0[2] * (o_).wr[2] + S0[3] * (o_).wr[3]), y1 = (S1[0] * (o_).wr[0] + S1[1] * (o_).wr[1]) + (S1[2] * (o_).wr[2] + S1[3] * (o_).wr[3]); \
        sa0 = dpp_add(sa0, 0); sa1 = dpp_add(sa1, 0); y0 = dpp_add(y0, 0); y1 = dpp_add(y1, 0); sa0 = dpp_add(sa0, 1); sa1 = dpp_add(sa1, 1); y0 = dpp_add(y0, 1); y1 = dpp_add(y1, 1); \
        sa0 = dpp_add(sa0, 2); sa1 = dpp_add(sa1, 2); y0 = dpp_add(y0, 2); y1 = dpp_add(y1, 2); sa0 = dpp_add(sa0, 3); sa1 = dpp_add(sa1, 3); y0 = dpp_add(y0, 3); y1 = dpp_add(y1, 3); \
        S0 = S0 * (o_).w4 + ((o_).bb * sa0 + (o_).km * (o_).vv[0]); S1 = S1 * (o_).w4 + ((o_).bb * sa1 + (o_).km * (o_).vv[1]); \
        f32x2_t yy; yy[0] = y0 + (o_).vv[2]; yy[1] = y1 + (o_).vv[3]; \
        asm volatile("ds_write_b64 %0, %1 offset:%2" :: "v"(ay), "v"(yy), "i"((dt_) * 128) : "memory"); } while (0)
    constexpr int NB = TP / WK_TB;
    if (!stepper) {
        const int ht = (tid - 256) >> 4;
        const f32x4 kkc = *(const f32x4*)(k_k + ch), kac = *(const f32x4*)(k_a + ch), rkc = *(const f32x4*)(r_k + ch), w0c = *(const f32x4*)(w0p + ch);
        WK_PREP1(0, 0, ht); WK_PREP1(0, 0, ht + 16);
        LDS_WAIT(); __builtin_amdgcn_s_barrier(); asm volatile("" ::: "memory");
        for (int n = 0; n < NB; ++n) { const int cur = n & 1;
            if (n + 1 < NB) { WK_PREP1(cur ^ 1, n + 1, ht); WK_PREP1(cur ^ 1, n + 1, ht + 16); }
            if (n >= 1) {
                const int yt = (tid - 256) >> 3, yq = (tid & 7) * 4; const f32x4 y4 = *(const LAS f32x4*)(L + WK_Y + (cur ^ 1) * WK_YB + yt * 32 + yq);
                uint2 ov; ov.x = pk2(y4[0], y4[1]); ov.y = pk2(y4[2], y4[3]);
                *(uint2*)(Y + (tokb + (size_t)(n - 1) * WK_TB + yt) * D + h * 64 + half * 32 + yq) = ov; }
            LDS_WAIT(); __builtin_amdgcn_s_barrier(); asm volatile("" ::: "memory");
        }
        { const int yt = (tid - 256) >> 3, yq = (tid & 7) * 4; const f32x4 y4 = *(const LAS f32x4*)(L + WK_Y + ((NB - 1) & 1) * WK_YB + yt * 32 + yq);
            uint2 ov; ov.x = pk2(y4[0], y4[1]); ov.y = pk2(y4[2], y4[3]); *(uint2*)(Y + (tokb + (size_t)(NB - 1) * WK_TB + yt) * D + h * 64 + half * 32 + yq) = ov; }
    } else {
        LDS_WAIT(); __builtin_amdgcn_s_barrier(); asm volatile("" ::: "memory");
        const unsigned lbase = (unsigned)(size_t)L;
        for (int n = 0; n < NB; ++n) { const int cur = n & 1;
            unsigned aop = lbase + (unsigned)(cur * WK_PB + 4 * jq) * 4u, av = lbase + (unsigned)(cur * WK_PB + WK_V + 4 * rp) * 4u;
            unsigned ay = lbase + (unsigned)(jq == 0 ? WK_Y + cur * WK_YB + 2 * rp : WK_Y + 2 * WK_YB + 2 * tid) * 4u;
            WkvOps o0, o1, o2, o3;
            asm volatile("s_waitcnt lgkmcnt(0)" ::: "memory");
            WK_LOADOPS(o0, 0); WK_LOADOPS(o1, 1);
            WK_LOADOPS(o2, 2); WK_WAIT(12, o0); WK_STEP(o0, 0);
            WK_LOADOPS(o3, 3); WK_WAIT(13, o1); WK_STEP(o1, 1);
            for (int t4 = 0; t4 < 7; ++t4) {
                WK_LOADOPS(o0, 4); WK_WAIT(14, o2); WK_STEP(o2, 2);
                WK_LOADOPS(o1, 5); WK_WAIT(14, o3); WK_STEP(o3, 3);
                aop += 1024; av += 1024; ay += 512;
                WK_LOADOPS(o2, 2); WK_WAIT(14, o0); WK_STEP(o0, 0);
                WK_LOADOPS(o3, 3); WK_WAIT(14, o1); WK_STEP(o1, 1);
            }
            WK_WAIT(8, o2); WK_STEP(o2, 2);
            WK_WAIT(2, o3); WK_STEP(o3, 3);
            asm volatile("s_waitcnt lgkmcnt(0)" ::: "memory");
            __builtin_amdgcn_s_barrier(); asm volatile("" ::: "memory");
        }
        float* so = s_out + (((size_t)b * 16 + h) * 64 + half * 32 + 2 * rp) * 64 + 4 * jq; *(f32x4*)so = S0; *(f32x4*)(so + 64) = S1;
    }
#undef WK_LOADOPS
#undef WK_STEP
#undef WK_WAIT
#undef WK_RD128
#undef WK_PREP1
}
DEVI void wkv_ypass_row(size_t tok, int lane, const bf16* Y, const bf16* V, bf16* GO, const float* BON, const float* lnx_g, const float* lnx_b) {
    const int c0 = lane * 16; const size_t o = tok * D + c0;
    const v4u ya = *(const v4u*)(Y + o), yb = *(const v4u*)(Y + o + 8), va = *(const v4u*)(V + o), vb = *(const v4u*)(V + o + 8), ga = *(const v4u*)(GO + o), gb = *(const v4u*)(GO + o + 8);
    const unsigned yw[8] = {ya.x, ya.y, ya.z, ya.w, yb.x, yb.y, yb.z, yb.w}, vw[8] = {va.x, va.y, va.z, va.w, vb.x, vb.y, vb.z, vb.w}, gw_[8] = {ga.x, ga.y, ga.z, ga.w, gb.x, gb.y, gb.z, gb.w};
    float y[16]; float s = 0.f;
#pragma unroll
    for (int e = 0; e < 8; ++e) { y[2 * e] = __uint_as_float(yw[e] << 16); y[2 * e + 1] = __uint_as_float(yw[e] & 0xffff0000u); s += y[2 * e] + y[2 * e + 1]; }
    s = dpp_add(s, 0); s = dpp_add(s, 1); const float mean = s * (1.f / 64.f); float q = 0.f;
#pragma unroll
    for (int e = 0; e < 16; ++e) { y[e] -= mean; q += y[e] * y[e]; }
    q = dpp_add(q, 0); q = dpp_add(q, 1); const float rstd = rsqrtf(q * (1.f / 64.f) + 64e-5f), bon = BON[tok * 16 + (lane >> 2)];
    unsigned ow[8];
#pragma unroll
    for (int e = 0; e < 8; ++e) { const float v0 = __uint_as_float(vw[e] << 16), v1 = __uint_as_float(vw[e] & 0xffff0000u), g0 = __uint_as_float(gw_[e] << 16), g1 = __uint_as_float(gw_[e] & 0xffff0000u);
        const float o0 = (y[2 * e] * rstd * lnx_g[c0 + 2 * e] + lnx_b[c0 + 2 * e] + bon * v0) * g0, o1 = (y[2 * e + 1] * rstd * lnx_g[c0 + 2 * e + 1] + lnx_b[c0 + 2 * e + 1] + bon * v1) * g1; ow[e] = pk2(o0, o1); }
    *(v4u*)(GO + o) = (v4u){ow[0], ow[1], ow[2], ow[3]}; *(v4u*)(GO + o + 8) = (v4u){ow[4], ow[5], ow[6], ow[7]};
}

constexpr int GL_BF = 0, GL_QI = 16384, GL_KI = 25600, GL_SC = 34816, GL_VT = 44032, GL_ST = 62464, GL_RS = 80896, GL_WG = 81920, GL_GKL = 86016, GL_SEG = 90112;
constexpr int GL_LD = 72;
DEVI bf16x8 gl_frag(LAS unsigned char* lds, int base, int row, int k0, int fq) { return *(const LAS bf16x8*)(lds + base + (row * GL_LD + k0 + 8 * fq) * 2); }
DEVI void gla_cumdecay(LAS unsigned char* lds, int tid, int h, size_t tok0, const float* GKL, const float* w_gk, const float* b_gk) {
    asm volatile("" : "+v"(tid));
    LAS float* BF = (LAS float*)(lds + GL_BF); LAS float* WG = (LAS float*)(lds + GL_WG); LAS float* GK = (LAS float*)(lds + GL_GKL); LAS float* SEG = (LAS float*)(lds + GL_SEG);
    for (int i = tid; i < 1024; i += 512) { WG[i] = w_gk[(i >> 6) * 256 + h * 64 + (i & 63)]; GK[i] = GKL[tok0 * 16 + i]; }
    LDS_WAIT(); __builtin_amdgcn_s_barrier(); asm volatile("" ::: "memory");
    { const int t = tid >> 3, d0 = (tid & 7) * 8; float x[8];
#pragma unroll
        for (int e = 0; e < 8; ++e) x[e] = b_gk[h * 64 + d0 + e];
#pragma unroll
        for (int r = 0; r < 16; ++r) { const float gv = GK[t * 16 + r]; const f32x4 w0 = *(const LAS f32x4*)(WG + r * 64 + d0), w1 = *(const LAS f32x4*)(WG + r * 64 + d0 + 4);
#pragma unroll
            for (int e = 0; e < 4; ++e) { x[e] += gv * w0[e]; x[4 + e] += gv * w1[e]; } }
#pragma unroll
        for (int e = 0; e < 8; ++e) { const float xx = x[e]; x[e] = (fminf(xx, 0.f) - log1pf(__expf(-fabsf(xx)))) * (1.f / 16.f); }
        *(LAS f32x4*)(BF + t * 64 + d0) = (f32x4){x[0], x[1], x[2], x[3]}; *(LAS f32x4*)(BF + t * 64 + d0 + 4) = (f32x4){x[4], x[5], x[6], x[7]}; }
    LDS_WAIT(); __builtin_amdgcn_s_barrier(); asm volatile("" ::: "memory");
    { const int dk = tid & 63, sg = tid >> 6; float a = 0.f;
#pragma unroll
        for (int i = 0; i < 8; ++i) { a += BF[(sg * 8 + i) * 64 + dk]; BF[(sg * 8 + i) * 64 + dk] = a; }
        SEG[sg * 64 + dk] = a; }
    LDS_WAIT(); __builtin_amdgcn_s_barrier(); asm volatile("" ::: "memory");
    { const int dk = tid & 63, sg = tid >> 6; float off = 0.f;
        for (int s = 0; s < sg; ++s) off += SEG[s * 64 + dk];
#pragma unroll
        for (int i = 0; i < 8; ++i) BF[(sg * 8 + i) * 64 + dk] += off; }
    LDS_WAIT(); __builtin_amdgcn_s_barrier(); asm volatile("" ::: "memory");
}
DEVI void gla_stage_vt(LAS unsigned char* lds, int tid, int h, size_t tok0, const bf16* P) {
    const int t = tid >> 3, dv0 = (tid & 7) * 16; const bf16* vp = P + (tok0 + t) * NINP + 512 + h * 128 + dv0;
    const v4u a = *(const v4u*)vp, b = *(const v4u*)(vp + 8); LAS bf16* VT = (LAS bf16*)(lds + GL_VT);
    const unsigned w[8] = {a.x, a.y, a.z, a.w, b.x, b.y, b.z, b.w};
#pragma unroll
    for (int e = 0; e < 8; ++e) { VT[(dv0 + 2 * e) * GL_LD + t] = (bf16)(w[e] & 0xffffu); VT[(dv0 + 2 * e + 1) * GL_LD + t] = (bf16)(w[e] >> 16); }
}
DEVI void gla_unit_a(LAS unsigned char* lds, int tid, int u, const bf16* P, const float* GKL, const float* w_gk, const float* b_gk, float* KV, float* DEC) {
    asm volatile("" : "+v"(tid));
    const int bh = u >> 5, ck = u & 31, b = bh >> 2, h = bh & 3; const size_t tok0 = (size_t)b * TP + ck * 64;
    const int lane = tid & 63, wave = tid >> 6, fr = lane & 15, fq = lane >> 4;
    gla_cumdecay(lds, tid, h, tok0, GKL, w_gk, b_gk);
    LAS float* BF = (LAS float*)(lds + GL_BF);
    { const int t = tid >> 3, d0 = (tid & 7) * 8; const v4u kq = *(const v4u*)(P + (tok0 + t) * NINP + 256 + h * 64 + d0); LAS bf16* KST = (LAS bf16*)(lds + GL_QI);
        const unsigned w[4] = {kq.x, kq.y, kq.z, kq.w};
#pragma unroll
        for (int e = 0; e < 8; ++e) { const float kv = __uint_as_float((e & 1) ? (w[e >> 1] & 0xffff0000u) : (w[e >> 1] << 16)); const float sc = __expf(BF[63 * 64 + d0 + e] - BF[t * 64 + d0 + e]);
            KST[(d0 + e) * GL_LD + t] = (bf16)f2bf(kv * sc); } }
    gla_stage_vt(lds, tid, h, tok0, P);
    if (tid < 64) DEC[(size_t)u * 64 + tid] = __expf(BF[63 * 64 + tid]);
    LDS_WAIT(); __builtin_amdgcn_s_barrier(); asm volatile("" ::: "memory");
#pragma unroll
    for (int dt = 0; dt < 4; ++dt) { f32x4 acc = {0.f, 0.f, 0.f, 0.f};
#pragma unroll
        for (int k0 = 0; k0 < 64; k0 += 32) acc = __builtin_amdgcn_mfma_f32_16x16x32_bf16(gl_frag(lds, GL_VT, wave * 16 + fr, k0, fq), gl_frag(lds, GL_QI, dt * 16 + fr, k0, fq), acc, 0, 0, 0);
        *(f32x4*)(KV + ((size_t)u * 64 + dt * 16 + fr) * 128 + wave * 16 + 4 * fq) = acc; }
    LDS_WAIT(); __builtin_amdgcn_s_barrier(); asm volatile("" ::: "memory");
}
DEVI void gla_scan_b(int gtid, float* KV, const float* DEC, float* s_out) {
    const int dv = gtid & 127, dkq = (gtid >> 7) & 15, bh = gtid >> 11; float S[4] = {0.f, 0.f, 0.f, 0.f};
#pragma unroll 4
    for (int c = 0; c < 32; ++c) { const size_t u = (size_t)bh * 32 + c; float* kp = KV + (u * 64 + dkq * 4) * 128 + dv;
#pragma unroll
        for (int e = 0; e < 4; ++e) { const float kv = kp[e * 128], dc = DEC[u * 64 + dkq * 4 + e]; kp[e * 128] = S[e]; S[e] = dc * S[e] + kv; } }
#pragma unroll
    for (int e = 0; e < 4; ++e) s_out[((size_t)bh * 64 + dkq * 4 + e) * 128 + dv] = S[e];
}
DEVI void gla_unit_c(LAS unsigned char* lds, int tid, int u, const bf16* P, const float* GKL, const float* w_gk, const float* b_gk, const float* KV, const float* norm_g, bf16* O) {
    asm volatile("" : "+v"(tid));
    const int bh = u >> 5, ck = u & 31, b = bh >> 2, h = bh & 3; const size_t tok0 = (size_t)b * TP + ck * 64;
    const int lane = tid & 63, wave = tid >> 6, fr = lane & 15, fq = lane >> 4;
    gla_cumdecay(lds, tid, h, tok0, GKL, w_gk, b_gk);
    LAS float* BF = (LAS float*)(lds + GL_BF);
    { const int t = tid >> 3, d0 = (tid & 7) * 8; const v4u qq = *(const v4u*)(P + (tok0 + t) * NINP + h * 64 + d0), kq = *(const v4u*)(P + (tok0 + t) * NINP + 256 + h * 64 + d0);
        const unsigned wq[4] = {qq.x, qq.y, qq.z, qq.w}, wk[4] = {kq.x, kq.y, kq.z, kq.w}; float qo[8], ko[8];
#pragma unroll
        for (int e = 0; e < 8; ++e) { const float qv = __uint_as_float((e & 1) ? (wq[e >> 1] & 0xffff0000u) : (wq[e >> 1] << 16)), kv = __uint_as_float((e & 1) ? (wk[e >> 1] & 0xffff0000u) : (wk[e >> 1] << 16));
            const float bb = BF[t * 64 + d0 + e]; qo[e] = qv * 0.125f * __expf(bb); ko[e] = kv * __expf(-bb); }
        v4u a, c; a.x = pk2(qo[0], qo[1]); a.y = pk2(qo[2], qo[3]); a.z = pk2(qo[4], qo[5]); a.w = pk2(qo[6], qo[7]); c.x = pk2(ko[0], ko[1]); c.y = pk2(ko[2], ko[3]); c.z = pk2(ko[4], ko[5]); c.w = pk2(ko[6], ko[7]);
        *(LAS v4u*)(lds + GL_QI + (t * GL_LD + d0) * 2) = a; *(LAS v4u*)(lds + GL_KI + (t * GL_LD + d0) * 2) = c; }
    gla_stage_vt(lds, tid, h, tok0, P);
    { const int dk = tid >> 3, dv0 = (tid & 7) * 16; const float* sp = KV + ((size_t)u * 64 + dk) * 128 + dv0; LAS bf16* ST = (LAS bf16*)(lds + GL_ST);
#pragma unroll
        for (int q = 0; q < 4; ++q) { const f32x4 s4 = *(const f32x4*)(sp + 4 * q);
#pragma unroll
            for (int e = 0; e < 4; ++e) ST[(dv0 + 4 * q + e) * GL_LD + dk] = (bf16)f2bf(s4[e]); } }
    LDS_WAIT(); __builtin_amdgcn_s_barrier(); asm volatile("" ::: "memory");
#pragma unroll
    for (int q = 0; q < 2; ++q) { const int id = wave * 2 + q, tt = id >> 2, st = id & 3; f32x4 acc = {0.f, 0.f, 0.f, 0.f};
#pragma unroll
        for (int k0 = 0; k0 < 64; k0 += 32) acc = __builtin_amdgcn_mfma_f32_16x16x32_bf16(gl_frag(lds, GL_KI, st * 16 + fr, k0, fq), gl_frag(lds, GL_QI, tt * 16 + fr, k0, fq), acc, 0, 0, 0);
        const int t = tt * 16 + fr, s0 = st * 16 + 4 * fq;
#pragma unroll
        for (int e = 0; e < 4; ++e) if (s0 + e > t) acc[e] = 0.f;
        *(LAS unsigned long long*)(lds + GL_SC + (t * GL_LD + s0) * 2) = (unsigned long long)pk2(acc[0], acc[1]) | ((unsigned long long)pk2(acc[2], acc[3]) << 32); }
    LDS_WAIT(); __builtin_amdgcn_s_barrier(); asm volatile("" ::: "memory");
    const int tt = wave & 3, hv = wave >> 2; f32x4 o[4]; float ssq = 0.f;
#pragma unroll
    for (int dt = 0; dt < 4; ++dt) { f32x4 acc = {0.f, 0.f, 0.f, 0.f}; const int dvr = (hv * 4 + dt) * 16 + fr;
#pragma unroll
        for (int k0 = 0; k0 < 64; k0 += 32) { acc = __builtin_amdgcn_mfma_f32_16x16x32_bf16(gl_frag(lds, GL_VT, dvr, k0, fq), gl_frag(lds, GL_SC, tt * 16 + fr, k0, fq), acc, 0, 0, 0);
            acc = __builtin_amdgcn_mfma_f32_16x16x32_bf16(gl_frag(lds, GL_ST, dvr, k0, fq), gl_frag(lds, GL_QI, tt * 16 + fr, k0, fq), acc, 0, 0, 0); }
        o[dt] = acc; ssq += (acc[0] * acc[0] + acc[1] * acc[1]) + (acc[2] * acc[2] + acc[3] * acc[3]); }
    ssq += __shfl_xor(ssq, 16); ssq += __shfl_xor(ssq, 32);
    LAS float* RS = (LAS float*)(lds + GL_RS);
    if (fq == 0) RS[hv * 64 + tt * 16 + fr] = ssq;
    LDS_WAIT(); __builtin_amdgcn_s_barrier(); asm volatile("" ::: "memory");
    { const int t = tt * 16 + fr; const float rstd = rsqrtf((RS[t] + RS[64 + t]) * (1.f / 128.f) + 1e-5f); const size_t tok = tok0 + t;
#pragma unroll
        for (int dt = 0; dt < 4; ++dt) { const int dv = (hv * 4 + dt) * 16 + 4 * fq; const uint2 gg = *(const uint2*)(P + tok * NINP + 1024 + h * 128 + dv); const f32x4 ng = *(const f32x4*)(norm_g + dv);
            const float g0 = __uint_as_float(gg.x << 16), g1 = __uint_as_float(gg.x & 0xffff0000u), g2 = __uint_as_float(gg.y << 16), g3 = __uint_as_float(gg.y & 0xffff0000u);
            uint2 ov; ov.x = pk2(o[dt][0] * rstd * ng[0] * siluf_(g0), o[dt][1] * rstd * ng[1] * siluf_(g1)); ov.y = pk2(o[dt][2] * rstd * ng[2] * siluf_(g2), o[dt][3] * rstd * ng[3] * siluf_(g3));
            *(uint2*)(O + tok * D + h * 128 + dv) = ov; } }
    LDS_WAIT(); __builtin_amdgcn_s_barrier(); asm volatile("" ::: "memory");
}

constexpr int I_UP = (D / 64) * (NUP / 32), I_DN = (FFP / 64) * (D / 32), I_IN = (D / 64) * (NINP / 32), I_GLU = (512 / 64) * (512 / 32), I_SQ = (D / 64) * (D / 32), I_RK = (KRK / 64) * (NRK / 32), I_L2 = (NL1 / 64) * (3072 / 32);
constexpr int NITEMS = 4 * I_UP + 4 * I_DN + I_IN + I_GLU + 2 * I_SQ + I_RK + I_L2;
DEVI void cvt_dispatch(int r, unsigned char* ws, LAS float* wscr, int lane) {
            if (r < 4 * I_UP) { const int q = r / I_UP, l = q >> 1, f = q & 1; r -= q * I_UP;
                const int kb = r / (NUP / 32), nb = r % (NUP / 32), pn = nb >> 3, half = (nb >> 2) & 1, c0 = pn * 128 + (nb & 3) * 32;
                bf16* dst = (bf16*)(ws + (l ? WS_WUP_L1 : WS_WUP_L0) + f * SZ_WUP) + (size_t)(nb * 32) * D;
                if (c0 >= FF) { SrcZero s; cvt_item(s, dst, D, 1, wscr, kb, lane); }
                else if (half) { SrcPlain s{INPD(f ? 17 : 14) + (size_t)l * D * FF + c0, D, FF - c0, FF}; cvt_item(s, dst, D, 1, wscr, kb, lane); }
                else { SrcPlain s{INPD(f ? 16 : 13) + (size_t)l * D * FF + c0, D, FF - c0, FF}; cvt_item(s, dst, D, 1, wscr, kb, lane); }
                return; } r -= 4 * I_UP;
            if (r < 4 * I_DN) { const int q = r / I_DN, l = q >> 1, f = q & 1; r -= q * I_DN;
                SrcPlain s{INPD(f ? 18 : 15) + (size_t)l * FF * D, FF, D, D};
                cvt_item(s, (bf16*)(ws + (l ? WS_WDN_L1 : WS_WDN_L0) + f * SZ_WDN), FFP, D / 32, wscr, r, lane); return; } r -= 4 * I_DN;
            if (r < I_IN) { SrcPlain s{INPD(19), D, NIN, NIN}; cvt_item(s, (bf16*)(ws + WS_WIN), D, NINP / 32, wscr, r, lane); return; } r -= I_IN;
            if (r < I_GLU) { SrcPlain s{INPD(32), 512, 512, 512}; cvt_item(s, (bf16*)(ws + WS_WGLU), 512, 512 / 32, wscr, r, lane); return; } r -= I_GLU;
            if (r < I_SQ) { SrcPlain s{INPD(20), D, D, D}; cvt_item(s, (bf16*)(ws + WS_WOUT), D, D / 32, wscr, r, lane); return; } r -= I_SQ;
            if (r < I_SQ) { SrcPlain s{INPD(38), D, D, D}; cvt_item(s, (bf16*)(ws + WS_WO), D, D / 32, wscr, r, lane); return; } r -= I_SQ;
            if (r < I_RK) { const int kb = r / (NRK / 32), nb = r % (NRK / 32), n0 = nb * 32; bf16* dst = (bf16*)(ws + WS_WRK) + (size_t)n0 * KRK;
                if (n0 < 1024) { SrcFold s{INPD(35) + n0, INPD(34) + 0 * 1024, 1024}; cvt_item(s, dst, KRK, 1, wscr, kb, lane); }
                else if (n0 < 2048) { SrcFold s{INPD(36) + (n0 - 1024), INPD(34) + 2 * 1024, 1024}; cvt_item(s, dst, KRK, 1, wscr, kb, lane); }
                else if (n0 < 3072) { SrcFold s{INPD(37) + (n0 - 2048), INPD(34) + 3 * 1024, 1024}; cvt_item(s, dst, KRK, 1, wscr, kb, lane); }
                else if (n0 < 3136) { SrcFold s{INPD(40) + (n0 - 3072), INPD(34) + 1 * 1024, 64}; cvt_item(s, dst, KRK, 1, wscr, kb, lane); }
                else if (n0 < 3200) { SrcFold s{INPD(43) + (n0 - 3136), INPD(34) + 4 * 1024, 64}; cvt_item(s, dst, KRK, 1, wscr, kb, lane); }
                else if (n0 < 3360) { SrcFold s{INPD(45) + (n0 - 3200), INPD(34) + 5 * 1024, 160}; cvt_item(s, dst, KRK, 1, wscr, kb, lane); }
                else { SrcZero s; cvt_item(s, dst, KRK, 1, wscr, kb, lane); }
                return; } r -= I_RK;
            { const int kb = r / (3072 / 32), nb = r % (3072 / 32), n0 = nb * 32; bf16* dst = (bf16*)(ws + WS_WL2) + (size_t)n0 * NL1;
                if (n0 < 1024) { SrcBlk s{INPD(41) + n0, 0, 64}; cvt_item(s, dst, NL1, 1, wscr, kb, lane); }
                else if (n0 < 2048) { SrcBlk s{INPD(44) + (n0 - 1024), 64, 128}; cvt_item(s, dst, NL1, 1, wscr, kb, lane); }
                else { SrcBlk s{INPD(46) + (n0 - 2048), 128, 288}; cvt_item(s, dst, NL1, 1, wscr, kb, lane); } }
}

__global__ void __launch_bounds__(NWAVES * 64, 2) __attribute__((target("no-packed-fp32-ops"))) mk_fwd(Args args) {
    extern __shared__ __attribute__((aligned(16))) unsigned char lds_raw[];
    LAS unsigned char* lds = (LAS unsigned char*)lds_raw;
    volatile LAS unsigned* MISC = (volatile LAS unsigned*)(lds + MISC_OFF);
    const int tid = threadIdx.x, lane = tid & 63, wave = __builtin_amdgcn_readfirstlane(tid >> 6), G = gridDim.x, blk = blockIdx.x;
#define LW() (*(unsigned char* const __attribute__((address_space(4)))*)(KARG() + 424))
#define LO() (*(float* const __attribute__((address_space(4)))*)(KARG() + 416))
#define PTRS unsigned char* ws = LW(); float* out = LO(); float* MODS = (float*)(ws + WS_MODS); float* SP = (float*)(ws + WS_SP); bf16* H = (bf16*)(ws + WS_H); float* Z = (float*)(ws + WS_Z); bf16* ACT = (bf16*)(ws + WS_ACT); float* X = out; \
    (void)MODS; (void)SP; (void)H; (void)Z; (void)ACT; (void)X
    for (int u = tid; u < (LDS_BYTES - LDSCTL_OFF) / 4; u += NWAVES * 64) ((LAS unsigned*)(lds + LDSCTL_OFF))[u] = 0u;
    __syncthreads();
    { XcdBarrier b0_ = xcd_barrier_post((unsigned*)(LW() + WS_CTL) + CW_BAR, MISC + 8); (void)b0_; }
#define GRID_BAR() do { XcdBarrier b_; b_.bar = (unsigned*)(LW() + WS_CTL) + CW_BAR; b_.x = xb_xcc_id(); b_.st = MISC + 8; xcd_barrier(b_); if (XP == 6) xcd_barrier(b_); \
        if (PROBE && blk == 0 && tid == 0) ((unsigned long long*)(LW() + WS_CTL + 524288))[nst] = rt(); ++nst; } while (0)
    int nst = 0;
    if (PROBE && blk == 0 && tid == 0) ((unsigned long long*)(LW() + WS_CTL + 524288))[63] = rt();
    const int gw = blk * NWAVES + wave, NGW = G * NWAVES;
    const int gws = wave * G + blk;
    LAS float* wscr = (LAS float*)(lds + RING_OFF + wave * 16384);
    const int NP0 = G > 72 ? (G - 72) * NWAVES * P0_PER : 0;

    for (int xrep = 0; xrep < (XP == 1 ? 2 : 1); ++xrep) { PTRS;
        { float* STt = (float*)(ws + WS_ST); for (int i = blk * 512 + tid; i < 144 * 1024; i += G * 512) { const int r = i >> 10, k = i & 1023; float v = 0.f; if (r < 8) v = siluf_(INP(7)[r * 1024 + k]); else if (r < 136) v = siluf_(INP(8)[(r - 8) * 1024 + k]); STt[k * 144 + r] = v; } }
        for (int it = blk * 512 + tid; it < 2048 * 18; it += G * 512) { const int i = it & 2047, tau = it >> 11;
            if (tau == 17) s5prep_one(i, INP(24), INP(25), INP(26), INP(27), INP(28), SP); else s5prep_pw(i, tau, INP(24), INP(25), INP(26), SP); }
        if (blk >= 72) for (int it = (blk - 72) * NWAVES + wave; it < NP0; it += (G - 72) * NWAVES) cvt_dispatch(it, ws, wscr, lane);
    }
    GRID_BAR();
    for (int xq = 0; xq < (XP == 17 ? 2 : 1); ++xq) { PTRS; bf16* TM = (bf16*)(ws + WS_TM); bf16* HM = (bf16*)(ws + WS_HM);
        constexpr int NMW = 864, HS = MODS_HS;
        for (int xr = 0; xr < (XP == 10 ? 2 : 1); ++xr) for (int j = gws; j < NMW; j += NGW) { int cg, rs; if (j < 768) { cg = j & 255; rs = j >> 8; } else { const int e = j - 768; cg = 256 + e / 3; rs = e - (e / 3) * 3; }
            mods_job3(__builtin_amdgcn_readfirstlane(cg), __builtin_amdgcn_readfirstlane(rs), lane, (const float*)(ws + WS_ST), INPD(9), INPD(10), MODS); }
        const int ncw = NGW - NMW, NA = ncw > 0 ? (NP0 + HS * ncw < NITEMS ? NP0 + HS * ncw : NITEMS) : NP0;
        for (int xc = 0; xc < (XP == 19 ? 2 : 1); ++xc) { bool stA = (gws >= NMW) && NA > NP0;
        for (int itn = stA ? NP0 + gws - NMW : NA + (NGW - 1 - gws); itn < NITEMS; ) {
            int r = itn;
            if (stA) { itn += ncw; if (itn >= NA) { stA = false; itn = NA + (NGW - 1 - gws); } } else itn += NGW;
            cvt_dispatch(r, ws, wscr, lane);
        } }
        for (int xr = 0; xr < (XP == 20 ? 2 : 1); ++xr) for (int j = NGW - 1 - gws; j < 32 * 17 + 32 * 16; j += NGW) { if (j < 544) s5_tm_job(j / 17, j % 17, lane, SP, INPD(29), INPD(30), INPD(31), TM); else s5_hm_job((j - 544) >> 4, (j - 544) & 15, lane, SP, HM); }
        for (int i = gw * 64 + lane; i < 32 * 128 * 256 / 8; i += NGW * 64) { const int g = i >> 12, r = i & 4095; *(v4u*)(HM + ((size_t)g * 256 + 128) * 256 + (size_t)r * 8) = (v4u){0u, 0u, 0u, 0u}; } }
    GRID_BAR();
    { PTRS; for (int xr = 0; xr < (XP == 18 ? 2 : 1); ++xr) for (int row = gw; row < MTP; row += NGW) init_row(row, lane, INP(0), INP(1), MODS, X, H, (float*)(ws + WS_ZS)); }
    GRID_BAR();

#define GEMM_PHASE(EPI, Aptr, Bptr, NN, KK, ...) do { pg8::GemmX g_{(const pg8::bf16_t*)(Aptr), (const pg8::bf16_t*)(Bptr), MTP, NN, KK, KK, KK, -1}; pg8::StaticOrder S_; S_.init(MTP, NN, G, blk); pg8::EPI E_{__VA_ARGS__}; \
        pg8::gemm_phase<pg8::EPI, pg8::StaticOrder, true, true>(lds + RING_OFF, g_, S_, E_); } while (0)
#define GEMMX_PHASE(EPI, Aptr, Bptr, MM, NN, KK, LDA, LDB, GSH, ...) do { pg8::GemmX g_{(const pg8::bf16_t*)(Aptr), (const pg8::bf16_t*)(Bptr), MM, NN, KK, LDA, LDB, GSH}; pg8::StaticOrder S_; S_.init(MM, NN, G, blk); pg8::EPI E_{__VA_ARGS__}; \
        pg8::gemm_phase<pg8::EPI, pg8::StaticOrder, true, true>(lds + RING_OFF, g_, S_, E_); } while (0)
#define RESID_PHASE(XS, Aptr, Bptr, KK, gatep, rcv) do { \
        { pg8::GemmX g_{(const pg8::bf16_t*)(Aptr), (const pg8::bf16_t*)(Bptr), NP, D, KK, KK, KK, -1}; pg8::StaticOrder S_; S_.init(NP, D, G, blk); pg8::EpiResid E_{(XS), Z, gatep, rcv, 0}; \
          pg8::gemm_phase<pg8::EpiResid, pg8::StaticOrder, true, true>(lds + RING_OFF, g_, S_, E_); } \
        { pg8::GemmX g_{(const pg8::bf16_t*)(Aptr), (const pg8::bf16_t*)(Bptr), MTP, D, 256, KK, KK, -1}; pg8::SplitOrder S_{64, 4, (KK) / 256, 256, G, blk}; pg8::EpiResidS E_{(float*)(ws + WS_SL), gatep, rcv, 0}; \
          pg8::gemm_phase<pg8::EpiResidS, pg8::SplitOrder, true, true>(lds + RING_OFF, g_, S_, E_); } } while (0)
#define LN_PASS(l, idx, Hout, nsh, nsc) do { PTRS; const int nsl_ = ((idx) == 1) ? 4 : 11; for (int row = gw; row < MT; row += NGW) ln_row(row, lane, Z, (float*)(ws + WS_ZS), (const float*)(ws + WS_SL), nsl_, INP(11) + ((l) * 3 + (idx)) * D, INP(12) + ((l) * 3 + (idx)) * D, X, Hout, nsh, nsc); } while (0)
#define FFN(XS, l, f, which0, lnidx, HOUT, nshw, nscw) do { \
        { PTRS; { int ru_ = (XP == 41 ? 2 : 1); asm volatile("" : "+s"(ru_)); for (int xu = 0; xu < ru_; ++xu) GEMM_PHASE(EpiSwiglu, H, ws + ((l) ? WS_WUP_L1 : WS_WUP_L0) + (f) * SZ_WUP, NUP, D, (pg8::bf16_t*)ACT); } if (XP == 2) { GEMM_PHASE(EpiSwiglu, H, ws + ((l) ? WS_WUP_L1 : WS_WUP_L0) + (f) * SZ_WUP, NUP, D, (pg8::bf16_t*)ACT); } if (XP == 42) { GEMM_PHASE(EpiHloc, H, ws + ((l) ? WS_WUP_L1 : WS_WUP_L0) + (f) * SZ_WUP, NUP, D, (float*)(ws + WS_Z)); } } GRID_BAR(); \
        { PTRS; RESID_PHASE(XS, ACT, ws + ((l) ? WS_WDN_L1 : WS_WDN_L0) + (f) * SZ_WDN, FFP, modp(MODS, l, (which0) + 2), 0.5f); if (XP == 3) { RESID_PHASE(XS, ACT, ws + ((l) ? WS_WDN_L1 : WS_WDN_L0) + (f) * SZ_WDN, FFP, modp(MODS, l, (which0) + 2), 0.5f); } } GRID_BAR(); \
        LN_PASS(l, lnidx, HOUT, nshw, nscw); if (XP == 4) { LN_PASS(l, lnidx, HOUT, nshw, nscw); } GRID_BAR(); } while (0)

    FFN(INP(0), 0, 0, 0, 0, H, modp(MODS, 0, 3), modp(MODS, 0, 4));
#define L0PTRS PTRS; bf16* P = (bf16*)(ws + WS_P); float* GKL = (float*)(ws + WS_GKL); float* OGS = (float*)(ws + WS_OGS) - (size_t)NP * 512; bf16* Z5 = (bf16*)(ws + WS_Z5); bf16* O = (bf16*)(ws + WS_O); \
        bf16* UB = (bf16*)(ws + WS_UBUF); float* HL = (float*)(ws + WS_HLOC); float* KV = (float*)(ws + WS_KV); float* DEC = (float*)(ws + WS_DEC); (void)P; (void)GKL; (void)OGS; (void)Z5; (void)O; (void)UB; (void)HL; (void)KV; (void)DEC
    { L0PTRS; for (int xr = 0; xr < (XP == 11 ? 2 : 1); ++xr) GEMM_PHASE(EpiInproj, H, ws + WS_WIN, NINP, D, (pg8::bf16_t*)P, GKL, (pg8::bf16_t*)UB); } GRID_BAR();
    for (int xr = 0; xr < (XP == 12 ? 2 : 1); ++xr) { if (xr) { GRID_BAR(); --nst; } L0PTRS;
        { int reps_ = (XP == 25 ? 2 : (XP == 26 ? 5 : 1)); asm volatile("" : "+s"(reps_)); for (int xh = 0; xh < reps_; ++xh) GEMMX_PHASE(EpiHloc, UB, ws + WS_HM, 32768, 256, 256, 384, 256, 2, HL); }
        for (int u = (blk + 128) & 255; u < 1024; u += 256) gla_unit_a(lds + RING_OFF, tid, u, P, GKL, INPD(21), INPD(22), KV, DEC);
    }
    GRID_BAR();
    { L0PTRS;
        for (int xr = 0; xr < (XP == 13 ? 2 : 1); ++xr) if (gws < 256) s5_carry_job(gws >> 5, gws & 31, lane, SP, HL, UB, out + O_S5RE_P, out + O_S5IM_P);
        if (blk >= 128) gla_scan_b((blk - 128) * 512 + tid, KV, DEC, out + O_GLA_P);
        for (int s = gws; s < 1536; s += NGW) {
            if (s < 1024) gla_job(wscr, lane, s >> 3, (s >> 1) & 3, s & 1, P, GKL, INPD(21), INPD(22), NP, 1, INPD(2), out + O_GLA_S, OGS);
            else { const int j = s - 1024; s5_job(wscr, lane, j & 31, (j >> 5) * 8, 8, P, SP, INPD(29), INPD(30), INPD(31), NP, 1, INPD(3), INPD(4), out + O_S5RE_S, out + O_S5IM_S, Z5); } }
    } GRID_BAR();
    for (int xr = 0; xr < (XP == 14 ? 2 : 1); ++xr) { L0PTRS;
        GEMMX_PHASE(EpiS5Y, UB, ws + WS_TM, 32768, 256, 384, 384, 384, 2, (pg8::bf16_t*)Z5);
        for (int u = (blk + 128) & 255; u < 1024; u += 256) gla_unit_c(lds + RING_OFF, tid, u, P, GKL, INPD(21), INPD(22), KV, INPD(23), O);
        for (int w = NP * 4 + gw; w < MT * 4; w += NGW) gla_post_one(w, lane, OGS, P, INP(23), O); } GRID_BAR();
    { L0PTRS; { int rg_ = (XP == 24 ? 2 : 1); asm volatile("" : "+s"(rg_)); for (int xr = 0; xr < rg_; ++xr) GEMM_PHASE(EpiGlu, Z5, ws + WS_WGLU, 512, 512, (const pg8::bf16_t*)Z5, (pg8::bf16_t*)O, INP(33)); }
        if (XP == 40) { int rh_ = 2; asm volatile("" : "+s"(rh_)); for (int xr = 0; xr < rh_; ++xr) GEMM_PHASE(EpiHloc, Z5, ws + WS_WGLU, 512, 512, HL); } } GRID_BAR();
    { L0PTRS; RESID_PHASE(X, O, ws + WS_WOUT, D, modp(MODS, 0, 5), 1.0f); } GRID_BAR();
    LN_PASS(0, 1, H, modp(MODS, 0, 6), modp(MODS, 0, 7)); GRID_BAR();
    FFN(X, 0, 1, 6, 2, H, modp(MODS, 1, 0), modp(MODS, 1, 1));
    FFN(X, 1, 0, 0, 0, (bf16*)nullptr, (const float*)nullptr, (const float*)nullptr);
#define L1PTRS PTRS; bf16* A2 = (bf16*)(ws + WS_A2); bf16* R = (bf16*)(ws + WS_R); bf16* Kb = (bf16*)(ws + WS_K); bf16* V = (bf16*)(ws + WS_V); bf16* L1 = (bf16*)(ws + WS_L1A); \
        bf16* WRAW = (bf16*)(ws + WS_WRAW); bf16* YB = (bf16*)(ws + WS_YB); float* BON = (float*)(ws + WS_BON); bf16* AS = (bf16*)(ws + WS_AS); bf16* Gt = (bf16*)(ws + WS_G); (void)A2; (void)R; (void)Kb; (void)V; (void)L1; (void)WRAW; (void)YB; (void)BON; (void)AS; (void)Gt
    { L1PTRS; for (int row = gw; row < MTP; row += NGW) shiftcat_row(row, lane, X, MODS, INP(5), A2, out); } GRID_BAR();
    { L1PTRS; GEMM_PHASE(EpiRk, A2, ws + WS_WRK, NRK, KRK, (pg8::bf16_t*)R, (size_t)MTP * D, (pg8::bf16_t*)L1); if (XP == 7) { GEMM_PHASE(EpiRk, A2, ws + WS_WRK, NRK, KRK, (pg8::bf16_t*)R, (size_t)MTP * D, (pg8::bf16_t*)L1); } } GRID_BAR();
    { L1PTRS; GEMM_PHASE(EpiLora2, L1, ws + WS_WL2, 3072, NL1, (pg8::bf16_t*)WRAW, (pg8::bf16_t*)AS, (pg8::bf16_t*)Gt, INP(42)); } GRID_BAR();
    if (XP == 21 || XP == 22) { L1PTRS; bf16* dY = (bf16*)(ws + WS_L0 + 32 * MiB); float* dB = (float*)(ws + WS_L0 + 26 * MiB); float* dS = (float*)(ws + WS_L0 + 25 * MiB + 524288);
        if (XP == 21) wkv_half<1>((LAS float*)(lds + RING_OFF), tid, 0, 0, 0, R, Kb, V, WRAW, AS, INPD(39), INPD(47), INPD(48), INPD(49), dY, dB, dS);
        else wkv_half<2>((LAS float*)(lds + RING_OFF), tid, 0, 0, 0, R, Kb, V, WRAW, AS, INPD(39), INPD(47), INPD(48), INPD(49), dY, dB, dS); __syncthreads(); }
    for (int xr = 0; xr < (XP == 5 ? 2 : 1); ++xr) { L1PTRS; wkv_half<0>((LAS float*)(lds + RING_OFF), tid, blk >> 5, (blk >> 1) & 15, blk & 1, R, Kb, V, WRAW, AS, INPD(39), INPD(47), INPD(48), INPD(49), YB, BON, out + O_WKV_P); if (XP == 5) __syncthreads(); } GRID_BAR();
    { L1PTRS;
        for (int t = gw; t < NP; t += NGW) wkv_ypass_row((size_t)t, lane, YB, V, Gt, BON, INPD(50), INPD(51));
        for (int s = gws; s < 2048; s += NGW) wkv_job(wscr, lane, s >> 4, s & 15, R, Kb, V, WRAW, INPD(39), AS, Gt, INPD(47), INPD(48), INPD(49), INPD(50), INPD(51), NP, 1, INPD(6), out + O_WKV_S); }
    GRID_BAR();
    { L1PTRS; RESID_PHASE(X, Gt, ws + WS_WO, D, modp(MODS, 1, 5), 1.0f); } GRID_BAR();
    LN_PASS(1, 1, H, modp(MODS, 1, 6), modp(MODS, 1, 7)); GRID_BAR();
    { PTRS; GEMM_PHASE(EpiSwiglu, H, ws + WS_WUP_L1 + SZ_WUP, NUP, D, (pg8::bf16_t*)ACT); if (XP == 2) { GEMM_PHASE(EpiSwiglu, H, ws + WS_WUP_L1 + SZ_WUP, NUP, D, (pg8::bf16_t*)ACT); } } GRID_BAR();
    { PTRS; RESID_PHASE(X, ACT, ws + WS_WDN_L1 + SZ_WDN, FFP, modp(MODS, 1, 8), 0.5f); if (XP == 3) { RESID_PHASE(X, ACT, ws + WS_WDN_L1 + SZ_WDN, FFP, modp(MODS, 1, 8), 0.5f); } } GRID_BAR();
    LN_PASS(1, 2, (bf16*)nullptr, (const float*)nullptr, (const float*)nullptr); if (XP == 4) { LN_PASS(1, 2, (bf16*)nullptr, (const float*)nullptr, (const float*)nullptr); }
#if PROBE
    {
        __syncthreads();
        PTRS; const unsigned long long* TS = (const unsigned long long*)(ws + WS_CTL + 524288);
        const float v1 = (float)(TS[PROBE_A1] - TS[PROBE_A0]) * 0.01f, v2 = (float)(TS[PROBE_B1] - TS[PROBE_B0]) * 0.01f * 10.0f;
        for (int row = NP + gw; row < MT; row += NGW) for (int j = 0; j < 16; ++j) X[(size_t)row * D + j * 64 + lane] = v1;
        if (blk == 0 && tid == 0) out[O_WKV_S] = v2;
    }
#endif
}

extern "C" void kernel_launch(void* const* d_in, const int* in_sizes, int n_in, void* d_out, int out_size, void* d_ws, size_t ws_size, hipStream_t stream) {
    static int grid = 0;
    if (grid == 0) {
        if (n_in != 52 || ws_size < WS_END) { fprintf(stderr, "kernel_launch: unexpected n_in %d or ws %zu\n", n_in, ws_size); grid = -1; return; }
        int dev = 0, cus = 0, per_cu = 0;
        if (hipGetDevice(&dev) != hipSuccess || hipDeviceGetAttribute(&cus, hipDeviceAttributeMultiprocessorCount, dev) != hipSuccess) { grid = -1; return; }
        if (hipFuncSetAttribute((const void*)mk_fwd, hipFuncAttributeMaxDynamicSharedMemorySize, LDS_BYTES) != hipSuccess) { fprintf(stderr, "hipFuncSetAttribute failed\n"); grid = -1; return; }
        if (hipOccupancyMaxActiveBlocksPerMultiprocessor(&per_cu, (const void*)mk_fwd, NWAVES * 64, LDS_BYTES) != hipSuccess || per_cu < 1) { fprintf(stderr, "occupancy query: %d\n", per_cu); per_cu = 1; }
        (void)hipGetLastError();
        grid = cus;
    }
    if (grid < 0) return;
    (void)hipMemsetAsync((char*)d_ws + WS_CTL, 0, CTL_ZERO_BYTES, stream);
    Args a{};
    for (int i = 0; i < 52; ++i) a.in[i] = (const float*)d_in[i];
    a.out = (float*)d_out; a.ws = (unsigned char*)d_ws;
    hipLaunchKernelGGL(mk_fwd, dim3(grid), dim3(NWAVES * 64), LDS_BYTES, stream, a);
}
```

```cpp
#include <hip/hip_runtime.h>
#include <cstdint>
#include <cstdio>

#ifndef PROBE
#define PROBE 0
#endif
#define XP 0
#ifndef P0_PER
#define P0_PER 8
#endif
#ifndef MODS_HS
#define MODS_HS 6
#endif
#define PROBE_A0 63
#define PROBE_A1 1
#define PROBE_B0 1
#define PROBE_B1 4
typedef unsigned short bf16;
typedef short bf16x8 __attribute__((ext_vector_type(8)));
typedef float f32x4 __attribute__((ext_vector_type(4)));
#define DEVI __device__ __forceinline__
__device__ __forceinline__ void mk_syncthreads() { asm volatile("s_waitcnt vmcnt(0) lgkmcnt(0)" ::: "memory"); __builtin_amdgcn_s_barrier(); asm volatile("" ::: "memory"); }
#define __syncthreads() mk_syncthreads()

constexpr int D = 1024, NP = 16384, NS = 128, MT = NP + NS, MTP = 16640, TP = 2048, BP = 8;
constexpr int FF = 2752, FFP = 2816, NUP = 2 * FFP;
constexpr int NIN = 2064, NINP = 2304;
constexpr int NRK = 3584, KRK = 2048, NL1 = 384;
constexpr int NMODROW = 136;
constexpr float ALPHA = 1.41421356237309515f;

constexpr size_t O_Y = 0, O_GLA_P = 16908288, O_S5RE_P = 17170432, O_S5IM_P = 17186816, O_SHIFT_P = 17203200, O_WKV_P = 17211392,
                 O_GLA_S = 17735680, O_S5RE_S = 21929984, O_S5IM_S = 22192128, O_SHIFT_S = 22454272, O_WKV_S = 22585344;

constexpr size_t MiB = 1u << 20;
constexpr size_t WS_CTL = 0, CTL_ZERO_BYTES = 1 * MiB;
constexpr size_t WS_MODS = 1 * MiB, WS_SP = 12 * MiB, WS_ST = 344 * MiB, WS_ZS = 345 * MiB, WS_SL = 336 * MiB;
constexpr size_t WS_W = 13 * MiB;
constexpr size_t SZ_WUP = (size_t)NUP * D * 2;
constexpr size_t SZ_WDN = (size_t)D * FFP * 2;
constexpr size_t WS_L0 = WS_W;
constexpr size_t WS_WUP_L0 = WS_L0, WS_WDN_L0 = WS_L0 + 22 * MiB, WS_WIN = WS_L0 + 33 * MiB, WS_WGLU = WS_WIN + 4608 * 1024, WS_WOUT = WS_WGLU + 512 * 1024;
constexpr size_t WS_L1 = WS_L0 + 40 * MiB;
constexpr size_t WS_WUP_L1 = WS_L1, WS_WDN_L1 = WS_L1 + 22 * MiB, WS_WRK = WS_L1 + 33 * MiB, WS_WL2 = WS_WRK + 14 * MiB, WS_WO = WS_WL2 + 2304 * 1024;
static_assert(WS_WO + 2 * MiB <= 105 * MiB, "W region");
constexpr size_t WS_H = 105 * MiB, WS_Z = 138 * MiB, WS_ACT = 203 * MiB, WS_S2 = 293 * MiB, WS_END = 346 * MiB;
constexpr size_t WS_P = WS_ACT, WS_GKL = 277 * MiB, WS_Z5 = WS_Z, WS_O = WS_H, WS_DEC = 195 * MiB, WS_OGS = 196 * MiB, WS_KV = WS_S2;
constexpr size_t WS_UBUF = 155 * MiB, WS_HLOC = 179 * MiB, WS_HM = 326 * MiB, WS_TM = 330 * MiB;
constexpr size_t WS_A2 = WS_ACT, WS_K = WS_Z, WS_R = WS_Z - (size_t)MTP * D * 2, WS_V = WS_Z + (size_t)MTP * D * 2, WS_L1A = WS_L0, WS_WRAW = WS_ACT, WS_YB = WS_ACT + (size_t)MTP * D * 2, WS_BON = WS_L0 + 30 * MiB, WS_AS = 268 * MiB, WS_G = WS_AS + (size_t)MTP * D * 2;
static_assert(WS_G + (size_t)MTP * D * 2 <= WS_END, "ws");
constexpr int CW_TMO = 0, CW_BAR = 4096;

#define GAS __attribute__((address_space(1)))
#define LAS __attribute__((address_space(3)))
typedef unsigned short bf16;
typedef unsigned v4u __attribute__((ext_vector_type(4)));
typedef float f32x4 __attribute__((ext_vector_type(4)));
typedef short bf16x8 __attribute__((ext_vector_type(8)));
typedef GAS unsigned gu32;
typedef GAS unsigned long long gu64;
#define RLX_AGENT __ATOMIC_RELAXED, __HIP_MEMORY_SCOPE_AGENT
#define LDS_WAIT() asm volatile("s_waitcnt lgkmcnt(0)" ::: "memory")
#define VM_WAIT() asm volatile("s_waitcnt vmcnt(0)" ::: "memory")
__device__ __forceinline__ unsigned long long rt() { return __builtin_amdgcn_s_memrealtime(); }
__device__ __forceinline__ unsigned f2bf(float f) { unsigned u = __builtin_bit_cast(unsigned, f); return (u + 0x7fffu + ((u >> 16) & 1u)) >> 16; }
__device__ __forceinline__ unsigned pk2(float lo, float hi) { return f2bf(lo) | (f2bf(hi) << 16); }

#define XB_TMO      128
#define XB_XCNT(j)  (256  + 64 * (j))
#define XB_XSUB(j)  (1280 + 64 * (j))
#define XB_XGEN(j)  (2304 + 64 * (j))
#define XB_TOP      3328
#define XB_TOPGEN   3392
#define XCD_BAR_WORDS 3456
#define XB_SPIN_CAP (1u << 18)

__device__ __forceinline__ unsigned xb_ld(unsigned* p)              { return __hip_atomic_load(p, __ATOMIC_RELAXED, __HIP_MEMORY_SCOPE_AGENT); }
__device__ __forceinline__ unsigned xb_add(unsigned* p, unsigned v) { return __hip_atomic_fetch_add(p, v, __ATOMIC_RELAXED, __HIP_MEMORY_SCOPE_AGENT); }
__device__ __forceinline__ unsigned xb_xcc_id() { return (unsigned)__builtin_amdgcn_s_getreg((3 << 11) | 20) & 0xFu; }
#define XB_SPIN(cond, bar) do { unsigned _sp = 0; while (cond) { __builtin_amdgcn_s_sleep(1); \
    if ((++_sp & 255u) == 0u) { if (xb_ld(&(bar)[XB_TMO])) break; if (_sp > XB_SPIN_CAP) { atomicAdd(&(bar)[XB_TMO], 1u); break; } } } } while (0)

struct XcdBarrier {
    unsigned* bar; unsigned x;
    volatile LAS unsigned* st;
};

__device__ __forceinline__ XcdBarrier xcd_barrier_post(unsigned* bar, volatile LAS unsigned* st) {
    XcdBarrier b; b.bar = bar; b.x = xb_xcc_id(); b.st = st;
    if (threadIdx.x == 0) (void)xb_add(&bar[XB_XCNT(b.x)], 1u);
    return b;
}
__device__ __forceinline__ void xcd_barrier_complete(unsigned* bar, unsigned x, unsigned& nloc, unsigned& nx) {
    const unsigned G = gridDim.x * gridDim.y * gridDim.z;
    unsigned sum, cnt, mine, sp = 0u;
    for (;;) {
        sum = 0u; cnt = 0u; mine = 0u;
#pragma unroll
        for (unsigned j = 0; j < 16; ++j) { const unsigned c = xb_ld(&bar[XB_XCNT(j)]); sum += c; cnt += (c > 0u) ? 1u : 0u; mine = (j == x) ? c : mine; }
        if (sum == G) break;
        __builtin_amdgcn_s_sleep(1);
        if ((++sp & 255u) == 0u) { if (xb_ld(&bar[XB_TMO])) break; if (sp > XB_SPIN_CAP) { atomicAdd(&bar[XB_TMO], 1u); break; } }
    }
    nloc = mine > 0u ? mine : 1u; nx = cnt > 0u ? cnt : 1u;
}

__device__ __forceinline__ void xcd_barrier(const XcdBarrier& b) {
    asm volatile("s_waitcnt vmcnt(0)" ::: "memory");
    __syncthreads();
    if (threadIdx.x == 0) {
        unsigned* bar = b.bar;
        __builtin_amdgcn_s_waitcnt(0);
        unsigned nloc = b.st[0], nx = b.st[1];
        if (nloc == 0u) { xcd_barrier_complete(bar, b.x, nloc, nx); b.st[0] = nloc; b.st[1] = nx; }
        const unsigned old = xb_add(&bar[XB_XSUB(b.x)], 1u);
        const unsigned gen = old / nloc;
        if (old + 1u == (gen + 1u) * nloc) {
            __builtin_amdgcn_fence(__ATOMIC_RELEASE, "agent");
            asm volatile("s_waitcnt vmcnt(0)" ::: "memory");
            const unsigned og = xb_add(&bar[XB_TOP], 1u);
            const unsigned tg = og / nx;
            if (og + 1u == (tg + 1u) * nx) xb_add(&bar[XB_TOPGEN], 1u);
            else XB_SPIN(xb_ld(&bar[XB_TOPGEN]) == tg, bar);
            __builtin_amdgcn_fence(__ATOMIC_ACQUIRE, "agent");
            xb_add(&bar[XB_XGEN(b.x)], 1u);
            asm volatile("s_waitcnt vmcnt(0)" ::: "memory");
        } else {
            XB_SPIN(xb_ld(&bar[XB_XGEN(b.x)]) == gen, bar);
            __builtin_amdgcn_fence(__ATOMIC_ACQUIRE, "agent");
            asm volatile("s_waitcnt vmcnt(0)" ::: "memory");
        }
    }
    __syncthreads();
}

DEVI float bf2f(unsigned short h) { return __uint_as_float(((unsigned)h) << 16); }
DEVI int mrow(int i) { return i < NP ? (i >> 11) : (8 + i - NP); }
DEVI float sigmoidf_(float x) { return 1.0f / (1.0f + __expf(-x)); }
DEVI float siluf_(float x) { return x / (1.0f + __expf(-x)); }
DEVI float softplusf_(float x) { return fmaxf(x, 0.f) + log1pf(__expf(-fabsf(x))); }
DEVI float gelu_tanh(float x) { const float u = 0.7978845608028654f * (x + 0.044715f * x * x * x); return 0.5f * x * (1.0f + tanhf(u)); }
DEVI float wave_sum(float v) {
#pragma unroll
    for (int o = 1; o < 64; o <<= 1) v += __shfl_xor(v, o);
    return v;
}
__host__ __device__ __forceinline__ const float* modp(const float* mods, int l, int which) { return mods + (size_t)l * NMODROW * 9216 + which * 1024; }

namespace pg8 {
#define PG8_LAS __attribute__((address_space(3)))
typedef unsigned short bf16_t;
typedef short bf16x8 __attribute__((ext_vector_type(8)));
typedef float f32x4 __attribute__((ext_vector_type(4)));
typedef unsigned u32x4 __attribute__((ext_vector_type(4)));
constexpr int BM = 256, BK = 64, HALF = 128, HTB = HALF * BK * 2  , STAGE_BYTES = 8 * HTB, NXCD = 8, WGM = 8;

__host__ __device__ __forceinline__ int lds_byte(int r, int c) { const int st = (r >> 4) * 2 + (c >> 5), rr = r & 15, cc = c & 31, ob = rr * 64 + cc * 2; return st * 1024 + (ob ^ (((ob >> 9) & 1) << 5)); }
__host__ __device__ __forceinline__ void stage_rc(int b, int& R, int& C) { const int st = b / 1024, sb = b % 1024, swz = sb ^ (((sb >> 9) & 1) << 5); R = (st >> 1) * 16 + swz / 64; C = (st & 1) * 32 + (swz % 64) / 2; }
__host__ __device__ __forceinline__ int perm32(int rho) { const int n = rho >> 4, i = rho & 15; return 8 * (i >> 2) + 4 * n + (i & 3); }

struct Unit { int pm, pn, ko; };
struct Gemm { const bf16_t* A; const bf16_t* Bt; int M, N, K; };
struct GemmX { const bf16_t* A; const bf16_t* Bt; int M, N, K, lda, ldb, gsh; };

struct StaticOrder {
    int nM, nN, nwg, G, c;
    __host__ __device__ __forceinline__ void init(int M, int N, int G_, int c_) { nM = M / BM; nN = N / BM; nwg = nM * nN; G = G_; c = c_; }
    __host__ __device__ __forceinline__ bool next(int i, Unit& u) const {
        const long L = (long)i * G + c; if (L >= nwg) return false;
        int wgid = (int)L; { const int q = nwg / NXCD, r = nwg % NXCD, xcd = wgid % NXCD, off = wgid / NXCD; wgid = (xcd < r ? xcd * (q + 1) : r * (q + 1) + (xcd - r) * q) + off; }
        const int nig = WGM * nN, gid = wgid / nig, fm = gid * WGM, gsz = (nM - fm) < WGM ? (nM - fm) : WGM;
        u.pm = fm + ((wgid % nig) % gsz); u.pn = (wgid % nig) / gsz; u.ko = 0; return true;
    }
    __device__ __forceinline__ void a_ready(const Unit&) const {}
    __device__ __forceinline__ void done(const Unit&) const {}
};

struct SplitOrder {
    int pm0, nN, nsplit, kspl, G, c;
    __host__ __device__ __forceinline__ bool next(int i, Unit& u) const { const int L = i * G + c; if (L >= nsplit * nN) return false; u.pm = pm0; u.pn = L % nN; u.ko = (L / nN) * kspl; return true; }
    __device__ __forceinline__ void a_ready(const Unit&) const {}
    __device__ __forceinline__ void done(const Unit&) const {}
};

__device__ __forceinline__ unsigned cvt_pk_bf16(float lo, float hi) { unsigned r; asm volatile("v_cvt_pk_bf16_f32 %0, %1, %2" : "=v"(r) : "v"(lo), "v"(hi)); return r; }
__device__ __forceinline__ float fsilu(float x) { return x * __builtin_amdgcn_rcpf(1.0f + __builtin_amdgcn_exp2f(-1.44269504089f * x)); }
__device__ __forceinline__ float fsigm(float x) { return __builtin_amdgcn_rcpf(1.0f + __builtin_amdgcn_exp2f(-1.44269504089f * x)); }
__device__ __forceinline__ u32x4 pack8(const f32x4 a, const f32x4 b) { u32x4 w; w.x = cvt_pk_bf16(a[0], a[1]); w.y = cvt_pk_bf16(a[2], a[3]); w.z = cvt_pk_bf16(b[0], b[1]); w.w = cvt_pk_bf16(b[2], b[3]); return w; }
struct EpiSwiglu { static constexpr bool PERM = true, AFTER_DRAIN = false; bf16_t* ACT;
    __device__ __forceinline__ void operator()(const f32x4 (&acc)[2][2][4][2], const Unit& u, int wr, int wc, int fr, int fq) const {
        const int row0 = u.pm * BM + wr * 64 + fr, col0 = u.pn * 128 + wc * 32 + 8 * fq;
#pragma unroll
        for (int ai = 0; ai < 2; ++ai)
#pragma unroll
            for (int m = 0; m < 4; ++m) { f32x4 o0, o1;
#pragma unroll
                for (int e = 0; e < 4; ++e) { o0[e] = fsilu(acc[ai][0][m][0][e]) * acc[ai][1][m][0][e]; o1[e] = fsilu(acc[ai][0][m][1][e]) * acc[ai][1][m][1][e]; }
                *(u32x4*)(ACT + (size_t)(row0 + ai * HALF + m * 16) * 2816 + col0) = pack8(o0, o1); }
    } };
struct EpiResid { static constexpr bool PERM = true, AFTER_DRAIN = false; const float* X; float* Z; const float* gate; float rc; int pad;
    __device__ __forceinline__ void operator()(const f32x4 (&acc)[2][2][4][2], const Unit& u, int wr, int wc, int fr, int fq) const {
        const float* __restrict__ xp = X + (size_t)(u.pm * BM + wr * 64 + fr) * 1024 + u.pn * BM + wc * 32 + 8 * fq; float* __restrict__ zp = Z + (size_t)(u.pm * BM + wr * 64 + fr) * 1024 + u.pn * BM + wc * 32 + 8 * fq;
        const float* __restrict__ gp = gate + (size_t)(u.pm >> 3) * 9216 + u.pn * BM + wc * 32 + 8 * fq;
        f32x4 g[2][2], xa[2][2], xb[2][2];
#pragma unroll
        for (int bj = 0; bj < 2; ++bj)
#pragma unroll
            for (int n = 0; n < 2; ++n) { g[bj][n] = (*(const f32x4*)(gp + bj * HALF + 4 * n) + 1.0f) * rc; xa[bj][n] = *(const f32x4*)(xp + bj * HALF + 4 * n); }
#pragma unroll
        for (int i = 0; i < 8; ++i) { const int ai = i >> 2, m = i & 3; const size_t ro = (size_t)(ai * HALF + m * 16) * 1024;
            if (i + 1 < 8) { const size_t rn = (size_t)(((i + 1) >> 2) * HALF + ((i + 1) & 3) * 16) * 1024;
#pragma unroll
                for (int bj = 0; bj < 2; ++bj)
#pragma unroll
                    for (int n = 0; n < 2; ++n) { if (i & 1) xa[bj][n] = *(const f32x4*)(xp + rn + bj * HALF + 4 * n); else xb[bj][n] = *(const f32x4*)(xp + rn + bj * HALF + 4 * n); } }
#pragma unroll
            for (int bj = 0; bj < 2; ++bj)
#pragma unroll
                for (int n = 0; n < 2; ++n) { const f32x4 x = (i & 1) ? xb[bj][n] : xa[bj][n]; *(f32x4*)(zp + ro + bj * HALF + 4 * n) = x * 1.41421356237309515f + g[bj][n] * acc[ai][bj][m][n]; } }
    } };
struct EpiInproj { static constexpr bool PERM = true, AFTER_DRAIN = false; bf16_t* P; float* GKL; bf16_t* UB;
    __device__ __forceinline__ void operator()(const f32x4 (&acc)[2][2][4][2], const Unit& u, int wr, int wc, int fr, int fq) const {
        const int row0 = u.pm * BM + wr * 64 + fr;
#pragma unroll
        for (int ai = 0; ai < 2; ++ai)
#pragma unroll
            for (int m = 0; m < 4; ++m) { const int row = row0 + ai * HALF + m * 16;
#pragma unroll
                for (int bj = 0; bj < 2; ++bj) { const int c = u.pn * BM + bj * HALF + wc * 32 + 8 * fq;
                    const u32x4 pk = pack8(acc[ai][bj][m][0], acc[ai][bj][m][1]);
                    *(u32x4*)(P + (size_t)row * 2304 + c) = pk;
                    if (c >= 1552 && c < 2064 && row < 16384) { const int cu = c - 1552; *(u32x4*)(UB + ((size_t)((cu >> 4) * 1024 + (row >> 4))) * 384 + (row & 15) * 16 + (cu & 15)) = pk; }
                    if (c >= 1536 && c < 1552) { *(f32x4*)(GKL + (size_t)row * 16 + (c - 1536)) = acc[ai][bj][m][0]; *(f32x4*)(GKL + (size_t)row * 16 + (c - 1536) + 4) = acc[ai][bj][m][1]; } } }
    } };
struct EpiGlu { static constexpr bool PERM = true, AFTER_DRAIN = false; const bf16_t* Z5; bf16_t* O; const float* bg;
    __device__ __forceinline__ void operator()(const f32x4 (&acc)[2][2][4][2], const Unit& u, int wr, int wc, int fr, int fq) const {
        const int cb = u.pn * BM + wc * 32 + 8 * fq;
        const bf16_t* __restrict__ zp = Z5 + (size_t)(u.pm * BM + wr * 64 + fr) * 512 + cb; bf16_t* __restrict__ op = O + (size_t)(u.pm * BM + wr * 64 + fr) * 1024 + 512 + cb;
        f32x4 b[2][2]; u32x4 za[2], zb[2];
#pragma unroll
        for (int bj = 0; bj < 2; ++bj) { b[bj][0] = *(const f32x4*)(bg + cb + bj * HALF); b[bj][1] = *(const f32x4*)(bg + cb + bj * HALF + 4); za[bj] = *(const u32x4*)(zp + bj * HALF); }
#pragma unroll
        for (int i = 0; i < 8; ++i) { const int ai = i >> 2, m = i & 3; const size_t rr = (size_t)(ai * HALF + m * 16);
            if (i + 1 < 8) { const size_t rn = (size_t)(((i + 1) >> 2) * HALF + ((i + 1) & 3) * 16) * 512;
#pragma unroll
                for (int bj = 0; bj < 2; ++bj) { if (i & 1) za[bj] = *(const u32x4*)(zp + rn + bj * HALF); else zb[bj] = *(const u32x4*)(zp + rn + bj * HALF); } }
#pragma unroll
            for (int bj = 0; bj < 2; ++bj) { const u32x4 zz = (i & 1) ? zb[bj] : za[bj]; f32x4 o0, o1;
#pragma unroll
                for (int e = 0; e < 4; ++e) { const unsigned w0 = zz[e >> 1], w1 = zz[2 + (e >> 1)];
                    const float z0 = __uint_as_float((e & 1) ? (w0 & 0xffff0000u) : (w0 << 16)), z1 = __uint_as_float((e & 1) ? (w1 & 0xffff0000u) : (w1 << 16));
                    o0[e] = z0 * fsigm(acc[ai][bj][m][0][e] + b[bj][0][e]); o1[e] = z1 * fsigm(acc[ai][bj][m][1][e] + b[bj][1][e]); }
                *(u32x4*)(op + rr * 1024 + bj * HALF) = pack8(o0, o1); } }
    } };
__device__ __forceinline__ float ftanh(float x) { const float e = __builtin_amdgcn_exp2f(-2.88539008178f * fabsf(x)); const float t = (1.0f - e) * __builtin_amdgcn_rcpf(1.0f + e); return x < 0.f ? -t : t; }
struct EpiRk { static constexpr bool PERM = true, AFTER_DRAIN = false; bf16_t* R; size_t rkv_stride; bf16_t* L1;
    __device__ __forceinline__ void operator()(const f32x4 (&acc)[2][2][4][2], const Unit& u, int wr, int wc, int fr, int fq) const {
        const int row0 = u.pm * BM + wr * 64 + fr;
#pragma unroll
        for (int ai = 0; ai < 2; ++ai)
#pragma unroll
            for (int m = 0; m < 4; ++m) { const int row = row0 + ai * HALF + m * 16;
#pragma unroll
                for (int bj = 0; bj < 2; ++bj) { const int c = u.pn * BM + bj * HALF + wc * 32 + 8 * fq;
                    if (c < 3072) { bf16_t* dst = R + (size_t)(c >> 10) * rkv_stride; *(u32x4*)(dst + (size_t)row * 1024 + (c & 1023)) = pack8(acc[ai][bj][m][0], acc[ai][bj][m][1]); }
                    else { const int cc = c - 3072; if (cc < 384) { f32x4 o0 = acc[ai][bj][m][0], o1 = acc[ai][bj][m][1];
                        if (cc < 64) {
#pragma unroll
                            for (int e = 0; e < 4; ++e) { o0[e] = ftanh(o0[e]); o1[e] = ftanh(o1[e]); } }
                        else if (cc >= 128 && cc < 288) {
#pragma unroll
                            for (int e = 0; e < 4; ++e) { o0[e] = fsigm(o0[e]); o1[e] = fsigm(o1[e]); } }
                        else if (cc >= 288) { o0 = (f32x4){0.f, 0.f, 0.f, 0.f}; o1 = o0; }
                        *(u32x4*)(L1 + (size_t)row * 384 + cc) = pack8(o0, o1); } } } }
    } };
struct EpiLora2 { static constexpr bool PERM = true, AFTER_DRAIN = false; bf16_t* WRAW; bf16_t* AS; bf16_t* G; const float* a0;
    __device__ __forceinline__ void operator()(const f32x4 (&acc)[2][2][4][2], const Unit& u, int wr, int wc, int fr, int fq) const {
        const int row0 = u.pm * BM + wr * 64 + fr;
#pragma unroll
        for (int ai = 0; ai < 2; ++ai)
#pragma unroll
            for (int m = 0; m < 4; ++m) { const int row = row0 + ai * HALF + m * 16;
#pragma unroll
                for (int bj = 0; bj < 2; ++bj) { const int c = u.pn * BM + bj * HALF + wc * 32 + 8 * fq;
                    if (c < 1024) *(u32x4*)(WRAW + (size_t)row * 1024 + c) = pack8(acc[ai][bj][m][0], acc[ai][bj][m][1]);
                    else if (c < 2048) { const f32x4 a0v = *(const f32x4*)(a0 + c - 1024), a1v = *(const f32x4*)(a0 + c - 1024 + 4); f32x4 o0, o1;
#pragma unroll
                        for (int e = 0; e < 4; ++e) { o0[e] = fsigm(a0v[e] + acc[ai][bj][m][0][e]); o1[e] = fsigm(a1v[e] + acc[ai][bj][m][1][e]); }
                        *(u32x4*)(AS + (size_t)row * 1024 + c - 1024) = pack8(o0, o1); }
                    else *(u32x4*)(G + (size_t)row * 1024 + c - 2048) = pack8(acc[ai][bj][m][0], acc[ai][bj][m][1]); } }
    } };
struct EpiHloc { static constexpr bool PERM = true, AFTER_DRAIN = false; float* HL;
    __device__ __forceinline__ void operator()(const f32x4 (&acc)[2][2][4][2], const Unit& u, int wr, int wc, int fr, int fq) const {
        const int row0 = u.pm * BM + wr * 64 + fr, c = wc * 32 + 8 * fq;
#pragma unroll
        for (int ai = 0; ai < 2; ++ai)
#pragma unroll
            for (int m = 0; m < 4; ++m) { float* p = HL + (size_t)(row0 + ai * HALF + m * 16) * 128 + c; *(f32x4*)p = acc[ai][0][m][0]; *(f32x4*)(p + 4) = acc[ai][0][m][1]; }
    } };
__device__ __forceinline__ float fgelu(float x) { const float u2 = 1.5957691216057308f * (x + 0.044715f * x * x * x); return x * fsigm(u2); }
struct EpiS5Y { static constexpr bool PERM = true, AFTER_DRAIN = false; bf16_t* Z5;
    __device__ __forceinline__ void operator()(const f32x4 (&acc)[2][2][4][2], const Unit& u, int wr, int wc, int fr, int fq) const {
        const int row0 = u.pm * BM + wr * 64 + fr;
#pragma unroll
        for (int ai = 0; ai < 2; ++ai)
#pragma unroll
            for (int m = 0; m < 4; ++m) { const int row = row0 + ai * HALF + m * 16, g = row >> 10, chunk = row & 1023;
#pragma unroll
                for (int bj = 0; bj < 2; ++bj) { const int c = bj * HALF + wc * 32 + 8 * fq, t = c >> 4, co = c & 15; f32x4 o0, o1;
#pragma unroll
                    for (int e = 0; e < 4; ++e) { o0[e] = fgelu(acc[ai][bj][m][0][e]); o1[e] = fgelu(acc[ai][bj][m][1][e]); }
                    *(u32x4*)(Z5 + (size_t)(chunk * 16 + t) * 512 + g * 16 + co) = pack8(o0, o1); } }
    } };

struct EpiResidS { static constexpr bool PERM = true, AFTER_DRAIN = false; float* SL; const float* gate; float rc; int pad;
    __device__ __forceinline__ void operator()(const f32x4 (&acc)[2][2][4][2], const Unit& u, int wr, int wc, int fr, int fq) const {
        const int r0 = wr * 64 + fr; float* __restrict__ sl = SL + (size_t)(u.ko >> 8) * 128 * 1024;
#pragma unroll
        for (int m = 0; m < 4; ++m) { const int r = r0 + m * 16; const int mr = 8 + r;
#pragma unroll
            for (int bj = 0; bj < 2; ++bj)
#pragma unroll
                for (int n = 0; n < 2; ++n) { const int c = u.pn * BM + bj * HALF + wc * 32 + 8 * fq + 4 * n; const f32x4 g = *(const f32x4*)(gate + (size_t)mr * 9216 + c);
                    *(f32x4*)(sl + (size_t)r * 1024 + c) = (g + 1.0f) * rc * acc[0][bj][m][n]; } }
    } };
enum { EK_SWIGLU = 0, EK_RESID, EK_RESIDS, EK_INPROJ, EK_GLU, EK_RK, EK_LORA2, EK_HLOC, EK_S5Y };
struct EpiAny { static constexpr bool PERM = true, AFTER_DRAIN = false; int kind; void* p0; void* p1; const void* p2; const void* p3; float f0;
    __device__ __forceinline__ void operator()(const f32x4 (&acc)[2][2][4][2], const Unit& u, int wr, int wc, int fr, int fq) const {
        asm volatile("" : "+v"(fr), "+v"(fq));
        switch (kind) {
        case EK_SWIGLU: { EpiSwiglu e{(bf16_t*)p0}; e(acc, u, wr, wc, fr, fq); break; }
        case EK_RESID: { EpiResid e{(const float*)p0, (float*)p1, (const float*)p2, f0, 0}; e(acc, u, wr, wc, fr, fq); break; }
        case EK_RESIDS: { EpiResidS e{(float*)p0, (const float*)p2, f0, 0}; e(acc, u, wr, wc, fr, fq); break; }
        case EK_INPROJ: { EpiInproj e{(bf16_t*)p0, (float*)p1, (bf16_t*)p2}; e(acc, u, wr, wc, fr, fq); break; }
        case EK_GLU: { EpiGlu e{(const bf16_t*)p0, (bf16_t*)p1, (const float*)p2}; e(acc, u, wr, wc, fr, fq); break; }
        case EK_RK: { EpiRk e{(bf16_t*)p0, (size_t)16640 * 1024, (bf16_t*)p1}; e(acc, u, wr, wc, fr, fq); break; }
        case EK_LORA2: { EpiLora2 e{(bf16_t*)p0, (bf16_t*)p1, (bf16_t*)p2, (const float*)p3}; e(acc, u, wr, wc, fr, fq); break; }
        case EK_HLOC: { EpiHloc e{(float*)p0}; e(acc, u, wr, wc, fr, fq); break; }
        default: { EpiS5Y e{(bf16_t*)p0}; e(acc, u, wr, wc, fr, fq); break; }
        }
    } };
struct AnyOrder { StaticOrder so; SplitOrder sp; int split;
    __device__ __forceinline__ bool next(int i, Unit& u) const { return split ? sp.next(i, u) : so.next(i, u); }
    __device__ __forceinline__ void a_ready(const Unit&) const {}
    __device__ __forceinline__ void done(const Unit&) const {} };
template <class Epi, class Sched, bool ALIGN_EPI = false, bool SP2 = false>
__device__ __forceinline__ void gemm_phase(PG8_LAS unsigned char* lds, const GemmX g, const Sched& S, const Epi& E) {
    int tid_ = threadIdx.x; asm volatile("" : "+v"(tid_));
    const int tid = tid_, wid = __builtin_amdgcn_readfirstlane(tid >> 6), lane = tid & 63, wr = wid >> 2, wc = wid & 3, fr = lane & 15, fq = lane >> 4;
    int K_ = g.K; asm volatile("" : "+s"(K_));
    const int K = K_, nt = K / BK;
    int lda_ = g.lda, ldb_ = g.ldb; asm volatile("" : "+s"(lda_), "+s"(ldb_)); const int lda = lda_, ldb = ldb_, gsh = g.gsh, nNb = g.N / BM;
    unsigned voffA[2], voffB[2];
#pragma unroll
    for (int i = 0; i < 2; ++i) { int R, C; stage_rc(tid * 16 + i * 8192, R, C); const int Rb = Epi::PERM ? ((R & ~31) + perm32(R & 31)) : R;
        voffA[i] = (unsigned)(R * lda + C) * 2u; voffB[i] = (unsigned)(Rb * ldb + C) * 2u; }
    const size_t kstep = (size_t)(BK * 2);
    const size_t hstepA = (size_t)HALF * lda * 2, hstepB = (size_t)HALF * ldb * 2;
    const size_t tstepA = 2 * hstepA, tstepB = 2 * hstepB;
#define PG8_BTILE(u_) ((size_t)(gsh >= 0 ? ((u_).pm >> gsh) * nNb + (u_).pn : (u_).pn))
    const unsigned ldsw = (unsigned)wid * 1024u;
    const int aoff = lds_byte(wr * 64 + fr, fq * 8), boff = lds_byte(wc * 32 + fr, fq * 8);
#define PG8_SA(b, h) (((b) * 2 + (h)) * HTB)
#define PG8_SB(b, h) ((4 + (b) * 2 + (h)) * HTB)
#define PG8_STAGE(bufoff, gbase, voff) do { _Pragma("unroll") for (int _i = 0; _i < 2; ++_i) \
        __builtin_amdgcn_global_load_lds((const unsigned*)((const char*)(gbase) + (voff)[_i]), (PG8_LAS unsigned*)(lds + (bufoff) + ldsw + _i * 8192), 16, 0, 0); } while (0)
#define PG8_LDA(dst, b, h) do { _Pragma("unroll") for (int m = 0; m < 4; ++m) _Pragma("unroll") for (int k = 0; k < 2; ++k) dst[m][k] = *(const PG8_LAS bf16x8*)(lds + PG8_SA(b, h) + aoff + m * 2048 + k * 1024); } while (0)
#define PG8_LDB(dst, b, h) do { _Pragma("unroll") for (int n = 0; n < 2; ++n) _Pragma("unroll") for (int k = 0; k < 2; ++k) dst[n][k] = *(const PG8_LAS bf16x8*)(lds + PG8_SB(b, h) + boff + n * 2048 + k * 1024); } while (0)
#define PG8_MMA(ai, bj, At, Bt) do { __builtin_amdgcn_s_setprio(1); _Pragma("unroll") for (int m = 0; m < 4; ++m) _Pragma("unroll") for (int n = 0; n < 2; ++n) _Pragma("unroll") for (int k = 0; k < 2; ++k) \
        acc[ai][bj][m][n] = __builtin_amdgcn_mfma_f32_16x16x32_bf16(Bt[n][k], At[m][k], acc[ai][bj][m][n], 0, 0, 0); __builtin_amdgcn_s_setprio(0); } while (0)
#define PG8_WAIT_V(n) asm volatile("s_waitcnt vmcnt(" #n ")" ::: "memory")
#define PG8_WAIT_L(n) asm volatile("s_waitcnt lgkmcnt(" #n ")" ::: "memory")
#define PG8_BAR __builtin_amdgcn_s_barrier()
#define PG8_SCHED __builtin_amdgcn_sched_barrier(0)
    Unit cur, nxt; int ui = 0;
    if (!S.next(0, cur)) return;
    f32x4 acc[2][2][4][2];
#pragma unroll
    for (int a = 0; a < 2; ++a)
#pragma unroll
        for (int b = 0; b < 2; ++b)
#pragma unroll
            for (int m = 0; m < 4; ++m)
#pragma unroll
                for (int n = 0; n < 2; ++n) acc[a][b][m][n] = (f32x4){0.f, 0.f, 0.f, 0.f};
    bf16x8 At[4][2], B0[2][2], B1[2][2];
    const char* cA = (const char*)g.A + (size_t)cur.pm * tstepA + (size_t)cur.ko * 2; const char* cB = (const char*)g.Bt + PG8_BTILE(cur) * tstepB + (size_t)cur.ko * 2;
    S.a_ready(cur);
    if constexpr (SP2) {
        PG8_STAGE(PG8_SB(0, 0), cB, voffB); PG8_STAGE(PG8_SB(0, 1), cB + hstepB, voffB); PG8_STAGE(PG8_SA(0, 0), cA, voffA); PG8_STAGE(PG8_SA(0, 1), cA + hstepA, voffA);
        if (wr == 1) PG8_BAR;
        PG8_WAIT_V(2); PG8_BAR;
        PG8_STAGE(PG8_SB(1, 0), cB + kstep, voffB); PG8_STAGE(PG8_SA(1, 0), cA + kstep, voffA); PG8_STAGE(PG8_SB(1, 1), cB + hstepB + kstep, voffB);
        PG8_WAIT_V(6); PG8_BAR;
    } else {
        PG8_STAGE(PG8_SB(0, 0), cB, voffB); PG8_STAGE(PG8_SA(0, 0), cA, voffA); PG8_STAGE(PG8_SB(0, 1), cB + hstepB, voffB); PG8_STAGE(PG8_SA(0, 1), cA + hstepA, voffA);
        if (wr == 1) PG8_BAR;
        PG8_WAIT_V(4); PG8_BAR;
        PG8_STAGE(PG8_SB(1, 0), cB + kstep, voffB); PG8_STAGE(PG8_SA(1, 0), cA + kstep, voffA); PG8_STAGE(PG8_SB(1, 1), cB + hstepB + kstep, voffB);
        PG8_WAIT_V(6); PG8_BAR;
    }
    for (;;) {
        const bool has_next = S.next(ui + 1, nxt);
        const char* nA = has_next ? (const char*)g.A + (size_t)nxt.pm * tstepA + (size_t)nxt.ko * 2 : cA; const char* nB = has_next ? (const char*)g.Bt + PG8_BTILE(nxt) * tstepB + (size_t)nxt.ko * 2 : cB;
        for (int t = 0; t < nt; t += 2) {
            const bool last = (t == nt - 2);
            const char* a1 = cA + (size_t)(t + 1) * kstep;
            const char* a2 = last ? nA : cA + (size_t)(t + 2) * kstep; const char* b2 = last ? nB : cB + (size_t)(t + 2) * kstep;
            const char* a3 = a2 + kstep; const char* b3 = b2 + kstep;
            if (last && has_next) S.a_ready(nxt);
            if constexpr (SP2) {
            PG8_LDB(B0, 0, 0); PG8_LDB(B1, 0, 1); PG8_SCHED; PG8_LDA(At, 0, 0); PG8_STAGE(PG8_SA(1, 1), a1 + hstepA, voffA);
            PG8_WAIT_V(8); PG8_WAIT_L(0); PG8_BAR; PG8_MMA(0, 0, At, B0); PG8_MMA(0, 1, At, B1); PG8_BAR; PG8_SCHED;
            PG8_LDA(At, 0, 1); PG8_STAGE(PG8_SB(0, 0), b2, voffB); PG8_STAGE(PG8_SB(0, 1), b2 + hstepB, voffB); PG8_STAGE(PG8_SA(0, 0), a2, voffA);
            PG8_WAIT_V(8); PG8_WAIT_L(0); PG8_BAR; PG8_MMA(1, 0, At, B0); PG8_MMA(1, 1, At, B1); PG8_BAR; PG8_SCHED;
            PG8_LDB(B0, 1, 0); PG8_LDB(B1, 1, 1); PG8_SCHED; PG8_LDA(At, 1, 0); PG8_STAGE(PG8_SA(0, 1), a2 + hstepA, voffA);
            PG8_WAIT_V(8); PG8_WAIT_L(0); PG8_BAR; PG8_MMA(0, 0, At, B0); PG8_MMA(0, 1, At, B1); PG8_BAR; PG8_SCHED;
            PG8_LDA(At, 1, 1); PG8_STAGE(PG8_SB(1, 0), b3, voffB); PG8_STAGE(PG8_SB(1, 1), b3 + hstepB, voffB); PG8_STAGE(PG8_SA(1, 0), a3, voffA);
            PG8_WAIT_V(8); PG8_WAIT_L(0); PG8_BAR; PG8_MMA(1, 0, At, B0); PG8_MMA(1, 1, At, B1); PG8_BAR; PG8_SCHED;
            } else {
            PG8_LDB(B0, 0, 0); PG8_SCHED; PG8_LDA(At, 0, 0); PG8_STAGE(PG8_SA(1, 1), a1 + hstepA, voffA);
            PG8_WAIT_L(8); PG8_BAR; PG8_WAIT_L(0); PG8_MMA(0, 0, At, B0); PG8_BAR; PG8_SCHED;
            PG8_LDB(B1, 0, 1); PG8_STAGE(PG8_SB(0, 0), b2, voffB);
            PG8_BAR; PG8_WAIT_L(0); PG8_MMA(0, 1, At, B1); PG8_BAR;
            PG8_LDA(At, 0, 1); PG8_STAGE(PG8_SA(0, 0), a2, voffA);
            PG8_BAR; PG8_WAIT_L(0); PG8_MMA(1, 0, At, B0); PG8_BAR; PG8_SCHED;
            PG8_STAGE(PG8_SB(0, 1), b2 + hstepB, voffB);
            PG8_WAIT_V(6); PG8_BAR; PG8_MMA(1, 1, At, B1); PG8_BAR;
            PG8_LDB(B0, 1, 0); PG8_SCHED; PG8_LDA(At, 1, 0); PG8_STAGE(PG8_SA(0, 1), a2 + hstepA, voffA);
            PG8_WAIT_L(8); PG8_BAR; PG8_WAIT_L(0); PG8_MMA(0, 0, At, B0); PG8_BAR; PG8_SCHED;
            PG8_LDB(B1, 1, 1); PG8_STAGE(PG8_SB(1, 0), b3, voffB);
            PG8_BAR; PG8_WAIT_L(0); PG8_MMA(0, 1, At, B1); PG8_BAR;
            PG8_LDA(At, 1, 1); PG8_STAGE(PG8_SA(1, 0), a3, voffA);
            PG8_BAR; PG8_WAIT_L(0); PG8_MMA(1, 0, At, B0); PG8_BAR; PG8_SCHED;
            PG8_STAGE(PG8_SB(1, 1), b3 + hstepB, voffB);
            PG8_WAIT_V(6); PG8_BAR; PG8_MMA(1, 1, At, B1); PG8_BAR;
            }
        }
        if constexpr (ALIGN_EPI) { if (wr == 0) PG8_BAR; }
        if constexpr (!Epi::AFTER_DRAIN) { E(acc, cur, wr, wc, fr, fq); S.done(cur); }
        if (!has_next) break;
#pragma unroll
        for (int a = 0; a < 2; ++a)
#pragma unroll
            for (int b = 0; b < 2; ++b)
#pragma unroll
                for (int m = 0; m < 4; ++m)
#pragma unroll
                    for (int n = 0; n < 2; ++n) acc[a][b][m][n] = (f32x4){0.f, 0.f, 0.f, 0.f};
        cur = nxt; cA = nA; cB = nB; ++ui;
        if constexpr (ALIGN_EPI) { if (wr == 1) PG8_BAR; }
    }
    PG8_WAIT_V(0);
    if constexpr (!ALIGN_EPI) { if (wr == 0) PG8_BAR; }
    PG8_BAR;
    if constexpr (Epi::AFTER_DRAIN) { E.fused(acc, cur, wr, wc, fr, fq, lds, wid, lane); S.done(cur); }
#undef PG8_BTILE
#undef PG8_SA
#undef PG8_SB
#undef PG8_STAGE
#undef PG8_LDA
#undef PG8_LDB
#undef PG8_MMA
#undef PG8_WAIT_V
#undef PG8_WAIT_L
#undef PG8_BAR
#undef PG8_SCHED
}
}

constexpr int NWAVES = 8;
constexpr int RING_OFF = 0, RING_BYTES = 131072;
constexpr int LDSCTL_OFF = RING_BYTES, MISC_OFF = LDSCTL_OFF + 320;
constexpr int LDS_BYTES = 147456;

struct Args { const float* in[52]; float* out; unsigned char* ws; };
static_assert(sizeof(Args) == 432, "kernarg layout");

struct Frame {
    LAS unsigned char* lds; int tid, lane, wave, G, blk;
    const float* const* in; float* out; unsigned char* ws;
};
#define INP(i) INPD(i)
#define KARG() ({ const unsigned char __attribute__((address_space(4)))* k_ = (const unsigned char __attribute__((address_space(4)))*)__builtin_amdgcn_kernarg_segment_ptr(); asm volatile("" : "+s"(k_)); k_; })
#define INPD(i) (*(const float* const __attribute__((address_space(4)))*)(KARG() + 8 * (i)))

template <class Src>
DEVI void cvt_item(const Src src, bf16* WT, int Kd, int nblk, LAS float* scr, int item, int lane) {
    const int kb = item / nblk, nb = item % nblk, k0 = 64 * kb, n0 = 32 * nb;
    const int kr = lane >> 3, nq = (lane & 7) * 4;
    f32x4 v[8];
#pragma unroll
    for (int i = 0; i < 8; ++i) v[i] = src.load4(k0 + 8 * i + kr, n0 + nq);
#pragma unroll
    for (int i = 0; i < 8; ++i) { LAS float* s = scr + (8 * i + kr) * 33 + nq; s[0] = v[i][0]; s[1] = v[i][1]; s[2] = v[i][2]; s[3] = v[i][3]; }
    LDS_WAIT(); asm volatile("" ::: "memory");
    const int c = lane & 7;
#pragma unroll
    for (int j = 0; j < 4; ++j) { const int n = (lane >> 3) + 8 * j; const LAS float* s = scr + (8 * c) * 33 + n;
        v4u o; o.x = pk2(s[0 * 33], s[1 * 33]); o.y = pk2(s[2 * 33], s[3 * 33]); o.z = pk2(s[4 * 33], s[5 * 33]); o.w = pk2(s[6 * 33], s[7 * 33]);
        *(GAS v4u*)(WT + (size_t)(n0 + n) * Kd + k0 + 8 * c) = o; }
    LDS_WAIT(); asm volatile("" ::: "memory");
}
struct SrcPlain { const float* W; int K, N, ld; DEVI f32x4 load4(int k, int n) const { return (k < K && n < N) ? *(const f32x4*)(W + (size_t)k * ld + n) : (f32x4){0.f, 0.f, 0.f, 0.f}; } };
struct SrcFold { const float* W; const float* mu; int ld; DEVI f32x4 load4(int k, int n) const { const int kk = k & 1023; const float m = mu[kk]; return *(const f32x4*)(W + (size_t)kk * ld + n) * (k < 1024 ? m : (1.0f - m)); } };
struct SrcBlk { const float* W; int k0, k1; DEVI f32x4 load4(int k, int n) const { return (k >= k0 && k < k1) ? *(const f32x4*)(W + (size_t)(k - k0) * 1024 + n) : (f32x4){0.f, 0.f, 0.f, 0.f}; } };
struct SrcZero { DEVI f32x4 load4(int, int) const { return (f32x4){0.f, 0.f, 0.f, 0.f}; } };

DEVI void sincos_d(double x, double& s, double& c) {
    const double n = rint(x * 0.63661977236758134308);
    double r = fma(-n, 1.57079632679489655800e+00, x); r = fma(-n, 6.12323399573676603587e-17, r);
    const double r2 = r * r;
    double sp = -7.6471637318198164759e-13; sp = fma(sp, r2, 1.6059043836821614599e-10); sp = fma(sp, r2, -2.5052108385441718775e-08); sp = fma(sp, r2, 2.7557319223985890653e-06);
    sp = fma(sp, r2, -1.9841269841269841270e-04); sp = fma(sp, r2, 8.3333333333333333333e-03); sp = fma(sp, r2, -1.6666666666666666667e-01); const double sr = fma(sp * r2, r, r);
    double cp = 4.7794773323873852974e-14; cp = fma(cp, r2, -1.1470745597729724714e-11); cp = fma(cp, r2, 2.0876756987868098979e-09); cp = fma(cp, r2, -2.7557319223985890653e-07);
    cp = fma(cp, r2, 2.4801587301587301587e-05); cp = fma(cp, r2, -1.3888888888888888889e-03); cp = fma(cp, r2, 4.1666666666666666667e-02); cp = fma(cp, r2, -0.5); const double cr = fma(cp, r2, 1.0);
    const int q = ((int)n) & 3;
    s = (q == 0) ? sr : (q == 1) ? cr : (q == 2) ? -sr : -cr;
    c = (q == 0) ? cr : (q == 1) ? -sr : (q == 2) ? -cr : sr;
}
DEVI void s5prep_one(int i, const float* a_re, const float* a_im, const float* log_step, const float* b_re, const float* b_im, float* sp) {
    const int g = i >> 6;
    const double dt = exp((double)log_step[g]), ar = a_re[i], ai = a_im[i];
    const double mag = exp(ar * dt); double s, c; sincos_d(ai * dt, s, c);
    const double abr = mag * c, abi = mag * s, den = ar * ar + ai * ai, nr = abr - 1.0;
    const double zr = (nr * ar + abi * ai) / den, zi = (abi * ar - nr * ai) / den;
    sp[i] = (float)abr; sp[2048 + i] = (float)abi;
    for (int cc = 0; cc < 16; ++cc) { const double br = b_re[i * 16 + cc], bi = b_im[i * 16 + cc];
        sp[4096 + i * 16 + cc] = (float)(zr * br - zi * bi); sp[4096 + 32768 + i * 16 + cc] = (float)(zr * bi + zi * br); }
}


constexpr int SP_PW = 4096 + 65536;
DEVI void s5prep_pw(int i, int tau, const float* a_re, const float* a_im, const float* log_step, float* sp) {
    const int g = i >> 6; const double dt = exp((double)log_step[g]), ar = a_re[i], ai = a_im[i];
    const double mag = exp(ar * dt * tau); double s, c; sincos_d(ai * dt * tau, s, c); sp[SP_PW + i * 34 + tau * 2] = (float)(mag * c); sp[SP_PW + i * 34 + tau * 2 + 1] = (float)(mag * s);
}
DEVI void s5_tm_job(int g, int tau, int lane, const float* sp, const float* c_re, const float* c_im, const float* dd, bf16* TM) {
    bf16* tm = TM + (size_t)g * 256 * 384;
    if (tau <= 15) {
        const int co = lane >> 2, ci0 = (lane & 3) * 4; float kv[4] = {0.f, 0.f, 0.f, 0.f};
#pragma unroll 8
        for (int p = 0; p < 64; ++p) { const float pr = sp[SP_PW + (g * 64 + p) * 34 + tau * 2], pi = sp[SP_PW + (g * 64 + p) * 34 + tau * 2 + 1];
            const float cr = c_re[(g * 16 + co) * 64 + p], ci = c_im[(g * 16 + co) * 64 + p];
            const f32x4 br = *(const f32x4*)(sp + 4096 + (g * 64 + p) * 16 + ci0), bi = *(const f32x4*)(sp + 4096 + 32768 + (g * 64 + p) * 16 + ci0);
#pragma unroll
            for (int q = 0; q < 4; ++q) { const float wr = pr * br[q] - pi * bi[q], wi = pr * bi[q] + pi * br[q]; kv[q] += cr * wr - ci * wi; } }
        if (tau == 0) {
#pragma unroll
            for (int q = 0; q < 4; ++q) if (ci0 + q == co) kv[q] += dd[g * 16 + co]; }
        const unsigned long long pk = (unsigned long long)pk2(kv[0], kv[1]) | ((unsigned long long)pk2(kv[2], kv[3]) << 32);
        for (int t = tau; t < 16; ++t) *(unsigned long long*)(tm + (size_t)(t * 16 + co) * 384 + (t - tau) * 16 + ci0) = pk;
        if (tau >= 1) for (int t = 0; t + tau < 16; ++t) *(unsigned long long*)(tm + (size_t)(t * 16 + co) * 384 + (t + tau) * 16 + ci0) = 0ull;
    }
    if (tau >= 1) { const int t = tau - 1, p = lane; const float pr = sp[SP_PW + (g * 64 + p) * 34 + tau * 2], pi = sp[SP_PW + (g * 64 + p) * 34 + tau * 2 + 1];
#pragma unroll
        for (int co = 0; co < 16; ++co) { const float cr = c_re[(g * 16 + co) * 64 + p], ci = c_im[(g * 16 + co) * 64 + p];
            tm[(size_t)(t * 16 + co) * 384 + 256 + p] = (bf16)f2bf(cr * pr - ci * pi); tm[(size_t)(t * 16 + co) * 384 + 320 + p] = (bf16)f2bf(-(cr * pi + ci * pr)); } }
}
DEVI void s5_hm_job(int g, int s, int lane, const float* sp, bf16* HM) {
    const int p = lane; const float pr = sp[SP_PW + (g * 64 + p) * 34 + (15 - s) * 2], pi = sp[SP_PW + (g * 64 + p) * 34 + (15 - s) * 2 + 1];
    bf16* hr = HM + ((size_t)g * 256 + p) * 256 + s * 16; bf16* hi = hr + 64 * 256;
#pragma unroll
    for (int h8 = 0; h8 < 2; ++h8) { float wr[8], wi[8];
#pragma unroll
        for (int q = 0; q < 8; ++q) { const float br = sp[4096 + (g * 64 + p) * 16 + h8 * 8 + q], bi = sp[4096 + 32768 + (g * 64 + p) * 16 + h8 * 8 + q]; wr[q] = pr * br - pi * bi; wi[q] = pr * bi + pi * br; }
        v4u a, b; a.x = pk2(wr[0], wr[1]); a.y = pk2(wr[2], wr[3]); a.z = pk2(wr[4], wr[5]); a.w = pk2(wr[6], wr[7]); b.x = pk2(wi[0], wi[1]); b.y = pk2(wi[2], wi[3]); b.z = pk2(wi[4], wi[5]); b.w = pk2(wi[6], wi[7]);
        *(v4u*)(hr + h8 * 8) = a; *(v4u*)(hi + h8 * 8) = b; }
}
DEVI void s5_carry_job(int b, int g, int lane, const float* sp, const float* HL, bf16* UB, float* ore, float* oim) {
    const int p = lane; const float ar = sp[SP_PW + (g * 64 + p) * 34 + 32], ai = sp[SP_PW + (g * 64 + p) * 34 + 33];
    float cr = 0.f, ci = 0.f;
#pragma unroll 8
    for (int n = 0; n < 128; ++n) { const size_t row = (size_t)g * 1024 + b * 128 + n;
        UB[row * 384 + 256 + p] = (bf16)f2bf(cr); UB[row * 384 + 320 + p] = (bf16)f2bf(ci);
        const float hr = HL[row * 128 + p], hi = HL[row * 128 + 64 + p];
        const float nr = ar * cr - ai * ci + hr, ni = ar * ci + ai * cr + hi; cr = nr; ci = ni; }
    ore[((size_t)b * 32 + g) * 64 + p] = cr; oim[((size_t)b * 32 + g) * 64 + p] = ci;
}


template <int NT> DEVI void mods_half(int m0, int l, int n0, int lane, const float* __restrict__ ST, const float* __restrict__ ada_w, const float* __restrict__ ada_b, float* MODS) {
    const int i16 = lane & 15, kq = lane >> 4;
    f32x4 acc[NT];
#pragma unroll
    for (int m = 0; m < NT; ++m) acc[m] = (f32x4){0.f, 0.f, 0.f, 0.f};
    const float* w = ada_w + (size_t)l * 1024 * 9216 + (size_t)kq * 9216 + n0 + i16; const float* st = ST + kq * 144 + i16 + m0 * 16;
    float a[4][NT], bv[4];
#pragma unroll
    for (int s = 0; s < 4; ++s) { bv[s] = w[(size_t)(4 * s) * 9216];
#pragma unroll
        for (int m = 0; m < NT; ++m) a[s][m] = st[(4 * s) * 144 + m * 16]; }
    for (int k0 = 0; k0 < 1024; k0 += 16) {
#pragma unroll
        for (int s = 0; s < 4; ++s) {
#pragma unroll
            for (int m = 0; m < NT; ++m) acc[m] = __builtin_amdgcn_mfma_f32_16x16x4f32(a[s][m], bv[s], acc[m], 0, 0, 0);
            const int kn = k0 + 16 + 4 * s; if (kn < 1024) { bv[s] = w[(size_t)kn * 9216];
#pragma unroll
                for (int m = 0; m < NT; ++m) a[s][m] = st[kn * 144 + m * 16]; } } }
    const float bb = ada_b[l * 9216 + n0 + i16];
#pragma unroll
    for (int m = 0; m < NT; ++m)
#pragma unroll
        for (int q = 0; q < 4; ++q) { const int r = (m0 + m) * 16 + kq * 4 + q; if (r < NMODROW) MODS[((size_t)l * NMODROW + r) * 9216 + n0 + i16] = acc[m][q] + bb; }
}
DEVI void mods_job(int job, int lane, const float* __restrict__ ST, const float* __restrict__ ada_w, const float* __restrict__ ada_b, float* MODS) {
    asm volatile("" : "+v"(lane));
    const int mh = job & 1, jb = job >> 1, l = jb / 576, n0 = (jb % 576) * 16;
    if (mh) mods_half<4>(5, l, n0, lane, ST, ada_w, ada_b, MODS); else mods_half<5>(0, l, n0, lane, ST, ada_w, ada_b, MODS);
}

DEVI void mods_job3(int cg, int rs, int lane, const float* __restrict__ ST, const float* __restrict__ ada_w, const float* __restrict__ ada_b, float* MODS) {
    asm volatile("" : "+v"(lane));
    const int l = cg / 144, n0 = (cg % 144) * 64, i16 = lane & 15, kq = lane >> 4;
    f32x4 acc[3][4];
#pragma unroll
    for (int m = 0; m < 3; ++m)
#pragma unroll
        for (int c = 0; c < 4; ++c) acc[m][c] = (f32x4){0.f, 0.f, 0.f, 0.f};
    const float* w = ada_w + (size_t)l * 1024 * 9216 + (size_t)kq * 9216 + n0 + 4 * i16; const float* st = ST + kq * 144 + rs * 48 + i16;
    constexpr int DEP = 8;
    f32x4 bv[DEP]; float a[DEP][3];
#define MODS_LD(s, kn) do { const float* wp_ = w + (size_t)(kn) * 9216; const float* sp_ = st + (kn) * 144; \
        asm volatile("global_load_dwordx4 %0, %1, off" : "=v"(bv[s]) : "v"(wp_) : "memory"); \
        asm volatile("global_load_dword %0, %1, off" : "=v"(a[s][0]) : "v"(sp_) : "memory"); \
        asm volatile("global_load_dword %0, %1, off offset:64" : "=v"(a[s][1]) : "v"(sp_) : "memory"); \
        asm volatile("global_load_dword %0, %1, off offset:128" : "=v"(a[s][2]) : "v"(sp_) : "memory"); } while (0)
#define MODS_MM(s) do { _Pragma("unroll") for (int m = 0; m < 3; ++m) _Pragma("unroll") for (int c = 0; c < 4; ++c) acc[m][c] = __builtin_amdgcn_mfma_f32_16x16x4f32(a[s][m], bv[s][c], acc[m][c], 0, 0, 0); } while (0)
#define MODS_WAIT(s, n) asm volatile("s_waitcnt vmcnt(" #n ")" : "+v"(bv[s]), "+v"(a[s][0]), "+v"(a[s][1]), "+v"(a[s][2]) :: "memory")
#pragma unroll
    for (int s = 0; s < DEP; ++s) MODS_LD(s, 4 * s);
    for (int k0 = 0; k0 < 1024 - 4 * DEP; k0 += 4 * DEP) {
#pragma unroll
        for (int s = 0; s < DEP; ++s) { MODS_WAIT(s, 28); MODS_MM(s); MODS_LD(s, k0 + 4 * DEP + 4 * s); } }
    MODS_WAIT(0, 28); MODS_MM(0); MODS_WAIT(1, 24); MODS_MM(1); MODS_WAIT(2, 20); MODS_MM(2); MODS_WAIT(3, 16); MODS_MM(3);
    MODS_WAIT(4, 12); MODS_MM(4); MODS_WAIT(5, 8); MODS_MM(5); MODS_WAIT(6, 4); MODS_MM(6); MODS_WAIT(7, 0); MODS_MM(7);
#undef MODS_LD
#undef MODS_MM
#undef MODS_WAIT
    const f32x4 bb = *(const f32x4*)(ada_b + l * 9216 + n0 + 4 * i16);
#pragma unroll
    for (int m = 0; m < 3; ++m)
#pragma unroll
        for (int q = 0; q < 4; ++q) { const int r = (rs * 3 + m) * 16 + kq * 4 + q;
            if (r < NMODROW) *(f32x4*)(MODS + ((size_t)l * NMODROW + r) * 9216 + n0 + 4 * i16) = (f32x4){acc[m][0][q] + bb[0], acc[m][1][q] + bb[1], acc[m][2][q] + bb[2], acc[m][3][q] + bb[3]}; }
}

DEVI void init_row(int row, int lane, const float* xp, const float* xs, const float* mods, float* X, bf16* H, float* ZS) {
    if (row >= MT) { for (int j = 0; j < 16; ++j) H[(size_t)row * D + j * 64 + lane] = 0; return; }
    const float* src = row < NP ? xp + (size_t)row * D : xs + (size_t)(row - NP) * D;
    const float* sh = modp(mods, 0, 0) + (size_t)mrow(row) * 9216; const float* sc = modp(mods, 0, 1) + (size_t)mrow(row) * 9216;
#pragma unroll
    for (int j = 0; j < 4; ++j) { const int c = j * 256 + lane * 4; const f32x4 v = *(const f32x4*)(src + c), a = *(const f32x4*)(sc + c), b = *(const f32x4*)(sh + c);
        if (row >= NP) *(f32x4*)(ZS + (size_t)(row - NP) * D + c) = v * ALPHA; const f32x4 h = v * (a + 1.0f) + b;
        *(unsigned long long*)(H + (size_t)row * D + c) = (unsigned long long)pk2(h[0], h[1]) | ((unsigned long long)pk2(h[2], h[3]) << 32); }
}
template <int NR> DEVI void init_rows(int row0, int stride, int lane, const float* xp, const float* mods, bf16* H) {
    f32x4 v[NR][4];
#pragma unroll
    for (int i = 0; i < NR; ++i)
#pragma unroll
        for (int j = 0; j < 4; ++j) v[i][j] = *(const f32x4*)(xp + (size_t)(row0 + i * stride) * D + j * 256 + lane * 4);
#pragma unroll
    for (int i = 0; i < NR; ++i) { const int row = row0 + i * stride; const float* sh = modp(mods, 0, 0) + (size_t)mrow(row) * 9216; const float* sc = modp(mods, 0, 1) + (size_t)mrow(row) * 9216;
#pragma unroll
        for (int j = 0; j < 4; ++j) { const int c = j * 256 + lane * 4; const f32x4 h = v[i][j] * (*(const f32x4*)(sc + c) + 1.0f) + *(const f32x4*)(sh + c);
            *(unsigned long long*)(H + (size_t)row * D + c) = (unsigned long long)pk2(h[0], h[1]) | ((unsigned long long)pk2(h[2], h[3]) << 32); } }
}
DEVI void ln_row(int row, int lane, const float* Z, float* ZS, const float* SL, int nsl, const float* g, const float* b, float* X, bf16* H, const float* sh, const float* sc) {
    const float* z = row < NP ? Z + (size_t)row * D : ZS + (size_t)(row - NP) * D; f32x4 v[4]; float s = 0.f;
#pragma unroll
    for (int j = 0; j < 4; ++j) v[j] = *(const f32x4*)(z + j * 256 + lane * 4);
    if (row >= NP) for (int q = 0; q < nsl; ++q) {
#pragma unroll
        for (int j = 0; j < 4; ++j) v[j] = v[j] + *(const f32x4*)(SL + ((size_t)q * 128 + (row - NP)) * D + j * 256 + lane * 4); }
#pragma unroll
    for (int j = 0; j < 4; ++j) s += (v[j][0] + v[j][1]) + (v[j][2] + v[j][3]);
    const float mean = wave_sum(s) * (1.f / D); float q = 0.f;
#pragma unroll
    for (int j = 0; j < 4; ++j) { v[j] = v[j] - mean; q += (v[j][0] * v[j][0] + v[j][1] * v[j][1]) + (v[j][2] * v[j][2] + v[j][3] * v[j][3]); }
    const float rstd = rsqrtf(wave_sum(q) * (1.f / D) + 1e-5f);
    const int mr = mrow(row);
#pragma unroll
    for (int j = 0; j < 4; ++j) { const int c = j * 256 + lane * 4; const f32x4 x = v[j] * rstd * *(const f32x4*)(g + c) + *(const f32x4*)(b + c); *(f32x4*)(X + (size_t)row * D + c) = x; if (row >= NP) *(f32x4*)(ZS + (size_t)(row - NP) * D + c) = x * ALPHA;
        if (H) { const f32x4 h = x * (*(const f32x4*)(sc + (size_t)mr * 9216 + c) + 1.0f) + *(const f32x4*)(sh + (size_t)mr * 9216 + c);
            *(unsigned long long*)(H + (size_t)row * D + c) = (unsigned long long)pk2(h[0], h[1]) | ((unsigned long long)pk2(h[2], h[3]) << 32); } }
}
template <int NR> DEVI void ln_rows(int row0, int stride, int lane, const float* Z, const float* g, const float* b, float* X, bf16* H, const float* sh, const float* sc) {
    f32x4 v[NR][4]; float rstd[NR];
#pragma unroll
    for (int i = 0; i < NR; ++i)
#pragma unroll
        for (int j = 0; j < 4; ++j) v[i][j] = *(const f32x4*)(Z + (size_t)(row0 + i * stride) * D + j * 256 + lane * 4);
    f32x4 gg[4], bb[4];
#pragma unroll
    for (int j = 0; j < 4; ++j) { gg[j] = *(const f32x4*)(g + j * 256 + lane * 4); bb[j] = *(const f32x4*)(b + j * 256 + lane * 4); }
#pragma unroll
    for (int i = 0; i < NR; ++i) { float s = 0.f;
#pragma unroll
        for (int j = 0; j < 4; ++j) s += (v[i][j][0] + v[i][j][1]) + (v[i][j][2] + v[i][j][3]);
        const float mean = wave_sum(s) * (1.f / D); float q = 0.f;
#pragma unroll
        for (int j = 0; j < 4; ++j) { v[i][j] = v[i][j] - mean; q += (v[i][j][0] * v[i][j][0] + v[i][j][1] * v[i][j][1]) + (v[i][j][2] * v[i][j][2] + v[i][j][3] * v[i][j][3]); }
        rstd[i] = rsqrtf(wave_sum(q) * (1.f / D) + 1e-5f); }
#pragma unroll
    for (int i = 0; i < NR; ++i) { const int row = row0 + i * stride, mr = mrow(row);
#pragma unroll
        for (int j = 0; j < 4; ++j) { const int c = j * 256 + lane * 4; const f32x4 x = v[i][j] * rstd[i] * gg[j] + bb[j]; *(f32x4*)(X + (size_t)row * D + c) = x;
            if (H) { const f32x4 h = x * (*(const f32x4*)(sc + (size_t)mr * 9216 + c) + 1.0f) + *(const f32x4*)(sh + (size_t)mr * 9216 + c);
                *(unsigned long long*)(H + (size_t)row * D + c) = (unsigned long long)pk2(h[0], h[1]) | ((unsigned long long)pk2(h[2], h[3]) << 32); } } }
}
DEVI void ln_shift_rows(int row0, int n, int lane, const float* Z, float* ZS, const float* g, const float* b, float* X, const float* mods, const float* shift_in, bf16* A2, float* out) {
    f32x4 prev[4], gg[4], bb[4];
#pragma unroll
    for (int j = 0; j < 4; ++j) { gg[j] = *(const f32x4*)(g + j * 256 + lane * 4); bb[j] = *(const f32x4*)(b + j * 256 + lane * 4); prev[j] = (f32x4){0.f, 0.f, 0.f, 0.f}; }
    for (int r = ((row0 < NP && (row0 & 2047) != 0) ? row0 - 1 : row0); r < row0 + n; ++r) {
        const bool warm = r < row0;
        const float* z = r < NP ? Z + (size_t)r * D : ZS + (size_t)(r - NP) * D; f32x4 v[4]; float s = 0.f;
#pragma unroll
        for (int j = 0; j < 4; ++j) { v[j] = *(const f32x4*)(z + j * 256 + lane * 4); s += (v[j][0] + v[j][1]) + (v[j][2] + v[j][3]); }
        const float mean = wave_sum(s) * (1.f / D); float q = 0.f;
#pragma unroll
        for (int j = 0; j < 4; ++j) { v[j] = v[j] - mean; q += (v[j][0] * v[j][0] + v[j][1] * v[j][1]) + (v[j][2] * v[j][2] + v[j][3] * v[j][3]); }
        const float rstd = rsqrtf(wave_sum(q) * (1.f / D) + 1e-5f);
        const int mr = mrow(r); const float* sh = modp(mods, 1, 3) + (size_t)mr * 9216; const float* sc = modp(mods, 1, 4) + (size_t)mr * 9216;
        const bool prompt = r < NP; const int t = r & 2047;
#pragma unroll
        for (int j = 0; j < 4; ++j) { const int c = j * 256 + lane * 4; const f32x4 x = v[j] * rstd * gg[j] + bb[j]; const f32x4 h = x * (*(const f32x4*)(sc + c) + 1.0f) + *(const f32x4*)(sh + c);
            if (!warm) { *(f32x4*)(X + (size_t)r * D + c) = x; if (r >= NP) *(f32x4*)(ZS + (size_t)(r - NP) * D + c) = x * ALPHA;
                f32x4 pv = prev[j]; if (!prompt) pv = *(const f32x4*)(shift_in + (size_t)(r - NP) * D + c); else if (t == 0) pv = (f32x4){0.f, 0.f, 0.f, 0.f};
                *(unsigned long long*)(A2 + (size_t)r * KRK + c) = (unsigned long long)pk2(pv[0], pv[1]) | ((unsigned long long)pk2(pv[2], pv[3]) << 32);
                *(unsigned long long*)(A2 + (size_t)r * KRK + 1024 + c) = (unsigned long long)pk2(h[0], h[1]) | ((unsigned long long)pk2(h[2], h[3]) << 32);
                if (prompt) { if (t == 2047) *(f32x4*)(out + O_SHIFT_P + (size_t)(r >> 11) * D + c) = h; } else *(f32x4*)(out + O_SHIFT_S + (size_t)(r - NP) * D + c) = h; }
            prev[j] = h; }
    }
}
DEVI void shiftcat_row(int row, int lane, const float* X, const float* mods, const float* shift_in, bf16* A2, float* out) {
    if (row >= MT) { for (int j = 0; j < 8; ++j) *(unsigned long long*)(A2 + (size_t)row * KRK + j * 256 + lane * 4) = 0ull; return; }
    const int mr = mrow(row); const float* sh = modp(mods, 1, 3) + (size_t)mr * 9216; const float* sc = modp(mods, 1, 4) + (size_t)mr * 9216;
    const bool prompt = row < NP; const int t = row & 2047;
#pragma unroll
    for (int j = 0; j < 4; ++j) { const int c = j * 256 + lane * 4; const f32x4 a = *(const f32x4*)(sc + c) + 1.0f, b = *(const f32x4*)(sh + c);
        const f32x4 h = *(const f32x4*)(X + (size_t)row * D + c) * a + b; f32x4 pv;
        if (prompt) pv = t == 0 ? (f32x4){0.f, 0.f, 0.f, 0.f} : *(const f32x4*)(X + (size_t)(row - 1) * D + c) * a + b; else pv = *(const f32x4*)(shift_in + (size_t)(row - NP) * D + c);
        *(unsigned long long*)(A2 + (size_t)row * KRK + c) = (unsigned long long)pk2(pv[0], pv[1]) | ((unsigned long long)pk2(pv[2], pv[3]) << 32);
        *(unsigned long long*)(A2 + (size_t)row * KRK + 1024 + c) = (unsigned long long)pk2(h[0], h[1]) | ((unsigned long long)pk2(h[2], h[3]) << 32);
        if (prompt) { if (t == 2047) *(f32x4*)(out + O_SHIFT_P + (size_t)(row >> 11) * D + c) = h; } else *(f32x4*)(out + O_SHIFT_S + (size_t)(row - NP) * D + c) = h; }
}
template <int NR> DEVI void shiftcat_rows(int row0, int stride, int lane, const float* X, const float* mods, bf16* A2, float* out) {
    f32x4 v[NR][4], pr[NR][4];
#pragma unroll
    for (int i = 0; i < NR; ++i) { const int row = row0 + i * stride, rp = (row & 2047) ? row - 1 : row;
#pragma unroll
        for (int j = 0; j < 4; ++j) { v[i][j] = *(const f32x4*)(X + (size_t)row * D + j * 256 + lane * 4); pr[i][j] = *(const f32x4*)(X + (size_t)rp * D + j * 256 + lane * 4); } }
#pragma unroll
    for (int i = 0; i < NR; ++i) { const int row = row0 + i * stride, t = row & 2047, mr = mrow(row); const float* sh = modp(mods, 1, 3) + (size_t)mr * 9216; const float* sc = modp(mods, 1, 4) + (size_t)mr * 9216;
#pragma unroll
        for (int j = 0; j < 4; ++j) { const int c = j * 256 + lane * 4; const f32x4 a = *(const f32x4*)(sc + c) + 1.0f, b = *(const f32x4*)(sh + c);
            const f32x4 h = v[i][j] * a + b; f32x4 pv = pr[i][j] * a + b; if (t == 0) pv = (f32x4){0.f, 0.f, 0.f, 0.f};
            *(unsigned long long*)(A2 + (size_t)row * KRK + c) = (unsigned long long)pk2(pv[0], pv[1]) | ((unsigned long long)pk2(pv[2], pv[3]) << 32);
            *(unsigned long long*)(A2 + (size_t)row * KRK + 1024 + c) = (unsigned long long)pk2(h[0], h[1]) | ((unsigned long long)pk2(h[2], h[3]) << 32);
            if (t == 2047) *(f32x4*)(out + O_SHIFT_P + (size_t)(row >> 11) * D + c) = h; } }
}
DEVI void gla_post_one(int w, int lane, const float* OG, const bf16* P, const float* norm_g, bf16* O) {
    const int tok = w >> 2, h = w & 3;
    const float o0 = OG[(size_t)tok * 512 + h * 128 + lane], o1 = OG[(size_t)tok * 512 + h * 128 + 64 + lane];
    const float ms = wave_sum(o0 * o0 + o1 * o1) * (1.f / 128.f), r = rsqrtf(ms + 1e-5f);
    const float g0 = bf2f(P[(size_t)tok * NINP + 1024 + h * 128 + lane]), g1 = bf2f(P[(size_t)tok * NINP + 1024 + h * 128 + 64 + lane]);
    O[(size_t)tok * D + h * 128 + lane] = (bf16)f2bf(o0 * r * norm_g[lane] * siluf_(g0));
    O[(size_t)tok * D + h * 128 + 64 + lane] = (bf16)f2bf(o1 * r * norm_g[64 + lane] * siluf_(g1));
}

DEVI void gla_job(LAS float* scr, int lane, int b, int h, int half, const bf16* P, const float* GKL, const float* w_gk, const float* b_gk, int tok_base, int T, const float* s0, float* s_out, float* OG) {
    LAS float* sdec = scr; LAS float* sq = scr + 1024; LAS float* sk = scr + 2048;
    const int dv = half * 64 + lane;
    float S[64];
#pragma unroll
    for (int i = 0; i < 64; ++i) S[i] = s0 ? s0[(((size_t)b * 4 + h) * 64 + i) * 128 + dv] : 0.f;
    float wg[16];
#pragma unroll
    for (int r = 0; r < 16; ++r) wg[r] = w_gk[r * 256 + h * 64 + lane];
    const float bg = b_gk[h * 64 + lane];
    for (int t0 = 0; t0 < T; t0 += 16) { const int nt = (T - t0) < 16 ? (T - t0) : 16;
        for (int tt = 0; tt < nt; ++tt) { const size_t tok = (size_t)tok_base + (size_t)b * T + t0 + tt; float x = bg;
#pragma unroll
            for (int r = 0; r < 16; ++r) x += GKL[tok * 16 + r] * wg[r];
            const float ls = fminf(x, 0.f) - log1pf(__expf(-fabsf(x)));
            sdec[tt * 64 + lane] = __expf(ls * (1.f / 16.f)); sq[tt * 64 + lane] = bf2f(P[tok * NINP + h * 64 + lane]) * 0.125f; sk[tt * 64 + lane] = bf2f(P[tok * NINP + 256 + h * 64 + lane]); }
        LDS_WAIT(); asm volatile("" ::: "memory");
        for (int tt = 0; tt < nt; ++tt) { const size_t tok = (size_t)tok_base + (size_t)b * T + t0 + tt;
            const float v = bf2f(P[tok * NINP + 512 + h * 128 + dv]); float o = 0.f;
#pragma unroll
            for (int i = 0; i < 64; ++i) { S[i] = S[i] * sdec[tt * 64 + i] + sk[tt * 64 + i] * v; o += sq[tt * 64 + i] * S[i]; }
            OG[tok * 512 + h * 128 + dv] = o; }
        LDS_WAIT(); asm volatile("" ::: "memory");
    }
#pragma unroll
    for (int i = 0; i < 64; ++i) s_out[(((size_t)b * 4 + h) * 64 + i) * 128 + dv] = S[i];
}
DEVI void s5_job(LAS float* scr, int lane, int g, int b0, int nb, const bf16* P, const float* sp, const float* c_re, const float* c_im, const float* dd, int tok_base, int T,
                 const float* h0re, const float* h0im, float* ore, float* oim, bf16* Z5) {
    const int p = lane, c = p & 15, pq = p >> 4;
    const float abr = sp[g * 64 + p], abi = sp[2048 + g * 64 + p];
    float bbr[16], bbi[16], cr[16], ci[16];
#pragma unroll
    for (int i = 0; i < 16; ++i) { bbr[i] = sp[4096 + (g * 64 + p) * 16 + i]; bbi[i] = sp[4096 + 32768 + (g * 64 + p) * 16 + i];
        cr[i] = c_re[(g * 16 + c) * 64 + pq * 16 + i]; ci[i] = c_im[(g * 16 + c) * 64 + pq * 16 + i]; }
    const float dv = dd[g * 16 + c];
    for (int b = b0; b < b0 + nb; ++b) {
        float hr = h0re ? h0re[((size_t)b * 32 + g) * 64 + p] : 0.f, hi = h0im ? h0im[((size_t)b * 32 + g) * 64 + p] : 0.f;
        for (int t = 0; t < T; ++t) { const size_t tok = (size_t)tok_base + (size_t)b * T + t;
            const bf16* up = P + tok * NINP + 1552 + g * 16; float u[16];
#pragma unroll
            for (int i = 0; i < 16; ++i) u[i] = bf2f(up[i]);
            const float uc = bf2f(up[c]);
            float br = 0.f, bi = 0.f;
#pragma unroll
            for (int i = 0; i < 16; ++i) { br += u[i] * bbr[i]; bi += u[i] * bbi[i]; }
            const float nr = abr * hr - abi * hi + br, ni = abr * hi + abi * hr + bi; hr = nr; hi = ni;
            LAS float* hs = scr + (t & 1) * 128;
            hs[p] = hr; hs[64 + p] = hi;
            LDS_WAIT(); asm volatile("" ::: "memory");
            float y = 0.f;
#pragma unroll
            for (int i = 0; i < 16; ++i) y += cr[i] * hs[pq * 16 + i] - ci[i] * hs[64 + pq * 16 + i];
            y += __shfl_xor(y, 16); y += __shfl_xor(y, 32);
            if (p < 16) { y += dv * uc; Z5[tok * 512 + g * 16 + c] = (bf16)f2bf(gelu_tanh(y)); }
        }
        ore[((size_t)b * 32 + g) * 64 + p] = hr; oim[((size_t)b * 32 + g) * 64 + p] = hi;
        LDS_WAIT(); asm volatile("" ::: "memory");
    }
}
DEVI float wkv_decay(float w0, float raw) { const float x = -(w0 + raw); const float sp = fmaxf(x, 0.f) + log1pf(__expf(-fabsf(x))); return __expf(-__expf(-sp - 0.5f)); }
DEVI void wkv_job(LAS float* scr, int lane, int b, int h, const bf16* R, const bf16* Kb, const bf16* V, const bf16* WRAW, const float* w0p, const bf16* AS, bf16* GO, const float* k_k, const float* k_a, const float* r_k, const float* lnx_g, const float* lnx_b,
                  int tok_base, int T, const float* s0, float* s_out) {
    LAS float* sw = scr; LAS float* skm = scr + 512; LAS float* sa_ = scr + 1024; LAS float* sb = scr + 1536; LAS float* sr = scr + 2048; LAS float* sbon = scr + 2560;
    const int i = lane, ch = h * 64 + i;
    float S[64];
#pragma unroll
    for (int j = 0; j < 64; ++j) S[j] = s0 ? s0[(((size_t)b * 16 + h) * 64 + i) * 64 + j] : 0.f;
    const float kkc = k_k[ch], kac = k_a[ch], rkc = r_k[ch], lg = lnx_g[ch], lb = lnx_b[ch];
    for (int t0 = 0; t0 < T; t0 += 8) { const int nt = (T - t0) < 8 ? (T - t0) : 8;
        for (int tt = 0; tt < nt; ++tt) { const size_t tok = (size_t)tok_base + (size_t)b * T + t0 + tt;
            const float k = bf2f(Kb[tok * D + ch]), r = bf2f(R[tok * D + ch]), a = bf2f(AS[tok * D + ch]), w = wkv_decay(w0p[ch], bf2f(WRAW[tok * D + ch]));
            float kk = k * kkc; const float nrm = sqrtf(wave_sum(kk * kk)); kk = kk / fmaxf(nrm, 1e-12f);
            const float km = k * (1.f + (a - 1.f) * kac);
            sw[tt * 64 + i] = w; skm[tt * 64 + i] = km; sa_[tt * 64 + i] = -kk; sb[tt * 64 + i] = kk * a; sr[tt * 64 + i] = r;
            const float bon = wave_sum(r * km * rkc); if (i == 0) sbon[tt] = bon; }
        LDS_WAIT(); asm volatile("" ::: "memory");
        for (int tt = 0; tt < nt; ++tt) { const size_t tok = (size_t)tok_base + (size_t)b * T + t0 + tt;
            const float v = bf2f(V[tok * D + ch]); float sa = 0.f;
#pragma unroll
            for (int j = 0; j < 64; ++j) sa += S[j] * sa_[tt * 64 + j];
            float y = 0.f;
#pragma unroll
            for (int j = 0; j < 64; ++j) { S[j] = S[j] * sw[tt * 64 + j] + sa * sb[tt * 64 + j] + v * skm[tt * 64 + j]; y += S[j] * sr[tt * 64 + j]; }
            const float mean = wave_sum(y) * (1.f / 64.f), dy = y - mean, var = wave_sum(dy * dy) * (1.f / 64.f);
            float yn = dy * rsqrtf(var + 64e-5f) * lg + lb; yn += sbon[tt] * v;
            const float gt = bf2f(GO[tok * D + ch]); GO[tok * D + ch] = (bf16)f2bf(yn * gt); }
        LDS_WAIT(); asm volatile("" ::: "memory");
    }
#pragma unroll
    for (int j = 0; j < 64; ++j) s_out[(((size_t)b * 16 + h) * 64 + i) * 64 + j] = S[j];
}

DEVI float dpp_add(float v, const int ctrl_sel) {
    int r;
    switch (ctrl_sel) {
    case 0: r = __builtin_amdgcn_update_dpp(0, __builtin_bit_cast(int, v), 0xB1, 0xF, 0xF, true); break;
    case 1: r = __builtin_amdgcn_update_dpp(0, __builtin_bit_cast(int, v), 0x4E, 0xF, 0xF, true); break;
    case 2: r = __builtin_amdgcn_update_dpp(0, __builtin_bit_cast(int, v), 0x141, 0xF, 0xF, true); break;
    default: r = __builtin_amdgcn_update_dpp(0, __builtin_bit_cast(int, v), 0x140, 0xF, 0xF, true); break;
    }
    return v + __builtin_bit_cast(float, r);
}
DEVI float red16(float v) { v = dpp_add(v, 0); v = dpp_add(v, 1); v = dpp_add(v, 2); v = dpp_add(v, 3); return v; }
constexpr int WK_TB = 32;
constexpr int WK_W = 0, WK_KM = 2048, WK_NA = 4096, WK_BB = 6144, WK_WR = 8192, WK_V = 10240, WK_PB = 12800;
constexpr int WK_Y = 2 * WK_PB, WK_YB = 1024;
static_assert((WK_Y + 2 * WK_YB + 512 + 1200) * 4 <= RING_BYTES, "wkv lds");
struct WkvLoad { uint2 k, r, a, v, w; };
typedef float f32x2_t __attribute__((ext_vector_type(2)));
struct WkvOps { f32x4 na, wr, w4, bb, km, vv; };
DEVI float wkv_decay_fast(float w0, float raw) { const float x = -(w0 + raw); const float sp = fmaxf(x, 0.f) + 0.69314718056f * __builtin_amdgcn_logf(1.0f + __builtin_amdgcn_exp2f(-1.44269504089f * fabsf(x)));
    const float ee = __builtin_amdgcn_exp2f(-1.44269504089f * (sp + 0.5f)); return __builtin_amdgcn_exp2f(-1.44269504089f * ee); }
template <int MODE> DEVI void wkv_half(LAS float* L, int tid, int b, int h, int half, const bf16* R, const bf16* Kb, const bf16* V, const bf16* WRAW, const bf16* AS, const float* w0p,
                   const float* k_k, const float* k_a, const float* r_k, bf16* Y, float* BON, float* s_out) {
    asm volatile("" : "+v"(tid));
    const int rp = (tid >> 4) & 15, jq = tid & 15; const bool stepper = tid < 256;
    const int ch = h * 64 + 4 * jq, chv = h * 64 + half * 32 + 4 * (jq & 7);
    f32x4 S0 = {0.f, 0.f, 0.f, 0.f}, S1 = {0.f, 0.f, 0.f, 0.f};
    const size_t tokb = (size_t)b * TP;
    auto bf4 = [](uint2 u) -> f32x4 { f32x4 o; o[0] = __uint_as_float(u.x << 16); o[1] = __uint_as_float(u.x & 0xffff0000u); o[2] = __uint_as_float(u.y << 16); o[3] = __uint_as_float(u.y & 0xffff0000u); return o; };
#define WK_PREP1(bufidx, blkidx, tt_) do { LAS float* pb_ = L + (bufidx) * WK_PB; const size_t t_ = tokb + (size_t)(blkidx) * WK_TB + (tt_); const size_t o_ = t_ * D + ch; \
        const f32x4 k4 = bf4(*(const uint2*)(Kb + o_)), r4 = bf4(*(const uint2*)(R + o_)), a4 = bf4(*(const uint2*)(AS + o_)), wraw = bf4(*(const uint2*)(WRAW + o_)), v4 = bf4(*(const uint2*)(V + t_ * D + chv)); f32x4 w4; \
        _Pragma("unroll") for (int e_ = 0; e_ < 4; ++e_) w4[e_] = wkv_decay_fast(w0c[e_], wraw[e_]); \
        f32x4 kk = k4 * kkc; float ss = red16((kk[0] * kk[0] + kk[1] * kk[1]) + (kk[2] * kk[2] + kk[3] * kk[3])); const float inv = 1.0f / fmaxf(sqrtf(ss), 1e-12f); kk = kk * inv; \
        const f32x4 km = k4 * ((a4 - 1.0f) * kac + 1.0f); const f32x4 pr = r4 * km; const f32x4 prk = pr * rkc; const float bon = red16((prk[0] + prk[1]) + (prk[2] + prk[3])); \
        const f32x4 bbv = kk * a4; const f32x4 pb2 = bbv * r4; const float brs = red16((pb2[0] + pb2[1]) + (pb2[2] + pb2[3])), krs = red16((pr[0] + pr[1]) + (pr[2] + pr[3])); \
        *(LAS f32x4*)(pb_ + WK_W + (tt_) * 64 + 4 * jq) = w4; *(LAS f32x4*)(pb_ + WK_KM + (tt_) * 64 + 4 * jq) = km; *(LAS f32x4*)(pb_ + WK_NA + (tt_) * 64 + 4 * jq) = -kk; \
        *(LAS f32x4*)(pb_ + WK_BB + (tt_) * 64 + 4 * jq) = bbv; *(LAS f32x4*)(pb_ + WK_WR + (tt_) * 64 + 4 * jq) = w4 * r4 - kk * brs; \
        if (jq < 8) { *(LAS f32x4*)(pb_ + WK_V + (tt_) * 64 + 8 * jq) = (f32x4){v4[0], v4[1], v4[0] * krs, v4[1] * krs}; *(LAS f32x4*)(pb_ + WK_V + (tt_) * 64 + 8 * jq + 4) = (f32x4){v4[2], v4[3], v4[2] * krs, v4[3] * krs}; } \
        if (jq == 0 && half == 0) BON[t_ * 16 + h] = bon; } while (0)
#define WK_RD128(dst, ad, off) asm volatile("ds_read_b128 %0, %1 offset:%2" : "=v"(dst) : "v"(ad), "i"(off))
#define WK_LOADOPS(o_, dt_) do { WK_RD128((o_).na, aop, WK_NA * 4 + (dt_) * 256); WK_RD128((o_).wr, aop, WK_WR * 4 + (dt_) * 256); WK_RD128((o_).w4, aop, WK_W * 4 + (dt_) * 256); \
        WK_RD128((o_).bb, aop, WK_BB * 4 + (dt_) * 256); WK_RD128((o_).km, aop, WK_KM * 4 + (dt_) * 256); WK_RD128((o_).vv, av, (dt_) * 256); } while (0)
#define WK_WAIT(n_, o_) asm volatile("s_waitcnt lgkmcnt(" #n_ ")" : "+v"((o_).na), "+v"((o_).wr), "+v"((o_).w4), "+v"((o_).bb), "+v"((o_).km), "+v"((o_).vv))
#define WK_STEP(o_, dt_) do { \
        float sa0 = (S0[0] * (o_).na[0] + S0[1] * (o_).na[1]) + (S0[2] * (o_).na[2] + S0[3] * (o_).na[3]), sa1 = (S1[0] * (o_).na[0] + S1[1] * (o_).na[1]) + (S1[2] * (o_).na[2] + S1[3] * (o_).na[3]); \
        float y0 = (S0[0] * (o_).wr[0] + S0[1] * (o_).wr[1]) + (S0[2] * (o_).wr[2] + S0[3] * (o_).wr[3]), y1 = (S1[0] * (o_).wr[0] + S1[1] * (o_).wr[1]) + (S1[2] * (o_).wr[2] + S1[3] * (o_).wr[3]); \
        sa0 = dpp_add(sa0, 0); sa1 = dpp_add(sa1, 0); y0 = dpp_add(y0, 0); y1 = dpp_add(y1, 0); sa0 = dpp_add(sa0, 1); sa1 = dpp_add(sa1, 1); y0 = dpp_add(y0, 1); y1 = dpp_add(y1, 1); \
        sa0 = dpp_add(sa0, 2); sa1 = dpp_add(sa1, 2); y0 = dpp_add(y0, 2); y1 = dpp_add(y1, 2); sa0 = dpp_add(sa0, 3); sa1 = dpp_add(sa1, 3); y0 = dpp_add(y0, 3); y1 = dpp_add(y1, 3); \
        S0 = S0 * (o_).w4 + ((o_).bb * sa0 + (o_).km * (o_).vv[0]); S1 = S1 * (o_).w4 + ((o_).bb * sa1 + (o_).km * (o_).vv[1]); \
        f32x2_t yy; yy[0] = y0 + (o_).vv[2]; yy[1] = y1 + (o_).vv[3]; \
        asm volatile("ds_write_b64 %0, %1 offset:%2" :: "v"(ay), "v"(yy), "i"((dt_) * 128) : "memory"); } while (0)
    constexpr int NB = TP / WK_TB;
    if (!stepper) {
        const int ht = (tid - 256) >> 4;
        const f32x4 kkc = *(const f32x4*)(k_k + ch), kac = *(const f32x4*)(k_a + ch), rkc = *(const f32x4*)(r_k + ch), w0c = *(const f32x4*)(w0p + ch);
        WK_PREP1(0, 0, ht); WK_PREP1(0, 0, ht + 16);
        LDS_WAIT(); __builtin_amdgcn_s_barrier(); asm volatile("" ::: "memory");
        for (int n = 0; n < NB; ++n) { const int cur = n & 1;
            if (n + 1 < NB) { WK_PREP1(cur ^ 1, n + 1, ht); WK_PREP1(cur ^ 1, n + 1, ht + 16); }
            if (n >= 1) {
                const int yt = (tid - 256) >> 3, yq = (tid & 7) * 4; const f32x4 y4 = *(const LAS f32x4*)(L + WK_Y + (cur ^ 1) * WK_YB + yt * 32 + yq);
                uint2 ov; ov.x = pk2(y4[0], y4[1]); ov.y = pk2(y4[2], y4[3]);
                *(uint2*)(Y + (tokb + (size_t)(n - 1) * WK_TB + yt) * D + h * 64 + half * 32 + yq) = ov; }
            LDS_WAIT(); __builtin_amdgcn_s_barrier(); asm volatile("" ::: "memory");
        }
        { const int yt = (tid - 256) >> 3, yq = (tid & 7) * 4; const f32x4 y4 = *(const LAS f32x4*)(L + WK_Y + ((NB - 1) & 1) * WK_YB + yt * 32 + yq);
            uint2 ov; ov.x = pk2(y4[0], y4[1]); ov.y = pk2(y4[2], y4[3]); *(uint2*)(Y + (tokb + (size_t)(NB - 1) * WK_TB + yt) * D + h * 64 + half * 32 + yq) = ov; }
    } else {
        LDS_WAIT(); __builtin_amdgcn_s_barrier(); asm volatile("" ::: "memory");
        const unsigned lbase = (unsigned)(size_t)L;
        for (int n = 0; n < NB; ++n) { const int cur = n & 1;
            unsigned aop = lbase + (unsigned)(cur * WK_PB + 4 * jq) * 4u, av = lbase + (unsigned)(cur * WK_PB + WK_V + 4 * rp) * 4u;
            unsigned ay = lbase + (unsigned)(jq == 0 ? WK_Y + cur * WK_YB + 2 * rp : WK_Y + 2 * WK_YB + 2 * tid) * 4u;
            WkvOps o0, o1, o2, o3;
            asm volatile("s_waitcnt lgkmcnt(0)" ::: "memory");
            WK_LOADOPS(o0, 0); WK_LOADOPS(o1, 1);
            WK_LOADOPS(o2, 2); WK_WAIT(12, o0); WK_STEP(o0, 0);
            WK_LOADOPS(o3, 3); WK_WAIT(13, o1); WK_STEP(o1, 1);
            for (int t4 = 0; t4 < 7; ++t4) {
                WK_LOADOPS(o0, 4); WK_WAIT(14, o2); WK_STEP(o2, 2);
                WK_LOADOPS(o1, 5); WK_WAIT(14, o3); WK_STEP(o3, 3);
                aop += 1024; av += 1024; ay += 512;
                WK_LOADOPS(o2, 2); WK_WAIT(14, o0); WK_STEP(o0, 0);
                WK_LOADOPS(o3, 3); WK_WAIT(14, o1); WK_STEP(o1, 1);
            }
            WK_WAIT(8, o2); WK_STEP(o2, 2);
            WK_WAIT(2, o3); WK_STEP(o3, 3);
            asm volatile("s_waitcnt lgkmcnt(0)" ::: "memory");
            __builtin_amdgcn_s_barrier(); asm volatile("" ::: "memory");
        }
        float* so = s_out + (((size_t)b * 16 + h) * 64 + half * 32 + 2 * rp) * 64 + 4 * jq; *(f32x4*)so = S0; *(f32x4*)(so + 64) = S1;
    }
#undef WK_LOADOPS
#undef WK_STEP
#undef WK_WAIT
#undef WK_RD128
#undef WK_PREP1
}
struct YpIn { v4u ya, yb, va, vb, ga, gb; };
DEVI YpIn wkv_ypass_load(size_t tok, int lane, const bf16* Y, const bf16* V, const bf16* GO) { const size_t o = tok * D + lane * 16; YpIn r; r.ya = *(const v4u*)(Y + o); r.yb = *(const v4u*)(Y + o + 8); r.va = *(const v4u*)(V + o); r.vb = *(const v4u*)(V + o + 8); r.ga = *(const v4u*)(GO + o); r.gb = *(const v4u*)(GO + o + 8); return r; }
DEVI void wkv_ypass_fin(size_t tok, int lane, const YpIn& in, bf16* GO, const float* BON, const float* lnx_g, const float* lnx_b) {
    const int c0 = lane * 16; const size_t o = tok * D + c0;
    const v4u ya = in.ya, yb = in.yb, va = in.va, vb = in.vb, ga = in.ga, gb = in.gb;
    const unsigned yw[8] = {ya.x, ya.y, ya.z, ya.w, yb.x, yb.y, yb.z, yb.w}, vw[8] = {va.x, va.y, va.z, va.w, vb.x, vb.y, vb.z, vb.w}, gw_[8] = {ga.x, ga.y, ga.z, ga.w, gb.x, gb.y, gb.z, gb.w};
    float y[16]; float s = 0.f;
#pragma unroll
    for (int e = 0; e < 8; ++e) { y[2 * e] = __uint_as_float(yw[e] << 16); y[2 * e + 1] = __uint_as_float(yw[e] & 0xffff0000u); s += y[2 * e] + y[2 * e + 1]; }
    s = dpp_add(s, 0); s = dpp_add(s, 1); const float mean = s * (1.f / 64.f); float q = 0.f;
#pragma unroll
    for (int e = 0; e < 16; ++e) { y[e] -= mean; q += y[e] * y[e]; }
    q = dpp_add(q, 0); q = dpp_add(q, 1); const float rstd = rsqrtf(q * (1.f / 64.f) + 64e-5f), bon = BON[tok * 16 + (lane >> 2)];
    unsigned ow[8];
#pragma unroll
    for (int e = 0; e < 8; ++e) { const float v0 = __uint_as_float(vw[e] << 16), v1 = __uint_as_float(vw[e] & 0xffff0000u), g0 = __uint_as_float(gw_[e] << 16), g1 = __uint_as_float(gw_[e] & 0xffff0000u);
        const float o0 = (y[2 * e] * rstd * lnx_g[c0 + 2 * e] + lnx_b[c0 + 2 * e] + bon * v0) * g0, o1 = (y[2 * e + 1] * rstd * lnx_g[c0 + 2 * e + 1] + lnx_b[c0 + 2 * e + 1] + bon * v1) * g1; ow[e] = pk2(o0, o1); }
    *(v4u*)(GO + o) = (v4u){ow[0], ow[1], ow[2], ow[3]}; *(v4u*)(GO + o + 8) = (v4u){ow[4], ow[5], ow[6], ow[7]};
}
DEVI void wkv_ypass_row(size_t tok, int lane, const bf16* Y, const bf16* V, bf16* GO, const float* BON, const float* lnx_g, const float* lnx_b) { const YpIn in = wkv_ypass_load(tok, lane, Y, V, GO); wkv_ypass_fin(tok, lane, in, GO, BON, lnx_g, lnx_b); }
DEVI void wkv_ypass_rows4(size_t tok0, size_t stride, int lane, const bf16* Y, const bf16* V, bf16* GO, const float* BON, const float* lnx_g, const float* lnx_b) {
    const YpIn a = wkv_ypass_load(tok0, lane, Y, V, GO), b = wkv_ypass_load(tok0 + stride, lane, Y, V, GO), c = wkv_ypass_load(tok0 + 2 * stride, lane, Y, V, GO), d = wkv_ypass_load(tok0 + 3 * stride, lane, Y, V, GO);
    wkv_ypass_fin(tok0, lane, a, GO, BON, lnx_g, lnx_b); wkv_ypass_fin(tok0 + stride, lane, b, GO, BON, lnx_g, lnx_b); wkv_ypass_fin(tok0 + 2 * stride, lane, c, GO, BON, lnx_g, lnx_b); wkv_ypass_fin(tok0 + 3 * stride, lane, d, GO, BON, lnx_g, lnx_b);
}

constexpr int GL_BF = 0, GL_QI = 16384, GL_KI = 25600, GL_SC = 34816, GL_VT = 44032, GL_ST = 62464, GL_RS = 80896, GL_WG = 81920, GL_GKL = 86016, GL_SEG = 90112;
constexpr int GL_LD = 72;
DEVI bf16x8 gl_frag(LAS unsigned char* lds, int base, int row, int k0, int fq) { return *(const LAS bf16x8*)(lds + base + (row * GL_LD + k0 + 8 * fq) * 2); }
DEVI void gla_cumdecay(LAS unsigned char* lds, int tid, int h, size_t tok0, const float* GKL, const float* w_gk, const float* b_gk) {
    asm volatile("" : "+v"(tid));
    LAS float* BF = (LAS float*)(lds + GL_BF); LAS float* WG = (LAS float*)(lds + GL_WG); LAS float* GK = (LAS float*)(lds + GL_GKL); LAS float* SEG = (LAS float*)(lds + GL_SEG);
    for (int i = tid; i < 1024; i += 512) { WG[i] = w_gk[(i >> 6) * 256 + h * 64 + (i & 63)]; GK[i] = GKL[tok0 * 16 + i]; }
    LDS_WAIT(); __builtin_amdgcn_s_barrier(); asm volatile("" ::: "memory");
    { const int t = tid >> 3, d0 = (tid & 7) * 8; float x[8];
#pragma unroll
        for (int e = 0; e < 8; ++e) x[e] = b_gk[h * 64 + d0 + e];
#pragma unroll
        for (int r = 0; r < 16; ++r) { const float gv = GK[t * 16 + r]; const f32x4 w0 = *(const LAS f32x4*)(WG + r * 64 + d0), w1 = *(const LAS f32x4*)(WG + r * 64 + d0 + 4);
#pragma unroll
            for (int e = 0; e < 4; ++e) { x[e] += gv * w0[e]; x[4 + e] += gv * w1[e]; } }
#pragma unroll
        for (int e = 0; e < 8; ++e) { const float xx = x[e]; x[e] = (fminf(xx, 0.f) - log1pf(__expf(-fabsf(xx)))) * (1.f / 16.f); }
        *(LAS f32x4*)(BF + t * 64 + d0) = (f32x4){x[0], x[1], x[2], x[3]}; *(LAS f32x4*)(BF + t * 64 + d0 + 4) = (f32x4){x[4], x[5], x[6], x[7]}; }
    LDS_WAIT(); __builtin_amdgcn_s_barrier(); asm volatile("" ::: "memory");
    { const int dk = tid & 63, sg = tid >> 6; float a = 0.f;
#pragma unroll
        for (int i = 0; i < 8; ++i) { a += BF[(sg * 8 + i) * 64 + dk]; BF[(sg * 8 + i) * 64 + dk] = a; }
        SEG[sg * 64 + dk] = a; }
    LDS_WAIT(); __builtin_amdgcn_s_barrier(); asm volatile("" ::: "memory");
    { const int dk = tid & 63, sg = tid >> 6; float off = 0.f;
        for (int s = 0; s < sg; ++s) off += SEG[s * 64 + dk];
#pragma unroll
        for (int i = 0; i < 8; ++i) BF[(sg * 8 + i) * 64 + dk] += off; }
    LDS_WAIT(); __builtin_amdgcn_s_barrier(); asm volatile("" ::: "memory");
}
DEVI void gla_stage_vt(LAS unsigned char* lds, int tid, int h, size_t tok0, const bf16* P) {
    const int t = tid >> 3, dv0 = (tid & 7) * 16; const bf16* vp = P + (tok0 + t) * NINP + 512 + h * 128 + dv0;
    const v4u a = *(const v4u*)vp, b = *(const v4u*)(vp + 8); LAS bf16* VT = (LAS bf16*)(lds + GL_VT);
    const unsigned w[8] = {a.x, a.y, a.z, a.w, b.x, b.y, b.z, b.w};
#pragma unroll
    for (int e = 0; e < 8; ++e) { VT[(dv0 + 2 * e) * GL_LD + t] = (bf16)(w[e] & 0xffffu); VT[(dv0 + 2 * e + 1) * GL_LD + t] = (bf16)(w[e] >> 16); }
}
DEVI void gla_unit_a(LAS unsigned char* lds, int tid, int u, const bf16* P, const float* GKL, const float* w_gk, const float* b_gk, float* KV, float* DEC) {
    asm volatile("" : "+v"(tid));
    const int bh = u >> 5, ck = u & 31, b = bh >> 2, h = bh & 3; const size_t tok0 = (size_t)b * TP + ck * 64;
    const int lane = tid & 63, wave = tid >> 6, fr = lane & 15, fq = lane >> 4;
    gla_cumdecay(lds, tid, h, tok0, GKL, w_gk, b_gk);
    LAS float* BF = (LAS float*)(lds + GL_BF);
    { const int t = tid >> 3, d0 = (tid & 7) * 8; const v4u kq = *(const v4u*)(P + (tok0 + t) * NINP + 256 + h * 64 + d0); LAS bf16* KST = (LAS bf16*)(lds + GL_QI);
        const unsigned w[4] = {kq.x, kq.y, kq.z, kq.w};
#pragma unroll
        for (int e = 0; e < 8; ++e) { const float kv = __uint_as_float((e & 1) ? (w[e >> 1] & 0xffff0000u) : (w[e >> 1] << 16)); const float sc = __expf(BF[63 * 64 + d0 + e] - BF[t * 64 + d0 + e]);
            KST[(d0 + e) * GL_LD + t] = (bf16)f2bf(kv * sc); } }
    gla_stage_vt(lds, tid, h, tok0, P);
    if (tid < 64) DEC[(size_t)u * 64 + tid] = __expf(BF[63 * 64 + tid]);
    LDS_WAIT(); __builtin_amdgcn_s_barrier(); asm volatile("" ::: "memory");
#pragma unroll
    for (int dt = 0; dt < 4; ++dt) { f32x4 acc = {0.f, 0.f, 0.f, 0.f};
#pragma unroll
        for (int k0 = 0; k0 < 64; k0 += 32) acc = __builtin_amdgcn_mfma_f32_16x16x32_bf16(gl_frag(lds, GL_VT, wave * 16 + fr, k0, fq), gl_frag(lds, GL_QI, dt * 16 + fr, k0, fq), acc, 0, 0, 0);
        *(f32x4*)(KV + ((size_t)u * 64 + dt * 16 + fr) * 128 + wave * 16 + 4 * fq) = acc; }
    LDS_WAIT(); __builtin_amdgcn_s_barrier(); asm volatile("" ::: "memory");
}
DEVI void gla_scan_b(int gtid, float* KV, const float* DEC, float* s_out) {
    const int dv = gtid & 127, dkq = (gtid >> 7) & 15, bh = gtid >> 11; float S[4] = {0.f, 0.f, 0.f, 0.f};
    for (int c0 = 0; c0 < 32; c0 += 8) {
        float kv[8][4], dc[8][4];
#pragma unroll
        for (int cc = 0; cc < 8; ++cc) { const size_t u = (size_t)bh * 32 + c0 + cc; const float* kp = KV + (u * 64 + dkq * 4) * 128 + dv;
#pragma unroll
            for (int e = 0; e < 4; ++e) { kv[cc][e] = kp[e * 128]; dc[cc][e] = DEC[u * 64 + dkq * 4 + e]; } }
#pragma unroll
        for (int cc = 0; cc < 8; ++cc) { const size_t u = (size_t)bh * 32 + c0 + cc; float* kp = KV + (u * 64 + dkq * 4) * 128 + dv;
#pragma unroll
            for (int e = 0; e < 4; ++e) { kp[e * 128] = S[e]; S[e] = dc[cc][e] * S[e] + kv[cc][e]; } } }
#pragma unroll
    for (int e = 0; e < 4; ++e) s_out[((size_t)bh * 64 + dkq * 4 + e) * 128 + dv] = S[e];
}
DEVI void gla_unit_c(LAS unsigned char* lds, int tid, int u, const bf16* P, const float* GKL, const float* w_gk, const float* b_gk, const float* KV, const float* norm_g, bf16* O) {
    asm volatile("" : "+v"(tid));
    const int bh = u >> 5, ck = u & 31, b = bh >> 2, h = bh & 3; const size_t tok0 = (size_t)b * TP + ck * 64;
    const int lane = tid & 63, wave = tid >> 6, fr = lane & 15, fq = lane >> 4;
    gla_cumdecay(lds, tid, h, tok0, GKL, w_gk, b_gk);
    LAS float* BF = (LAS float*)(lds + GL_BF);
    { const int t = tid >> 3, d0 = (tid & 7) * 8; const v4u qq = *(const v4u*)(P + (tok0 + t) * NINP + h * 64 + d0), kq = *(const v4u*)(P + (tok0 + t) * NINP + 256 + h * 64 + d0);
        const unsigned wq[4] = {qq.x, qq.y, qq.z, qq.w}, wk[4] = {kq.x, kq.y, kq.z, kq.w}; float qo[8], ko[8];
#pragma unroll
        for (int e = 0; e < 8; ++e) { const float qv = __uint_as_float((e & 1) ? (wq[e >> 1] & 0xffff0000u) : (wq[e >> 1] << 16)), kv = __uint_as_float((e & 1) ? (wk[e >> 1] & 0xffff0000u) : (wk[e >> 1] << 16));
            const float bb = BF[t * 64 + d0 + e]; qo[e] = qv * 0.125f * __expf(bb); ko[e] = kv * __expf(-bb); }
        v4u a, c; a.x = pk2(qo[0], qo[1]); a.y = pk2(qo[2], qo[3]); a.z = pk2(qo[4], qo[5]); a.w = pk2(qo[6], qo[7]); c.x = pk2(ko[0], ko[1]); c.y = pk2(ko[2], ko[3]); c.z = pk2(ko[4], ko[5]); c.w = pk2(ko[6], ko[7]);
        *(LAS v4u*)(lds + GL_QI + (t * GL_LD + d0) * 2) = a; *(LAS v4u*)(lds + GL_KI + (t * GL_LD + d0) * 2) = c; }
    gla_stage_vt(lds, tid, h, tok0, P);
    { const int dk = tid >> 3, dv0 = (tid & 7) * 16; const float* sp = KV + ((size_t)u * 64 + dk) * 128 + dv0; LAS bf16* ST = (LAS bf16*)(lds + GL_ST);
#pragma unroll
        for (int q = 0; q < 4; ++q) { const f32x4 s4 = *(const f32x4*)(sp + 4 * q);
#pragma unroll
            for (int e = 0; e < 4; ++e) ST[(dv0 + 4 * q + e) * GL_LD + dk] = (bf16)f2bf(s4[e]); } }
    LDS_WAIT(); __builtin_amdgcn_s_barrier(); asm volatile("" ::: "memory");
#pragma unroll
    for (int q = 0; q < 2; ++q) { const int id = wave * 2 + q, tt = id >> 2, st = id & 3; f32x4 acc = {0.f, 0.f, 0.f, 0.f};
#pragma unroll
        for (int k0 = 0; k0 < 64; k0 += 32) acc = __builtin_amdgcn_mfma_f32_16x16x32_bf16(gl_frag(lds, GL_KI, st * 16 + fr, k0, fq), gl_frag(lds, GL_QI, tt * 16 + fr, k0, fq), acc, 0, 0, 0);
        const int t = tt * 16 + fr, s0 = st * 16 + 4 * fq;
#pragma unroll
        for (int e = 0; e < 4; ++e) if (s0 + e > t) acc[e] = 0.f;
        *(LAS unsigned long long*)(lds + GL_SC + (t * GL_LD + s0) * 2) = (unsigned long long)pk2(acc[0], acc[1]) | ((unsigned long long)pk2(acc[2], acc[3]) << 32); }
    LDS_WAIT(); __builtin_amdgcn_s_barrier(); asm volatile("" ::: "memory");
    const int tt = wave & 3, hv = wave >> 2; f32x4 o[4]; float ssq = 0.f;
#pragma unroll
    for (int dt = 0; dt < 4; ++dt) { f32x4 acc = {0.f, 0.f, 0.f, 0.f}; const int dvr = (hv * 4 + dt) * 16 + fr;
#pragma unroll
        for (int k0 = 0; k0 < 64; k0 += 32) { acc = __builtin_amdgcn_mfma_f32_16x16x32_bf16(gl_frag(lds, GL_VT, dvr, k0, fq), gl_frag(lds, GL_SC, tt * 16 + fr, k0, fq), acc, 0, 0, 0);
            acc = __builtin_amdgcn_mfma_f32_16x16x32_bf16(gl_frag(lds, GL_ST, dvr, k0, fq), gl_frag(lds, GL_QI, tt * 16 + fr, k0, fq), acc, 0, 0, 0); }
        o[dt] = acc; ssq += (acc[0] * acc[0] + acc[1] * acc[1]) + (acc[2] * acc[2] + acc[3] * acc[3]); }
    ssq += __shfl_xor(ssq, 16); ssq += __shfl_xor(ssq, 32);
    LAS float* RS = (LAS float*)(lds + GL_RS);
    if (fq == 0) RS[hv * 64 + tt * 16 + fr] = ssq;
    LDS_WAIT(); __builtin_amdgcn_s_barrier(); asm volatile("" ::: "memory");
    { const int t = tt * 16 + fr; const float rstd = rsqrtf((RS[t] + RS[64 + t]) * (1.f / 128.f) + 1e-5f); const size_t tok = tok0 + t;
#pragma unroll
        for (int dt = 0; dt < 4; ++dt) { const int dv = (hv * 4 + dt) * 16 + 4 * fq; const uint2 gg = *(const uint2*)(P + tok * NINP + 1024 + h * 128 + dv); const f32x4 ng = *(const f32x4*)(norm_g + dv);
            const float g0 = __uint_as_float(gg.x << 16), g1 = __uint_as_float(gg.x & 0xffff0000u), g2 = __uint_as_float(gg.y << 16), g3 = __uint_as_float(gg.y & 0xffff0000u);
            uint2 ov; ov.x = pk2(o[dt][0] * rstd * ng[0] * siluf_(g0), o[dt][1] * rstd * ng[1] * siluf_(g1)); ov.y = pk2(o[dt][2] * rstd * ng[2] * siluf_(g2), o[dt][3] * rstd * ng[3] * siluf_(g3));
            *(uint2*)(O + tok * D + h * 128 + dv) = ov; } }
    LDS_WAIT(); __builtin_amdgcn_s_barrier(); asm volatile("" ::: "memory");
}

constexpr int I_UP = (D / 64) * (NUP / 32), I_DN = (FFP / 64) * (D / 32), I_IN = (D / 64) * (NINP / 32), I_GLU = (512 / 64) * (512 / 32), I_SQ = (D / 64) * (D / 32), I_RK = (KRK / 64) * (NRK / 32), I_L2 = (NL1 / 64) * (3072 / 32);
constexpr int NITEMS = 4 * I_UP + 4 * I_DN + I_IN + I_GLU + 2 * I_SQ + I_RK + I_L2;
DEVI void cvt_dispatch(int r, unsigned char* ws, LAS float* wscr, int lane) {
            if (r < 4 * I_UP) { const int q = r / I_UP, l = q >> 1, f = q & 1; r -= q * I_UP;
                const int kb = r / (NUP / 32), nb = r % (NUP / 32), pn = nb >> 3, half = (nb >> 2) & 1, c0 = pn * 128 + (nb & 3) * 32;
                bf16* dst = (bf16*)(ws + (l ? WS_WUP_L1 : WS_WUP_L0) + f * SZ_WUP) + (size_t)(nb * 32) * D;
                if (c0 >= FF) { SrcZero s; cvt_item(s, dst, D, 1, wscr, kb, lane); }
                else if (half) { SrcPlain s{INPD(f ? 17 : 14) + (size_t)l * D * FF + c0, D, FF - c0, FF}; cvt_item(s, dst, D, 1, wscr, kb, lane); }
                else { SrcPlain s{INPD(f ? 16 : 13) + (size_t)l * D * FF + c0, D, FF - c0, FF}; cvt_item(s, dst, D, 1, wscr, kb, lane); }
                return; } r -= 4 * I_UP;
            if (r < 4 * I_DN) { const int q = r / I_DN, l = q >> 1, f = q & 1; r -= q * I_DN;
                SrcPlain s{INPD(f ? 18 : 15) + (size_t)l * FF * D, FF, D, D};
                cvt_item(s, (bf16*)(ws + (l ? WS_WDN_L1 : WS_WDN_L0) + f * SZ_WDN), FFP, D / 32, wscr, r, lane); return; } r -= 4 * I_DN;
            if (r < I_IN) { SrcPlain s{INPD(19), D, NIN, NIN}; cvt_item(s, (bf16*)(ws + WS_WIN), D, NINP / 32, wscr, r, lane); return; } r -= I_IN;
            if (r < I_GLU) { SrcPlain s{INPD(32), 512, 512, 512}; cvt_item(s, (bf16*)(ws + WS_WGLU), 512, 512 / 32, wscr, r, lane); return; } r -= I_GLU;
            if (r < I_SQ) { SrcPlain s{INPD(20), D, D, D}; cvt_item(s, (bf16*)(ws + WS_WOUT), D, D / 32, wscr, r, lane); return; } r -= I_SQ;
            if (r < I_SQ) { SrcPlain s{INPD(38), D, D, D}; cvt_item(s, (bf16*)(ws + WS_WO), D, D / 32, wscr, r, lane); return; } r -= I_SQ;
            if (r < I_RK) { const int kb = r / (NRK / 32), nb = r % (NRK / 32), n0 = nb * 32; bf16* dst = (bf16*)(ws + WS_WRK) + (size_t)n0 * KRK;
                if (n0 < 1024) { SrcFold s{INPD(35) + n0, INPD(34) + 0 * 1024, 1024}; cvt_item(s, dst, KRK, 1, wscr, kb, lane); }
                else if (n0 < 2048) { SrcFold s{INPD(36) + (n0 - 1024), INPD(34) + 2 * 1024, 1024}; cvt_item(s, dst, KRK, 1, wscr, kb, lane); }
                else if (n0 < 3072) { SrcFold s{INPD(37) + (n0 - 2048), INPD(34) + 3 * 1024, 1024}; cvt_item(s, dst, KRK, 1, wscr, kb, lane); }
                else if (n0 < 3136) { SrcFold s{INPD(40) + (n0 - 3072), INPD(34) + 1 * 1024, 64}; cvt_item(s, dst, KRK, 1, wscr, kb, lane); }
                else if (n0 < 3200) { SrcFold s{INPD(43) + (n0 - 3136), INPD(34) + 4 * 1024, 64}; cvt_item(s, dst, KRK, 1, wscr, kb, lane); }
                else if (n0 < 3360) { SrcFold s{INPD(45) + (n0 - 3200), INPD(34) + 5 * 1024, 160}; cvt_item(s, dst, KRK, 1, wscr, kb, lane); }
                else { SrcZero s; cvt_item(s, dst, KRK, 1, wscr, kb, lane); }
                return; } r -= I_RK;
            { const int kb = r / (3072 / 32), nb = r % (3072 / 32), n0 = nb * 32; bf16* dst = (bf16*)(ws + WS_WL2) + (size_t)n0 * NL1;
                if (n0 < 1024) { SrcBlk s{INPD(41) + n0, 0, 64}; cvt_item(s, dst, NL1, 1, wscr, kb, lane); }
                else if (n0 < 2048) { SrcBlk s{INPD(44) + (n0 - 1024), 64, 128}; cvt_item(s, dst, NL1, 1, wscr, kb, lane); }
                else { SrcBlk s{INPD(46) + (n0 - 2048), 128, 288}; cvt_item(s, dst, NL1, 1, wscr, kb, lane); } }
}

__global__ void __launch_bounds__(NWAVES * 64, 2) __attribute__((target("no-packed-fp32-ops"))) mk_fwd(Args args) {
    extern __shared__ __attribute__((aligned(16))) unsigned char lds_raw[];
    LAS unsigned char* lds = (LAS unsigned char*)lds_raw;
    volatile LAS unsigned* MISC = (volatile LAS unsigned*)(lds + MISC_OFF);
    const int tid = threadIdx.x, lane = tid & 63, wave = __builtin_amdgcn_readfirstlane(tid >> 6), G = gridDim.x, blk = blockIdx.x;
#define LW() (*(unsigned char* const __attribute__((address_space(4)))*)(KARG() + 424))
#define LO() (*(float* const __attribute__((address_space(4)))*)(KARG() + 416))
#define PTRS unsigned char* ws = LW(); float* out = LO(); float* MODS = (float*)(ws + WS_MODS); float* SP = (float*)(ws + WS_SP); bf16* H = (bf16*)(ws + WS_H); float* Z = (float*)(ws + WS_Z); bf16* ACT = (bf16*)(ws + WS_ACT); float* X = out; \
    (void)MODS; (void)SP; (void)H; (void)Z; (void)ACT; (void)X
    for (int u = tid; u < (LDS_BYTES - LDSCTL_OFF) / 4; u += NWAVES * 64) ((LAS unsigned*)(lds + LDSCTL_OFF))[u] = 0u;
    __syncthreads();
    { XcdBarrier b0_ = xcd_barrier_post((unsigned*)(LW() + WS_CTL) + CW_BAR, MISC + 8); (void)b0_; }
#define GRID_BAR() do { XcdBarrier b_; b_.bar = (unsigned*)(LW() + WS_CTL) + CW_BAR; b_.x = xb_xcc_id(); b_.st = MISC + 8; xcd_barrier(b_); if (XP == 6) xcd_barrier(b_); \
        if (PROBE && blk == 0 && tid == 0) ((unsigned long long*)(LW() + WS_CTL + 524288))[nst] = rt(); ++nst; } while (0)
    int nst = 0;
    if (PROBE && blk == 0 && tid == 0) ((unsigned long long*)(LW() + WS_CTL + 524288))[63] = rt();
    const int gw = blk * NWAVES + wave, NGW = G * NWAVES;
    const int gws = wave * G + blk;
    LAS float* wscr = (LAS float*)(lds + RING_OFF + wave * 16384);
    const int NP0 = G > 72 ? (G - 72) * NWAVES * P0_PER : 0;

    for (int xrep = 0; xrep < (XP == 1 ? 2 : 1); ++xrep) { PTRS;
        { float* STt = (float*)(ws + WS_ST); for (int i = blk * 512 + tid; i < 144 * 1024; i += G * 512) { const int r = i >> 10, k = i & 1023; float v = 0.f; if (r < 8) v = siluf_(INP(7)[r * 1024 + k]); else if (r < 136) v = siluf_(INP(8)[(r - 8) * 1024 + k]); STt[k * 144 + r] = v; } }
        for (int it = blk * 512 + tid; it < 2048 * 18; it += G * 512) { const int i = it & 2047, tau = it >> 11;
            if (tau == 17) s5prep_one(i, INP(24), INP(25), INP(26), INP(27), INP(28), SP); else s5prep_pw(i, tau, INP(24), INP(25), INP(26), SP); }
        if (blk >= 72) for (int it = (blk - 72) * NWAVES + wave; it < NP0; it += (G - 72) * NWAVES) cvt_dispatch(it, ws, wscr, lane);
    }
    GRID_BAR();
    for (int xq = 0; xq < (XP == 17 ? 2 : 1); ++xq) { PTRS; bf16* TM = (bf16*)(ws + WS_TM); bf16* HM = (bf16*)(ws + WS_HM);
        constexpr int NMW = 864, HS = MODS_HS;
        for (int xr = 0; xr < (XP == 10 ? 2 : 1); ++xr) for (int j = gws; j < NMW; j += NGW) { int cg, rs; if (j < 768) { cg = j & 255; rs = j >> 8; } else { const int e = j - 768; cg = 256 + e / 3; rs = e - (e / 3) * 3; }
            mods_job3(__builtin_amdgcn_readfirstlane(cg), __builtin_amdgcn_readfirstlane(rs), lane, (const float*)(ws + WS_ST), INPD(9), INPD(10), MODS); }
        const int ncw = NGW - NMW, NA = ncw > 0 ? (NP0 + HS * ncw < NITEMS ? NP0 + HS * ncw : NITEMS) : NP0;
        for (int xc = 0; xc < (XP == 19 ? 2 : 1); ++xc) { bool stA = (gws >= NMW) && NA > NP0;
        for (int itn = stA ? NP0 + gws - NMW : NA + (NGW - 1 - gws); itn < NITEMS; ) {
            int r = itn;
            if (stA) { itn += ncw; if (itn >= NA) { stA = false; itn = NA + (NGW - 1 - gws); } } else itn += NGW;
            cvt_dispatch(r, ws, wscr, lane);
        } }
        for (int xr = 0; xr < (XP == 20 ? 2 : 1); ++xr) for (int j = NGW - 1 - gws; j < 32 * 17 + 32 * 16; j += NGW) { if (j < 544) s5_tm_job(j / 17, j % 17, lane, SP, INPD(29), INPD(30), INPD(31), TM); else s5_hm_job((j - 544) >> 4, (j - 544) & 15, lane, SP, HM); }
        for (int i = gw * 64 + lane; i < 32 * 128 * 256 / 8; i += NGW * 64) { const int g = i >> 12, r = i & 4095; *(v4u*)(HM + ((size_t)g * 256 + 128) * 256 + (size_t)r * 8) = (v4u){0u, 0u, 0u, 0u}; } }
    GRID_BAR();
    { PTRS; for (int xr = 0; xr < (XP == 18 ? 2 : 1); ++xr) { int row = gw; for (; row + 3 * NGW < NP; row += 4 * NGW) init_rows<4>(row, NGW, lane, INP(0), MODS, H); for (; row < MTP; row += NGW) init_row(row, lane, INP(0), INP(1), MODS, X, H, (float*)(ws + WS_ZS)); } }
    GRID_BAR();

#define GEMM_PHASE(EPI, Aptr, Bptr, NN, KK, ...) do { pg8::GemmX g_{(const pg8::bf16_t*)(Aptr), (const pg8::bf16_t*)(Bptr), MTP, NN, KK, KK, KK, -1}; pg8::StaticOrder S_; S_.init(MTP, NN, G, blk); pg8::EPI E_{__VA_ARGS__}; \
        pg8::gemm_phase<pg8::EPI, pg8::StaticOrder, true, true>(lds + RING_OFF, g_, S_, E_); } while (0)
#define GEMMX_PHASE(EPI, Aptr, Bptr, MM, NN, KK, LDA, LDB, GSH, ...) do { pg8::GemmX g_{(const pg8::bf16_t*)(Aptr), (const pg8::bf16_t*)(Bptr), MM, NN, KK, LDA, LDB, GSH}; pg8::StaticOrder S_; S_.init(MM, NN, G, blk); pg8::EPI E_{__VA_ARGS__}; \
        pg8::gemm_phase<pg8::EPI, pg8::StaticOrder, true, true>(lds + RING_OFF, g_, S_, E_); } while (0)
#define RESID_PHASE(XS, Aptr, Bptr, KK, gatep, rcv) do { \
        { pg8::GemmX g_{(const pg8::bf16_t*)(Aptr), (const pg8::bf16_t*)(Bptr), NP, D, KK, KK, KK, -1}; pg8::StaticOrder S_; S_.init(NP, D, G, blk); pg8::EpiResid E_{(XS), Z, gatep, rcv, 0}; \
          pg8::gemm_phase<pg8::EpiResid, pg8::StaticOrder, true, true>(lds + RING_OFF, g_, S_, E_); } \
        { pg8::GemmX g_{(const pg8::bf16_t*)(Aptr), (const pg8::bf16_t*)(Bptr), MTP, D, 256, KK, KK, -1}; pg8::SplitOrder S_{64, 4, (KK) / 256, 256, G, blk}; pg8::EpiResidS E_{(float*)(ws + WS_SL), gatep, rcv, 0}; \
          pg8::gemm_phase<pg8::EpiResidS, pg8::SplitOrder, true, true>(lds + RING_OFF, g_, S_, E_); } } while (0)
#define LN_PASS(l, idx, Hout, nsh, nsc) do { PTRS; const int nsl_ = ((idx) == 1) ? 4 : 11; int row = gw; for (; row + 3 * NGW < NP; row += 4 * NGW) ln_rows<4>(row, NGW, lane, Z, INP(11) + ((l) * 3 + (idx)) * D, INP(12) + ((l) * 3 + (idx)) * D, X, Hout, nsh, nsc); \
        for (; row < MT; row += NGW) ln_row(row, lane, Z, (float*)(ws + WS_ZS), (const float*)(ws + WS_SL), nsl_, INP(11) + ((l) * 3 + (idx)) * D, INP(12) + ((l) * 3 + (idx)) * D, X, Hout, nsh, nsc); } while (0)
#define FFN(XS, l, f, which0, lnidx, HOUT, nshw, nscw) do { \
        { PTRS; { int ru_ = (XP == 41 ? 2 : 1); asm volatile("" : "+s"(ru_)); for (int xu = 0; xu < ru_; ++xu) GEMM_PHASE(EpiSwiglu, H, ws + ((l) ? WS_WUP_L1 : WS_WUP_L0) + (f) * SZ_WUP, NUP, D, (pg8::bf16_t*)ACT); } if (XP == 2) { GEMM_PHASE(EpiSwiglu, H, ws + ((l) ? WS_WUP_L1 : WS_WUP_L0) + (f) * SZ_WUP, NUP, D, (pg8::bf16_t*)ACT); } if (XP == 42) { GEMM_PHASE(EpiHloc, H, ws + ((l) ? WS_WUP_L1 : WS_WUP_L0) + (f) * SZ_WUP, NUP, D, (float*)(ws + WS_Z)); } } GRID_BAR(); \
        { PTRS; RESID_PHASE(XS, ACT, ws + ((l) ? WS_WDN_L1 : WS_WDN_L0) + (f) * SZ_WDN, FFP, modp(MODS, l, (which0) + 2), 0.5f); if (XP == 3) { RESID_PHASE(XS, ACT, ws + ((l) ? WS_WDN_L1 : WS_WDN_L0) + (f) * SZ_WDN, FFP, modp(MODS, l, (which0) + 2), 0.5f); } } GRID_BAR(); \
        LN_PASS(l, lnidx, HOUT, nshw, nscw); if (XP == 4) { LN_PASS(l, lnidx, HOUT, nshw, nscw); } GRID_BAR(); } while (0)

    FFN(INP(0), 0, 0, 0, 0, H, modp(MODS, 0, 3), modp(MODS, 0, 4));
#define L0PTRS PTRS; bf16* P = (bf16*)(ws + WS_P); float* GKL = (float*)(ws + WS_GKL); float* OGS = (float*)(ws + WS_OGS) - (size_t)NP * 512; bf16* Z5 = (bf16*)(ws + WS_Z5); bf16* O = (bf16*)(ws + WS_O); \
        bf16* UB = (bf16*)(ws + WS_UBUF); float* HL = (float*)(ws + WS_HLOC); float* KV = (float*)(ws + WS_KV); float* DEC = (float*)(ws + WS_DEC); (void)P; (void)GKL; (void)OGS; (void)Z5; (void)O; (void)UB; (void)HL; (void)KV; (void)DEC
    { L0PTRS; for (int xr = 0; xr < (XP == 11 ? 2 : 1); ++xr) GEMM_PHASE(EpiInproj, H, ws + WS_WIN, NINP, D, (pg8::bf16_t*)P, GKL, (pg8::bf16_t*)UB); } GRID_BAR();
    for (int xr = 0; xr < (XP == 12 ? 2 : 1); ++xr) { if (xr) { GRID_BAR(); --nst; } L0PTRS;
        { int reps_ = (XP == 25 ? 2 : (XP == 26 ? 5 : 1)); asm volatile("" : "+s"(reps_)); for (int xh = 0; xh < reps_; ++xh) GEMMX_PHASE(EpiHloc, UB, ws + WS_HM, 32768, 256, 256, 384, 256, 2, HL); }
        for (int u = (blk + 128) & 255; u < 1024; u += 256) gla_unit_a(lds + RING_OFF, tid, u, P, GKL, INPD(21), INPD(22), KV, DEC);
    }
    GRID_BAR();
    { L0PTRS;
        if (blk >= 128) gla_scan_b((blk - 128) * 512 + tid, KV, DEC, out + O_GLA_P);
        else if (wave < 2) { const int j = wave * 128 + blk;
            for (int xr = 0; xr < (XP == 13 ? 2 : 1); ++xr) s5_carry_job(j >> 5, j & 31, lane, SP, HL, UB, out + O_S5RE_P, out + O_S5IM_P); }
        else for (int s = (wave - 2) * 128 + blk; s < 1536; s += 768) {
            if (s < 1024) gla_job(wscr, lane, s >> 3, (s >> 1) & 3, s & 1, P, GKL, INPD(21), INPD(22), NP, 1, INPD(2), out + O_GLA_S, OGS);
            else { const int j = s - 1024; s5_job(wscr, lane, j & 31, (j >> 5) * 8, 8, P, SP, INPD(29), INPD(30), INPD(31), NP, 1, INPD(3), INPD(4), out + O_S5RE_S, out + O_S5IM_S, Z5); } }
    } GRID_BAR();
    for (int xr = 0; xr < (XP == 14 ? 2 : 1); ++xr) { L0PTRS;
        GEMMX_PHASE(EpiS5Y, UB, ws + WS_TM, 32768, 256, 384, 384, 384, 2, (pg8::bf16_t*)Z5);
        for (int u = (blk + 128) & 255; u < 1024; u += 256) gla_unit_c(lds + RING_OFF, tid, u, P, GKL, INPD(21), INPD(22), KV, INPD(23), O);
        for (int w = NP * 4 + gw; w < MT * 4; w += NGW) gla_post_one(w, lane, OGS, P, INP(23), O); } GRID_BAR();
    { L0PTRS; { int rg_ = (XP == 24 ? 2 : 1); asm volatile("" : "+s"(rg_)); for (int xr = 0; xr < rg_; ++xr) GEMM_PHASE(EpiGlu, Z5, ws + WS_WGLU, 512, 512, (const pg8::bf16_t*)Z5, (pg8::bf16_t*)O, INP(33)); }
        if (XP == 40) { int rh_ = 2; asm volatile("" : "+s"(rh_)); for (int xr = 0; xr < rh_; ++xr) GEMM_PHASE(EpiHloc, Z5, ws + WS_WGLU, 512, 512, HL); } } GRID_BAR();
    { L0PTRS; RESID_PHASE(X, O, ws + WS_WOUT, D, modp(MODS, 0, 5), 1.0f); } GRID_BAR();
    LN_PASS(0, 1, H, modp(MODS, 0, 6), modp(MODS, 0, 7)); GRID_BAR();
    FFN(X, 0, 1, 6, 2, H, modp(MODS, 1, 0), modp(MODS, 1, 1));
    FFN(X, 1, 0, 0, 0, (bf16*)nullptr, (const float*)nullptr, (const float*)nullptr);
#define L1PTRS PTRS; bf16* A2 = (bf16*)(ws + WS_A2); bf16* R = (bf16*)(ws + WS_R); bf16* Kb = (bf16*)(ws + WS_K); bf16* V = (bf16*)(ws + WS_V); bf16* L1 = (bf16*)(ws + WS_L1A); \
        bf16* WRAW = (bf16*)(ws + WS_WRAW); bf16* YB = (bf16*)(ws + WS_YB); float* BON = (float*)(ws + WS_BON); bf16* AS = (bf16*)(ws + WS_AS); bf16* Gt = (bf16*)(ws + WS_G); (void)A2; (void)R; (void)Kb; (void)V; (void)L1; (void)WRAW; (void)YB; (void)BON; (void)AS; (void)Gt
    { L1PTRS; int row = gw; for (; row + 3 * NGW < NP; row += 4 * NGW) shiftcat_rows<4>(row, NGW, lane, X, MODS, A2, out); for (; row < MTP; row += NGW) shiftcat_row(row, lane, X, MODS, INP(5), A2, out); } GRID_BAR();
    { L1PTRS; GEMM_PHASE(EpiRk, A2, ws + WS_WRK, NRK, KRK, (pg8::bf16_t*)R, (size_t)MTP * D, (pg8::bf16_t*)L1); if (XP == 7) { GEMM_PHASE(EpiRk, A2, ws + WS_WRK, NRK, KRK, (pg8::bf16_t*)R, (size_t)MTP * D, (pg8::bf16_t*)L1); } } GRID_BAR();
    { L1PTRS; GEMM_PHASE(EpiLora2, L1, ws + WS_WL2, 3072, NL1, (pg8::bf16_t*)WRAW, (pg8::bf16_t*)AS, (pg8::bf16_t*)Gt, INP(42)); } GRID_BAR();
    if (XP == 21 || XP == 22) { L1PTRS; bf16* dY = (bf16*)(ws + WS_L0 + 32 * MiB); float* dB = (float*)(ws + WS_L0 + 26 * MiB); float* dS = (float*)(ws + WS_L0 + 25 * MiB + 524288);
        if (XP == 21) wkv_half<1>((LAS float*)(lds + RING_OFF), tid, 0, 0, 0, R, Kb, V, WRAW, AS, INPD(39), INPD(47), INPD(48), INPD(49), dY, dB, dS);
        else wkv_half<2>((LAS float*)(lds + RING_OFF), tid, 0, 0, 0, R, Kb, V, WRAW, AS, INPD(39), INPD(47), INPD(48), INPD(49), dY, dB, dS); __syncthreads(); }
    for (int xr = 0; xr < (XP == 5 ? 2 : 1); ++xr) { L1PTRS; wkv_half<0>((LAS float*)(lds + RING_OFF), tid, blk >> 5, (blk >> 1) & 15, blk & 1, R, Kb, V, WRAW, AS, INPD(39), INPD(47), INPD(48), INPD(49), YB, BON, out + O_WKV_P); if (XP == 5) __syncthreads(); } GRID_BAR();
    { L1PTRS;
        { int t = gw; for (; t + 3 * NGW < NP; t += 4 * NGW) wkv_ypass_rows4((size_t)t, (size_t)NGW, lane, YB, V, Gt, BON, INPD(50), INPD(51)); for (; t < NP; t += NGW) wkv_ypass_row((size_t)t, lane, YB, V, Gt, BON, INPD(50), INPD(51)); }
        for (int s = gws; s < 2048; s += NGW) wkv_job(wscr, lane, s >> 4, s & 15, R, Kb, V, WRAW, INPD(39), AS, Gt, INPD(47), INPD(48), INPD(49), INPD(50), INPD(51), NP, 1, INPD(6), out + O_WKV_S); }
    GRID_BAR();
    { L1PTRS; RESID_PHASE(X, Gt, ws + WS_WO, D, modp(MODS, 1, 5), 1.0f); } GRID_BAR();
    LN_PASS(1, 1, H, modp(MODS, 1, 6), modp(MODS, 1, 7)); GRID_BAR();
    { PTRS; GEMM_PHASE(EpiSwiglu, H, ws + WS_WUP_L1 + SZ_WUP, NUP, D, (pg8::bf16_t*)ACT); if (XP == 2) { GEMM_PHASE(EpiSwiglu, H, ws + WS_WUP_L1 + SZ_WUP, NUP, D, (pg8::bf16_t*)ACT); } } GRID_BAR();
    { PTRS; RESID_PHASE(X, ACT, ws + WS_WDN_L1 + SZ_WDN, FFP, modp(MODS, 1, 8), 0.5f); if (XP == 3) { RESID_PHASE(X, ACT, ws + WS_WDN_L1 + SZ_WDN, FFP, modp(MODS, 1, 8), 0.5f); } } GRID_BAR();
    LN_PASS(1, 2, (bf16*)nullptr, (const float*)nullptr, (const float*)nullptr); if (XP == 4) { LN_PASS(1, 2, (bf16*)nullptr, (const float*)nullptr, (const float*)nullptr); }
#if PROBE
    {
        __syncthreads();
        PTRS; const unsigned long long* TS = (const unsigned long long*)(ws + WS_CTL + 524288);
        const float v1 = (float)(TS[PROBE_A1] - TS[PROBE_A0]) * 0.01f, v2 = (float)(TS[PROBE_B1] - TS[PROBE_B0]) * 0.01f * 10.0f;
        for (int row = NP + gw; row < MT; row += NGW) for (int j = 0; j < 16; ++j) X[(size_t)row * D + j * 64 + lane] = v1;
        if (blk == 0 && tid == 0) out[O_WKV_S] = v2;
    }
#endif
}

extern "C" void kernel_launch(void* const* d_in, const int* in_sizes, int n_in, void* d_out, int out_size, void* d_ws, size_t ws_size, hipStream_t stream) {
    static int grid = 0;
    if (grid == 0) {
        if (n_in != 52 || ws_size < WS_END) { fprintf(stderr, "kernel_launch: unexpected n_in %d or ws %zu\n", n_in, ws_size); grid = -1; return; }
        int dev = 0, cus = 0, per_cu = 0;
        if (hipGetDevice(&dev) != hipSuccess || hipDeviceGetAttribute(&cus, hipDeviceAttributeMultiprocessorCount, dev) != hipSuccess) { grid = -1; return; }
        if (hipFuncSetAttribute((const void*)mk_fwd, hipFuncAttributeMaxDynamicSharedMemorySize, LDS_BYTES) != hipSuccess) { fprintf(stderr, "hipFuncSetAttribute failed\n"); grid = -1; return; }
        if (hipOccupancyMaxActiveBlocksPerMultiprocessor(&per_cu, (const void*)mk_fwd, NWAVES * 64, LDS_BYTES) != hipSuccess || per_cu < 1) { fprintf(stderr, "occupancy query: %d\n", per_cu); per_cu = 1; }
        (void)hipGetLastError();
        grid = cus;
    }
    if (grid < 0) return;
    (void)hipMemsetAsync((char*)d_ws + WS_CTL, 0, CTL_ZERO_BYTES, stream);
    Args a{};
    for (int i = 0; i < 52; ++i) a.in[i] = (const float*)d_in[i];
    a.out = (float*)d_out; a.ws = (unsigned char*)d_ws;
    hipLaunchKernelGGL(mk_fwd, dim3(grid), dim3(NWAVES * 64), LDS_BYTES, stream, a);
}
```

```cpp
#include <hip/hip_runtime.h>
#include <cstdint>
#include <cstdio>

#ifndef PROBE
#define PROBE 0
#endif
#define XP 0
#ifndef P0_PER
#define P0_PER 8
#endif
#ifndef MODS_HS
#define MODS_HS 6
#endif
#define PROBE_A0 63
#define PROBE_A1 1
#define PROBE_B0 1
#define PROBE_B1 4
typedef unsigned short bf16;
typedef short bf16x8 __attribute__((ext_vector_type(8)));
typedef float f32x4 __attribute__((ext_vector_type(4)));
#define DEVI __device__ __forceinline__
__device__ __forceinline__ void mk_syncthreads() { asm volatile("s_waitcnt vmcnt(0) lgkmcnt(0)" ::: "memory"); __builtin_amdgcn_s_barrier(); asm volatile("" ::: "memory"); }
#define __syncthreads() mk_syncthreads()

constexpr int D = 1024, NP = 16384, NS = 128, MT = NP + NS, MTP = 16640, TP = 2048, BP = 8;
constexpr int FF = 2752, FFP = 2816, NUP = 2 * FFP;
constexpr int NIN = 2064, NINP = 2304;
constexpr int NRK = 3584, KRK = 2048, NL1 = 384;
constexpr int NMODROW = 136;
constexpr float ALPHA = 1.41421356237309515f;

constexpr size_t O_Y = 0, O_GLA_P = 16908288, O_S5RE_P = 17170432, O_S5IM_P = 17186816, O_SHIFT_P = 17203200, O_WKV_P = 17211392,
                 O_GLA_S = 17735680, O_S5RE_S = 21929984, O_S5IM_S = 22192128, O_SHIFT_S = 22454272, O_WKV_S = 22585344;

constexpr size_t MiB = 1u << 20;
constexpr size_t WS_CTL = 0, CTL_ZERO_BYTES = 1 * MiB;
constexpr size_t WS_MODS = 1 * MiB, WS_SP = 12 * MiB, WS_ST = 344 * MiB, WS_ZS = 345 * MiB, WS_SL = 336 * MiB;
constexpr size_t WS_W = 13 * MiB;
constexpr size_t SZ_WUP = (size_t)NUP * D * 2;
constexpr size_t SZ_WDN = (size_t)D * FFP * 2;
constexpr size_t WS_L0 = WS_W;
constexpr size_t WS_WUP_L0 = WS_L0, WS_WDN_L0 = WS_L0 + 22 * MiB, WS_WIN = WS_L0 + 33 * MiB, WS_WGLU = WS_WIN + 4608 * 1024, WS_WOUT = WS_WGLU + 512 * 1024;
constexpr size_t WS_L1 = WS_L0 + 40 * MiB;
constexpr size_t WS_WUP_L1 = WS_L1, WS_WDN_L1 = WS_L1 + 22 * MiB, WS_WRK = WS_L1 + 33 * MiB, WS_WL2 = WS_WRK + 14 * MiB, WS_WO = WS_WL2 + 2304 * 1024;
static_assert(WS_WO + 2 * MiB <= 105 * MiB, "W region");
constexpr size_t WS_H = 105 * MiB, WS_Z = 138 * MiB, WS_ACT = 203 * MiB, WS_S2 = 293 * MiB, WS_END = 346 * MiB;
constexpr size_t WS_P = WS_ACT, WS_GKL = 277 * MiB, WS_Z5 = WS_Z, WS_O = WS_H, WS_DEC = 195 * MiB, WS_OGS = 196 * MiB, WS_KV = WS_S2;
constexpr size_t WS_UBUF = 155 * MiB, WS_HLOC = 179 * MiB, WS_HM = 326 * MiB, WS_TM = 330 * MiB;
constexpr size_t WS_A2 = WS_ACT, WS_K = WS_Z, WS_R = WS_Z - (size_t)MTP * D * 2, WS_V = WS_Z + (size_t)MTP * D * 2, WS_L1A = WS_L0, WS_WRAW = WS_ACT, WS_YB = WS_ACT + (size_t)MTP * D * 2, WS_BON = WS_L0 + 30 * MiB, WS_AS = 268 * MiB, WS_G = WS_AS + (size_t)MTP * D * 2;
static_assert(WS_G + (size_t)MTP * D * 2 <= WS_END, "ws");
constexpr int CW_TMO = 0, CW_BAR = 4096;

#define GAS __attribute__((address_space(1)))
#define LAS __attribute__((address_space(3)))
typedef unsigned short bf16;
typedef unsigned v4u __attribute__((ext_vector_type(4)));
typedef float f32x4 __attribute__((ext_vector_type(4)));
typedef short bf16x8 __attribute__((ext_vector_type(8)));
typedef GAS unsigned gu32;
typedef GAS unsigned long long gu64;
#define RLX_AGENT __ATOMIC_RELAXED, __HIP_MEMORY_SCOPE_AGENT
#define LDS_WAIT() asm volatile("s_waitcnt lgkmcnt(0)" ::: "memory")
#define VM_WAIT() asm volatile("s_waitcnt vmcnt(0)" ::: "memory")
__device__ __forceinline__ unsigned long long rt() { return __builtin_amdgcn_s_memrealtime(); }
__device__ __forceinline__ unsigned f2bf(float f) { unsigned u = __builtin_bit_cast(unsigned, f); return (u + 0x7fffu + ((u >> 16) & 1u)) >> 16; }
__device__ __forceinline__ unsigned pk2(float lo, float hi) { return f2bf(lo) | (f2bf(hi) << 16); }

#define XB_TMO      128
#define XB_XCNT(j)  (256  + 64 * (j))
#define XB_XSUB(j)  (1280 + 64 * (j))
#define XB_XGEN(j)  (2304 + 64 * (j))
#define XB_TOP      3328
#define XB_TOPGEN   3392
#define XCD_BAR_WORDS 3456
#define XB_SPIN_CAP (1u << 18)

__device__ __forceinline__ unsigned xb_ld(unsigned* p)              { return __hip_atomic_load(p, __ATOMIC_RELAXED, __HIP_MEMORY_SCOPE_AGENT); }
__device__ __forceinline__ unsigned xb_add(unsigned* p, unsigned v) { return __hip_atomic_fetch_add(p, v, __ATOMIC_RELAXED, __HIP_MEMORY_SCOPE_AGENT); }
__device__ __forceinline__ unsigned xb_xcc_id() { return (unsigned)__builtin_amdgcn_s_getreg((3 << 11) | 20) & 0xFu; }
#define XB_SPIN(cond, bar) do { unsigned _sp = 0; while (cond) { __builtin_amdgcn_s_sleep(1); \
    if ((++_sp & 255u) == 0u) { if (xb_ld(&(bar)[XB_TMO])) break; if (_sp > XB_SPIN_CAP) { atomicAdd(&(bar)[XB_TMO], 1u); break; } } } } while (0)

struct XcdBarrier {
    unsigned* bar; unsigned x;
    volatile LAS unsigned* st;
};

__device__ __forceinline__ XcdBarrier xcd_barrier_post(unsigned* bar, volatile LAS unsigned* st) {
    XcdBarrier b; b.bar = bar; b.x = xb_xcc_id(); b.st = st;
    if (threadIdx.x == 0) (void)xb_add(&bar[XB_XCNT(b.x)], 1u);
    return b;
}
__device__ __forceinline__ void xcd_barrier_complete(unsigned* bar, unsigned x, unsigned& nloc, unsigned& nx) {
    const unsigned G = gridDim.x * gridDim.y * gridDim.z;
    unsigned sum, cnt, mine, sp = 0u;
    for (;;) {
        sum = 0u; cnt = 0u; mine = 0u;
#pragma unroll
        for (unsigned j = 0; j < 16; ++j) { const unsigned c = xb_ld(&bar[XB_XCNT(j)]); sum += c; cnt += (c > 0u) ? 1u : 0u; mine = (j == x) ? c : mine; }
        if (sum == G) break;
        __builtin_amdgcn_s_sleep(1);
        if ((++sp & 255u) == 0u) { if (xb_ld(&bar[XB_TMO])) break; if (sp > XB_SPIN_CAP) { atomicAdd(&bar[XB_TMO], 1u); break; } }
    }
    nloc = mine > 0u ? mine : 1u; nx = cnt > 0u ? cnt : 1u;
}

__device__ __forceinline__ void xcd_barrier(const XcdBarrier& b) {
    asm volatile("s_waitcnt vmcnt(0)" ::: "memory");
    __syncthreads();
    if (threadIdx.x == 0) {
        unsigned* bar = b.bar;
        __builtin_amdgcn_s_waitcnt(0);
        unsigned nloc = b.st[0], nx = b.st[1];
        if (nloc == 0u) { xcd_barrier_complete(bar, b.x, nloc, nx); b.st[0] = nloc; b.st[1] = nx; }
        const unsigned old = xb_add(&bar[XB_XSUB(b.x)], 1u);
        const unsigned gen = old / nloc;
        if (old + 1u == (gen + 1u) * nloc) {
            __builtin_amdgcn_fence(__ATOMIC_RELEASE, "agent");
            asm volatile("s_waitcnt vmcnt(0)" ::: "memory");
            const unsigned og = xb_add(&bar[XB_TOP], 1u);
            const unsigned tg = og / nx;
            if (og + 1u == (tg + 1u) * nx) xb_add(&bar[XB_TOPGEN], 1u);
            else XB_SPIN(xb_ld(&bar[XB_TOPGEN]) == tg, bar);
            __builtin_amdgcn_fence(__ATOMIC_ACQUIRE, "agent");
            xb_add(&bar[XB_XGEN(b.x)], 1u);
            asm volatile("s_waitcnt vmcnt(0)" ::: "memory");
        } else {
            XB_SPIN(xb_ld(&bar[XB_XGEN(b.x)]) == gen, bar);
            __builtin_amdgcn_fence(__ATOMIC_ACQUIRE, "agent");
            asm volatile("s_waitcnt vmcnt(0)" ::: "memory");
        }
    }
    __syncthreads();
}

DEVI float bf2f(unsigned short h) { return __uint_as_float(((unsigned)h) << 16); }
DEVI int mrow(int i) { return i < NP ? (i >> 11) : (8 + i - NP); }
DEVI float sigmoidf_(float x) { return 1.0f / (1.0f + __expf(-x)); }
DEVI float siluf_(float x) { return x / (1.0f + __expf(-x)); }
DEVI float softplusf_(float x) { return fmaxf(x, 0.f) + log1pf(__expf(-fabsf(x))); }
DEVI float gelu_tanh(float x) { const float u = 0.7978845608028654f * (x + 0.044715f * x * x * x); return 0.5f * x * (1.0f + tanhf(u)); }
DEVI float wave_sum(float v) {
#pragma unroll
    for (int o = 1; o < 64; o <<= 1) v += __shfl_xor(v, o);
    return v;
}
__host__ __device__ __forceinline__ const float* modp(const float* mods, int l, int which) { return mods + (size_t)l * NMODROW * 9216 + which * 1024; }

namespace pg8 {
#define PG8_LAS __attribute__((address_space(3)))
typedef unsigned short bf16_t;
typedef short bf16x8 __attribute__((ext_vector_type(8)));
typedef float f32x4 __attribute__((ext_vector_type(4)));
typedef unsigned u32x4 __attribute__((ext_vector_type(4)));
constexpr int BM = 256, BK = 64, HALF = 128, HTB = HALF * BK * 2  , STAGE_BYTES = 8 * HTB, NXCD = 8, WGM = 8;

__host__ __device__ __forceinline__ int lds_byte(int r, int c) { const int st = (r >> 4) * 2 + (c >> 5), rr = r & 15, cc = c & 31, ob = rr * 64 + cc * 2; return st * 1024 + (ob ^ (((ob >> 9) & 1) << 5)); }
__host__ __device__ __forceinline__ void stage_rc(int b, int& R, int& C) { const int st = b / 1024, sb = b % 1024, swz = sb ^ (((sb >> 9) & 1) << 5); R = (st >> 1) * 16 + swz / 64; C = (st & 1) * 32 + (swz % 64) / 2; }
__host__ __device__ __forceinline__ int perm32(int rho) { const int n = rho >> 4, i = rho & 15; return 8 * (i >> 2) + 4 * n + (i & 3); }

struct Unit { int pm, pn, ko; };
struct Gemm { const bf16_t* A; const bf16_t* Bt; int M, N, K; };
struct GemmX { const bf16_t* A; const bf16_t* Bt; int M, N, K, lda, ldb, gsh; };

struct StaticOrder {
    int nM, nN, nwg, G, c;
    __host__ __device__ __forceinline__ void init(int M, int N, int G_, int c_) { nM = M / BM; nN = N / BM; nwg = nM * nN; G = G_; c = c_; }
    __host__ __device__ __forceinline__ bool next(int i, Unit& u) const {
        const long L = (long)i * G + c; if (L >= nwg) return false;
        int wgid = (int)L; { const int q = nwg / NXCD, r = nwg % NXCD, xcd = wgid % NXCD, off = wgid / NXCD; wgid = (xcd < r ? xcd * (q + 1) : r * (q + 1) + (xcd - r) * q) + off; }
        const int nig = WGM * nN, gid = wgid / nig, fm = gid * WGM, gsz = (nM - fm) < WGM ? (nM - fm) : WGM;
        u.pm = fm + ((wgid % nig) % gsz); u.pn = (wgid % nig) / gsz; u.ko = 0; return true;
    }
    __device__ __forceinline__ void a_ready(const Unit&) const {}
    __device__ __forceinline__ void done(const Unit&) const {}
};

struct SplitOrder {
    int pm0, nN, nsplit, kspl, G, c;
    __host__ __device__ __forceinline__ bool next(int i, Unit& u) const { const int L = i * G + c; if (L >= nsplit * nN) return false; u.pm = pm0; u.pn = L % nN; u.ko = (L / nN) * kspl; return true; }
    __device__ __forceinline__ void a_ready(const Unit&) const {}
    __device__ __forceinline__ void done(const Unit&) const {}
};

__device__ __forceinline__ unsigned cvt_pk_bf16(float lo, float hi) { unsigned r; asm volatile("v_cvt_pk_bf16_f32 %0, %1, %2" : "=v"(r) : "v"(lo), "v"(hi)); return r; }
__device__ __forceinline__ float fsilu(float x) { return x * __builtin_amdgcn_rcpf(1.0f + __builtin_amdgcn_exp2f(-1.44269504089f * x)); }
__device__ __forceinline__ float fsigm(float x) { return __builtin_amdgcn_rcpf(1.0f + __builtin_amdgcn_exp2f(-1.44269504089f * x)); }
__device__ __forceinline__ u32x4 pack8(const f32x4 a, const f32x4 b) { u32x4 w; w.x = cvt_pk_bf16(a[0], a[1]); w.y = cvt_pk_bf16(a[2], a[3]); w.z = cvt_pk_bf16(b[0], b[1]); w.w = cvt_pk_bf16(b[2], b[3]); return w; }
struct EpiSwiglu { static constexpr bool PERM = true, AFTER_DRAIN = false; bf16_t* ACT;
    __device__ __forceinline__ void operator()(const f32x4 (&acc)[2][2][4][2], const Unit& u, int wr, int wc, int fr, int fq) const {
        const int row0 = u.pm * BM + wr * 64 + fr, col0 = u.pn * 128 + wc * 32 + 8 * fq;
#pragma unroll
        for (int ai = 0; ai < 2; ++ai)
#pragma unroll
            for (int m = 0; m < 4; ++m) { f32x4 o0, o1;
#pragma unroll
                for (int e = 0; e < 4; ++e) { o0[e] = fsilu(acc[ai][0][m][0][e]) * acc[ai][1][m][0][e]; o1[e] = fsilu(acc[ai][0][m][1][e]) * acc[ai][1][m][1][e]; }
                *(u32x4*)(ACT + (size_t)(row0 + ai * HALF + m * 16) * 2816 + col0) = pack8(o0, o1); }
    } };
struct EpiResid { static constexpr bool PERM = true, AFTER_DRAIN = false; const float* X; float* Z; const float* gate; float rc; int pad;
    __device__ __forceinline__ void operator()(const f32x4 (&acc)[2][2][4][2], const Unit& u, int wr, int wc, int fr, int fq) const {
        const float* __restrict__ xp = X + (size_t)(u.pm * BM + wr * 64 + fr) * 1024 + u.pn * BM + wc * 32 + 8 * fq; float* __restrict__ zp = Z + (size_t)(u.pm * BM + wr * 64 + fr) * 1024 + u.pn * BM + wc * 32 + 8 * fq;
        const float* __restrict__ gp = gate + (size_t)(u.pm >> 3) * 9216 + u.pn * BM + wc * 32 + 8 * fq;
        f32x4 g[2][2], xa[2][2], xb[2][2];
#pragma unroll
        for (int bj = 0; bj < 2; ++bj)
#pragma unroll
            for (int n = 0; n < 2; ++n) { g[bj][n] = (*(const f32x4*)(gp + bj * HALF + 4 * n) + 1.0f) * rc; xa[bj][n] = *(const f32x4*)(xp + bj * HALF + 4 * n); }
#pragma unroll
        for (int i = 0; i < 8; ++i) { const int ai = i >> 2, m = i & 3; const size_t ro = (size_t)(ai * HALF + m * 16) * 1024;
            if (i + 1 < 8) { const size_t rn = (size_t)(((i + 1) >> 2) * HALF + ((i + 1) & 3) * 16) * 1024;
#pragma unroll
                for (int bj = 0; bj < 2; ++bj)
#pragma unroll
                    for (int n = 0; n < 2; ++n) { if (i & 1) xa[bj][n] = *(const f32x4*)(xp + rn + bj * HALF + 4 * n); else xb[bj][n] = *(const f32x4*)(xp + rn + bj * HALF + 4 * n); } }
#pragma unroll
            for (int bj = 0; bj < 2; ++bj)
#pragma unroll
                for (int n = 0; n < 2; ++n) { const f32x4 x = (i & 1) ? xb[bj][n] : xa[bj][n]; *(f32x4*)(zp + ro + bj * HALF + 4 * n) = x * 1.41421356237309515f + g[bj][n] * acc[ai][bj][m][n]; } }
    } };
struct EpiInproj { static constexpr bool PERM = true, AFTER_DRAIN = false; bf16_t* P; float* GKL; bf16_t* UB;
    __device__ __forceinline__ void operator()(const f32x4 (&acc)[2][2][4][2], const Unit& u, int wr, int wc, int fr, int fq) const {
        const int row0 = u.pm * BM + wr * 64 + fr;
#pragma unroll
        for (int ai = 0; ai < 2; ++ai)
#pragma unroll
            for (int m = 0; m < 4; ++m) { const int row = row0 + ai * HALF + m * 16;
#pragma unroll
                for (int bj = 0; bj < 2; ++bj) { const int c = u.pn * BM + bj * HALF + wc * 32 + 8 * fq;
                    const u32x4 pk = pack8(acc[ai][bj][m][0], acc[ai][bj][m][1]);
                    *(u32x4*)(P + (size_t)row * 2304 + c) = pk;
                    if (c >= 1552 && c < 2064 && row < 16384) { const int cu = c - 1552; *(u32x4*)(UB + ((size_t)((cu >> 4) * 1024 + (row >> 4))) * 384 + (row & 15) * 16 + (cu & 15)) = pk; }
                    if (c >= 1536 && c < 1552) { *(f32x4*)(GKL + (size_t)row * 16 + (c - 1536)) = acc[ai][bj][m][0]; *(f32x4*)(GKL + (size_t)row * 16 + (c - 1536) + 4) = acc[ai][bj][m][1]; } } }
    } };
struct EpiGlu { static constexpr bool PERM = true, AFTER_DRAIN = false; const bf16_t* Z5; bf16_t* O; const float* bg;
    __device__ __forceinline__ void operator()(const f32x4 (&acc)[2][2][4][2], const Unit& u, int wr, int wc, int fr, int fq) const {
        const int cb = u.pn * BM + wc * 32 + 8 * fq;
        const bf16_t* __restrict__ zp = Z5 + (size_t)(u.pm * BM + wr * 64 + fr) * 512 + cb; bf16_t* __restrict__ op = O + (size_t)(u.pm * BM + wr * 64 + fr) * 1024 + 512 + cb;
        f32x4 b[2][2]; u32x4 za[2], zb[2];
#pragma unroll
        for (int bj = 0; bj < 2; ++bj) { b[bj][0] = *(const f32x4*)(bg + cb + bj * HALF); b[bj][1] = *(const f32x4*)(bg + cb + bj * HALF + 4); za[bj] = *(const u32x4*)(zp + bj * HALF); }
#pragma unroll
        for (int i = 0; i < 8; ++i) { const int ai = i >> 2, m = i & 3; const size_t rr = (size_t)(ai * HALF + m * 16);
            if (i + 1 < 8) { const size_t rn = (size_t)(((i + 1) >> 2) * HALF + ((i + 1) & 3) * 16) * 512;
#pragma unroll
                for (int bj = 0; bj < 2; ++bj) { if (i & 1) za[bj] = *(const u32x4*)(zp + rn + bj * HALF); else zb[bj] = *(const u32x4*)(zp + rn + bj * HALF); } }
#pragma unroll
            for (int bj = 0; bj < 2; ++bj) { const u32x4 zz = (i & 1) ? zb[bj] : za[bj]; f32x4 o0, o1;
#pragma unroll
                for (int e = 0; e < 4; ++e) { const unsigned w0 = zz[e >> 1], w1 = zz[2 + (e >> 1)];
                    const float z0 = __uint_as_float((e & 1) ? (w0 & 0xffff0000u) : (w0 << 16)), z1 = __uint_as_float((e & 1) ? (w1 & 0xffff0000u) : (w1 << 16));
                    o0[e] = z0 * fsigm(acc[ai][bj][m][0][e] + b[bj][0][e]); o1[e] = z1 * fsigm(acc[ai][bj][m][1][e] + b[bj][1][e]); }
                *(u32x4*)(op + rr * 1024 + bj * HALF) = pack8(o0, o1); } }
    } };
__device__ __forceinline__ float ftanh(float x) { const float e = __builtin_amdgcn_exp2f(-2.88539008178f * fabsf(x)); const float t = (1.0f - e) * __builtin_amdgcn_rcpf(1.0f + e); return x < 0.f ? -t : t; }
struct EpiRk { static constexpr bool PERM = true, AFTER_DRAIN = false; bf16_t* R; size_t rkv_stride; bf16_t* L1;
    __device__ __forceinline__ void operator()(const f32x4 (&acc)[2][2][4][2], const Unit& u, int wr, int wc, int fr, int fq) const {
        const int row0 = u.pm * BM + wr * 64 + fr;
#pragma unroll
        for (int ai = 0; ai < 2; ++ai)
#pragma unroll
            for (int m = 0; m < 4; ++m) { const int row = row0 + ai * HALF + m * 16;
#pragma unroll
                for (int bj = 0; bj < 2; ++bj) { const int c = u.pn * BM + bj * HALF + wc * 32 + 8 * fq;
                    if (c < 3072) { bf16_t* dst = R + (size_t)(c >> 10) * rkv_stride; *(u32x4*)(dst + (size_t)row * 1024 + (c & 1023)) = pack8(acc[ai][bj][m][0], acc[ai][bj][m][1]); }
                    else { const int cc = c - 3072; if (cc < 384) { f32x4 o0 = acc[ai][bj][m][0], o1 = acc[ai][bj][m][1];
                        if (cc < 64) {
#pragma unroll
                            for (int e = 0; e < 4; ++e) { o0[e] = ftanh(o0[e]); o1[e] = ftanh(o1[e]); } }
                        else if (cc >= 128 && cc < 288) {
#pragma unroll
                            for (int e = 0; e < 4; ++e) { o0[e] = fsigm(o0[e]); o1[e] = fsigm(o1[e]); } }
                        else if (cc >= 288) { o0 = (f32x4){0.f, 0.f, 0.f, 0.f}; o1 = o0; }
                        *(u32x4*)(L1 + (size_t)row * 384 + cc) = pack8(o0, o1); } } } }
    } };
struct EpiLora2 { static constexpr bool PERM = true, AFTER_DRAIN = false; bf16_t* WRAW; bf16_t* AS; bf16_t* G; const float* a0;
    __device__ __forceinline__ void operator()(const f32x4 (&acc)[2][2][4][2], const Unit& u, int wr, int wc, int fr, int fq) const {
        const int row0 = u.pm * BM + wr * 64 + fr;
#pragma unroll
        for (int ai = 0; ai < 2; ++ai)
#pragma unroll
            for (int m = 0; m < 4; ++m) { const int row = row0 + ai * HALF + m * 16;
#pragma unroll
                for (int bj = 0; bj < 2; ++bj) { const int c = u.pn * BM + bj * HALF + wc * 32 + 8 * fq;
                    if (c < 1024) *(u32x4*)(WRAW + (size_t)row * 1024 + c) = pack8(acc[ai][bj][m][0], acc[ai][bj][m][1]);
                    else if (c < 2048) { const f32x4 a0v = *(const f32x4*)(a0 + c - 1024), a1v = *(const f32x4*)(a0 + c - 1024 + 4); f32x4 o0, o1;
#pragma unroll
                        for (int e = 0; e < 4; ++e) { o0[e] = fsigm(a0v[e] + acc[ai][bj][m][0][e]); o1[e] = fsigm(a1v[e] + acc[ai][bj][m][1][e]); }
                        *(u32x4*)(AS + (size_t)row * 1024 + c - 1024) = pack8(o0, o1); }
                    else *(u32x4*)(G + (size_t)row * 1024 + c - 2048) = pack8(acc[ai][bj][m][0], acc[ai][bj][m][1]); } }
    } };
struct EpiHloc { static constexpr bool PERM = true, AFTER_DRAIN = false; float* HL;
    __device__ __forceinline__ void operator()(const f32x4 (&acc)[2][2][4][2], const Unit& u, int wr, int wc, int fr, int fq) const {
        const int row0 = u.pm * BM + wr * 64 + fr, c = wc * 32 + 8 * fq;
#pragma unroll
        for (int ai = 0; ai < 2; ++ai)
#pragma unroll
            for (int m = 0; m < 4; ++m) { float* p = HL + (size_t)(row0 + ai * HALF + m * 16) * 128 + c; *(f32x4*)p = acc[ai][0][m][0]; *(f32x4*)(p + 4) = acc[ai][0][m][1]; }
    } };
__device__ __forceinline__ float fgelu(float x) { const float u2 = 1.5957691216057308f * (x + 0.044715f * x * x * x); return x * fsigm(u2); }
struct EpiS5Y { static constexpr bool PERM = true, AFTER_DRAIN = false; bf16_t* Z5;
    __device__ __forceinline__ void operator()(const f32x4 (&acc)[2][2][4][2], const Unit& u, int wr, int wc, int fr, int fq) const {
        const int row0 = u.pm * BM + wr * 64 + fr;
#pragma unroll
        for (int ai = 0; ai < 2; ++ai)
#pragma unroll
            for (int m = 0; m < 4; ++m) { const int row = row0 + ai * HALF + m * 16, g = row >> 10, chunk = row & 1023;
#pragma unroll
                for (int bj = 0; bj < 2; ++bj) { const int c = bj * HALF + wc * 32 + 8 * fq, t = c >> 4, co = c & 15; f32x4 o0, o1;
#pragma unroll
                    for (int e = 0; e < 4; ++e) { o0[e] = fgelu(acc[ai][bj][m][0][e]); o1[e] = fgelu(acc[ai][bj][m][1][e]); }
                    *(u32x4*)(Z5 + (size_t)(chunk * 16 + t) * 512 + g * 16 + co) = pack8(o0, o1); } }
    } };

struct EpiResidS { static constexpr bool PERM = true, AFTER_DRAIN = false; float* SL; const float* gate; float rc; int pad;
    __device__ __forceinline__ void operator()(const f32x4 (&acc)[2][2][4][2], const Unit& u, int wr, int wc, int fr, int fq) const {
        const int r0 = wr * 64 + fr; float* __restrict__ sl = SL + (size_t)(u.ko >> 8) * 128 * 1024;
#pragma unroll
        for (int m = 0; m < 4; ++m) { const int r = r0 + m * 16; const int mr = 8 + r;
#pragma unroll
            for (int bj = 0; bj < 2; ++bj)
#pragma unroll
                for (int n = 0; n < 2; ++n) { const int c = u.pn * BM + bj * HALF + wc * 32 + 8 * fq + 4 * n; const f32x4 g = *(const f32x4*)(gate + (size_t)mr * 9216 + c);
                    *(f32x4*)(sl + (size_t)r * 1024 + c) = (g + 1.0f) * rc * acc[0][bj][m][n]; } }
    } };
enum { EK_SWIGLU = 0, EK_RESID, EK_RESIDS, EK_INPROJ, EK_GLU, EK_RK, EK_LORA2, EK_HLOC, EK_S5Y };
struct EpiAny { static constexpr bool PERM = true, AFTER_DRAIN = false; int kind; void* p0; void* p1; const void* p2; const void* p3; float f0;
    __device__ __forceinline__ void operator()(const f32x4 (&acc)[2][2][4][2], const Unit& u, int wr, int wc, int fr, int fq) const {
        asm volatile("" : "+v"(fr), "+v"(fq));
        switch (kind) {
        case EK_SWIGLU: { EpiSwiglu e{(bf16_t*)p0}; e(acc, u, wr, wc, fr, fq); break; }
        case EK_RESID: { EpiResid e{(const float*)p0, (float*)p1, (const float*)p2, f0, 0}; e(acc, u, wr, wc, fr, fq); break; }
        case EK_RESIDS: { EpiResidS e{(float*)p0, (const float*)p2, f0, 0}; e(acc, u, wr, wc, fr, fq); break; }
        case EK_INPROJ: { EpiInproj e{(bf16_t*)p0, (float*)p1, (bf16_t*)p2}; e(acc, u, wr, wc, fr, fq); break; }
        case EK_GLU: { EpiGlu e{(const bf16_t*)p0, (bf16_t*)p1, (const float*)p2}; e(acc, u, wr, wc, fr, fq); break; }
        case EK_RK: { EpiRk e{(bf16_t*)p0, (size_t)16640 * 1024, (bf16_t*)p1}; e(acc, u, wr, wc, fr, fq); break; }
        case EK_LORA2: { EpiLora2 e{(bf16_t*)p0, (bf16_t*)p1, (bf16_t*)p2, (const float*)p3}; e(acc, u, wr, wc, fr, fq); break; }
        case EK_HLOC: { EpiHloc e{(float*)p0}; e(acc, u, wr, wc, fr, fq); break; }
        default: { EpiS5Y e{(bf16_t*)p0}; e(acc, u, wr, wc, fr, fq); break; }
        }
    } };
struct AnyOrder { StaticOrder so; SplitOrder sp; int split;
    __device__ __forceinline__ bool next(int i, Unit& u) const { return split ? sp.next(i, u) : so.next(i, u); }
    __device__ __forceinline__ void a_ready(const Unit&) const {}
    __device__ __forceinline__ void done(const Unit&) const {} };
template <class Epi, class Sched, bool ALIGN_EPI = false, bool SP2 = false>
__device__ __forceinline__ void gemm_phase(PG8_LAS unsigned char* lds, const GemmX g, const Sched& S, const Epi& E) {
    int tid_ = threadIdx.x; asm volatile("" : "+v"(tid_));
    const int tid = tid_, wid = __builtin_amdgcn_readfirstlane(tid >> 6), lane = tid & 63, wr = wid >> 2, wc = wid & 3, fr = lane & 15, fq = lane >> 4;
    int K_ = g.K; asm volatile("" : "+s"(K_));
    const int K = K_, nt = K / BK;
    int lda_ = g.lda, ldb_ = g.ldb; asm volatile("" : "+s"(lda_), "+s"(ldb_)); const int lda = lda_, ldb = ldb_, gsh = g.gsh, nNb = g.N / BM;
    unsigned voffA[2], voffB[2];
#pragma unroll
    for (int i = 0; i < 2; ++i) { int R, C; stage_rc(tid * 16 + i * 8192, R, C); const int Rb = Epi::PERM ? ((R & ~31) + perm32(R & 31)) : R;
        voffA[i] = (unsigned)(R * lda + C) * 2u; voffB[i] = (unsigned)(Rb * ldb + C) * 2u; }
    const size_t kstep = (size_t)(BK * 2);
    const size_t hstepA = (size_t)HALF * lda * 2, hstepB = (size_t)HALF * ldb * 2;
    const size_t tstepA = 2 * hstepA, tstepB = 2 * hstepB;
#define PG8_BTILE(u_) ((size_t)(gsh >= 0 ? ((u_).pm >> gsh) * nNb + (u_).pn : (u_).pn))
    const unsigned ldsw = (unsigned)wid * 1024u;
    const int aoff = lds_byte(wr * 64 + fr, fq * 8), boff = lds_byte(wc * 32 + fr, fq * 8);
#define PG8_SA(b, h) (((b) * 2 + (h)) * HTB)
#define PG8_SB(b, h) ((4 + (b) * 2 + (h)) * HTB)
#define PG8_STAGE(bufoff, gbase, voff) do { _Pragma("unroll") for (int _i = 0; _i < 2; ++_i) \
        __builtin_amdgcn_global_load_lds((const unsigned*)((const char*)(gbase) + (voff)[_i]), (PG8_LAS unsigned*)(lds + (bufoff) + ldsw + _i * 8192), 16, 0, 0); } while (0)
#define PG8_LDA(dst, b, h) do { _Pragma("unroll") for (int m = 0; m < 4; ++m) _Pragma("unroll") for (int k = 0; k < 2; ++k) dst[m][k] = *(const PG8_LAS bf16x8*)(lds + PG8_SA(b, h) + aoff + m * 2048 + k * 1024); } while (0)
#define PG8_LDB(dst, b, h) do { _Pragma("unroll") for (int n = 0; n < 2; ++n) _Pragma("unroll") for (int k = 0; k < 2; ++k) dst[n][k] = *(const PG8_LAS bf16x8*)(lds + PG8_SB(b, h) + boff + n * 2048 + k * 1024); } while (0)
#define PG8_MMA(ai, bj, At, Bt) do { __builtin_amdgcn_s_setprio(1); _Pragma("unroll") for (int m = 0; m < 4; ++m) _Pragma("unroll") for (int n = 0; n < 2; ++n) _Pragma("unroll") for (int k = 0; k < 2; ++k) \
        acc[ai][bj][m][n] = __builtin_amdgcn_mfma_f32_16x16x32_bf16(Bt[n][k], At[m][k], acc[ai][bj][m][n], 0, 0, 0); __builtin_amdgcn_s_setprio(0); } while (0)
#define PG8_WAIT_V(n) asm volatile("s_waitcnt vmcnt(" #n ")" ::: "memory")
#define PG8_WAIT_L(n) asm volatile("s_waitcnt lgkmcnt(" #n ")" ::: "memory")
#define PG8_BAR __builtin_amdgcn_s_barrier()
#define PG8_SCHED __builtin_amdgcn_sched_barrier(0)
    Unit cur, nxt; int ui = 0;
    if (!S.next(0, cur)) return;
    f32x4 acc[2][2][4][2];
#pragma unroll
    for (int a = 0; a < 2; ++a)
#pragma unroll
        for (int b = 0; b < 2; ++b)
#pragma unroll
            for (int m = 0; m < 4; ++m)
#pragma unroll
                for (int n = 0; n < 2; ++n) acc[a][b][m][n] = (f32x4){0.f, 0.f, 0.f, 0.f};
    bf16x8 At[4][2], B0[2][2], B1[2][2];
    const char* cA = (const char*)g.A + (size_t)cur.pm * tstepA + (size_t)cur.ko * 2; const char* cB = (const char*)g.Bt + PG8_BTILE(cur) * tstepB + (size_t)cur.ko * 2;
    S.a_ready(cur);
    if constexpr (SP2) {
        PG8_STAGE(PG8_SB(0, 0), cB, voffB); PG8_STAGE(PG8_SB(0, 1), cB + hstepB, voffB); PG8_STAGE(PG8_SA(0, 0), cA, voffA); PG8_STAGE(PG8_SA(0, 1), cA + hstepA, voffA);
        if (wr == 1) PG8_BAR;
        PG8_WAIT_V(2); PG8_BAR;
        PG8_STAGE(PG8_SB(1, 0), cB + kstep, voffB); PG8_STAGE(PG8_SA(1, 0), cA + kstep, voffA); PG8_STAGE(PG8_SB(1, 1), cB + hstepB + kstep, voffB);
        PG8_WAIT_V(6); PG8_BAR;
    } else {
        PG8_STAGE(PG8_SB(0, 0), cB, voffB); PG8_STAGE(PG8_SA(0, 0), cA, voffA); PG8_STAGE(PG8_SB(0, 1), cB + hstepB, voffB); PG8_STAGE(PG8_SA(0, 1), cA + hstepA, voffA);
        if (wr == 1) PG8_BAR;
        PG8_WAIT_V(4); PG8_BAR;
        PG8_STAGE(PG8_SB(1, 0), cB + kstep, voffB); PG8_STAGE(PG8_SA(1, 0), cA + kstep, voffA); PG8_STAGE(PG8_SB(1, 1), cB + hstepB + kstep, voffB);
        PG8_WAIT_V(6); PG8_BAR;
    }
    for (;;) {
        const bool has_next = S.next(ui + 1, nxt);
        const char* nA = has_next ? (const char*)g.A + (size_t)nxt.pm * tstepA + (size_t)nxt.ko * 2 : cA; const char* nB = has_next ? (const char*)g.Bt + PG8_BTILE(nxt) * tstepB + (size_t)nxt.ko * 2 : cB;
        for (int t = 0; t < nt; t += 2) {
            const bool last = (t == nt - 2);
            const char* a1 = cA + (size_t)(t + 1) * kstep;
            const char* a2 = last ? nA : cA + (size_t)(t + 2) * kstep; const char* b2 = last ? nB : cB + (size_t)(t + 2) * kstep;
            const char* a3 = a2 + kstep; const char* b3 = b2 + kstep;
            if (last && has_next) S.a_ready(nxt);
            if constexpr (SP2) {
            PG8_LDB(B0, 0, 0); PG8_LDB(B1, 0, 1); PG8_SCHED; PG8_LDA(At, 0, 0); PG8_STAGE(PG8_SA(1, 1), a1 + hstepA, voffA);
            PG8_WAIT_V(8); PG8_WAIT_L(0); PG8_BAR; PG8_MMA(0, 0, At, B0); PG8_MMA(0, 1, At, B1); PG8_BAR; PG8_SCHED;
            PG8_LDA(At, 0, 1); PG8_STAGE(PG8_SB(0, 0), b2, voffB); PG8_STAGE(PG8_SB(0, 1), b2 + hstepB, voffB); PG8_STAGE(PG8_SA(0, 0), a2, voffA);
            PG8_WAIT_V(8); PG8_WAIT_L(0); PG8_BAR; PG8_MMA(1, 0, At, B0); PG8_MMA(1, 1, At, B1); PG8_BAR; PG8_SCHED;
            PG8_LDB(B0, 1, 0); PG8_LDB(B1, 1, 1); PG8_SCHED; PG8_LDA(At, 1, 0); PG8_STAGE(PG8_SA(0, 1), a2 + hstepA, voffA);
            PG8_WAIT_V(8); PG8_WAIT_L(0); PG8_BAR; PG8_MMA(0, 0, At, B0); PG8_MMA(0, 1, At, B1); PG8_BAR; PG8_SCHED;
            PG8_LDA(At, 1, 1); PG8_STAGE(PG8_SB(1, 0), b3, voffB); PG8_STAGE(PG8_SB(1, 1), b3 + hstepB, voffB); PG8_STAGE(PG8_SA(1, 0), a3, voffA);
            PG8_WAIT_V(8); PG8_WAIT_L(0); PG8_BAR; PG8_MMA(1, 0, At, B0); PG8_MMA(1, 1, At, B1); PG8_BAR; PG8_SCHED;
            } else {
            PG8_LDB(B0, 0, 0); PG8_SCHED; PG8_LDA(At, 0, 0); PG8_STAGE(PG8_SA(1, 1), a1 + hstepA, voffA);
            PG8_WAIT_L(8); PG8_BAR; PG8_WAIT_L(0); PG8_MMA(0, 0, At, B0); PG8_BAR; PG8_SCHED;
            PG8_LDB(B1, 0, 1); PG8_STAGE(PG8_SB(0, 0), b2, voffB);
            PG8_BAR; PG8_WAIT_L(0); PG8_MMA(0, 1, At, B1); PG8_BAR;
            PG8_LDA(At, 0, 1); PG8_STAGE(PG8_SA(0, 0), a2, voffA);
            PG8_BAR; PG8_WAIT_L(0); PG8_MMA(1, 0, At, B0); PG8_BAR; PG8_SCHED;
            PG8_STAGE(PG8_SB(0, 1), b2 + hstepB, voffB);
            PG8_WAIT_V(6); PG8_BAR; PG8_MMA(1, 1, At, B1); PG8_BAR;
            PG8_LDB(B0, 1, 0); PG8_SCHED; PG8_LDA(At, 1, 0); PG8_STAGE(PG8_SA(0, 1), a2 + hstepA, voffA);
            PG8_WAIT_L(8); PG8_BAR; PG8_WAIT_L(0); PG8_MMA(0, 0, At, B0); PG8_BAR; PG8_SCHED;
            PG8_LDB(B1, 1, 1); PG8_STAGE(PG8_SB(1, 0), b3, voffB);
            PG8_BAR; PG8_WAIT_L(0); PG8_MMA(0, 1, At, B1); PG8_BAR;
            PG8_LDA(At, 1, 1); PG8_STAGE(PG8_SA(1, 0), a3, voffA);
            PG8_BAR; PG8_WAIT_L(0); PG8_MMA(1, 0, At, B0); PG8_BAR; PG8_SCHED;
            PG8_STAGE(PG8_SB(1, 1), b3 + hstepB, voffB);
            PG8_WAIT_V(6); PG8_BAR; PG8_MMA(1, 1, At, B1); PG8_BAR;
            }
        }
        if constexpr (ALIGN_EPI) { if (wr == 0) PG8_BAR; }
        if constexpr (!Epi::AFTER_DRAIN) { E(acc, cur, wr, wc, fr, fq); S.done(cur); }
        if (!has_next) break;
#pragma unroll
        for (int a = 0; a < 2; ++a)
#pragma unroll
            for (int b = 0; b < 2; ++b)
#pragma unroll
                for (int m = 0; m < 4; ++m)
#pragma unroll
                    for (int n = 0; n < 2; ++n) acc[a][b][m][n] = (f32x4){0.f, 0.f, 0.f, 0.f};
        cur = nxt; cA = nA; cB = nB; ++ui;
        if constexpr (ALIGN_EPI) { if (wr == 1) PG8_BAR; }
    }
    PG8_WAIT_V(0);
    if constexpr (!ALIGN_EPI) { if (wr == 0) PG8_BAR; }
    PG8_BAR;
    if constexpr (Epi::AFTER_DRAIN) { E.fused(acc, cur, wr, wc, fr, fq, lds, wid, lane); S.done(cur); }
#undef PG8_BTILE
#undef PG8_SA
#undef PG8_SB
#undef PG8_STAGE
#undef PG8_LDA
#undef PG8_LDB
#undef PG8_MMA
#undef PG8_WAIT_V
#undef PG8_WAIT_L
#undef PG8_BAR
#undef PG8_SCHED
}
}

constexpr int NWAVES = 8;
constexpr int RING_OFF = 0, RING_BYTES = 131072;
constexpr int LDSCTL_OFF = RING_BYTES, MISC_OFF = LDSCTL_OFF + 320;
constexpr int LDS_BYTES = 147456;

struct Args { const float* in[52]; float* out; unsigned char* ws; };
static_assert(sizeof(Args) == 432, "kernarg layout");

struct Frame {
    LAS unsigned char* lds; int tid, lane, wave, G, blk;
    const float* const* in; float* out; unsigned char* ws;
};
#define INP(i) INPD(i)
#define KARG() ({ const unsigned char __attribute__((address_space(4)))* k_ = (const unsigned char __attribute__((address_space(4)))*)__builtin_amdgcn_kernarg_segment_ptr(); asm volatile("" : "+s"(k_)); k_; })
#define INPD(i) (*(const float* const __attribute__((address_space(4)))*)(KARG() + 8 * (i)))

template <class Src>
DEVI void cvt_item(const Src src, bf16* WT, int Kd, int nblk, LAS float* scr, int item, int lane) {
    const int kb = item / nblk, nb = item % nblk, k0 = 64 * kb, n0 = 32 * nb;
    const int kr = lane >> 3, nq = (lane & 7) * 4;
    f32x4 v[8];
#pragma unroll
    for (int i = 0; i < 8; ++i) v[i] = src.load4(k0 + 8 * i + kr, n0 + nq);
#pragma unroll
    for (int i = 0; i < 8; ++i) { LAS float* s = scr + (8 * i + kr) * 33 + nq; s[0] = v[i][0]; s[1] = v[i][1]; s[2] = v[i][2]; s[3] = v[i][3]; }
    LDS_WAIT(); asm volatile("" ::: "memory");
    const int c = lane & 7;
#pragma unroll
    for (int j = 0; j < 4; ++j) { const int n = (lane >> 3) + 8 * j; const LAS float* s = scr + (8 * c) * 33 + n;
        v4u o; o.x = pk2(s[0 * 33], s[1 * 33]); o.y = pk2(s[2 * 33], s[3 * 33]); o.z = pk2(s[4 * 33], s[5 * 33]); o.w = pk2(s[6 * 33], s[7 * 33]);
        *(GAS v4u*)(WT + (size_t)(n0 + n) * Kd + k0 + 8 * c) = o; }
    LDS_WAIT(); asm volatile("" ::: "memory");
}
struct SrcPlain { const float* W; int K, N, ld; DEVI f32x4 load4(int k, int n) const { return (k < K && n < N) ? *(const f32x4*)(W + (size_t)k * ld + n) : (f32x4){0.f, 0.f, 0.f, 0.f}; } };
struct SrcFold { const float* W; const float* mu; int ld; DEVI f32x4 load4(int k, int n) const { const int kk = k & 1023; const float m = mu[kk]; return *(const f32x4*)(W + (size_t)kk * ld + n) * (k < 1024 ? m : (1.0f - m)); } };
struct SrcBlk { const float* W; int k0, k1; DEVI f32x4 load4(int k, int n) const { return (k >= k0 && k < k1) ? *(const f32x4*)(W + (size_t)(k - k0) * 1024 + n) : (f32x4){0.f, 0.f, 0.f, 0.f}; } };
struct SrcZero { DEVI f32x4 load4(int, int) const { return (f32x4){0.f, 0.f, 0.f, 0.f}; } };

DEVI void sincos_d(double x, double& s, double& c) {
    const double n = rint(x * 0.63661977236758134308);
    double r = fma(-n, 1.57079632679489655800e+00, x); r = fma(-n, 6.12323399573676603587e-17, r);
    const double r2 = r * r;
    double sp = -7.6471637318198164759e-13; sp = fma(sp, r2, 1.6059043836821614599e-10); sp = fma(sp, r2, -2.5052108385441718775e-08); sp = fma(sp, r2, 2.7557319223985890653e-06);
    sp = fma(sp, r2, -1.9841269841269841270e-04); sp = fma(sp, r2, 8.3333333333333333333e-03); sp = fma(sp, r2, -1.6666666666666666667e-01); const double sr = fma(sp * r2, r, r);
    double cp = 4.7794773323873852974e-14; cp = fma(cp, r2, -1.1470745597729724714e-11); cp = fma(cp, r2, 2.0876756987868098979e-09); cp = fma(cp, r2, -2.7557319223985890653e-07);
    cp = fma(cp, r2, 2.4801587301587301587e-05); cp = fma(cp, r2, -1.3888888888888888889e-03); cp = fma(cp, r2, 4.1666666666666666667e-02); cp = fma(cp, r2, -0.5); const double cr = fma(cp, r2, 1.0);
    const int q = ((int)n) & 3;
    s = (q == 0) ? sr : (q == 1) ? cr : (q == 2) ? -sr : -cr;
    c = (q == 0) ? cr : (q == 1) ? -sr : (q == 2) ? -cr : sr;
}
DEVI void s5prep_one(int i, const float* a_re, const float* a_im, const float* log_step, const float* b_re, const float* b_im, float* sp) {
    const int g = i >> 6;
    const double dt = exp((double)log_step[g]), ar = a_re[i], ai = a_im[i];
    const double mag = exp(ar * dt); double s, c; sincos_d(ai * dt, s, c);
    const double abr = mag * c, abi = mag * s, den = ar * ar + ai * ai, nr = abr - 1.0;
    const double zr = (nr * ar + abi * ai) / den, zi = (abi * ar - nr * ai) / den;
    sp[i] = (float)abr; sp[2048 + i] = (float)abi;
    for (int cc = 0; cc < 16; ++cc) { const double br = b_re[i * 16 + cc], bi = b_im[i * 16 + cc];
        sp[4096 + i * 16 + cc] = (float)(zr * br - zi * bi); sp[4096 + 32768 + i * 16 + cc] = (float)(zr * bi + zi * br); }
}


constexpr int SP_PW = 4096 + 65536;
DEVI void s5prep_pw(int i, int tau, const float* a_re, const float* a_im, const float* log_step, float* sp) {
    const int g = i >> 6; const double dt = exp((double)log_step[g]), ar = a_re[i], ai = a_im[i];
    const double mag = exp(ar * dt * tau); double s, c; sincos_d(ai * dt * tau, s, c); sp[SP_PW + i * 34 + tau * 2] = (float)(mag * c); sp[SP_PW + i * 34 + tau * 2 + 1] = (float)(mag * s);
}
DEVI void s5_tm_job(int g, int tau, int lane, const float* sp, const float* c_re, const float* c_im, const float* dd, bf16* TM) {
    bf16* tm = TM + (size_t)g * 256 * 384;
    if (tau <= 15) {
        const int co = lane >> 2, ci0 = (lane & 3) * 4; float kv[4] = {0.f, 0.f, 0.f, 0.f};
#pragma unroll 8
        for (int p = 0; p < 64; ++p) { const float pr = sp[SP_PW + (g * 64 + p) * 34 + tau * 2], pi = sp[SP_PW + (g * 64 + p) * 34 + tau * 2 + 1];
            const float cr = c_re[(g * 16 + co) * 64 + p], ci = c_im[(g * 16 + co) * 64 + p];
            const f32x4 br = *(const f32x4*)(sp + 4096 + (g * 64 + p) * 16 + ci0), bi = *(const f32x4*)(sp + 4096 + 32768 + (g * 64 + p) * 16 + ci0);
#pragma unroll
            for (int q = 0; q < 4; ++q) { const float wr = pr * br[q] - pi * bi[q], wi = pr * bi[q] + pi * br[q]; kv[q] += cr * wr - ci * wi; } }
        if (tau == 0) {
#pragma unroll
            for (int q = 0; q < 4; ++q) if (ci0 + q == co) kv[q] += dd[g * 16 + co]; }
        const unsigned long long pk = (unsigned long long)pk2(kv[0], kv[1]) | ((unsigned long long)pk2(kv[2], kv[3]) << 32);
        for (int t = tau; t < 16; ++t) *(unsigned long long*)(tm + (size_t)(t * 16 + co) * 384 + (t - tau) * 16 + ci0) = pk;
        if (tau >= 1) for (int t = 0; t + tau < 16; ++t) *(unsigned long long*)(tm + (size_t)(t * 16 + co) * 384 + (t + tau) * 16 + ci0) = 0ull;
    }
    if (tau >= 1) { const int t = tau - 1, p = lane; const float pr = sp[SP_PW + (g * 64 + p) * 34 + tau * 2], pi = sp[SP_PW + (g * 64 + p) * 34 + tau * 2 + 1];
#pragma unroll
        for (int co = 0; co < 16; ++co) { const float cr = c_re[(g * 16 + co) * 64 + p], ci = c_im[(g * 16 + co) * 64 + p];
            tm[(size_t)(t * 16 + co) * 384 + 256 + p] = (bf16)f2bf(cr * pr - ci * pi); tm[(size_t)(t * 16 + co) * 384 + 320 + p] = (bf16)f2bf(-(cr * pi + ci * pr)); } }
}
DEVI void s5_hm_job(int g, int s, int lane, const float* sp, bf16* HM) {
    const int p = lane; const float pr = sp[SP_PW + (g * 64 + p) * 34 + (15 - s) * 2], pi = sp[SP_PW + (g * 64 + p) * 34 + (15 - s) * 2 + 1];
    bf16* hr = HM + ((size_t)g * 256 + p) * 256 + s * 16; bf16* hi = hr + 64 * 256;
#pragma unroll
    for (int h8 = 0; h8 < 2; ++h8) { float wr[8], wi[8];
#pragma unroll
        for (int q = 0; q < 8; ++q) { const float br = sp[4096 + (g * 64 + p) * 16 + h8 * 8 + q], bi = sp[4096 + 32768 + (g * 64 + p) * 16 + h8 * 8 + q]; wr[q] = pr * br - pi * bi; wi[q] = pr * bi + pi * br; }
        v4u a, b; a.x = pk2(wr[0], wr[1]); a.y = pk2(wr[2], wr[3]); a.z = pk2(wr[4], wr[5]); a.w = pk2(wr[6], wr[7]); b.x = pk2(wi[0], wi[1]); b.y = pk2(wi[2], wi[3]); b.z = pk2(wi[4], wi[5]); b.w = pk2(wi[6], wi[7]);
        *(v4u*)(hr + h8 * 8) = a; *(v4u*)(hi + h8 * 8) = b; }
}
DEVI void s5_carry_job(int b, int g, int lane, const float* sp, const float* HL, bf16* UB, float* ore, float* oim) {
    const int p = lane; const float ar = sp[SP_PW + (g * 64 + p) * 34 + 32], ai = sp[SP_PW + (g * 64 + p) * 34 + 33];
    float cr = 0.f, ci = 0.f;
#pragma unroll 8
    for (int n = 0; n < 128; ++n) { const size_t row = (size_t)g * 1024 + b * 128 + n;
        UB[row * 384 + 256 + p] = (bf16)f2bf(cr); UB[row * 384 + 320 + p] = (bf16)f2bf(ci);
        const float hr = HL[row * 128 + p], hi = HL[row * 128 + 64 + p];
        const float nr = ar * cr - ai * ci + hr, ni = ar * ci + ai * cr + hi; cr = nr; ci = ni; }
    ore[((size_t)b * 32 + g) * 64 + p] = cr; oim[((size_t)b * 32 + g) * 64 + p] = ci;
}


template <int NT> DEVI void mods_half(int m0, int l, int n0, int lane, const float* __restrict__ ST, const float* __restrict__ ada_w, const float* __restrict__ ada_b, float* MODS) {
    const int i16 = lane & 15, kq = lane >> 4;
    f32x4 acc[NT];
#pragma unroll
    for (int m = 0; m < NT; ++m) acc[m] = (f32x4){0.f, 0.f, 0.f, 0.f};
    const float* w = ada_w + (size_t)l * 1024 * 9216 + (size_t)kq * 9216 + n0 + i16; const float* st = ST + kq * 144 + i16 + m0 * 16;
    float a[4][NT], bv[4];
#pragma unroll
    for (int s = 0; s < 4; ++s) { bv[s] = w[(size_t)(4 * s) * 9216];
#pragma unroll
        for (int m = 0; m < NT; ++m) a[s][m] = st[(4 * s) * 144 + m * 16]; }
    for (int k0 = 0; k0 < 1024; k0 += 16) {
#pragma unroll
        for (int s = 0; s < 4; ++s) {
#pragma unroll
            for (int m = 0; m < NT; ++m) acc[m] = __builtin_amdgcn_mfma_f32_16x16x4f32(a[s][m], bv[s], acc[m], 0, 0, 0);
            const int kn = k0 + 16 + 4 * s; if (kn < 1024) { bv[s] = w[(size_t)kn * 9216];
#pragma unroll
                for (int m = 0; m < NT; ++m) a[s][m] = st[kn * 144 + m * 16]; } } }
    const float bb = ada_b[l * 9216 + n0 + i16];
#pragma unroll
    for (int m = 0; m < NT; ++m)
#pragma unroll
        for (int q = 0; q < 4; ++q) { const int r = (m0 + m) * 16 + kq * 4 + q; if (r < NMODROW) MODS[((size_t)l * NMODROW + r) * 9216 + n0 + i16] = acc[m][q] + bb; }
}
DEVI void mods_job(int job, int lane, const float* __restrict__ ST, const float* __restrict__ ada_w, const float* __restrict__ ada_b, float* MODS) {
    asm volatile("" : "+v"(lane));
    const int mh = job & 1, jb = job >> 1, l = jb / 576, n0 = (jb % 576) * 16;
    if (mh) mods_half<4>(5, l, n0, lane, ST, ada_w, ada_b, MODS); else mods_half<5>(0, l, n0, lane, ST, ada_w, ada_b, MODS);
}

DEVI void mods_job3(int cg, int rs, int lane, const float* __restrict__ ST, const float* __restrict__ ada_w, const float* __restrict__ ada_b, float* MODS) {
    asm volatile("" : "+v"(lane));
    const int l = cg / 144, n0 = (cg % 144) * 64, i16 = lane & 15, kq = lane >> 4;
    f32x4 acc[3][4];
#pragma unroll
    for (int m = 0; m < 3; ++m)
#pragma unroll
        for (int c = 0; c < 4; ++c) acc[m][c] = (f32x4){0.f, 0.f, 0.f, 0.f};
    const float* w = ada_w + (size_t)l * 1024 * 9216 + (size_t)kq * 9216 + n0 + 4 * i16; const float* st = ST + kq * 144 + rs * 48 + i16;
    constexpr int DEP = 8;
    f32x4 bv[DEP]; float a[DEP][3];
#define MODS_LD(s, kn) do { const float* wp_ = w + (size_t)(kn) * 9216; const float* sp_ = st + (kn) * 144; \
        asm volatile("global_load_dwordx4 %0, %1, off" : "=v"(bv[s]) : "v"(wp_) : "memory"); \
        asm volatile("global_load_dword %0, %1, off" : "=v"(a[s][0]) : "v"(sp_) : "memory"); \
        asm volatile("global_load_dword %0, %1, off offset:64" : "=v"(a[s][1]) : "v"(sp_) : "memory"); \
        asm volatile("global_load_dword %0, %1, off offset:128" : "=v"(a[s][2]) : "v"(sp_) : "memory"); } while (0)
#define MODS_MM(s) do { _Pragma("unroll") for (int m = 0; m < 3; ++m) _Pragma("unroll") for (int c = 0; c < 4; ++c) acc[m][c] = __builtin_amdgcn_mfma_f32_16x16x4f32(a[s][m], bv[s][c], acc[m][c], 0, 0, 0); } while (0)
#define MODS_WAIT(s, n) asm volatile("s_waitcnt vmcnt(" #n ")" : "+v"(bv[s]), "+v"(a[s][0]), "+v"(a[s][1]), "+v"(a[s][2]) :: "memory")
#pragma unroll
    for (int s = 0; s < DEP; ++s) MODS_LD(s, 4 * s);
    for (int k0 = 0; k0 < 1024 - 4 * DEP; k0 += 4 * DEP) {
#pragma unroll
        for (int s = 0; s < DEP; ++s) { MODS_WAIT(s, 28); MODS_MM(s); MODS_LD(s, k0 + 4 * DEP + 4 * s); } }
    MODS_WAIT(0, 28); MODS_MM(0); MODS_WAIT(1, 24); MODS_MM(1); MODS_WAIT(2, 20); MODS_MM(2); MODS_WAIT(3, 16); MODS_MM(3);
    MODS_WAIT(4, 12); MODS_MM(4); MODS_WAIT(5, 8); MODS_MM(5); MODS_WAIT(6, 4); MODS_MM(6); MODS_WAIT(7, 0); MODS_MM(7);
#undef MODS_LD
#undef MODS_MM
#undef MODS_WAIT
    const f32x4 bb = *(const f32x4*)(ada_b + l * 9216 + n0 + 4 * i16);
#pragma unroll
    for (int m = 0; m < 3; ++m)
#pragma unroll
        for (int q = 0; q < 4; ++q) { const int r = (rs * 3 + m) * 16 + kq * 4 + q;
            if (r < NMODROW) *(f32x4*)(MODS + ((size_t)l * NMODROW + r) * 9216 + n0 + 4 * i16) = (f32x4){acc[m][0][q] + bb[0], acc[m][1][q] + bb[1], acc[m][2][q] + bb[2], acc[m][3][q] + bb[3]}; }
}

DEVI void init_row(int row, int lane, const float* xp, const float* xs, const float* mods, float* X, bf16* H, float* ZS) {
    if (row >= MT) { for (int j = 0; j < 16; ++j) H[(size_t)row * D + j * 64 + lane] = 0; return; }
    const float* src = row < NP ? xp + (size_t)row * D : xs + (size_t)(row - NP) * D;
    const float* sh = modp(mods, 0, 0) + (size_t)mrow(row) * 9216; const float* sc = modp(mods, 0, 1) + (size_t)mrow(row) * 9216;
#pragma unroll
    for (int j = 0; j < 4; ++j) { const int c = j * 256 + lane * 4; const f32x4 v = *(const f32x4*)(src + c), a = *(const f32x4*)(sc + c), b = *(const f32x4*)(sh + c);
        if (row >= NP) *(f32x4*)(ZS + (size_t)(row - NP) * D + c) = v * ALPHA; const f32x4 h = v * (a + 1.0f) + b;
        *(unsigned long long*)(H + (size_t)row * D + c) = (unsigned long long)pk2(h[0], h[1]) | ((unsigned long long)pk2(h[2], h[3]) << 32); }
}
template <int NR> DEVI void init_rows(int row0, int stride, int lane, const float* xp, const float* mods, bf16* H) {
    f32x4 v[NR][4];
#pragma unroll
    for (int i = 0; i < NR; ++i)
#pragma unroll
        for (int j = 0; j < 4; ++j) v[i][j] = *(const f32x4*)(xp + (size_t)(row0 + i * stride) * D + j * 256 + lane * 4);
#pragma unroll
    for (int i = 0; i < NR; ++i) { const int row = row0 + i * stride; const float* sh = modp(mods, 0, 0) + (size_t)mrow(row) * 9216; const float* sc = modp(mods, 0, 1) + (size_t)mrow(row) * 9216;
#pragma unroll
        for (int j = 0; j < 4; ++j) { const int c = j * 256 + lane * 4; const f32x4 h = v[i][j] * (*(const f32x4*)(sc + c) + 1.0f) + *(const f32x4*)(sh + c);
            *(unsigned long long*)(H + (size_t)row * D + c) = (unsigned long long)pk2(h[0], h[1]) | ((unsigned long long)pk2(h[2], h[3]) << 32); } }
}
DEVI void ln_row(int row, int lane, const float* Z, float* ZS, const float* SL, int nsl, const float* g, const float* b, float* X, bf16* H, const float* sh, const float* sc) {
    const float* z = row < NP ? Z + (size_t)row * D : ZS + (size_t)(row - NP) * D; f32x4 v[4]; float s = 0.f;
#pragma unroll
    for (int j = 0; j < 4; ++j) v[j] = *(const f32x4*)(z + j * 256 + lane * 4);
    if (row >= NP) for (int q = 0; q < nsl; ++q) {
#pragma unroll
        for (int j = 0; j < 4; ++j) v[j] = v[j] + *(const f32x4*)(SL + ((size_t)q * 128 + (row - NP)) * D + j * 256 + lane * 4); }
#pragma unroll
    for (int j = 0; j < 4; ++j) s += (v[j][0] + v[j][1]) + (v[j][2] + v[j][3]);
    const float mean = wave_sum(s) * (1.f / D); float q = 0.f;
#pragma unroll
    for (int j = 0; j < 4; ++j) { v[j] = v[j] - mean; q += (v[j][0] * v[j][0] + v[j][1] * v[j][1]) + (v[j][2] * v[j][2] + v[j][3] * v[j][3]); }
    const float rstd = rsqrtf(wave_sum(q) * (1.f / D) + 1e-5f);
    const int mr = mrow(row);
#pragma unroll
    for (int j = 0; j < 4; ++j) { const int c = j * 256 + lane * 4; const f32x4 x = v[j] * rstd * *(const f32x4*)(g + c) + *(const f32x4*)(b + c); *(f32x4*)(X + (size_t)row * D + c) = x; if (row >= NP) *(f32x4*)(ZS + (size_t)(row - NP) * D + c) = x * ALPHA;
        if (H) { const f32x4 h = x * (*(const f32x4*)(sc + (size_t)mr * 9216 + c) + 1.0f) + *(const f32x4*)(sh + (size_t)mr * 9216 + c);
            *(unsigned long long*)(H + (size_t)row * D + c) = (unsigned long long)pk2(h[0], h[1]) | ((unsigned long long)pk2(h[2], h[3]) << 32); } }
}
template <int NR> DEVI void ln_rows(int row0, int stride, int lane, const float* Z, const float* g, const float* b, float* X, bf16* H, const float* sh, const float* sc) {
    f32x4 v[NR][4]; float rstd[NR];
#pragma unroll
    for (int i = 0; i < NR; ++i)
#pragma unroll
        for (int j = 0; j < 4; ++j) v[i][j] = *(const f32x4*)(Z + (size_t)(row0 + i * stride) * D + j * 256 + lane * 4);
    f32x4 gg[4], bb[4];
#pragma unroll
    for (int j = 0; j < 4; ++j) { gg[j] = *(const f32x4*)(g + j * 256 + lane * 4); bb[j] = *(const f32x4*)(b + j * 256 + lane * 4); }
#pragma unroll
    for (int i = 0; i < NR; ++i) { float s = 0.f;
#pragma unroll
        for (int j = 0; j < 4; ++j) s += (v[i][j][0] + v[i][j][1]) + (v[i][j][2] + v[i][j][3]);
        const float mean = wave_sum(s) * (1.f / D); float q = 0.f;
#pragma unroll
        for (int j = 0; j < 4; ++j) { v[i][j] = v[i][j] - mean; q += (v[i][j][0] * v[i][j][0] + v[i][j][1] * v[i][j][1]) + (v[i][j][2] * v[i][j][2] + v[i][j][3] * v[i][j][3]); }
        rstd[i] = rsqrtf(wave_sum(q) * (1.f / D) + 1e-5f); }
#pragma unroll
    for (int i = 0; i < NR; ++i) { const int row = row0 + i * stride, mr = mrow(row);
#pragma unroll
        for (int j = 0; j < 4; ++j) { const int c = j * 256 + lane * 4; const f32x4 x = v[i][j] * rstd[i] * gg[j] + bb[j]; *(f32x4*)(X + (size_t)row * D + c) = x;
            if (H) { const f32x4 h = x * (*(const f32x4*)(sc + (size_t)mr * 9216 + c) + 1.0f) + *(const f32x4*)(sh + (size_t)mr * 9216 + c);
                *(unsigned long long*)(H + (size_t)row * D + c) = (unsigned long long)pk2(h[0], h[1]) | ((unsigned long long)pk2(h[2], h[3]) << 32); } } }
}
DEVI void ln_shift_rows(int row0, int n, int lane, const float* Z, float* ZS, const float* g, const float* b, float* X, const float* mods, const float* shift_in, bf16* A2, float* out) {
    f32x4 prev[4], gg[4], bb[4];
#pragma unroll
    for (int j = 0; j < 4; ++j) { gg[j] = *(const f32x4*)(g + j * 256 + lane * 4); bb[j] = *(const f32x4*)(b + j * 256 + lane * 4); prev[j] = (f32x4){0.f, 0.f, 0.f, 0.f}; }
    for (int r = ((row0 < NP && (row0 & 2047) != 0) ? row0 - 1 : row0); r < row0 + n; ++r) {
        const bool warm = r < row0;
        const float* z = r < NP ? Z + (size_t)r * D : ZS + (size_t)(r - NP) * D; f32x4 v[4]; float s = 0.f;
#pragma unroll
        for (int j = 0; j < 4; ++j) { v[j] = *(const f32x4*)(z + j * 256 + lane * 4); s += (v[j][0] + v[j][1]) + (v[j][2] + v[j][3]); }
        const float mean = wave_sum(s) * (1.f / D); float q = 0.f;
#pragma unroll
        for (int j = 0; j < 4; ++j) { v[j] = v[j] - mean; q += (v[j][0] * v[j][0] + v[j][1] * v[j][1]) + (v[j][2] * v[j][2] + v[j][3] * v[j][3]); }
        const float rstd = rsqrtf(wave_sum(q) * (1.f / D) + 1e-5f);
        const int mr = mrow(r); const float* sh = modp(mods, 1, 3) + (size_t)mr * 9216; const float* sc = modp(mods, 1, 4) + (size_t)mr * 9216;
        const bool prompt = r < NP; const int t = r & 2047;
#pragma unroll
        for (int j = 0; j < 4; ++j) { const int c = j * 256 + lane * 4; const f32x4 x = v[j] * rstd * gg[j] + bb[j]; const f32x4 h = x * (*(const f32x4*)(sc + c) + 1.0f) + *(const f32x4*)(sh + c);
            if (!warm) { *(f32x4*)(X + (size_t)r * D + c) = x; if (r >= NP) *(f32x4*)(ZS + (size_t)(r - NP) * D + c) = x * ALPHA;
                f32x4 pv = prev[j]; if (!prompt) pv = *(const f32x4*)(shift_in + (size_t)(r - NP) * D + c); else if (t == 0) pv = (f32x4){0.f, 0.f, 0.f, 0.f};
                *(unsigned long long*)(A2 + (size_t)r * KRK + c) = (unsigned long long)pk2(pv[0], pv[1]) | ((unsigned long long)pk2(pv[2], pv[3]) << 32);
                *(unsigned long long*)(A2 + (size_t)r * KRK + 1024 + c) = (unsigned long long)pk2(h[0], h[1]) | ((unsigned long long)pk2(h[2], h[3]) << 32);
                if (prompt) { if (t == 2047) *(f32x4*)(out + O_SHIFT_P + (size_t)(r >> 11) * D + c) = h; } else *(f32x4*)(out + O_SHIFT_S + (size_t)(r - NP) * D + c) = h; }
            prev[j] = h; }
    }
}
DEVI void shiftcat_row(int row, int lane, const float* X, const float* mods, const float* shift_in, bf16* A2, float* out) {
    if (row >= MT) { for (int j = 0; j < 8; ++j) *(unsigned long long*)(A2 + (size_t)row * KRK + j * 256 + lane * 4) = 0ull; return; }
    const int mr = mrow(row); const float* sh = modp(mods, 1, 3) + (size_t)mr * 9216; const float* sc = modp(mods, 1, 4) + (size_t)mr * 9216;
    const bool prompt = row < NP; const int t = row & 2047;
#pragma unroll
    for (int j = 0; j < 4; ++j) { const int c = j * 256 + lane * 4; const f32x4 a = *(const f32x4*)(sc + c) + 1.0f, b = *(const f32x4*)(sh + c);
        const f32x4 h = *(const f32x4*)(X + (size_t)row * D + c) * a + b; f32x4 pv;
        if (prompt) pv = t == 0 ? (f32x4){0.f, 0.f, 0.f, 0.f} : *(const f32x4*)(X + (size_t)(row - 1) * D + c) * a + b; else pv = *(const f32x4*)(shift_in + (size_t)(row - NP) * D + c);
        *(unsigned long long*)(A2 + (size_t)row * KRK + c) = (unsigned long long)pk2(pv[0], pv[1]) | ((unsigned long long)pk2(pv[2], pv[3]) << 32);
        *(unsigned long long*)(A2 + (size_t)row * KRK + 1024 + c) = (unsigned long long)pk2(h[0], h[1]) | ((unsigned long long)pk2(h[2], h[3]) << 32);
        if (prompt) { if (t == 2047) *(f32x4*)(out + O_SHIFT_P + (size_t)(row >> 11) * D + c) = h; } else *(f32x4*)(out + O_SHIFT_S + (size_t)(row - NP) * D + c) = h; }
}
template <int NR> DEVI void shiftcat_rows(int row0, int stride, int lane, const float* X, const float* mods, bf16* A2, float* out) {
    f32x4 v[NR][4], pr[NR][4];
#pragma unroll
    for (int i = 0; i < NR; ++i) { const int row = row0 + i * stride, rp = (row & 2047) ? row - 1 : row;
#pragma unroll
        for (int j = 0; j < 4; ++j) { v[i][j] = *(const f32x4*)(X + (size_t)row * D + j * 256 + lane * 4); pr[i][j] = *(const f32x4*)(X + (size_t)rp * D + j * 256 + lane * 4); } }
#pragma unroll
    for (int i = 0; i < NR; ++i) { const int row = row0 + i * stride, t = row & 2047, mr = mrow(row); const float* sh = modp(mods, 1, 3) + (size_t)mr * 9216; const float* sc = modp(mods, 1, 4) + (size_t)mr * 9216;
#pragma unroll
        for (int j = 0; j < 4; ++j) { const int c = j * 256 + lane * 4; const f32x4 a = *(const f32x4*)(sc + c) + 1.0f, b = *(const f32x4*)(sh + c);
            const f32x4 h = v[i][j] * a + b; f32x4 pv = pr[i][j] * a + b; if (t == 0) pv = (f32x4){0.f, 0.f, 0.f, 0.f};
            *(unsigned long long*)(A2 + (size_t)row * KRK + c) = (unsigned long long)pk2(pv[0], pv[1]) | ((unsigned long long)pk2(pv[2], pv[3]) << 32);
            *(unsigned long long*)(A2 + (size_t)row * KRK + 1024 + c) = (unsigned long long)pk2(h[0], h[1]) | ((unsigned long long)pk2(h[2], h[3]) << 32);
            if (t == 2047) *(f32x4*)(out + O_SHIFT_P + (size_t)(row >> 11) * D + c) = h; } }
}
DEVI void gla_post_one(int w, int lane, const float* OG, const bf16* P, const float* norm_g, bf16* O) {
    const int tok = w >> 2, h = w & 3;
    const float o0 = OG[(size_t)tok * 512 + h * 128 + lane], o1 = OG[(size_t)tok * 512 + h * 128 + 64 + lane];
    const float ms = wave_sum(o0 * o0 + o1 * o1) * (1.f / 128.f), r = rsqrtf(ms + 1e-5f);
    const float g0 = bf2f(P[(size_t)tok * NINP + 1024 + h * 128 + lane]), g1 = bf2f(P[(size_t)tok * NINP + 1024 + h * 128 + 64 + lane]);
    O[(size_t)tok * D + h * 128 + lane] = (bf16)f2bf(o0 * r * norm_g[lane] * siluf_(g0));
    O[(size_t)tok * D + h * 128 + 64 + lane] = (bf16)f2bf(o1 * r * norm_g[64 + lane] * siluf_(g1));
}

DEVI void gla_job(LAS float* scr, int lane, int b, int h, int half, const bf16* P, const float* GKL, const float* w_gk, const float* b_gk, int tok_base, int T, const float* s0, float* s_out, float* OG) {
    LAS float* sdec = scr; LAS float* sq = scr + 1024; LAS float* sk = scr + 2048;
    const int dv = half * 64 + lane;
    float S[64];
#pragma unroll
    for (int i = 0; i < 64; ++i) S[i] = s0 ? s0[(((size_t)b * 4 + h) * 64 + i) * 128 + dv] : 0.f;
    float wg[16];
#pragma unroll
    for (int r = 0; r < 16; ++r) wg[r] = w_gk[r * 256 + h * 64 + lane];
    const float bg = b_gk[h * 64 + lane];
    for (int t0 = 0; t0 < T; t0 += 16) { const int nt = (T - t0) < 16 ? (T - t0) : 16;
        for (int tt = 0; tt < nt; ++tt) { const size_t tok = (size_t)tok_base + (size_t)b * T + t0 + tt; float x = bg;
#pragma unroll
            for (int r = 0; r < 16; ++r) x += GKL[tok * 16 + r] * wg[r];
            const float ls = fminf(x, 0.f) - log1pf(__expf(-fabsf(x)));
            sdec[tt * 64 + lane] = __expf(ls * (1.f / 16.f)); sq[tt * 64 + lane] = bf2f(P[tok * NINP + h * 64 + lane]) * 0.125f; sk[tt * 64 + lane] = bf2f(P[tok * NINP + 256 + h * 64 + lane]); }
        LDS_WAIT(); asm volatile("" ::: "memory");
        for (int tt = 0; tt < nt; ++tt) { const size_t tok = (size_t)tok_base + (size_t)b * T + t0 + tt;
            const float v = bf2f(P[tok * NINP + 512 + h * 128 + dv]); float o = 0.f;
#pragma unroll
            for (int i = 0; i < 64; ++i) { S[i] = S[i] * sdec[tt * 64 + i] + sk[tt * 64 + i] * v; o += sq[tt * 64 + i] * S[i]; }
            OG[tok * 512 + h * 128 + dv] = o; }
        LDS_WAIT(); asm volatile("" ::: "memory");
    }
#pragma unroll
    for (int i = 0; i < 64; ++i) s_out[(((size_t)b * 4 + h) * 64 + i) * 128 + dv] = S[i];
}
DEVI void s5_job(LAS float* scr, int lane, int g, int b0, int nb, const bf16* P, const float* sp, const float* c_re, const float* c_im, const float* dd, int tok_base, int T,
                 const float* h0re, const float* h0im, float* ore, float* oim, bf16* Z5) {
    const int p = lane, c = p & 15, pq = p >> 4;
    const float abr = sp[g * 64 + p], abi = sp[2048 + g * 64 + p];
    float bbr[16], bbi[16], cr[16], ci[16];
#pragma unroll
    for (int i = 0; i < 16; ++i) { bbr[i] = sp[4096 + (g * 64 + p) * 16 + i]; bbi[i] = sp[4096 + 32768 + (g * 64 + p) * 16 + i];
        cr[i] = c_re[(g * 16 + c) * 64 + pq * 16 + i]; ci[i] = c_im[(g * 16 + c) * 64 + pq * 16 + i]; }
    const float dv = dd[g * 16 + c];
    for (int b = b0; b < b0 + nb; ++b) {
        float hr = h0re ? h0re[((size_t)b * 32 + g) * 64 + p] : 0.f, hi = h0im ? h0im[((size_t)b * 32 + g) * 64 + p] : 0.f;
        for (int t = 0; t < T; ++t) { const size_t tok = (size_t)tok_base + (size_t)b * T + t;
            const bf16* up = P + tok * NINP + 1552 + g * 16; float u[16];
#pragma unroll
            for (int i = 0; i < 16; ++i) u[i] = bf2f(up[i]);
            const float uc = bf2f(up[c]);
            float br = 0.f, bi = 0.f;
#pragma unroll
            for (int i = 0; i < 16; ++i) { br += u[i] * bbr[i]; bi += u[i] * bbi[i]; }
            const float nr = abr * hr - abi * hi + br, ni = abr * hi + abi * hr + bi; hr = nr; hi = ni;
            LAS float* hs = scr + (t & 1) * 128;
            hs[p] = hr; hs[64 + p] = hi;
            LDS_WAIT(); asm volatile("" ::: "memory");
            float y = 0.f;
#pragma unroll
            for (int i = 0; i < 16; ++i) y += cr[i] * hs[pq * 16 + i] - ci[i] * hs[64 + pq * 16 + i];
            y += __shfl_xor(y, 16); y += __shfl_xor(y, 32);
            if (p < 16) { y += dv * uc; Z5[tok * 512 + g * 16 + c] = (bf16)f2bf(gelu_tanh(y)); }
        }
        ore[((size_t)b * 32 + g) * 64 + p] = hr; oim[((size_t)b * 32 + g) * 64 + p] = hi;
        LDS_WAIT(); asm volatile("" ::: "memory");
    }
}
DEVI float wkv_decay(float w0, float raw) { const float x = -(w0 + raw); const float sp = fmaxf(x, 0.f) + log1pf(__expf(-fabsf(x))); return __expf(-__expf(-sp - 0.5f)); }
DEVI void wkv_job(LAS float* scr, int lane, int b, int h, const bf16* R, const bf16* Kb, const bf16* V, const bf16* WRAW, const float* w0p, const bf16* AS, bf16* GO, const float* k_k, const float* k_a, const float* r_k, const float* lnx_g, const float* lnx_b,
                  int tok_base, int T, const float* s0, float* s_out) {
    LAS float* sw = scr; LAS float* skm = scr + 512; LAS float* sa_ = scr + 1024; LAS float* sb = scr + 1536; LAS float* sr = scr + 2048; LAS float* sbon = scr + 2560;
    const int i = lane, ch = h * 64 + i;
    float S[64];
#pragma unroll
    for (int j = 0; j < 64; ++j) S[j] = s0 ? s0[(((size_t)b * 16 + h) * 64 + i) * 64 + j] : 0.f;
    const float kkc = k_k[ch], kac = k_a[ch], rkc = r_k[ch], lg = lnx_g[ch], lb = lnx_b[ch];
    for (int t0 = 0; t0 < T; t0 += 8) { const int nt = (T - t0) < 8 ? (T - t0) : 8;
        for (int tt = 0; tt < nt; ++tt) { const size_t tok = (size_t)tok_base + (size_t)b * T + t0 + tt;
            const float k = bf2f(Kb[tok * D + ch]), r = bf2f(R[tok * D + ch]), a = bf2f(AS[tok * D + ch]), w = wkv_decay(w0p[ch], bf2f(WRAW[tok * D + ch]));
            float kk = k * kkc; const float nrm = sqrtf(wave_sum(kk * kk)); kk = kk / fmaxf(nrm, 1e-12f);
            const float km = k * (1.f + (a - 1.f) * kac);
            sw[tt * 64 + i] = w; skm[tt * 64 + i] = km; sa_[tt * 64 + i] = -kk; sb[tt * 64 + i] = kk * a; sr[tt * 64 + i] = r;
            const float bon = wave_sum(r * km * rkc); if (i == 0) sbon[tt] = bon; }
        LDS_WAIT(); asm volatile("" ::: "memory");
        for (int tt = 0; tt < nt; ++tt) { const size_t tok = (size_t)tok_base + (size_t)b * T + t0 + tt;
            const float v = bf2f(V[tok * D + ch]); float sa = 0.f;
#pragma unroll
            for (int j = 0; j < 64; ++j) sa += S[j] * sa_[tt * 64 + j];
            float y = 0.f;
#pragma unroll
            for (int j = 0; j < 64; ++j) { S[j] = S[j] * sw[tt * 64 + j] + sa * sb[tt * 64 + j] + v * skm[tt * 64 + j]; y += S[j] * sr[tt * 64 + j]; }
            const float mean = wave_sum(y) * (1.f / 64.f), dy = y - mean, var = wave_sum(dy * dy) * (1.f / 64.f);
            float yn = dy * rsqrtf(var + 64e-5f) * lg + lb; yn += sbon[tt] * v;
            const float gt = bf2f(GO[tok * D + ch]); GO[tok * D + ch] = (bf16)f2bf(yn * gt); }
        LDS_WAIT(); asm volatile("" ::: "memory");
    }
#pragma unroll
    for (int j = 0; j < 64; ++j) s_out[(((size_t)b * 16 + h) * 64 + i) * 64 + j] = S[j];
}

DEVI float dpp_add(float v, const int ctrl_sel) {
    int r;
    switch (ctrl_sel) {
    case 0: r = __builtin_amdgcn_update_dpp(0, __builtin_bit_cast(int, v), 0xB1, 0xF, 0xF, true); break;
    case 1: r = __builtin_amdgcn_update_dpp(0, __builtin_bit_cast(int, v), 0x4E, 0xF, 0xF, true); break;
    case 2: r = __builtin_amdgcn_update_dpp(0, __builtin_bit_cast(int, v), 0x141, 0xF, 0xF, true); break;
    default: r = __builtin_amdgcn_update_dpp(0, __builtin_bit_cast(int, v), 0x140, 0xF, 0xF, true); break;
    }
    return v + __builtin_bit_cast(float, r);
}
DEVI float red16(float v) { v = dpp_add(v, 0); v = dpp_add(v, 1); v = dpp_add(v, 2); v = dpp_add(v, 3); return v; }
constexpr int WK_TB = 32;
constexpr int WK_W = 0, WK_KM = 2048, WK_NA = 4096, WK_BB = 6144, WK_WR = 8192, WK_V = 10240, WK_PB = 12800;
constexpr int WK_Y = 2 * WK_PB, WK_YB = 1024;
static_assert((WK_Y + 2 * WK_YB + 512 + 1200) * 4 <= RING_BYTES, "wkv lds");
struct WkvLoad { uint2 k, r, a, v, w; };
typedef float f32x2_t __attribute__((ext_vector_type(2)));
struct WkvOps { f32x4 na, wr, w4, bb, km, vv; };
DEVI float wkv_decay_fast(float w0, float raw) { const float x = -(w0 + raw); const float sp = fmaxf(x, 0.f) + 0.69314718056f * __builtin_amdgcn_logf(1.0f + __builtin_amdgcn_exp2f(-1.44269504089f * fabsf(x)));
    const float ee = __builtin_amdgcn_exp2f(-1.44269504089f * (sp + 0.5f)); return __builtin_amdgcn_exp2f(-1.44269504089f * ee); }
template <int MODE> DEVI void wkv_half(LAS float* L, int tid, int b, int h, int half, const bf16* R, const bf16* Kb, const bf16* V, const bf16* WRAW, const bf16* AS, const float* w0p,
                   const float* k_k, const float* k_a, const float* r_k, bf16* Y, float* BON, float* s_out) {
    asm volatile("" : "+v"(tid));
    const int rp = (tid >> 4) & 15, jq = tid & 15; const bool stepper = tid < 256;
    const int ch = h * 64 + 4 * jq, chv = h * 64 + half * 32 + 4 * (jq & 7);
    f32x4 S0 = {0.f, 0.f, 0.f, 0.f}, S1 = {0.f, 0.f, 0.f, 0.f};
    const size_t tokb = (size_t)b * TP;
    auto bf4 = [](uint2 u) -> f32x4 { f32x4 o; o[0] = __uint_as_float(u.x << 16); o[1] = __uint_as_float(u.x & 0xffff0000u); o[2] = __uint_as_float(u.y << 16); o[3] = __uint_as_float(u.y & 0xffff0000u); return o; };
#define WK_PREP1(bufidx, blkidx, tt_) do { LAS float* pb_ = L + (bufidx) * WK_PB; const size_t t_ = tokb + (size_t)(blkidx) * WK_TB + (tt_); const size_t o_ = t_ * D + ch; \
        const f32x4 k4 = bf4(*(const uint2*)(Kb + o_)), r4 = bf4(*(const uint2*)(R + o_)), a4 = bf4(*(const uint2*)(AS + o_)), wraw = bf4(*(const uint2*)(WRAW + o_)), v4 = bf4(*(const uint2*)(V + t_ * D + chv)); f32x4 w4; \
        _Pragma("unroll") for (int e_ = 0; e_ < 4; ++e_) w4[e_] = wkv_decay_fast(w0c[e_], wraw[e_]); \
        f32x4 kk = k4 * kkc; float ss = red16((kk[0] * kk[0] + kk[1] * kk[1]) + (kk[2] * kk[2] + kk[3] * kk[3])); const float inv = 1.0f / fmaxf(sqrtf(ss), 1e-12f); kk = kk * inv; \
        const f32x4 km = k4 * ((a4 - 1.0f) * kac + 1.0f); const f32x4 pr = r4 * km; const f32x4 prk = pr * rkc; const float bon = red16((prk[0] + prk[1]) + (prk[2] + prk[3])); \
        const f32x4 bbv = kk * a4; const f32x4 pb2 = bbv * r4; const float brs = red16((pb2[0] + pb2[1]) + (pb2[2] + pb2[3])), krs = red16((pr[0] + pr[1]) + (pr[2] + pr[3])); \
        *(LAS f32x4*)(pb_ + WK_W + (tt_) * 64 + 4 * jq) = w4; *(LAS f32x4*)(pb_ + WK_KM + (tt_) * 64 + 4 * jq) = km; *(LAS f32x4*)(pb_ + WK_NA + (tt_) * 64 + 4 * jq) = -kk; \
        *(LAS f32x4*)(pb_ + WK_BB + (tt_) * 64 + 4 * jq) = bbv; *(LAS f32x4*)(pb_ + WK_WR + (tt_) * 64 + 4 * jq) = w4 * r4 - kk * brs; \
        if (jq < 8) { *(LAS f32x4*)(pb_ + WK_V + (tt_) * 64 + 8 * jq) = (f32x4){v4[0], v4[1], v4[0] * krs, v4[1] * krs}; *(LAS f32x4*)(pb_ + WK_V + (tt_) * 64 + 8 * jq + 4) = (f32x4){v4[2], v4[3], v4[2] * krs, v4[3] * krs}; } \
        if (jq == 0 && half == 0) BON[t_ * 16 + h] = bon; } while (0)
#define WK_RD128(dst, ad, off) asm volatile("ds_read_b128 %0, %1 offset:%2" : "=v"(dst) : "v"(ad), "i"(off))
#define WK_LOADOPS(o_, dt_) do { WK_RD128((o_).na, aop, WK_NA * 4 + (dt_) * 256); WK_RD128((o_).wr, aop, WK_WR * 4 + (dt_) * 256); WK_RD128((o_).w4, aop, WK_W * 4 + (dt_) * 256); \
        WK_RD128((o_).bb, aop, WK_BB * 4 + (dt_) * 256); WK_RD128((o_).km, aop, WK_KM * 4 + (dt_) * 256); WK_RD128((o_).vv, av, (dt_) * 256); } while (0)
#define WK_WAIT(n_, o_) asm volatile("s_waitcnt lgkmcnt(" #n_ ")" : "+v"((o_).na), "+v"((o_).wr), "+v"((o_).w4), "+v"((o_).bb), "+v"((o_).km), "+v"((o_).vv))
#define WK_STEP(o_, dt_) do { \
        float sa0 = (S0[0] * (o_).na[0] + S0[1] * (o_).na[1]) + (S0[2] * (o_).na[2] + S0[3] * (o_).na[3]), sa1 = (S1[0] * (o_).na[0] + S1[1] * (o_).na[1]) + (S1[2] * (o_).na[2] + S1[3] * (o_).na[3]); \
        float y0 = (S0[0] * (o_).wr[0] + S0[1] * (o_).wr[1]) + (S0[2] * (o_).wr[2] + S0[3] * (o_).wr[3]), y1 = (S1[0] * (o_).wr[0] + S1[1] * (o_).wr[1]) + (S1[2] * (o_).wr[2] + S1[3] * (o_).wr[3]); \
        sa0 = dpp_add(sa0, 0); sa1 = dpp_add(sa1, 0); y0 = dpp_add(y0, 0); y1 = dpp_add(y1, 0); sa0 = dpp_add(sa0, 1); sa1 = dpp_add(sa1, 1); y0 = dpp_add(y0, 1); y1 = dpp_add(y1, 1); \
        sa0 = dpp_add(sa0, 2); sa1 = dpp_add(sa1, 2); y0 = dpp_add(y0, 2); y1 = dpp_add(y1, 2); sa0 = dpp_add(sa0, 3); sa1 = dpp_add(sa1, 3); y0 = dpp_add(y0, 3); y1 = dpp_add(y1, 3); \
        S0 = S0 * (o_).w4 + ((o_).bb * sa0 + (o_).km * (o_).vv[0]); S1 = S1 * (o_).w4 + ((o_).bb * sa1 + (o_).km * (o_).vv[1]); \
        f32x2_t yy; yy[0] = y0 + (o_).vv[2]; yy[1] = y1 + (o_).vv[3]; \
        asm volatile("ds_write_b64 %0, %1 offset:%2" :: "v"(ay), "v"(yy), "i"((dt_) * 128) : "memory"); } while (0)
    constexpr int NB = TP / WK_TB;
    if (!stepper) {
        const int ht = (tid - 256) >> 4;
        const f32x4 kkc = *(const f32x4*)(k_k + ch), kac = *(const f32x4*)(k_a + ch), rkc = *(const f32x4*)(r_k + ch), w0c = *(const f32x4*)(w0p + ch);
        WK_PREP1(0, 0, ht); WK_PREP1(0, 0, ht + 16);
        LDS_WAIT(); __builtin_amdgcn_s_barrier(); asm volatile("" ::: "memory");
        for (int n = 0; n < NB; ++n) { const int cur = n & 1;
            if (n + 1 < NB) { WK_PREP1(cur ^ 1, n + 1, ht); WK_PREP1(cur ^ 1, n + 1, ht + 16); }
            if (n >= 1) {
                const int yt = (tid - 256) >> 3, yq = (tid & 7) * 4; const f32x4 y4 = *(const LAS f32x4*)(L + WK_Y + (cur ^ 1) * WK_YB + yt * 32 + yq);
                uint2 ov; ov.x = pk2(y4[0], y4[1]); ov.y = pk2(y4[2], y4[3]);
                *(uint2*)(Y + (tokb + (size_t)(n - 1) * WK_TB + yt) * D + h * 64 + half * 32 + yq) = ov; }
            LDS_WAIT(); __builtin_amdgcn_s_barrier(); asm volatile("" ::: "memory");
        }
        { const int yt = (tid - 256) >> 3, yq = (tid & 7) * 4; const f32x4 y4 = *(const LAS f32x4*)(L + WK_Y + ((NB - 1) & 1) * WK_YB + yt * 32 + yq);
            uint2 ov; ov.x = pk2(y4[0], y4[1]); ov.y = pk2(y4[2], y4[3]); *(uint2*)(Y + (tokb + (size_t)(NB - 1) * WK_TB + yt) * D + h * 64 + half * 32 + yq) = ov; }
    } else {
        LDS_WAIT(); __builtin_amdgcn_s_barrier(); asm volatile("" ::: "memory");
        const unsigned lbase = (unsigned)(size_t)L;
        for (int n = 0; n < NB; ++n) { const int cur = n & 1;
            unsigned aop = lbase + (unsigned)(cur * WK_PB + 4 * jq) * 4u, av = lbase + (unsigned)(cur * WK_PB + WK_V + 4 * rp) * 4u;
            unsigned ay = lbase + (unsigned)(jq == 0 ? WK_Y + cur * WK_YB + 2 * rp : WK_Y + 2 * WK_YB + 2 * tid) * 4u;
            WkvOps o0, o1, o2, o3;
            asm volatile("s_waitcnt lgkmcnt(0)" ::: "memory");
            WK_LOADOPS(o0, 0); WK_LOADOPS(o1, 1);
            WK_LOADOPS(o2, 2); WK_WAIT(12, o0); WK_STEP(o0, 0);
            WK_LOADOPS(o3, 3); WK_WAIT(13, o1); WK_STEP(o1, 1);
            for (int t4 = 0; t4 < 7; ++t4) {
                WK_LOADOPS(o0, 4); WK_WAIT(14, o2); WK_STEP(o2, 2);
                WK_LOADOPS(o1, 5); WK_WAIT(14, o3); WK_STEP(o3, 3);
                aop += 1024; av += 1024; ay += 512;
                WK_LOADOPS(o2, 2); WK_WAIT(14, o0); WK_STEP(o0, 0);
                WK_LOADOPS(o3, 3); WK_WAIT(14, o1); WK_STEP(o1, 1);
            }
            WK_WAIT(8, o2); WK_STEP(o2, 2);
            WK_WAIT(2, o3); WK_STEP(o3, 3);
            asm volatile("s_waitcnt lgkmcnt(0)" ::: "memory");
            __builtin_amdgcn_s_barrier(); asm volatile("" ::: "memory");
        }
        float* so = s_out + (((size_t)b * 16 + h) * 64 + half * 32 + 2 * rp) * 64 + 4 * jq; *(f32x4*)so = S0; *(f32x4*)(so + 64) = S1;
    }
#undef WK_LOADOPS
#undef WK_STEP
#undef WK_WAIT
#undef WK_RD128
#undef WK_PREP1
}
constexpr int W2_KM = 0, W2_NA = 2048, W2_BB = 4096, W2_WR = 6144, W2_V = 8192, W2_PB = 10752;
constexpr int W2_Y = 2 * W2_PB, W2_YB = 1024, W2_LD = 25344, W2_TOT = W2_LD + 4096, W2_PE = W2_TOT + 512;
static_assert(W2_Y + 2 * W2_YB + 512 + 1200 <= W2_LD && (W2_PE + 128) * 4 <= RING_BYTES, "wkv2 lds");
struct Wkv2Ops { f32x4 na, wr, bb, km, vv; };
DEVI void wkv_half2(LAS float* L, int tid, int b, int h, int half, const bf16* R, const bf16* Kb, const bf16* V, const bf16* WRAW, const bf16* AS, const float* w0p,
                    const float* k_k, const float* k_a, const float* r_k, bf16* Y, float* BON, float* s_out) {
    asm volatile("" : "+v"(tid));
    const int rp = (tid >> 4) & 15, jq = tid & 15; const bool stepper = tid < 256;
    const int ch = h * 64 + 4 * jq, chv = h * 64 + half * 32 + 4 * (jq & 7);
    f32x4 S0 = {0.f, 0.f, 0.f, 0.f}, S1 = {0.f, 0.f, 0.f, 0.f};
    const size_t tokb = (size_t)b * TP;
    auto bf4 = [](uint2 u) -> f32x4 { f32x4 o; o[0] = __uint_as_float(u.x << 16); o[1] = __uint_as_float(u.x & 0xffff0000u); o[2] = __uint_as_float(u.y << 16); o[3] = __uint_as_float(u.y & 0xffff0000u); return o; };
#define W2_STAGEA(m_) do { LAS float* ld_ = L + W2_LD + ((m_) & 1) * 2048; const size_t t0_ = tokb + (size_t)(m_) * WK_TB + 8 * hw; float raw_[8]; \
        _Pragma("unroll") for (int i_ = 0; i_ < 8; ++i_) raw_[i_] = bf2f(WRAW[(t0_ + i_) * D + h * 64 + cl]); \
        float cum_ = 0.f; \
        _Pragma("unroll") for (int i_ = 0; i_ < 8; ++i_) { const float x_ = -(w0s + raw_[i_]); const float sp_ = fmaxf(x_, 0.f) + 0.69314718056f * __builtin_amdgcn_logf(1.0f + __builtin_amdgcn_exp2f(-1.44269504089f * fabsf(x_))); \
            cum_ -= 1.44269504089f * __builtin_amdgcn_exp2f(-1.44269504089f * (sp_ + 0.5f)); ld_[(8 * hw + i_) * 64 + cl] = cum_; } \
        L[W2_TOT + ((m_) & 1) * 256 + hw * 64 + cl] = cum_; } while (0)
#define W2_PREP1(m_, tt_) do { LAS float* pb_ = L + ((m_) & 1) * W2_PB; const LAS float* ld_ = L + W2_LD + ((m_) & 1) * 2048; const LAS float* tot_ = L + W2_TOT + ((m_) & 1) * 256; \
        const size_t t_ = tokb + (size_t)(m_) * WK_TB + (tt_); const size_t o_ = t_ * D + ch; \
        const f32x4 k4 = bf4(*(const uint2*)(Kb + o_)), r4 = bf4(*(const uint2*)(R + o_)), a4 = bf4(*(const uint2*)(AS + o_)), v4 = bf4(*(const uint2*)(V + t_ * D + chv)); \
        f32x4 Lt = *(const LAS f32x4*)(ld_ + (tt_) * 64 + 4 * jq), Lp = {0.f, 0.f, 0.f, 0.f}; if ((tt_) & 7) Lp = *(const LAS f32x4*)(ld_ + ((tt_) - 1) * 64 + 4 * jq); \
        for (int q_ = 0; q_ < ((tt_) >> 3); ++q_) { const f32x4 to_ = *(const LAS f32x4*)(tot_ + q_ * 64 + 4 * jq); Lt = Lt + to_; Lp = Lp + to_; } \
        f32x4 Pt, Pp, iP; \
        _Pragma("unroll") for (int e_ = 0; e_ < 4; ++e_) { Pt[e_] = __builtin_amdgcn_exp2f(Lt[e_]); Pp[e_] = __builtin_amdgcn_exp2f(Lp[e_]); iP[e_] = __builtin_amdgcn_exp2f(-Lt[e_]); } \
        f32x4 kk = k4 * kkc; float ss = red16((kk[0] * kk[0] + kk[1] * kk[1]) + (kk[2] * kk[2] + kk[3] * kk[3])); const float inv = 1.0f / fmaxf(sqrtf(ss), 1e-12f); kk = kk * inv; \
        const f32x4 km = k4 * ((a4 - 1.0f) * kac + 1.0f); const f32x4 pr = r4 * km; const f32x4 prk = pr * rkc; const float bon = red16((prk[0] + prk[1]) + (prk[2] + prk[3])); \
        const f32x4 bbv = kk * a4; const f32x4 pb2 = bbv * r4; const float brs = red16((pb2[0] + pb2[1]) + (pb2[2] + pb2[3])), krs = red16((pr[0] + pr[1]) + (pr[2] + pr[3])); \
        const f32x4 nah = -(kk * Pp); \
        *(LAS f32x4*)(pb_ + W2_KM + (tt_) * 64 + 4 * jq) = km * iP; *(LAS f32x4*)(pb_ + W2_NA + (tt_) * 64 + 4 * jq) = nah; \
        *(LAS f32x4*)(pb_ + W2_BB + (tt_) * 64 + 4 * jq) = bbv * iP; *(LAS f32x4*)(pb_ + W2_WR + (tt_) * 64 + 4 * jq) = Pt * r4 + nah * brs; \
        if (jq < 8) { *(LAS f32x4*)(pb_ + W2_V + (tt_) * 64 + 8 * jq) = (f32x4){v4[0], v4[1], v4[0] * krs, v4[1] * krs}; *(LAS f32x4*)(pb_ + W2_V + (tt_) * 64 + 8 * jq + 4) = (f32x4){v4[2], v4[3], v4[2] * krs, v4[3] * krs}; } \
        if ((tt_) == WK_TB - 1) *(LAS f32x4*)(L + W2_PE + ((m_) & 1) * 64 + 4 * jq) = Pt; \
        if (jq == 0 && half == 0) BON[t_ * 16 + h] = bon; } while (0)
#define W2_RD128(dst, ad, off) asm volatile("ds_read_b128 %0, %1 offset:%2" : "=v"(dst) : "v"(ad), "i"(off))
#define W2_LOADOPS(o_, dt_) do { W2_RD128((o_).na, aop, W2_NA * 4 + (dt_) * 256); W2_RD128((o_).wr, aop, W2_WR * 4 + (dt_) * 256); W2_RD128((o_).bb, aop, W2_BB * 4 + (dt_) * 256); \
        W2_RD128((o_).km, aop, W2_KM * 4 + (dt_) * 256); W2_RD128((o_).vv, av, (dt_) * 256); } while (0)
#define W2_WAIT(n_, o_) asm volatile("s_waitcnt lgkmcnt(" #n_ ")" : "+v"((o_).na), "+v"((o_).wr), "+v"((o_).bb), "+v"((o_).km), "+v"((o_).vv))
#define W2_STEP(o_, dt_) do { \
        float sa0 = (S0[0] * (o_).na[0] + S0[1] * (o_).na[1]) + (S0[2] * (o_).na[2] + S0[3] * (o_).na[3]), sa1 = (S1[0] * (o_).na[0] + S1[1] * (o_).na[1]) + (S1[2] * (o_).na[2] + S1[3] * (o_).na[3]); \
        float y0 = (S0[0] * (o_).wr[0] + S0[1] * (o_).wr[1]) + (S0[2] * (o_).wr[2] + S0[3] * (o_).wr[3]), y1 = (S1[0] * (o_).wr[0] + S1[1] * (o_).wr[1]) + (S1[2] * (o_).wr[2] + S1[3] * (o_).wr[3]); \
        S0 = S0 + (o_).km * (o_).vv[0]; S1 = S1 + (o_).km * (o_).vv[1]; \
        sa0 = dpp_add(sa0, 0); sa1 = dpp_add(sa1, 0); y0 = dpp_add(y0, 0); y1 = dpp_add(y1, 0); sa0 = dpp_add(sa0, 1); sa1 = dpp_add(sa1, 1); y0 = dpp_add(y0, 1); y1 = dpp_add(y1, 1); \
        sa0 = dpp_add(sa0, 2); sa1 = dpp_add(sa1, 2); y0 = dpp_add(y0, 2); y1 = dpp_add(y1, 2); sa0 = dpp_add(sa0, 3); sa1 = dpp_add(sa1, 3); y0 = dpp_add(y0, 3); y1 = dpp_add(y1, 3); \
        S0 = S0 + (o_).bb * sa0; S1 = S1 + (o_).bb * sa1; \
        f32x2_t yy; yy[0] = y0 + (o_).vv[2]; yy[1] = y1 + (o_).vv[3]; \
        asm volatile("ds_write_b64 %0, %1 offset:%2" :: "v"(ay), "v"(yy), "i"((dt_) * 128) : "memory"); } while (0)
    constexpr int NB = TP / WK_TB;
    if (!stepper) {
        const int ht = (tid - 256) >> 4, hw = (tid - 256) >> 6, cl = tid & 63;
        const f32x4 kkc = *(const f32x4*)(k_k + ch), kac = *(const f32x4*)(k_a + ch), rkc = *(const f32x4*)(r_k + ch); const float w0s = w0p[h * 64 + cl];
        W2_STAGEA(0);
        LDS_WAIT(); __builtin_amdgcn_s_barrier(); asm volatile("" ::: "memory");
        W2_STAGEA(1); W2_PREP1(0, ht); W2_PREP1(0, ht + 16);
        LDS_WAIT(); __builtin_amdgcn_s_barrier(); asm volatile("" ::: "memory");
        for (int n = 0; n < NB; ++n) { const int cur = n & 1;
            if (n + 2 < NB) W2_STAGEA(n + 2);
            if (n + 1 < NB) { W2_PREP1(n + 1, ht); W2_PREP1(n + 1, ht + 16); }
            if (n >= 1) {
                const int yt = (tid - 256) >> 3, yq = (tid & 7) * 4; const f32x4 y4 = *(const LAS f32x4*)(L + W2_Y + (cur ^ 1) * W2_YB + yt * 32 + yq);
                uint2 ov; ov.x = pk2(y4[0], y4[1]); ov.y = pk2(y4[2], y4[3]);
                *(uint2*)(Y + (tokb + (size_t)(n - 1) * WK_TB + yt) * D + h * 64 + half * 32 + yq) = ov; }
            LDS_WAIT(); __builtin_amdgcn_s_barrier(); asm volatile("" ::: "memory");
        }
        { const int yt = (tid - 256) >> 3, yq = (tid & 7) * 4; const f32x4 y4 = *(const LAS f32x4*)(L + W2_Y + ((NB - 1) & 1) * W2_YB + yt * 32 + yq);
            uint2 ov; ov.x = pk2(y4[0], y4[1]); ov.y = pk2(y4[2], y4[3]); *(uint2*)(Y + (tokb + (size_t)(NB - 1) * WK_TB + yt) * D + h * 64 + half * 32 + yq) = ov; }
    } else {
        LDS_WAIT(); __builtin_amdgcn_s_barrier(); asm volatile("" ::: "memory");
        LDS_WAIT(); __builtin_amdgcn_s_barrier(); asm volatile("" ::: "memory");
        const unsigned lbase = (unsigned)(size_t)L;
        for (int n = 0; n < NB; ++n) { const int cur = n & 1;
            unsigned aop = lbase + (unsigned)(cur * W2_PB + 4 * jq) * 4u, av = lbase + (unsigned)(cur * W2_PB + W2_V + 4 * rp) * 4u;
            unsigned ay = lbase + (unsigned)(jq == 0 ? W2_Y + cur * W2_YB + 2 * rp : W2_Y + 2 * W2_YB + 2 * tid) * 4u;
            Wkv2Ops o0, o1, o2, o3;
            asm volatile("s_waitcnt lgkmcnt(0)" ::: "memory");
            W2_LOADOPS(o0, 0); W2_LOADOPS(o1, 1);
            W2_LOADOPS(o2, 2); W2_WAIT(10, o0); W2_STEP(o0, 0);
            W2_LOADOPS(o3, 3); W2_WAIT(11, o1); W2_STEP(o1, 1);
            for (int t4 = 0; t4 < 7; ++t4) {
                W2_LOADOPS(o0, 4); W2_WAIT(12, o2); W2_STEP(o2, 2);
                W2_LOADOPS(o1, 5); W2_WAIT(12, o3); W2_STEP(o3, 3);
                aop += 1024; av += 1024; ay += 512;
                W2_LOADOPS(o2, 2); W2_WAIT(12, o0); W2_STEP(o0, 0);
                W2_LOADOPS(o3, 3); W2_WAIT(12, o1); W2_STEP(o1, 1);
            }
            W2_WAIT(7, o2); W2_STEP(o2, 2);
            W2_WAIT(2, o3); W2_STEP(o3, 3);
            asm volatile("s_waitcnt lgkmcnt(0)" ::: "memory");
            { const f32x4 pe = *(const LAS f32x4*)(L + W2_PE + cur * 64 + 4 * jq); S0 = S0 * pe; S1 = S1 * pe; }
            LDS_WAIT(); __builtin_amdgcn_s_barrier(); asm volatile("" ::: "memory");
        }
        float* so = s_out + (((size_t)b * 16 + h) * 64 + half * 32 + 2 * rp) * 64 + 4 * jq; *(f32x4*)so = S0; *(f32x4*)(so + 64) = S1;
    }
#undef W2_LOADOPS
#undef W2_STEP
#undef W2_WAIT
#undef W2_RD128
#undef W2_PREP1
#undef W2_STAGEA
}
struct YpIn { v4u ya, yb, va, vb, ga, gb; };
DEVI YpIn wkv_ypass_load(size_t tok, int lane, const bf16* Y, const bf16* V, const bf16* GO) { const size_t o = tok * D + lane * 16; YpIn r; r.ya = *(const v4u*)(Y + o); r.yb = *(const v4u*)(Y + o + 8); r.va = *(const v4u*)(V + o); r.vb = *(const v4u*)(V + o + 8); r.ga = *(const v4u*)(GO + o); r.gb = *(const v4u*)(GO + o + 8); return r; }
DEVI void wkv_ypass_fin(size_t tok, int lane, const YpIn& in, bf16* GO, const float* BON, const float* lnx_g, const float* lnx_b) {
    const int c0 = lane * 16; const size_t o = tok * D + c0;
    const v4u ya = in.ya, yb = in.yb, va = in.va, vb = in.vb, ga = in.ga, gb = in.gb;
    const unsigned yw[8] = {ya.x, ya.y, ya.z, ya.w, yb.x, yb.y, yb.z, yb.w}, vw[8] = {va.x, va.y, va.z, va.w, vb.x, vb.y, vb.z, vb.w}, gw_[8] = {ga.x, ga.y, ga.z, ga.w, gb.x, gb.y, gb.z, gb.w};
    float y[16]; float s = 0.f;
#pragma unroll
    for (int e = 0; e < 8; ++e) { y[2 * e] = __uint_as_float(yw[e] << 16); y[2 * e + 1] = __uint_as_float(yw[e] & 0xffff0000u); s += y[2 * e] + y[2 * e + 1]; }
    s = dpp_add(s, 0); s = dpp_add(s, 1); const float mean = s * (1.f / 64.f); float q = 0.f;
#pragma unroll
    for (int e = 0; e < 16; ++e) { y[e] -= mean; q += y[e] * y[e]; }
    q = dpp_add(q, 0); q = dpp_add(q, 1); const float rstd = rsqrtf(q * (1.f / 64.f) + 64e-5f), bon = BON[tok * 16 + (lane >> 2)];
    unsigned ow[8];
#pragma unroll
    for (int e = 0; e < 8; ++e) { const float v0 = __uint_as_float(vw[e] << 16), v1 = __uint_as_float(vw[e] & 0xffff0000u), g0 = __uint_as_float(gw_[e] << 16), g1 = __uint_as_float(gw_[e] & 0xffff0000u);
        const float o0 = (y[2 * e] * rstd * lnx_g[c0 + 2 * e] + lnx_b[c0 + 2 * e] + bon * v0) * g0, o1 = (y[2 * e + 1] * rstd * lnx_g[c0 + 2 * e + 1] + lnx_b[c0 + 2 * e + 1] + bon * v1) * g1; ow[e] = pk2(o0, o1); }
    *(v4u*)(GO + o) = (v4u){ow[0], ow[1], ow[2], ow[3]}; *(v4u*)(GO + o + 8) = (v4u){ow[4], ow[5], ow[6], ow[7]};
}
DEVI void wkv_ypass_row(size_t tok, int lane, const bf16* Y, const bf16* V, bf16* GO, const float* BON, const float* lnx_g, const float* lnx_b) { const YpIn in = wkv_ypass_load(tok, lane, Y, V, GO); wkv_ypass_fin(tok, lane, in, GO, BON, lnx_g, lnx_b); }
DEVI void wkv_ypass_rows4(size_t tok0, size_t stride, int lane, const bf16* Y, const bf16* V, bf16* GO, const float* BON, const float* lnx_g, const float* lnx_b) {
    const YpIn a = wkv_ypass_load(tok0, lane, Y, V, GO), b = wkv_ypass_load(tok0 + stride, lane, Y, V, GO), c = wkv_ypass_load(tok0 + 2 * stride, lane, Y, V, GO), d = wkv_ypass_load(tok0 + 3 * stride, lane, Y, V, GO);
    wkv_ypass_fin(tok0, lane, a, GO, BON, lnx_g, lnx_b); wkv_ypass_fin(tok0 + stride, lane, b, GO, BON, lnx_g, lnx_b); wkv_ypass_fin(tok0 + 2 * stride, lane, c, GO, BON, lnx_g, lnx_b); wkv_ypass_fin(tok0 + 3 * stride, lane, d, GO, BON, lnx_g, lnx_b);
}

constexpr int GL_BF = 0, GL_QI = 16384, GL_KI = 25600, GL_SC = 34816, GL_VT = 44032, GL_ST = 62464, GL_RS = 80896, GL_WG = 81920, GL_GKL = 86016, GL_SEG = 90112;
constexpr int GL_LD = 72;
DEVI bf16x8 gl_frag(LAS unsigned char* lds, int base, int row, int k0, int fq) { return *(const LAS bf16x8*)(lds + base + (row * GL_LD + k0 + 8 * fq) * 2); }
DEVI void gla_cumdecay(LAS unsigned char* lds, int tid, int h, size_t tok0, const float* GKL, const float* w_gk, const float* b_gk) {
    asm volatile("" : "+v"(tid));
    LAS float* BF = (LAS float*)(lds + GL_BF); LAS float* WG = (LAS float*)(lds + GL_WG); LAS float* GK = (LAS float*)(lds + GL_GKL); LAS float* SEG = (LAS float*)(lds + GL_SEG);
    for (int i = tid; i < 1024; i += 512) { WG[i] = w_gk[(i >> 6) * 256 + h * 64 + (i & 63)]; GK[i] = GKL[tok0 * 16 + i]; }
    LDS_WAIT(); __builtin_amdgcn_s_barrier(); asm volatile("" ::: "memory");
    { const int t = tid >> 3, d0 = (tid & 7) * 8; float x[8];
#pragma unroll
        for (int e = 0; e < 8; ++e) x[e] = b_gk[h * 64 + d0 + e];
#pragma unroll
        for (int r = 0; r < 16; ++r) { const float gv = GK[t * 16 + r]; const f32x4 w0 = *(const LAS f32x4*)(WG + r * 64 + d0), w1 = *(const LAS f32x4*)(WG + r * 64 + d0 + 4);
#pragma unroll
            for (int e = 0; e < 4; ++e) { x[e] += gv * w0[e]; x[4 + e] += gv * w1[e]; } }
#pragma unroll
        for (int e = 0; e < 8; ++e) { const float xx = x[e]; x[e] = (fminf(xx, 0.f) - log1pf(__expf(-fabsf(xx)))) * (1.f / 16.f); }
        *(LAS f32x4*)(BF + t * 64 + d0) = (f32x4){x[0], x[1], x[2], x[3]}; *(LAS f32x4*)(BF + t * 64 + d0 + 4) = (f32x4){x[4], x[5], x[6], x[7]}; }
    LDS_WAIT(); __builtin_amdgcn_s_barrier(); asm volatile("" ::: "memory");
    { const int dk = tid & 63, sg = tid >> 6; float a = 0.f;
#pragma unroll
        for (int i = 0; i < 8; ++i) { a += BF[(sg * 8 + i) * 64 + dk]; BF[(sg * 8 + i) * 64 + dk] = a; }
        SEG[sg * 64 + dk] = a; }
    LDS_WAIT(); __builtin_amdgcn_s_barrier(); asm volatile("" ::: "memory");
    { const int dk = tid & 63, sg = tid >> 6; float off = 0.f;
        for (int s = 0; s < sg; ++s) off += SEG[s * 64 + dk];
#pragma unroll
        for (int i = 0; i < 8; ++i) BF[(sg * 8 + i) * 64 + dk] += off; }
    LDS_WAIT(); __builtin_amdgcn_s_barrier(); asm volatile("" ::: "memory");
}
DEVI void gla_stage_vt(LAS unsigned char* lds, int tid, int h, size_t tok0, const bf16* P) {
    const int t = tid >> 3, dv0 = (tid & 7) * 16; const bf16* vp = P + (tok0 + t) * NINP + 512 + h * 128 + dv0;
    const v4u a = *(const v4u*)vp, b = *(const v4u*)(vp + 8); LAS bf16* VT = (LAS bf16*)(lds + GL_VT);
    const unsigned w[8] = {a.x, a.y, a.z, a.w, b.x, b.y, b.z, b.w};
#pragma unroll
    for (int e = 0; e < 8; ++e) { VT[(dv0 + 2 * e) * GL_LD + t] = (bf16)(w[e] & 0xffffu); VT[(dv0 + 2 * e + 1) * GL_LD + t] = (bf16)(w[e] >> 16); }
}
DEVI void gla_unit_a(LAS unsigned char* lds, int tid, int u, const bf16* P, const float* GKL, const float* w_gk, const float* b_gk, float* KV, float* DEC) {
    asm volatile("" : "+v"(tid));
    const int bh = u >> 5, ck = u & 31, b = bh >> 2, h = bh & 3; const size_t tok0 = (size_t)b * TP + ck * 64;
    const int lane = tid & 63, wave = tid >> 6, fr = lane & 15, fq = lane >> 4;
    gla_cumdecay(lds, tid, h, tok0, GKL, w_gk, b_gk);
    LAS float* BF = (LAS float*)(lds + GL_BF);
    { const int t = tid >> 3, d0 = (tid & 7) * 8; const v4u kq = *(const v4u*)(P + (tok0 + t) * NINP + 256 + h * 64 + d0); LAS bf16* KST = (LAS bf16*)(lds + GL_QI);
        const unsigned w[4] = {kq.x, kq.y, kq.z, kq.w};
#pragma unroll
        for (int e = 0; e < 8; ++e) { const float kv = __uint_as_float((e & 1) ? (w[e >> 1] & 0xffff0000u) : (w[e >> 1] << 16)); const float sc = __expf(BF[63 * 64 + d0 + e] - BF[t * 64 + d0 + e]);
            KST[(d0 + e) * GL_LD + t] = (bf16)f2bf(kv * sc); } }
    gla_stage_vt(lds, tid, h, tok0, P);
    if (tid < 64) DEC[(size_t)u * 64 + tid] = __expf(BF[63 * 64 + tid]);
    LDS_WAIT(); __builtin_amdgcn_s_barrier(); asm volatile("" ::: "memory");
#pragma unroll
    for (int dt = 0; dt < 4; ++dt) { f32x4 acc = {0.f, 0.f, 0.f, 0.f};
#pragma unroll
        for (int k0 = 0; k0 < 64; k0 += 32) acc = __builtin_amdgcn_mfma_f32_16x16x32_bf16(gl_frag(lds, GL_VT, wave * 16 + fr, k0, fq), gl_frag(lds, GL_QI, dt * 16 + fr, k0, fq), acc, 0, 0, 0);
        *(f32x4*)(KV + ((size_t)u * 64 + dt * 16 + fr) * 128 + wave * 16 + 4 * fq) = acc; }
    LDS_WAIT(); __builtin_amdgcn_s_barrier(); asm volatile("" ::: "memory");
}
DEVI void gla_scan_b(int gtid, float* KV, const float* DEC, float* s_out) {
    const int dv = gtid & 127, dkq = (gtid >> 7) & 15, bh = gtid >> 11; float S[4] = {0.f, 0.f, 0.f, 0.f};
    for (int c0 = 0; c0 < 32; c0 += 8) {
        float kv[8][4], dc[8][4];
#pragma unroll
        for (int cc = 0; cc < 8; ++cc) { const size_t u = (size_t)bh * 32 + c0 + cc; const float* kp = KV + (u * 64 + dkq * 4) * 128 + dv;
#pragma unroll
            for (int e = 0; e < 4; ++e) { kv[cc][e] = kp[e * 128]; dc[cc][e] = DEC[u * 64 + dkq * 4 + e]; } }
#pragma unroll
        for (int cc = 0; cc < 8; ++cc) { const size_t u = (size_t)bh * 32 + c0 + cc; float* kp = KV + (u * 64 + dkq * 4) * 128 + dv;
#pragma unroll
            for (int e = 0; e < 4; ++e) { kp[e * 128] = S[e]; S[e] = dc[cc][e] * S[e] + kv[cc][e]; } } }
#pragma unroll
    for (int e = 0; e < 4; ++e) s_out[((size_t)bh * 64 + dkq * 4 + e) * 128 + dv] = S[e];
}
DEVI void gla_unit_c(LAS unsigned char* lds, int tid, int u, const bf16* P, const float* GKL, const float* w_gk, const float* b_gk, const float* KV, const float* norm_g, bf16* O) {
    asm volatile("" : "+v"(tid));
    const int bh = u >> 5, ck = u & 31, b = bh >> 2, h = bh & 3; const size_t tok0 = (size_t)b * TP + ck * 64;
    const int lane = tid & 63, wave = tid >> 6, fr = lane & 15, fq = lane >> 4;
    gla_cumdecay(lds, tid, h, tok0, GKL, w_gk, b_gk);
    LAS float* BF = (LAS float*)(lds + GL_BF);
    { const int t = tid >> 3, d0 = (tid & 7) * 8; const v4u qq = *(const v4u*)(P + (tok0 + t) * NINP + h * 64 + d0), kq = *(const v4u*)(P + (tok0 + t) * NINP + 256 + h * 64 + d0);
        const unsigned wq[4] = {qq.x, qq.y, qq.z, qq.w}, wk[4] = {kq.x, kq.y, kq.z, kq.w}; float qo[8], ko[8];
#pragma unroll
        for (int e = 0; e < 8; ++e) { const float qv = __uint_as_float((e & 1) ? (wq[e >> 1] & 0xffff0000u) : (wq[e >> 1] << 16)), kv = __uint_as_float((e & 1) ? (wk[e >> 1] & 0xffff0000u) : (wk[e >> 1] << 16));
            const float bb = BF[t * 64 + d0 + e]; qo[e] = qv * 0.125f * __expf(bb); ko[e] = kv * __expf(-bb); }
        v4u a, c; a.x = pk2(qo[0], qo[1]); a.y = pk2(qo[2], qo[3]); a.z = pk2(qo[4], qo[5]); a.w = pk2(qo[6], qo[7]); c.x = pk2(ko[0], ko[1]); c.y = pk2(ko[2], ko[3]); c.z = pk2(ko[4], ko[5]); c.w = pk2(ko[6], ko[7]);
        *(LAS v4u*)(lds + GL_QI + (t * GL_LD + d0) * 2) = a; *(LAS v4u*)(lds + GL_KI + (t * GL_LD + d0) * 2) = c; }
    gla_stage_vt(lds, tid, h, tok0, P);
    { const int dk = tid >> 3, dv0 = (tid & 7) * 16; const float* sp = KV + ((size_t)u * 64 + dk) * 128 + dv0; LAS bf16* ST = (LAS bf16*)(lds + GL_ST);
#pragma unroll
        for (int q = 0; q < 4; ++q) { const f32x4 s4 = *(const f32x4*)(sp + 4 * q);
#pragma unroll
            for (int e = 0; e < 4; ++e) ST[(dv0 + 4 * q + e) * GL_LD + dk] = (bf16)f2bf(s4[e]); } }
    LDS_WAIT(); __builtin_amdgcn_s_barrier(); asm volatile("" ::: "memory");
#pragma unroll
    for (int q = 0; q < 2; ++q) { const int id = wave * 2 + q, tt = id >> 2, st = id & 3; f32x4 acc = {0.f, 0.f, 0.f, 0.f};
#pragma unroll
        for (int k0 = 0; k0 < 64; k0 += 32) acc = __builtin_amdgcn_mfma_f32_16x16x32_bf16(gl_frag(lds, GL_KI, st * 16 + fr, k0, fq), gl_frag(lds, GL_QI, tt * 16 + fr, k0, fq), acc, 0, 0, 0);
        const int t = tt * 16 + fr, s0 = st * 16 + 4 * fq;
#pragma unroll
        for (int e = 0; e < 4; ++e) if (s0 + e > t) acc[e] = 0.f;
        *(LAS unsigned long long*)(lds + GL_SC + (t * GL_LD + s0) * 2) = (unsigned long long)pk2(acc[0], acc[1]) | ((unsigned long long)pk2(acc[2], acc[3]) << 32); }
    LDS_WAIT(); __builtin_amdgcn_s_barrier(); asm volatile("" ::: "memory");
    const int tt = wave & 3, hv = wave >> 2; f32x4 o[4]; float ssq = 0.f;
#pragma unroll
    for (int dt = 0; dt < 4; ++dt) { f32x4 acc = {0.f, 0.f, 0.f, 0.f}; const int dvr = (hv * 4 + dt) * 16 + fr;
#pragma unroll
        for (int k0 = 0; k0 < 64; k0 += 32) { acc = __builtin_amdgcn_mfma_f32_16x16x32_bf16(gl_frag(lds, GL_VT, dvr, k0, fq), gl_frag(lds, GL_SC, tt * 16 + fr, k0, fq), acc, 0, 0, 0);
            acc = __builtin_amdgcn_mfma_f32_16x16x32_bf16(gl_frag(lds, GL_ST, dvr, k0, fq), gl_frag(lds, GL_QI, tt * 16 + fr, k0, fq), acc, 0, 0, 0); }
        o[dt] = acc; ssq += (acc[0] * acc[0] + acc[1] * acc[1]) + (acc[2] * acc[2] + acc[3] * acc[3]); }
    ssq += __shfl_xor(ssq, 16); ssq += __shfl_xor(ssq, 32);
    LAS float* RS = (LAS float*)(lds + GL_RS);
    if (fq == 0) RS[hv * 64 + tt * 16 + fr] = ssq;
    LDS_WAIT(); __builtin_amdgcn_s_barrier(); asm volatile("" ::: "memory");
    { const int t = tt * 16 + fr; const float rstd = rsqrtf((RS[t] + RS[64 + t]) * (1.f / 128.f) + 1e-5f); const size_t tok = tok0 + t;
#pragma unroll
        for (int dt = 0; dt < 4; ++dt) { const int dv = (hv * 4 + dt) * 16 + 4 * fq; const uint2 gg = *(const uint2*)(P + tok * NINP + 1024 + h * 128 + dv); const f32x4 ng = *(const f32x4*)(norm_g + dv);
            const float g0 = __uint_as_float(gg.x << 16), g1 = __uint_as_float(gg.x & 0xffff0000u), g2 = __uint_as_float(gg.y << 16), g3 = __uint_as_float(gg.y & 0xffff0000u);
            uint2 ov; ov.x = pk2(o[dt][0] * rstd * ng[0] * siluf_(g0), o[dt][1] * rstd * ng[1] * siluf_(g1)); ov.y = pk2(o[dt][2] * rstd * ng[2] * siluf_(g2), o[dt][3] * rstd * ng[3] * siluf_(g3));
            *(uint2*)(O + tok * D + h * 128 + dv) = ov; } }
    LDS_WAIT(); __builtin_amdgcn_s_barrier(); asm volatile("" ::: "memory");
}

constexpr int I_UP = (D / 64) * (NUP / 32), I_DN = (FFP / 64) * (D / 32), I_IN = (D / 64) * (NINP / 32), I_GLU = (512 / 64) * (512 / 32), I_SQ = (D / 64) * (D / 32), I_RK = (KRK / 64) * (NRK / 32), I_L2 = (NL1 / 64) * (3072 / 32);
constexpr int NITEMS = 4 * I_UP + 4 * I_DN + I_IN + I_GLU + 2 * I_SQ + I_RK + I_L2;
DEVI void cvt_dispatch(int r, unsigned char* ws, LAS float* wscr, int lane) {
            if (r < 4 * I_UP) { const int q = r / I_UP, l = q >> 1, f = q & 1; r -= q * I_UP;
                const int kb = r / (NUP / 32), nb = r % (NUP / 32), pn = nb >> 3, half = (nb >> 2) & 1, c0 = pn * 128 + (nb & 3) * 32;
                bf16* dst = (bf16*)(ws + (l ? WS_WUP_L1 : WS_WUP_L0) + f * SZ_WUP) + (size_t)(nb * 32) * D;
                if (c0 >= FF) { SrcZero s; cvt_item(s, dst, D, 1, wscr, kb, lane); }
                else if (half) { SrcPlain s{INPD(f ? 17 : 14) + (size_t)l * D * FF + c0, D, FF - c0, FF}; cvt_item(s, dst, D, 1, wscr, kb, lane); }
                else { SrcPlain s{INPD(f ? 16 : 13) + (size_t)l * D * FF + c0, D, FF - c0, FF}; cvt_item(s, dst, D, 1, wscr, kb, lane); }
                return; } r -= 4 * I_UP;
            if (r < 4 * I_DN) { const int q = r / I_DN, l = q >> 1, f = q & 1; r -= q * I_DN;
                SrcPlain s{INPD(f ? 18 : 15) + (size_t)l * FF * D, FF, D, D};
                cvt_item(s, (bf16*)(ws + (l ? WS_WDN_L1 : WS_WDN_L0) + f * SZ_WDN), FFP, D / 32, wscr, r, lane); return; } r -= 4 * I_DN;
            if (r < I_IN) { SrcPlain s{INPD(19), D, NIN, NIN}; cvt_item(s, (bf16*)(ws + WS_WIN), D, NINP / 32, wscr, r, lane); return; } r -= I_IN;
            if (r < I_GLU) { SrcPlain s{INPD(32), 512, 512, 512}; cvt_item(s, (bf16*)(ws + WS_WGLU), 512, 512 / 32, wscr, r, lane); return; } r -= I_GLU;
            if (r < I_SQ) { SrcPlain s{INPD(20), D, D, D}; cvt_item(s, (bf16*)(ws + WS_WOUT), D, D / 32, wscr, r, lane); return; } r -= I_SQ;
            if (r < I_SQ) { SrcPlain s{INPD(38), D, D, D}; cvt_item(s, (bf16*)(ws + WS_WO), D, D / 32, wscr, r, lane); return; } r -= I_SQ;
            if (r < I_RK) { const int kb = r / (NRK / 32), nb = r % (NRK / 32), n0 = nb * 32; bf16* dst = (bf16*)(ws + WS_WRK) + (size_t)n0 * KRK;
                if (n0 < 1024) { SrcFold s{INPD(35) + n0, INPD(34) + 0 * 1024, 1024}; cvt_item(s, dst, KRK, 1, wscr, kb, lane); }
                else if (n0 < 2048) { SrcFold s{INPD(36) + (n0 - 1024), INPD(34) + 2 * 1024, 1024}; cvt_item(s, dst, KRK, 1, wscr, kb, lane); }
                else if (n0 < 3072) { SrcFold s{INPD(37) + (n0 - 2048), INPD(34) + 3 * 1024, 1024}; cvt_item(s, dst, KRK, 1, wscr, kb, lane); }
                else if (n0 < 3136) { SrcFold s{INPD(40) + (n0 - 3072), INPD(34) + 1 * 1024, 64}; cvt_item(s, dst, KRK, 1, wscr, kb, lane); }
                else if (n0 < 3200) { SrcFold s{INPD(43) + (n0 - 3136), INPD(34) + 4 * 1024, 64}; cvt_item(s, dst, KRK, 1, wscr, kb, lane); }
                else if (n0 < 3360) { SrcFold s{INPD(45) + (n0 - 3200), INPD(34) + 5 * 1024, 160}; cvt_item(s, dst, KRK, 1, wscr, kb, lane); }
                else { SrcZero s; cvt_item(s, dst, KRK, 1, wscr, kb, lane); }
                return; } r -= I_RK;
            { const int kb = r / (3072 / 32), nb = r % (3072 / 32), n0 = nb * 32; bf16* dst = (bf16*)(ws + WS_WL2) + (size_t)n0 * NL1;
                if (n0 < 1024) { SrcBlk s{INPD(41) + n0, 0, 64}; cvt_item(s, dst, NL1, 1, wscr, kb, lane); }
                else if (n0 < 2048) { SrcBlk s{INPD(44) + (n0 - 1024), 64, 128}; cvt_item(s, dst, NL1, 1, wscr, kb, lane); }
                else { SrcBlk s{INPD(46) + (n0 - 2048), 128, 288}; cvt_item(s, dst, NL1, 1, wscr, kb, lane); } }
}

__global__ void __launch_bounds__(NWAVES * 64, 2) __attribute__((target("no-packed-fp32-ops"))) mk_fwd(Args args) {
    extern __shared__ __attribute__((aligned(16))) unsigned char lds_raw[];
    LAS unsigned char* lds = (LAS unsigned char*)lds_raw;
    volatile LAS unsigned* MISC = (volatile LAS unsigned*)(lds + MISC_OFF);
    const int tid = threadIdx.x, lane = tid & 63, wave = __builtin_amdgcn_readfirstlane(tid >> 6), G = gridDim.x, blk = blockIdx.x;
#define LW() (*(unsigned char* const __attribute__((address_space(4)))*)(KARG() + 424))
#define LO() (*(float* const __attribute__((address_space(4)))*)(KARG() + 416))
#define PTRS unsigned char* ws = LW(); float* out = LO(); float* MODS = (float*)(ws + WS_MODS); float* SP = (float*)(ws + WS_SP); bf16* H = (bf16*)(ws + WS_H); float* Z = (float*)(ws + WS_Z); bf16* ACT = (bf16*)(ws + WS_ACT); float* X = out; \
    (void)MODS; (void)SP; (void)H; (void)Z; (void)ACT; (void)X
    for (int u = tid; u < (LDS_BYTES - LDSCTL_OFF) / 4; u += NWAVES * 64) ((LAS unsigned*)(lds + LDSCTL_OFF))[u] = 0u;
    __syncthreads();
    { XcdBarrier b0_ = xcd_barrier_post((unsigned*)(LW() + WS_CTL) + CW_BAR, MISC + 8); (void)b0_; }
#define GRID_BAR() do { XcdBarrier b_; b_.bar = (unsigned*)(LW() + WS_CTL) + CW_BAR; b_.x = xb_xcc_id(); b_.st = MISC + 8; xcd_barrier(b_); if (XP == 6) xcd_barrier(b_); \
        if (PROBE && blk == 0 && tid == 0) ((unsigned long long*)(LW() + WS_CTL + 524288))[nst] = rt(); ++nst; } while (0)
    int nst = 0;
    if (PROBE && blk == 0 && tid == 0) ((unsigned long long*)(LW() + WS_CTL + 524288))[63] = rt();
    const int gw = blk * NWAVES + wave, NGW = G * NWAVES;
    const int gws = wave * G + blk;
    LAS float* wscr = (LAS float*)(lds + RING_OFF + wave * 16384);
    const int NP0 = G > 72 ? (G - 72) * NWAVES * P0_PER : 0;

    for (int xrep = 0; xrep < (XP == 1 ? 2 : 1); ++xrep) { PTRS;
        { float* STt = (float*)(ws + WS_ST); for (int i = blk * 512 + tid; i < 144 * 1024; i += G * 512) { const int r = i >> 10, k = i & 1023; float v = 0.f; if (r < 8) v = siluf_(INP(7)[r * 1024 + k]); else if (r < 136) v = siluf_(INP(8)[(r - 8) * 1024 + k]); STt[k * 144 + r] = v; } }
        for (int it = blk * 512 + tid; it < 2048 * 18; it += G * 512) { const int i = it & 2047, tau = it >> 11;
            if (tau == 17) s5prep_one(i, INP(24), INP(25), INP(26), INP(27), INP(28), SP); else s5prep_pw(i, tau, INP(24), INP(25), INP(26), SP); }
        if (blk >= 72) for (int it = (blk - 72) * NWAVES + wave; it < NP0; it += (G - 72) * NWAVES) cvt_dispatch(it, ws, wscr, lane);
    }
    GRID_BAR();
    for (int xq = 0; xq < (XP == 17 ? 2 : 1); ++xq) { PTRS; bf16* TM = (bf16*)(ws + WS_TM); bf16* HM = (bf16*)(ws + WS_HM);
        constexpr int NMW = 864, HS = MODS_HS;
        for (int xr = 0; xr < (XP == 10 ? 2 : 1); ++xr) for (int j = gws; j < NMW; j += NGW) { int cg, rs; if (j < 768) { cg = j & 255; rs = j >> 8; } else { const int e = j - 768; cg = 256 + e / 3; rs = e - (e / 3) * 3; }
            mods_job3(__builtin_amdgcn_readfirstlane(cg), __builtin_amdgcn_readfirstlane(rs), lane, (const float*)(ws + WS_ST), INPD(9), INPD(10), MODS); }
        const int ncw = NGW - NMW, NA = ncw > 0 ? (NP0 + HS * ncw < NITEMS ? NP0 + HS * ncw : NITEMS) : NP0;
        for (int xc = 0; xc < (XP == 19 ? 2 : 1); ++xc) { bool stA = (gws >= NMW) && NA > NP0;
        for (int itn = stA ? NP0 + gws - NMW : NA + (NGW - 1 - gws); itn < NITEMS; ) {
            int r = itn;
            if (stA) { itn += ncw; if (itn >= NA) { stA = false; itn = NA + (NGW - 1 - gws); } } else itn += NGW;
            cvt_dispatch(r, ws, wscr, lane);
        } }
        for (int xr = 0; xr < (XP == 20 ? 2 : 1); ++xr) for (int j = NGW - 1 - gws; j < 32 * 17 + 32 * 16; j += NGW) { if (j < 544) s5_tm_job(j / 17, j % 17, lane, SP, INPD(29), INPD(30), INPD(31), TM); else s5_hm_job((j - 544) >> 4, (j - 544) & 15, lane, SP, HM); }
        for (int i = gw * 64 + lane; i < 32 * 128 * 256 / 8; i += NGW * 64) { const int g = i >> 12, r = i & 4095; *(v4u*)(HM + ((size_t)g * 256 + 128) * 256 + (size_t)r * 8) = (v4u){0u, 0u, 0u, 0u}; } }
    GRID_BAR();
    { PTRS; for (int xr = 0; xr < (XP == 18 ? 2 : 1); ++xr) { int row = gw; for (; row + 3 * NGW < NP; row += 4 * NGW) init_rows<4>(row, NGW, lane, INP(0), MODS, H); for (; row < MTP; row += NGW) init_row(row, lane, INP(0), INP(1), MODS, X, H, (float*)(ws + WS_ZS)); } }
    GRID_BAR();

#define GEMM_PHASE(EPI, Aptr, Bptr, NN, KK, ...) do { pg8::GemmX g_{(const pg8::bf16_t*)(Aptr), (const pg8::bf16_t*)(Bptr), MTP, NN, KK, KK, KK, -1}; pg8::StaticOrder S_; S_.init(MTP, NN, G, blk); pg8::EPI E_{__VA_ARGS__}; \
        pg8::gemm_phase<pg8::EPI, pg8::StaticOrder, true, true>(lds + RING_OFF, g_, S_, E_); } while (0)
#define GEMMX_PHASE(EPI, Aptr, Bptr, MM, NN, KK, LDA, LDB, GSH, ...) do { pg8::GemmX g_{(const pg8::bf16_t*)(Aptr), (const pg8::bf16_t*)(Bptr), MM, NN, KK, LDA, LDB, GSH}; pg8::StaticOrder S_; S_.init(MM, NN, G, blk); pg8::EPI E_{__VA_ARGS__}; \
        pg8::gemm_phase<pg8::EPI, pg8::StaticOrder, true, true>(lds + RING_OFF, g_, S_, E_); } while (0)
#define RESID_PHASE(XS, Aptr, Bptr, KK, gatep, rcv) do { \
        { pg8::GemmX g_{(const pg8::bf16_t*)(Aptr), (const pg8::bf16_t*)(Bptr), NP, D, KK, KK, KK, -1}; pg8::StaticOrder S_; S_.init(NP, D, G, blk); pg8::EpiResid E_{(XS), Z, gatep, rcv, 0}; \
          pg8::gemm_phase<pg8::EpiResid, pg8::StaticOrder, true, true>(lds + RING_OFF, g_, S_, E_); } \
        { pg8::GemmX g_{(const pg8::bf16_t*)(Aptr), (const pg8::bf16_t*)(Bptr), MTP, D, 256, KK, KK, -1}; pg8::SplitOrder S_{64, 4, (KK) / 256, 256, G, blk}; pg8::EpiResidS E_{(float*)(ws + WS_SL), gatep, rcv, 0}; \
          pg8::gemm_phase<pg8::EpiResidS, pg8::SplitOrder, true, true>(lds + RING_OFF, g_, S_, E_); } } while (0)
#define LN_PASS(l, idx, Hout, nsh, nsc) do { PTRS; const int nsl_ = ((idx) == 1) ? 4 : 11; int row = gw; for (; row + 3 * NGW < NP; row += 4 * NGW) ln_rows<4>(row, NGW, lane, Z, INP(11) + ((l) * 3 + (idx)) * D, INP(12) + ((l) * 3 + (idx)) * D, X, Hout, nsh, nsc); \
        for (; row < MT; row += NGW) ln_row(row, lane, Z, (float*)(ws + WS_ZS), (const float*)(ws + WS_SL), nsl_, INP(11) + ((l) * 3 + (idx)) * D, INP(12) + ((l) * 3 + (idx)) * D, X, Hout, nsh, nsc); } while (0)
#define FFN(XS, l, f, which0, lnidx, HOUT, nshw, nscw) do { \
        { PTRS; { int ru_ = (XP == 41 ? 2 : 1); asm volatile("" : "+s"(ru_)); for (int xu = 0; xu < ru_; ++xu) GEMM_PHASE(EpiSwiglu, H, ws + ((l) ? WS_WUP_L1 : WS_WUP_L0) + (f) * SZ_WUP, NUP, D, (pg8::bf16_t*)ACT); } if (XP == 2) { GEMM_PHASE(EpiSwiglu, H, ws + ((l) ? WS_WUP_L1 : WS_WUP_L0) + (f) * SZ_WUP, NUP, D, (pg8::bf16_t*)ACT); } if (XP == 42) { GEMM_PHASE(EpiHloc, H, ws + ((l) ? WS_WUP_L1 : WS_WUP_L0) + (f) * SZ_WUP, NUP, D, (float*)(ws + WS_Z)); } } GRID_BAR(); \
        { PTRS; RESID_PHASE(XS, ACT, ws + ((l) ? WS_WDN_L1 : WS_WDN_L0) + (f) * SZ_WDN, FFP, modp(MODS, l, (which0) + 2), 0.5f); if (XP == 3) { RESID_PHASE(XS, ACT, ws + ((l) ? WS_WDN_L1 : WS_WDN_L0) + (f) * SZ_WDN, FFP, modp(MODS, l, (which0) + 2), 0.5f); } } GRID_BAR(); \
        LN_PASS(l, lnidx, HOUT, nshw, nscw); if (XP == 4) { LN_PASS(l, lnidx, HOUT, nshw, nscw); } GRID_BAR(); } while (0)

    FFN(INP(0), 0, 0, 0, 0, H, modp(MODS, 0, 3), modp(MODS, 0, 4));
#define L0PTRS PTRS; bf16* P = (bf16*)(ws + WS_P); float* GKL = (float*)(ws + WS_GKL); float* OGS = (float*)(ws + WS_OGS) - (size_t)NP * 512; bf16* Z5 = (bf16*)(ws + WS_Z5); bf16* O = (bf16*)(ws + WS_O); \
        bf16* UB = (bf16*)(ws + WS_UBUF); float* HL = (float*)(ws + WS_HLOC); float* KV = (float*)(ws + WS_KV); float* DEC = (float*)(ws + WS_DEC); (void)P; (void)GKL; (void)OGS; (void)Z5; (void)O; (void)UB; (void)HL; (void)KV; (void)DEC
    { L0PTRS; for (int xr = 0; xr < (XP == 11 ? 2 : 1); ++xr) GEMM_PHASE(EpiInproj, H, ws + WS_WIN, NINP, D, (pg8::bf16_t*)P, GKL, (pg8::bf16_t*)UB); } GRID_BAR();
    for (int xr = 0; xr < (XP == 12 ? 2 : 1); ++xr) { if (xr) { GRID_BAR(); --nst; } L0PTRS;
        { int reps_ = (XP == 25 ? 2 : (XP == 26 ? 5 : 1)); asm volatile("" : "+s"(reps_)); for (int xh = 0; xh < reps_; ++xh) GEMMX_PHASE(EpiHloc, UB, ws + WS_HM, 32768, 256, 256, 384, 256, 2, HL); }
        for (int u = (blk + 128) & 255; u < 1024; u += 256) gla_unit_a(lds + RING_OFF, tid, u, P, GKL, INPD(21), INPD(22), KV, DEC);
    }
    GRID_BAR();
    { L0PTRS;
        if (blk >= 128) gla_scan_b((blk - 128) * 512 + tid, KV, DEC, out + O_GLA_P);
        else if (wave < 2) { const int j = wave * 128 + blk;
            for (int xr = 0; xr < (XP == 13 ? 2 : 1); ++xr) s5_carry_job(j >> 5, j & 31, lane, SP, HL, UB, out + O_S5RE_P, out + O_S5IM_P); }
        else for (int s = (wave - 2) * 128 + blk; s < 1536; s += 768) {
            if (s < 1024) gla_job(wscr, lane, s >> 3, (s >> 1) & 3, s & 1, P, GKL, INPD(21), INPD(22), NP, 1, INPD(2), out + O_GLA_S, OGS);
            else { const int j = s - 1024; s5_job(wscr, lane, j & 31, (j >> 5) * 8, 8, P, SP, INPD(29), INPD(30), INPD(31), NP, 1, INPD(3), INPD(4), out + O_S5RE_S, out + O_S5IM_S, Z5); } }
    } GRID_BAR();
    for (int xr = 0; xr < (XP == 14 ? 2 : 1); ++xr) { L0PTRS;
        GEMMX_PHASE(EpiS5Y, UB, ws + WS_TM, 32768, 256, 384, 384, 384, 2, (pg8::bf16_t*)Z5);
        for (int u = (blk + 128) & 255; u < 1024; u += 256) gla_unit_c(lds + RING_OFF, tid, u, P, GKL, INPD(21), INPD(22), KV, INPD(23), O);
        for (int w = NP * 4 + gw; w < MT * 4; w += NGW) gla_post_one(w, lane, OGS, P, INP(23), O); } GRID_BAR();
    { L0PTRS; { int rg_ = (XP == 24 ? 2 : 1); asm volatile("" : "+s"(rg_)); for (int xr = 0; xr < rg_; ++xr) GEMM_PHASE(EpiGlu, Z5, ws + WS_WGLU, 512, 512, (const pg8::bf16_t*)Z5, (pg8::bf16_t*)O, INP(33)); }
        if (XP == 40) { int rh_ = 2; asm volatile("" : "+s"(rh_)); for (int xr = 0; xr < rh_; ++xr) GEMM_PHASE(EpiHloc, Z5, ws + WS_WGLU, 512, 512, HL); } } GRID_BAR();
    { L0PTRS; RESID_PHASE(X, O, ws + WS_WOUT, D, modp(MODS, 0, 5), 1.0f); } GRID_BAR();
    LN_PASS(0, 1, H, modp(MODS, 0, 6), modp(MODS, 0, 7)); GRID_BAR();
    FFN(X, 0, 1, 6, 2, H, modp(MODS, 1, 0), modp(MODS, 1, 1));
    FFN(X, 1, 0, 0, 0, (bf16*)nullptr, (const float*)nullptr, (const float*)nullptr);
#define L1PTRS PTRS; bf16* A2 = (bf16*)(ws + WS_A2); bf16* R = (bf16*)(ws + WS_R); bf16* Kb = (bf16*)(ws + WS_K); bf16* V = (bf16*)(ws + WS_V); bf16* L1 = (bf16*)(ws + WS_L1A); \
        bf16* WRAW = (bf16*)(ws + WS_WRAW); bf16* YB = (bf16*)(ws + WS_YB); float* BON = (float*)(ws + WS_BON); bf16* AS = (bf16*)(ws + WS_AS); bf16* Gt = (bf16*)(ws + WS_G); (void)A2; (void)R; (void)Kb; (void)V; (void)L1; (void)WRAW; (void)YB; (void)BON; (void)AS; (void)Gt
    { L1PTRS; int row = gw; for (; row + 3 * NGW < NP; row += 4 * NGW) shiftcat_rows<4>(row, NGW, lane, X, MODS, A2, out); for (; row < MTP; row += NGW) shiftcat_row(row, lane, X, MODS, INP(5), A2, out); } GRID_BAR();
    { L1PTRS; GEMM_PHASE(EpiRk, A2, ws + WS_WRK, NRK, KRK, (pg8::bf16_t*)R, (size_t)MTP * D, (pg8::bf16_t*)L1); if (XP == 7) { GEMM_PHASE(EpiRk, A2, ws + WS_WRK, NRK, KRK, (pg8::bf16_t*)R, (size_t)MTP * D, (pg8::bf16_t*)L1); } } GRID_BAR();
    { L1PTRS; GEMM_PHASE(EpiLora2, L1, ws + WS_WL2, 3072, NL1, (pg8::bf16_t*)WRAW, (pg8::bf16_t*)AS, (pg8::bf16_t*)Gt, INP(42)); } GRID_BAR();
    if (XP == 21 || XP == 22) { L1PTRS; bf16* dY = (bf16*)(ws + WS_L0 + 32 * MiB); float* dB = (float*)(ws + WS_L0 + 26 * MiB); float* dS = (float*)(ws + WS_L0 + 25 * MiB + 524288);
        if (XP == 21) wkv_half<1>((LAS float*)(lds + RING_OFF), tid, 0, 0, 0, R, Kb, V, WRAW, AS, INPD(39), INPD(47), INPD(48), INPD(49), dY, dB, dS);
        else wkv_half<2>((LAS float*)(lds + RING_OFF), tid, 0, 0, 0, R, Kb, V, WRAW, AS, INPD(39), INPD(47), INPD(48), INPD(49), dY, dB, dS); __syncthreads(); }
    for (int xr = 0; xr < (XP == 5 ? 2 : 1); ++xr) { L1PTRS; wkv_half2((LAS float*)(lds + RING_OFF), tid, blk >> 5, (blk >> 1) & 15, blk & 1, R, Kb, V, WRAW, AS, INPD(39), INPD(47), INPD(48), INPD(49), YB, BON, out + O_WKV_P); if (XP == 5) __syncthreads(); } GRID_BAR();
    { L1PTRS;
        { int t = gw; for (; t + 3 * NGW < NP; t += 4 * NGW) wkv_ypass_rows4((size_t)t, (size_t)NGW, lane, YB, V, Gt, BON, INPD(50), INPD(51)); for (; t < NP; t += NGW) wkv_ypass_row((size_t)t, lane, YB, V, Gt, BON, INPD(50), INPD(51)); }
        for (int s = gws; s < 2048; s += NGW) wkv_job(wscr, lane, s >> 4, s & 15, R, Kb, V, WRAW, INPD(39), AS, Gt, INPD(47), INPD(48), INPD(49), INPD(50), INPD(51), NP, 1, INPD(6), out + O_WKV_S); }
    GRID_BAR();
    { L1PTRS; RESID_PHASE(X, Gt, ws + WS_WO, D, modp(MODS, 1, 5), 1.0f); } GRID_BAR();
    LN_PASS(1, 1, H, modp(MODS, 1, 6), modp(MODS, 1, 7)); GRID_BAR();
    { PTRS; GEMM_PHASE(EpiSwiglu, H, ws + WS_WUP_L1 + SZ_WUP, NUP, D, (pg8::bf16_t*)ACT); if (XP == 2) { GEMM_PHASE(EpiSwiglu, H, ws + WS_WUP_L1 + SZ_WUP, NUP, D, (pg8::bf16_t*)ACT); } } GRID_BAR();
    { PTRS; RESID_PHASE(X, ACT, ws + WS_WDN_L1 + SZ_WDN, FFP, modp(MODS, 1, 8), 0.5f); if (XP == 3) { RESID_PHASE(X, ACT, ws + WS_WDN_L1 + SZ_WDN, FFP, modp(MODS, 1, 8), 0.5f); } } GRID_BAR();
    LN_PASS(1, 2, (bf16*)nullptr, (const float*)nullptr, (const float*)nullptr); if (XP == 4) { LN_PASS(1, 2, (bf16*)nullptr, (const float*)nullptr, (const float*)nullptr); }
#if PROBE
    {
        __syncthreads();
        PTRS; const unsigned long long* TS = (const unsigned long long*)(ws + WS_CTL + 524288);
        const float v1 = (float)(TS[PROBE_A1] - TS[PROBE_A0]) * 0.01f, v2 = (float)(TS[PROBE_B1] - TS[PROBE_B0]) * 0.01f * 10.0f;
        for (int row = NP + gw; row < MT; row += NGW) for (int j = 0; j < 16; ++j) X[(size_t)row * D + j * 64 + lane] = v1;
        if (blk == 0 && tid == 0) out[O_WKV_S] = v2;
    }
#endif
}

extern "C" void kernel_launch(void* const* d_in, const int* in_sizes, int n_in, void* d_out, int out_size, void* d_ws, size_t ws_size, hipStream_t stream) {
    static int grid = 0;
    if (grid == 0) {
        if (n_in != 52 || ws_size < WS_END) { fprintf(stderr, "kernel_launch: unexpected n_in %d or ws %zu\n", n_in, ws_size); grid = -1; return; }
        int dev = 0, cus = 0, per_cu = 0;
        if (hipGetDevice(&dev) != hipSuccess || hipDeviceGetAttribute(&cus, hipDeviceAttributeMultiprocessorCount, dev) != hipSuccess) { grid = -1; return; }
        if (hipFuncSetAttribute((const void*)mk_fwd, hipFuncAttributeMaxDynamicSharedMemorySize, LDS_BYTES) != hipSuccess) { fprintf(stderr, "hipFuncSetAttribute failed\n"); grid = -1; return; }
        if (hipOccupancyMaxActiveBlocksPerMultiprocessor(&per_cu, (const void*)mk_fwd, NWAVES * 64, LDS_BYTES) != hipSuccess || per_cu < 1) { fprintf(stderr, "occupancy query: %d\n", per_cu); per_cu = 1; }
        (void)hipGetLastError();
        grid = cus;
    }
    if (grid < 0) return;
    (void)hipMemsetAsync((char*)d_ws + WS_CTL, 0, CTL_ZERO_BYTES, stream);
    Args a{};
    for (int i = 0; i < 52; ++i) a.in[i] = (const float*)d_in[i];
    a.out = (float*)d_out; a.ws = (unsigned char*)d_ws;
    hipLaunchKernelGGL(mk_fwd, dim3(grid), dim3(NWAVES * 64), LDS_BYTES, stream, a);
}
```
